# Optimizing an MI355X kernel written in HIP

```python
import math
import jax, jax.numpy as jnp
from jax import lax
import numpy as np

D_MODEL = 1024
BATCH = 8
SEQ = 2048
DEPTH = 2

CHUNK = 64
Q_BLOCK = 128
PLE_DIM = 256

A_HEADS = 6
A_DIM = 32
A_VDIM = 2 * A_DIM
B_HEADS = 6
B_Q_RANK = 256
B_KV_RANK = 128
B_NOPE = 64
B_ROPE = 32
B_VDIM = 64
ROPE_THETA = 10000.0
C_HEADS = 4
C_DIM = 64

MIX_A = A_HEADS * A_VDIM
MIX_B = B_HEADS * B_VDIM
MIX_C = C_HEADS * C_DIM
D_MIX = MIX_A + MIX_B + MIX_C
IN_SPLITS = (A_HEADS * 2 * A_DIM, A_HEADS * 2 * A_DIM, MIX_A,
             B_Q_RANK, B_KV_RANK, B_ROPE,
             MIX_C, MIX_C, MIX_C, C_HEADS)
D_IN = sum(IN_SPLITS)

N_GROUPS = 4
EXPERTS_PER_GROUP = 8
N_EXPERTS = N_GROUPS * EXPERTS_PER_GROUP
TOP_K_IN_GROUP = 2
D_EXPERT = 256

DEEPNORM_ALPHA = (2 * DEPTH) ** 0.25
DEEPNORM_BETA = (8 * DEPTH) ** -0.25
LN_EPS = 1e-5
RMS_EPS = 1e-6

kernel_name = "hymba_style_diff_mla_fox_hiermoe_deepnorm"


def _layer_norm(x, g, b):
    xf = x.astype(jnp.float32)
    mu = jnp.mean(xf, axis=-1, keepdims=True)
    var = jnp.mean(jnp.square(xf - mu), axis=-1, keepdims=True)
    y = (xf - mu) * lax.rsqrt(var + LN_EPS) * g.astype(jnp.float32) + b.astype(jnp.float32)
    return y.astype(x.dtype)


def _rms_norm(x, g):
    xf = x.astype(jnp.float32)
    y = xf * lax.rsqrt(jnp.mean(jnp.square(xf), axis=-1, keepdims=True) + RMS_EPS)
    return (y * g.astype(jnp.float32)).astype(x.dtype)


def _rope_tables(pos):
    half = B_ROPE // 2
    inv = ROPE_THETA ** (-jnp.arange(half, dtype=jnp.float32) / half)
    ang = pos.astype(jnp.float32)[..., None] * inv
    return jnp.cos(ang), jnp.sin(ang)


def _rope(x, cos, sin):
    half = x.shape[-1] // 2
    x1, x2 = x[..., :half], x[..., half:]
    c, s = cos.astype(x.dtype), sin.astype(x.dtype)
    return jnp.concatenate([x1 * c - x2 * s, x2 * c + x1 * s], axis=-1)


def _alibi_slopes(n):
    return 2.0 ** (-8.0 * jnp.arange(1, n + 1, dtype=jnp.float32) / n)


def _to_heads(t, n_heads):
    b, s, _ = t.shape
    return t.reshape(b, s, n_heads, -1).transpose(0, 2, 1, 3)


def _from_heads(t):
    b, h, s, d = t.shape
    return t.transpose(0, 2, 1, 3).reshape(b, s, h * d)


def _block_attention(q, k, v, scale, bias_fn, per_frame_causal):
    seq = q.shape[2]
    outs = []
    for t0 in range(0, seq, Q_BLOCK):
        t1 = t0 + Q_BLOCK
        logits = jnp.einsum('bhqd,bhkd->bhqk', q[:, :, t0:t1], k[:, :, :t1],
                            preferred_element_type=jnp.float32) * scale
        if bias_fn is not None:
            logits = logits + bias_fn(t0, t1)
        t_idx = jnp.arange(t0, t1)[:, None]
        s_idx = jnp.arange(t1)[None, :]
        allowed = (s_idx <= t_idx) if per_frame_causal else (s_idx // CHUNK <= t_idx // CHUNK)
        logits = jnp.where(allowed, logits, -jnp.inf)
        probs = jax.nn.softmax(logits, axis=-1).astype(v.dtype)
        outs.append(jnp.einsum('bhqk,bhkd->bhqd', probs, v[:, :, :t1]))
    return jnp.concatenate(outs, axis=2)


def _token_mixers(x, layer, pos, cos, sin, w_in, w_uq, w_ukv, g_cq, g_ckv,
                  lam_q1, lam_k1, lam_q2, lam_k2, g_diff, b_forget, w_out):
    b, s, _ = x.shape
    z = x @ w_in
    qa, ka, va, cq, ckv, kr, qc, kc, vc, fc = jnp.split(
        z, np.cumsum(IN_SPLITS)[:-1].tolist(), axis=-1)

    qa = qa.reshape(b, s, A_HEADS, 2, A_DIM)
    ka = ka.reshape(b, s, A_HEADS, 2, A_DIM)
    qa1, qa2 = qa[:, :, :, 0].transpose(0, 2, 1, 3), qa[:, :, :, 1].transpose(0, 2, 1, 3)
    ka1, ka2 = ka[:, :, :, 0].transpose(0, 2, 1, 3), ka[:, :, :, 1].transpose(0, 2, 1, 3)
    v_a = _to_heads(va, A_HEADS)
    slopes = _alibi_slopes(A_HEADS)
    posf = pos.astype(jnp.float32)

    def alibi(t0, t1):
        dist = jnp.abs(posf[:, None, t0:t1, None] - posf[:, None, None, :t1])
        return -slopes[None, :, None, None] * dist

    scale_a = 1.0 / math.sqrt(A_DIM)
    o_a1 = _block_attention(qa1, ka1, v_a, scale_a, alibi, False)
    o_a2 = _block_attention(qa2, ka2, v_a, scale_a, alibi, False)
    lam_init = 0.8 - 0.6 * math.exp(-0.3 * layer)
    lam = (jnp.exp(jnp.sum(lam_q1.astype(jnp.float32) * lam_k1.astype(jnp.float32)))
           - jnp.exp(jnp.sum(lam_q2.astype(jnp.float32) * lam_k2.astype(jnp.float32))) + lam_init)
    o_a = o_a1 - lam.astype(o_a1.dtype) * o_a2
    o_a = _rms_norm(o_a, g_diff) * (1.0 - lam_init)

    c_q = _rms_norm(cq, g_cq)
    q_b = (c_q @ w_uq).reshape(b, s, B_HEADS, B_NOPE + B_ROPE)
    q_rope = _rope(q_b[..., B_NOPE:], cos[:, :, None], sin[:, :, None])
    q_b = jnp.concatenate([q_b[..., :B_NOPE], q_rope], axis=-1)
    c_kv = _rms_norm(ckv, g_ckv)
    kv_b = (c_kv @ w_ukv).reshape(b, s, B_HEADS, B_NOPE + B_VDIM)
    k_nope, v_b = kv_b[..., :B_NOPE], kv_b[..., B_NOPE:]
    k_rope = _rope(kr, cos, sin)
    k_b = jnp.concatenate(
        [k_nope, jnp.broadcast_to(k_rope[:, :, None], (b, s, B_HEADS, B_ROPE))], axis=-1)
    o_b = _block_attention(q_b.transpose(0, 2, 1, 3), k_b.transpose(0, 2, 1, 3),
                           v_b.transpose(0, 2, 1, 3), 1.0 / math.sqrt(B_NOPE + B_ROPE),
                           None, False)

    log_f = jax.nn.log_sigmoid(fc.astype(jnp.float32) + b_forget.astype(jnp.float32))
    cum = jnp.cumsum(log_f, axis=1).transpose(0, 2, 1)

    def decay(t0, t1):
        return cum[:, :, t0:t1, None] - cum[:, :, None, :t1]

    o_c = _block_attention(_to_heads(qc, C_HEADS), _to_heads(kc, C_HEADS),
                           _to_heads(vc, C_HEADS), 1.0 / math.sqrt(C_DIM), decay, True)

    mixed = jnp.concatenate([_from_heads(o_a), _from_heads(o_b), _from_heads(o_c)], axis=-1)
    return mixed @ w_out


def _hier_moe(h, w_group, b_group, w_erouter, b_erouter, w_gate_e, w_up_e, w_down_e):
    b, s, d = h.shape
    xt = h.reshape(b * s, d)
    g_logits = (xt @ w_group).astype(jnp.float32) + b_group.astype(jnp.float32)
    g_prob = jax.nn.softmax(g_logits, axis=-1)
    _, g_idx = lax.top_k(g_logits, 1)
    g_w = jnp.take_along_axis(g_prob, g_idx, axis=-1)
    e_all = jnp.einsum('nd,gde->nge', xt, w_erouter).astype(jnp.float32) + b_erouter.astype(jnp.float32)
    e_logits = jnp.einsum('ng,nge->ne', jax.nn.one_hot(g_idx[:, 0], N_GROUPS, dtype=jnp.float32), e_all)
    top_val, top_idx = lax.top_k(e_logits, TOP_K_IN_GROUP)
    e_w = jax.nn.softmax(top_val, axis=-1) * g_w
    expert_id = g_idx * EXPERTS_PER_GROUP + top_idx
    combine = jnp.sum(jax.nn.one_hot(expert_id, N_EXPERTS, dtype=jnp.float32) * e_w[..., None], axis=1)
    gate = jnp.einsum('nd,edf->nef', xt, w_gate_e)
    up = jnp.einsum('nd,edf->nef', xt, w_up_e)
    act = jax.nn.silu(gate) * up * combine[:, :, None].astype(xt.dtype)
    y = jnp.einsum('nef,efd->nd', act, w_down_e)
    return y.reshape(b, s, d)


def setup_inputs(seed: int = 0) -> dict:
    key = jax.random.key(seed)
    ks = iter(jax.random.split(key, 32))

    def nrm(shape, scale):
        return jax.random.normal(next(ks), shape, jnp.float32) * scale

    def gain(shape):
        return 1.0 + nrm(shape, 0.02)

    x = nrm((BATCH, SEQ, D_MODEL), 1.0)
    p = nrm((DEPTH, BATCH, SEQ, PLE_DIM), 1.0)
    offset = jax.random.randint(next(ks), (BATCH,), 0, 64, jnp.int32) * CHUNK
    positions = offset[:, None] + jnp.arange(SEQ, dtype=jnp.int32)[None, :]
    return {
        "x": x,
        "p": p,
        "positions": positions,
        "w_in": nrm((DEPTH, D_MODEL, D_IN), D_MODEL ** -0.5),
        "w_uq": nrm((DEPTH, B_Q_RANK, B_HEADS * (B_NOPE + B_ROPE)), B_Q_RANK ** -0.5),
        "w_ukv": nrm((DEPTH, B_KV_RANK, B_HEADS * (B_NOPE + B_VDIM)), B_KV_RANK ** -0.5),
        "g_cq": gain((DEPTH, B_Q_RANK)),
        "g_ckv": gain((DEPTH, B_KV_RANK)),
        "lam_q1": nrm((DEPTH, A_DIM), 0.1),
        "lam_k1": nrm((DEPTH, A_DIM), 0.1),
        "lam_q2": nrm((DEPTH, A_DIM), 0.1),
        "lam_k2": nrm((DEPTH, A_DIM), 0.1),
        "g_diff": gain((DEPTH, A_VDIM)),
        "b_forget": 2.0 + nrm((DEPTH, C_HEADS), 0.1),
        "w_out": nrm((DEPTH, D_MIX, D_MODEL), D_MIX ** -0.5 * DEEPNORM_BETA),
        "ln1_g": gain((DEPTH, D_MODEL)),
        "ln1_b": nrm((DEPTH, D_MODEL), 0.02),
        "w_group": nrm((DEPTH, D_MODEL, N_GROUPS), D_MODEL ** -0.5),
        "b_group": nrm((DEPTH, N_GROUPS), 0.01),
        "w_erouter": nrm((DEPTH, N_GROUPS, D_MODEL, EXPERTS_PER_GROUP), D_MODEL ** -0.5),
        "b_erouter": nrm((DEPTH, N_GROUPS, EXPERTS_PER_GROUP), 0.01),
        "w_gate_e": nrm((DEPTH, N_EXPERTS, D_MODEL, D_EXPERT), D_MODEL ** -0.5),
        "w_up_e": nrm((DEPTH, N_EXPERTS, D_MODEL, D_EXPERT), D_MODEL ** -0.5),
        "w_down_e": nrm((DEPTH, N_EXPERTS, D_EXPERT, D_MODEL), D_EXPERT ** -0.5 * DEEPNORM_BETA),
        "w_ple_gate": nrm((DEPTH, D_MODEL, D_MODEL), D_MODEL ** -0.5),
        "w_ple_proj": nrm((DEPTH, PLE_DIM, D_MODEL), PLE_DIM ** -0.5 * DEEPNORM_BETA),
        "ln2_g": gain((DEPTH, D_MODEL)),
        "ln2_b": nrm((DEPTH, D_MODEL), 0.02),
    }


def reference(x, p, positions, w_in, w_uq, w_ukv, g_cq, g_ckv, lam_q1, lam_k1, lam_q2, lam_k2,
              g_diff, b_forget, w_out, ln1_g, ln1_b, w_group, b_group, w_erouter, b_erouter,
              w_gate_e, w_up_e, w_down_e, w_ple_gate, w_ple_proj, ln2_g, ln2_b):
    cos, sin = _rope_tables(positions)
    for i in range(DEPTH):
        mix = _token_mixers(x, i, positions, cos, sin, w_in[i], w_uq[i], w_ukv[i], g_cq[i],
                            g_ckv[i], lam_q1[i], lam_k1[i], lam_q2[i], lam_k2[i], g_diff[i],
                            b_forget[i], w_out[i])
        h = _layer_norm(DEEPNORM_ALPHA * x + mix, ln1_g[i], ln1_b[i])
        moe = _hier_moe(h, w_group[i], b_group[i], w_erouter[i], b_erouter[i],
                        w_gate_e[i], w_up_e[i], w_down_e[i])
        ple = jax.nn.sigmoid(h @ w_ple_gate[i]) * (p[i].astype(h.dtype) @ w_ple_proj[i])
        x = _layer_norm(DEEPNORM_ALPHA * h + moe + ple, ln2_g[i], ln2_b[i])
    return x
```

```cpp
#include <hip/hip_runtime.h>
#include <hip/hip_cooperative_groups.h>
#include <cstdio>
#include <cstdint>
namespace cg = cooperative_groups;

constexpr int D_MODEL = 1024, BATCH = 8, SEQ = 2048, NTOK = BATCH * SEQ, DEPTH = 2;
constexpr int D_IN = 2340;
constexpr int OFF_QA = 0, OFF_KA = 384, OFF_VA = 768, OFF_CQ = 1152, OFF_CKV = 1408, OFF_KR = 1536,
              OFF_QC = 1568, OFF_KC = 1824, OFF_VC = 2080, OFF_FC = 2336;
constexpr int A_HEADS = 6, B_HEADS = 6, C_HEADS = 4;
constexpr int NQB = 576, NKVB = 768;
constexpr int N_EXPERTS = 32, D_EXPERT = 256, PLE_DIM = 256;
constexpr int MAX_SLOTS = 32768 + 32 * 128;
constexpr int NSLOT_TILES = MAX_SLOTS / 128;
constexpr float ALPHA = 1.4142135623730951f;
constexpr float LN_EPS = 1e-5f, RMS_EPS = 1e-6f;
constexpr int NTHREADS = 512;

constexpr size_t MiB = 1u << 20;
constexpr size_t WS_CTL = 0;
constexpr size_t WS_COS = 1 * MiB, WS_SIN = 2 * MiB;
constexpr size_t WS_X = 3 * MiB;
constexpr size_t WS_Z = WS_X;
constexpr size_t WS_H = WS_X;
constexpr size_t WS_TMP = WS_X + 64 * MiB;
constexpr size_t WS_ACT = WS_TMP;
constexpr size_t WS_Y = 150 * MiB;
constexpr size_t WS_QB = WS_Y;
constexpr size_t WS_KVB = WS_Y + 36 * MiB;
constexpr size_t WS_KRR = WS_Y + 84 * MiB;
constexpr size_t WS_CUM = WS_Y + 86 * MiB;
constexpr size_t WS_MIXED = WS_Y + 87 * MiB;
constexpr size_t WS_OUTS = WS_Y;
constexpr size_t WS_RT = 302 * MiB;
constexpr size_t WS_END = 304 * MiB;
constexpr size_t RT_IDS = 0, RT_WTS = 128 * 1024, RT_RANK = 256 * 1024, RT_SLOTOF = 384 * 1024, RT_SLOTTOK = 512 * 1024, RT_TILEE = 768 * 1024;
constexpr int CW_CNT = 0;

struct Args { const void* in[28]; float* out; unsigned char* ws; int ph_lo, ph_hi; };

__device__ __forceinline__ float wave_sum(float v) {
#pragma unroll
    for (int o = 1; o < 64; o <<= 1) v += __shfl_xor(v, o);
    return v;
}

struct GD {
    const float* A; long lda; const int* gather; const float* B; long ldb; long bstride; const int* tile_e;
    float* C; long ldc; int M, N, K, mode;
};
__device__ __forceinline__ void gemm_naive(const GD& g, float* sm, const int tid) {
    float* As = sm;
    float* Bs = sm + 16 * 132;
    const int ty = tid >> 5, tx = tid & 31;
    const int ntm = g.M / 128, ntn = (g.N + 127) / 128;
    const int lr = tid >> 2, lc = (tid & 3) * 4;
    const int kr = tid >> 5, bc = (tid & 31) * 4;
    for (int tile = blockIdx.x; tile < ntm * ntn; tile += gridDim.x) {
        const int tm = tile / ntn, tn = tile % ntn;
        const float* Bp = g.B;
        if (g.tile_e) { const int e = g.tile_e[tm]; if (e < 0) continue; Bp += (long)e * g.bstride; }
        long arow = (long)tm * 128 + lr;
        if (g.gather) arow = g.gather[tm * 128 + lr];
        const float* ap = g.A + (arow < 0 ? 0 : arow) * g.lda + lc;
        const int bcol = tn * 128 + bc;
        float acc[8][4];
#pragma unroll
        for (int i = 0; i < 8; ++i)
#pragma unroll
            for (int j = 0; j < 4; ++j) acc[i][j] = 0.f;
        for (int k0 = 0; k0 < g.K; k0 += 16) {
            float4 av = make_float4(0.f, 0.f, 0.f, 0.f), bv = make_float4(0.f, 0.f, 0.f, 0.f);
            if (arow >= 0) av = *(const float4*)(ap + k0);
            if (bcol < g.N) bv = *(const float4*)(Bp + (long)(k0 + kr) * g.ldb + bcol);
            __syncthreads();
            As[(lc + 0) * 132 + lr] = av.x; As[(lc + 1) * 132 + lr] = av.y; As[(lc + 2) * 132 + lr] = av.z; As[(lc + 3) * 132 + lr] = av.w;
            *(float4*)(Bs + kr * 132 + bc) = bv;
            __syncthreads();
#pragma unroll 2
            for (int k = 0; k < 16; ++k) {
                const float4 a0 = *(const float4*)(As + k * 132 + ty * 8), a1 = *(const float4*)(As + k * 132 + ty * 8 + 4);
                const float4 b = *(const float4*)(Bs + k * 132 + tx * 4);
                const float a[8] = {a0.x, a0.y, a0.z, a0.w, a1.x, a1.y, a1.z, a1.w};
                const float bb[4] = {b.x, b.y, b.z, b.w};
#pragma unroll
                for (int i = 0; i < 8; ++i)
#pragma unroll
                    for (int j = 0; j < 4; ++j) acc[i][j] = fmaf(a[i], bb[j], acc[i][j]);
            }
        }
        const int col = tn * 128 + tx * 4;
        if (col < g.N) {
#pragma unroll
            for (int i = 0; i < 8; ++i) {
                float* cp = g.C + ((long)tm * 128 + ty * 8 + i) * g.ldc + col;
                float4 o = make_float4(acc[i][0], acc[i][1], acc[i][2], acc[i][3]);
                if (g.mode == 1) {
                    const float4 c = *(const float4*)cp;
                    o.x *= c.x / (1.f + expf(-c.x)); o.y *= c.y / (1.f + expf(-c.y)); o.z *= c.z / (1.f + expf(-c.z)); o.w *= c.w / (1.f + expf(-c.w));
                } else if (g.mode == 2) {
                    const float4 c = *(const float4*)cp;
                    o.x = c.x / (1.f + expf(-o.x)); o.y = c.y / (1.f + expf(-o.y)); o.z = c.z / (1.f + expf(-o.z)); o.w = c.w / (1.f + expf(-o.w));
                }
                *(float4*)cp = o;
            }
        }
    }
    __syncthreads();
}

struct AttnP {
    const float* z; const float* qb; const float* kvb; const float* krr; const float* cum; const float* cosT; const float* sinT;
    const int* pos; float* mixed; const float* lq1; const float* lk1; const float* lq2; const float* lk2; const float* gdiff; int layer;
};
template <int MODE> __device__ __forceinline__ void attn_naive_unit(const AttnP& p, int b, int h, int qb, float* sm, const int tid) {
    constexpr int DK = MODE == 0 ? 32 : (MODE == 1 ? 96 : 64);
    constexpr int DK4 = DK / 4, DH = DK / 2, DH4 = DH / 4;
    float* Ks = sm;
    float* Vs = Ks + 64 * DK;
    float* Bs = Vs + 64 * 64;
    const int lane = tid & 63, w = __builtin_amdgcn_readfirstlane(tid >> 6), part = lane & 1;
    const int c = qb * 4 + (w >> 1), t = c * 64 + (w & 1) * 32 + (lane >> 1);
    const long row = (long)b * SEQ + t;
    const float scale = MODE == 0 ? 0.17677669529663687f : (MODE == 1 ? 0.10206207261596575f : 0.125f);
    float qbias = 0.f, slope = 0.f;
    if (MODE == 0) { qbias = (float)p.pos[row]; slope = exp2f(-8.0f * (float)(h + 1) / 6.0f); }
    if (MODE == 2) qbias = p.cum[row * 4 + h];
    float o1[32];
    constexpr int NMAPS = MODE == 0 ? 2 : 1;
#pragma unroll 1
    for (int m = 0; m < NMAPS; ++m) {
        float q[DH];
        {
            const float* qsrc = MODE == 0 ? p.z + row * D_IN + OFF_QA + h * 64 + m * 32 : (MODE == 1 ? p.qb + row * NQB + h * 96 : p.z + row * D_IN + OFF_QC + h * 64);
            const float4* qp = (const float4*)(qsrc + part * DH);
#pragma unroll
            for (int i = 0; i < DH4; ++i) { const float4 v = qp[i]; q[4 * i] = v.x; q[4 * i + 1] = v.y; q[4 * i + 2] = v.z; q[4 * i + 3] = v.w; }
        }
        if (MODE == 1) {
#pragma unroll
            for (int j = 0; j < 16; ++j) {
                const float cs = p.cosT[row * 16 + j], sn = p.sinT[row * 16 + j];
                const float x1 = q[(16 + j) % DH], x2 = q[(32 + j) % DH];
                if (part == 1) { q[(16 + j) % DH] = x1 * cs - x2 * sn; q[(32 + j) % DH] = x2 * cs + x1 * sn; }
            }
        }
        float acc[32];
#pragma unroll
        for (int i = 0; i < 32; ++i) acc[i] = 0.f;
        float mx = -INFINITY, l = 0.f;
        const int ntiles = qb * 4 + 4;
#pragma unroll 1
        for (int kt = 0; kt < ntiles; ++kt) {
            const int k0 = kt * 64;
            __syncthreads();
#pragma unroll
            for (int i = 0; i < (64 * DK4 + NTHREADS - 1) / NTHREADS; ++i) {
                const int idx = tid + i * NTHREADS;
                if (idx < 64 * DK4) {
                    const int s = idx / DK4, d4 = idx % DK4; const long kr = (long)b * SEQ + k0 + s;
                    float4 v;
                    if (MODE == 0) v = *(const float4*)(p.z + kr * D_IN + OFF_KA + h * 64 + m * 32 + d4 * 4);
                    else if (MODE == 1) v = (d4 < 16) ? *(const float4*)(p.kvb + kr * NKVB + h * 128 + d4 * 4) : *(const float4*)(p.krr + kr * 32 + (d4 - 16) * 4);
                    else v = *(const float4*)(p.z + kr * D_IN + OFF_KC + h * 64 + d4 * 4);
                    *(float4*)(Ks + s * DK + d4 * 4) = v;
                }
            }
#pragma unroll
            for (int i = 0; i < 2; ++i) {
                const int idx = tid + i * NTHREADS; const int s = idx >> 4, d4 = idx & 15; const long kr = (long)b * SEQ + k0 + s;
                float4 v;
                if (MODE == 0) v = *(const float4*)(p.z + kr * D_IN + OFF_VA + h * 64 + d4 * 4);
                else if (MODE == 1) v = *(const float4*)(p.kvb + kr * NKVB + h * 128 + 64 + d4 * 4);
                else v = *(const float4*)(p.z + kr * D_IN + OFF_VC + h * 64 + d4 * 4);
                *(float4*)(Vs + s * 64 + d4 * 4) = v;
            }
            if (tid < 64) {
                const long kr = (long)b * SEQ + k0 + tid;
                Bs[tid] = MODE == 0 ? (float)p.pos[kr] : (MODE == 2 ? p.cum[kr * 4 + h] : 0.f);
            }
            __syncthreads();
            if (kt <= c) {
#pragma unroll 1
                for (int s = 0; s < 64; ++s) {
                    const float4* kp = (const float4*)(Ks + s * DK + part * DH);
                    float dot = 0.f;
#pragma unroll
                    for (int i = 0; i < DH4; ++i) { const float4 kv = kp[i]; dot = fmaf(q[4 * i], kv.x, dot); dot = fmaf(q[4 * i + 1], kv.y, dot); dot = fmaf(q[4 * i + 2], kv.z, dot); dot = fmaf(q[4 * i + 3], kv.w, dot); }
                    dot += __shfl_xor(dot, 1);
                    float lg = dot * scale;
                    if (MODE == 0) lg -= slope * fabsf(qbias - Bs[s]);
                    if (MODE == 2) lg += qbias - Bs[s];
                    const bool ok = (MODE != 2) || (k0 + s <= t);
                    if (ok) {
                        if (lg > mx) {
                            const float corr = expf(mx - lg); l *= corr;
#pragma unroll
                            for (int i = 0; i < 32; ++i) acc[i] *= corr;
                            mx = lg;
                        }
                        const float pe = expf(lg - mx); l += pe;
                        const float4* vp = (const float4*)(Vs + s * 64 + part * 32);
#pragma unroll
                        for (int i = 0; i < 8; ++i) { const float4 vv = vp[i]; acc[4 * i] = fmaf(pe, vv.x, acc[4 * i]); acc[4 * i + 1] = fmaf(pe, vv.y, acc[4 * i + 1]); acc[4 * i + 2] = fmaf(pe, vv.z, acc[4 * i + 2]); acc[4 * i + 3] = fmaf(pe, vv.w, acc[4 * i + 3]); }
                    }
                }
            }
        }
        const float inv = 1.f / l;
        if (MODE == 0 && m == 0) {
#pragma unroll
            for (int i = 0; i < 32; ++i) o1[i] = acc[i] * inv;
        } else {
            float* op = p.mixed + row * D_MODEL + (MODE == 0 ? 0 : (MODE == 1 ? 384 : 768)) + h * 64 + part * 32;
            if (MODE == 0) {
                const float lam_init = 0.8f - 0.6f * expf(-0.3f * (float)p.layer);
                float s1 = 0.f, s2 = 0.f;
                for (int i = 0; i < 32; ++i) { s1 += p.lq1[i] * p.lk1[i]; s2 += p.lq2[i] * p.lk2[i]; }
                const float lam = expf(s1) - expf(s2) + lam_init;
                float ss = 0.f;
#pragma unroll
                for (int i = 0; i < 32; ++i) { acc[i] = o1[i] - lam * (acc[i] * inv); ss = fmaf(acc[i], acc[i], ss); }
                ss += __shfl_xor(ss, 1);
                const float r = rsqrtf(ss * (1.f / 64.f) + RMS_EPS) * (1.f - lam_init);
#pragma unroll
                for (int i = 0; i < 8; ++i) {
                    const float4 gv = *(const float4*)(p.gdiff + part * 32 + 4 * i);
                    *(float4*)(op + 4 * i) = make_float4(acc[4 * i] * r * gv.x, acc[4 * i + 1] * r * gv.y, acc[4 * i + 2] * r * gv.z, acc[4 * i + 3] * r * gv.w);
                }
            } else {
#pragma unroll
                for (int i = 0; i < 8; ++i) *(float4*)(op + 4 * i) = make_float4(acc[4 * i] * inv, acc[4 * i + 1] * inv, acc[4 * i + 2] * inv, acc[4 * i + 3] * inv);
            }
        }
    }
    __syncthreads();
}

__global__ void __launch_bounds__(NTHREADS, 2) mega(Args a) {
    extern __shared__ __attribute__((aligned(16))) unsigned char lds_raw[];
    float* sm = (float*)lds_raw;
    cg::grid_group grid = cg::this_grid();
    const int G = gridDim.x, NGW = G * 8, NGT = G * NTHREADS;
    unsigned char* ws = a.ws;
    const float* x0 = (const float*)a.in[0];
    const float* pin = (const float*)a.in[1];
    const int* pos = (const int*)a.in[2];
    float* cosT = (float*)(ws + WS_COS); float* sinT = (float*)(ws + WS_SIN);
    float* z = (float*)(ws + WS_Z); float* hbuf = (float*)(ws + WS_H); float* tmp = (float*)(ws + WS_TMP); float* act = (float*)(ws + WS_ACT);
    float* qbuf = (float*)(ws + WS_QB); float* kvb = (float*)(ws + WS_KVB); float* krr = (float*)(ws + WS_KRR); float* cum = (float*)(ws + WS_CUM);
    float* mixed = (float*)(ws + WS_MIXED); float* outs = (float*)(ws + WS_OUTS);
    int* ids = (int*)(ws + WS_RT + RT_IDS); float* wts = (float*)(ws + WS_RT + RT_WTS); int* rank = (int*)(ws + WS_RT + RT_RANK);
    int* slot_of = (int*)(ws + WS_RT + RT_SLOTOF); int* slot_tok = (int*)(ws + WS_RT + RT_SLOTTOK); int* tile_e = (int*)(ws + WS_RT + RT_TILEE);
    unsigned* ctl = (unsigned*)(ws + WS_CTL);

    constexpr int PH_PER_LAYER = 11;
    const int NPH = 1 + DEPTH * PH_PER_LAYER;
    for (int ph = a.ph_lo; ph < a.ph_hi && ph < NPH; ++ph) {
        int tid = threadIdx.x; asm volatile("" : "+v"(tid));
        const int lane = tid & 63, wave = __builtin_amdgcn_readfirstlane(tid >> 6);
        const int gw = blockIdx.x * 8 + wave, gtid = blockIdx.x * NTHREADS + tid;
        if (ph == 0) {
            for (int i = gtid; i < NTOK * 16; i += NGT) {
                const int tk = i >> 4, j = i & 15;
                const int j4 = j >> 2, jr = j & 3;
                const double inv = (j4 == 0 ? 1.0 : (j4 == 1 ? 0.1 : (j4 == 2 ? 0.01 : 0.001))) * (jr == 0 ? 1.0 : (jr == 1 ? 0.5623413251903491 : (jr == 2 ? 0.31622776601683794 : 0.1778279410038923)));
                const double ang = (double)pos[tk] * inv;
                const double k = rint(ang * 0.15915494309189535);
                const double r = fma(-k, 6.283185307179586, ang) - k * 2.4492935982947064e-16;
                cosT[i] = cosf((float)r); sinT[i] = sinf((float)r);
            }
        } else {
            const int l = (ph - 1) / PH_PER_LAYER, sp = (ph - 1) % PH_PER_LAYER;
            const float* xin = (l == 0) ? x0 : a.out;
            const float* w_in = (const float*)a.in[3] + (size_t)l * D_MODEL * D_IN;
            const float* w_uq = (const float*)a.in[4] + (size_t)l * 256 * NQB;
            const float* w_ukv = (const float*)a.in[5] + (size_t)l * 128 * NKVB;
            const float* g_cq = (const float*)a.in[6] + l * 256;
            const float* g_ckv = (const float*)a.in[7] + l * 128;
            const float* b_forget = (const float*)a.in[13] + l * 4;
            const float* w_out = (const float*)a.in[14] + (size_t)l * 1024 * 1024;
            const float* ln1_g = (const float*)a.in[15] + l * 1024; const float* ln1_b = (const float*)a.in[16] + l * 1024;
            const float* w_group = (const float*)a.in[17] + l * 1024 * 4; const float* b_group = (const float*)a.in[18] + l * 4;
            const float* w_er = (const float*)a.in[19] + (size_t)l * 4 * 1024 * 8; const float* b_er = (const float*)a.in[20] + l * 32;
            const float* w_ge = (const float*)a.in[21] + (size_t)l * 32 * 1024 * 256;
            const float* w_ue = (const float*)a.in[22] + (size_t)l * 32 * 1024 * 256;
            const float* w_de = (const float*)a.in[23] + (size_t)l * 32 * 256 * 1024;
            const float* w_pg = (const float*)a.in[24] + (size_t)l * 1024 * 1024;
            const float* w_pp = (const float*)a.in[25] + (size_t)l * 256 * 1024;
            const float* ln2_g = (const float*)a.in[26] + l * 1024; const float* ln2_b = (const float*)a.in[27] + l * 1024;
            const float* pl = pin + (size_t)l * NTOK * PLE_DIM;
            unsigned* cnt = ctl + CW_CNT + l * 32;
            if (sp == 0) {
                GD g{xin, D_MODEL, nullptr, w_in, D_IN, 0, nullptr, z, D_IN, NTOK, D_IN, D_MODEL, 0};
                gemm_naive(g, sm, tid);
            } else if (sp == 1) {
                for (int tk = gw; tk < NTOK; tk += NGW) {
                    float* zr = z + (size_t)tk * D_IN;
                    float4 v = *(float4*)(zr + OFF_CQ + lane * 4);
                    float ss = wave_sum(v.x * v.x + v.y * v.y + v.z * v.z + v.w * v.w);
                    float r = rsqrtf(ss * (1.f / 256.f) + RMS_EPS);
                    const float4 gq = *(const float4*)(g_cq + lane * 4);
                    *(float4*)(zr + OFF_CQ + lane * 4) = make_float4(v.x * r * gq.x, v.y * r * gq.y, v.z * r * gq.z, v.w * r * gq.w);
                    float2 u = *(float2*)(zr + OFF_CKV + lane * 2);
                    ss = wave_sum(u.x * u.x + u.y * u.y);
                    r = rsqrtf(ss * (1.f / 128.f) + RMS_EPS);
                    const float2 gk = *(const float2*)(g_ckv + lane * 2);
                    *(float2*)(zr + OFF_CKV + lane * 2) = make_float2(u.x * r * gk.x, u.y * r * gk.y);
                    if (lane < 16) {
                        const float x1 = zr[OFF_KR + lane], x2 = zr[OFF_KR + 16 + lane];
                        const float cs = cosT[tk * 16 + lane], sn = sinT[tk * 16 + lane];
                        krr[tk * 32 + lane] = x1 * cs - x2 * sn; krr[tk * 32 + 16 + lane] = x2 * cs + x1 * sn;
                    }
                    if (lane < 4) {
                        const float xf = zr[OFF_FC + lane] + b_forget[lane];
                        cum[tk * 4 + lane] = fminf(xf, 0.f) - log1pf(expf(-fabsf(xf)));
                    }
                }
            } else if (sp == 2) {
                GD g1{z + OFF_CQ, D_IN, nullptr, w_uq, NQB, 0, nullptr, qbuf, NQB, NTOK, NQB, 256, 0};
                gemm_naive(g1, sm, tid);
                GD g2{z + OFF_CKV, D_IN, nullptr, w_ukv, NKVB, 0, nullptr, kvb, NKVB, NTOK, NKVB, 128, 0};
                gemm_naive(g2, sm, tid);
                const int cw = NGW - 1 - gw;
                if (cw < 32) {
                    const int b = cw >> 2, hh = cw & 3;
                    float* cp = cum + ((size_t)b * SEQ) * 4 + hh;
                    float loc[32]; float run = 0.f;
#pragma unroll
                    for (int i = 0; i < 32; ++i) { run += cp[(size_t)(lane * 32 + i) * 4]; loc[i] = run; }
                    float pre = run;
#pragma unroll
                    for (int o = 1; o < 64; o <<= 1) { const float n = __shfl_up(pre, o); if (lane >= o) pre += n; }
                    pre -= run;
#pragma unroll
                    for (int i = 0; i < 32; ++i) cp[(size_t)(lane * 32 + i) * 4] = loc[i] + pre;
                }
            } else if (sp == 3) {
                AttnP p{z, qbuf, kvb, krr, cum, cosT, sinT, pos, mixed,
                        (const float*)a.in[8] + l * 32, (const float*)a.in[9] + l * 32, (const float*)a.in[10] + l * 32, (const float*)a.in[11] + l * 32,
                        (const float*)a.in[12] + l * 64, l};
                for (int idx = blockIdx.x; idx < 1024; idx += G) {
                    const int qb = 7 - idx / 128, j = idx % 128;
                    if (j < 48) attn_naive_unit<0>(p, j / 6, j % 6, qb, sm, tid);
                    else if (j < 96) attn_naive_unit<1>(p, (j - 48) / 6, (j - 48) % 6, qb, sm, tid);
                    else attn_naive_unit<2>(p, (j - 96) / 4, (j - 96) % 4, qb, sm, tid);
                }
            } else if (sp == 4) {
                GD g{mixed, D_MODEL, nullptr, w_out, D_MODEL, 0, nullptr, tmp, D_MODEL, NTOK, D_MODEL, D_MODEL, 0};
                gemm_naive(g, sm, tid);
            } else if (sp == 5) {
                for (int tk = gw; tk < NTOK; tk += NGW) {
                    float4 v[4]; float s = 0.f;
#pragma unroll
                    for (int j = 0; j < 4; ++j) {
                        const float4 xv = *(const float4*)(xin + (size_t)tk * D_MODEL + j * 256 + lane * 4);
                        const float4 tv = *(const float4*)(tmp + (size_t)tk * D_MODEL + j * 256 + lane * 4);
                        v[j] = make_float4(ALPHA * xv.x + tv.x, ALPHA * xv.y + tv.y, ALPHA * xv.z + tv.z, ALPHA * xv.w + tv.w);
                        s += (v[j].x + v[j].y) + (v[j].z + v[j].w);
                    }
                    const float mean = wave_sum(s) * (1.f / 1024.f); float s2 = 0.f;
#pragma unroll
                    for (int j = 0; j < 4; ++j) { v[j].x -= mean; v[j].y -= mean; v[j].z -= mean; v[j].w -= mean; s2 += (v[j].x * v[j].x + v[j].y * v[j].y) + (v[j].z * v[j].z + v[j].w * v[j].w); }
                    const float rstd = rsqrtf(wave_sum(s2) * (1.f / 1024.f) + LN_EPS);
                    float gl[4] = {0.f, 0.f, 0.f, 0.f};
#pragma unroll
                    for (int j = 0; j < 4; ++j) {
                        const int d0 = j * 256 + lane * 4;
                        const float4 gg = *(const float4*)(ln1_g + d0), bb = *(const float4*)(ln1_b + d0);
                        v[j] = make_float4(v[j].x * rstd * gg.x + bb.x, v[j].y * rstd * gg.y + bb.y, v[j].z * rstd * gg.z + bb.z, v[j].w * rstd * gg.w + bb.w);
                        *(float4*)(hbuf + (size_t)tk * D_MODEL + d0) = v[j];
                        const float hv[4] = {v[j].x, v[j].y, v[j].z, v[j].w};
#pragma unroll
                        for (int i = 0; i < 4; ++i) {
                            const float4 wg = *(const float4*)(w_group + (size_t)(d0 + i) * 4);
                            gl[0] = fmaf(hv[i], wg.x, gl[0]); gl[1] = fmaf(hv[i], wg.y, gl[1]); gl[2] = fmaf(hv[i], wg.z, gl[2]); gl[3] = fmaf(hv[i], wg.w, gl[3]);
                        }
                    }
#pragma unroll
                    for (int i = 0; i < 4; ++i) gl[i] = wave_sum(gl[i]) + b_group[i];
                    int gi = 0; float gm = gl[0];
#pragma unroll
                    for (int i = 1; i < 4; ++i) if (gl[i] > gm) { gm = gl[i]; gi = i; }
                    float gden = 0.f;
#pragma unroll
                    for (int i = 0; i < 4; ++i) gden += expf(gl[i] - gm);
                    const float gwt = 1.f / gden;
                    float el[8] = {0.f, 0.f, 0.f, 0.f, 0.f, 0.f, 0.f, 0.f};
                    const float* we = w_er + (size_t)gi * 1024 * 8;
#pragma unroll
                    for (int j = 0; j < 4; ++j) {
                        const int d0 = j * 256 + lane * 4;
                        const float hv[4] = {v[j].x, v[j].y, v[j].z, v[j].w};
#pragma unroll
                        for (int i = 0; i < 4; ++i) {
                            const float4 w0 = *(const float4*)(we + (size_t)(d0 + i) * 8), w1 = *(const float4*)(we + (size_t)(d0 + i) * 8 + 4);
                            el[0] = fmaf(hv[i], w0.x, el[0]); el[1] = fmaf(hv[i], w0.y, el[1]); el[2] = fmaf(hv[i], w0.z, el[2]); el[3] = fmaf(hv[i], w0.w, el[3]);
                            el[4] = fmaf(hv[i], w1.x, el[4]); el[5] = fmaf(hv[i], w1.y, el[5]); el[6] = fmaf(hv[i], w1.z, el[6]); el[7] = fmaf(hv[i], w1.w, el[7]);
                        }
                    }
#pragma unroll
                    for (int i = 0; i < 8; ++i) el[i] = wave_sum(el[i]) + b_er[gi * 8 + i];
                    int i0 = 0; float v0 = el[0];
#pragma unroll
                    for (int i = 1; i < 8; ++i) if (el[i] > v0) { v0 = el[i]; i0 = i; }
                    int i1 = -1; float v1 = -INFINITY;
#pragma unroll
                    for (int i = 0; i < 8; ++i) if (i != i0 && el[i] > v1) { v1 = el[i]; i1 = i; }
                    const float e1 = expf(v1 - v0);
                    const float w0 = gwt / (1.f + e1), w1 = gwt * e1 / (1.f + e1);
                    if (lane == 0) {
                        const int ea = gi * 8 + i0, eb = gi * 8 + i1;
                        ids[tk * 2] = ea; ids[tk * 2 + 1] = eb; wts[tk * 2] = w0; wts[tk * 2 + 1] = w1;
                        rank[tk * 2] = (int)atomicAdd(cnt + ea, 1u); rank[tk * 2 + 1] = (int)atomicAdd(cnt + eb, 1u);
                    }
                }
            } else if (sp == 6) {
                int* offs = (int*)sm;
                __syncthreads();
                if (tid == 0) { int o = 0; for (int e = 0; e < 32; ++e) { offs[e] = o; o += ((int)cnt[e] + 127) & ~127; } offs[32] = o; }
                __syncthreads();
                for (int i = gtid; i < NTOK * 2; i += NGT) { const int e = ids[i]; const int s = offs[e] + rank[i]; slot_of[i] = s; slot_tok[s] = i >> 1; }
                for (int i = gtid; i < 32 * 128; i += NGT) { const int e = i >> 7, j = i & 127; const int s = offs[e] + (int)cnt[e] + j; if (s < offs[e + 1]) slot_tok[s] = -1; }
                for (int i = gtid; i < NSLOT_TILES; i += NGT) { int e = -1; for (int k = 0; k < 32; ++k) if (i * 128 >= offs[k] && i * 128 < offs[k + 1]) e = k; tile_e[i] = e; }
                __syncthreads();
            } else if (sp == 7) {
                GD g{hbuf, D_MODEL, slot_tok, w_ge, D_EXPERT, (long)D_MODEL * D_EXPERT, tile_e, act, D_EXPERT, MAX_SLOTS, D_EXPERT, D_MODEL, 0};
                gemm_naive(g, sm, tid);
                GD g2{pl, PLE_DIM, nullptr, w_pp, D_MODEL, 0, nullptr, a.out, D_MODEL, NTOK, D_MODEL, PLE_DIM, 0};
                gemm_naive(g2, sm, tid);
            } else if (sp == 8) {
                GD g{hbuf, D_MODEL, slot_tok, w_ue, D_EXPERT, (long)D_MODEL * D_EXPERT, tile_e, act, D_EXPERT, MAX_SLOTS, D_EXPERT, D_MODEL, 1};
                gemm_naive(g, sm, tid);
                GD g2{hbuf, D_MODEL, nullptr, w_pg, D_MODEL, 0, nullptr, a.out, D_MODEL, NTOK, D_MODEL, D_MODEL, 2};
                gemm_naive(g2, sm, tid);
            } else if (sp == 9) {
                GD g{act, D_EXPERT, nullptr, w_de, D_MODEL, (long)D_EXPERT * D_MODEL, tile_e, outs, D_MODEL, MAX_SLOTS, D_MODEL, D_EXPERT, 0};
                gemm_naive(g, sm, tid);
            } else if (sp == 10) {
                for (int tk = gw; tk < NTOK; tk += NGW) {
                    const int s0 = slot_of[tk * 2], s1 = slot_of[tk * 2 + 1]; const float w0 = wts[tk * 2], w1 = wts[tk * 2 + 1];
                    float4 v[4]; float s = 0.f;
#pragma unroll
                    for (int j = 0; j < 4; ++j) {
                        const int d0 = j * 256 + lane * 4;
                        const float4 hv = *(const float4*)(hbuf + (size_t)tk * D_MODEL + d0);
                        const float4 oa = *(const float4*)(outs + (size_t)s0 * D_MODEL + d0), ob = *(const float4*)(outs + (size_t)s1 * D_MODEL + d0);
                        const float4 pv = *(const float4*)(a.out + (size_t)tk * D_MODEL + d0);
                        v[j] = make_float4(ALPHA * hv.x + w0 * oa.x + w1 * ob.x + pv.x, ALPHA * hv.y + w0 * oa.y + w1 * ob.y + pv.y,
                                           ALPHA * hv.z + w0 * oa.z + w1 * ob.z + pv.z, ALPHA * hv.w + w0 * oa.w + w1 * ob.w + pv.w);
                        s += (v[j].x + v[j].y) + (v[j].z + v[j].w);
                    }
                    const float mean = wave_sum(s) * (1.f / 1024.f); float s2 = 0.f;
#pragma unroll
                    for (int j = 0; j < 4; ++j) { v[j].x -= mean; v[j].y -= mean; v[j].z -= mean; v[j].w -= mean; s2 += (v[j].x * v[j].x + v[j].y * v[j].y) + (v[j].z * v[j].z + v[j].w * v[j].w); }
                    const float rstd = rsqrtf(wave_sum(s2) * (1.f / 1024.f) + LN_EPS);
#pragma unroll
                    for (int j = 0; j < 4; ++j) {
                        const int d0 = j * 256 + lane * 4;
                        const float4 gg = *(const float4*)(ln2_g + d0), bb = *(const float4*)(ln2_b + d0);
                        *(float4*)(a.out + (size_t)tk * D_MODEL + d0) = make_float4(v[j].x * rstd * gg.x + bb.x, v[j].y * rstd * gg.y + bb.y, v[j].z * rstd * gg.z + bb.z, v[j].w * rstd * gg.w + bb.w);
                    }
                }
            }
        }
        if (ph + 1 < a.ph_hi && ph + 1 < NPH) grid.sync();
    }
}

extern "C" void kernel_launch(void* const* d_in, const int* in_sizes, int n_in, void* d_out, int out_size, void* d_ws, size_t ws_size, hipStream_t stream) {
    constexpr int LDS_BYTES = 48 * 1024;
    static int grid = 0;
    if (grid == 0) {
        if (n_in != 28 || ws_size < WS_END) { fprintf(stderr, "kernel_launch: unexpected n_in %d or ws_size %zu (< %zu)\n", n_in, ws_size, (size_t)WS_END); grid = -1; return; }
        int dev = 0, cus = 0, per_cu = 0;
        hipGetDevice(&dev);
        hipDeviceGetAttribute(&cus, hipDeviceAttributeMultiprocessorCount, dev);
        hipFuncSetAttribute((const void*)mega, hipFuncAttributeMaxDynamicSharedMemorySize, LDS_BYTES);
        hipOccupancyMaxActiveBlocksPerMultiprocessor(&per_cu, (const void*)mega, NTHREADS, LDS_BYTES);
        if (per_cu < 1) { fprintf(stderr, "kernel_launch: occupancy query says %d blocks/CU\n", per_cu); per_cu = 1; }
        (void)hipGetLastError();
        grid = cus;
    }
    if (grid < 0) return;
    hipMemsetAsync((char*)d_ws + WS_CTL, 0, 64 * 1024, stream);
    Args a{};
    for (int i = 0; i < 28; ++i) a.in[i] = d_in[i];
    a.out = (float*)d_out; a.ws = (unsigned char*)d_ws; a.ph_lo = 0; a.ph_hi = 1 + DEPTH * 11;
    void* params[] = {&a};
    hipError_t e = hipLaunchCooperativeKernel((const void*)mega, dim3(grid), dim3(NTHREADS), params, LDS_BYTES, stream);
    if (e != hipSuccess) fprintf(stderr, "cooperative launch failed: %s (grid %d)\n", hipGetErrorString(e), grid);
}
```

```cpp
#include <hip/hip_runtime.h>
#include <hip/hip_cooperative_groups.h>
#include <cstdio>
#include <cstdint>
namespace cg = cooperative_groups;

constexpr int D_MODEL = 1024, BATCH = 8, SEQ = 2048, NTOK = BATCH * SEQ, DEPTH = 2;
constexpr int D_IN = 2340;
constexpr int OFF_QA = 0, OFF_KA = 384, OFF_VA = 768, OFF_CQ = 1152, OFF_CKV = 1408, OFF_KR = 1536,
              OFF_QC = 1568, OFF_KC = 1824, OFF_VC = 2080, OFF_FC = 2336;
constexpr int ZP = 2560;
constexpr int Z_QA = 0, Z_KA = 384, Z_VA = 768, Z_QC = 1152, Z_KC = 1408, Z_VC = 1664, Z_CKV = 1920, Z_CQ = 2048, Z_KR = 2304, Z_FC = 2336;
constexpr int NQB = 576, NKVB = 768, NQBP = 768;
constexpr int N_EXPERTS = 32, D_EXPERT = 256, PLE_DIM = 256;
constexpr int MAX_SLOTS = 32768 + 32 * 128;
constexpr int NSLOT_TILES = MAX_SLOTS / 128;
constexpr float ALPHA = 1.4142135623730951f;
constexpr float LN_EPS = 1e-5f, RMS_EPS = 1e-6f;
constexpr int NTHREADS = 512;
constexpr int LDS_BYTES = 147456;

constexpr size_t MiB = 1u << 20;
constexpr size_t WS_CTL = 0;
constexpr size_t WS_COS = 1 * MiB, WS_SIN = 2 * MiB;
constexpr size_t WS_W = 3 * MiB;
constexpr size_t WS_WIN = WS_W;
constexpr size_t WS_WUQ = WS_W + 5 * MiB;
constexpr size_t WS_WUKV = WS_WUQ + 393216;
constexpr size_t WS_WOUT = WS_W + 6 * MiB;
constexpr size_t WS_A16 = 61 * MiB;
constexpr size_t WS_Z16 = 93 * MiB;
constexpr size_t WS_QB16 = 173 * MiB;
constexpr size_t WS_KVB16 = 197 * MiB;
constexpr size_t WS_KRR16 = 221 * MiB;
constexpr size_t WS_FC = 222 * MiB;
constexpr size_t WS_CUM = WS_FC + 256 * 1024;
constexpr size_t WS_RQ = WS_CUM + 256 * 1024;
constexpr size_t WS_RKV = WS_RQ + 64 * 1024;
constexpr size_t WS_MIXED16 = 223 * MiB;
constexpr size_t WS_MIX16 = 255 * MiB;
constexpr size_t WS_ACT = 3 * MiB;
constexpr size_t WS_OUTS = 93 * MiB;
constexpr size_t WS_PLE = 255 * MiB;
constexpr size_t WS_RT = 320 * MiB;
constexpr size_t WS_END = 322 * MiB;
constexpr size_t RT_IDS = 0, RT_WTS = 128 * 1024, RT_RANK = 256 * 1024, RT_SLOTOF = 384 * 1024, RT_SLOTTOK = 512 * 1024, RT_TILEE = 768 * 1024;
constexpr int CW_CNT = 0;

struct Args { const void* in[28]; float* out; unsigned char* ws; int ph_lo, ph_hi; };

#define LAS __attribute__((address_space(3)))
typedef unsigned short bf16;
typedef unsigned v4u __attribute__((ext_vector_type(4)));
typedef unsigned v2u __attribute__((ext_vector_type(2)));

__device__ __forceinline__ float wave_sum(float v) {
#pragma unroll
    for (int o = 1; o < 64; o <<= 1) v += __shfl_xor(v, o);
    return v;
}
__device__ __forceinline__ unsigned f2bf(float f) { unsigned u = __builtin_bit_cast(unsigned, f); return (u + 0x7fffu + ((u >> 16) & 1u)) >> 16; }
__device__ __forceinline__ unsigned pk2(float lo, float hi) { return f2bf(lo) | (f2bf(hi) << 16); }
__device__ __forceinline__ float bflo(unsigned w) { return __uint_as_float(w << 16); }
__device__ __forceinline__ float bfhi(unsigned w) { return __uint_as_float(w & 0xffff0000u); }
__device__ __forceinline__ void unpack8(const v4u w, float* f) { f[0] = bflo(w.x); f[1] = bfhi(w.x); f[2] = bflo(w.y); f[3] = bfhi(w.y); f[4] = bflo(w.z); f[5] = bfhi(w.z); f[6] = bflo(w.w); f[7] = bfhi(w.w); }
namespace pg8 {
#define PG8_LAS __attribute__((address_space(3)))
typedef unsigned short bf16_t;
typedef short bf16x8 __attribute__((ext_vector_type(8)));
typedef float f32x4 __attribute__((ext_vector_type(4)));
typedef unsigned u32x4 __attribute__((ext_vector_type(4)));
constexpr int BM = 256, BK = 64, HALF = 128, HTB = HALF * BK * 2  , STAGE_BYTES = 8 * HTB, NXCD = 8, WGM = 8;

__host__ __device__ __forceinline__ int lds_byte(int r, int c) { const int st = (r >> 4) * 2 + (c >> 5), rr = r & 15, cc = c & 31, ob = rr * 64 + cc * 2; return st * 1024 + (ob ^ (((ob >> 9) & 1) << 5)); }
__host__ __device__ __forceinline__ void stage_rc(int b, int& R, int& C) { const int st = b / 1024, sb = b % 1024, swz = sb ^ (((sb >> 9) & 1) << 5); R = (st >> 1) * 16 + swz / 64; C = (st & 1) * 32 + (swz % 64) / 2; }
__host__ __device__ __forceinline__ int perm32(int rho) { const int n = rho >> 4, i = rho & 15; return 8 * (i >> 2) + 4 * n + (i & 3); }

struct Unit { int pm, pn; };
struct Gemm { const bf16_t* A; const bf16_t* Bt; int M, N, K, lda, ldb; };

struct StaticOrder {
    int nM, nN, nwg, G, c;
    __host__ __device__ void init(int M, int N, int G_, int c_) { nM = M / BM; nN = N / BM; nwg = nM * nN; G = G_; c = c_; }
    __host__ __device__ bool next(int i, Unit& u) const {
        const long L = (long)i * G + c; if (L >= nwg) return false;
        int wgid = (int)L; { const int q = nwg / NXCD, r = nwg % NXCD, xcd = wgid % NXCD, off = wgid / NXCD; wgid = (xcd < r ? xcd * (q + 1) : r * (q + 1) + (xcd - r) * q) + off; }
        const int nig = WGM * nN, gid = wgid / nig, fm = gid * WGM, gsz = (nM - fm) < WGM ? (nM - fm) : WGM;
        u.pm = fm + ((wgid % nig) % gsz); u.pn = (wgid % nig) / gsz; return true;
    }
    __device__ __forceinline__ void a_ready(const Unit&) const {}
    __device__ __forceinline__ void done(const Unit&) const {}
};

__device__ __forceinline__ unsigned cvt_pk_bf16(float lo, float hi) { unsigned r; asm volatile("v_cvt_pk_bf16_f32 %0, %1, %2" : "=v"(r) : "v"(lo), "v"(hi)); return r; }
typedef float f32x2 __attribute__((ext_vector_type(2)));
__device__ __forceinline__ f32x2 gelu_pk(f32x2 v) {
    const f32x2 av = __builtin_elementwise_abs(v), d = av * 0.2316418882f + 1.0f;
    f32x2 t; t.x = __builtin_amdgcn_rcpf(d.x); t.y = __builtin_amdgcn_rcpf(d.y);
    f32x2 q = t * 0.5307027145f + (-0.7265760135f); q = q * t + 0.7107068705f; q = q * t + (-0.142248368f); q = q * t + 0.127414796f; q = q * t;
    const f32x2 s = (v * v) * (-0.72134752044f);
    f32x2 e; e.x = __builtin_amdgcn_exp2f(s.x); e.y = __builtin_amdgcn_exp2f(s.y);
    const f32x2 m = v * (q * e), r = v - m;
    f32x2 o; o.x = v.x < 0.f ? m.x : r.x; o.y = v.y < 0.f ? m.y : r.y; return o;
}

template <int ACT  > struct EpiBf16 {
    static constexpr bool PERM = true, AFTER_DRAIN = false; static_assert(ACT == 0 || ACT == 1, "EpiBf16: ACT is 0 (none) or 1 (gelu_pk)");
    bf16_t* O; int ldc; const float* bias; int split_cols; size_t split_stride; float scale0;
    __device__ __forceinline__ void operator()(const f32x4 (&acc)[2][2][4][2], const Unit& u, int wr, int wc, int fr, int fq) const {
        const int row0 = u.pm * BM + wr * 64 + fr; int colt = u.pn * BM; bf16_t* base = O;
        float sc = 1.f; if (split_cols) { const int t = colt / split_cols; base += (size_t)t * split_stride; colt -= t * split_cols; if (t == 0) sc = scale0; }
        const int col0 = colt + wc * 32 + 8 * fq, bcol0 = u.pn * BM + wc * 32 + 8 * fq;
        f32x4 bv[2][2];
#pragma unroll
        for (int bj = 0; bj < 2; ++bj)
#pragma unroll
            for (int n = 0; n < 2; ++n) bv[bj][n] = bias ? *(const f32x4*)(bias + bcol0 + bj * HALF + 4 * n) : (f32x4){0.f, 0.f, 0.f, 0.f};
#pragma unroll
        for (int ai = 0; ai < 2; ++ai)
#pragma unroll
            for (int m = 0; m < 4; ++m) { bf16_t* rowp = base + (size_t)(row0 + ai * HALF + m * 16) * ldc + col0;
#pragma unroll
                for (int bj = 0; bj < 2; ++bj) { f32x4 v0 = acc[ai][bj][m][0] + bv[bj][0], v1 = acc[ai][bj][m][1] + bv[bj][1];
                    if (ACT == 1) { f32x2 a = gelu_pk((f32x2){v0[0], v0[1]}), b = gelu_pk((f32x2){v0[2], v0[3]}), c = gelu_pk((f32x2){v1[0], v1[1]}), d = gelu_pk((f32x2){v1[2], v1[3]});
                        v0 = (f32x4){a.x, a.y, b.x, b.y}; v1 = (f32x4){c.x, c.y, d.x, d.y}; }
                    v0 = v0 * sc; v1 = v1 * sc; u32x4 w; w.x = cvt_pk_bf16(v0[0], v0[1]); w.y = cvt_pk_bf16(v0[2], v0[3]); w.z = cvt_pk_bf16(v1[0], v1[1]); w.w = cvt_pk_bf16(v1[2], v1[3]);
                    *(u32x4*)(rowp + bj * HALF) = w; } }
    }
};
template <class Epi, class Sched, bool ALIGN_EPI = false, bool SP2 = false>
__device__ __forceinline__ void gemm_phase(PG8_LAS unsigned char* lds, const Gemm g, const Sched& S, const Epi& E, const int tid) {
    const int wid = __builtin_amdgcn_readfirstlane(tid >> 6), lane = tid & 63, wr = wid >> 2, wc = wid & 3, fr = lane & 15, fq = lane >> 4;
    const int K = g.K, nt = K / BK;
    unsigned voffA[2], voffB[2];
#pragma unroll
    for (int i = 0; i < 2; ++i) { int R, C; stage_rc(tid * 16 + i * 8192, R, C); const int Rb = Epi::PERM ? ((R & ~31) + perm32(R & 31)) : R;
        voffA[i] = (unsigned)(R * g.lda + C) * 2u; voffB[i] = (unsigned)(Rb * g.ldb + C) * 2u; }
    const size_t kstep = (size_t)(BK * 2);
    const size_t hstepA = (size_t)HALF * g.lda * 2, hstepB = (size_t)HALF * g.ldb * 2;
    const size_t tstepA = 2 * hstepA, tstepB = 2 * hstepB;
    const unsigned ldsw = (unsigned)wid * 1024u;
    const int aoff = lds_byte(wr * 64 + fr, fq * 8), boff = lds_byte(wc * 32 + fr, fq * 8);
#define PG8_SA(b, h) (((b) * 2 + (h)) * HTB)
#define PG8_SB(b, h) ((4 + (b) * 2 + (h)) * HTB)
#define PG8_STAGE(bufoff, gbase, voff) do { _Pragma("unroll") for (int _i = 0; _i < 2; ++_i) \
        __builtin_amdgcn_global_load_lds((const unsigned*)((const char*)(gbase) + (voff)[_i]), (PG8_LAS unsigned*)(lds + (bufoff) + ldsw + _i * 8192), 16, 0, 0); } while (0)
#define PG8_LDA(dst, b, h) do { _Pragma("unroll") for (int m = 0; m < 4; ++m) _Pragma("unroll") for (int k = 0; k < 2; ++k) dst[m][k] = *(const PG8_LAS bf16x8*)(lds + PG8_SA(b, h) + aoff + m * 2048 + k * 1024); } while (0)
#define PG8_LDB(dst, b, h) do { _Pragma("unroll") for (int n = 0; n < 2; ++n) _Pragma("unroll") for (int k = 0; k < 2; ++k) dst[n][k] = *(const PG8_LAS bf16x8*)(lds + PG8_SB(b, h) + boff + n * 2048 + k * 1024); } while (0)
#define PG8_MMA(ai, bj, At, Bt) do { __builtin_amdgcn_s_setprio(1); _Pragma("unroll") for (int m = 0; m < 4; ++m) _Pragma("unroll") for (int n = 0; n < 2; ++n) _Pragma("unroll") for (int k = 0; k < 2; ++k) \
        acc[ai][bj][m][n] = __builtin_amdgcn_mfma_f32_16x16x32_bf16(Bt[n][k], At[m][k], acc[ai][bj][m][n], 0, 0, 0); __builtin_amdgcn_s_setprio(0); } while (0)
#define PG8_WAIT_V(n) asm volatile("s_waitcnt vmcnt(" #n ")" ::: "memory")
#define PG8_WAIT_L(n) asm volatile("s_waitcnt lgkmcnt(" #n ")" ::: "memory")
#define PG8_BAR __builtin_amdgcn_s_barrier()
#define PG8_SCHED __builtin_amdgcn_sched_barrier(0)
    Unit cur, nxt; int ui = 0;
    if (!S.next(0, cur)) return;
    f32x4 acc[2][2][4][2];
#pragma unroll
    for (int a = 0; a < 2; ++a)
#pragma unroll
        for (int b = 0; b < 2; ++b)
#pragma unroll
            for (int m = 0; m < 4; ++m)
#pragma unroll
                for (int n = 0; n < 2; ++n) acc[a][b][m][n] = (f32x4){0.f, 0.f, 0.f, 0.f};
    bf16x8 At[4][2], B0[2][2], B1[2][2];
    const char* cA = (const char*)g.A + (size_t)cur.pm * tstepA; const char* cB = (const char*)g.Bt + (size_t)cur.pn * tstepB;
    S.a_ready(cur);
    if constexpr (SP2) {
        PG8_STAGE(PG8_SB(0, 0), cB, voffB); PG8_STAGE(PG8_SB(0, 1), cB + hstepB, voffB); PG8_STAGE(PG8_SA(0, 0), cA, voffA); PG8_STAGE(PG8_SA(0, 1), cA + hstepA, voffA);
        if (wr == 1) PG8_BAR;
        PG8_WAIT_V(2); PG8_BAR;
        PG8_STAGE(PG8_SB(1, 0), cB + kstep, voffB); PG8_STAGE(PG8_SA(1, 0), cA + kstep, voffA); PG8_STAGE(PG8_SB(1, 1), cB + hstepB + kstep, voffB);
        PG8_WAIT_V(6); PG8_BAR;
    } else {
        PG8_STAGE(PG8_SB(0, 0), cB, voffB); PG8_STAGE(PG8_SA(0, 0), cA, voffA); PG8_STAGE(PG8_SB(0, 1), cB + hstepB, voffB); PG8_STAGE(PG8_SA(0, 1), cA + hstepA, voffA);
        if (wr == 1) PG8_BAR;
        PG8_WAIT_V(4); PG8_BAR;
        PG8_STAGE(PG8_SB(1, 0), cB + kstep, voffB); PG8_STAGE(PG8_SA(1, 0), cA + kstep, voffA); PG8_STAGE(PG8_SB(1, 1), cB + hstepB + kstep, voffB);
        PG8_WAIT_V(6); PG8_BAR;
    }
    for (;;) {
        const bool has_next = S.next(ui + 1, nxt);
        const char* nA = has_next ? (const char*)g.A + (size_t)nxt.pm * tstepA : cA; const char* nB = has_next ? (const char*)g.Bt + (size_t)nxt.pn * tstepB : cB;
        for (int t = 0; t < nt; t += 2) {
            const bool last = (t == nt - 2);
            const char* a1 = cA + (size_t)(t + 1) * kstep;
            const char* a2 = last ? nA : cA + (size_t)(t + 2) * kstep; const char* b2 = last ? nB : cB + (size_t)(t + 2) * kstep;
            const char* a3 = a2 + kstep; const char* b3 = b2 + kstep;
            if (last && has_next) S.a_ready(nxt);
            if constexpr (SP2) {
            PG8_LDB(B0, 0, 0); PG8_LDB(B1, 0, 1); PG8_SCHED; PG8_LDA(At, 0, 0); PG8_STAGE(PG8_SA(1, 1), a1 + hstepA, voffA);
            PG8_WAIT_V(8); PG8_WAIT_L(0); PG8_BAR; PG8_MMA(0, 0, At, B0); PG8_MMA(0, 1, At, B1); PG8_BAR; PG8_SCHED;
            PG8_LDA(At, 0, 1); PG8_STAGE(PG8_SB(0, 0), b2, voffB); PG8_STAGE(PG8_SB(0, 1), b2 + hstepB, voffB); PG8_STAGE(PG8_SA(0, 0), a2, voffA);
            PG8_WAIT_V(8); PG8_WAIT_L(0); PG8_BAR; PG8_MMA(1, 0, At, B0); PG8_MMA(1, 1, At, B1); PG8_BAR; PG8_SCHED;
            PG8_LDB(B0, 1, 0); PG8_LDB(B1, 1, 1); PG8_SCHED; PG8_LDA(At, 1, 0); PG8_STAGE(PG8_SA(0, 1), a2 + hstepA, voffA);
            PG8_WAIT_V(8); PG8_WAIT_L(0); PG8_BAR; PG8_MMA(0, 0, At, B0); PG8_MMA(0, 1, At, B1); PG8_BAR; PG8_SCHED;
            PG8_LDA(At, 1, 1); PG8_STAGE(PG8_SB(1, 0), b3, voffB); PG8_STAGE(PG8_SB(1, 1), b3 + hstepB, voffB); PG8_STAGE(PG8_SA(1, 0), a3, voffA);
            PG8_WAIT_V(8); PG8_WAIT_L(0); PG8_BAR; PG8_MMA(1, 0, At, B0); PG8_MMA(1, 1, At, B1); PG8_BAR; PG8_SCHED;
            } else {
            PG8_LDB(B0, 0, 0); PG8_SCHED; PG8_LDA(At, 0, 0); PG8_STAGE(PG8_SA(1, 1), a1 + hstepA, voffA);
            PG8_WAIT_L(8); PG8_BAR; PG8_WAIT_L(0); PG8_MMA(0, 0, At, B0); PG8_BAR; PG8_SCHED;
            PG8_LDB(B1, 0, 1); PG8_STAGE(PG8_SB(0, 0), b2, voffB);
            PG8_BAR; PG8_WAIT_L(0); PG8_MMA(0, 1, At, B1); PG8_BAR;
            PG8_LDA(At, 0, 1); PG8_STAGE(PG8_SA(0, 0), a2, voffA);
            PG8_BAR; PG8_WAIT_L(0); PG8_MMA(1, 0, At, B0); PG8_BAR; PG8_SCHED;
            PG8_STAGE(PG8_SB(0, 1), b2 + hstepB, voffB);
            PG8_WAIT_V(6); PG8_BAR; PG8_MMA(1, 1, At, B1); PG8_BAR;
            PG8_LDB(B0, 1, 0); PG8_SCHED; PG8_LDA(At, 1, 0); PG8_STAGE(PG8_SA(0, 1), a2 + hstepA, voffA);
            PG8_WAIT_L(8); PG8_BAR; PG8_WAIT_L(0); PG8_MMA(0, 0, At, B0); PG8_BAR; PG8_SCHED;
            PG8_LDB(B1, 1, 1); PG8_STAGE(PG8_SB(1, 0), b3, voffB);
            PG8_BAR; PG8_WAIT_L(0); PG8_MMA(0, 1, At, B1); PG8_BAR;
            PG8_LDA(At, 1, 1); PG8_STAGE(PG8_SA(1, 0), a3, voffA);
            PG8_BAR; PG8_WAIT_L(0); PG8_MMA(1, 0, At, B0); PG8_BAR; PG8_SCHED;
            PG8_STAGE(PG8_SB(1, 1), b3 + hstepB, voffB);
            PG8_WAIT_V(6); PG8_BAR; PG8_MMA(1, 1, At, B1); PG8_BAR;
            }
        }
        if constexpr (ALIGN_EPI) { if (wr == 0) PG8_BAR; }
        if constexpr (!Epi::AFTER_DRAIN) { E(acc, cur, wr, wc, fr, fq); S.done(cur); }
        if (!has_next) break;
#pragma unroll
        for (int a = 0; a < 2; ++a)
#pragma unroll
            for (int b = 0; b < 2; ++b)
#pragma unroll
                for (int m = 0; m < 4; ++m)
#pragma unroll
                    for (int n = 0; n < 2; ++n) acc[a][b][m][n] = (f32x4){0.f, 0.f, 0.f, 0.f};
        cur = nxt; cA = nA; cB = nB; ++ui;
        if constexpr (ALIGN_EPI) { if (wr == 1) PG8_BAR; }
    }
    PG8_WAIT_V(0);
    if constexpr (!ALIGN_EPI) { if (wr == 0) PG8_BAR; }
    PG8_BAR;
    if constexpr (Epi::AFTER_DRAIN) { E.fused(acc, cur, wr, wc, fr, fq, lds, wid, lane); S.done(cur); }
#undef PG8_SA
#undef PG8_SB
#undef PG8_STAGE
#undef PG8_LDA
#undef PG8_LDB
#undef PG8_MMA
#undef PG8_WAIT_V
#undef PG8_WAIT_L
#undef PG8_BAR
#undef PG8_SCHED
}
}

namespace pg8 {
struct EpiZ {
    static constexpr bool PERM = true, AFTER_DRAIN = false;
    bf16_t* O; int ldc; float* fcbuf;
    __device__ __forceinline__ void operator()(const f32x4 (&acc)[2][2][4][2], const Unit& u, int wr, int wc, int fr, int fq) const {
        const int row0 = u.pm * BM + wr * 64 + fr, col0 = u.pn * BM + wc * 32 + 8 * fq;
        const bool fcl = (u.pn == 9) && (wc == 1) && (fq == 0);
#pragma unroll
        for (int ai = 0; ai < 2; ++ai)
#pragma unroll
            for (int m = 0; m < 4; ++m) {
                const int row = row0 + ai * HALF + m * 16;
                bf16_t* rowp = O + (size_t)row * ldc + col0;
#pragma unroll
                for (int bj = 0; bj < 2; ++bj) {
                    const f32x4 v0 = acc[ai][bj][m][0], v1 = acc[ai][bj][m][1];
                    u32x4 w; w.x = cvt_pk_bf16(v0[0], v0[1]); w.y = cvt_pk_bf16(v0[2], v0[3]); w.z = cvt_pk_bf16(v1[0], v1[1]); w.w = cvt_pk_bf16(v1[2], v1[3]);
                    *(u32x4*)(rowp + bj * HALF) = w;
                }
                if (fcl) *(f32x4*)(fcbuf + (size_t)row * 4) = acc[ai][0][m][0];
            }
    }
};
struct EpiRowScale {
    static constexpr bool PERM = true, AFTER_DRAIN = false;
    bf16_t* O; int ldc; const float* rs;
    __device__ __forceinline__ void operator()(const f32x4 (&acc)[2][2][4][2], const Unit& u, int wr, int wc, int fr, int fq) const {
        const int row0 = u.pm * BM + wr * 64 + fr, col0 = u.pn * BM + wc * 32 + 8 * fq;
#pragma unroll
        for (int ai = 0; ai < 2; ++ai)
#pragma unroll
            for (int m = 0; m < 4; ++m) {
                const int row = row0 + ai * HALF + m * 16;
                const float s = rs[row];
                bf16_t* rowp = O + (size_t)row * ldc + col0;
#pragma unroll
                for (int bj = 0; bj < 2; ++bj) {
                    const f32x4 v0 = acc[ai][bj][m][0] * s, v1 = acc[ai][bj][m][1] * s;
                    u32x4 w; w.x = cvt_pk_bf16(v0[0], v0[1]); w.y = cvt_pk_bf16(v0[2], v0[3]); w.z = cvt_pk_bf16(v1[0], v1[1]); w.w = cvt_pk_bf16(v1[2], v1[3]);
                    *(u32x4*)(rowp + bj * HALF) = w;
                }
            }
    }
};
}

template <class Map>
__device__ __forceinline__ void transpose_rows(const Map mp, const float* ks, int nrows_out, int K, bf16* WT, LAS float* scr, int gw, int NGW, int lane) {
    const int nblk = nrows_out / 32, nitems = (K / 64) * nblk;
    for (int it = gw; it < nitems; it += NGW) {
        const int kb = it / nblk, nb = it % nblk, k0 = 64 * kb, n0 = 32 * nb;
        const float* src; long pitch; float sc;
        mp.get(n0 + (lane & 31), src, pitch, sc);
#pragma unroll 8
        for (int i = 0; i < 32; ++i) {
            const int kk = 2 * i + (lane >> 5);
            float v = 0.f;
            if (src) { v = src[(size_t)(k0 + kk) * pitch] * sc; if (ks) v *= ks[k0 + kk]; }
            scr[kk * 33 + (lane & 31)] = v;
        }
        asm volatile("s_waitcnt lgkmcnt(0)" ::: "memory");
        const int c = lane & 7;
#pragma unroll
        for (int j = 0; j < 4; ++j) {
            const int n = (lane >> 3) + 8 * j; const LAS float* s = scr + (8 * c) * 33 + n;
            v4u o; o.x = pk2(s[0 * 33], s[1 * 33]); o.y = pk2(s[2 * 33], s[3 * 33]); o.z = pk2(s[4 * 33], s[5 * 33]); o.w = pk2(s[6 * 33], s[7 * 33]);
            *(v4u*)(WT + (size_t)(n0 + n) * K + k0 + 8 * c) = o;
        }
        asm volatile("s_waitcnt lgkmcnt(0)" ::: "memory");
    }
}
struct MapIn {
    const float* w;
    __device__ __forceinline__ void get(int n, const float*& src, long& pitch, float& sc) const {
        int c;
        if (n < 1152) c = n;
        else if (n < Z_CKV) c = OFF_QC + (n - Z_QC);
        else if (n < Z_CQ) c = OFF_CKV + (n - Z_CKV);
        else if (n < Z_KR) c = OFF_CQ + (n - Z_CQ);
        else if (n < Z_FC) c = OFF_KR + (n - Z_KR);
        else if (n < Z_FC + 4) c = OFF_FC + (n - Z_FC);
        else c = -1;
        src = c >= 0 ? w + c : nullptr; pitch = D_IN; sc = 1.f;
    }
};
struct MapPlain {
    const float* w; int N, nvalid;
    __device__ __forceinline__ void get(int n, const float*& src, long& pitch, float& sc) const { src = n < nvalid ? w + n : nullptr; pitch = N; sc = 1.f; }
};

struct GD {
    const float* A; long lda; const int* gather; const float* B; long ldb; long bstride; const int* tile_e;
    float* C; long ldc; int M, N, K, mode;
};
__device__ __forceinline__ void gemm_naive(const GD& g, float* sm, const int tid) {
    float* As = sm;
    float* Bs = sm + 16 * 132;
    const int ty = tid >> 5, tx = tid & 31;
    const int ntm = g.M / 128, ntn = (g.N + 127) / 128;
    const int lr = tid >> 2, lc = (tid & 3) * 4;
    const int kr = tid >> 5, bc = (tid & 31) * 4;
    for (int tile = blockIdx.x; tile < ntm * ntn; tile += gridDim.x) {
        const int tm = tile / ntn, tn = tile % ntn;
        const float* Bp = g.B;
        if (g.tile_e) { const int e = g.tile_e[tm]; if (e < 0) continue; Bp += (long)e * g.bstride; }
        long arow = (long)tm * 128 + lr;
        if (g.gather) arow = g.gather[tm * 128 + lr];
        const float* ap = g.A + (arow < 0 ? 0 : arow) * g.lda + lc;
        const int bcol = tn * 128 + bc;
        float acc[8][4];
#pragma unroll
        for (int i = 0; i < 8; ++i)
#pragma unroll
            for (int j = 0; j < 4; ++j) acc[i][j] = 0.f;
        for (int k0 = 0; k0 < g.K; k0 += 16) {
            float4 av = make_float4(0.f, 0.f, 0.f, 0.f), bv = make_float4(0.f, 0.f, 0.f, 0.f);
            if (arow >= 0) av = *(const float4*)(ap + k0);
            if (bcol < g.N) bv = *(const float4*)(Bp + (long)(k0 + kr) * g.ldb + bcol);
            __syncthreads();
            As[(lc + 0) * 132 + lr] = av.x; As[(lc + 1) * 132 + lr] = av.y; As[(lc + 2) * 132 + lr] = av.z; As[(lc + 3) * 132 + lr] = av.w;
            *(float4*)(Bs + kr * 132 + bc) = bv;
            __syncthreads();
#pragma unroll 2
            for (int k = 0; k < 16; ++k) {
                const float4 a0 = *(const float4*)(As + k * 132 + ty * 8), a1 = *(const float4*)(As + k * 132 + ty * 8 + 4);
                const float4 b = *(const float4*)(Bs + k * 132 + tx * 4);
                const float a[8] = {a0.x, a0.y, a0.z, a0.w, a1.x, a1.y, a1.z, a1.w};
                const float bb[4] = {b.x, b.y, b.z, b.w};
#pragma unroll
                for (int i = 0; i < 8; ++i)
#pragma unroll
                    for (int j = 0; j < 4; ++j) acc[i][j] = fmaf(a[i], bb[j], acc[i][j]);
            }
        }
        const int col = tn * 128 + tx * 4;
        if (col < g.N) {
#pragma unroll
            for (int i = 0; i < 8; ++i) {
                float* cp = g.C + ((long)tm * 128 + ty * 8 + i) * g.ldc + col;
                float4 o = make_float4(acc[i][0], acc[i][1], acc[i][2], acc[i][3]);
                if (g.mode == 1) {
                    const float4 c = *(const float4*)cp;
                    o.x *= c.x / (1.f + expf(-c.x)); o.y *= c.y / (1.f + expf(-c.y)); o.z *= c.z / (1.f + expf(-c.z)); o.w *= c.w / (1.f + expf(-c.w));
                } else if (g.mode == 2) {
                    const float4 c = *(const float4*)cp;
                    o.x = c.x / (1.f + expf(-o.x)); o.y = c.y / (1.f + expf(-o.y)); o.z = c.z / (1.f + expf(-o.z)); o.w = c.w / (1.f + expf(-o.w));
                }
                *(float4*)cp = o;
            }
        }
    }
    __syncthreads();
}

struct AttnP {
    const bf16* z16; const bf16* qb16; const bf16* kvb16; const bf16* krr16; const float* cum; const float* cosT; const float* sinT;
    const int* pos; bf16* mixed16; const float* lq1; const float* lk1; const float* lq2; const float* lk2; const float* gdiff; int layer;
};
template <int MODE> __device__ __forceinline__ void attn_naive_unit(const AttnP& p, int b, int h, int qb, float* sm, const int tid) {
    constexpr int DK = MODE == 0 ? 32 : (MODE == 1 ? 96 : 64);
    constexpr int DK8 = DK / 8, DH = DK / 2, DH4 = DH / 4, DH8 = DH / 8;
    float* Ks = sm;
    float* Vs = Ks + 64 * DK;
    float* Bs = Vs + 64 * 64;
    const int lane = tid & 63, w = __builtin_amdgcn_readfirstlane(tid >> 6), part = lane & 1;
    const int c = qb * 4 + (w >> 1), t = c * 64 + (w & 1) * 32 + (lane >> 1);
    const long row = (long)b * SEQ + t;
    const float scale = MODE == 0 ? 0.17677669529663687f : (MODE == 1 ? 0.10206207261596575f : 0.125f);
    float qbias = 0.f, slope = 0.f;
    if (MODE == 0) { qbias = (float)p.pos[row]; slope = exp2f(-8.0f * (float)(h + 1) / 6.0f); }
    if (MODE == 2) qbias = p.cum[row * 4 + h];
    float o1[32];
    constexpr int NMAPS = MODE == 0 ? 2 : 1;
#pragma unroll 1
    for (int m = 0; m < NMAPS; ++m) {
        float q[DH];
        {
            const bf16* qsrc = MODE == 0 ? p.z16 + row * ZP + Z_QA + h * 64 + m * 32 : (MODE == 1 ? p.qb16 + row * NQBP + h * 96 : p.z16 + row * ZP + Z_QC + h * 64);
            const v4u* qp = (const v4u*)(qsrc + part * DH);
#pragma unroll
            for (int i = 0; i < DH8; ++i) unpack8(qp[i], q + 8 * i);
        }
        if (MODE == 1) {
#pragma unroll
            for (int j = 0; j < 16; ++j) {
                const float cs = p.cosT[row * 16 + j], sn = p.sinT[row * 16 + j];
                const float x1 = q[(16 + j) % DH], x2 = q[(32 + j) % DH];
                if (part == 1) { q[(16 + j) % DH] = x1 * cs - x2 * sn; q[(32 + j) % DH] = x2 * cs + x1 * sn; }
            }
        }
        float acc[32];
#pragma unroll
        for (int i = 0; i < 32; ++i) acc[i] = 0.f;
        float mx = -INFINITY, l = 0.f;
        const int ntiles = qb * 4 + 4;
#pragma unroll 1
        for (int kt = 0; kt < ntiles; ++kt) {
            const int k0 = kt * 64;
            __syncthreads();
#pragma unroll
            for (int i = 0; i < (64 * DK8 + NTHREADS - 1) / NTHREADS; ++i) {
                const int idx = tid + i * NTHREADS;
                if (idx < 64 * DK8) {
                    const int s = idx / DK8, c8 = idx % DK8; const long kr = (long)b * SEQ + k0 + s;
                    v4u v;
                    if (MODE == 0) v = *(const v4u*)(p.z16 + kr * ZP + Z_KA + h * 64 + m * 32 + c8 * 8);
                    else if (MODE == 1) v = (c8 < 8) ? *(const v4u*)(p.kvb16 + kr * NKVB + h * 128 + c8 * 8) : *(const v4u*)(p.krr16 + kr * 32 + (c8 - 8) * 8);
                    else v = *(const v4u*)(p.z16 + kr * ZP + Z_KC + h * 64 + c8 * 8);
                    float f[8]; unpack8(v, f);
                    *(float4*)(Ks + s * DK + c8 * 8) = make_float4(f[0], f[1], f[2], f[3]);
                    *(float4*)(Ks + s * DK + c8 * 8 + 4) = make_float4(f[4], f[5], f[6], f[7]);
                }
            }
            {
                const int s = tid >> 3, c8 = tid & 7; const long kr = (long)b * SEQ + k0 + s;
                v4u v;
                if (MODE == 0) v = *(const v4u*)(p.z16 + kr * ZP + Z_VA + h * 64 + c8 * 8);
                else if (MODE == 1) v = *(const v4u*)(p.kvb16 + kr * NKVB + h * 128 + 64 + c8 * 8);
                else v = *(const v4u*)(p.z16 + kr * ZP + Z_VC + h * 64 + c8 * 8);
                float f[8]; unpack8(v, f);
                *(float4*)(Vs + s * 64 + c8 * 8) = make_float4(f[0], f[1], f[2], f[3]);
                *(float4*)(Vs + s * 64 + c8 * 8 + 4) = make_float4(f[4], f[5], f[6], f[7]);
            }
            if (tid < 64) {
                const long kr = (long)b * SEQ + k0 + tid;
                Bs[tid] = MODE == 0 ? (float)p.pos[kr] : (MODE == 2 ? p.cum[kr * 4 + h] : 0.f);
            }
            __syncthreads();
            if (kt <= c) {
#pragma unroll 1
                for (int s = 0; s < 64; ++s) {
                    const float4* kp = (const float4*)(Ks + s * DK + part * DH);
                    float dot = 0.f;
#pragma unroll
                    for (int i = 0; i < DH4; ++i) { const float4 kv = kp[i]; dot = fmaf(q[4 * i], kv.x, dot); dot = fmaf(q[4 * i + 1], kv.y, dot); dot = fmaf(q[4 * i + 2], kv.z, dot); dot = fmaf(q[4 * i + 3], kv.w, dot); }
                    dot += __shfl_xor(dot, 1);
                    float lg = dot * scale;
                    if (MODE == 0) lg -= slope * fabsf(qbias - Bs[s]);
                    if (MODE == 2) lg += qbias - Bs[s];
                    const bool ok = (MODE != 2) || (k0 + s <= t);
                    if (ok) {
                        if (lg > mx) {
                            const float corr = expf(mx - lg); l *= corr;
#pragma unroll
                            for (int i = 0; i < 32; ++i) acc[i] *= corr;
                            mx = lg;
                        }
                        const float pe = expf(lg - mx); l += pe;
                        const float4* vp = (const float4*)(Vs + s * 64 + part * 32);
#pragma unroll
                        for (int i = 0; i < 8; ++i) { const float4 vv = vp[i]; acc[4 * i] = fmaf(pe, vv.x, acc[4 * i]); acc[4 * i + 1] = fmaf(pe, vv.y, acc[4 * i + 1]); acc[4 * i + 2] = fmaf(pe, vv.z, acc[4 * i + 2]); acc[4 * i + 3] = fmaf(pe, vv.w, acc[4 * i + 3]); }
                    }
                }
            }
        }
        const float inv = 1.f / l;
        if (MODE == 0 && m == 0) {
#pragma unroll
            for (int i = 0; i < 32; ++i) o1[i] = acc[i] * inv;
        } else {
            bf16* op = p.mixed16 + row * D_MODEL + (MODE == 0 ? 0 : (MODE == 1 ? 384 : 768)) + h * 64 + part * 32;
            if (MODE == 0) {
                const float lam_init = 0.8f - 0.6f * expf(-0.3f * (float)p.layer);
                float s1 = 0.f, s2 = 0.f;
                for (int i = 0; i < 32; ++i) { s1 += p.lq1[i] * p.lk1[i]; s2 += p.lq2[i] * p.lk2[i]; }
                const float lam = expf(s1) - expf(s2) + lam_init;
                float ss = 0.f;
#pragma unroll
                for (int i = 0; i < 32; ++i) { acc[i] = o1[i] - lam * (acc[i] * inv); ss = fmaf(acc[i], acc[i], ss); }
                ss += __shfl_xor(ss, 1);
                const float r = rsqrtf(ss * (1.f / 64.f) + RMS_EPS) * (1.f - lam_init);
#pragma unroll
                for (int i = 0; i < 32; ++i) acc[i] = acc[i] * r * p.gdiff[part * 32 + i];
            } else {
#pragma unroll
                for (int i = 0; i < 32; ++i) acc[i] *= inv;
            }
#pragma unroll
            for (int i = 0; i < 4; ++i) {
                v4u o; o.x = pk2(acc[8 * i], acc[8 * i + 1]); o.y = pk2(acc[8 * i + 2], acc[8 * i + 3]); o.z = pk2(acc[8 * i + 4], acc[8 * i + 5]); o.w = pk2(acc[8 * i + 6], acc[8 * i + 7]);
                *(v4u*)(op + 8 * i) = o;
            }
        }
    }
    __syncthreads();
}

__device__ __forceinline__ void convert_layer_weights(const Args& a, int l, unsigned char* ws, LAS float* scr, int gw, int NGW, int lane) {
    const float* w_in = (const float*)a.in[3] + (size_t)l * D_MODEL * D_IN;
    const float* w_uq = (const float*)a.in[4] + (size_t)l * 256 * NQB;
    const float* w_ukv = (const float*)a.in[5] + (size_t)l * 128 * NKVB;
    const float* g_cq = (const float*)a.in[6] + l * 256;
    const float* g_ckv = (const float*)a.in[7] + l * 128;
    const float* w_out = (const float*)a.in[14] + (size_t)l * 1024 * 1024;
    transpose_rows(MapIn{w_in}, nullptr, ZP, 1024, (bf16*)(ws + WS_WIN), scr, gw, NGW, lane);
    transpose_rows(MapPlain{w_uq, NQB, NQB}, g_cq, NQBP, 256, (bf16*)(ws + WS_WUQ), scr, gw, NGW, lane);
    transpose_rows(MapPlain{w_ukv, NKVB, NKVB}, g_ckv, NKVB, 128, (bf16*)(ws + WS_WUKV), scr, gw, NGW, lane);
    transpose_rows(MapPlain{w_out, 1024, 1024}, nullptr, 1024, 1024, (bf16*)(ws + WS_WOUT), scr, gw, NGW, lane);
}

constexpr int PH_PER_LAYER = 11, NPH = 1 + DEPTH * PH_PER_LAYER;
template <int PH> __device__ __forceinline__ void run_phase(const Args& a, unsigned char* lds_raw) {
    float* sm = (float*)lds_raw;
    const int G = gridDim.x, NGW = G * 8, NGT = G * NTHREADS;
    unsigned char* ws = a.ws;
    const float* x0 = (const float*)a.in[0];
    const float* pin = (const float*)a.in[1];
    const int* pos = (const int*)a.in[2];
    float* cosT = (float*)(ws + WS_COS); float* sinT = (float*)(ws + WS_SIN);
    bf16* a16 = (bf16*)(ws + WS_A16); bf16* z16 = (bf16*)(ws + WS_Z16); bf16* qb16 = (bf16*)(ws + WS_QB16); bf16* kvb16 = (bf16*)(ws + WS_KVB16);
    bf16* krr16 = (bf16*)(ws + WS_KRR16); float* fcbuf = (float*)(ws + WS_FC); float* cum = (float*)(ws + WS_CUM);
    float* rq = (float*)(ws + WS_RQ); float* rkv = (float*)(ws + WS_RKV);
    bf16* mixed16 = (bf16*)(ws + WS_MIXED16); bf16* mix16 = (bf16*)(ws + WS_MIX16);
    float* hbuf = a.out; float* act = (float*)(ws + WS_ACT); float* outs = (float*)(ws + WS_OUTS); float* ple = (float*)(ws + WS_PLE);
    int* ids = (int*)(ws + WS_RT + RT_IDS); float* wts = (float*)(ws + WS_RT + RT_WTS); int* rank = (int*)(ws + WS_RT + RT_RANK);
    int* slot_of = (int*)(ws + WS_RT + RT_SLOTOF); int* slot_tok = (int*)(ws + WS_RT + RT_SLOTTOK); int* tile_e = (int*)(ws + WS_RT + RT_TILEE);
    unsigned* ctl = (unsigned*)(ws + WS_CTL);

        int tid = threadIdx.x; asm volatile("" : "+v"(tid));
        const int lane = tid & 63, wave = __builtin_amdgcn_readfirstlane(tid >> 6);
        const int gw = blockIdx.x * 8 + wave, gtid = blockIdx.x * NTHREADS + tid;
        LAS float* scr = (LAS float*)((LAS unsigned char*)lds_raw + wave * 16384);
        if constexpr (PH == 0) {
            for (int i = gtid; i < NTOK * 16; i += NGT) {
                const int tk = i >> 4, j = i & 15;
                const int j4 = j >> 2, jr = j & 3;
                const double inv = (j4 == 0 ? 1.0 : (j4 == 1 ? 0.1 : (j4 == 2 ? 0.01 : 0.001))) * (jr == 0 ? 1.0 : (jr == 1 ? 0.5623413251903491 : (jr == 2 ? 0.31622776601683794 : 0.1778279410038923)));
                const double ang = (double)pos[tk] * inv;
                const double k = rint(ang * 0.15915494309189535);
                const double r = fma(-k, 6.283185307179586, ang) - k * 2.4492935982947064e-16;
                cosT[i] = cosf((float)r); sinT[i] = sinf((float)r);
            }
            for (int i = gtid; i < NTOK * D_MODEL / 8; i += NGT) {
                const float4 v0 = *(const float4*)(x0 + (size_t)i * 8), v1 = *(const float4*)(x0 + (size_t)i * 8 + 4);
                v4u o; o.x = pk2(v0.x, v0.y); o.y = pk2(v0.z, v0.w); o.z = pk2(v1.x, v1.y); o.w = pk2(v1.z, v1.w);
                *(v4u*)(a16 + (size_t)i * 8) = o;
            }
            convert_layer_weights(a, 0, ws, scr, gw, NGW, lane);
        } else {
            constexpr int l = (PH - 1) / PH_PER_LAYER, sp = (PH - 1) % PH_PER_LAYER;
            const float* xin = (l == 0) ? x0 : a.out;
            const float* b_forget = (const float*)a.in[13] + l * 4;
            const float* ln1_g = (const float*)a.in[15] + l * 1024; const float* ln1_b = (const float*)a.in[16] + l * 1024;
            const float* w_group = (const float*)a.in[17] + l * 1024 * 4; const float* b_group = (const float*)a.in[18] + l * 4;
            const float* w_er = (const float*)a.in[19] + (size_t)l * 4 * 1024 * 8; const float* b_er = (const float*)a.in[20] + l * 32;
            const float* w_ge = (const float*)a.in[21] + (size_t)l * 32 * 1024 * 256;
            const float* w_ue = (const float*)a.in[22] + (size_t)l * 32 * 1024 * 256;
            const float* w_de = (const float*)a.in[23] + (size_t)l * 32 * 256 * 1024;
            const float* w_pg = (const float*)a.in[24] + (size_t)l * 1024 * 1024;
            const float* w_pp = (const float*)a.in[25] + (size_t)l * 256 * 1024;
            const float* ln2_g = (const float*)a.in[26] + l * 1024; const float* ln2_b = (const float*)a.in[27] + l * 1024;
            const float* pl = pin + (size_t)l * NTOK * PLE_DIM;
            unsigned* cnt = ctl + CW_CNT + l * 32;
            if constexpr (sp == 0) {
                pg8::Gemm g{a16, (const bf16*)(ws + WS_WIN), NTOK, ZP, 1024, 1024, 1024};
                pg8::StaticOrder S; S.init(NTOK, ZP, G, (int)blockIdx.x);
                pg8::EpiZ E{z16, ZP, fcbuf};
                pg8::gemm_phase<pg8::EpiZ, pg8::StaticOrder, true, true>((LAS unsigned char*)lds_raw, g, S, E, tid);
            } else if constexpr (sp == 1) {
                for (int tk = gw; tk < NTOK; tk += NGW) {
                    const bf16* zr = z16 + (size_t)tk * ZP;
                    const v2u cv = *(const v2u*)(zr + Z_CQ + lane * 4);
                    const float c0 = bflo(cv.x), c1 = bfhi(cv.x), c2 = bflo(cv.y), c3 = bfhi(cv.y);
                    float ss = wave_sum(c0 * c0 + c1 * c1 + c2 * c2 + c3 * c3);
                    const float r1 = rsqrtf(ss * (1.f / 256.f) + RMS_EPS);
                    const unsigned kvw = *(const unsigned*)(zr + Z_CKV + lane * 2);
                    const float k0 = bflo(kvw), k1 = bfhi(kvw);
                    ss = wave_sum(k0 * k0 + k1 * k1);
                    const float r2 = rsqrtf(ss * (1.f / 128.f) + RMS_EPS);
                    if (lane == 0) { rq[tk] = r1; rkv[tk] = r2; }
                    if (lane < 16) {
                        const float x1 = __uint_as_float((unsigned)zr[Z_KR + lane] << 16), x2 = __uint_as_float((unsigned)zr[Z_KR + 16 + lane] << 16);
                        const float cs = cosT[tk * 16 + lane], sn = sinT[tk * 16 + lane];
                        krr16[tk * 32 + lane] = (bf16)f2bf(x1 * cs - x2 * sn); krr16[tk * 32 + 16 + lane] = (bf16)f2bf(x2 * cs + x1 * sn);
                    }
                    if (lane < 4) {
                        const float xf = fcbuf[tk * 4 + lane] + b_forget[lane];
                        cum[tk * 4 + lane] = fminf(xf, 0.f) - log1pf(expf(-fabsf(xf)));
                    }
                }
            } else if constexpr (sp == 2) {
                {
                    pg8::Gemm g{z16 + Z_CQ, (const bf16*)(ws + WS_WUQ), NTOK, NQBP, 256, ZP, 256};
                    pg8::StaticOrder S; S.init(NTOK, NQBP, G, (int)blockIdx.x);
                    pg8::EpiRowScale E{qb16, NQBP, rq};
                    pg8::gemm_phase<pg8::EpiRowScale, pg8::StaticOrder, true, true>((LAS unsigned char*)lds_raw, g, S, E, tid);
                }
                {
                    pg8::Gemm g{z16 + Z_CKV, (const bf16*)(ws + WS_WUKV), NTOK, NKVB, 128, ZP, 128};
                    pg8::StaticOrder S; S.init(NTOK, NKVB, G, (int)((blockIdx.x + 128) % G));
                    pg8::EpiRowScale E{kvb16, NKVB, rkv};
                    pg8::gemm_phase<pg8::EpiRowScale, pg8::StaticOrder, true, true>((LAS unsigned char*)lds_raw, g, S, E, tid);
                }
                const int cw = NGW - 1 - gw;
                if (cw < 32) {
                    const int b = cw >> 2, hh = cw & 3;
                    float* cp = cum + ((size_t)b * SEQ) * 4 + hh;
                    float loc[32]; float run = 0.f;
#pragma unroll
                    for (int i = 0; i < 32; ++i) { run += cp[(size_t)(lane * 32 + i) * 4]; loc[i] = run; }
                    float pre = run;
#pragma unroll
                    for (int o = 1; o < 64; o <<= 1) { const float n = __shfl_up(pre, o); if (lane >= o) pre += n; }
                    pre -= run;
#pragma unroll
                    for (int i = 0; i < 32; ++i) cp[(size_t)(lane * 32 + i) * 4] = loc[i] + pre;
                }
            } else if constexpr (sp == 3) {
                __syncthreads();
                AttnP p{z16, qb16, kvb16, krr16, cum, cosT, sinT, pos, mixed16,
                        (const float*)a.in[8] + l * 32, (const float*)a.in[9] + l * 32, (const float*)a.in[10] + l * 32, (const float*)a.in[11] + l * 32,
                        (const float*)a.in[12] + l * 64, l};
                for (int idx = blockIdx.x; idx < 1024; idx += G) {
                    const int qb = 7 - idx / 128, j = idx % 128;
                    if (j < 48) attn_naive_unit<0>(p, j / 6, j % 6, qb, sm, tid);
                    else if (j < 96) attn_naive_unit<1>(p, (j - 48) / 6, (j - 48) % 6, qb, sm, tid);
                    else attn_naive_unit<2>(p, (j - 96) / 4, (j - 96) % 4, qb, sm, tid);
                }
            } else if constexpr (sp == 4) {
                pg8::Gemm g{mixed16, (const bf16*)(ws + WS_WOUT), NTOK, 1024, 1024, 1024, 1024};
                pg8::StaticOrder S; S.init(NTOK, 1024, G, (int)blockIdx.x);
                pg8::EpiBf16<0> E{mix16, 1024, nullptr, 0, 0, 1.f};
                pg8::gemm_phase<pg8::EpiBf16<0>, pg8::StaticOrder, true, true>((LAS unsigned char*)lds_raw, g, S, E, tid);
            } else if constexpr (sp == 5) {
                for (int tk = gw; tk < NTOK; tk += NGW) {
                    float4 v[4]; float s = 0.f;
#pragma unroll
                    for (int j = 0; j < 4; ++j) {
                        const float4 xv = *(const float4*)(xin + (size_t)tk * D_MODEL + j * 256 + lane * 4);
                        const v2u mw = *(const v2u*)(mix16 + (size_t)tk * D_MODEL + j * 256 + lane * 4);
                        v[j] = make_float4(ALPHA * xv.x + bflo(mw.x), ALPHA * xv.y + bfhi(mw.x), ALPHA * xv.z + bflo(mw.y), ALPHA * xv.w + bfhi(mw.y));
                        s += (v[j].x + v[j].y) + (v[j].z + v[j].w);
                    }
                    const float mean = wave_sum(s) * (1.f / 1024.f); float s2 = 0.f;
#pragma unroll
                    for (int j = 0; j < 4; ++j) { v[j].x -= mean; v[j].y -= mean; v[j].z -= mean; v[j].w -= mean; s2 += (v[j].x * v[j].x + v[j].y * v[j].y) + (v[j].z * v[j].z + v[j].w * v[j].w); }
                    const float rstd = rsqrtf(wave_sum(s2) * (1.f / 1024.f) + LN_EPS);
                    float gl[4] = {0.f, 0.f, 0.f, 0.f};
#pragma unroll
                    for (int j = 0; j < 4; ++j) {
                        const int d0 = j * 256 + lane * 4;
                        const float4 gg = *(const float4*)(ln1_g + d0), bb = *(const float4*)(ln1_b + d0);
                        v[j] = make_float4(v[j].x * rstd * gg.x + bb.x, v[j].y * rstd * gg.y + bb.y, v[j].z * rstd * gg.z + bb.z, v[j].w * rstd * gg.w + bb.w);
                        *(float4*)(hbuf + (size_t)tk * D_MODEL + d0) = v[j];
                        const float hv[4] = {v[j].x, v[j].y, v[j].z, v[j].w};
#pragma unroll
                        for (int i = 0; i < 4; ++i) {
                            const float4 wg = *(const float4*)(w_group + (size_t)(d0 + i) * 4);
                            gl[0] = fmaf(hv[i], wg.x, gl[0]); gl[1] = fmaf(hv[i], wg.y, gl[1]); gl[2] = fmaf(hv[i], wg.z, gl[2]); gl[3] = fmaf(hv[i], wg.w, gl[3]);
                        }
                    }
#pragma unroll
                    for (int i = 0; i < 4; ++i) gl[i] = wave_sum(gl[i]) + b_group[i];
                    int gi = 0; float gm = gl[0];
#pragma unroll
                    for (int i = 1; i < 4; ++i) if (gl[i] > gm) { gm = gl[i]; gi = i; }
                    float gden = 0.f;
#pragma unroll
                    for (int i = 0; i < 4; ++i) gden += expf(gl[i] - gm);
                    const float gwt = 1.f / gden;
                    float el[8] = {0.f, 0.f, 0.f, 0.f, 0.f, 0.f, 0.f, 0.f};
                    const float* we = w_er + (size_t)gi * 1024 * 8;
#pragma unroll
                    for (int j = 0; j < 4; ++j) {
                        const int d0 = j * 256 + lane * 4;
                        const float hv[4] = {v[j].x, v[j].y, v[j].z, v[j].w};
#pragma unroll
                        for (int i = 0; i < 4; ++i) {
                            const float4 w0 = *(const float4*)(we + (size_t)(d0 + i) * 8), w1 = *(const float4*)(we + (size_t)(d0 + i) * 8 + 4);
                            el[0] = fmaf(hv[i], w0.x, el[0]); el[1] = fmaf(hv[i], w0.y, el[1]); el[2] = fmaf(hv[i], w0.z, el[2]); el[3] = fmaf(hv[i], w0.w, el[3]);
                            el[4] = fmaf(hv[i], w1.x, el[4]); el[5] = fmaf(hv[i], w1.y, el[5]); el[6] = fmaf(hv[i], w1.z, el[6]); el[7] = fmaf(hv[i], w1.w, el[7]);
                        }
                    }
#pragma unroll
                    for (int i = 0; i < 8; ++i) el[i] = wave_sum(el[i]) + b_er[gi * 8 + i];
                    int i0 = 0; float v0 = el[0];
#pragma unroll
                    for (int i = 1; i < 8; ++i) if (el[i] > v0) { v0 = el[i]; i0 = i; }
                    int i1 = -1; float v1 = -INFINITY;
#pragma unroll
                    for (int i = 0; i < 8; ++i) if (i != i0 && el[i] > v1) { v1 = el[i]; i1 = i; }
                    const float e1 = expf(v1 - v0);
                    const float w0 = gwt / (1.f + e1), w1 = gwt * e1 / (1.f + e1);
                    if (lane == 0) {
                        const int ea = gi * 8 + i0, eb = gi * 8 + i1;
                        ids[tk * 2] = ea; ids[tk * 2 + 1] = eb; wts[tk * 2] = w0; wts[tk * 2 + 1] = w1;
                        rank[tk * 2] = (int)atomicAdd(cnt + ea, 1u); rank[tk * 2 + 1] = (int)atomicAdd(cnt + eb, 1u);
                    }
                }
            } else if constexpr (sp == 6) {
                int* offs = (int*)sm;
                __syncthreads();
                if (tid == 0) { int o = 0; for (int e = 0; e < 32; ++e) { offs[e] = o; o += ((int)cnt[e] + 127) & ~127; } offs[32] = o; }
                __syncthreads();
                for (int i = gtid; i < NTOK * 2; i += NGT) { const int e = ids[i]; const int s = offs[e] + rank[i]; slot_of[i] = s; slot_tok[s] = i >> 1; }
                for (int i = gtid; i < 32 * 128; i += NGT) { const int e = i >> 7, j = i & 127; const int s = offs[e] + (int)cnt[e] + j; if (s < offs[e + 1]) slot_tok[s] = -1; }
                for (int i = gtid; i < NSLOT_TILES; i += NGT) { int e = -1; for (int k = 0; k < 32; ++k) if (i * 128 >= offs[k] && i * 128 < offs[k + 1]) e = k; tile_e[i] = e; }
                __syncthreads();
            } else if constexpr (sp == 7) {
                GD g{hbuf, D_MODEL, slot_tok, w_ge, D_EXPERT, (long)D_MODEL * D_EXPERT, tile_e, act, D_EXPERT, MAX_SLOTS, D_EXPERT, D_MODEL, 0};
                gemm_naive(g, sm, tid);
                GD g2{pl, PLE_DIM, nullptr, w_pp, D_MODEL, 0, nullptr, ple, D_MODEL, NTOK, D_MODEL, PLE_DIM, 0};
                gemm_naive(g2, sm, tid);
            } else if constexpr (sp == 8) {
                GD g{hbuf, D_MODEL, slot_tok, w_ue, D_EXPERT, (long)D_MODEL * D_EXPERT, tile_e, act, D_EXPERT, MAX_SLOTS, D_EXPERT, D_MODEL, 1};
                gemm_naive(g, sm, tid);
                GD g2{hbuf, D_MODEL, nullptr, w_pg, D_MODEL, 0, nullptr, ple, D_MODEL, NTOK, D_MODEL, D_MODEL, 2};
                gemm_naive(g2, sm, tid);
            } else if constexpr (sp == 9) {
                GD g{act, D_EXPERT, nullptr, w_de, D_MODEL, (long)D_EXPERT * D_MODEL, tile_e, outs, D_MODEL, MAX_SLOTS, D_MODEL, D_EXPERT, 0};
                gemm_naive(g, sm, tid);
            } else if constexpr (sp == 10) {
                for (int tk = gw; tk < NTOK; tk += NGW) {
                    const int s0 = slot_of[tk * 2], s1 = slot_of[tk * 2 + 1]; const float w0 = wts[tk * 2], w1 = wts[tk * 2 + 1];
                    float4 v[4]; float s = 0.f;
#pragma unroll
                    for (int j = 0; j < 4; ++j) {
                        const int d0 = j * 256 + lane * 4;
                        const float4 hv = *(const float4*)(hbuf + (size_t)tk * D_MODEL + d0);
                        const float4 oa = *(const float4*)(outs + (size_t)s0 * D_MODEL + d0), ob = *(const float4*)(outs + (size_t)s1 * D_MODEL + d0);
                        const float4 pv = *(const float4*)(ple + (size_t)tk * D_MODEL + d0);
                        v[j] = make_float4(ALPHA * hv.x + w0 * oa.x + w1 * ob.x + pv.x, ALPHA * hv.y + w0 * oa.y + w1 * ob.y + pv.y,
                                           ALPHA * hv.z + w0 * oa.z + w1 * ob.z + pv.z, ALPHA * hv.w + w0 * oa.w + w1 * ob.w + pv.w);
                        s += (v[j].x + v[j].y) + (v[j].z + v[j].w);
                    }
                    const float mean = wave_sum(s) * (1.f / 1024.f); float s2 = 0.f;
#pragma unroll
                    for (int j = 0; j < 4; ++j) { v[j].x -= mean; v[j].y -= mean; v[j].z -= mean; v[j].w -= mean; s2 += (v[j].x * v[j].x + v[j].y * v[j].y) + (v[j].z * v[j].z + v[j].w * v[j].w); }
                    const float rstd = rsqrtf(wave_sum(s2) * (1.f / 1024.f) + LN_EPS);
#pragma unroll
                    for (int j = 0; j < 4; ++j) {
                        const int d0 = j * 256 + lane * 4;
                        const float4 gg = *(const float4*)(ln2_g + d0), bb = *(const float4*)(ln2_b + d0);
                        const float4 o = make_float4(v[j].x * rstd * gg.x + bb.x, v[j].y * rstd * gg.y + bb.y, v[j].z * rstd * gg.z + bb.z, v[j].w * rstd * gg.w + bb.w);
                        *(float4*)(a.out + (size_t)tk * D_MODEL + d0) = o;
                        v2u ob16; ob16.x = pk2(o.x, o.y); ob16.y = pk2(o.z, o.w);
                        *(v2u*)(a16 + (size_t)tk * D_MODEL + d0) = ob16;
                    }
                }
                if (l + 1 < DEPTH) convert_layer_weights(a, l + 1, ws, scr, gw, NGW, lane);
            }
        }
}

__global__ void __launch_bounds__(NTHREADS, 2) mega(Args a) {
    extern __shared__ __attribute__((aligned(16))) unsigned char lds_raw[];
    cg::grid_group grid = cg::this_grid();
#define RUN(ph) if (a.ph_lo <= (ph) && (ph) < a.ph_hi) { run_phase<ph>(a, lds_raw); if ((ph) + 1 < a.ph_hi && (ph) + 1 < NPH) grid.sync(); }
    RUN(0) RUN(1) RUN(2) RUN(3) RUN(4) RUN(5) RUN(6) RUN(7) RUN(8) RUN(9) RUN(10) RUN(11)
    RUN(12) RUN(13) RUN(14) RUN(15) RUN(16) RUN(17) RUN(18) RUN(19) RUN(20) RUN(21) RUN(22)
#undef RUN
}

extern "C" void kernel_launch(void* const* d_in, const int* in_sizes, int n_in, void* d_out, int out_size, void* d_ws, size_t ws_size, hipStream_t stream) {
    static int grid = 0;
    if (grid == 0) {
        if (n_in != 28 || ws_size < WS_END) { fprintf(stderr, "kernel_launch: unexpected n_in %d or ws_size %zu (< %zu)\n", n_in, ws_size, (size_t)WS_END); grid = -1; return; }
        int dev = 0, cus = 0, per_cu = 0;
        (void)hipGetDevice(&dev);
        (void)hipDeviceGetAttribute(&cus, hipDeviceAttributeMultiprocessorCount, dev);
        (void)hipFuncSetAttribute((const void*)mega, hipFuncAttributeMaxDynamicSharedMemorySize, LDS_BYTES);
        (void)hipOccupancyMaxActiveBlocksPerMultiprocessor(&per_cu, (const void*)mega, NTHREADS, LDS_BYTES);
        if (per_cu < 1) { fprintf(stderr, "kernel_launch: occupancy query says %d blocks/CU\n", per_cu); }
        (void)hipGetLastError();
        grid = cus;
    }
    if (grid < 0) return;
    (void)hipMemsetAsync((char*)d_ws + WS_CTL, 0, 64 * 1024, stream);
    Args a{};
    for (int i = 0; i < 28; ++i) a.in[i] = d_in[i];
    a.out = (float*)d_out; a.ws = (unsigned char*)d_ws; a.ph_lo = 0; a.ph_hi = 1 + DEPTH * 11;
    void* params[] = {&a};
    hipError_t e = hipLaunchCooperativeKernel((const void*)mega, dim3(grid), dim3(NTHREADS), params, LDS_BYTES, stream);
    if (e != hipSuccess) fprintf(stderr, "cooperative launch failed: %s (grid %d)\n", hipGetErrorString(e), grid);
}
```

```cpp
#include <hip/hip_runtime.h>
#include <hip/hip_cooperative_groups.h>
#include <cstdio>
#include <cstdint>
namespace cg = cooperative_groups;

constexpr int D_MODEL = 1024, BATCH = 8, SEQ = 2048, NTOK = BATCH * SEQ, DEPTH = 2;
constexpr int D_IN = 2340;
constexpr int OFF_QA = 0, OFF_KA = 384, OFF_VA = 768, OFF_CQ = 1152, OFF_CKV = 1408, OFF_KR = 1536,
              OFF_QC = 1568, OFF_KC = 1824, OFF_VC = 2080, OFF_FC = 2336;
constexpr int ZP = 2560;
constexpr int Z_QA = 0, Z_KA = 384, Z_VA = 768, Z_QC = 1152, Z_KC = 1408, Z_VC = 1664, Z_CKV = 1920, Z_CQ = 2048, Z_KR = 2304, Z_FC = 2336;
constexpr int NQB = 576, NKVB = 768, NQBP = 768;
constexpr int N_EXPERTS = 32, D_EXPERT = 256, PLE_DIM = 256;
constexpr int MAX_SLOTS = 32768 + 32 * 256;
constexpr int NSLOT_TILES = MAX_SLOTS / 256;
constexpr float ALPHA = 1.4142135623730951f;
constexpr float LN_EPS = 1e-5f, RMS_EPS = 1e-6f;
constexpr int NTHREADS = 512;
constexpr int LDS_BYTES = 147456;

constexpr size_t MiB = 1u << 20;
constexpr size_t WS_CTL = 0;
constexpr size_t WS_COS = 1 * MiB, WS_SIN = 2 * MiB;
constexpr size_t WS_WIN = 3 * MiB;
constexpr size_t WS_WUQ = 8 * MiB;
constexpr size_t WS_WUKV = WS_WUQ + 393216;
constexpr size_t WS_WOUT = 9 * MiB;
constexpr size_t WS_WPG = 11 * MiB;
constexpr size_t WS_WPP = 13 * MiB;
constexpr size_t WS_WGU = 14 * MiB;
constexpr size_t WS_WD = 46 * MiB;
constexpr size_t WS_A16 = 62 * MiB;
constexpr size_t WS_P16 = 94 * MiB;
constexpr size_t WS_Z16 = 110 * MiB;
constexpr size_t WS_HS16 = WS_Z16;
constexpr size_t WS_OUTS16 = WS_Z16;
constexpr size_t WS_QB16 = 190 * MiB;
constexpr size_t WS_KVB16 = 214 * MiB;
constexpr size_t WS_KRR16 = 238 * MiB;
constexpr size_t WS_FC = 239 * MiB;
constexpr size_t WS_CUM = WS_FC + 256 * 1024;
constexpr size_t WS_RQ = WS_CUM + 256 * 1024;
constexpr size_t WS_RKV = WS_RQ + 64 * 1024;
constexpr size_t WS_MIX16 = 190 * MiB;
constexpr size_t WS_PP16 = 190 * MiB;
constexpr size_t WS_ACT16 = 222 * MiB;
constexpr size_t WS_MIXED16 = 242 * MiB;
constexpr size_t WS_PLE16 = 242 * MiB;
constexpr size_t WS_RT = 274 * MiB;
constexpr size_t WS_END = 276 * MiB;
constexpr size_t RT_IDS = 0, RT_WTS = 128 * 1024, RT_RANK = 256 * 1024, RT_SLOTOF = 384 * 1024, RT_TILEE = 768 * 1024;
constexpr int CW_CNT = 0;
static_assert((WS_A16 - WS_HS16) % (256 * 1024 * 2) == 0 || true, "");

struct Args { const void* in[28]; float* out; unsigned char* ws; int ph_lo, ph_hi; };

#define LAS __attribute__((address_space(3)))
typedef unsigned short bf16;
typedef unsigned v4u __attribute__((ext_vector_type(4)));
typedef unsigned v2u __attribute__((ext_vector_type(2)));

__device__ __forceinline__ float wave_sum(float v) {
#pragma unroll
    for (int o = 1; o < 64; o <<= 1) v += __shfl_xor(v, o);
    return v;
}
__device__ __forceinline__ unsigned f2bf(float f) { unsigned u = __builtin_bit_cast(unsigned, f); return (u + 0x7fffu + ((u >> 16) & 1u)) >> 16; }
__device__ __forceinline__ unsigned pk2(float lo, float hi) { return f2bf(lo) | (f2bf(hi) << 16); }
__device__ __forceinline__ float bflo(unsigned w) { return __uint_as_float(w << 16); }
__device__ __forceinline__ float bfhi(unsigned w) { return __uint_as_float(w & 0xffff0000u); }
__device__ __forceinline__ void unpack8(const v4u w, float* f) { f[0] = bflo(w.x); f[1] = bfhi(w.x); f[2] = bflo(w.y); f[3] = bfhi(w.y); f[4] = bflo(w.z); f[5] = bfhi(w.z); f[6] = bflo(w.w); f[7] = bfhi(w.w); }
namespace pg8 {
#define PG8_LAS __attribute__((address_space(3)))
typedef unsigned short bf16_t;
typedef short bf16x8 __attribute__((ext_vector_type(8)));
typedef float f32x4 __attribute__((ext_vector_type(4)));
typedef unsigned u32x4 __attribute__((ext_vector_type(4)));
constexpr int BM = 256, BK = 64, HALF = 128, HTB = HALF * BK * 2  , STAGE_BYTES = 8 * HTB, NXCD = 8, WGM = 8;

__host__ __device__ __forceinline__ int lds_byte(int r, int c) { const int st = (r >> 4) * 2 + (c >> 5), rr = r & 15, cc = c & 31, ob = rr * 64 + cc * 2; return st * 1024 + (ob ^ (((ob >> 9) & 1) << 5)); }
__host__ __device__ __forceinline__ void stage_rc(int b, int& R, int& C) { const int st = b / 1024, sb = b % 1024, swz = sb ^ (((sb >> 9) & 1) << 5); R = (st >> 1) * 16 + swz / 64; C = (st & 1) * 32 + (swz % 64) / 2; }
__host__ __device__ __forceinline__ int perm32(int rho) { const int n = rho >> 4, i = rho & 15; return 8 * (i >> 2) + 4 * n + (i & 3); }

struct Unit { int pm, pn; };
struct Gemm { const bf16_t* A; const bf16_t* Bt; int M, N, K, lda, ldb; };

struct StaticOrder {
    int nM, nN, nwg, G, c;
    __host__ __device__ void init(int M, int N, int G_, int c_) { nM = M / BM; nN = N / BM; nwg = nM * nN; G = G_; c = c_; }
    __host__ __device__ bool next(int i, Unit& u) const {
        const long L = (long)i * G + c; if (L >= nwg) return false;
        int wgid = (int)L; { const int q = nwg / NXCD, r = nwg % NXCD, xcd = wgid % NXCD, off = wgid / NXCD; wgid = (xcd < r ? xcd * (q + 1) : r * (q + 1) + (xcd - r) * q) + off; }
        const int nig = WGM * nN, gid = wgid / nig, fm = gid * WGM, gsz = (nM - fm) < WGM ? (nM - fm) : WGM;
        u.pm = fm + ((wgid % nig) % gsz); u.pn = (wgid % nig) / gsz; return true;
    }
    __device__ __forceinline__ void a_ready(const Unit&) const {}
    __device__ __forceinline__ void done(const Unit&) const {}
};

__device__ __forceinline__ unsigned cvt_pk_bf16(float lo, float hi) { unsigned r; asm volatile("v_cvt_pk_bf16_f32 %0, %1, %2" : "=v"(r) : "v"(lo), "v"(hi)); return r; }
typedef float f32x2 __attribute__((ext_vector_type(2)));
__device__ __forceinline__ f32x2 gelu_pk(f32x2 v) {
    const f32x2 av = __builtin_elementwise_abs(v), d = av * 0.2316418882f + 1.0f;
    f32x2 t; t.x = __builtin_amdgcn_rcpf(d.x); t.y = __builtin_amdgcn_rcpf(d.y);
    f32x2 q = t * 0.5307027145f + (-0.7265760135f); q = q * t + 0.7107068705f; q = q * t + (-0.142248368f); q = q * t + 0.127414796f; q = q * t;
    const f32x2 s = (v * v) * (-0.72134752044f);
    f32x2 e; e.x = __builtin_amdgcn_exp2f(s.x); e.y = __builtin_amdgcn_exp2f(s.y);
    const f32x2 m = v * (q * e), r = v - m;
    f32x2 o; o.x = v.x < 0.f ? m.x : r.x; o.y = v.y < 0.f ? m.y : r.y; return o;
}

template <int ACT  > struct EpiBf16 {
    static constexpr bool PERM = true, AFTER_DRAIN = false; static_assert(ACT == 0 || ACT == 1, "EpiBf16: ACT is 0 (none) or 1 (gelu_pk)");
    bf16_t* O; int ldc; const float* bias; int split_cols; size_t split_stride; float scale0;
    __device__ __forceinline__ void operator()(const f32x4 (&acc)[2][2][4][2], const Unit& u, int wr, int wc, int fr, int fq) const {
        const int row0 = u.pm * BM + wr * 64 + fr; int colt = u.pn * BM; bf16_t* base = O;
        float sc = 1.f; if (split_cols) { const int t = colt / split_cols; base += (size_t)t * split_stride; colt -= t * split_cols; if (t == 0) sc = scale0; }
        const int col0 = colt + wc * 32 + 8 * fq, bcol0 = u.pn * BM + wc * 32 + 8 * fq;
        f32x4 bv[2][2];
#pragma unroll
        for (int bj = 0; bj < 2; ++bj)
#pragma unroll
            for (int n = 0; n < 2; ++n) bv[bj][n] = bias ? *(const f32x4*)(bias + bcol0 + bj * HALF + 4 * n) : (f32x4){0.f, 0.f, 0.f, 0.f};
#pragma unroll
        for (int ai = 0; ai < 2; ++ai)
#pragma unroll
            for (int m = 0; m < 4; ++m) { bf16_t* rowp = base + (size_t)(row0 + ai * HALF + m * 16) * ldc + col0;
#pragma unroll
                for (int bj = 0; bj < 2; ++bj) { f32x4 v0 = acc[ai][bj][m][0] + bv[bj][0], v1 = acc[ai][bj][m][1] + bv[bj][1];
                    if (ACT == 1) { f32x2 a = gelu_pk((f32x2){v0[0], v0[1]}), b = gelu_pk((f32x2){v0[2], v0[3]}), c = gelu_pk((f32x2){v1[0], v1[1]}), d = gelu_pk((f32x2){v1[2], v1[3]});
                        v0 = (f32x4){a.x, a.y, b.x, b.y}; v1 = (f32x4){c.x, c.y, d.x, d.y}; }
                    v0 = v0 * sc; v1 = v1 * sc; u32x4 w; w.x = cvt_pk_bf16(v0[0], v0[1]); w.y = cvt_pk_bf16(v0[2], v0[3]); w.z = cvt_pk_bf16(v1[0], v1[1]); w.w = cvt_pk_bf16(v1[2], v1[3]);
                    *(u32x4*)(rowp + bj * HALF) = w; } }
    }
};
template <class Epi, class Sched, bool ALIGN_EPI = false, bool SP2 = false>
__device__ __forceinline__ void gemm_phase(PG8_LAS unsigned char* lds, const Gemm g, const Sched& S, const Epi& E, const int tid) {
    const int wid = __builtin_amdgcn_readfirstlane(tid >> 6), lane = tid & 63, wr = wid >> 2, wc = wid & 3, fr = lane & 15, fq = lane >> 4;
    int K = g.K; asm volatile("" : "+s"(K));
    const int nt = K / BK;
    unsigned voffA[2], voffB[2];
#pragma unroll
    for (int i = 0; i < 2; ++i) { int R, C; stage_rc(tid * 16 + i * 8192, R, C); const int Rb = Epi::PERM ? ((R & ~31) + perm32(R & 31)) : R;
        voffA[i] = (unsigned)(R * g.lda + C) * 2u; voffB[i] = (unsigned)(Rb * g.ldb + C) * 2u; }
    const size_t kstep = (size_t)(BK * 2);
    const size_t hstepA = (size_t)HALF * g.lda * 2, hstepB = (size_t)HALF * g.ldb * 2;
    const size_t tstepA = 2 * hstepA, tstepB = 2 * hstepB;
    const unsigned ldsw = (unsigned)wid * 1024u;
    const int aoff = lds_byte(wr * 64 + fr, fq * 8), boff = lds_byte(wc * 32 + fr, fq * 8);
#define PG8_SA(b, h) (((b) * 2 + (h)) * HTB)
#define PG8_SB(b, h) ((4 + (b) * 2 + (h)) * HTB)
#define PG8_STAGE(bufoff, gbase, voff) do { _Pragma("unroll") for (int _i = 0; _i < 2; ++_i) \
        __builtin_amdgcn_global_load_lds((const unsigned*)((const char*)(gbase) + (voff)[_i]), (PG8_LAS unsigned*)(lds + (bufoff) + ldsw + _i * 8192), 16, 0, 0); } while (0)
#define PG8_LDA(dst, b, h) do { _Pragma("unroll") for (int m = 0; m < 4; ++m) _Pragma("unroll") for (int k = 0; k < 2; ++k) dst[m][k] = *(const PG8_LAS bf16x8*)(lds + PG8_SA(b, h) + aoff + m * 2048 + k * 1024); } while (0)
#define PG8_LDB(dst, b, h) do { _Pragma("unroll") for (int n = 0; n < 2; ++n) _Pragma("unroll") for (int k = 0; k < 2; ++k) dst[n][k] = *(const PG8_LAS bf16x8*)(lds + PG8_SB(b, h) + boff + n * 2048 + k * 1024); } while (0)
#define PG8_MMA(ai, bj, At, Bt) do { __builtin_amdgcn_s_setprio(1); _Pragma("unroll") for (int m = 0; m < 4; ++m) _Pragma("unroll") for (int n = 0; n < 2; ++n) _Pragma("unroll") for (int k = 0; k < 2; ++k) \
        acc[ai][bj][m][n] = __builtin_amdgcn_mfma_f32_16x16x32_bf16(Bt[n][k], At[m][k], acc[ai][bj][m][n], 0, 0, 0); __builtin_amdgcn_s_setprio(0); } while (0)
#define PG8_WAIT_V(n) asm volatile("s_waitcnt vmcnt(" #n ")" ::: "memory")
#define PG8_WAIT_L(n) asm volatile("s_waitcnt lgkmcnt(" #n ")" ::: "memory")
#define PG8_BAR __builtin_amdgcn_s_barrier()
#define PG8_SCHED __builtin_amdgcn_sched_barrier(0)
    Unit cur, nxt; int ui = 0;
    if (!S.next(0, cur)) return;
    f32x4 acc[2][2][4][2];
#pragma unroll
    for (int a = 0; a < 2; ++a)
#pragma unroll
        for (int b = 0; b < 2; ++b)
#pragma unroll
            for (int m = 0; m < 4; ++m)
#pragma unroll
                for (int n = 0; n < 2; ++n) acc[a][b][m][n] = (f32x4){0.f, 0.f, 0.f, 0.f};
    bf16x8 At[4][2], B0[2][2], B1[2][2];
    const char* cA = (const char*)g.A + (size_t)cur.pm * tstepA; const char* cB = (const char*)g.Bt + (size_t)cur.pn * tstepB;
    S.a_ready(cur);
    if constexpr (SP2) {
        PG8_STAGE(PG8_SB(0, 0), cB, voffB); PG8_STAGE(PG8_SB(0, 1), cB + hstepB, voffB); PG8_STAGE(PG8_SA(0, 0), cA, voffA); PG8_STAGE(PG8_SA(0, 1), cA + hstepA, voffA);
        if (wr == 1) PG8_BAR;
        PG8_WAIT_V(2); PG8_BAR;
        PG8_STAGE(PG8_SB(1, 0), cB + kstep, voffB); PG8_STAGE(PG8_SA(1, 0), cA + kstep, voffA); PG8_STAGE(PG8_SB(1, 1), cB + hstepB + kstep, voffB);
        PG8_WAIT_V(6); PG8_BAR;
    } else {
        PG8_STAGE(PG8_SB(0, 0), cB, voffB); PG8_STAGE(PG8_SA(0, 0), cA, voffA); PG8_STAGE(PG8_SB(0, 1), cB + hstepB, voffB); PG8_STAGE(PG8_SA(0, 1), cA + hstepA, voffA);
        if (wr == 1) PG8_BAR;
        PG8_WAIT_V(4); PG8_BAR;
        PG8_STAGE(PG8_SB(1, 0), cB + kstep, voffB); PG8_STAGE(PG8_SA(1, 0), cA + kstep, voffA); PG8_STAGE(PG8_SB(1, 1), cB + hstepB + kstep, voffB);
        PG8_WAIT_V(6); PG8_BAR;
    }
    for (;;) {
        const bool has_next = S.next(ui + 1, nxt);
        const char* nA = has_next ? (const char*)g.A + (size_t)nxt.pm * tstepA : cA; const char* nB = has_next ? (const char*)g.Bt + (size_t)nxt.pn * tstepB : cB;
        for (int t = 0; t < nt; t += 2) {
            const bool last = (t == nt - 2);
            const char* a1 = cA + (size_t)(t + 1) * kstep;
            const char* a2 = last ? nA : cA + (size_t)(t + 2) * kstep; const char* b2 = last ? nB : cB + (size_t)(t + 2) * kstep;
            const char* a3 = a2 + kstep; const char* b3 = b2 + kstep;
            if (last && has_next) S.a_ready(nxt);
            if constexpr (SP2) {
            PG8_LDB(B0, 0, 0); PG8_LDB(B1, 0, 1); PG8_SCHED; PG8_LDA(At, 0, 0); PG8_STAGE(PG8_SA(1, 1), a1 + hstepA, voffA);
            PG8_WAIT_V(8); PG8_WAIT_L(0); PG8_BAR; PG8_MMA(0, 0, At, B0); PG8_MMA(0, 1, At, B1); PG8_BAR; PG8_SCHED;
            PG8_LDA(At, 0, 1); PG8_STAGE(PG8_SB(0, 0), b2, voffB); PG8_STAGE(PG8_SB(0, 1), b2 + hstepB, voffB); PG8_STAGE(PG8_SA(0, 0), a2, voffA);
            PG8_WAIT_V(8); PG8_WAIT_L(0); PG8_BAR; PG8_MMA(1, 0, At, B0); PG8_MMA(1, 1, At, B1); PG8_BAR; PG8_SCHED;
            PG8_LDB(B0, 1, 0); PG8_LDB(B1, 1, 1); PG8_SCHED; PG8_LDA(At, 1, 0); PG8_STAGE(PG8_SA(0, 1), a2 + hstepA, voffA);
            PG8_WAIT_V(8); PG8_WAIT_L(0); PG8_BAR; PG8_MMA(0, 0, At, B0); PG8_MMA(0, 1, At, B1); PG8_BAR; PG8_SCHED;
            PG8_LDA(At, 1, 1); PG8_STAGE(PG8_SB(1, 0), b3, voffB); PG8_STAGE(PG8_SB(1, 1), b3 + hstepB, voffB); PG8_STAGE(PG8_SA(1, 0), a3, voffA);
            PG8_WAIT_V(8); PG8_WAIT_L(0); PG8_BAR; PG8_MMA(1, 0, At, B0); PG8_MMA(1, 1, At, B1); PG8_BAR; PG8_SCHED;
            } else {
            PG8_LDB(B0, 0, 0); PG8_SCHED; PG8_LDA(At, 0, 0); PG8_STAGE(PG8_SA(1, 1), a1 + hstepA, voffA);
            PG8_WAIT_L(8); PG8_BAR; PG8_WAIT_L(0); PG8_MMA(0, 0, At, B0); PG8_BAR; PG8_SCHED;
            PG8_LDB(B1, 0, 1); PG8_STAGE(PG8_SB(0, 0), b2, voffB);
            PG8_BAR; PG8_WAIT_L(0); PG8_MMA(0, 1, At, B1); PG8_BAR;
            PG8_LDA(At, 0, 1); PG8_STAGE(PG8_SA(0, 0), a2, voffA);
            PG8_BAR; PG8_WAIT_L(0); PG8_MMA(1, 0, At, B0); PG8_BAR; PG8_SCHED;
            PG8_STAGE(PG8_SB(0, 1), b2 + hstepB, voffB);
            PG8_WAIT_V(6); PG8_BAR; PG8_MMA(1, 1, At, B1); PG8_BAR;
            PG8_LDB(B0, 1, 0); PG8_SCHED; PG8_LDA(At, 1, 0); PG8_STAGE(PG8_SA(0, 1), a2 + hstepA, voffA);
            PG8_WAIT_L(8); PG8_BAR; PG8_WAIT_L(0); PG8_MMA(0, 0, At, B0); PG8_BAR; PG8_SCHED;
            PG8_LDB(B1, 1, 1); PG8_STAGE(PG8_SB(1, 0), b3, voffB);
            PG8_BAR; PG8_WAIT_L(0); PG8_MMA(0, 1, At, B1); PG8_BAR;
            PG8_LDA(At, 1, 1); PG8_STAGE(PG8_SA(1, 0), a3, voffA);
            PG8_BAR; PG8_WAIT_L(0); PG8_MMA(1, 0, At, B0); PG8_BAR; PG8_SCHED;
            PG8_STAGE(PG8_SB(1, 1), b3 + hstepB, voffB);
            PG8_WAIT_V(6); PG8_BAR; PG8_MMA(1, 1, At, B1); PG8_BAR;
            }
        }
        if constexpr (ALIGN_EPI) { if (wr == 0) PG8_BAR; }
        if constexpr (!Epi::AFTER_DRAIN) { E(acc, cur, wr, wc, fr, fq); S.done(cur); }
        if (!has_next) break;
#pragma unroll
        for (int a = 0; a < 2; ++a)
#pragma unroll
            for (int b = 0; b < 2; ++b)
#pragma unroll
                for (int m = 0; m < 4; ++m)
#pragma unroll
                    for (int n = 0; n < 2; ++n) acc[a][b][m][n] = (f32x4){0.f, 0.f, 0.f, 0.f};
        cur = nxt; cA = nA; cB = nB; ++ui;
        if constexpr (ALIGN_EPI) { if (wr == 1) PG8_BAR; }
    }
    PG8_WAIT_V(0);
    if constexpr (!ALIGN_EPI) { if (wr == 0) PG8_BAR; }
    PG8_BAR;
    if constexpr (Epi::AFTER_DRAIN) { E.fused(acc, cur, wr, wc, fr, fq, lds, wid, lane); S.done(cur); }
#undef PG8_SA
#undef PG8_SB
#undef PG8_STAGE
#undef PG8_LDA
#undef PG8_LDB
#undef PG8_MMA
#undef PG8_WAIT_V
#undef PG8_WAIT_L
#undef PG8_BAR
#undef PG8_SCHED
}
}

namespace pg8 {
struct EpiZ {
    static constexpr bool PERM = true, AFTER_DRAIN = false;
    bf16_t* O; int ldc; float* fcbuf;
    __device__ __forceinline__ void operator()(const f32x4 (&acc)[2][2][4][2], const Unit& u, int wr, int wc, int fr, int fq) const {
        const int row0 = u.pm * BM + wr * 64 + fr, col0 = u.pn * BM + wc * 32 + 8 * fq;
        const bool fcl = (u.pn == 9) && (wc == 1) && (fq == 0);
#pragma unroll
        for (int ai = 0; ai < 2; ++ai)
#pragma unroll
            for (int m = 0; m < 4; ++m) {
                const int row = row0 + ai * HALF + m * 16;
                bf16_t* rowp = O + (size_t)row * ldc + col0;
#pragma unroll
                for (int bj = 0; bj < 2; ++bj) {
                    const f32x4 v0 = acc[ai][bj][m][0], v1 = acc[ai][bj][m][1];
                    u32x4 w; w.x = cvt_pk_bf16(v0[0], v0[1]); w.y = cvt_pk_bf16(v0[2], v0[3]); w.z = cvt_pk_bf16(v1[0], v1[1]); w.w = cvt_pk_bf16(v1[2], v1[3]);
                    *(u32x4*)(rowp + bj * HALF) = w;
                }
                if (fcl) *(f32x4*)(fcbuf + (size_t)row * 4) = acc[ai][0][m][0];
            }
    }
};
struct EpiRowScale {
    static constexpr bool PERM = true, AFTER_DRAIN = false;
    bf16_t* O; int ldc; const float* rs;
    __device__ __forceinline__ void operator()(const f32x4 (&acc)[2][2][4][2], const Unit& u, int wr, int wc, int fr, int fq) const {
        const int row0 = u.pm * BM + wr * 64 + fr, col0 = u.pn * BM + wc * 32 + 8 * fq;
#pragma unroll
        for (int ai = 0; ai < 2; ++ai)
#pragma unroll
            for (int m = 0; m < 4; ++m) {
                const int row = row0 + ai * HALF + m * 16;
                const float s = rs[row];
                bf16_t* rowp = O + (size_t)row * ldc + col0;
#pragma unroll
                for (int bj = 0; bj < 2; ++bj) {
                    const f32x4 v0 = acc[ai][bj][m][0] * s, v1 = acc[ai][bj][m][1] * s;
                    u32x4 w; w.x = cvt_pk_bf16(v0[0], v0[1]); w.y = cvt_pk_bf16(v0[2], v0[3]); w.z = cvt_pk_bf16(v1[0], v1[1]); w.w = cvt_pk_bf16(v1[2], v1[3]);
                    *(u32x4*)(rowp + bj * HALF) = w;
                }
            }
    }
};
struct EpiGU {
    static constexpr bool PERM = true, AFTER_DRAIN = false;
    bf16_t* O;
    __device__ __forceinline__ void operator()(const f32x4 (&acc)[2][2][4][2], const Unit& u, int wr, int wc, int fr, int fq) const {
        const int row0 = u.pm * BM + wr * 64 + fr, f0 = ((u.pn & 1) * BM + wc * 32 + 8 * fq) >> 1;
#pragma unroll
        for (int ai = 0; ai < 2; ++ai)
#pragma unroll
            for (int m = 0; m < 4; ++m) {
                bf16_t* rowp = O + (size_t)(row0 + ai * HALF + m * 16) * 256 + f0;
#pragma unroll
                for (int bj = 0; bj < 2; ++bj) {
                    const f32x4 v0 = acc[ai][bj][m][0], v1 = acc[ai][bj][m][1];
                    const float a0 = v0[0] / (1.f + __expf(-v0[0])) * v0[1], a1 = v0[2] / (1.f + __expf(-v0[2])) * v0[3];
                    const float a2 = v1[0] / (1.f + __expf(-v1[0])) * v1[1], a3 = v1[2] / (1.f + __expf(-v1[2])) * v1[3];
                    typedef unsigned u32x2 __attribute__((ext_vector_type(2)));
                    u32x2 w; w.x = cvt_pk_bf16(a0, a1); w.y = cvt_pk_bf16(a2, a3);
                    *(u32x2*)(rowp + bj * (HALF / 2)) = w;
                }
            }
    }
};
struct EpiPleGate {
    static constexpr bool PERM = true, AFTER_DRAIN = false;
    bf16_t* O; const bf16_t* PP;
    __device__ __forceinline__ void operator()(const f32x4 (&acc)[2][2][4][2], const Unit& u, int wr, int wc, int fr, int fq) const {
        const int row0 = u.pm * BM + wr * 64 + fr, col0 = u.pn * BM + wc * 32 + 8 * fq;
#pragma unroll
        for (int ai = 0; ai < 2; ++ai)
#pragma unroll
            for (int m = 0; m < 4; ++m) {
                const size_t off = (size_t)(row0 + ai * HALF + m * 16) * 1024 + col0;
#pragma unroll
                for (int bj = 0; bj < 2; ++bj) {
                    const f32x4 v0 = acc[ai][bj][m][0], v1 = acc[ai][bj][m][1];
                    const u32x4 pw = *(const u32x4*)(PP + off + bj * HALF);
                    float o[8];
                    o[0] = __uint_as_float(pw.x << 16) / (1.f + __expf(-v0[0])); o[1] = __uint_as_float(pw.x & 0xffff0000u) / (1.f + __expf(-v0[1]));
                    o[2] = __uint_as_float(pw.y << 16) / (1.f + __expf(-v0[2])); o[3] = __uint_as_float(pw.y & 0xffff0000u) / (1.f + __expf(-v0[3]));
                    o[4] = __uint_as_float(pw.z << 16) / (1.f + __expf(-v1[0])); o[5] = __uint_as_float(pw.z & 0xffff0000u) / (1.f + __expf(-v1[1]));
                    o[6] = __uint_as_float(pw.w << 16) / (1.f + __expf(-v1[2])); o[7] = __uint_as_float(pw.w & 0xffff0000u) / (1.f + __expf(-v1[3]));
                    u32x4 w; w.x = cvt_pk_bf16(o[0], o[1]); w.y = cvt_pk_bf16(o[2], o[3]); w.z = cvt_pk_bf16(o[4], o[5]); w.w = cvt_pk_bf16(o[6], o[7]);
                    *(u32x4*)(O + off + bj * HALF) = w;
                }
            }
    }
};
struct EpiDown {
    static constexpr bool PERM = true, AFTER_DRAIN = false;
    bf16_t* O;
    __device__ __forceinline__ void operator()(const f32x4 (&acc)[2][2][4][2], const Unit& u, int wr, int wc, int fr, int fq) const {
        const int row0 = u.pm * BM + wr * 64 + fr, col0 = (u.pn & 3) * BM + wc * 32 + 8 * fq;
#pragma unroll
        for (int ai = 0; ai < 2; ++ai)
#pragma unroll
            for (int m = 0; m < 4; ++m) {
                bf16_t* rowp = O + (size_t)(row0 + ai * HALF + m * 16) * 1024 + col0;
#pragma unroll
                for (int bj = 0; bj < 2; ++bj) {
                    const f32x4 v0 = acc[ai][bj][m][0], v1 = acc[ai][bj][m][1];
                    u32x4 w; w.x = cvt_pk_bf16(v0[0], v0[1]); w.y = cvt_pk_bf16(v0[2], v0[3]); w.z = cvt_pk_bf16(v1[0], v1[1]); w.w = cvt_pk_bf16(v1[2], v1[3]);
                    *(u32x4*)(rowp + bj * HALF) = w;
                }
            }
    }
};
struct GroupSched {
    const int* tile_e; int T, NJ, G, vc;
    __device__ __forceinline__ bool next(int i, Unit& u) const {
        const long L = (long)i * G + vc; if (L >= (long)T * NJ) return false;
        const int t = (int)(L / NJ), j = (int)(L % NJ);
        u.pm = t; u.pn = __builtin_amdgcn_readfirstlane(tile_e[t]) * NJ + j; return true;
    }
    __device__ __forceinline__ void a_ready(const Unit&) const {}
    __device__ __forceinline__ void done(const Unit&) const {}
};
}

template <class Map>
__device__ __forceinline__ void transpose_rows(const Map mp, const float* ks, int nrows_out, int K, bf16* WT, LAS float* scr, int gw, int NGW, int lane) {
    const int nblk = nrows_out / 32, nitems = (K / 64) * nblk;
    for (int it = gw; it < nitems; it += NGW) {
        const int kb = it / nblk, nb = it % nblk, k0 = 64 * kb, n0 = 32 * nb;
        const float* src; long pitch; float sc;
        mp.get(n0 + (lane & 31), src, pitch, sc);
#pragma unroll 8
        for (int i = 0; i < 32; ++i) {
            const int kk = 2 * i + (lane >> 5);
            float v = 0.f;
            if (src) { v = src[(size_t)(k0 + kk) * pitch] * sc; if (ks) v *= ks[k0 + kk]; }
            scr[kk * 33 + (lane & 31)] = v;
        }
        asm volatile("s_waitcnt lgkmcnt(0)" ::: "memory");
        const int c = lane & 7;
#pragma unroll
        for (int j = 0; j < 4; ++j) {
            const int n = (lane >> 3) + 8 * j; const LAS float* s = scr + (8 * c) * 33 + n;
            v4u o; o.x = pk2(s[0 * 33], s[1 * 33]); o.y = pk2(s[2 * 33], s[3 * 33]); o.z = pk2(s[4 * 33], s[5 * 33]); o.w = pk2(s[6 * 33], s[7 * 33]);
            *(v4u*)(WT + (size_t)(n0 + n) * K + k0 + 8 * c) = o;
        }
        asm volatile("s_waitcnt lgkmcnt(0)" ::: "memory");
    }
}
struct MapIn {
    const float* w;
    __device__ __forceinline__ void get(int n, const float*& src, long& pitch, float& sc) const {
        int c;
        if (n < 1152) c = n;
        else if (n < Z_CKV) c = OFF_QC + (n - Z_QC);
        else if (n < Z_CQ) c = OFF_CKV + (n - Z_CKV);
        else if (n < Z_KR) c = OFF_CQ + (n - Z_CQ);
        else if (n < Z_FC) c = OFF_KR + (n - Z_KR);
        else if (n < Z_FC + 4) c = OFF_FC + (n - Z_FC);
        else c = -1;
        src = c >= 0 ? w + c : nullptr; pitch = D_IN; sc = 1.f;
    }
};
struct MapPlain {
    const float* w; int N, nvalid;
    __device__ __forceinline__ void get(int n, const float*& src, long& pitch, float& sc) const { src = n < nvalid ? w + n : nullptr; pitch = N; sc = 1.f; }
};

struct MapGU {
    const float* wg; const float* wu;
    __device__ __forceinline__ void get(int n, const float*& src, long& pitch, float& sc) const {
        const int e = n >> 9, r = n & 511, f = r >> 1;
        const long dlt = (r & 1) ? (long)(wu - wg) : 0l;
        src = wg + dlt + (size_t)e * 1024 * 256 + f; pitch = 256; sc = 1.f;
    }
};
struct MapD {
    const float* wd;
    __device__ __forceinline__ void get(int n, const float*& src, long& pitch, float& sc) const {
        const int e = n >> 10, c = n & 1023;
        src = wd + (size_t)e * 256 * 1024 + c; pitch = 1024; sc = 1.f;
    }
};

struct AttnP {
    const bf16* z16; const bf16* qb16; const bf16* kvb16; const bf16* krr16; const float* cum; const float* cosT; const float* sinT;
    const int* pos; bf16* mixed16; const float* lq1; const float* lk1; const float* lq2; const float* lk2; const float* gdiff; int layer;
};
template <int MODE> __device__ __forceinline__ void attn_naive_unit(const AttnP& p, int b, int h, int qb, float* sm, const int tid) {
    constexpr int DK = MODE == 0 ? 32 : (MODE == 1 ? 96 : 64);
    constexpr int DK8 = DK / 8, DH = DK / 2, DH4 = DH / 4, DH8 = DH / 8;
    float* Ks = sm;
    float* Vs = Ks + 64 * DK;
    float* Bs = Vs + 64 * 64;
    const int lane = tid & 63, w = __builtin_amdgcn_readfirstlane(tid >> 6), part = lane & 1;
    const int c = qb * 4 + (w >> 1), t = c * 64 + (w & 1) * 32 + (lane >> 1);
    const long row = (long)b * SEQ + t;
    const float scale = MODE == 0 ? 0.17677669529663687f : (MODE == 1 ? 0.10206207261596575f : 0.125f);
    float qbias = 0.f, slope = 0.f;
    if (MODE == 0) { qbias = (float)p.pos[row]; slope = exp2f(-8.0f * (float)(h + 1) / 6.0f); }
    if (MODE == 2) qbias = p.cum[row * 4 + h];
    float o1[32];
    constexpr int NMAPS = MODE == 0 ? 2 : 1;
#pragma unroll 1
    for (int m = 0; m < NMAPS; ++m) {
        float q[DH];
        {
            const bf16* qsrc = MODE == 0 ? p.z16 + row * ZP + Z_QA + h * 64 + m * 32 : (MODE == 1 ? p.qb16 + row * NQBP + h * 96 : p.z16 + row * ZP + Z_QC + h * 64);
            const v4u* qp = (const v4u*)(qsrc + part * DH);
#pragma unroll
            for (int i = 0; i < DH8; ++i) unpack8(qp[i], q + 8 * i);
        }
        if (MODE == 1) {
#pragma unroll
            for (int j = 0; j < 16; ++j) {
                const float cs = p.cosT[row * 16 + j], sn = p.sinT[row * 16 + j];
                const float x1 = q[(16 + j) % DH], x2 = q[(32 + j) % DH];
                if (part == 1) { q[(16 + j) % DH] = x1 * cs - x2 * sn; q[(32 + j) % DH] = x2 * cs + x1 * sn; }
            }
        }
        float acc[32];
#pragma unroll
        for (int i = 0; i < 32; ++i) acc[i] = 0.f;
        float mx = -INFINITY, l = 0.f;
        const int ntiles = qb * 4 + 4;
#pragma unroll 1
        for (int kt = 0; kt < ntiles; ++kt) {
            const int k0 = kt * 64;
            __syncthreads();
#pragma unroll
            for (int i = 0; i < (64 * DK8 + NTHREADS - 1) / NTHREADS; ++i) {
                const int idx = tid + i * NTHREADS;
                if (idx < 64 * DK8) {
                    const int s = idx / DK8, c8 = idx % DK8; const long kr = (long)b * SEQ + k0 + s;
                    v4u v;
                    if (MODE == 0) v = *(const v4u*)(p.z16 + kr * ZP + Z_KA + h * 64 + m * 32 + c8 * 8);
                    else if (MODE == 1) v = (c8 < 8) ? *(const v4u*)(p.kvb16 + kr * NKVB + h * 128 + c8 * 8) : *(const v4u*)(p.krr16 + kr * 32 + (c8 - 8) * 8);
                    else v = *(const v4u*)(p.z16 + kr * ZP + Z_KC + h * 64 + c8 * 8);
                    float f[8]; unpack8(v, f);
                    *(float4*)(Ks + s * DK + c8 * 8) = make_float4(f[0], f[1], f[2], f[3]);
                    *(float4*)(Ks + s * DK + c8 * 8 + 4) = make_float4(f[4], f[5], f[6], f[7]);
                }
            }
            {
                const int s = tid >> 3, c8 = tid & 7; const long kr = (long)b * SEQ + k0 + s;
                v4u v;
                if (MODE == 0) v = *(const v4u*)(p.z16 + kr * ZP + Z_VA + h * 64 + c8 * 8);
                else if (MODE == 1) v = *(const v4u*)(p.kvb16 + kr * NKVB + h * 128 + 64 + c8 * 8);
                else v = *(const v4u*)(p.z16 + kr * ZP + Z_VC + h * 64 + c8 * 8);
                float f[8]; unpack8(v, f);
                *(float4*)(Vs + s * 64 + c8 * 8) = make_float4(f[0], f[1], f[2], f[3]);
                *(float4*)(Vs + s * 64 + c8 * 8 + 4) = make_float4(f[4], f[5], f[6], f[7]);
            }
            if (tid < 64) {
                const long kr = (long)b * SEQ + k0 + tid;
                Bs[tid] = MODE == 0 ? (float)p.pos[kr] : (MODE == 2 ? p.cum[kr * 4 + h] : 0.f);
            }
            __syncthreads();
            if (kt <= c) {
#pragma unroll 1
                for (int s = 0; s < 64; ++s) {
                    const float4* kp = (const float4*)(Ks + s * DK + part * DH);
                    float dot = 0.f;
#pragma unroll
                    for (int i = 0; i < DH4; ++i) { const float4 kv = kp[i]; dot = fmaf(q[4 * i], kv.x, dot); dot = fmaf(q[4 * i + 1], kv.y, dot); dot = fmaf(q[4 * i + 2], kv.z, dot); dot = fmaf(q[4 * i + 3], kv.w, dot); }
                    dot += __shfl_xor(dot, 1);
                    float lg = dot * scale;
                    if (MODE == 0) lg -= slope * fabsf(qbias - Bs[s]);
                    if (MODE == 2) lg += qbias - Bs[s];
                    const bool ok = (MODE != 2) || (k0 + s <= t);
                    if (ok) {
                        if (lg > mx) {
                            const float corr = expf(mx - lg); l *= corr;
#pragma unroll
                            for (int i = 0; i < 32; ++i) acc[i] *= corr;
                            mx = lg;
                        }
                        const float pe = expf(lg - mx); l += pe;
                        const float4* vp = (const float4*)(Vs + s * 64 + part * 32);
#pragma unroll
                        for (int i = 0; i < 8; ++i) { const float4 vv = vp[i]; acc[4 * i] = fmaf(pe, vv.x, acc[4 * i]); acc[4 * i + 1] = fmaf(pe, vv.y, acc[4 * i + 1]); acc[4 * i + 2] = fmaf(pe, vv.z, acc[4 * i + 2]); acc[4 * i + 3] = fmaf(pe, vv.w, acc[4 * i + 3]); }
                    }
                }
            }
        }
        const float inv = 1.f / l;
        if (MODE == 0 && m == 0) {
#pragma unroll
            for (int i = 0; i < 32; ++i) o1[i] = acc[i] * inv;
        } else {
            bf16* op = p.mixed16 + row * D_MODEL + (MODE == 0 ? 0 : (MODE == 1 ? 384 : 768)) + h * 64 + part * 32;
            if (MODE == 0) {
                const float lam_init = 0.8f - 0.6f * expf(-0.3f * (float)p.layer);
                float s1 = 0.f, s2 = 0.f;
                for (int i = 0; i < 32; ++i) { s1 += p.lq1[i] * p.lk1[i]; s2 += p.lq2[i] * p.lk2[i]; }
                const float lam = expf(s1) - expf(s2) + lam_init;
                float ss = 0.f;
#pragma unroll
                for (int i = 0; i < 32; ++i) { acc[i] = o1[i] - lam * (acc[i] * inv); ss = fmaf(acc[i], acc[i], ss); }
                ss += __shfl_xor(ss, 1);
                const float r = rsqrtf(ss * (1.f / 64.f) + RMS_EPS) * (1.f - lam_init);
#pragma unroll
                for (int i = 0; i < 32; ++i) acc[i] = acc[i] * r * p.gdiff[part * 32 + i];
            } else {
#pragma unroll
                for (int i = 0; i < 32; ++i) acc[i] *= inv;
            }
#pragma unroll
            for (int i = 0; i < 4; ++i) {
                v4u o; o.x = pk2(acc[8 * i], acc[8 * i + 1]); o.y = pk2(acc[8 * i + 2], acc[8 * i + 3]); o.z = pk2(acc[8 * i + 4], acc[8 * i + 5]); o.w = pk2(acc[8 * i + 6], acc[8 * i + 7]);
                *(v4u*)(op + 8 * i) = o;
            }
        }
    }
    __syncthreads();
}

__device__ __forceinline__ void convert_layer_weights(const Args& a, int l, unsigned char* ws, LAS float* scr, int gw, int NGW, int lane) {
    const float* w_in = (const float*)a.in[3] + (size_t)l * D_MODEL * D_IN;
    const float* w_uq = (const float*)a.in[4] + (size_t)l * 256 * NQB;
    const float* w_ukv = (const float*)a.in[5] + (size_t)l * 128 * NKVB;
    const float* g_cq = (const float*)a.in[6] + l * 256;
    const float* g_ckv = (const float*)a.in[7] + l * 128;
    const float* w_out = (const float*)a.in[14] + (size_t)l * 1024 * 1024;
    transpose_rows(MapIn{w_in}, nullptr, ZP, 1024, (bf16*)(ws + WS_WIN), scr, gw, NGW, lane);
    transpose_rows(MapPlain{w_uq, NQB, NQB}, g_cq, NQBP, 256, (bf16*)(ws + WS_WUQ), scr, gw, NGW, lane);
    transpose_rows(MapPlain{w_ukv, NKVB, NKVB}, g_ckv, NKVB, 128, (bf16*)(ws + WS_WUKV), scr, gw, NGW, lane);
    transpose_rows(MapPlain{w_out, 1024, 1024}, nullptr, 1024, 1024, (bf16*)(ws + WS_WOUT), scr, gw, NGW, lane);
    transpose_rows(MapPlain{(const float*)a.in[24] + (size_t)l * 1024 * 1024, 1024, 1024}, nullptr, 1024, 1024, (bf16*)(ws + WS_WPG), scr, gw, NGW, lane);
    transpose_rows(MapPlain{(const float*)a.in[25] + (size_t)l * 256 * 1024, 1024, 1024}, nullptr, 1024, 256, (bf16*)(ws + WS_WPP), scr, gw, NGW, lane);
    transpose_rows(MapGU{(const float*)a.in[21] + (size_t)l * 32 * 1024 * 256, (const float*)a.in[22] + (size_t)l * 32 * 1024 * 256}, nullptr, 32 * 512, 1024, (bf16*)(ws + WS_WGU), scr, gw, NGW, lane);
    transpose_rows(MapD{(const float*)a.in[23] + (size_t)l * 32 * 256 * 1024}, nullptr, 32 * 1024, 256, (bf16*)(ws + WS_WD), scr, gw, NGW, lane);
}

constexpr int PH_PER_LAYER = 10, NPH = 1 + DEPTH * PH_PER_LAYER;
template <int PH> __device__ __forceinline__ void run_phase(const Args& a, unsigned char* lds_raw) {
    float* sm = (float*)lds_raw;
    const int G = gridDim.x, NGW = G * 8, NGT = G * NTHREADS;
    unsigned char* ws = a.ws;
    const float* x0 = (const float*)a.in[0];
    const float* pin = (const float*)a.in[1];
    const int* pos = (const int*)a.in[2];
    float* cosT = (float*)(ws + WS_COS); float* sinT = (float*)(ws + WS_SIN);
    bf16* a16 = (bf16*)(ws + WS_A16); bf16* z16 = (bf16*)(ws + WS_Z16); bf16* qb16 = (bf16*)(ws + WS_QB16); bf16* kvb16 = (bf16*)(ws + WS_KVB16);
    bf16* krr16 = (bf16*)(ws + WS_KRR16); float* fcbuf = (float*)(ws + WS_FC); float* cum = (float*)(ws + WS_CUM);
    float* rq = (float*)(ws + WS_RQ); float* rkv = (float*)(ws + WS_RKV);
    bf16* mixed16 = (bf16*)(ws + WS_MIXED16); bf16* mix16 = (bf16*)(ws + WS_MIX16);
    float* hbuf = a.out; bf16* hs16 = (bf16*)(ws + WS_HS16); bf16* act16 = (bf16*)(ws + WS_ACT16); bf16* outs16 = (bf16*)(ws + WS_OUTS16); bf16* ple16 = (bf16*)(ws + WS_PLE16); bf16* pp16 = (bf16*)(ws + WS_PP16); bf16* p16 = (bf16*)(ws + WS_P16);
    int* ids = (int*)(ws + WS_RT + RT_IDS); float* wts = (float*)(ws + WS_RT + RT_WTS); int* rank = (int*)(ws + WS_RT + RT_RANK);
    int* slot_of = (int*)(ws + WS_RT + RT_SLOTOF); int* tile_e = (int*)(ws + WS_RT + RT_TILEE);
    unsigned* ctl = (unsigned*)(ws + WS_CTL);

        int tid = threadIdx.x; asm volatile("" : "+v"(tid));
        const int lane = tid & 63, wave = __builtin_amdgcn_readfirstlane(tid >> 6);
        const int gw = blockIdx.x * 8 + wave, gtid = blockIdx.x * NTHREADS + tid;
        LAS float* scr = (LAS float*)((LAS unsigned char*)lds_raw + wave * 16384);
        if constexpr (PH == 0) {
            for (int i = gtid; i < NTOK * 16; i += NGT) {
                const int tk = i >> 4, j = i & 15;
                const int j4 = j >> 2, jr = j & 3;
                const double inv = (j4 == 0 ? 1.0 : (j4 == 1 ? 0.1 : (j4 == 2 ? 0.01 : 0.001))) * (jr == 0 ? 1.0 : (jr == 1 ? 0.5623413251903491 : (jr == 2 ? 0.31622776601683794 : 0.1778279410038923)));
                const double ang = (double)pos[tk] * inv;
                const double k = rint(ang * 0.15915494309189535);
                const double r = fma(-k, 6.283185307179586, ang) - k * 2.4492935982947064e-16;
                cosT[i] = cosf((float)r); sinT[i] = sinf((float)r);
            }
            for (int i = gtid; i < NTOK * D_MODEL / 8; i += NGT) {
                const float4 v0 = *(const float4*)(x0 + (size_t)i * 8), v1 = *(const float4*)(x0 + (size_t)i * 8 + 4);
                v4u o; o.x = pk2(v0.x, v0.y); o.y = pk2(v0.z, v0.w); o.z = pk2(v1.x, v1.y); o.w = pk2(v1.z, v1.w);
                *(v4u*)(a16 + (size_t)i * 8) = o;
            }
            for (int i = gtid; i < DEPTH * NTOK * PLE_DIM / 8; i += NGT) {
                const float4 v0 = *(const float4*)(pin + (size_t)i * 8), v1 = *(const float4*)(pin + (size_t)i * 8 + 4);
                v4u o; o.x = pk2(v0.x, v0.y); o.y = pk2(v0.z, v0.w); o.z = pk2(v1.x, v1.y); o.w = pk2(v1.z, v1.w);
                *(v4u*)(p16 + (size_t)i * 8) = o;
            }
            convert_layer_weights(a, 0, ws, scr, gw, NGW, lane);
        } else {
            constexpr int l = (PH - 1) / PH_PER_LAYER, sp = (PH - 1) % PH_PER_LAYER;
            const float* xin = (l == 0) ? x0 : a.out;
            const float* b_forget = (const float*)a.in[13] + l * 4;
            const float* ln1_g = (const float*)a.in[15] + l * 1024; const float* ln1_b = (const float*)a.in[16] + l * 1024;
            const float* w_group = (const float*)a.in[17] + l * 1024 * 4; const float* b_group = (const float*)a.in[18] + l * 4;
            const float* w_er = (const float*)a.in[19] + (size_t)l * 4 * 1024 * 8; const float* b_er = (const float*)a.in[20] + l * 32;
            const float* ln2_g = (const float*)a.in[26] + l * 1024; const float* ln2_b = (const float*)a.in[27] + l * 1024;
            unsigned* cnt = ctl + CW_CNT + l * 32;
            if constexpr (sp == 0) {
                pg8::Gemm g{a16, (const bf16*)(ws + WS_WIN), NTOK, ZP, 1024, 1024, 1024};
                pg8::StaticOrder S; S.init(NTOK, ZP, G, (int)blockIdx.x);
                pg8::EpiZ E{z16, ZP, fcbuf};
                pg8::gemm_phase<pg8::EpiZ, pg8::StaticOrder, true, true>((LAS unsigned char*)lds_raw, g, S, E, tid);
            } else if constexpr (sp == 1) {
                for (int tk = gw; tk < NTOK; tk += NGW) {
                    const bf16* zr = z16 + (size_t)tk * ZP;
                    const v2u cv = *(const v2u*)(zr + Z_CQ + lane * 4);
                    const float c0 = bflo(cv.x), c1 = bfhi(cv.x), c2 = bflo(cv.y), c3 = bfhi(cv.y);
                    float ss = wave_sum(c0 * c0 + c1 * c1 + c2 * c2 + c3 * c3);
                    const float r1 = rsqrtf(ss * (1.f / 256.f) + RMS_EPS);
                    const unsigned kvw = *(const unsigned*)(zr + Z_CKV + lane * 2);
                    const float k0 = bflo(kvw), k1 = bfhi(kvw);
                    ss = wave_sum(k0 * k0 + k1 * k1);
                    const float r2 = rsqrtf(ss * (1.f / 128.f) + RMS_EPS);
                    if (lane == 0) { rq[tk] = r1; rkv[tk] = r2; }
                    if (lane < 16) {
                        const float x1 = __uint_as_float((unsigned)zr[Z_KR + lane] << 16), x2 = __uint_as_float((unsigned)zr[Z_KR + 16 + lane] << 16);
                        const float cs = cosT[tk * 16 + lane], sn = sinT[tk * 16 + lane];
                        krr16[tk * 32 + lane] = (bf16)f2bf(x1 * cs - x2 * sn); krr16[tk * 32 + 16 + lane] = (bf16)f2bf(x2 * cs + x1 * sn);
                    }
                    if (lane < 4) {
                        const float xf = fcbuf[tk * 4 + lane] + b_forget[lane];
                        cum[tk * 4 + lane] = fminf(xf, 0.f) - log1pf(expf(-fabsf(xf)));
                    }
                }
            } else if constexpr (sp == 2) {
                {
                    pg8::Gemm g{z16 + Z_CQ, (const bf16*)(ws + WS_WUQ), NTOK, NQBP, 256, ZP, 256};
                    pg8::StaticOrder S; S.init(NTOK, NQBP, G, (int)blockIdx.x);
                    pg8::EpiRowScale E{qb16, NQBP, rq};
                    pg8::gemm_phase<pg8::EpiRowScale, pg8::StaticOrder, true, true>((LAS unsigned char*)lds_raw, g, S, E, tid);
                }
                {
                    pg8::Gemm g{z16 + Z_CKV, (const bf16*)(ws + WS_WUKV), NTOK, NKVB, 128, ZP, 128};
                    pg8::StaticOrder S; S.init(NTOK, NKVB, G, (int)((blockIdx.x + 128) % G));
                    pg8::EpiRowScale E{kvb16, NKVB, rkv};
                    pg8::gemm_phase<pg8::EpiRowScale, pg8::StaticOrder, true, true>((LAS unsigned char*)lds_raw, g, S, E, tid);
                }
                const int cw = NGW - 1 - gw;
                if (cw < 32) {
                    const int b = cw >> 2, hh = cw & 3;
                    float* cp = cum + ((size_t)b * SEQ) * 4 + hh;
                    float loc[32]; float run = 0.f;
#pragma unroll
                    for (int i = 0; i < 32; ++i) { run += cp[(size_t)(lane * 32 + i) * 4]; loc[i] = run; }
                    float pre = run;
#pragma unroll
                    for (int o = 1; o < 64; o <<= 1) { const float n = __shfl_up(pre, o); if (lane >= o) pre += n; }
                    pre -= run;
#pragma unroll
                    for (int i = 0; i < 32; ++i) cp[(size_t)(lane * 32 + i) * 4] = loc[i] + pre;
                }
            } else if constexpr (sp == 3) {
                __syncthreads();
                AttnP p{z16, qb16, kvb16, krr16, cum, cosT, sinT, pos, mixed16,
                        (const float*)a.in[8] + l * 32, (const float*)a.in[9] + l * 32, (const float*)a.in[10] + l * 32, (const float*)a.in[11] + l * 32,
                        (const float*)a.in[12] + l * 64, l};
                for (int idx = blockIdx.x; idx < 1024; idx += G) {
                    const int qb = 7 - idx / 128, j = idx % 128;
                    if (j < 48) attn_naive_unit<0>(p, j / 6, j % 6, qb, sm, tid);
                    else if (j < 96) attn_naive_unit<1>(p, (j - 48) / 6, (j - 48) % 6, qb, sm, tid);
                    else attn_naive_unit<2>(p, (j - 96) / 4, (j - 96) % 4, qb, sm, tid);
                }
            } else if constexpr (sp == 4) {
                pg8::Gemm g{mixed16, (const bf16*)(ws + WS_WOUT), NTOK, 1024, 1024, 1024, 1024};
                pg8::StaticOrder S; S.init(NTOK, 1024, G, (int)blockIdx.x);
                pg8::EpiBf16<0> E{mix16, 1024, nullptr, 0, 0, 1.f};
                pg8::gemm_phase<pg8::EpiBf16<0>, pg8::StaticOrder, true, true>((LAS unsigned char*)lds_raw, g, S, E, tid);
            } else if constexpr (sp == 5) {
                for (int tk = gw; tk < NTOK; tk += NGW) {
                    float4 v[4]; float s = 0.f;
#pragma unroll
                    for (int j = 0; j < 4; ++j) {
                        const float4 xv = *(const float4*)(xin + (size_t)tk * D_MODEL + j * 256 + lane * 4);
                        const v2u mw = *(const v2u*)(mix16 + (size_t)tk * D_MODEL + j * 256 + lane * 4);
                        v[j] = make_float4(ALPHA * xv.x + bflo(mw.x), ALPHA * xv.y + bfhi(mw.x), ALPHA * xv.z + bflo(mw.y), ALPHA * xv.w + bfhi(mw.y));
                        s += (v[j].x + v[j].y) + (v[j].z + v[j].w);
                    }
                    const float mean = wave_sum(s) * (1.f / 1024.f); float s2 = 0.f;
#pragma unroll
                    for (int j = 0; j < 4; ++j) { v[j].x -= mean; v[j].y -= mean; v[j].z -= mean; v[j].w -= mean; s2 += (v[j].x * v[j].x + v[j].y * v[j].y) + (v[j].z * v[j].z + v[j].w * v[j].w); }
                    const float rstd = rsqrtf(wave_sum(s2) * (1.f / 1024.f) + LN_EPS);
                    float gl[4] = {0.f, 0.f, 0.f, 0.f};
#pragma unroll
                    for (int j = 0; j < 4; ++j) {
                        const int d0 = j * 256 + lane * 4;
                        const float4 gg = *(const float4*)(ln1_g + d0), bb = *(const float4*)(ln1_b + d0);
                        v[j] = make_float4(v[j].x * rstd * gg.x + bb.x, v[j].y * rstd * gg.y + bb.y, v[j].z * rstd * gg.z + bb.z, v[j].w * rstd * gg.w + bb.w);
                        *(float4*)(hbuf + (size_t)tk * D_MODEL + d0) = v[j];
                        { v2u hb; hb.x = pk2(v[j].x, v[j].y); hb.y = pk2(v[j].z, v[j].w); *(v2u*)(a16 + (size_t)tk * D_MODEL + d0) = hb; }
                        const float hv[4] = {v[j].x, v[j].y, v[j].z, v[j].w};
#pragma unroll
                        for (int i = 0; i < 4; ++i) {
                            const float4 wg = *(const float4*)(w_group + (size_t)(d0 + i) * 4);
                            gl[0] = fmaf(hv[i], wg.x, gl[0]); gl[1] = fmaf(hv[i], wg.y, gl[1]); gl[2] = fmaf(hv[i], wg.z, gl[2]); gl[3] = fmaf(hv[i], wg.w, gl[3]);
                        }
                    }
#pragma unroll
                    for (int i = 0; i < 4; ++i) gl[i] = wave_sum(gl[i]) + b_group[i];
                    int gi = 0; float gm = gl[0];
#pragma unroll
                    for (int i = 1; i < 4; ++i) if (gl[i] > gm) { gm = gl[i]; gi = i; }
                    float gden = 0.f;
#pragma unroll
                    for (int i = 0; i < 4; ++i) gden += expf(gl[i] - gm);
                    const float gwt = 1.f / gden;
                    float el[8] = {0.f, 0.f, 0.f, 0.f, 0.f, 0.f, 0.f, 0.f};
                    const float* we = w_er + (size_t)gi * 1024 * 8;
#pragma unroll
                    for (int j = 0; j < 4; ++j) {
                        const int d0 = j * 256 + lane * 4;
                        const float hv[4] = {v[j].x, v[j].y, v[j].z, v[j].w};
#pragma unroll
                        for (int i = 0; i < 4; ++i) {
                            const float4 w0 = *(const float4*)(we + (size_t)(d0 + i) * 8), w1 = *(const float4*)(we + (size_t)(d0 + i) * 8 + 4);
                            el[0] = fmaf(hv[i], w0.x, el[0]); el[1] = fmaf(hv[i], w0.y, el[1]); el[2] = fmaf(hv[i], w0.z, el[2]); el[3] = fmaf(hv[i], w0.w, el[3]);
                            el[4] = fmaf(hv[i], w1.x, el[4]); el[5] = fmaf(hv[i], w1.y, el[5]); el[6] = fmaf(hv[i], w1.z, el[6]); el[7] = fmaf(hv[i], w1.w, el[7]);
                        }
                    }
#pragma unroll
                    for (int i = 0; i < 8; ++i) el[i] = wave_sum(el[i]) + b_er[gi * 8 + i];
                    int i0 = 0; float v0 = el[0];
#pragma unroll
                    for (int i = 1; i < 8; ++i) if (el[i] > v0) { v0 = el[i]; i0 = i; }
                    int i1 = -1; float v1 = -INFINITY;
#pragma unroll
                    for (int i = 0; i < 8; ++i) if (i != i0 && el[i] > v1) { v1 = el[i]; i1 = i; }
                    const float e1 = expf(v1 - v0);
                    const float w0 = gwt / (1.f + e1), w1 = gwt * e1 / (1.f + e1);
                    if (lane == 0) {
                        const int ea = gi * 8 + i0, eb = gi * 8 + i1;
                        ids[tk * 2] = ea; ids[tk * 2 + 1] = eb; wts[tk * 2] = w0; wts[tk * 2 + 1] = w1;
                        rank[tk * 2] = (int)atomicAdd(cnt + ea, 1u); rank[tk * 2 + 1] = (int)atomicAdd(cnt + eb, 1u);
                    }
                }
            } else if constexpr (sp == 6) {
                int* offs = (int*)sm;
                __syncthreads();
                if (tid == 0) { int o = 0; for (int e = 0; e < 32; ++e) { offs[e] = o; o += ((int)cnt[e] + 255) & ~255; } offs[32] = o; }
                __syncthreads();
                for (int i = gtid; i < NSLOT_TILES; i += NGT) { int e = -1; for (int k = 0; k < 32; ++k) if (i * 256 >= offs[k] && i * 256 < offs[k + 1]) e = k; tile_e[i] = e; }
                for (int i = gw; i < NTOK * 2; i += NGW) {
                    const int e = ids[i]; const int s = offs[e] + rank[i];
                    if (lane == 0) slot_of[i] = s;
                    const v4u* srow = (const v4u*)(a16 + (size_t)(i >> 1) * D_MODEL); v4u* drow = (v4u*)(hs16 + (size_t)s * D_MODEL);
                    const v4u r0 = srow[lane], r1 = srow[64 + lane];
                    drow[lane] = r0; drow[64 + lane] = r1;
                }
                __syncthreads();
                {
                    pg8::Gemm g{p16 + (size_t)l * NTOK * PLE_DIM, (const bf16*)(ws + WS_WPP), NTOK, 1024, 256, 256, 256};
                    pg8::StaticOrder S; S.init(NTOK, 1024, G, (int)blockIdx.x);
                    pg8::EpiBf16<0> E{pp16, 1024, nullptr, 0, 0, 1.f};
                    pg8::gemm_phase<pg8::EpiBf16<0>, pg8::StaticOrder, true, true>((LAS unsigned char*)lds_raw, g, S, E, tid);
                }
                {
                    pg8::Gemm g{a16, (const bf16*)(ws + WS_WPG), NTOK, 1024, 1024, 1024, 1024};
                    pg8::StaticOrder S; S.init(NTOK, 1024, G, (int)blockIdx.x);
                    pg8::EpiPleGate E{ple16, pp16};
                    pg8::gemm_phase<pg8::EpiPleGate, pg8::StaticOrder, true, true>((LAS unsigned char*)lds_raw, g, S, E, tid);
                }
            } else if constexpr (sp == 7) {
                int T = 0; for (int e = 0; e < 32; ++e) T += ((int)cnt[e] + 255) >> 8;
                T = __builtin_amdgcn_readfirstlane(T);
                pg8::Gemm g{hs16, (const bf16*)(ws + WS_WGU), MAX_SLOTS, 32 * 512, 1024, 1024, 1024};
                pg8::GroupSched S{tile_e, T, 2, G, (int)((blockIdx.x % 8) * (G / 8) + blockIdx.x / 8)};
                pg8::EpiGU E{act16};
                pg8::gemm_phase<pg8::EpiGU, pg8::GroupSched, true, true>((LAS unsigned char*)lds_raw, g, S, E, tid);
            } else if constexpr (sp == 8) {
                int T = 0; for (int e = 0; e < 32; ++e) T += ((int)cnt[e] + 255) >> 8;
                T = __builtin_amdgcn_readfirstlane(T);
                pg8::Gemm g{act16, (const bf16*)(ws + WS_WD), MAX_SLOTS, 32 * 1024, 256, 256, 256};
                pg8::GroupSched S{tile_e, T, 4, G, (int)((blockIdx.x % 8) * (G / 8) + blockIdx.x / 8)};
                pg8::EpiDown E{outs16};
                pg8::gemm_phase<pg8::EpiDown, pg8::GroupSched, true, true>((LAS unsigned char*)lds_raw, g, S, E, tid);
            } else if constexpr (sp == 9) {
                for (int tk = gw; tk < NTOK; tk += NGW) {
                    const int s0 = slot_of[tk * 2], s1 = slot_of[tk * 2 + 1]; const float w0 = wts[tk * 2], w1 = wts[tk * 2 + 1];
                    float4 v[4]; float s = 0.f;
#pragma unroll
                    for (int j = 0; j < 4; ++j) {
                        const int d0 = j * 256 + lane * 4;
                        const float4 hv = *(const float4*)(hbuf + (size_t)tk * D_MODEL + d0);
                        const v2u oa = *(const v2u*)(outs16 + (size_t)s0 * D_MODEL + d0), ob = *(const v2u*)(outs16 + (size_t)s1 * D_MODEL + d0);
                        const v2u pv = *(const v2u*)(ple16 + (size_t)tk * D_MODEL + d0);
                        v[j] = make_float4(ALPHA * hv.x + w0 * bflo(oa.x) + w1 * bflo(ob.x) + bflo(pv.x), ALPHA * hv.y + w0 * bfhi(oa.x) + w1 * bfhi(ob.x) + bfhi(pv.x),
                                           ALPHA * hv.z + w0 * bflo(oa.y) + w1 * bflo(ob.y) + bflo(pv.y), ALPHA * hv.w + w0 * bfhi(oa.y) + w1 * bfhi(ob.y) + bfhi(pv.y));
                        s += (v[j].x + v[j].y) + (v[j].z + v[j].w);
                    }
                    const float mean = wave_sum(s) * (1.f / 1024.f); float s2 = 0.f;
#pragma unroll
                    for (int j = 0; j < 4; ++j) { v[j].x -= mean; v[j].y -= mean; v[j].z -= mean; v[j].w -= mean; s2 += (v[j].x * v[j].x + v[j].y * v[j].y) + (v[j].z * v[j].z + v[j].w * v[j].w); }
                    const float rstd = rsqrtf(wave_sum(s2) * (1.f / 1024.f) + LN_EPS);
#pragma unroll
                    for (int j = 0; j < 4; ++j) {
                        const int d0 = j * 256 + lane * 4;
                        const float4 gg = *(const float4*)(ln2_g + d0), bb = *(const float4*)(ln2_b + d0);
                        const float4 o = make_float4(v[j].x * rstd * gg.x + bb.x, v[j].y * rstd * gg.y + bb.y, v[j].z * rstd * gg.z + bb.z, v[j].w * rstd * gg.w + bb.w);
                        *(float4*)(a.out + (size_t)tk * D_MODEL + d0) = o;
                        v2u ob16; ob16.x = pk2(o.x, o.y); ob16.y = pk2(o.z, o.w);
                        *(v2u*)(a16 + (size_t)tk * D_MODEL + d0) = ob16;
                    }
                }
                if (l + 1 < DEPTH) convert_layer_weights(a, l + 1, ws, scr, gw, NGW, lane);
            }
        }
}

__global__ void __launch_bounds__(NTHREADS, 2) mega(Args a) {
    extern __shared__ __attribute__((aligned(16))) unsigned char lds_raw[];
    cg::grid_group grid = cg::this_grid();
#define RUN(ph) if (a.ph_lo <= (ph) && (ph) < a.ph_hi) { run_phase<ph>(a, lds_raw); if ((ph) + 1 < a.ph_hi && (ph) + 1 < NPH) grid.sync(); }
    RUN(0) RUN(1) RUN(2) RUN(3) RUN(4) RUN(5) RUN(6) RUN(7) RUN(8) RUN(9) RUN(10)
    RUN(11) RUN(12) RUN(13) RUN(14) RUN(15) RUN(16) RUN(17) RUN(18) RUN(19) RUN(20)
#undef RUN
}

extern "C" void kernel_launch(void* const* d_in, const int* in_sizes, int n_in, void* d_out, int out_size, void* d_ws, size_t ws_size, hipStream_t stream) {
    static int grid = 0;
    if (grid == 0) {
        if (n_in != 28 || ws_size < WS_END) { fprintf(stderr, "kernel_launch: unexpected n_in %d or ws_size %zu (< %zu)\n", n_in, ws_size, (size_t)WS_END); grid = -1; return; }
        int dev = 0, cus = 0, per_cu = 0;
        (void)hipGetDevice(&dev);
        (void)hipDeviceGetAttribute(&cus, hipDeviceAttributeMultiprocessorCount, dev);
        (void)hipFuncSetAttribute((const void*)mega, hipFuncAttributeMaxDynamicSharedMemorySize, LDS_BYTES);
        (void)hipOccupancyMaxActiveBlocksPerMultiprocessor(&per_cu, (const void*)mega, NTHREADS, LDS_BYTES);
        if (per_cu < 1) { fprintf(stderr, "kernel_launch: occupancy query says %d blocks/CU\n", per_cu); }
        (void)hipGetLastError();
        grid = cus;
    }
    if (grid < 0) return;
    (void)hipMemsetAsync((char*)d_ws + WS_CTL, 0, 64 * 1024, stream);
    Args a{};
    for (int i = 0; i < 28; ++i) a.in[i] = d_in[i];
    a.out = (float*)d_out; a.ws = (unsigned char*)d_ws; a.ph_lo = 0; a.ph_hi = NPH;
    void* params[] = {&a};
    hipError_t e = hipLaunchCooperativeKernel((const void*)mega, dim3(grid), dim3(NTHREADS), params, LDS_BYTES, stream);
    if (e != hipSuccess) fprintf(stderr, "cooperative launch failed: %s (grid %d)\n", hipGetErrorString(e), grid);
}
```

```cpp
#include <hip/hip_runtime.h>
#include <hip/hip_cooperative_groups.h>
#include <cstdio>
#include <cstdint>
namespace cg = cooperative_groups;

constexpr int D_MODEL = 1024, BATCH = 8, SEQ = 2048, NTOK = BATCH * SEQ, DEPTH = 2;
constexpr int D_IN = 2340;
constexpr int OFF_QA = 0, OFF_KA = 384, OFF_VA = 768, OFF_CQ = 1152, OFF_CKV = 1408, OFF_KR = 1536,
              OFF_QC = 1568, OFF_KC = 1824, OFF_VC = 2080, OFF_FC = 2336;
constexpr int ZP = 2560;
constexpr int Z_QA = 0, Z_KA = 384, Z_VA = 768, Z_QC = 1152, Z_KC = 1408, Z_VC = 1664, Z_CKV = 1920, Z_CQ = 2048, Z_KR = 2304, Z_FC = 2336;
constexpr int NQB = 576, NKVB = 768, NQBP = 768;
constexpr int N_EXPERTS = 32, D_EXPERT = 256, PLE_DIM = 256;
constexpr int MAX_SLOTS = 32768 + 32 * 256;
constexpr int NSLOT_TILES = MAX_SLOTS / 256;
constexpr float ALPHA = 1.4142135623730951f;
constexpr float LN_EPS = 1e-5f, RMS_EPS = 1e-6f;
constexpr int NTHREADS = 512;
constexpr int LDS_BYTES = 147456;

constexpr size_t MiB = 1u << 20;
constexpr size_t WS_CTL = 0;
constexpr size_t WS_COS = 1 * MiB, WS_SIN = 2 * MiB;
constexpr size_t WS_WIN = 3 * MiB;
constexpr size_t WS_WUQ = 8 * MiB;
constexpr size_t WS_WUKV = WS_WUQ + 393216;
constexpr size_t WS_WOUT = 9 * MiB;
constexpr size_t WS_WPG = 11 * MiB;
constexpr size_t WS_WPP = 13 * MiB;
constexpr size_t WS_WGU = 14 * MiB;
constexpr size_t WS_WD = 46 * MiB;
constexpr size_t WS_A16 = 62 * MiB;
constexpr size_t WS_P16 = 94 * MiB;
constexpr size_t WS_Z16 = 110 * MiB;
constexpr size_t WS_HS16 = WS_Z16;
constexpr size_t WS_OUTS16 = WS_Z16;
constexpr size_t WS_QB16 = 190 * MiB;
constexpr size_t WS_KVB16 = 214 * MiB;
constexpr size_t WS_KRR16 = 238 * MiB;
constexpr size_t WS_FC = 239 * MiB;
constexpr size_t WS_CUM = WS_FC + 256 * 1024;
constexpr size_t WS_RQ = WS_CUM + 256 * 1024;
constexpr size_t WS_RKV = WS_RQ + 64 * 1024;
constexpr size_t WS_MIX16 = 190 * MiB;
constexpr size_t WS_PP16 = 190 * MiB;
constexpr size_t WS_ACT16 = 222 * MiB;
constexpr size_t WS_MIXED16 = 242 * MiB;
constexpr size_t WS_PLE16 = 242 * MiB;
constexpr size_t WS_RT = 274 * MiB;
constexpr size_t WS_END = 276 * MiB;
constexpr size_t RT_IDS = 0, RT_WTS = 128 * 1024, RT_RANK = 256 * 1024, RT_SLOTOF = 384 * 1024, RT_TILEE = 768 * 1024;
constexpr int CW_CNT = 0;
static_assert((WS_A16 - WS_HS16) % (256 * 1024 * 2) == 0 || true, "");

struct Args { const void* in[28]; float* out; unsigned char* ws; int ph_lo, ph_hi; };

#define LAS __attribute__((address_space(3)))
typedef unsigned short bf16;
typedef unsigned v4u __attribute__((ext_vector_type(4)));
typedef unsigned v2u __attribute__((ext_vector_type(2)));

__device__ __forceinline__ float wave_sum(float v) {
#pragma unroll
    for (int o = 1; o < 64; o <<= 1) v += __shfl_xor(v, o);
    return v;
}
__device__ __forceinline__ unsigned f2bf(float f) { unsigned u = __builtin_bit_cast(unsigned, f); return (u + 0x7fffu + ((u >> 16) & 1u)) >> 16; }
__device__ __forceinline__ unsigned pk2(float lo, float hi) { return f2bf(lo) | (f2bf(hi) << 16); }
__device__ __forceinline__ float bflo(unsigned w) { return __uint_as_float(w << 16); }
__device__ __forceinline__ float bfhi(unsigned w) { return __uint_as_float(w & 0xffff0000u); }
__device__ __forceinline__ void unpack8(const v4u w, float* f) { f[0] = bflo(w.x); f[1] = bfhi(w.x); f[2] = bflo(w.y); f[3] = bfhi(w.y); f[4] = bflo(w.z); f[5] = bfhi(w.z); f[6] = bflo(w.w); f[7] = bfhi(w.w); }
namespace pg8 {
#define PG8_LAS __attribute__((address_space(3)))
typedef unsigned short bf16_t;
typedef short bf16x8 __attribute__((ext_vector_type(8)));
typedef float f32x4 __attribute__((ext_vector_type(4)));
typedef unsigned u32x4 __attribute__((ext_vector_type(4)));
constexpr int BM = 256, BK = 64, HALF = 128, HTB = HALF * BK * 2  , STAGE_BYTES = 8 * HTB, NXCD = 8, WGM = 8;

__host__ __device__ __forceinline__ int lds_byte(int r, int c) { const int st = (r >> 4) * 2 + (c >> 5), rr = r & 15, cc = c & 31, ob = rr * 64 + cc * 2; return st * 1024 + (ob ^ (((ob >> 9) & 1) << 5)); }
__host__ __device__ __forceinline__ void stage_rc(int b, int& R, int& C) { const int st = b / 1024, sb = b % 1024, swz = sb ^ (((sb >> 9) & 1) << 5); R = (st >> 1) * 16 + swz / 64; C = (st & 1) * 32 + (swz % 64) / 2; }
__host__ __device__ __forceinline__ int perm32(int rho) { const int n = rho >> 4, i = rho & 15; return 8 * (i >> 2) + 4 * n + (i & 3); }

struct Unit { int pm, pn; };
struct Gemm { const bf16_t* A; const bf16_t* Bt; int M, N, K, lda, ldb; };

struct StaticOrder {
    int nM, nN, nwg, G, c;
    __host__ __device__ void init(int M, int N, int G_, int c_) { nM = M / BM; nN = N / BM; nwg = nM * nN; G = G_; c = c_; }
    __host__ __device__ bool next(int i, Unit& u) const {
        const long L = (long)i * G + c; if (L >= nwg) return false;
        int wgid = (int)L; { const int q = nwg / NXCD, r = nwg % NXCD, xcd = wgid % NXCD, off = wgid / NXCD; wgid = (xcd < r ? xcd * (q + 1) : r * (q + 1) + (xcd - r) * q) + off; }
        const int nig = WGM * nN, gid = wgid / nig, fm = gid * WGM, gsz = (nM - fm) < WGM ? (nM - fm) : WGM;
        u.pm = fm + ((wgid % nig) % gsz); u.pn = (wgid % nig) / gsz; return true;
    }
    __device__ __forceinline__ void a_ready(const Unit&) const {}
    __device__ __forceinline__ void done(const Unit&) const {}
};

__device__ __forceinline__ unsigned cvt_pk_bf16(float lo, float hi) { unsigned r; asm volatile("v_cvt_pk_bf16_f32 %0, %1, %2" : "=v"(r) : "v"(lo), "v"(hi)); return r; }
typedef float f32x2 __attribute__((ext_vector_type(2)));
__device__ __forceinline__ f32x2 gelu_pk(f32x2 v) {
    const f32x2 av = __builtin_elementwise_abs(v), d = av * 0.2316418882f + 1.0f;
    f32x2 t; t.x = __builtin_amdgcn_rcpf(d.x); t.y = __builtin_amdgcn_rcpf(d.y);
    f32x2 q = t * 0.5307027145f + (-0.7265760135f); q = q * t + 0.7107068705f; q = q * t + (-0.142248368f); q = q * t + 0.127414796f; q = q * t;
    const f32x2 s = (v * v) * (-0.72134752044f);
    f32x2 e; e.x = __builtin_amdgcn_exp2f(s.x); e.y = __builtin_amdgcn_exp2f(s.y);
    const f32x2 m = v * (q * e), r = v - m;
    f32x2 o; o.x = v.x < 0.f ? m.x : r.x; o.y = v.y < 0.f ? m.y : r.y; return o;
}

template <int ACT  > struct EpiBf16 {
    static constexpr bool PERM = true, AFTER_DRAIN = false; static_assert(ACT == 0 || ACT == 1, "EpiBf16: ACT is 0 (none) or 1 (gelu_pk)");
    bf16_t* O; int ldc; const float* bias; int split_cols; size_t split_stride; float scale0;
    __device__ __forceinline__ void operator()(const f32x4 (&acc)[2][2][4][2], const Unit& u, int wr, int wc, int fr, int fq) const {
        const int row0 = u.pm * BM + wr * 64 + fr; int colt = u.pn * BM; bf16_t* base = O;
        float sc = 1.f; if (split_cols) { const int t = colt / split_cols; base += (size_t)t * split_stride; colt -= t * split_cols; if (t == 0) sc = scale0; }
        const int col0 = colt + wc * 32 + 8 * fq, bcol0 = u.pn * BM + wc * 32 + 8 * fq;
        f32x4 bv[2][2];
#pragma unroll
        for (int bj = 0; bj < 2; ++bj)
#pragma unroll
            for (int n = 0; n < 2; ++n) bv[bj][n] = bias ? *(const f32x4*)(bias + bcol0 + bj * HALF + 4 * n) : (f32x4){0.f, 0.f, 0.f, 0.f};
#pragma unroll
        for (int ai = 0; ai < 2; ++ai)
#pragma unroll
            for (int m = 0; m < 4; ++m) { bf16_t* rowp = base + (size_t)(row0 + ai * HALF + m * 16) * ldc + col0;
#pragma unroll
                for (int bj = 0; bj < 2; ++bj) { f32x4 v0 = acc[ai][bj][m][0] + bv[bj][0], v1 = acc[ai][bj][m][1] + bv[bj][1];
                    if (ACT == 1) { f32x2 a = gelu_pk((f32x2){v0[0], v0[1]}), b = gelu_pk((f32x2){v0[2], v0[3]}), c = gelu_pk((f32x2){v1[0], v1[1]}), d = gelu_pk((f32x2){v1[2], v1[3]});
                        v0 = (f32x4){a.x, a.y, b.x, b.y}; v1 = (f32x4){c.x, c.y, d.x, d.y}; }
                    v0 = v0 * sc; v1 = v1 * sc; u32x4 w; w.x = cvt_pk_bf16(v0[0], v0[1]); w.y = cvt_pk_bf16(v0[2], v0[3]); w.z = cvt_pk_bf16(v1[0], v1[1]); w.w = cvt_pk_bf16(v1[2], v1[3]);
                    *(u32x4*)(rowp + bj * HALF) = w; } }
    }
};
template <class Epi, class Sched, bool ALIGN_EPI = false, bool SP2 = false>
__device__ __forceinline__ void gemm_phase(PG8_LAS unsigned char* lds, const Gemm g, const Sched& S, const Epi& E, const int tid) {
    const int wid = __builtin_amdgcn_readfirstlane(tid >> 6), lane = tid & 63, wr = wid >> 2, wc = wid & 3, fr = lane & 15, fq = lane >> 4;
    int K = g.K; asm volatile("" : "+s"(K));
    const int nt = K / BK;
    unsigned voffA[2], voffB[2];
#pragma unroll
    for (int i = 0; i < 2; ++i) { int R, C; stage_rc(tid * 16 + i * 8192, R, C); const int Rb = Epi::PERM ? ((R & ~31) + perm32(R & 31)) : R;
        voffA[i] = (unsigned)(R * g.lda + C) * 2u; voffB[i] = (unsigned)(Rb * g.ldb + C) * 2u; }
    const size_t kstep = (size_t)(BK * 2);
    const size_t hstepA = (size_t)HALF * g.lda * 2, hstepB = (size_t)HALF * g.ldb * 2;
    const size_t tstepA = 2 * hstepA, tstepB = 2 * hstepB;
    const unsigned ldsw = (unsigned)wid * 1024u;
    const int aoff = lds_byte(wr * 64 + fr, fq * 8), boff = lds_byte(wc * 32 + fr, fq * 8);
#define PG8_SA(b, h) (((b) * 2 + (h)) * HTB)
#define PG8_SB(b, h) ((4 + (b) * 2 + (h)) * HTB)
#define PG8_STAGE(bufoff, gbase, voff) do { _Pragma("unroll") for (int _i = 0; _i < 2; ++_i) \
        __builtin_amdgcn_global_load_lds((const unsigned*)((const char*)(gbase) + (voff)[_i]), (PG8_LAS unsigned*)(lds + (bufoff) + ldsw + _i * 8192), 16, 0, 0); } while (0)
#define PG8_LDA(dst, b, h) do { _Pragma("unroll") for (int m = 0; m < 4; ++m) _Pragma("unroll") for (int k = 0; k < 2; ++k) dst[m][k] = *(const PG8_LAS bf16x8*)(lds + PG8_SA(b, h) + aoff + m * 2048 + k * 1024); } while (0)
#define PG8_LDB(dst, b, h) do { _Pragma("unroll") for (int n = 0; n < 2; ++n) _Pragma("unroll") for (int k = 0; k < 2; ++k) dst[n][k] = *(const PG8_LAS bf16x8*)(lds + PG8_SB(b, h) + boff + n * 2048 + k * 1024); } while (0)
#define PG8_MMA(ai, bj, At, Bt) do { __builtin_amdgcn_s_setprio(1); _Pragma("unroll") for (int m = 0; m < 4; ++m) _Pragma("unroll") for (int n = 0; n < 2; ++n) _Pragma("unroll") for (int k = 0; k < 2; ++k) \
        acc[ai][bj][m][n] = __builtin_amdgcn_mfma_f32_16x16x32_bf16(Bt[n][k], At[m][k], acc[ai][bj][m][n], 0, 0, 0); __builtin_amdgcn_s_setprio(0); } while (0)
#define PG8_WAIT_V(n) asm volatile("s_waitcnt vmcnt(" #n ")" ::: "memory")
#define PG8_WAIT_L(n) asm volatile("s_waitcnt lgkmcnt(" #n ")" ::: "memory")
#define PG8_BAR __builtin_amdgcn_s_barrier()
#define PG8_SCHED __builtin_amdgcn_sched_barrier(0)
    Unit cur, nxt; int ui = 0;
    if (!S.next(0, cur)) return;
    f32x4 acc[2][2][4][2];
#pragma unroll
    for (int a = 0; a < 2; ++a)
#pragma unroll
        for (int b = 0; b < 2; ++b)
#pragma unroll
            for (int m = 0; m < 4; ++m)
#pragma unroll
                for (int n = 0; n < 2; ++n) acc[a][b][m][n] = (f32x4){0.f, 0.f, 0.f, 0.f};
    bf16x8 At[4][2], B0[2][2], B1[2][2];
    const char* cA = (const char*)g.A + (size_t)cur.pm * tstepA; const char* cB = (const char*)g.Bt + (size_t)cur.pn * tstepB;
    S.a_ready(cur);
    if constexpr (SP2) {
        PG8_STAGE(PG8_SB(0, 0), cB, voffB); PG8_STAGE(PG8_SB(0, 1), cB + hstepB, voffB); PG8_STAGE(PG8_SA(0, 0), cA, voffA); PG8_STAGE(PG8_SA(0, 1), cA + hstepA, voffA);
        if (wr == 1) PG8_BAR;
        PG8_WAIT_V(2); PG8_BAR;
        PG8_STAGE(PG8_SB(1, 0), cB + kstep, voffB); PG8_STAGE(PG8_SA(1, 0), cA + kstep, voffA); PG8_STAGE(PG8_SB(1, 1), cB + hstepB + kstep, voffB);
        PG8_WAIT_V(6); PG8_BAR;
    } else {
        PG8_STAGE(PG8_SB(0, 0), cB, voffB); PG8_STAGE(PG8_SA(0, 0), cA, voffA); PG8_STAGE(PG8_SB(0, 1), cB + hstepB, voffB); PG8_STAGE(PG8_SA(0, 1), cA + hstepA, voffA);
        if (wr == 1) PG8_BAR;
        PG8_WAIT_V(4); PG8_BAR;
        PG8_STAGE(PG8_SB(1, 0), cB + kstep, voffB); PG8_STAGE(PG8_SA(1, 0), cA + kstep, voffA); PG8_STAGE(PG8_SB(1, 1), cB + hstepB + kstep, voffB);
        PG8_WAIT_V(6); PG8_BAR;
    }
    for (;;) {
        const bool has_next = S.next(ui + 1, nxt);
        const char* nA = has_next ? (const char*)g.A + (size_t)nxt.pm * tstepA : cA; const char* nB = has_next ? (const char*)g.Bt + (size_t)nxt.pn * tstepB : cB;
        for (int t = 0; t < nt; t += 2) {
            const bool last = (t == nt - 2);
            const char* a1 = cA + (size_t)(t + 1) * kstep;
            const char* a2 = last ? nA : cA + (size_t)(t + 2) * kstep; const char* b2 = last ? nB : cB + (size_t)(t + 2) * kstep;
            const char* a3 = a2 + kstep; const char* b3 = b2 + kstep;
            if (last && has_next) S.a_ready(nxt);
            if constexpr (SP2) {
            PG8_LDB(B0, 0, 0); PG8_LDB(B1, 0, 1); PG8_SCHED; PG8_LDA(At, 0, 0); PG8_STAGE(PG8_SA(1, 1), a1 + hstepA, voffA);
            PG8_WAIT_V(8); PG8_WAIT_L(0); PG8_BAR; PG8_MMA(0, 0, At, B0); PG8_MMA(0, 1, At, B1); PG8_BAR; PG8_SCHED;
            PG8_LDA(At, 0, 1); PG8_STAGE(PG8_SB(0, 0), b2, voffB); PG8_STAGE(PG8_SB(0, 1), b2 + hstepB, voffB); PG8_STAGE(PG8_SA(0, 0), a2, voffA);
            PG8_WAIT_V(8); PG8_WAIT_L(0); PG8_BAR; PG8_MMA(1, 0, At, B0); PG8_MMA(1, 1, At, B1); PG8_BAR; PG8_SCHED;
            PG8_LDB(B0, 1, 0); PG8_LDB(B1, 1, 1); PG8_SCHED; PG8_LDA(At, 1, 0); PG8_STAGE(PG8_SA(0, 1), a2 + hstepA, voffA);
            PG8_WAIT_V(8); PG8_WAIT_L(0); PG8_BAR; PG8_MMA(0, 0, At, B0); PG8_MMA(0, 1, At, B1); PG8_BAR; PG8_SCHED;
            PG8_LDA(At, 1, 1); PG8_STAGE(PG8_SB(1, 0), b3, voffB); PG8_STAGE(PG8_SB(1, 1), b3 + hstepB, voffB); PG8_STAGE(PG8_SA(1, 0), a3, voffA);
            PG8_WAIT_V(8); PG8_WAIT_L(0); PG8_BAR; PG8_MMA(1, 0, At, B0); PG8_MMA(1, 1, At, B1); PG8_BAR; PG8_SCHED;
            } else {
            PG8_LDB(B0, 0, 0); PG8_SCHED; PG8_LDA(At, 0, 0); PG8_STAGE(PG8_SA(1, 1), a1 + hstepA, voffA);
            PG8_WAIT_L(8); PG8_BAR; PG8_WAIT_L(0); PG8_MMA(0, 0, At, B0); PG8_BAR; PG8_SCHED;
            PG8_LDB(B1, 0, 1); PG8_STAGE(PG8_SB(0, 0), b2, voffB);
            PG8_BAR; PG8_WAIT_L(0); PG8_MMA(0, 1, At, B1); PG8_BAR;
            PG8_LDA(At, 0, 1); PG8_STAGE(PG8_SA(0, 0), a2, voffA);
            PG8_BAR; PG8_WAIT_L(0); PG8_MMA(1, 0, At, B0); PG8_BAR; PG8_SCHED;
            PG8_STAGE(PG8_SB(0, 1), b2 + hstepB, voffB);
            PG8_WAIT_V(6); PG8_BAR; PG8_MMA(1, 1, At, B1); PG8_BAR;
            PG8_LDB(B0, 1, 0); PG8_SCHED; PG8_LDA(At, 1, 0); PG8_STAGE(PG8_SA(0, 1), a2 + hstepA, voffA);
            PG8_WAIT_L(8); PG8_BAR; PG8_WAIT_L(0); PG8_MMA(0, 0, At, B0); PG8_BAR; PG8_SCHED;
            PG8_LDB(B1, 1, 1); PG8_STAGE(PG8_SB(1, 0), b3, voffB);
            PG8_BAR; PG8_WAIT_L(0); PG8_MMA(0, 1, At, B1); PG8_BAR;
            PG8_LDA(At, 1, 1); PG8_STAGE(PG8_SA(1, 0), a3, voffA);
            PG8_BAR; PG8_WAIT_L(0); PG8_MMA(1, 0, At, B0); PG8_BAR; PG8_SCHED;
            PG8_STAGE(PG8_SB(1, 1), b3 + hstepB, voffB);
            PG8_WAIT_V(6); PG8_BAR; PG8_MMA(1, 1, At, B1); PG8_BAR;
            }
        }
        if constexpr (ALIGN_EPI) { if (wr == 0) PG8_BAR; }
        if constexpr (!Epi::AFTER_DRAIN) { E(acc, cur, wr, wc, fr, fq); S.done(cur); }
        if (!has_next) break;
#pragma unroll
        for (int a = 0; a < 2; ++a)
#pragma unroll
            for (int b = 0; b < 2; ++b)
#pragma unroll
                for (int m = 0; m < 4; ++m)
#pragma unroll
                    for (int n = 0; n < 2; ++n) acc[a][b][m][n] = (f32x4){0.f, 0.f, 0.f, 0.f};
        cur = nxt; cA = nA; cB = nB; ++ui;
        if constexpr (ALIGN_EPI) { if (wr == 1) PG8_BAR; }
    }
    PG8_WAIT_V(0);
    if constexpr (!ALIGN_EPI) { if (wr == 0) PG8_BAR; }
    PG8_BAR;
    if constexpr (Epi::AFTER_DRAIN) { E.fused(acc, cur, wr, wc, fr, fq, lds, wid, lane); S.done(cur); }
#undef PG8_SA
#undef PG8_SB
#undef PG8_STAGE
#undef PG8_LDA
#undef PG8_LDB
#undef PG8_MMA
#undef PG8_WAIT_V
#undef PG8_WAIT_L
#undef PG8_BAR
#undef PG8_SCHED
}
}

namespace pg8 {
struct EpiZ {
    static constexpr bool PERM = true, AFTER_DRAIN = false;
    bf16_t* O; int ldc; float* fcbuf;
    __device__ __forceinline__ void operator()(const f32x4 (&acc)[2][2][4][2], const Unit& u, int wr, int wc, int fr, int fq) const {
        const int row0 = u.pm * BM + wr * 64 + fr, col0 = u.pn * BM + wc * 32 + 8 * fq;
        const bool fcl = (u.pn == 9) && (wc == 1) && (fq == 0);
#pragma unroll
        for (int ai = 0; ai < 2; ++ai)
#pragma unroll
            for (int m = 0; m < 4; ++m) {
                const int row = row0 + ai * HALF + m * 16;
                bf16_t* rowp = O + (size_t)row * ldc + col0;
#pragma unroll
                for (int bj = 0; bj < 2; ++bj) {
                    const f32x4 v0 = acc[ai][bj][m][0], v1 = acc[ai][bj][m][1];
                    u32x4 w; w.x = cvt_pk_bf16(v0[0], v0[1]); w.y = cvt_pk_bf16(v0[2], v0[3]); w.z = cvt_pk_bf16(v1[0], v1[1]); w.w = cvt_pk_bf16(v1[2], v1[3]);
                    *(u32x4*)(rowp + bj * HALF) = w;
                }
                if (fcl) *(f32x4*)(fcbuf + (size_t)row * 4) = acc[ai][0][m][0];
            }
    }
};
struct EpiRowScale {
    static constexpr bool PERM = true, AFTER_DRAIN = false;
    bf16_t* O; int ldc; const float* rs;
    __device__ __forceinline__ void operator()(const f32x4 (&acc)[2][2][4][2], const Unit& u, int wr, int wc, int fr, int fq) const {
        const int row0 = u.pm * BM + wr * 64 + fr, col0 = u.pn * BM + wc * 32 + 8 * fq;
#pragma unroll
        for (int ai = 0; ai < 2; ++ai)
#pragma unroll
            for (int m = 0; m < 4; ++m) {
                const int row = row0 + ai * HALF + m * 16;
                const float s = rs[row];
                bf16_t* rowp = O + (size_t)row * ldc + col0;
#pragma unroll
                for (int bj = 0; bj < 2; ++bj) {
                    const f32x4 v0 = acc[ai][bj][m][0] * s, v1 = acc[ai][bj][m][1] * s;
                    u32x4 w; w.x = cvt_pk_bf16(v0[0], v0[1]); w.y = cvt_pk_bf16(v0[2], v0[3]); w.z = cvt_pk_bf16(v1[0], v1[1]); w.w = cvt_pk_bf16(v1[2], v1[3]);
                    *(u32x4*)(rowp + bj * HALF) = w;
                }
            }
    }
};
struct EpiGU {
    static constexpr bool PERM = true, AFTER_DRAIN = false;
    bf16_t* O;
    __device__ __forceinline__ void operator()(const f32x4 (&acc)[2][2][4][2], const Unit& u, int wr, int wc, int fr, int fq) const {
        const int row0 = u.pm * BM + wr * 64 + fr, f0 = ((u.pn & 1) * BM + wc * 32 + 8 * fq) >> 1;
#pragma unroll
        for (int ai = 0; ai < 2; ++ai)
#pragma unroll
            for (int m = 0; m < 4; ++m) {
                bf16_t* rowp = O + (size_t)(row0 + ai * HALF + m * 16) * 256 + f0;
#pragma unroll
                for (int bj = 0; bj < 2; ++bj) {
                    const f32x4 v0 = acc[ai][bj][m][0], v1 = acc[ai][bj][m][1];
                    const float a0 = v0[0] / (1.f + __expf(-v0[0])) * v0[1], a1 = v0[2] / (1.f + __expf(-v0[2])) * v0[3];
                    const float a2 = v1[0] / (1.f + __expf(-v1[0])) * v1[1], a3 = v1[2] / (1.f + __expf(-v1[2])) * v1[3];
                    typedef unsigned u32x2 __attribute__((ext_vector_type(2)));
                    u32x2 w; w.x = cvt_pk_bf16(a0, a1); w.y = cvt_pk_bf16(a2, a3);
                    *(u32x2*)(rowp + bj * (HALF / 2)) = w;
                }
            }
    }
};
struct EpiPleGate {
    static constexpr bool PERM = true, AFTER_DRAIN = false;
    bf16_t* O; const bf16_t* PP;
    __device__ __forceinline__ void operator()(const f32x4 (&acc)[2][2][4][2], const Unit& u, int wr, int wc, int fr, int fq) const {
        const int row0 = u.pm * BM + wr * 64 + fr, col0 = u.pn * BM + wc * 32 + 8 * fq;
#pragma unroll
        for (int ai = 0; ai < 2; ++ai)
#pragma unroll
            for (int m = 0; m < 4; ++m) {
                const size_t off = (size_t)(row0 + ai * HALF + m * 16) * 1024 + col0;
#pragma unroll
                for (int bj = 0; bj < 2; ++bj) {
                    const f32x4 v0 = acc[ai][bj][m][0], v1 = acc[ai][bj][m][1];
                    const u32x4 pw = *(const u32x4*)(PP + off + bj * HALF);
                    float o[8];
                    o[0] = __uint_as_float(pw.x << 16) / (1.f + __expf(-v0[0])); o[1] = __uint_as_float(pw.x & 0xffff0000u) / (1.f + __expf(-v0[1]));
                    o[2] = __uint_as_float(pw.y << 16) / (1.f + __expf(-v0[2])); o[3] = __uint_as_float(pw.y & 0xffff0000u) / (1.f + __expf(-v0[3]));
                    o[4] = __uint_as_float(pw.z << 16) / (1.f + __expf(-v1[0])); o[5] = __uint_as_float(pw.z & 0xffff0000u) / (1.f + __expf(-v1[1]));
                    o[6] = __uint_as_float(pw.w << 16) / (1.f + __expf(-v1[2])); o[7] = __uint_as_float(pw.w & 0xffff0000u) / (1.f + __expf(-v1[3]));
                    u32x4 w; w.x = cvt_pk_bf16(o[0], o[1]); w.y = cvt_pk_bf16(o[2], o[3]); w.z = cvt_pk_bf16(o[4], o[5]); w.w = cvt_pk_bf16(o[6], o[7]);
                    *(u32x4*)(O + off + bj * HALF) = w;
                }
            }
    }
};
struct EpiDown {
    static constexpr bool PERM = true, AFTER_DRAIN = false;
    bf16_t* O;
    __device__ __forceinline__ void operator()(const f32x4 (&acc)[2][2][4][2], const Unit& u, int wr, int wc, int fr, int fq) const {
        const int row0 = u.pm * BM + wr * 64 + fr, col0 = (u.pn & 3) * BM + wc * 32 + 8 * fq;
#pragma unroll
        for (int ai = 0; ai < 2; ++ai)
#pragma unroll
            for (int m = 0; m < 4; ++m) {
                bf16_t* rowp = O + (size_t)(row0 + ai * HALF + m * 16) * 1024 + col0;
#pragma unroll
                for (int bj = 0; bj < 2; ++bj) {
                    const f32x4 v0 = acc[ai][bj][m][0], v1 = acc[ai][bj][m][1];
                    u32x4 w; w.x = cvt_pk_bf16(v0[0], v0[1]); w.y = cvt_pk_bf16(v0[2], v0[3]); w.z = cvt_pk_bf16(v1[0], v1[1]); w.w = cvt_pk_bf16(v1[2], v1[3]);
                    *(u32x4*)(rowp + bj * HALF) = w;
                }
            }
    }
};
struct GroupSched {
    const int* tile_e; int T, NJ, G, vc;
    __device__ __forceinline__ bool next(int i, Unit& u) const {
        const long L = (long)i * G + vc; if (L >= (long)T * NJ) return false;
        const int t = (int)(L / NJ), j = (int)(L % NJ);
        u.pm = t; u.pn = __builtin_amdgcn_readfirstlane(tile_e[t]) * NJ + j; return true;
    }
    __device__ __forceinline__ void a_ready(const Unit&) const {}
    __device__ __forceinline__ void done(const Unit&) const {}
};
}

template <class Map>
__device__ __forceinline__ void transpose_rows(const Map mp, const float* ks, int nrows_out, int K, bf16* WT, LAS float* scr, int gw, int NGW, int lane) {
    const int nblk = nrows_out / 32, nitems = (K / 64) * nblk;
    for (int it = gw; it < nitems; it += NGW) {
        const int kb = it / nblk, nb = it % nblk, k0 = 64 * kb, n0 = 32 * nb;
        const float* src; long pitch; float sc;
        mp.get(n0 + (lane & 31), src, pitch, sc);
#pragma unroll 8
        for (int i = 0; i < 32; ++i) {
            const int kk = 2 * i + (lane >> 5);
            float v = 0.f;
            if (src) { v = src[(size_t)(k0 + kk) * pitch] * sc; if (ks) v *= ks[k0 + kk]; }
            scr[kk * 33 + (lane & 31)] = v;
        }
        asm volatile("s_waitcnt lgkmcnt(0)" ::: "memory");
        const int c = lane & 7;
#pragma unroll
        for (int j = 0; j < 4; ++j) {
            const int n = (lane >> 3) + 8 * j; const LAS float* s = scr + (8 * c) * 33 + n;
            v4u o; o.x = pk2(s[0 * 33], s[1 * 33]); o.y = pk2(s[2 * 33], s[3 * 33]); o.z = pk2(s[4 * 33], s[5 * 33]); o.w = pk2(s[6 * 33], s[7 * 33]);
            *(v4u*)(WT + (size_t)(n0 + n) * K + k0 + 8 * c) = o;
        }
        asm volatile("s_waitcnt lgkmcnt(0)" ::: "memory");
    }
}
constexpr float LOG2E_W = 1.4426950408889634f;
struct MapIn {
    const float* w;
    __device__ __forceinline__ void get(int n, const float*& src, long& pitch, float& sc) const {
        int c;
        if (n < 1152) c = n;
        else if (n < Z_CKV) c = OFF_QC + (n - Z_QC);
        else if (n < Z_CQ) c = OFF_CKV + (n - Z_CKV);
        else if (n < Z_KR) c = OFF_CQ + (n - Z_CQ);
        else if (n < Z_FC) c = OFF_KR + (n - Z_KR);
        else if (n < Z_FC + 4) c = OFF_FC + (n - Z_FC);
        else c = -1;
        src = c >= 0 ? w + c : nullptr; pitch = D_IN;
        sc = n < Z_KA ? 0.17677669529663687f * LOG2E_W : ((n >= Z_QC && n < Z_KC) ? 0.125f * LOG2E_W : 1.f);
    }
};
struct MapPlain {
    const float* w; int N, nvalid; float scale;
    __device__ __forceinline__ void get(int n, const float*& src, long& pitch, float& sc) const { src = n < nvalid ? w + n : nullptr; pitch = N; sc = scale; }
};

struct MapGU {
    const float* wg; const float* wu;
    __device__ __forceinline__ void get(int n, const float*& src, long& pitch, float& sc) const {
        const int e = n >> 9, r = n & 511, f = r >> 1;
        const long dlt = (r & 1) ? (long)(wu - wg) : 0l;
        src = wg + dlt + (size_t)e * 1024 * 256 + f; pitch = 256; sc = 1.f;
    }
};
struct MapD {
    const float* wd;
    __device__ __forceinline__ void get(int n, const float*& src, long& pitch, float& sc) const {
        const int e = n >> 10, c = n & 1023;
        src = wd + (size_t)e * 256 * 1024 + c; pitch = 1024; sc = 1.f;
    }
};

struct AttnP {
    const bf16* z16; const bf16* qb16; const bf16* kvb16; const bf16* krr16; const float* cum; const float* cosT; const float* sinT;
    const int* pos; bf16* mixed16; const float* lq1; const float* lk1; const float* lq2; const float* lk2; const float* gdiff; int layer;
};
typedef short bf16x8_t __attribute__((ext_vector_type(8)));
typedef float f32x16_t __attribute__((ext_vector_type(16)));
typedef short s16x4_t __attribute__((ext_vector_type(4)));
typedef float f32x2_t __attribute__((ext_vector_type(2)));
typedef float f32x4_t __attribute__((ext_vector_type(4)));
typedef __bf16 bf16x2_t __attribute__((ext_vector_type(2)));
__device__ __forceinline__ unsigned cvtpk(float lo, float hi) { f32x2_t v = {lo, hi}; bf16x2_t b = __builtin_convertvector(v, bf16x2_t); return __builtin_bit_cast(unsigned, b); }
__device__ __forceinline__ int crow(int r, int hi) { return (r & 3) + 8 * (r >> 2) + 4 * hi; }
__device__ __forceinline__ s16x4_t vtr(const LAS unsigned char* p) { typedef short v4i16_t __attribute__((ext_vector_type(4))); return __builtin_bit_cast(s16x4_t, __builtin_amdgcn_ds_read_tr16_b64_v4i16((LAS v4i16_t*)p)); }
constexpr float LOG2E = 1.4426950408889634f;

template <int MODE> __device__ __forceinline__ void attn_unit(const AttnP& p, int b, int h, int qb, LAS unsigned char* lds, const int tid) {
    constexpr int NMAP = MODE == 0 ? 2 : 1;
    constexpr int NF = MODE == 0 ? 2 : (MODE == 1 ? 6 : 4);
    constexpr int NC = NMAP * NF * 2;
    constexpr int KB = NC * 1024, BUF = KB + 8192 + 256;
    constexpr int KI = (NC * 64 + NTHREADS - 1) / NTHREADS;
    const int lane = tid & 63, w = __builtin_amdgcn_readfirstlane(tid >> 6), r32 = lane & 31, hi = lane >> 5;
    const int c = qb * 4 + (w >> 1);
    const long tok0 = (long)b * SEQ;
    const long qrow = tok0 + qb * 256 + w * 32 + r32;
    bf16x8_t qf[NMAP * NF];
    {
        const bf16* qsrc = MODE == 0 ? p.z16 + qrow * ZP + Z_QA + h * 64 : (MODE == 1 ? p.qb16 + qrow * NQBP + h * 96 : p.z16 + qrow * ZP + Z_QC + h * 64);
#pragma unroll
        for (int i = 0; i < NMAP * NF; ++i) qf[i] = *(const bf16x8_t*)(qsrc + i * 16 + hi * 8);
    }
    if (MODE == 1) {
        const float4 c0 = *(const float4*)(p.cosT + qrow * 16 + hi * 8), c1 = *(const float4*)(p.cosT + qrow * 16 + hi * 8 + 4);
        const float4 s0 = *(const float4*)(p.sinT + qrow * 16 + hi * 8), s1 = *(const float4*)(p.sinT + qrow * 16 + hi * 8 + 4);
        const float cs[8] = {c0.x, c0.y, c0.z, c0.w, c1.x, c1.y, c1.z, c1.w}, sn[8] = {s0.x, s0.y, s0.z, s0.w, s1.x, s1.y, s1.z, s1.w};
        float n1[8], n2[8];
#pragma unroll
        for (int j = 0; j < 8; ++j) {
            const float x1 = __uint_as_float((unsigned)(unsigned short)qf[NF - 2][j] << 16), x2 = __uint_as_float((unsigned)(unsigned short)qf[NF - 1][j] << 16);
            n1[j] = x1 * cs[j] - x2 * sn[j]; n2[j] = x2 * cs[j] + x1 * sn[j];
        }
        v4u a, bb;
        a.x = cvtpk(n1[0], n1[1]); a.y = cvtpk(n1[2], n1[3]); a.z = cvtpk(n1[4], n1[5]); a.w = cvtpk(n1[6], n1[7]);
        bb.x = cvtpk(n2[0], n2[1]); bb.y = cvtpk(n2[2], n2[3]); bb.z = cvtpk(n2[4], n2[5]); bb.w = cvtpk(n2[6], n2[7]);
        qf[NF - 2] = __builtin_bit_cast(bf16x8_t, a); qf[NF - 1] = __builtin_bit_cast(bf16x8_t, bb);
    }
    float posq = 0.f, slope2 = 0.f;
    if (MODE == 0) { posq = (float)p.pos[qrow]; slope2 = exp2f(-8.0f * (float)(h + 1) / 6.0f) * LOG2E; }
    f32x16_t o[NMAP][2];
    float mrun[NMAP], lsum[NMAP];
#pragma unroll
    for (int m = 0; m < NMAP; ++m) { mrun[m] = -INFINITY; lsum[m] = 0.f;
#pragma unroll
        for (int r = 0; r < 16; ++r) { o[m][0][r] = 0.f; o[m][1][r] = 0.f; } }
    const bf16* ksrc[KI]; bool kok[KI];
#pragma unroll
    for (int i = 0; i < KI; ++i) {
        const int pidx = tid + i * NTHREADS, c8 = pidx >> 6, kv = pidx & 63;
        kok[i] = pidx < NC * 64;
        if (MODE == 0) ksrc[i] = p.z16 + (tok0 + kv) * ZP + Z_KA + h * 64 + c8 * 8;
        else if (MODE == 2) ksrc[i] = p.z16 + (tok0 + kv) * ZP + Z_KC + h * 64 + c8 * 8;
        else ksrc[i] = (c8 < 8) ? p.kvb16 + (tok0 + kv) * NKVB + h * 128 + c8 * 8 : p.krr16 + (tok0 + kv) * 32 + (c8 - 8) * 8;
    }
    const int kstride = MODE == 1 ? 0 : 64 * ZP;
    const int vcl = tid & 3, vkv = (tid >> 2) & 63, vch = tid >> 8;
    const bf16* vsrc = MODE == 0 ? p.z16 + (tok0 + vkv) * ZP + Z_VA + h * 64 + (vch * 4 + vcl) * 8
                     : (MODE == 1 ? p.kvb16 + (tok0 + vkv) * NKVB + h * 128 + 64 + (vch * 4 + vcl) * 8 : p.z16 + (tok0 + vkv) * ZP + Z_VC + h * 64 + (vch * 4 + vcl) * 8);
    const int vstride = MODE == 1 ? 64 * NKVB : 64 * ZP;
    const int vdst = KB + vch * 4096 + (vkv >> 3) * 512 + (vkv & 7) * 64 + vcl * 16;
    v4u kreg[KI], vreg; float breg = 0.f;
    auto stage_load = [&](int kt) {
#pragma unroll
        for (int i = 0; i < KI; ++i) if (kok[i]) {
            const int pidx = tid + i * NTHREADS;
            const long off = MODE == 1 ? ((pidx >> 6) < 8 ? (long)kt * 64 * NKVB : (long)kt * 64 * 32) : (long)kt * kstride;
            kreg[i] = *(const v4u*)(ksrc[i] + off);
        }
        vreg = *(const v4u*)(vsrc + (long)kt * vstride);
        if (MODE != 1 && tid < 64) breg = MODE == 0 ? (float)p.pos[tok0 + kt * 64 + tid] : -p.cum[(tok0 + kt * 64 + tid) * 4 + h] * LOG2E;
    };
    auto stage_write = [&](int buf) {
        LAS unsigned char* bp = lds + buf * BUF;
#pragma unroll
        for (int i = 0; i < KI; ++i) if (kok[i]) *(LAS v4u*)(bp + (tid + i * NTHREADS) * 16) = kreg[i];
        *(LAS v4u*)(bp + vdst) = vreg;
        if (MODE != 1 && tid < 64) *(LAS float*)(bp + KB + 8192 + tid * 4) = breg;
    };
    const int ntiles = qb * 4 + 4;
    const int voff = (4 * hi + ((lane & 15) >> 2)) * 64 + ((lane >> 4) & 1) * 32 + (lane & 3) * 8;
    stage_load(0); stage_write(0);
    __syncthreads();
#pragma unroll 1
    for (int kt = 0; kt < ntiles; ++kt) {
        if (kt + 1 < ntiles) stage_load(kt + 1);
        if (kt <= c) {
            const LAS unsigned char* bp = lds + (kt & 1) * BUF;
            const LAS unsigned char* vp = bp + KB + voff;
            const LAS float* bias = (const LAS float*)(bp + KB + 8192);
#pragma unroll
            for (int m = 0; m < NMAP; ++m) {
                f32x16_t p0, p1;
#pragma unroll
                for (int r = 0; r < 16; ++r) { p0[r] = 0.f; p1[r] = 0.f; }
#pragma unroll
                for (int d0 = 0; d0 < NF; ++d0) {
                    const LAS unsigned char* kp = bp + ((m * NF + d0) * 2 + hi) * 1024 + r32 * 16;
                    const bf16x8_t k0 = *(const LAS bf16x8_t*)kp, k1 = *(const LAS bf16x8_t*)(kp + 512);
                    p0 = __builtin_amdgcn_mfma_f32_32x32x16_bf16(k0, qf[m * NF + d0], p0, 0, 0, 0);
                    p1 = __builtin_amdgcn_mfma_f32_32x32x16_bf16(k1, qf[m * NF + d0], p1, 0, 0, 0);
                }
                if (MODE == 0) {
#pragma unroll
                    for (int g = 0; g < 4; ++g) {
                        const f32x4_t b0 = *(const LAS f32x4_t*)(bias + 8 * g + 4 * hi), b1 = *(const LAS f32x4_t*)(bias + 32 + 8 * g + 4 * hi);
                        p0[4 * g + 0] -= slope2 * fabsf(posq - b0.x); p0[4 * g + 1] -= slope2 * fabsf(posq - b0.y); p0[4 * g + 2] -= slope2 * fabsf(posq - b0.z); p0[4 * g + 3] -= slope2 * fabsf(posq - b0.w);
                        p1[4 * g + 0] -= slope2 * fabsf(posq - b1.x); p1[4 * g + 1] -= slope2 * fabsf(posq - b1.y); p1[4 * g + 2] -= slope2 * fabsf(posq - b1.z); p1[4 * g + 3] -= slope2 * fabsf(posq - b1.w);
                    }
                }
                if (MODE == 2) {
#pragma unroll
                    for (int g = 0; g < 4; ++g) {
                        const f32x4_t b0 = *(const LAS f32x4_t*)(bias + 8 * g + 4 * hi), b1 = *(const LAS f32x4_t*)(bias + 32 + 8 * g + 4 * hi);
                        p0[4 * g + 0] += b0.x; p0[4 * g + 1] += b0.y; p0[4 * g + 2] += b0.z; p0[4 * g + 3] += b0.w;
                        p1[4 * g + 0] += b1.x; p1[4 * g + 1] += b1.y; p1[4 * g + 2] += b1.z; p1[4 * g + 3] += b1.w;
                    }
                    if (kt == c) {
                        const int qi = (w & 1) * 32 + r32;
#pragma unroll
                        for (int r = 0; r < 16; ++r) { const int kv = crow(r, hi); if (kv > qi) p0[r] = -INFINITY; if (kv + 32 > qi) p1[r] = -INFINITY; }
                    }
                }
                float tmax = fmaxf(p0[0], p1[0]);
#pragma unroll
                for (int r = 1; r < 16; ++r) tmax = fmaxf(tmax, fmaxf(p0[r], p1[r]));
                tmax = fmaxf(tmax, __shfl_xor(tmax, 32));
                const float mnew = fmaxf(mrun[m], tmax);
                if (__any(mnew > mrun[m])) {
                    const float f = __builtin_amdgcn_exp2f(mrun[m] - mnew);
                    lsum[m] *= f;
#pragma unroll
                    for (int r = 0; r < 16; ++r) { o[m][0][r] *= f; o[m][1][r] *= f; }
                    mrun[m] = mnew;
                }
                float ls = 0.f;
#pragma unroll
                for (int r = 0; r < 16; ++r) { p0[r] = __builtin_amdgcn_exp2f(p0[r] - mnew); p1[r] = __builtin_amdgcn_exp2f(p1[r] - mnew); ls += p0[r] + p1[r]; }
                lsum[m] += ls;
                bf16x8_t pa[4];
#pragma unroll
                for (int ks = 0; ks < 4; ++ks) {
                    v4u wv;
                    if (ks < 2) { wv.x = cvtpk(p0[8 * ks + 0], p0[8 * ks + 1]); wv.y = cvtpk(p0[8 * ks + 2], p0[8 * ks + 3]); wv.z = cvtpk(p0[8 * ks + 4], p0[8 * ks + 5]); wv.w = cvtpk(p0[8 * ks + 6], p0[8 * ks + 7]); }
                    else { wv.x = cvtpk(p1[8 * (ks - 2) + 0], p1[8 * (ks - 2) + 1]); wv.y = cvtpk(p1[8 * (ks - 2) + 2], p1[8 * (ks - 2) + 3]); wv.z = cvtpk(p1[8 * (ks - 2) + 4], p1[8 * (ks - 2) + 5]); wv.w = cvtpk(p1[8 * (ks - 2) + 6], p1[8 * (ks - 2) + 7]); }
                    pa[ks] = __builtin_bit_cast(bf16x8_t, wv);
                }
#pragma unroll
                for (int blk = 0; blk < 2; ++blk)
#pragma unroll
                    for (int ks = 0; ks < 4; ++ks) {
                        const s16x4_t lo = vtr(vp + blk * 4096 + ks * 1024), hi4 = vtr(vp + blk * 4096 + ks * 1024 + 512);
                        const bf16x8_t vf = {lo[0], lo[1], lo[2], lo[3], hi4[0], hi4[1], hi4[2], hi4[3]};
                        o[m][blk] = __builtin_amdgcn_mfma_f32_32x32x16_bf16(vf, pa[ks], o[m][blk], 0, 0, 0);
                    }
                __builtin_amdgcn_sched_barrier(0);
            }
        }
        if (kt + 1 < ntiles) stage_write((kt + 1) & 1);
        __syncthreads();
    }
    bf16* op = p.mixed16 + qrow * D_MODEL + (MODE == 0 ? 0 : (MODE == 1 ? 384 : 768)) + h * 64;
    if (MODE == 0) {
        const float l1 = lsum[0] + __shfl_xor(lsum[0], 32), l2 = lsum[NMAP - 1] + __shfl_xor(lsum[NMAP - 1], 32);
        const float lam_init = 0.8f - 0.6f * expf(-0.3f * (float)p.layer);
        float s1 = 0.f, s2 = 0.f;
        for (int i = 0; i < 32; ++i) { s1 += p.lq1[i] * p.lk1[i]; s2 += p.lq2[i] * p.lk2[i]; }
        const float lam = expf(s1) - expf(s2) + lam_init;
        const float i1 = 1.f / l1, i2 = lam / l2;
        float ss = 0.f;
#pragma unroll
        for (int blk = 0; blk < 2; ++blk)
#pragma unroll
            for (int r = 0; r < 16; ++r) { const float v = o[0][blk][r] * i1 - o[NMAP - 1][blk][r] * i2; o[0][blk][r] = v; ss = fmaf(v, v, ss); }
        ss += __shfl_xor(ss, 32);
        const float rr = rsqrtf(ss * (1.f / 64.f) + RMS_EPS) * (1.f - lam_init);
#pragma unroll
        for (int blk = 0; blk < 2; ++blk)
#pragma unroll
            for (int g = 0; g < 4; ++g) {
                const int d = 32 * blk + 8 * g + 4 * hi;
                const float4 gv = *(const float4*)(p.gdiff + d);
                v2u wv; wv.x = cvtpk(o[0][blk][4 * g] * rr * gv.x, o[0][blk][4 * g + 1] * rr * gv.y); wv.y = cvtpk(o[0][blk][4 * g + 2] * rr * gv.z, o[0][blk][4 * g + 3] * rr * gv.w);
                *(v2u*)(op + d) = wv;
            }
    } else {
        const float inv = 1.f / (lsum[0] + __shfl_xor(lsum[0], 32));
#pragma unroll
        for (int blk = 0; blk < 2; ++blk)
#pragma unroll
            for (int g = 0; g < 4; ++g) {
                const int d = 32 * blk + 8 * g + 4 * hi;
                v2u wv; wv.x = cvtpk(o[0][blk][4 * g] * inv, o[0][blk][4 * g + 1] * inv); wv.y = cvtpk(o[0][blk][4 * g + 2] * inv, o[0][blk][4 * g + 3] * inv);
                *(v2u*)(op + d) = wv;
            }
    }
}

__device__ __forceinline__ void convert_layer_weights(const Args& a, int l, unsigned char* ws, LAS float* scr, int gw, int NGW, int lane) {
    const float* w_in = (const float*)a.in[3] + (size_t)l * D_MODEL * D_IN;
    const float* w_uq = (const float*)a.in[4] + (size_t)l * 256 * NQB;
    const float* w_ukv = (const float*)a.in[5] + (size_t)l * 128 * NKVB;
    const float* g_cq = (const float*)a.in[6] + l * 256;
    const float* g_ckv = (const float*)a.in[7] + l * 128;
    const float* w_out = (const float*)a.in[14] + (size_t)l * 1024 * 1024;
    transpose_rows(MapIn{w_in}, nullptr, ZP, 1024, (bf16*)(ws + WS_WIN), scr, gw, NGW, lane);
    transpose_rows(MapPlain{w_uq, NQB, NQB, 0.10206207261596575f * LOG2E_W}, g_cq, NQBP, 256, (bf16*)(ws + WS_WUQ), scr, gw, NGW, lane);
    transpose_rows(MapPlain{w_ukv, NKVB, NKVB, 1.f}, g_ckv, NKVB, 128, (bf16*)(ws + WS_WUKV), scr, gw, NGW, lane);
    transpose_rows(MapPlain{w_out, 1024, 1024, 1.f}, nullptr, 1024, 1024, (bf16*)(ws + WS_WOUT), scr, gw, NGW, lane);
    transpose_rows(MapPlain{(const float*)a.in[24] + (size_t)l * 1024 * 1024, 1024, 1024, 1.f}, nullptr, 1024, 1024, (bf16*)(ws + WS_WPG), scr, gw, NGW, lane);
    transpose_rows(MapPlain{(const float*)a.in[25] + (size_t)l * 256 * 1024, 1024, 1024, 1.f}, nullptr, 1024, 256, (bf16*)(ws + WS_WPP), scr, gw, NGW, lane);
    transpose_rows(MapGU{(const float*)a.in[21] + (size_t)l * 32 * 1024 * 256, (const float*)a.in[22] + (size_t)l * 32 * 1024 * 256}, nullptr, 32 * 512, 1024, (bf16*)(ws + WS_WGU), scr, gw, NGW, lane);
    transpose_rows(MapD{(const float*)a.in[23] + (size_t)l * 32 * 256 * 1024}, nullptr, 32 * 1024, 256, (bf16*)(ws + WS_WD), scr, gw, NGW, lane);
}

constexpr int PH_PER_LAYER = 10, NPH = 1 + DEPTH * PH_PER_LAYER;
template <int PH> __device__ __forceinline__ void run_phase(const Args& a, unsigned char* lds_raw) {
    float* sm = (float*)lds_raw;
    const int G = gridDim.x, NGW = G * 8, NGT = G * NTHREADS;
    unsigned char* ws = a.ws;
    const float* x0 = (const float*)a.in[0];
    const float* pin = (const float*)a.in[1];
    const int* pos = (const int*)a.in[2];
    float* cosT = (float*)(ws + WS_COS); float* sinT = (float*)(ws + WS_SIN);
    bf16* a16 = (bf16*)(ws + WS_A16); bf16* z16 = (bf16*)(ws + WS_Z16); bf16* qb16 = (bf16*)(ws + WS_QB16); bf16* kvb16 = (bf16*)(ws + WS_KVB16);
    bf16* krr16 = (bf16*)(ws + WS_KRR16); float* fcbuf = (float*)(ws + WS_FC); float* cum = (float*)(ws + WS_CUM);
    float* rq = (float*)(ws + WS_RQ); float* rkv = (float*)(ws + WS_RKV);
    bf16* mixed16 = (bf16*)(ws + WS_MIXED16); bf16* mix16 = (bf16*)(ws + WS_MIX16);
    float* hbuf = a.out; bf16* hs16 = (bf16*)(ws + WS_HS16); bf16* act16 = (bf16*)(ws + WS_ACT16); bf16* outs16 = (bf16*)(ws + WS_OUTS16); bf16* ple16 = (bf16*)(ws + WS_PLE16); bf16* pp16 = (bf16*)(ws + WS_PP16); bf16* p16 = (bf16*)(ws + WS_P16);
    int* ids = (int*)(ws + WS_RT + RT_IDS); float* wts = (float*)(ws + WS_RT + RT_WTS); int* rank = (int*)(ws + WS_RT + RT_RANK);
    int* slot_of = (int*)(ws + WS_RT + RT_SLOTOF); int* tile_e = (int*)(ws + WS_RT + RT_TILEE);
    unsigned* ctl = (unsigned*)(ws + WS_CTL);

        int tid = threadIdx.x; asm volatile("" : "+v"(tid));
        const int lane = tid & 63, wave = __builtin_amdgcn_readfirstlane(tid >> 6);
        const int gw = blockIdx.x * 8 + wave, gtid = blockIdx.x * NTHREADS + tid;
        LAS float* scr = (LAS float*)((LAS unsigned char*)lds_raw + wave * 16384);
        if constexpr (PH == 0) {
            for (int i = gtid; i < NTOK * 16; i += NGT) {
                const int tk = i >> 4, j = i & 15;
                const int j4 = j >> 2, jr = j & 3;
                const double inv = (j4 == 0 ? 1.0 : (j4 == 1 ? 0.1 : (j4 == 2 ? 0.01 : 0.001))) * (jr == 0 ? 1.0 : (jr == 1 ? 0.5623413251903491 : (jr == 2 ? 0.31622776601683794 : 0.1778279410038923)));
                const double ang = (double)pos[tk] * inv;
                const double k = rint(ang * 0.15915494309189535);
                const double r = fma(-k, 6.283185307179586, ang) - k * 2.4492935982947064e-16;
                cosT[i] = cosf((float)r); sinT[i] = sinf((float)r);
            }
            for (int i = gtid; i < NTOK * D_MODEL / 8; i += NGT) {
                const float4 v0 = *(const float4*)(x0 + (size_t)i * 8), v1 = *(const float4*)(x0 + (size_t)i * 8 + 4);
                v4u o; o.x = pk2(v0.x, v0.y); o.y = pk2(v0.z, v0.w); o.z = pk2(v1.x, v1.y); o.w = pk2(v1.z, v1.w);
                *(v4u*)(a16 + (size_t)i * 8) = o;
            }
            for (int i = gtid; i < DEPTH * NTOK * PLE_DIM / 8; i += NGT) {
                const float4 v0 = *(const float4*)(pin + (size_t)i * 8), v1 = *(const float4*)(pin + (size_t)i * 8 + 4);
                v4u o; o.x = pk2(v0.x, v0.y); o.y = pk2(v0.z, v0.w); o.z = pk2(v1.x, v1.y); o.w = pk2(v1.z, v1.w);
                *(v4u*)(p16 + (size_t)i * 8) = o;
            }
            convert_layer_weights(a, 0, ws, scr, gw, NGW, lane);
        } else {
            constexpr int l = (PH - 1) / PH_PER_LAYER, sp = (PH - 1) % PH_PER_LAYER;
            const float* xin = (l == 0) ? x0 : a.out;
            const float* b_forget = (const float*)a.in[13] + l * 4;
            const float* ln1_g = (const float*)a.in[15] + l * 1024; const float* ln1_b = (const float*)a.in[16] + l * 1024;
            const float* w_group = (const float*)a.in[17] + l * 1024 * 4; const float* b_group = (const float*)a.in[18] + l * 4;
            const float* w_er = (const float*)a.in[19] + (size_t)l * 4 * 1024 * 8; const float* b_er = (const float*)a.in[20] + l * 32;
            const float* ln2_g = (const float*)a.in[26] + l * 1024; const float* ln2_b = (const float*)a.in[27] + l * 1024;
            unsigned* cnt = ctl + CW_CNT + l * 32;
            if constexpr (sp == 0) {
                pg8::Gemm g{a16, (const bf16*)(ws + WS_WIN), NTOK, ZP, 1024, 1024, 1024};
                pg8::StaticOrder S; S.init(NTOK, ZP, G, (int)blockIdx.x);
                pg8::EpiZ E{z16, ZP, fcbuf};
                pg8::gemm_phase<pg8::EpiZ, pg8::StaticOrder, true, true>((LAS unsigned char*)lds_raw, g, S, E, tid);
            } else if constexpr (sp == 1) {
                for (int tk = gw; tk < NTOK; tk += NGW) {
                    const bf16* zr = z16 + (size_t)tk * ZP;
                    const v2u cv = *(const v2u*)(zr + Z_CQ + lane * 4);
                    const float c0 = bflo(cv.x), c1 = bfhi(cv.x), c2 = bflo(cv.y), c3 = bfhi(cv.y);
                    float ss = wave_sum(c0 * c0 + c1 * c1 + c2 * c2 + c3 * c3);
                    const float r1 = rsqrtf(ss * (1.f / 256.f) + RMS_EPS);
                    const unsigned kvw = *(const unsigned*)(zr + Z_CKV + lane * 2);
                    const float k0 = bflo(kvw), k1 = bfhi(kvw);
                    ss = wave_sum(k0 * k0 + k1 * k1);
                    const float r2 = rsqrtf(ss * (1.f / 128.f) + RMS_EPS);
                    if (lane == 0) { rq[tk] = r1; rkv[tk] = r2; }
                    if (lane < 16) {
                        const float x1 = __uint_as_float((unsigned)zr[Z_KR + lane] << 16), x2 = __uint_as_float((unsigned)zr[Z_KR + 16 + lane] << 16);
                        const float cs = cosT[tk * 16 + lane], sn = sinT[tk * 16 + lane];
                        krr16[tk * 32 + lane] = (bf16)f2bf(x1 * cs - x2 * sn); krr16[tk * 32 + 16 + lane] = (bf16)f2bf(x2 * cs + x1 * sn);
                    }
                    if (lane < 4) {
                        const float xf = fcbuf[tk * 4 + lane] + b_forget[lane];
                        cum[tk * 4 + lane] = fminf(xf, 0.f) - log1pf(expf(-fabsf(xf)));
                    }
                }
            } else if constexpr (sp == 2) {
                {
                    pg8::Gemm g{z16 + Z_CQ, (const bf16*)(ws + WS_WUQ), NTOK, NQBP, 256, ZP, 256};
                    pg8::StaticOrder S; S.init(NTOK, NQBP, G, (int)blockIdx.x);
                    pg8::EpiRowScale E{qb16, NQBP, rq};
                    pg8::gemm_phase<pg8::EpiRowScale, pg8::StaticOrder, true, true>((LAS unsigned char*)lds_raw, g, S, E, tid);
                }
                {
                    pg8::Gemm g{z16 + Z_CKV, (const bf16*)(ws + WS_WUKV), NTOK, NKVB, 128, ZP, 128};
                    pg8::StaticOrder S; S.init(NTOK, NKVB, G, (int)((blockIdx.x + 128) % G));
                    pg8::EpiRowScale E{kvb16, NKVB, rkv};
                    pg8::gemm_phase<pg8::EpiRowScale, pg8::StaticOrder, true, true>((LAS unsigned char*)lds_raw, g, S, E, tid);
                }
                const int cw = NGW - 1 - gw;
                if (cw < 32) {
                    const int b = cw >> 2, hh = cw & 3;
                    float* cp = cum + ((size_t)b * SEQ) * 4 + hh;
                    float loc[32]; float run = 0.f;
#pragma unroll
                    for (int i = 0; i < 32; ++i) { run += cp[(size_t)(lane * 32 + i) * 4]; loc[i] = run; }
                    float pre = run;
#pragma unroll
                    for (int o = 1; o < 64; o <<= 1) { const float n = __shfl_up(pre, o); if (lane >= o) pre += n; }
                    pre -= run;
#pragma unroll
                    for (int i = 0; i < 32; ++i) cp[(size_t)(lane * 32 + i) * 4] = loc[i] + pre;
                }
            } else if constexpr (sp == 3) {
                __syncthreads();
                AttnP p{z16, qb16, kvb16, krr16, cum, cosT, sinT, pos, mixed16,
                        (const float*)a.in[8] + l * 32, (const float*)a.in[9] + l * 32, (const float*)a.in[10] + l * 32, (const float*)a.in[11] + l * 32,
                        (const float*)a.in[12] + l * 64, l};
                for (int rnd = 0; rnd < 4; ++rnd) {
                    const int bx = (int)blockIdx.x;
                    const int idx = rnd * 256 + ((rnd & 1) ? 255 - bx : bx);
                    const int qb = 7 - idx / 128, j = idx % 128;
                    if (j < 48) attn_unit<0>(p, j / 6, j % 6, qb, (LAS unsigned char*)lds_raw, tid);
                    else if (j < 96) attn_unit<1>(p, (j - 48) / 6, (j - 48) % 6, qb, (LAS unsigned char*)lds_raw, tid);
                    else attn_unit<2>(p, (j - 96) / 4, (j - 96) % 4, qb, (LAS unsigned char*)lds_raw, tid);
                }
            } else if constexpr (sp == 4) {
                pg8::Gemm g{mixed16, (const bf16*)(ws + WS_WOUT), NTOK, 1024, 1024, 1024, 1024};
                pg8::StaticOrder S; S.init(NTOK, 1024, G, (int)blockIdx.x);
                pg8::EpiBf16<0> E{mix16, 1024, nullptr, 0, 0, 1.f};
                pg8::gemm_phase<pg8::EpiBf16<0>, pg8::StaticOrder, true, true>((LAS unsigned char*)lds_raw, g, S, E, tid);
            } else if constexpr (sp == 5) {
                for (int tk = gw; tk < NTOK; tk += NGW) {
                    float4 v[4]; float s = 0.f;
#pragma unroll
                    for (int j = 0; j < 4; ++j) {
                        const float4 xv = *(const float4*)(xin + (size_t)tk * D_MODEL + j * 256 + lane * 4);
                        const v2u mw = *(const v2u*)(mix16 + (size_t)tk * D_MODEL + j * 256 + lane * 4);
                        v[j] = make_float4(ALPHA * xv.x + bflo(mw.x), ALPHA * xv.y + bfhi(mw.x), ALPHA * xv.z + bflo(mw.y), ALPHA * xv.w + bfhi(mw.y));
                        s += (v[j].x + v[j].y) + (v[j].z + v[j].w);
                    }
                    const float mean = wave_sum(s) * (1.f / 1024.f); float s2 = 0.f;
#pragma unroll
                    for (int j = 0; j < 4; ++j) { v[j].x -= mean; v[j].y -= mean; v[j].z -= mean; v[j].w -= mean; s2 += (v[j].x * v[j].x + v[j].y * v[j].y) + (v[j].z * v[j].z + v[j].w * v[j].w); }
                    const float rstd = rsqrtf(wave_sum(s2) * (1.f / 1024.f) + LN_EPS);
                    float gl[4] = {0.f, 0.f, 0.f, 0.f};
#pragma unroll
                    for (int j = 0; j < 4; ++j) {
                        const int d0 = j * 256 + lane * 4;
                        const float4 gg = *(const float4*)(ln1_g + d0), bb = *(const float4*)(ln1_b + d0);
                        v[j] = make_float4(v[j].x * rstd * gg.x + bb.x, v[j].y * rstd * gg.y + bb.y, v[j].z * rstd * gg.z + bb.z, v[j].w * rstd * gg.w + bb.w);
                        *(float4*)(hbuf + (size_t)tk * D_MODEL + d0) = v[j];
                        { v2u hb; hb.x = pk2(v[j].x, v[j].y); hb.y = pk2(v[j].z, v[j].w); *(v2u*)(a16 + (size_t)tk * D_MODEL + d0) = hb; }
                        const float hv[4] = {v[j].x, v[j].y, v[j].z, v[j].w};
#pragma unroll
                        for (int i = 0; i < 4; ++i) {
                            const float4 wg = *(const float4*)(w_group + (size_t)(d0 + i) * 4);
                            gl[0] = fmaf(hv[i], wg.x, gl[0]); gl[1] = fmaf(hv[i], wg.y, gl[1]); gl[2] = fmaf(hv[i], wg.z, gl[2]); gl[3] = fmaf(hv[i], wg.w, gl[3]);
                        }
                    }
#pragma unroll
                    for (int i = 0; i < 4; ++i) gl[i] = wave_sum(gl[i]) + b_group[i];
                    int gi = 0; float gm = gl[0];
#pragma unroll
                    for (int i = 1; i < 4; ++i) if (gl[i] > gm) { gm = gl[i]; gi = i; }
                    float gden = 0.f;
#pragma unroll
                    for (int i = 0; i < 4; ++i) gden += expf(gl[i] - gm);
                    const float gwt = 1.f / gden;
                    float el[8] = {0.f, 0.f, 0.f, 0.f, 0.f, 0.f, 0.f, 0.f};
                    const float* we = w_er + (size_t)gi * 1024 * 8;
#pragma unroll
                    for (int j = 0; j < 4; ++j) {
                        const int d0 = j * 256 + lane * 4;
                        const float hv[4] = {v[j].x, v[j].y, v[j].z, v[j].w};
#pragma unroll
                        for (int i = 0; i < 4; ++i) {
                            const float4 w0 = *(const float4*)(we + (size_t)(d0 + i) * 8), w1 = *(const float4*)(we + (size_t)(d0 + i) * 8 + 4);
                            el[0] = fmaf(hv[i], w0.x, el[0]); el[1] = fmaf(hv[i], w0.y, el[1]); el[2] = fmaf(hv[i], w0.z, el[2]); el[3] = fmaf(hv[i], w0.w, el[3]);
                            el[4] = fmaf(hv[i], w1.x, el[4]); el[5] = fmaf(hv[i], w1.y, el[5]); el[6] = fmaf(hv[i], w1.z, el[6]); el[7] = fmaf(hv[i], w1.w, el[7]);
                        }
                    }
#pragma unroll
                    for (int i = 0; i < 8; ++i) el[i] = wave_sum(el[i]) + b_er[gi * 8 + i];
                    int i0 = 0; float v0 = el[0];
#pragma unroll
                    for (int i = 1; i < 8; ++i) if (el[i] > v0) { v0 = el[i]; i0 = i; }
                    int i1 = -1; float v1 = -INFINITY;
#pragma unroll
                    for (int i = 0; i < 8; ++i) if (i != i0 && el[i] > v1) { v1 = el[i]; i1 = i; }
                    const float e1 = expf(v1 - v0);
                    const float w0 = gwt / (1.f + e1), w1 = gwt * e1 / (1.f + e1);
                    if (lane == 0) {
                        const int ea = gi * 8 + i0, eb = gi * 8 + i1;
                        ids[tk * 2] = ea; ids[tk * 2 + 1] = eb; wts[tk * 2] = w0; wts[tk * 2 + 1] = w1;
                        rank[tk * 2] = (int)atomicAdd(cnt + ea, 1u); rank[tk * 2 + 1] = (int)atomicAdd(cnt + eb, 1u);
                    }
                }
            } else if constexpr (sp == 6) {
                int* offs = (int*)sm;
                __syncthreads();
                if (tid == 0) { int o = 0; for (int e = 0; e < 32; ++e) { offs[e] = o; o += ((int)cnt[e] + 255) & ~255; } offs[32] = o; }
                __syncthreads();
                for (int i = gtid; i < NSLOT_TILES; i += NGT) { int e = -1; for (int k = 0; k < 32; ++k) if (i * 256 >= offs[k] && i * 256 < offs[k + 1]) e = k; tile_e[i] = e; }
                for (int i = gw; i < NTOK * 2; i += NGW) {
                    const int e = ids[i]; const int s = offs[e] + rank[i];
                    if (lane == 0) slot_of[i] = s;
                    const v4u* srow = (const v4u*)(a16 + (size_t)(i >> 1) * D_MODEL); v4u* drow = (v4u*)(hs16 + (size_t)s * D_MODEL);
                    const v4u r0 = srow[lane], r1 = srow[64 + lane];
                    drow[lane] = r0; drow[64 + lane] = r1;
                }
                __syncthreads();
                {
                    pg8::Gemm g{p16 + (size_t)l * NTOK * PLE_DIM, (const bf16*)(ws + WS_WPP), NTOK, 1024, 256, 256, 256};
                    pg8::StaticOrder S; S.init(NTOK, 1024, G, (int)blockIdx.x);
                    pg8::EpiBf16<0> E{pp16, 1024, nullptr, 0, 0, 1.f};
                    pg8::gemm_phase<pg8::EpiBf16<0>, pg8::StaticOrder, true, true>((LAS unsigned char*)lds_raw, g, S, E, tid);
                }
                {
                    pg8::Gemm g{a16, (const bf16*)(ws + WS_WPG), NTOK, 1024, 1024, 1024, 1024};
                    pg8::StaticOrder S; S.init(NTOK, 1024, G, (int)blockIdx.x);
                    pg8::EpiPleGate E{ple16, pp16};
                    pg8::gemm_phase<pg8::EpiPleGate, pg8::StaticOrder, true, true>((LAS unsigned char*)lds_raw, g, S, E, tid);
                }
            } else if constexpr (sp == 7) {
                int T = 0; for (int e = 0; e < 32; ++e) T += ((int)cnt[e] + 255) >> 8;
                T = __builtin_amdgcn_readfirstlane(T);
                pg8::Gemm g{hs16, (const bf16*)(ws + WS_WGU), MAX_SLOTS, 32 * 512, 1024, 1024, 1024};
                pg8::GroupSched S{tile_e, T, 2, G, (int)((blockIdx.x % 8) * (G / 8) + blockIdx.x / 8)};
                pg8::EpiGU E{act16};
                pg8::gemm_phase<pg8::EpiGU, pg8::GroupSched, true, true>((LAS unsigned char*)lds_raw, g, S, E, tid);
            } else if constexpr (sp == 8) {
                int T = 0; for (int e = 0; e < 32; ++e) T += ((int)cnt[e] + 255) >> 8;
                T = __builtin_amdgcn_readfirstlane(T);
                pg8::Gemm g{act16, (const bf16*)(ws + WS_WD), MAX_SLOTS, 32 * 1024, 256, 256, 256};
                pg8::GroupSched S{tile_e, T, 4, G, (int)((blockIdx.x % 8) * (G / 8) + blockIdx.x / 8)};
                pg8::EpiDown E{outs16};
                pg8::gemm_phase<pg8::EpiDown, pg8::GroupSched, true, true>((LAS unsigned char*)lds_raw, g, S, E, tid);
            } else if constexpr (sp == 9) {
                for (int tk = gw; tk < NTOK; tk += NGW) {
                    const int s0 = slot_of[tk * 2], s1 = slot_of[tk * 2 + 1]; const float w0 = wts[tk * 2], w1 = wts[tk * 2 + 1];
                    float4 v[4]; float s = 0.f;
#pragma unroll
                    for (int j = 0; j < 4; ++j) {
                        const int d0 = j * 256 + lane * 4;
                        const float4 hv = *(const float4*)(hbuf + (size_t)tk * D_MODEL + d0);
                        const v2u oa = *(const v2u*)(outs16 + (size_t)s0 * D_MODEL + d0), ob = *(const v2u*)(outs16 + (size_t)s1 * D_MODEL + d0);
                        const v2u pv = *(const v2u*)(ple16 + (size_t)tk * D_MODEL + d0);
                        v[j] = make_float4(ALPHA * hv.x + w0 * bflo(oa.x) + w1 * bflo(ob.x) + bflo(pv.x), ALPHA * hv.y + w0 * bfhi(oa.x) + w1 * bfhi(ob.x) + bfhi(pv.x),
                                           ALPHA * hv.z + w0 * bflo(oa.y) + w1 * bflo(ob.y) + bflo(pv.y), ALPHA * hv.w + w0 * bfhi(oa.y) + w1 * bfhi(ob.y) + bfhi(pv.y));
                        s += (v[j].x + v[j].y) + (v[j].z + v[j].w);
                    }
                    const float mean = wave_sum(s) * (1.f / 1024.f); float s2 = 0.f;
#pragma unroll
                    for (int j = 0; j < 4; ++j) { v[j].x -= mean; v[j].y -= mean; v[j].z -= mean; v[j].w -= mean; s2 += (v[j].x * v[j].x + v[j].y * v[j].y) + (v[j].z * v[j].z + v[j].w * v[j].w); }
                    const float rstd = rsqrtf(wave_sum(s2) * (1.f / 1024.f) + LN_EPS);
#pragma unroll
                    for (int j = 0; j < 4; ++j) {
                        const int d0 = j * 256 + lane * 4;
                        const float4 gg = *(const float4*)(ln2_g + d0), bb = *(const float4*)(ln2_b + d0);
                        const float4 o = make_float4(v[j].x * rstd * gg.x + bb.x, v[j].y * rstd * gg.y + bb.y, v[j].z * rstd * gg.z + bb.z, v[j].w * rstd * gg.w + bb.w);
                        *(float4*)(a.out + (size_t)tk * D_MODEL + d0) = o;
                        v2u ob16; ob16.x = pk2(o.x, o.y); ob16.y = pk2(o.z, o.w);
                        *(v2u*)(a16 + (size_t)tk * D_MODEL + d0) = ob16;
                    }
                }
                if (l + 1 < DEPTH) convert_layer_weights(a, l + 1, ws, scr, gw, NGW, lane);
            }
        }
}

__global__ void __launch_bounds__(NTHREADS, 2) mega(Args a) {
    extern __shared__ __attribute__((aligned(16))) unsigned char lds_raw[];
    cg::grid_group grid = cg::this_grid();
#define RUN(ph) if (a.ph_lo <= (ph) && (ph) < a.ph_hi) { run_phase<ph>(a, lds_raw); if ((ph) + 1 < a.ph_hi && (ph) + 1 < NPH) grid.sync(); }
    RUN(0) RUN(1) RUN(2) RUN(3) RUN(4) RUN(5) RUN(6) RUN(7) RUN(8) RUN(9) RUN(10)
    RUN(11) RUN(12) RUN(13) RUN(14) RUN(15) RUN(16) RUN(17) RUN(18) RUN(19) RUN(20)
#undef RUN
}

extern "C" void kernel_launch(void* const* d_in, const int* in_sizes, int n_in, void* d_out, int out_size, void* d_ws, size_t ws_size, hipStream_t stream) {
    static int grid = 0;
    if (grid == 0) {
        if (n_in != 28 || ws_size < WS_END) { fprintf(stderr, "kernel_launch: unexpected n_in %d or ws_size %zu (< %zu)\n", n_in, ws_size, (size_t)WS_END); grid = -1; return; }
        int dev = 0, cus = 0, per_cu = 0;
        (void)hipGetDevice(&dev);
        (void)hipDeviceGetAttribute(&cus, hipDeviceAttributeMultiprocessorCount, dev);
        (void)hipFuncSetAttribute((const void*)mega, hipFuncAttributeMaxDynamicSharedMemorySize, LDS_BYTES);
        (void)hipOccupancyMaxActiveBlocksPerMultiprocessor(&per_cu, (const void*)mega, NTHREADS, LDS_BYTES);
        if (per_cu < 1) { fprintf(stderr, "kernel_launch: occupancy query says %d blocks/CU\n", per_cu); }
        (void)hipGetLastError();
        grid = cus;
    }
    if (grid < 0) return;
    (void)hipMemsetAsync((char*)d_ws + WS_CTL, 0, 64 * 1024, stream);
    Args a{};
    for (int i = 0; i < 28; ++i) a.in[i] = d_in[i];
    a.out = (float*)d_out; a.ws = (unsigned char*)d_ws; a.ph_lo = 0; a.ph_hi = NPH;
    void* params[] = {&a};
    hipError_t e = hipLaunchCooperativeKernel((const void*)mega, dim3(grid), dim3(NTHREADS), params, LDS_BYTES, stream);
    if (e != hipSuccess) fprintf(stderr, "cooperative launch failed: %s (grid %d)\n", hipGetErrorString(e), grid);
}
```

```cpp
#include <hip/hip_runtime.h>
#include <hip/hip_cooperative_groups.h>
#include <cstdio>
#include <cstdint>
namespace cg = cooperative_groups;

constexpr int D_MODEL = 1024, BATCH = 8, SEQ = 2048, NTOK = BATCH * SEQ, DEPTH = 2;
constexpr int D_IN = 2340;
constexpr int OFF_QA = 0, OFF_KA = 384, OFF_VA = 768, OFF_CQ = 1152, OFF_CKV = 1408, OFF_KR = 1536,
              OFF_QC = 1568, OFF_KC = 1824, OFF_VC = 2080, OFF_FC = 2336;
constexpr int ZP = 2560;
constexpr int Z_QA = 0, Z_KA = 384, Z_VA = 768, Z_QC = 1152, Z_KC = 1408, Z_VC = 1664, Z_CKV = 1920, Z_CQ = 2048, Z_KR = 2304, Z_FC = 2336;
constexpr int NQB = 576, NKVB = 768, NQBP = 768;
constexpr int N_EXPERTS = 32, D_EXPERT = 256, PLE_DIM = 256;
constexpr int MAX_SLOTS = 32768 + 32 * 256;
constexpr int NSLOT_TILES = MAX_SLOTS / 256;
constexpr float ALPHA = 1.4142135623730951f;
constexpr float LN_EPS = 1e-5f, RMS_EPS = 1e-6f;
constexpr int NTHREADS = 512;
constexpr int LDS_BYTES = 147456 + 256;

constexpr size_t MiB = 1u << 20;
constexpr size_t WS_CTL = 0;
constexpr size_t WS_COS = 1 * MiB, WS_SIN = 2 * MiB;
constexpr size_t WS_WIN = 3 * MiB;
constexpr size_t WS_WUQ = 8 * MiB;
constexpr size_t WS_WUKV = WS_WUQ + 393216;
constexpr size_t WS_WOUT = 9 * MiB;
constexpr size_t WS_WPG = 11 * MiB;
constexpr size_t WS_WPP = 13 * MiB;
constexpr size_t WS_WGU = 14 * MiB;
constexpr size_t WS_WD = 46 * MiB;
constexpr size_t WS_A16 = 62 * MiB;
constexpr size_t WS_P16 = 94 * MiB;
constexpr size_t WS_Z16 = 110 * MiB;
constexpr size_t WS_HS16 = WS_Z16;
constexpr size_t WS_OUTS16 = WS_Z16;
constexpr size_t WS_QB16 = 190 * MiB;
constexpr size_t WS_KVB16 = 214 * MiB;
constexpr size_t WS_KRR16 = 238 * MiB;
constexpr size_t WS_FC = 239 * MiB;
constexpr size_t WS_CUM = WS_FC + 256 * 1024;
constexpr size_t WS_LOGF = WS_CUM + 256 * 1024;
constexpr size_t WS_RQ = WS_LOGF + 256 * 1024;
constexpr size_t WS_RKV = WS_RQ + 64 * 1024;
constexpr size_t WS_MIX16 = 190 * MiB;
constexpr size_t WS_PP16 = 190 * MiB;
constexpr size_t WS_ACT16 = 222 * MiB;
constexpr size_t WS_MIXED16 = 242 * MiB;
constexpr size_t WS_PLE16 = 242 * MiB;
constexpr size_t WS_RT = 274 * MiB;
constexpr size_t WS_END = 276 * MiB;
constexpr size_t RT_IDS = 0, RT_WTS = 128 * 1024, RT_RANK = 256 * 1024, RT_SLOTOF = 384 * 1024, RT_TILEE = 768 * 1024, RT_TPMAX = 800 * 1024;
constexpr int CW_CNT = 0;
static_assert((WS_A16 - WS_HS16) % (256 * 1024 * 2) == 0 || true, "");

struct Args { const void* in[28]; float* out; unsigned char* ws; int ph_lo, ph_hi; };

#define LAS __attribute__((address_space(3)))
typedef unsigned short bf16;
typedef unsigned v4u __attribute__((ext_vector_type(4)));
typedef unsigned v2u __attribute__((ext_vector_type(2)));
typedef float f32x4_t __attribute__((ext_vector_type(4)));

__device__ __forceinline__ float wave_sum(float v) {
#pragma unroll
    for (int o = 1; o < 64; o <<= 1) v += __shfl_xor(v, o);
    return v;
}
__device__ __forceinline__ unsigned f2bf(float f) { unsigned u = __builtin_bit_cast(unsigned, f); return (u + 0x7fffu + ((u >> 16) & 1u)) >> 16; }
__device__ __forceinline__ unsigned pk2(float lo, float hi) { return f2bf(lo) | (f2bf(hi) << 16); }
__device__ __forceinline__ float bflo(unsigned w) { return __uint_as_float(w << 16); }
__device__ __forceinline__ float bfhi(unsigned w) { return __uint_as_float(w & 0xffff0000u); }
__device__ __forceinline__ void unpack8(const v4u w, float* f) { f[0] = bflo(w.x); f[1] = bfhi(w.x); f[2] = bflo(w.y); f[3] = bfhi(w.y); f[4] = bflo(w.z); f[5] = bfhi(w.z); f[6] = bflo(w.w); f[7] = bfhi(w.w); }
__device__ __forceinline__ int lane_id_now() { int l; asm volatile("v_mbcnt_lo_u32_b32 %0, -1, 0\n\tv_mbcnt_hi_u32_b32 %0, -1, %0" : "=v"(l)); return l; }
namespace pg8 {
#define PG8_LAS __attribute__((address_space(3)))
typedef unsigned short bf16_t;
typedef short bf16x8 __attribute__((ext_vector_type(8)));
typedef float f32x4 __attribute__((ext_vector_type(4)));
typedef unsigned u32x4 __attribute__((ext_vector_type(4)));
constexpr int BM = 256, BK = 64, HALF = 128, HTB = HALF * BK * 2  , STAGE_BYTES = 8 * HTB, NXCD = 8, WGM = 8;

__host__ __device__ __forceinline__ int lds_byte(int r, int c) { const int st = (r >> 4) * 2 + (c >> 5), rr = r & 15, cc = c & 31, ob = rr * 64 + cc * 2; return st * 1024 + (ob ^ (((ob >> 9) & 1) << 5)); }
__host__ __device__ __forceinline__ void stage_rc(int b, int& R, int& C) { const int st = b / 1024, sb = b % 1024, swz = sb ^ (((sb >> 9) & 1) << 5); R = (st >> 1) * 16 + swz / 64; C = (st & 1) * 32 + (swz % 64) / 2; }
__host__ __device__ __forceinline__ int perm32(int rho) { const int n = rho >> 4, i = rho & 15; return 8 * (i >> 2) + 4 * n + (i & 3); }

struct Unit { int pm, pn; };
struct Gemm { const bf16_t* A; const bf16_t* Bt; int M, N, K, lda, ldb; };

struct StaticOrder {
    int nM, nN, nwg, G, c;
    __host__ __device__ void init(int M, int N, int G_, int c_) { nM = M / BM; nN = N / BM; nwg = nM * nN; G = G_; c = c_; }
    __host__ __device__ bool next(int i, Unit& u) const {
        const long L = (long)i * G + c; if (L >= nwg) return false;
        int wgid = (int)L; { const int q = nwg / NXCD, r = nwg % NXCD, xcd = wgid % NXCD, off = wgid / NXCD; wgid = (xcd < r ? xcd * (q + 1) : r * (q + 1) + (xcd - r) * q) + off; }
        const int nig = WGM * nN, gid = wgid / nig, fm = gid * WGM, gsz = (nM - fm) < WGM ? (nM - fm) : WGM;
        u.pm = fm + ((wgid % nig) % gsz); u.pn = (wgid % nig) / gsz; return true;
    }
    __device__ __forceinline__ void a_ready(const Unit&) const {}
    __device__ __forceinline__ void done(const Unit&) const {}
};

__device__ __forceinline__ unsigned cvt_pk_bf16(float lo, float hi) { unsigned r; asm volatile("v_cvt_pk_bf16_f32 %0, %1, %2" : "=v"(r) : "v"(lo), "v"(hi)); return r; }
typedef float f32x2 __attribute__((ext_vector_type(2)));
__device__ __forceinline__ f32x2 gelu_pk(f32x2 v) {
    const f32x2 av = __builtin_elementwise_abs(v), d = av * 0.2316418882f + 1.0f;
    f32x2 t; t.x = __builtin_amdgcn_rcpf(d.x); t.y = __builtin_amdgcn_rcpf(d.y);
    f32x2 q = t * 0.5307027145f + (-0.7265760135f); q = q * t + 0.7107068705f; q = q * t + (-0.142248368f); q = q * t + 0.127414796f; q = q * t;
    const f32x2 s = (v * v) * (-0.72134752044f);
    f32x2 e; e.x = __builtin_amdgcn_exp2f(s.x); e.y = __builtin_amdgcn_exp2f(s.y);
    const f32x2 m = v * (q * e), r = v - m;
    f32x2 o; o.x = v.x < 0.f ? m.x : r.x; o.y = v.y < 0.f ? m.y : r.y; return o;
}

template <int ACT  > struct EpiBf16 {
    static constexpr bool PERM = true, AFTER_DRAIN = false; static_assert(ACT == 0 || ACT == 1, "EpiBf16: ACT is 0 (none) or 1 (gelu_pk)");
    bf16_t* O; int ldc; const float* bias; int split_cols; size_t split_stride; float scale0;
    __device__ __forceinline__ void operator()(const f32x4 (&acc)[2][2][4][2], const Unit& u, int wr, int wc, int fr, int fq) const {
        const int row0 = u.pm * BM + wr * 64 + fr; int colt = u.pn * BM; bf16_t* base = O;
        float sc = 1.f; if (split_cols) { const int t = colt / split_cols; base += (size_t)t * split_stride; colt -= t * split_cols; if (t == 0) sc = scale0; }
        const int col0 = colt + wc * 32 + 8 * fq, bcol0 = u.pn * BM + wc * 32 + 8 * fq;
        f32x4 bv[2][2];
#pragma unroll
        for (int bj = 0; bj < 2; ++bj)
#pragma unroll
            for (int n = 0; n < 2; ++n) bv[bj][n] = bias ? *(const f32x4*)(bias + bcol0 + bj * HALF + 4 * n) : (f32x4){0.f, 0.f, 0.f, 0.f};
#pragma unroll
        for (int ai = 0; ai < 2; ++ai)
#pragma unroll
            for (int m = 0; m < 4; ++m) { bf16_t* rowp = base + (size_t)(row0 + ai * HALF + m * 16) * ldc + col0;
#pragma unroll
                for (int bj = 0; bj < 2; ++bj) { f32x4 v0 = acc[ai][bj][m][0] + bv[bj][0], v1 = acc[ai][bj][m][1] + bv[bj][1];
                    if (ACT == 1) { f32x2 a = gelu_pk((f32x2){v0[0], v0[1]}), b = gelu_pk((f32x2){v0[2], v0[3]}), c = gelu_pk((f32x2){v1[0], v1[1]}), d = gelu_pk((f32x2){v1[2], v1[3]});
                        v0 = (f32x4){a.x, a.y, b.x, b.y}; v1 = (f32x4){c.x, c.y, d.x, d.y}; }
                    v0 = v0 * sc; v1 = v1 * sc; u32x4 w; w.x = cvt_pk_bf16(v0[0], v0[1]); w.y = cvt_pk_bf16(v0[2], v0[3]); w.z = cvt_pk_bf16(v1[0], v1[1]); w.w = cvt_pk_bf16(v1[2], v1[3]);
                    *(u32x4*)(rowp + bj * HALF) = w; } }
    }
};
template <class Epi, class Sched, bool ALIGN_EPI = false, bool SP2 = false>
__device__ __forceinline__ void gemm_phase(PG8_LAS unsigned char* lds, const Gemm g, const Sched& S, const Epi& E, const int tid) {
    const int wid = __builtin_amdgcn_readfirstlane(tid >> 6), lane = tid & 63, wr = wid >> 2, wc = wid & 3, fr = lane & 15, fq = lane >> 4;
    int K = g.K; asm volatile("" : "+s"(K));
    const int nt = K / BK;
    unsigned voffA[2], voffB[2];
#pragma unroll
    for (int i = 0; i < 2; ++i) { int R, C; stage_rc(tid * 16 + i * 8192, R, C); const int Rb = Epi::PERM ? ((R & ~31) + perm32(R & 31)) : R;
        voffA[i] = (unsigned)(R * g.lda + C) * 2u; voffB[i] = (unsigned)(Rb * g.ldb + C) * 2u; }
    const size_t kstep = (size_t)(BK * 2);
    const size_t hstepA = (size_t)HALF * g.lda * 2, hstepB = (size_t)HALF * g.ldb * 2;
    const size_t tstepA = 2 * hstepA, tstepB = 2 * hstepB;
    const unsigned ldsw = (unsigned)wid * 1024u;
    const int aoff = lds_byte(wr * 64 + fr, fq * 8), boff = lds_byte(wc * 32 + fr, fq * 8);
#define PG8_SA(b, h) (((b) * 2 + (h)) * HTB)
#define PG8_SB(b, h) ((4 + (b) * 2 + (h)) * HTB)
#define PG8_STAGE(bufoff, gbase, voff) do { _Pragma("unroll") for (int _i = 0; _i < 2; ++_i) \
        __builtin_amdgcn_global_load_lds((const unsigned*)((const char*)(gbase) + (voff)[_i]), (PG8_LAS unsigned*)(lds + (bufoff) + ldsw + _i * 8192), 16, 0, 0); } while (0)
#define PG8_LDA(dst, b, h) do { _Pragma("unroll") for (int m = 0; m < 4; ++m) _Pragma("unroll") for (int k = 0; k < 2; ++k) dst[m][k] = *(const PG8_LAS bf16x8*)(lds + PG8_SA(b, h) + aoff + m * 2048 + k * 1024); } while (0)
#define PG8_LDB(dst, b, h) do { _Pragma("unroll") for (int n = 0; n < 2; ++n) _Pragma("unroll") for (int k = 0; k < 2; ++k) dst[n][k] = *(const PG8_LAS bf16x8*)(lds + PG8_SB(b, h) + boff + n * 2048 + k * 1024); } while (0)
#define PG8_MMA(ai, bj, At, Bt) do { __builtin_amdgcn_s_setprio(1); _Pragma("unroll") for (int m = 0; m < 4; ++m) _Pragma("unroll") for (int n = 0; n < 2; ++n) _Pragma("unroll") for (int k = 0; k < 2; ++k) \
        acc[ai][bj][m][n] = __builtin_amdgcn_mfma_f32_16x16x32_bf16(Bt[n][k], At[m][k], acc[ai][bj][m][n], 0, 0, 0); __builtin_amdgcn_s_setprio(0); } while (0)
#define PG8_WAIT_V(n) asm volatile("s_waitcnt vmcnt(" #n ")" ::: "memory")
#define PG8_WAIT_L(n) asm volatile("s_waitcnt lgkmcnt(" #n ")" ::: "memory")
#define PG8_BAR __builtin_amdgcn_s_barrier()
#define PG8_SCHED __builtin_amdgcn_sched_barrier(0)
    Unit cur, nxt; int ui = 0;
    if (!S.next(0, cur)) return;
    f32x4 acc[2][2][4][2];
#pragma unroll
    for (int a = 0; a < 2; ++a)
#pragma unroll
        for (int b = 0; b < 2; ++b)
#pragma unroll
            for (int m = 0; m < 4; ++m)
#pragma unroll
                for (int n = 0; n < 2; ++n) acc[a][b][m][n] = (f32x4){0.f, 0.f, 0.f, 0.f};
    bf16x8 At[4][2], B0[2][2], B1[2][2];
    const char* cA = (const char*)g.A + (size_t)cur.pm * tstepA; const char* cB = (const char*)g.Bt + (size_t)cur.pn * tstepB;
    S.a_ready(cur);
    if constexpr (SP2) {
        PG8_STAGE(PG8_SB(0, 0), cB, voffB); PG8_STAGE(PG8_SB(0, 1), cB + hstepB, voffB); PG8_STAGE(PG8_SA(0, 0), cA, voffA); PG8_STAGE(PG8_SA(0, 1), cA + hstepA, voffA);
        if (wr == 1) PG8_BAR;
        PG8_WAIT_V(2); PG8_BAR;
        PG8_STAGE(PG8_SB(1, 0), cB + kstep, voffB); PG8_STAGE(PG8_SA(1, 0), cA + kstep, voffA); PG8_STAGE(PG8_SB(1, 1), cB + hstepB + kstep, voffB);
        PG8_WAIT_V(6); PG8_BAR;
    } else {
        PG8_STAGE(PG8_SB(0, 0), cB, voffB); PG8_STAGE(PG8_SA(0, 0), cA, voffA); PG8_STAGE(PG8_SB(0, 1), cB + hstepB, voffB); PG8_STAGE(PG8_SA(0, 1), cA + hstepA, voffA);
        if (wr == 1) PG8_BAR;
        PG8_WAIT_V(4); PG8_BAR;
        PG8_STAGE(PG8_SB(1, 0), cB + kstep, voffB); PG8_STAGE(PG8_SA(1, 0), cA + kstep, voffA); PG8_STAGE(PG8_SB(1, 1), cB + hstepB + kstep, voffB);
        PG8_WAIT_V(6); PG8_BAR;
    }
    for (;;) {
        const bool has_next = S.next(ui + 1, nxt);
        const char* nA = has_next ? (const char*)g.A + (size_t)nxt.pm * tstepA : cA; const char* nB = has_next ? (const char*)g.Bt + (size_t)nxt.pn * tstepB : cB;
        for (int t = 0; t < nt; t += 2) {
            const bool last = (t == nt - 2);
            const char* a1 = cA + (size_t)(t + 1) * kstep;
            const char* a2 = last ? nA : cA + (size_t)(t + 2) * kstep; const char* b2 = last ? nB : cB + (size_t)(t + 2) * kstep;
            const char* a3 = a2 + kstep; const char* b3 = b2 + kstep;
            if (last && has_next) S.a_ready(nxt);
            if constexpr (SP2) {
            PG8_LDB(B0, 0, 0); PG8_LDB(B1, 0, 1); PG8_SCHED; PG8_LDA(At, 0, 0); PG8_STAGE(PG8_SA(1, 1), a1 + hstepA, voffA);
            PG8_WAIT_V(8); PG8_WAIT_L(0); PG8_BAR; PG8_MMA(0, 0, At, B0); PG8_MMA(0, 1, At, B1); PG8_BAR; PG8_SCHED;
            PG8_LDA(At, 0, 1); PG8_STAGE(PG8_SB(0, 0), b2, voffB); PG8_STAGE(PG8_SB(0, 1), b2 + hstepB, voffB); PG8_STAGE(PG8_SA(0, 0), a2, voffA);
            PG8_WAIT_V(8); PG8_WAIT_L(0); PG8_BAR; PG8_MMA(1, 0, At, B0); PG8_MMA(1, 1, At, B1); PG8_BAR; PG8_SCHED;
            PG8_LDB(B0, 1, 0); PG8_LDB(B1, 1, 1); PG8_SCHED; PG8_LDA(At, 1, 0); PG8_STAGE(PG8_SA(0, 1), a2 + hstepA, voffA);
            PG8_WAIT_V(8); PG8_WAIT_L(0); PG8_BAR; PG8_MMA(0, 0, At, B0); PG8_MMA(0, 1, At, B1); PG8_BAR; PG8_SCHED;
            PG8_LDA(At, 1, 1); PG8_STAGE(PG8_SB(1, 0), b3, voffB); PG8_STAGE(PG8_SB(1, 1), b3 + hstepB, voffB); PG8_STAGE(PG8_SA(1, 0), a3, voffA);
            PG8_WAIT_V(8); PG8_WAIT_L(0); PG8_BAR; PG8_MMA(1, 0, At, B0); PG8_MMA(1, 1, At, B1); PG8_BAR; PG8_SCHED;
            } else {
            PG8_LDB(B0, 0, 0); PG8_SCHED; PG8_LDA(At, 0, 0); PG8_STAGE(PG8_SA(1, 1), a1 + hstepA, voffA);
            PG8_WAIT_L(8); PG8_BAR; PG8_WAIT_L(0); PG8_MMA(0, 0, At, B0); PG8_BAR; PG8_SCHED;
            PG8_LDB(B1, 0, 1); PG8_STAGE(PG8_SB(0, 0), b2, voffB);
            PG8_BAR; PG8_WAIT_L(0); PG8_MMA(0, 1, At, B1); PG8_BAR;
            PG8_LDA(At, 0, 1); PG8_STAGE(PG8_SA(0, 0), a2, voffA);
            PG8_BAR; PG8_WAIT_L(0); PG8_MMA(1, 0, At, B0); PG8_BAR; PG8_SCHED;
            PG8_STAGE(PG8_SB(0, 1), b2 + hstepB, voffB);
            PG8_WAIT_V(6); PG8_BAR; PG8_MMA(1, 1, At, B1); PG8_BAR;
            PG8_LDB(B0, 1, 0); PG8_SCHED; PG8_LDA(At, 1, 0); PG8_STAGE(PG8_SA(0, 1), a2 + hstepA, voffA);
            PG8_WAIT_L(8); PG8_BAR; PG8_WAIT_L(0); PG8_MMA(0, 0, At, B0); PG8_BAR; PG8_SCHED;
            PG8_LDB(B1, 1, 1); PG8_STAGE(PG8_SB(1, 0), b3, voffB);
            PG8_BAR; PG8_WAIT_L(0); PG8_MMA(0, 1, At, B1); PG8_BAR;
            PG8_LDA(At, 1, 1); PG8_STAGE(PG8_SA(1, 0), a3, voffA);
            PG8_BAR; PG8_WAIT_L(0); PG8_MMA(1, 0, At, B0); PG8_BAR; PG8_SCHED;
            PG8_STAGE(PG8_SB(1, 1), b3 + hstepB, voffB);
            PG8_WAIT_V(6); PG8_BAR; PG8_MMA(1, 1, At, B1); PG8_BAR;
            }
        }
        if constexpr (ALIGN_EPI) { if (wr == 0) PG8_BAR; }
        if constexpr (!Epi::AFTER_DRAIN) { E(acc, cur, wr, wc, fr, fq); S.done(cur); }
        if (!has_next) break;
#pragma unroll
        for (int a = 0; a < 2; ++a)
#pragma unroll
            for (int b = 0; b < 2; ++b)
#pragma unroll
                for (int m = 0; m < 4; ++m)
#pragma unroll
                    for (int n = 0; n < 2; ++n) acc[a][b][m][n] = (f32x4){0.f, 0.f, 0.f, 0.f};
        cur = nxt; cA = nA; cB = nB; ++ui;
        if constexpr (ALIGN_EPI) { if (wr == 1) PG8_BAR; }
    }
    PG8_WAIT_V(0);
    if constexpr (!ALIGN_EPI) { if (wr == 0) PG8_BAR; }
    PG8_BAR;
    if constexpr (Epi::AFTER_DRAIN) { E.fused(acc, cur, wr, wc, fr, fq, lds, wid, lane); S.done(cur); }
#undef PG8_SA
#undef PG8_SB
#undef PG8_STAGE
#undef PG8_LDA
#undef PG8_LDB
#undef PG8_MMA
#undef PG8_WAIT_V
#undef PG8_WAIT_L
#undef PG8_BAR
#undef PG8_SCHED
}
}
#define XB_TMO      128
#define XB_XCNT(j)  (256  + 64 * (j))
#define XB_XSUB(j)  (1280 + 64 * (j))
#define XB_XGEN(j)  (2304 + 64 * (j))
#define XB_TOP      3328
#define XB_TOPGEN   3392
#define XCD_BAR_WORDS 3456
#define XB_SPIN_CAP (1u << 18)

__device__ __forceinline__ unsigned xb_ld(unsigned* p)              { return __hip_atomic_load(p, __ATOMIC_RELAXED, __HIP_MEMORY_SCOPE_AGENT); }
__device__ __forceinline__ unsigned xb_add(unsigned* p, unsigned v) { return __hip_atomic_fetch_add(p, v, __ATOMIC_RELAXED, __HIP_MEMORY_SCOPE_AGENT); }
__device__ __forceinline__ unsigned xb_xcc_id() { return (unsigned)__builtin_amdgcn_s_getreg((3 << 11) | 20) & 0xFu; }
#define XB_SPIN(cond, bar) do { unsigned _sp = 0; while (cond) { __builtin_amdgcn_s_sleep(1); \
    if ((++_sp & 255u) == 0u) { if (xb_ld(&(bar)[XB_TMO])) break; if (_sp > XB_SPIN_CAP) { atomicAdd(&(bar)[XB_TMO], 1u); break; } } } } while (0)

struct XcdBarrier {
    unsigned* bar; unsigned x;
    volatile LAS unsigned* st;
};

__device__ __forceinline__ XcdBarrier xcd_barrier_post(unsigned* bar, volatile LAS unsigned* st) {
    XcdBarrier b; b.bar = bar; b.x = xb_xcc_id(); b.st = st;
    if (threadIdx.x == 0) (void)xb_add(&bar[XB_XCNT(b.x)], 1u);
    return b;
}
__device__ __forceinline__ void xcd_barrier_complete(unsigned* bar, unsigned x, unsigned& nloc, unsigned& nx) {
    const unsigned G = gridDim.x * gridDim.y * gridDim.z;
    unsigned sum, cnt, mine, sp = 0u;
    for (;;) {
        sum = 0u; cnt = 0u; mine = 0u;
#pragma unroll
        for (unsigned j = 0; j < 16; ++j) { const unsigned c = xb_ld(&bar[XB_XCNT(j)]); sum += c; cnt += (c > 0u) ? 1u : 0u; mine = (j == x) ? c : mine; }
        if (sum == G) break;
        __builtin_amdgcn_s_sleep(1);
        if ((++sp & 255u) == 0u) { if (xb_ld(&bar[XB_TMO])) break; if (sp > XB_SPIN_CAP) { atomicAdd(&bar[XB_TMO], 1u); break; } }
    }
    nloc = mine > 0u ? mine : 1u; nx = cnt > 0u ? cnt : 1u;
}

__device__ __forceinline__ void xcd_barrier(const XcdBarrier& b, const bool is_t0) {
    asm volatile("s_waitcnt vmcnt(0)" ::: "memory");
    __syncthreads();
    if (is_t0) {
        unsigned* bar = b.bar;
        __builtin_amdgcn_s_waitcnt(0);
        unsigned nloc = b.st[0], nx = b.st[1];
        if (nloc == 0u) { xcd_barrier_complete(bar, b.x, nloc, nx); b.st[0] = nloc; b.st[1] = nx; }
        const unsigned old = xb_add(&bar[XB_XSUB(b.x)], 1u);
        const unsigned gen = old / nloc;
        if (old + 1u == (gen + 1u) * nloc) {
            __builtin_amdgcn_fence(__ATOMIC_RELEASE, "agent");
            asm volatile("s_waitcnt vmcnt(0)" ::: "memory");
            const unsigned og = xb_add(&bar[XB_TOP], 1u);
            const unsigned tg = og / nx;
            if (og + 1u == (tg + 1u) * nx) xb_add(&bar[XB_TOPGEN], 1u);
            else XB_SPIN(xb_ld(&bar[XB_TOPGEN]) == tg, bar);
            __builtin_amdgcn_fence(__ATOMIC_ACQUIRE, "agent");
            xb_add(&bar[XB_XGEN(b.x)], 1u);
            asm volatile("s_waitcnt vmcnt(0)" ::: "memory");
        } else {
            XB_SPIN(xb_ld(&bar[XB_XGEN(b.x)]) == gen, bar);
            __builtin_amdgcn_fence(__ATOMIC_ACQUIRE, "agent");
            asm volatile("s_waitcnt vmcnt(0)" ::: "memory");
        }
    }
    __syncthreads();
}


namespace pg8 {
struct EpiZ {
    static constexpr bool PERM = true, AFTER_DRAIN = false;
    bf16_t* O; int ldc; float* fcbuf;
    __device__ __forceinline__ void operator()(const f32x4 (&acc)[2][2][4][2], const Unit& u, int wr, int wc, int fr, int fq) const {
        const int row0 = u.pm * BM + wr * 64 + fr, col0 = u.pn * BM + wc * 32 + 8 * fq;
        const bool fcl = (u.pn == 9) && (wc == 1) && (fq == 0);
#pragma unroll
        for (int ai = 0; ai < 2; ++ai)
#pragma unroll
            for (int m = 0; m < 4; ++m) {
                const int row = row0 + ai * HALF + m * 16;
                bf16_t* rowp = O + (size_t)row * ldc + col0;
#pragma unroll
                for (int bj = 0; bj < 2; ++bj) {
                    const f32x4 v0 = acc[ai][bj][m][0], v1 = acc[ai][bj][m][1];
                    u32x4 w; w.x = cvt_pk_bf16(v0[0], v0[1]); w.y = cvt_pk_bf16(v0[2], v0[3]); w.z = cvt_pk_bf16(v1[0], v1[1]); w.w = cvt_pk_bf16(v1[2], v1[3]);
                    *(u32x4*)(rowp + bj * HALF) = w;
                }
                if (fcl) *(f32x4*)(fcbuf + (size_t)row * 4) = acc[ai][0][m][0];
            }
    }
};
struct EpiRowScale {
    static constexpr bool PERM = true, AFTER_DRAIN = false;
    bf16_t* O; int ldc; const float* rs;
    __device__ __forceinline__ void operator()(const f32x4 (&acc)[2][2][4][2], const Unit& u, int wr, int wc, int fr, int fq) const {
        const int row0 = u.pm * BM + wr * 64 + fr, col0 = u.pn * BM + wc * 32 + 8 * fq;
#pragma unroll
        for (int ai = 0; ai < 2; ++ai)
#pragma unroll
            for (int m = 0; m < 4; ++m) {
                const int row = row0 + ai * HALF + m * 16;
                const float s = rs[row];
                bf16_t* rowp = O + (size_t)row * ldc + col0;
#pragma unroll
                for (int bj = 0; bj < 2; ++bj) {
                    const f32x4 v0 = acc[ai][bj][m][0] * s, v1 = acc[ai][bj][m][1] * s;
                    u32x4 w; w.x = cvt_pk_bf16(v0[0], v0[1]); w.y = cvt_pk_bf16(v0[2], v0[3]); w.z = cvt_pk_bf16(v1[0], v1[1]); w.w = cvt_pk_bf16(v1[2], v1[3]);
                    *(u32x4*)(rowp + bj * HALF) = w;
                }
            }
    }
};
struct EpiGU {
    static constexpr bool PERM = true, AFTER_DRAIN = false;
    bf16_t* O;
    __device__ __forceinline__ void operator()(const f32x4 (&acc)[2][2][4][2], const Unit& u, int wr, int wc, int fr, int fq) const {
        const int row0 = u.pm * BM + wr * 64 + fr, f0 = ((u.pn & 1) * BM + wc * 32 + 8 * fq) >> 1;
#pragma unroll
        for (int ai = 0; ai < 2; ++ai)
#pragma unroll
            for (int m = 0; m < 4; ++m) {
                bf16_t* rowp = O + (size_t)(row0 + ai * HALF + m * 16) * 256 + f0;
#pragma unroll
                for (int bj = 0; bj < 2; ++bj) {
                    const f32x4 v0 = acc[ai][bj][m][0], v1 = acc[ai][bj][m][1];
                    const float a0 = v0[0] / (1.f + __expf(-v0[0])) * v0[1], a1 = v0[2] / (1.f + __expf(-v0[2])) * v0[3];
                    const float a2 = v1[0] / (1.f + __expf(-v1[0])) * v1[1], a3 = v1[2] / (1.f + __expf(-v1[2])) * v1[3];
                    typedef unsigned u32x2 __attribute__((ext_vector_type(2)));
                    u32x2 w; w.x = cvt_pk_bf16(a0, a1); w.y = cvt_pk_bf16(a2, a3);
                    *(u32x2*)(rowp + bj * (HALF / 2)) = w;
                }
            }
    }
};
struct EpiPleGate {
    static constexpr bool PERM = true, AFTER_DRAIN = false;
    bf16_t* O; const bf16_t* PP;
    __device__ __forceinline__ void operator()(const f32x4 (&acc)[2][2][4][2], const Unit& u, int wr, int wc, int fr, int fq) const {
        const int row0 = u.pm * BM + wr * 64 + fr, col0 = u.pn * BM + wc * 32 + 8 * fq;
#pragma unroll
        for (int ai = 0; ai < 2; ++ai)
#pragma unroll
            for (int m = 0; m < 4; ++m) {
                const size_t off = (size_t)(row0 + ai * HALF + m * 16) * 1024 + col0;
#pragma unroll
                for (int bj = 0; bj < 2; ++bj) {
                    const f32x4 v0 = acc[ai][bj][m][0], v1 = acc[ai][bj][m][1];
                    const u32x4 pw = *(const u32x4*)(PP + off + bj * HALF);
                    float o[8];
                    o[0] = __uint_as_float(pw.x << 16) / (1.f + __expf(-v0[0])); o[1] = __uint_as_float(pw.x & 0xffff0000u) / (1.f + __expf(-v0[1]));
                    o[2] = __uint_as_float(pw.y << 16) / (1.f + __expf(-v0[2])); o[3] = __uint_as_float(pw.y & 0xffff0000u) / (1.f + __expf(-v0[3]));
                    o[4] = __uint_as_float(pw.z << 16) / (1.f + __expf(-v1[0])); o[5] = __uint_as_float(pw.z & 0xffff0000u) / (1.f + __expf(-v1[1]));
                    o[6] = __uint_as_float(pw.w << 16) / (1.f + __expf(-v1[2])); o[7] = __uint_as_float(pw.w & 0xffff0000u) / (1.f + __expf(-v1[3]));
                    u32x4 w; w.x = cvt_pk_bf16(o[0], o[1]); w.y = cvt_pk_bf16(o[2], o[3]); w.z = cvt_pk_bf16(o[4], o[5]); w.w = cvt_pk_bf16(o[6], o[7]);
                    *(u32x4*)(O + off + bj * HALF) = w;
                }
            }
    }
};
struct EpiDown {
    static constexpr bool PERM = true, AFTER_DRAIN = false;
    bf16_t* O;
    __device__ __forceinline__ void operator()(const f32x4 (&acc)[2][2][4][2], const Unit& u, int wr, int wc, int fr, int fq) const {
        const int row0 = u.pm * BM + wr * 64 + fr, col0 = (u.pn & 3) * BM + wc * 32 + 8 * fq;
#pragma unroll
        for (int ai = 0; ai < 2; ++ai)
#pragma unroll
            for (int m = 0; m < 4; ++m) {
                bf16_t* rowp = O + (size_t)(row0 + ai * HALF + m * 16) * 1024 + col0;
#pragma unroll
                for (int bj = 0; bj < 2; ++bj) {
                    const f32x4 v0 = acc[ai][bj][m][0], v1 = acc[ai][bj][m][1];
                    u32x4 w; w.x = cvt_pk_bf16(v0[0], v0[1]); w.y = cvt_pk_bf16(v0[2], v0[3]); w.z = cvt_pk_bf16(v1[0], v1[1]); w.w = cvt_pk_bf16(v1[2], v1[3]);
                    *(u32x4*)(rowp + bj * HALF) = w;
                }
            }
    }
};
struct GroupSched {
    const int* tile_e; int T, NJ, G, vc;
    __device__ __forceinline__ bool next(int i, Unit& u) const {
        const long L = (long)i * G + vc; if (L >= (long)T * NJ) return false;
        const int t = (int)(L / NJ), j = (int)(L % NJ);
        u.pm = t; u.pn = __builtin_amdgcn_readfirstlane(tile_e[t]) * NJ + j; return true;
    }
    __device__ __forceinline__ void a_ready(const Unit&) const {}
    __device__ __forceinline__ void done(const Unit&) const {}
};
}

template <class Map>
__device__ __forceinline__ void transpose_rows(const Map mp, const float* ks, int nrows_out, int K, bf16* WT, LAS float* scr, int gw, int NGW, int lane) {
    const int nblk = nrows_out / 32, nitems = (K / 64) * nblk;
    const int f = lane & 7, kr = lane >> 3;
    for (int it = gw; it < nitems; it += NGW) {
        const int kb = it / nblk, nb = it % nblk, k0 = 64 * kb, n0 = 32 * nb;
        const float* src; long pitch; float sc; int nl0, nls;
        mp.get4(n0, f, src, pitch, sc, nl0, nls);
        f32x4_t vals[8];
#pragma unroll
        for (int i = 0; i < 8; ++i) vals[i] = src ? *(const f32x4_t*)(src + (size_t)(k0 + kr + 8 * i) * pitch) : (f32x4_t){0.f, 0.f, 0.f, 0.f};
#pragma unroll
        for (int i = 0; i < 8; ++i) {
            const int kk = kr + 8 * i;
            float m = sc; if (ks) m *= ks[k0 + kk];
            scr[kk * 33 + nl0] = vals[i].x * m; scr[kk * 33 + nl0 + nls] = vals[i].y * m; scr[kk * 33 + nl0 + 2 * nls] = vals[i].z * m; scr[kk * 33 + nl0 + 3 * nls] = vals[i].w * m;
        }
        asm volatile("s_waitcnt lgkmcnt(0)" ::: "memory");
        const int c = lane & 7;
#pragma unroll
        for (int j = 0; j < 4; ++j) {
            const int n = (lane >> 3) + 8 * j; const LAS float* s = scr + (8 * c) * 33 + n;
            v4u o; o.x = pk2(s[0 * 33], s[1 * 33]); o.y = pk2(s[2 * 33], s[3 * 33]); o.z = pk2(s[4 * 33], s[5 * 33]); o.w = pk2(s[6 * 33], s[7 * 33]);
            *(v4u*)(WT + (size_t)(n0 + n) * K + k0 + 8 * c) = o;
        }
        asm volatile("s_waitcnt lgkmcnt(0)" ::: "memory");
    }
}
constexpr float LOG2E_W = 1.4426950408889634f;
struct MapIn {
    const float* w;
    __device__ __forceinline__ void get(int n, const float*& src, long& pitch, float& sc) const {
        int c;
        if (n < 1152) c = n;
        else if (n < Z_CKV) c = OFF_QC + (n - Z_QC);
        else if (n < Z_CQ) c = OFF_CKV + (n - Z_CKV);
        else if (n < Z_KR) c = OFF_CQ + (n - Z_CQ);
        else if (n < Z_FC) c = OFF_KR + (n - Z_KR);
        else if (n < Z_FC + 4) c = OFF_FC + (n - Z_FC);
        else c = -1;
        src = c >= 0 ? w + c : nullptr; pitch = D_IN;
        sc = n < Z_KA ? 0.17677669529663687f * LOG2E_W : ((n >= Z_QC && n < Z_KC) ? 0.125f * LOG2E_W : 1.f);
    }
    __device__ __forceinline__ void get4(int n0, int f, const float*& src, long& pitch, float& sc, int& nl0, int& nls) const { get(n0 + 4 * f, src, pitch, sc); nl0 = 4 * f; nls = 1; }
};
struct MapPlain {
    const float* w; int N, nvalid; float scale;
    __device__ __forceinline__ void get(int n, const float*& src, long& pitch, float& sc) const { src = n < nvalid ? w + n : nullptr; pitch = N; sc = scale; }
    __device__ __forceinline__ void get4(int n0, int f, const float*& src, long& pitch, float& sc, int& nl0, int& nls) const { get(n0 + 4 * f, src, pitch, sc); nl0 = 4 * f; nls = 1; }
};

struct MapGU {
    const float* wg; const float* wu;
    __device__ __forceinline__ void get(int n, const float*& src, long& pitch, float& sc) const {
        const int e = n >> 9, r = n & 511, f = r >> 1;
        const long dlt = (r & 1) ? (long)(wu - wg) : 0l;
        src = wg + dlt + (size_t)e * 1024 * 256 + f; pitch = 256; sc = 1.f;
    }
    __device__ __forceinline__ void get4(int n0, int f, const float*& src, long& pitch, float& sc, int& nl0, int& nls) const {
        const int e = n0 >> 9, f0 = (n0 & 511) >> 1;
        const long dlt = (f >> 2) ? (long)(wu - wg) : 0l;
        src = wg + dlt + (size_t)e * 1024 * 256 + f0 + 4 * (f & 3); pitch = 256; sc = 1.f; nl0 = 8 * (f & 3) + (f >> 2); nls = 2;
    }
};
struct MapD {
    const float* wd;
    __device__ __forceinline__ void get(int n, const float*& src, long& pitch, float& sc) const {
        const int e = n >> 10, c = n & 1023;
        src = wd + (size_t)e * 256 * 1024 + c; pitch = 1024; sc = 1.f;
    }
    __device__ __forceinline__ void get4(int n0, int f, const float*& src, long& pitch, float& sc, int& nl0, int& nls) const { get(n0 + 4 * f, src, pitch, sc); nl0 = 4 * f; nls = 1; }
};

struct AttnP {
    const bf16* z16; const bf16* qb16; const bf16* kvb16; const bf16* krr16; const float* cum; const float* cosT; const float* sinT;
    const int* pos; bf16* mixed16; const float* lq1; const float* lk1; const float* lq2; const float* lk2; const float* gdiff; int layer; unsigned* prof; const int* tpmax; float lam, lam_init;
};
typedef short bf16x8_t __attribute__((ext_vector_type(8)));
typedef float f32x16_t __attribute__((ext_vector_type(16)));
typedef short s16x4_t __attribute__((ext_vector_type(4)));
typedef float f32x2_t __attribute__((ext_vector_type(2)));
typedef __bf16 bf16x2_t __attribute__((ext_vector_type(2)));
__device__ __forceinline__ unsigned cvtpk(float lo, float hi) { f32x2_t v = {lo, hi}; bf16x2_t b = __builtin_convertvector(v, bf16x2_t); return __builtin_bit_cast(unsigned, b); }
__device__ __forceinline__ int crow(int r, int hi) { return (r & 3) + 8 * (r >> 2) + 4 * hi; }
__device__ __forceinline__ s16x4_t vtr(const LAS unsigned char* p) { typedef short v4i16_t __attribute__((ext_vector_type(4))); return __builtin_bit_cast(s16x4_t, __builtin_amdgcn_ds_read_tr16_b64_v4i16((LAS v4i16_t*)p)); }
constexpr float LOG2E = 1.4426950408889634f;

__device__ __forceinline__ float xhalf_max(float m) { auto rr = __builtin_amdgcn_permlane32_swap(__float_as_uint(m), __float_as_uint(m), false, false); return __builtin_fmaxf(__uint_as_float(rr[0]), __uint_as_float(rr[1])); }
__device__ __forceinline__ float xhalf_sum(float m) { auto rr = __builtin_amdgcn_permlane32_swap(__float_as_uint(m), __float_as_uint(m), false, false); return __uint_as_float(rr[0]) + __uint_as_float(rr[1]); }
__device__ __forceinline__ float max3f(float a, float b, float c) { return __builtin_fmaxf(__builtin_fmaxf(a, b), c); }
template <int MODE> __device__ __forceinline__ void attn_unit(const AttnP& p, int b, int h, int qblk, LAS unsigned char* lds, const int tid_in) {
    int tid = tid_in * 64 + lane_id_now(); asm volatile("" : "+v"(tid));
#ifdef PROF_SEL
    const unsigned long long pu0 = __builtin_amdgcn_s_memrealtime(); unsigned long long pt0 = 0, pl0 = 0, pacc_c = 0, pacc_b = 0;
#define PROF_T(acc) do { const unsigned long long t_ = __builtin_amdgcn_s_memrealtime(); acc += t_ - pt0; pt0 = t_; } while (0)
#else
#define PROF_T(acc) do {} while (0)
#endif
    constexpr int NF = MODE == 0 ? 2 : (MODE == 1 ? 6 : 4);
    constexpr int NC = MODE == 1 ? 12 : 8;
    constexpr int KB = NC * 1024, KBUF = KB + 256;
    constexpr int VOFF = 2 * KBUF;
    constexpr int KI = (NC * 64 + NTHREADS - 1) / NTHREADS;
    const int lane = tid & 63, w = __builtin_amdgcn_readfirstlane(tid >> 6), r32 = lane & 31, hi = lane >> 5;
    const int map = MODE == 0 ? (w >> 2) : 0, qg = MODE == 0 ? (w & 3) : w;
    const int c = MODE == 0 ? qblk * 2 + (qg >> 1) : qblk * 4 + (qg >> 1);
    const int ntiles = MODE == 0 ? qblk * 2 + 2 : qblk * 4 + 4;
    const long tok0 = (long)b * SEQ;
    const int q0u = MODE == 0 ? qblk * 128 : qblk * 256;
    const long qrow = tok0 + q0u + qg * 32 + r32;
    float slope2 = 0.f, sq = 0.f, refv = 0.f; int qpmin = 0;
    const bf16* ksrc[KI]; bool kok[KI];
#pragma unroll
    for (int i = 0; i < KI; ++i) {
        const int pidx0 = tid + i * NTHREADS;
        kok[i] = pidx0 < NC * 64;
        const int pidx = kok[i] ? pidx0 : pidx0 - NTHREADS, c8 = pidx >> 6, kv = pidx & 63;
        if (MODE == 0) ksrc[i] = p.z16 + (tok0 + kv) * ZP + Z_KA + h * 64 + c8 * 8;
        else if (MODE == 2) ksrc[i] = p.z16 + (tok0 + kv) * ZP + Z_KC + h * 64 + c8 * 8;
        else ksrc[i] = (c8 < 8) ? p.kvb16 + (tok0 + kv) * NKVB + h * 128 + c8 * 8 : p.krr16 + (tok0 + kv) * 32 + (c8 - 8) * 8;
    }
    const int kstride = MODE == 1 ? 0 : 64 * ZP;
    const int vcl = tid & 3, vkv = (tid >> 2) & 63, vch = tid >> 8;
    const bf16* vsrc = MODE == 0 ? p.z16 + (tok0 + vkv) * ZP + Z_VA + h * 64 + (vch * 4 + vcl) * 8
                     : (MODE == 1 ? p.kvb16 + (tok0 + vkv) * NKVB + h * 128 + 64 + (vch * 4 + vcl) * 8 : p.z16 + (tok0 + vkv) * ZP + Z_VC + h * 64 + (vch * 4 + vcl) * 8);
    const int vstride = MODE == 1 ? 64 * NKVB : 64 * ZP;
    LAS unsigned char* const vdstp = lds + VOFF + vch * 4096 + (vkv >> 3) * 512 + (vkv & 7) * 64 + vcl * 16;
    LAS unsigned char* const kdstp = lds + tid * 16;
    v4u kreg0[KI], kreg1[KI], vreg0, vreg1; unsigned breg0 = 0u, breg1 = 0u;
    auto load_k = [&](int kt_, v4u (&kreg)[KI], unsigned& breg) {
        const int kt = kt_ < ntiles ? kt_ : ntiles - 1;
#pragma unroll
        for (int i = 0; i < KI; ++i) {
            const int pidx = tid + i * NTHREADS;
            const long off = MODE == 1 ? (((kok[i] ? pidx : pidx - NTHREADS) >> 6) < 8 ? (long)kt * 64 * NKVB : (long)kt * 64 * 32) : (long)kt * kstride;
            kreg[i] = *(const v4u*)(ksrc[i] + off);
        }
        if (MODE == 0) breg = (unsigned)p.pos[tok0 + kt * 64 + (tid & 63)];
        if (MODE == 2) breg = __float_as_uint(p.cum[(tok0 + kt * 64 + (tid & 63)) * 4 + h]);
    };
    auto load_v = [&](int kt_, v4u& vreg) { const int kt = kt_ < ntiles ? kt_ : ntiles - 1; vreg = *(const v4u*)(vsrc + (long)kt * vstride); };
    auto write_k = [&](const int par, const v4u (&kreg)[KI], const unsigned& breg) {
#pragma unroll
        for (int i = 0; i < KI; ++i) if (kok[i]) *(LAS v4u*)(kdstp + par * KBUF + i * NTHREADS * 16) = kreg[i];
        if (MODE != 1 && tid < 64) *(LAS float*)(lds + par * KBUF + KB + tid * 4) = MODE == 0 ? slope2 * ((float)(int)breg - refv) : (refv - __uint_as_float(breg)) * LOG2E;
    };
    auto write_v = [&](const int par, const v4u& vreg) { *(LAS v4u*)(vdstp + par * 8192) = vreg; };
    load_k(0, kreg0, breg0); load_k(1, kreg1, breg1); load_v(0, vreg0); load_v(1, vreg1);
    bf16x8_t qf[NF];
    {
        const bf16* qsrc = MODE == 0 ? p.z16 + qrow * ZP + Z_QA + h * 64 + map * 32 : (MODE == 1 ? p.qb16 + qrow * NQBP + h * 96 : p.z16 + qrow * ZP + Z_QC + h * 64);
#pragma unroll
        for (int i = 0; i < NF; ++i) qf[i] = *(const bf16x8_t*)(qsrc + i * 16 + hi * 8);
    }
    if (MODE == 1) {
        const float4 c0 = *(const float4*)(p.cosT + qrow * 16 + hi * 8), c1 = *(const float4*)(p.cosT + qrow * 16 + hi * 8 + 4);
        const float4 s0 = *(const float4*)(p.sinT + qrow * 16 + hi * 8), s1 = *(const float4*)(p.sinT + qrow * 16 + hi * 8 + 4);
        const float cs[8] = {c0.x, c0.y, c0.z, c0.w, c1.x, c1.y, c1.z, c1.w}, sn[8] = {s0.x, s0.y, s0.z, s0.w, s1.x, s1.y, s1.z, s1.w};
        float n1[8], n2[8];
#pragma unroll
        for (int j = 0; j < 8; ++j) {
            const float x1 = __uint_as_float((unsigned)(unsigned short)qf[NF - 2][j] << 16), x2 = __uint_as_float((unsigned)(unsigned short)qf[NF - 1][j] << 16);
            n1[j] = x1 * cs[j] - x2 * sn[j]; n2[j] = x2 * cs[j] + x1 * sn[j];
        }
        v4u a, bb;
        a.x = cvtpk(n1[0], n1[1]); a.y = cvtpk(n1[2], n1[3]); a.z = cvtpk(n1[4], n1[5]); a.w = cvtpk(n1[6], n1[7]);
        bb.x = cvtpk(n2[0], n2[1]); bb.y = cvtpk(n2[2], n2[3]); bb.z = cvtpk(n2[4], n2[5]); bb.w = cvtpk(n2[6], n2[7]);
        qf[NF - 2] = __builtin_bit_cast(bf16x8_t, a); qf[NF - 1] = __builtin_bit_cast(bf16x8_t, bb);
    }
    if (MODE == 0) {
        slope2 = exp2f(-8.0f * (float)(h + 1) / 6.0f) * LOG2E;
        const int pref = p.pos[tok0 + q0u]; refv = (float)pref;
        const int pq = p.pos[qrow]; sq = slope2 * (float)(pq - pref);
        int mn = pq;
#pragma unroll
        for (int o_ = 1; o_ < 64; o_ <<= 1) mn = min(mn, __builtin_amdgcn_ds_bpermute((lane ^ o_) << 2, mn));
        qpmin = __builtin_amdgcn_readfirstlane(mn);
    }
    if (MODE == 2) refv = p.cum[(tok0 + q0u) * 4 + h];
    f32x16_t o[2];
    float mrun = -INFINITY, lsum = 0.f;
#pragma unroll
    for (int r = 0; r < 16; ++r) { o[0][r] = 0.f; o[1][r] = 0.f; }
    LAS unsigned char* const kfp = lds + (map * NF * 2 + hi) * 1024 + r32 * 16;
    LAS unsigned char* const bfp = lds + KB + 16 * hi;
    LAS unsigned char* const vfp = lds + VOFF + (4 * hi + ((lane & 15) >> 2)) * 64 + ((lane >> 4) & 1) * 32 + (lane & 3) * 8;
    auto compute_s = [&](const int kt, const int par, f32x16_t& p0, f32x16_t& p1) {
        constexpr int KG = NF > 4 ? 3 : NF;
        bf16x8_t kf0[KG], kf1[KG];
#pragma unroll
        for (int d0 = 0; d0 < KG; ++d0) { kf0[d0] = *(const LAS bf16x8_t*)(kfp + par * KBUF + d0 * 2048); kf1[d0] = *(const LAS bf16x8_t*)(kfp + par * KBUF + d0 * 2048 + 512); }
        if (MODE == 1) {
#pragma unroll
            for (int r = 0; r < 16; ++r) { p0[r] = 0.f; p1[r] = 0.f; }
        } else {
#pragma unroll
            for (int g = 0; g < 4; ++g) {
                const f32x4_t b0 = *(const LAS f32x4_t*)(bfp + par * KBUF + 32 * g), b1 = *(const LAS f32x4_t*)(bfp + par * KBUF + 128 + 32 * g);
                p0[4 * g] = b0.x; p0[4 * g + 1] = b0.y; p0[4 * g + 2] = b0.z; p0[4 * g + 3] = b0.w;
                p1[4 * g] = b1.x; p1[4 * g + 1] = b1.y; p1[4 * g + 2] = b1.z; p1[4 * g + 3] = b1.w;
            }
        }
        __builtin_amdgcn_sched_barrier(0);
#pragma unroll
        for (int d0 = 0; d0 < KG; ++d0) {
            p0 = __builtin_amdgcn_mfma_f32_32x32x16_bf16(kf0[d0], qf[d0], p0, 0, 0, 0);
            p1 = __builtin_amdgcn_mfma_f32_32x32x16_bf16(kf1[d0], qf[d0], p1, 0, 0, 0);
        }
        if (NF > KG) {
#pragma unroll
            for (int d0 = KG; d0 < NF; ++d0) { kf0[d0 - KG] = *(const LAS bf16x8_t*)(kfp + par * KBUF + d0 * 2048); kf1[d0 - KG] = *(const LAS bf16x8_t*)(kfp + par * KBUF + d0 * 2048 + 512); }
#pragma unroll
            for (int d0 = KG; d0 < NF; ++d0) {
                p0 = __builtin_amdgcn_mfma_f32_32x32x16_bf16(kf0[d0 - KG], qf[d0], p0, 0, 0, 0);
                p1 = __builtin_amdgcn_mfma_f32_32x32x16_bf16(kf1[d0 - KG], qf[d0], p1, 0, 0, 0);
            }
        }
        if (MODE == 0) {
            if (kt == c || p.tpmax[b * 32 + kt] > qpmin) {
#pragma unroll
                for (int g = 0; g < 4; ++g) {
                    const f32x4_t b0 = *(const LAS f32x4_t*)(bfp + par * KBUF + 32 * g), b1 = *(const LAS f32x4_t*)(bfp + par * KBUF + 128 + 32 * g);
                    p0[4 * g] += 2.f * fminf(sq - b0.x, 0.f); p0[4 * g + 1] += 2.f * fminf(sq - b0.y, 0.f); p0[4 * g + 2] += 2.f * fminf(sq - b0.z, 0.f); p0[4 * g + 3] += 2.f * fminf(sq - b0.w, 0.f);
                    p1[4 * g] += 2.f * fminf(sq - b1.x, 0.f); p1[4 * g + 1] += 2.f * fminf(sq - b1.y, 0.f); p1[4 * g + 2] += 2.f * fminf(sq - b1.z, 0.f); p1[4 * g + 3] += 2.f * fminf(sq - b1.w, 0.f);
                }
            }
        }
        if (MODE == 2) {
            if (kt == c) {
                const int qi = (qg & 1) * 32 + r32;
#pragma unroll
                for (int r = 0; r < 16; ++r) { const int kv = crow(r, hi); if (kv > qi) p0[r] = -INFINITY; if (kv + 32 > qi) p1[r] = -INFINITY; }
            }
        }
    };
    auto softmax_pv = [&](const int par, f32x16_t& p0, f32x16_t& p1) {
        constexpr int VE = 4;
        s16x4_t vlo[8], vhi[8];
#pragma unroll
        for (int i = 0; i < VE; ++i) { vlo[i] = vtr(vfp + par * 8192 + (i & 1) * 4096 + (i >> 1) * 1024); vhi[i] = vtr(vfp + par * 8192 + (i & 1) * 4096 + (i >> 1) * 1024 + 512); }
        __builtin_amdgcn_sched_barrier(0);
        float tm0 = max3f(p0[0], p0[1], p0[2]), tm1 = max3f(p1[0], p1[1], p1[2]);
#pragma unroll
        for (int r = 3; r < 15; r += 2) { tm0 = max3f(tm0, p0[r], p0[r + 1]); tm1 = max3f(tm1, p1[r], p1[r + 1]); }
        float tmax = max3f(tm0, tm1, p0[15]); tmax = __builtin_fmaxf(tmax, p1[15]);
        tmax = xhalf_max(tmax);
        const float mnew = __builtin_fmaxf(mrun, tmax);
        if (__any(mnew > mrun)) {
            const float f = __builtin_amdgcn_exp2f(mrun - mnew);
            lsum *= f;
#pragma unroll
            for (int r = 0; r < 16; ++r) { o[0][r] *= f; o[1][r] *= f; }
            mrun = mnew;
        }
        float ls0 = 0.f, ls1 = 0.f;
#pragma unroll
        for (int r = 0; r < 16; ++r) { p0[r] = __builtin_amdgcn_exp2f(p0[r] - mnew); p1[r] = __builtin_amdgcn_exp2f(p1[r] - mnew); ls0 += p0[r]; ls1 += p1[r]; }
        lsum += ls0 + ls1;
        bf16x8_t pa[4];
#pragma unroll
        for (int ks = 0; ks < 4; ++ks) {
            v4u wv;
            if (ks < 2) { wv.x = cvtpk(p0[8 * ks + 0], p0[8 * ks + 1]); wv.y = cvtpk(p0[8 * ks + 2], p0[8 * ks + 3]); wv.z = cvtpk(p0[8 * ks + 4], p0[8 * ks + 5]); wv.w = cvtpk(p0[8 * ks + 6], p0[8 * ks + 7]); }
            else { wv.x = cvtpk(p1[8 * (ks - 2) + 0], p1[8 * (ks - 2) + 1]); wv.y = cvtpk(p1[8 * (ks - 2) + 2], p1[8 * (ks - 2) + 3]); wv.z = cvtpk(p1[8 * (ks - 2) + 4], p1[8 * (ks - 2) + 5]); wv.w = cvtpk(p1[8 * (ks - 2) + 6], p1[8 * (ks - 2) + 7]); }
            pa[ks] = __builtin_bit_cast(bf16x8_t, wv);
        }
#pragma unroll
        for (int i = VE; i < 8; ++i) { vlo[i] = vtr(vfp + par * 8192 + (i & 1) * 4096 + (i >> 1) * 1024); vhi[i] = vtr(vfp + par * 8192 + (i & 1) * 4096 + (i >> 1) * 1024 + 512); }
#pragma unroll
        for (int ks = 0; ks < 4; ++ks)
#pragma unroll
            for (int blk = 0; blk < 2; ++blk) {
                const s16x4_t lo = vlo[ks * 2 + blk], hi4 = vhi[ks * 2 + blk];
                const bf16x8_t vf = {lo[0], lo[1], lo[2], lo[3], hi4[0], hi4[1], hi4[2], hi4[3]};
                o[blk] = __builtin_amdgcn_mfma_f32_32x32x16_bf16(vf, pa[ks], o[blk], 0, 0, 0);
            }
    };
    constexpr bool PIPE = (MODE == 2);
    f32x16_t pA0, pA1, pB0, pB1;
    if (PIPE) {
        write_k(0, kreg0, breg0); write_k(1, kreg1, breg1); write_v(0, vreg0);
        load_k(2, kreg0, breg0);
        __syncthreads();
        compute_s(0, 0, pA0, pA1);
        __syncthreads();
    } else {
        write_k(0, kreg0, breg0); write_v(0, vreg0);
        __syncthreads();
    }
#ifdef PROF_SEL
    pl0 = __builtin_amdgcn_s_memrealtime();
#endif
#pragma unroll 1
    for (int kt = 0; kt < ntiles; kt += 2) {
#ifdef PROF_SEL
        pt0 = __builtin_amdgcn_s_memrealtime();
#endif
        if (PIPE) {
            load_k(kt + 3, kreg1, breg1); load_v(kt + 2, vreg0);
            if (kt < c) { compute_s(kt + 1, 1, pB0, pB1); __builtin_amdgcn_sched_barrier(0); softmax_pv(0, pA0, pA1); }
            else if (kt == c) softmax_pv(0, pA0, pA1);
            write_k(0, kreg0, breg0); write_v(1, vreg1);
        } else {
            load_k(kt + 2, kreg0, breg0); load_v(kt + 2, vreg0);
            if (kt <= c) { compute_s(kt, 0, pA0, pA1); softmax_pv(0, pA0, pA1); }
            write_k(1, kreg1, breg1); write_v(1, vreg1);
        }
        PROF_T(pacc_c);
        __syncthreads();
        PROF_T(pacc_b);
        if (PIPE) {
            load_k(kt + 4, kreg0, breg0); load_v(kt + 3, vreg1);
            if (kt + 1 < c) { compute_s(kt + 2, 0, pA0, pA1); __builtin_amdgcn_sched_barrier(0); softmax_pv(1, pB0, pB1); }
            else if (kt + 1 == c) softmax_pv(1, pB0, pB1);
            write_k(1, kreg1, breg1); write_v(0, vreg0);
        } else {
            load_k(kt + 3, kreg1, breg1); load_v(kt + 3, vreg1);
            if (kt + 1 <= c) { compute_s(kt + 1, 1, pA0, pA1); softmax_pv(1, pA0, pA1); }
            write_k(0, kreg0, breg0); write_v(0, vreg0);
        }
        PROF_T(pacc_c);
        __syncthreads();
        PROF_T(pacc_b);
    }
#ifdef PROF_SEL
    const unsigned long long pl1 = __builtin_amdgcn_s_memrealtime();
#endif
    const float inv = 1.f / xhalf_sum(lsum);
    int tid2 = tid_in * 64 + lane_id_now(); asm volatile("" : "+v"(tid2));
    const int lane2 = tid2 & 63, hi2 = lane2 >> 5, qg2 = MODE == 0 ? ((tid2 >> 6) & 3) : (tid2 >> 6);
    const long qrow2 = tok0 + q0u + qg2 * 32 + (lane2 & 31);
    bf16* op = p.mixed16 + qrow2 * D_MODEL + (MODE == 0 ? 0 : (MODE == 1 ? 384 : 768)) + h * 64;
    if (MODE == 0) {
        LAS float* xb = (LAS float*)lds + qg2 * 2048 + lane2;
        if (map == 1) {
#pragma unroll
            for (int blk = 0; blk < 2; ++blk)
#pragma unroll
                for (int r = 0; r < 16; ++r) xb[(blk * 16 + r) * 64] = o[blk][r] * inv;
        }
        __syncthreads();
        if (map == 0) {
            const float lam_init = p.lam_init, lam = p.lam;
            float ss = 0.f;
#pragma unroll
            for (int blk = 0; blk < 2; ++blk)
#pragma unroll
                for (int r = 0; r < 16; ++r) { const float v = o[blk][r] * inv - lam * xb[(blk * 16 + r) * 64]; o[blk][r] = v; ss = fmaf(v, v, ss); }
            ss = xhalf_sum(ss);
            const float rr = rsqrtf(ss * (1.f / 64.f) + RMS_EPS) * (1.f - lam_init);
#pragma unroll
            for (int blk = 0; blk < 2; ++blk)
#pragma unroll
                for (int g = 0; g < 4; ++g) {
                    const int d = 32 * blk + 8 * g + 4 * hi2;
                    const float4 gv = *(const float4*)(p.gdiff + d);
                    v2u wv; wv.x = cvtpk(o[blk][4 * g] * rr * gv.x, o[blk][4 * g + 1] * rr * gv.y); wv.y = cvtpk(o[blk][4 * g + 2] * rr * gv.z, o[blk][4 * g + 3] * rr * gv.w);
                    *(v2u*)(op + d) = wv;
                }
        }
        __syncthreads();
    } else {
#pragma unroll
        for (int blk = 0; blk < 2; ++blk)
#pragma unroll
            for (int g = 0; g < 4; ++g) {
                const int d = 32 * blk + 8 * g + 4 * hi2;
                v2u wv; wv.x = cvtpk(o[blk][4 * g] * inv, o[blk][4 * g + 1] * inv); wv.y = cvtpk(o[blk][4 * g + 2] * inv, o[blk][4 * g + 3] * inv);
                *(v2u*)(op + d) = wv;
            }
    }
#ifdef PROF_SEL
    if (p.layer == 0 && blockIdx.x == 7 && w == PROF_WAVE && lane == 0) {
        unsigned* pw = p.prof; const unsigned long long pu1 = __builtin_amdgcn_s_memrealtime();
        atomicAdd(pw + 0, (unsigned)(pu1 - pu0)); atomicAdd(pw + 1, (unsigned)(pl1 - pl0)); atomicAdd(pw + 2, (unsigned)pacc_c); atomicAdd(pw + 3, (unsigned)pacc_b);
        atomicAdd(pw + 4, (unsigned)ntiles * 100u); atomicAdd(pw + 5, 10000u); atomicAdd(pw + 6, (unsigned)(c + 1) * 100u);
    }
#endif
}

__device__ __forceinline__ void convert_layer_weights(const Args& a, int l, unsigned char* ws, LAS float* scr, int gw, int NGW, int lane) {
    const float* w_in = (const float*)a.in[3] + (size_t)l * D_MODEL * D_IN;
    const float* w_uq = (const float*)a.in[4] + (size_t)l * 256 * NQB;
    const float* w_ukv = (const float*)a.in[5] + (size_t)l * 128 * NKVB;
    const float* g_cq = (const float*)a.in[6] + l * 256;
    const float* g_ckv = (const float*)a.in[7] + l * 128;
    const float* w_out = (const float*)a.in[14] + (size_t)l * 1024 * 1024;
    transpose_rows(MapIn{w_in}, nullptr, ZP, 1024, (bf16*)(ws + WS_WIN), scr, gw, NGW, lane);
    transpose_rows(MapPlain{w_uq, NQB, NQB, 0.10206207261596575f * LOG2E_W}, g_cq, NQBP, 256, (bf16*)(ws + WS_WUQ), scr, gw, NGW, lane);
    transpose_rows(MapPlain{w_ukv, NKVB, NKVB, 1.f}, g_ckv, NKVB, 128, (bf16*)(ws + WS_WUKV), scr, gw, NGW, lane);
    transpose_rows(MapPlain{w_out, 1024, 1024, 1.f}, nullptr, 1024, 1024, (bf16*)(ws + WS_WOUT), scr, gw, NGW, lane);
    transpose_rows(MapPlain{(const float*)a.in[24] + (size_t)l * 1024 * 1024, 1024, 1024, 1.f}, nullptr, 1024, 1024, (bf16*)(ws + WS_WPG), scr, gw, NGW, lane);
    transpose_rows(MapPlain{(const float*)a.in[25] + (size_t)l * 256 * 1024, 1024, 1024, 1.f}, nullptr, 1024, 256, (bf16*)(ws + WS_WPP), scr, gw, NGW, lane);
    transpose_rows(MapGU{(const float*)a.in[21] + (size_t)l * 32 * 1024 * 256, (const float*)a.in[22] + (size_t)l * 32 * 1024 * 256}, nullptr, 32 * 512, 1024, (bf16*)(ws + WS_WGU), scr, gw, NGW, lane);
    transpose_rows(MapD{(const float*)a.in[23] + (size_t)l * 32 * 256 * 1024}, nullptr, 32 * 1024, 256, (bf16*)(ws + WS_WD), scr, gw, NGW, lane);
}

constexpr int LDS_MISC = 147456;
constexpr int PH_PER_LAYER = 10, NPH = 1 + DEPTH * PH_PER_LAYER;
template <int PH, bool DUMMY = false> __device__ __forceinline__ void run_phase(const Args& a, unsigned char* lds_raw, const int wave_s) {
    float* sm = (float*)lds_raw;
    const int G = gridDim.x, NGW = G * 8, NGT = G * NTHREADS;
    unsigned char* ws = a.ws;
    const float* x0 = (const float*)a.in[0];
    const float* pin = (const float*)a.in[1];
    const int* pos = (const int*)a.in[2];
    float* cosT = (float*)(ws + WS_COS); float* sinT = (float*)(ws + WS_SIN);
    bf16* a16 = (bf16*)(ws + WS_A16); bf16* z16 = (bf16*)(ws + WS_Z16); bf16* qb16 = (bf16*)(ws + WS_QB16); bf16* kvb16 = (bf16*)(ws + WS_KVB16);
    bf16* krr16 = (bf16*)(ws + WS_KRR16); float* fcbuf = (float*)(ws + WS_FC); float* cum = (float*)(ws + WS_CUM); float* logf = (float*)(ws + WS_LOGF);
    float* rq = (float*)(ws + WS_RQ); float* rkv = (float*)(ws + WS_RKV);
    bf16* mixed16 = (bf16*)(ws + WS_MIXED16); bf16* mix16 = (bf16*)(ws + WS_MIX16);
    float* hbuf = a.out; bf16* hs16 = (bf16*)(ws + WS_HS16); bf16* act16 = (bf16*)(ws + WS_ACT16); bf16* outs16 = (bf16*)(ws + WS_OUTS16); bf16* ple16 = (bf16*)(ws + WS_PLE16); bf16* pp16 = (bf16*)(ws + WS_PP16); bf16* p16 = (bf16*)(ws + WS_P16);
    int* ids = (int*)(ws + WS_RT + RT_IDS); float* wts = (float*)(ws + WS_RT + RT_WTS); int* rank = (int*)(ws + WS_RT + RT_RANK);
    int* slot_of = (int*)(ws + WS_RT + RT_SLOTOF); int* tile_e = (int*)(ws + WS_RT + RT_TILEE);
    unsigned* ctl = (unsigned*)(ws + WS_CTL);

        int tid = wave_s * 64 + lane_id_now(); asm volatile("" : "+v"(tid));
        const int lane = tid & 63, wave = __builtin_amdgcn_readfirstlane(tid >> 6);
        const int gw = blockIdx.x * 8 + wave, gtid = blockIdx.x * NTHREADS + tid;
        LAS float* scr = (LAS float*)((LAS unsigned char*)lds_raw + wave * 16384);
        if constexpr (PH == 0) {
            for (int i = gtid; i < NTOK * 16; i += NGT) {
                const int tk = i >> 4, j = i & 15;
                const int j4 = j >> 2, jr = j & 3;
                const double inv = (j4 == 0 ? 1.0 : (j4 == 1 ? 0.1 : (j4 == 2 ? 0.01 : 0.001))) * (jr == 0 ? 1.0 : (jr == 1 ? 0.5623413251903491 : (jr == 2 ? 0.31622776601683794 : 0.1778279410038923)));
                const double ang = (double)pos[tk] * inv;
                const double k = rint(ang * 0.15915494309189535);
                const double r = fma(-k, 6.283185307179586, ang) - k * 2.4492935982947064e-16;
                cosT[i] = cosf((float)r); sinT[i] = sinf((float)r);
            }
            auto cvt_stream = [&](const float* sp, bf16* dp, int n8) {
                for (int i = gtid; i < n8; i += 4 * NGT) {
                    f32x4_t v[8];
#pragma unroll
                    for (int u = 0; u < 4; ++u) { v[2 * u] = *(const f32x4_t*)(sp + (size_t)(i + u * NGT) * 8); v[2 * u + 1] = *(const f32x4_t*)(sp + (size_t)(i + u * NGT) * 8 + 4); }
#pragma unroll
                    for (int u = 0; u < 4; ++u) { v4u o; o.x = pk2(v[2 * u].x, v[2 * u].y); o.y = pk2(v[2 * u].z, v[2 * u].w); o.z = pk2(v[2 * u + 1].x, v[2 * u + 1].y); o.w = pk2(v[2 * u + 1].z, v[2 * u + 1].w);
                        *(v4u*)(dp + (size_t)(i + u * NGT) * 8) = o; }
                }
            };
            for (int i = gw; i < BATCH * 32; i += NGW) {
                int v = pos[i * 64 + lane];
#pragma unroll
                for (int o_ = 1; o_ < 64; o_ <<= 1) v = max(v, __shfl_xor(v, o_));
                if (lane == 0) ((int*)(ws + WS_RT + RT_TPMAX))[i] = v;
            }
            cvt_stream(x0, a16, NTOK * D_MODEL / 8);
            cvt_stream(pin, p16, DEPTH * NTOK * PLE_DIM / 8);
            convert_layer_weights(a, 0, ws, scr, gw, NGW, lane);
        } else {
            constexpr int l = (PH - 1) / PH_PER_LAYER, sp = (PH - 1) % PH_PER_LAYER;
            const float* xin = (l == 0) ? x0 : a.out;
            const float* b_forget = (const float*)a.in[13] + l * 4;
            const float* ln1_g = (const float*)a.in[15] + l * 1024; const float* ln1_b = (const float*)a.in[16] + l * 1024;
            const float* w_group = (const float*)a.in[17] + l * 1024 * 4; const float* b_group = (const float*)a.in[18] + l * 4;
            const float* w_er = (const float*)a.in[19] + (size_t)l * 4 * 1024 * 8; const float* b_er = (const float*)a.in[20] + l * 32;
            const float* ln2_g = (const float*)a.in[26] + l * 1024; const float* ln2_b = (const float*)a.in[27] + l * 1024;
            unsigned* cnt = ctl + CW_CNT + l * 2048 + (DUMMY ? 8192 : 0);
            if (DUMMY) rank = (int*)(ws + WS_RT + 512 * 1024);
            if constexpr (sp == 0) {
                pg8::Gemm g{a16, (const bf16*)(ws + WS_WIN), NTOK, ZP, 1024, 1024, 1024};
                pg8::StaticOrder S; S.init(NTOK, ZP, G, (int)blockIdx.x);
                pg8::EpiZ E{z16, ZP, fcbuf};
                pg8::gemm_phase<pg8::EpiZ, pg8::StaticOrder, true, true>((LAS unsigned char*)lds_raw, g, S, E, tid);
            } else if constexpr (sp == 1) {
                const int g16 = lane >> 4, l16 = lane & 15;
                for (int tk = gw * 4 + g16; tk < NTOK; tk += NGW * 4) {
                    const bf16* zr = z16 + (size_t)tk * ZP;
                    const v4u ca = *(const v4u*)(zr + Z_CQ + l16 * 16), cb = *(const v4u*)(zr + Z_CQ + l16 * 16 + 8);
                    const v4u ka = *(const v4u*)(zr + Z_CKV + l16 * 8);
                    const unsigned short kr1 = zr[Z_KR + l16], kr2 = zr[Z_KR + 16 + l16];
                    const float cs = cosT[tk * 16 + l16], sn = sinT[tk * 16 + l16];
                    const float fcv = fcbuf[tk * 4 + (l16 & 3)];
                    float f[8]; float ss = 0.f;
                    unpack8(ca, f);
#pragma unroll
                    for (int i = 0; i < 8; ++i) ss = fmaf(f[i], f[i], ss);
                    unpack8(cb, f);
#pragma unroll
                    for (int i = 0; i < 8; ++i) ss = fmaf(f[i], f[i], ss);
                    float s2 = 0.f;
                    unpack8(ka, f);
#pragma unroll
                    for (int i = 0; i < 8; ++i) s2 = fmaf(f[i], f[i], s2);
#pragma unroll
                    for (int o = 1; o < 16; o <<= 1) { ss += __shfl_xor(ss, o); s2 += __shfl_xor(s2, o); }
                    if (l16 == 0) { rq[tk] = rsqrtf(ss * (1.f / 256.f) + RMS_EPS); rkv[tk] = rsqrtf(s2 * (1.f / 128.f) + RMS_EPS); }
                    const float x1 = __uint_as_float((unsigned)kr1 << 16), x2 = __uint_as_float((unsigned)kr2 << 16);
                    krr16[tk * 32 + l16] = (bf16)f2bf(x1 * cs - x2 * sn); krr16[tk * 32 + 16 + l16] = (bf16)f2bf(x2 * cs + x1 * sn);
                    if (l16 < 4) {
                        const float xf = fcv + b_forget[l16];
                        logf[tk * 4 + l16] = fminf(xf, 0.f) - log1pf(expf(-fabsf(xf)));
                    }
                }
            } else if constexpr (sp == 2) {
                {
                    pg8::Gemm g{z16 + Z_CQ, (const bf16*)(ws + WS_WUQ), NTOK, NQBP, 256, ZP, 256};
                    pg8::StaticOrder S; S.init(NTOK, NQBP, G, (int)blockIdx.x);
                    pg8::EpiRowScale E{qb16, NQBP, rq};
                    pg8::gemm_phase<pg8::EpiRowScale, pg8::StaticOrder, true, true>((LAS unsigned char*)lds_raw, g, S, E, tid);
                }
                {
                    pg8::Gemm g{z16 + Z_CKV, (const bf16*)(ws + WS_WUKV), NTOK, NKVB, 128, ZP, 128};
                    pg8::StaticOrder S; S.init(NTOK, NKVB, G, (int)((blockIdx.x + 128) % G));
                    pg8::EpiRowScale E{kvb16, NKVB, rkv};
                    pg8::gemm_phase<pg8::EpiRowScale, pg8::StaticOrder, true, true>((LAS unsigned char*)lds_raw, g, S, E, tid);
                }
                const int cw = NGW - 1 - gw;
                if (cw < 32) {
                    const int b = cw >> 2, hh = cw & 3;
                    float* cp = cum + ((size_t)b * SEQ) * 4 + hh; const float* lp = logf + ((size_t)b * SEQ) * 4 + hh;
                    float loc[32]; float run = 0.f;
#pragma unroll
                    for (int i = 0; i < 32; ++i) { run += lp[(size_t)(lane * 32 + i) * 4]; loc[i] = run; }
                    float pre = run;
#pragma unroll
                    for (int o = 1; o < 64; o <<= 1) { const float n = __shfl_up(pre, o); if (lane >= o) pre += n; }
                    pre -= run;
#pragma unroll
                    for (int i = 0; i < 32; ++i) cp[(size_t)(lane * 32 + i) * 4] = loc[i] + pre;
                }
            } else if constexpr (sp == 3) {
                float lam_init_, lam_;
                {
                    const float* lq1 = (const float*)a.in[8] + l * 32; const float* lk1 = (const float*)a.in[9] + l * 32; const float* lq2 = (const float*)a.in[10] + l * 32; const float* lk2 = (const float*)a.in[11] + l * 32;
                    lam_init_ = 0.8f - 0.6f * expf(-0.3f * (float)l);
                    float s1 = 0.f, s2 = 0.f;
                    for (int i = 0; i < 32; ++i) { s1 += lq1[i] * lk1[i]; s2 += lq2[i] * lk2[i]; }
                    lam_ = expf(s1) - expf(s2) + lam_init_;
                }
                AttnP p{z16, qb16, kvb16, krr16, cum, cosT, sinT, pos, mixed16,
                        (const float*)a.in[8] + l * 32, (const float*)a.in[9] + l * 32, (const float*)a.in[10] + l * 32, (const float*)a.in[11] + l * 32,
                        (const float*)a.in[12] + l * 64, l, ctl + 14000, (const int*)(ws + WS_RT + RT_TPMAX), lam_, lam_init_};
                volatile LAS int* qslot = (volatile LAS int*)((LAS unsigned char*)lds_raw + LDS_MISC) + 48;
                unsigned* qctr = ctl + 12288 + l * 64 + (DUMMY ? 32 : 0);
                int idx = (int)blockIdx.x;
                for (;;) {
                    if (idx >= 1408) break;
                    int nxt_idx = 0;
                    if (wave_s == 0 && lane_id_now() == 0) nxt_idx = G + (int)atomicAdd(qctr, 1u);
                    const int pi = idx / 176, r = idx % 176, thi = 32 - 4 * pi;
                    if (r < 48) attn_unit<0>(p, r / 6, r % 6, thi / 2 - 1, (LAS unsigned char*)lds_raw, wave_s);
                    else if (r < 96) attn_unit<1>(p, (r - 48) / 6, (r - 48) % 6, thi / 4 - 1, (LAS unsigned char*)lds_raw, wave_s);
                    else if (r < 128) attn_unit<2>(p, (r - 96) / 4, (r - 96) % 4, thi / 4 - 1, (LAS unsigned char*)lds_raw, wave_s);
                    else attn_unit<0>(p, (r - 128) / 6, (r - 128) % 6, (thi - 2) / 2 - 1, (LAS unsigned char*)lds_raw, wave_s);
                    __syncthreads();
                    if (wave_s == 0 && lane_id_now() == 0) *qslot = nxt_idx;
                    __syncthreads();
                    idx = __builtin_amdgcn_readfirstlane(*qslot);
                }
            } else if constexpr (sp == 4) {
                pg8::Gemm g{mixed16, (const bf16*)(ws + WS_WOUT), NTOK, 1024, 1024, 1024, 1024};
                pg8::StaticOrder S; S.init(NTOK, 1024, G, (int)blockIdx.x);
                pg8::EpiBf16<0> E{mix16, 1024, nullptr, 0, 0, 1.f};
                pg8::gemm_phase<pg8::EpiBf16<0>, pg8::StaticOrder, true, true>((LAS unsigned char*)lds_raw, g, S, E, tid);
            } else if constexpr (sp == 5) {
                LAS f32x4_t* Lg = (LAS f32x4_t*)lds_raw; LAS f32x4_t* Le = Lg + 1024;
                LAS unsigned* lcnt = (LAS unsigned*)((LAS unsigned char*)lds_raw + LDS_MISC) + 16;
                __syncthreads();
                if (tid < 32) lcnt[tid] = 0u;
                for (int k = tid; k < 1024; k += NTHREADS) { const int j = k >> 8, ln = (k & 255) >> 2, i = k & 3; Lg[(j * 4 + i) * 64 + ln] = *(const f32x4_t*)(w_group + (size_t)k * 4); }
                for (int q = tid; q < 4 * 1024 * 2; q += NTHREADS) { const int g = q >> 11, k = (q >> 1) & 1023, half = q & 1; const int j = k >> 8, ln = (k & 255) >> 2, i = k & 3;
                    Le[((g * 16 + j * 4 + i) * 2 + half) * 64 + ln] = *(const f32x4_t*)(w_er + (size_t)q * 4); }
                __syncthreads();
                float4 xv[4]; v2u mw[4];
                if (gw < NTOK) {
#pragma unroll
                    for (int j = 0; j < 4; ++j) { xv[j] = *(const float4*)(xin + (size_t)gw * D_MODEL + j * 256 + lane * 4); mw[j] = *(const v2u*)(mix16 + (size_t)gw * D_MODEL + j * 256 + lane * 4); }
                }
                for (int tk = gw; tk < NTOK; tk += NGW) {
                    float4 v[4]; float s = 0.f;
#pragma unroll
                    for (int j = 0; j < 4; ++j) {
                        v[j] = make_float4(ALPHA * xv[j].x + bflo(mw[j].x), ALPHA * xv[j].y + bfhi(mw[j].x), ALPHA * xv[j].z + bflo(mw[j].y), ALPHA * xv[j].w + bfhi(mw[j].y));
                        s += (v[j].x + v[j].y) + (v[j].z + v[j].w);
                    }
                    if (tk + NGW < NTOK) {
#pragma unroll
                        for (int j = 0; j < 4; ++j) { xv[j] = *(const float4*)(xin + (size_t)(tk + NGW) * D_MODEL + j * 256 + lane * 4); mw[j] = *(const v2u*)(mix16 + (size_t)(tk + NGW) * D_MODEL + j * 256 + lane * 4); }
                    }
                    const float mean = wave_sum(s) * (1.f / 1024.f); float s2 = 0.f;
#pragma unroll
                    for (int j = 0; j < 4; ++j) { v[j].x -= mean; v[j].y -= mean; v[j].z -= mean; v[j].w -= mean; s2 += (v[j].x * v[j].x + v[j].y * v[j].y) + (v[j].z * v[j].z + v[j].w * v[j].w); }
                    const float rstd = rsqrtf(wave_sum(s2) * (1.f / 1024.f) + LN_EPS);
                    float gl[4] = {0.f, 0.f, 0.f, 0.f};
#pragma unroll
                    for (int j = 0; j < 4; ++j) {
                        const int d0 = j * 256 + lane * 4;
                        const float4 gg = *(const float4*)(ln1_g + d0), bb = *(const float4*)(ln1_b + d0);
                        v[j] = make_float4(v[j].x * rstd * gg.x + bb.x, v[j].y * rstd * gg.y + bb.y, v[j].z * rstd * gg.z + bb.z, v[j].w * rstd * gg.w + bb.w);
                        *(float4*)(hbuf + (size_t)tk * D_MODEL + d0) = v[j];
                        { v2u hb; hb.x = pk2(v[j].x, v[j].y); hb.y = pk2(v[j].z, v[j].w); *(v2u*)(a16 + (size_t)tk * D_MODEL + d0) = hb; }
                        const float hv[4] = {v[j].x, v[j].y, v[j].z, v[j].w};
#pragma unroll
                        for (int i = 0; i < 4; ++i) {
                            const f32x4_t wg = Lg[(j * 4 + i) * 64 + lane];
                            gl[0] = fmaf(hv[i], wg.x, gl[0]); gl[1] = fmaf(hv[i], wg.y, gl[1]); gl[2] = fmaf(hv[i], wg.z, gl[2]); gl[3] = fmaf(hv[i], wg.w, gl[3]);
                        }
                    }
#pragma unroll
                    for (int i = 0; i < 4; ++i) gl[i] = wave_sum(gl[i]) + b_group[i];
                    int gi = 0; float gm = gl[0];
#pragma unroll
                    for (int i = 1; i < 4; ++i) if (gl[i] > gm) { gm = gl[i]; gi = i; }
                    gi = __builtin_amdgcn_readfirstlane(gi);
                    float gden = 0.f;
#pragma unroll
                    for (int i = 0; i < 4; ++i) gden += expf(gl[i] - gm);
                    const float gwt = 1.f / gden;
                    float el[8] = {0.f, 0.f, 0.f, 0.f, 0.f, 0.f, 0.f, 0.f};
                    const LAS f32x4_t* we = Le + gi * 2048;
#pragma unroll
                    for (int j = 0; j < 4; ++j) {
                        const float hv[4] = {v[j].x, v[j].y, v[j].z, v[j].w};
#pragma unroll
                        for (int i = 0; i < 4; ++i) {
                            const f32x4_t w0 = we[((j * 4 + i) * 2) * 64 + lane], w1 = we[((j * 4 + i) * 2 + 1) * 64 + lane];
                            el[0] = fmaf(hv[i], w0.x, el[0]); el[1] = fmaf(hv[i], w0.y, el[1]); el[2] = fmaf(hv[i], w0.z, el[2]); el[3] = fmaf(hv[i], w0.w, el[3]);
                            el[4] = fmaf(hv[i], w1.x, el[4]); el[5] = fmaf(hv[i], w1.y, el[5]); el[6] = fmaf(hv[i], w1.z, el[6]); el[7] = fmaf(hv[i], w1.w, el[7]);
                        }
                    }
#pragma unroll
                    for (int i = 0; i < 8; ++i) el[i] = wave_sum(el[i]) + b_er[gi * 8 + i];
                    int i0 = 0; float v0 = el[0];
#pragma unroll
                    for (int i = 1; i < 8; ++i) if (el[i] > v0) { v0 = el[i]; i0 = i; }
                    int i1 = -1; float v1 = -INFINITY;
#pragma unroll
                    for (int i = 0; i < 8; ++i) if (i != i0 && el[i] > v1) { v1 = el[i]; i1 = i; }
                    const float e1 = expf(v1 - v0);
                    const float w0 = gwt / (1.f + e1), w1 = gwt * e1 / (1.f + e1);
                    if (lane == 0) {
                        const int ea = gi * 8 + i0, eb = gi * 8 + i1;
                        ids[tk * 2] = ea; ids[tk * 2 + 1] = eb; wts[tk * 2] = w0; wts[tk * 2 + 1] = w1;
                        rank[tk * 2] = (int)__hip_atomic_fetch_add(lcnt + ea, 1u, __ATOMIC_RELAXED, __HIP_MEMORY_SCOPE_WORKGROUP);
                        rank[tk * 2 + 1] = (int)__hip_atomic_fetch_add(lcnt + eb, 1u, __ATOMIC_RELAXED, __HIP_MEMORY_SCOPE_WORKGROUP);
                    }
                }
                __syncthreads();
                if (tid < 32) { const unsigned n = lcnt[tid]; lcnt[tid] = n ? atomicAdd(cnt + tid * 64, n) : 0u; }
                __syncthreads();
                if (lane == 0) for (int tk = gw; tk < NTOK; tk += NGW) { rank[tk * 2] += (int)lcnt[ids[tk * 2]]; rank[tk * 2 + 1] += (int)lcnt[ids[tk * 2 + 1]]; }
                __syncthreads();
            } else if constexpr (sp == 6) {
                int* offs = (int*)sm;
                __syncthreads();
                if (tid == 0) { int o = 0; for (int e = 0; e < 32; ++e) { offs[e] = o; o += ((int)cnt[e * 64] + 255) & ~255; } offs[32] = o; }
                __syncthreads();
                for (int i = gtid; i < NSLOT_TILES; i += NGT) { int e = -1; for (int k = 0; k < 32; ++k) if (i * 256 >= offs[k] && i * 256 < offs[k + 1]) e = k; tile_e[i] = e; }
                for (int i = gw; i < NTOK * 2; i += NGW) {
                    const int e = ids[i]; const int s = offs[e] + rank[i];
                    if (lane == 0) slot_of[i] = s;
                    const v4u* srow = (const v4u*)(a16 + (size_t)(i >> 1) * D_MODEL); v4u* drow = (v4u*)(hs16 + (size_t)s * D_MODEL);
                    const v4u r0 = srow[lane], r1 = srow[64 + lane];
                    drow[lane] = r0; drow[64 + lane] = r1;
                }
                __syncthreads();
                {
                    pg8::Gemm g{p16 + (size_t)l * NTOK * PLE_DIM, (const bf16*)(ws + WS_WPP), NTOK, 1024, 256, 256, 256};
                    pg8::StaticOrder S; S.init(NTOK, 1024, G, (int)blockIdx.x);
                    pg8::EpiBf16<0> E{pp16, 1024, nullptr, 0, 0, 1.f};
                    pg8::gemm_phase<pg8::EpiBf16<0>, pg8::StaticOrder, true, true>((LAS unsigned char*)lds_raw, g, S, E, tid);
                }
                {
                    pg8::Gemm g{a16, (const bf16*)(ws + WS_WPG), NTOK, 1024, 1024, 1024, 1024};
                    pg8::StaticOrder S; S.init(NTOK, 1024, G, (int)blockIdx.x);
                    pg8::EpiPleGate E{ple16, pp16};
                    pg8::gemm_phase<pg8::EpiPleGate, pg8::StaticOrder, true, true>((LAS unsigned char*)lds_raw, g, S, E, tid);
                }
            } else if constexpr (sp == 7) {
                int T = 0; for (int e = 0; e < 32; ++e) T += ((int)cnt[e * 64] + 255) >> 8;
                T = __builtin_amdgcn_readfirstlane(T);
                pg8::Gemm g{hs16, (const bf16*)(ws + WS_WGU), MAX_SLOTS, 32 * 512, 1024, 1024, 1024};
                pg8::GroupSched S{tile_e, T, 2, G, (int)((blockIdx.x % 8) * (G / 8) + blockIdx.x / 8)};
                pg8::EpiGU E{act16};
                pg8::gemm_phase<pg8::EpiGU, pg8::GroupSched, true, true>((LAS unsigned char*)lds_raw, g, S, E, tid);
            } else if constexpr (sp == 8) {
                int T = 0; for (int e = 0; e < 32; ++e) T += ((int)cnt[e * 64] + 255) >> 8;
                T = __builtin_amdgcn_readfirstlane(T);
                pg8::Gemm g{act16, (const bf16*)(ws + WS_WD), MAX_SLOTS, 32 * 1024, 256, 256, 256};
                pg8::GroupSched S{tile_e, T, 4, G, (int)((blockIdx.x % 8) * (G / 8) + blockIdx.x / 8)};
                pg8::EpiDown E{outs16};
                pg8::gemm_phase<pg8::EpiDown, pg8::GroupSched, true, true>((LAS unsigned char*)lds_raw, g, S, E, tid);
            } else if constexpr (sp == 9) {
                float4 hv[4]; v2u oa[4], ob[4], pv[4]; float w0 = 0.f, w1 = 0.f;
                auto ld_rows = [&](int tk) {
                    const int s0 = slot_of[tk * 2], s1 = slot_of[tk * 2 + 1]; w0 = wts[tk * 2]; w1 = wts[tk * 2 + 1];
#pragma unroll
                    for (int j = 0; j < 4; ++j) {
                        const int d0 = j * 256 + lane * 4;
                        hv[j] = *(const float4*)(hbuf + (size_t)tk * D_MODEL + d0);
                        oa[j] = *(const v2u*)(outs16 + (size_t)s0 * D_MODEL + d0); ob[j] = *(const v2u*)(outs16 + (size_t)s1 * D_MODEL + d0);
                        pv[j] = *(const v2u*)(ple16 + (size_t)tk * D_MODEL + d0);
                    }
                };
                if (gw < NTOK) ld_rows(gw);
                for (int tk = gw; tk < NTOK; tk += NGW) {
                    float4 v[4]; float s = 0.f;
#pragma unroll
                    for (int j = 0; j < 4; ++j) {
                        v[j] = make_float4(ALPHA * hv[j].x + w0 * bflo(oa[j].x) + w1 * bflo(ob[j].x) + bflo(pv[j].x), ALPHA * hv[j].y + w0 * bfhi(oa[j].x) + w1 * bfhi(ob[j].x) + bfhi(pv[j].x),
                                           ALPHA * hv[j].z + w0 * bflo(oa[j].y) + w1 * bflo(ob[j].y) + bflo(pv[j].y), ALPHA * hv[j].w + w0 * bfhi(oa[j].y) + w1 * bfhi(ob[j].y) + bfhi(pv[j].y));
                        s += (v[j].x + v[j].y) + (v[j].z + v[j].w);
                    }
                    if (tk + NGW < NTOK) ld_rows(tk + NGW);
                    const float mean = wave_sum(s) * (1.f / 1024.f); float s2 = 0.f;
#pragma unroll
                    for (int j = 0; j < 4; ++j) { v[j].x -= mean; v[j].y -= mean; v[j].z -= mean; v[j].w -= mean; s2 += (v[j].x * v[j].x + v[j].y * v[j].y) + (v[j].z * v[j].z + v[j].w * v[j].w); }
                    const float rstd = rsqrtf(wave_sum(s2) * (1.f / 1024.f) + LN_EPS);
#pragma unroll
                    for (int j = 0; j < 4; ++j) {
                        const int d0 = j * 256 + lane * 4;
                        const float4 gg = *(const float4*)(ln2_g + d0), bb = *(const float4*)(ln2_b + d0);
                        const float4 o = make_float4(v[j].x * rstd * gg.x + bb.x, v[j].y * rstd * gg.y + bb.y, v[j].z * rstd * gg.z + bb.z, v[j].w * rstd * gg.w + bb.w);
                        if (!DUMMY || w0 == 12345.678f) {
#ifdef PROF_SEL
                        float4 oo = o; if (l == DEPTH - 1) { const float dlt = sqrtf((float)ctl[14000 + PROF_SEL] * 1e-8f); oo.x += dlt; oo.y += dlt; oo.z += dlt; oo.w += dlt; }
                        *(float4*)(a.out + (size_t)tk * D_MODEL + d0) = oo;
#else
                        *(float4*)(a.out + (size_t)tk * D_MODEL + d0) = o;
#endif
                        v2u ob16; ob16.x = pk2(o.x, o.y); ob16.y = pk2(o.z, o.w);
                        *(v2u*)(a16 + (size_t)tk * D_MODEL + d0) = ob16;
                        }
                    }
                }
                if (l + 1 < DEPTH) convert_layer_weights(a, l + 1, ws, scr, gw, NGW, lane);
            }
        }
}

constexpr int CW_BAR = 4096;
__global__ void __launch_bounds__(NTHREADS, 2) mega(Args a) {
    extern __shared__ __attribute__((aligned(16))) unsigned char lds_raw[];
    cg::grid_group grid = cg::this_grid();
    volatile LAS unsigned* misc = (volatile LAS unsigned*)((LAS unsigned char*)lds_raw + LDS_MISC);
    if (threadIdx.x < 16) misc[threadIdx.x] = 0u;
    __syncthreads();
    XcdBarrier bar = xcd_barrier_post((unsigned*)(a.ws + WS_CTL) + CW_BAR, misc + 8);
    const int wave_s = __builtin_amdgcn_readfirstlane(threadIdx.x >> 6);
#define IS_T0 (wave_s == 0 && lane_id_now() == 0)
#ifndef DUP_SP
#define DUP_SP -1
#endif
#ifndef DUP_X
#define DUP_X 0
#endif
#define SEAM(ph) do { if ((ph) == 0) grid.sync(); else xcd_barrier(bar, IS_T0); } while (0)
#ifdef PROF_PH
    unsigned long long ph_t_prev = __builtin_amdgcn_s_memrealtime();
#define PHASE_STAMP(ph) do { const unsigned long long t_ = __builtin_amdgcn_s_memrealtime(); if ((ph) == PROF_PH && blockIdx.x == 0 && IS_T0) ((unsigned*)(a.ws + WS_CTL))[14000 + PROF_SEL] = (unsigned)(t_ - ph_t_prev); ph_t_prev = t_; } while (0)
#else
#define PHASE_STAMP(ph) do {} while (0)
#endif
#define RUN(ph) if (a.ph_lo <= (ph) && (ph) < a.ph_hi) { \
        if (DUP_X == 9 && (ph) > 0 && ((ph) - 1) % PH_PER_LAYER == 9) { run_phase<ph, true>(a, lds_raw, wave_s); xcd_barrier(bar, IS_T0); } \
        run_phase<ph>(a, lds_raw, wave_s); \
        if ((ph) > 0 && ((ph) - 1) % PH_PER_LAYER == DUP_SP) { xcd_barrier(bar, IS_T0); run_phase<ph>(a, lds_raw, wave_s); } \
        if (DUP_X == 100 && (ph) == 0) { xcd_barrier(bar, IS_T0); run_phase<ph>(a, lds_raw, wave_s); } \
        if (DUP_X == 5 && (ph) == 6) { xcd_barrier(bar, IS_T0); run_phase<ph, true>(a, lds_raw, wave_s); } \
        if (DUP_X == 3 && (ph) > 0 && ((ph) - 1) % PH_PER_LAYER == 3) { xcd_barrier(bar, IS_T0); run_phase<ph, true>(a, lds_raw, wave_s); } \
        if ((ph) + 1 < a.ph_hi && (ph) + 1 < NPH) SEAM(ph); PHASE_STAMP(ph); }
    RUN(0) RUN(1) RUN(2) RUN(3) RUN(4) RUN(5) RUN(6) RUN(7) RUN(8) RUN(9) RUN(10)
    RUN(11) RUN(12) RUN(13) RUN(14) RUN(15) RUN(16) RUN(17) RUN(18) RUN(19) RUN(20)
#undef RUN
#undef SEAM
}

extern "C" void kernel_launch(void* const* d_in, const int* in_sizes, int n_in, void* d_out, int out_size, void* d_ws, size_t ws_size, hipStream_t stream) {
    static int grid = 0;
    if (grid == 0) {
        if (n_in != 28 || ws_size < WS_END) { fprintf(stderr, "kernel_launch: unexpected n_in %d or ws_size %zu (< %zu)\n", n_in, ws_size, (size_t)WS_END); grid = -1; return; }
        int dev = 0, cus = 0, per_cu = 0;
        (void)hipGetDevice(&dev);
        (void)hipDeviceGetAttribute(&cus, hipDeviceAttributeMultiprocessorCount, dev);
        (void)hipFuncSetAttribute((const void*)mega, hipFuncAttributeMaxDynamicSharedMemorySize, LDS_BYTES);
        (void)hipOccupancyMaxActiveBlocksPerMultiprocessor(&per_cu, (const void*)mega, NTHREADS, LDS_BYTES);
        if (per_cu < 1) { fprintf(stderr, "kernel_launch: occupancy query says %d blocks/CU\n", per_cu); }
        (void)hipGetLastError();
        grid = cus;
    }
    if (grid < 0) return;
    (void)hipMemsetAsync((char*)d_ws + WS_CTL, 0, 64 * 1024, stream);
    Args a{};
    for (int i = 0; i < 28; ++i) a.in[i] = d_in[i];
    a.out = (float*)d_out; a.ws = (unsigned char*)d_ws; a.ph_lo = 0; a.ph_hi = NPH;
    void* params[] = {&a};
    hipError_t e = hipLaunchCooperativeKernel((const void*)mega, dim3(grid), dim3(NTHREADS), params, LDS_BYTES, stream);
    if (e != hipSuccess) fprintf(stderr, "cooperative launch failed: %s (grid %d)\n", hipGetErrorString(e), grid);
}
```

```cpp
#include <hip/hip_runtime.h>
#include <hip/hip_cooperative_groups.h>
#include <cstdio>
#include <cstdint>
namespace cg = cooperative_groups;

constexpr int D_MODEL = 1024, BATCH = 8, SEQ = 2048, NTOK = BATCH * SEQ, DEPTH = 2;
constexpr int D_IN = 2340;
constexpr int OFF_QA = 0, OFF_KA = 384, OFF_VA = 768, OFF_CQ = 1152, OFF_CKV = 1408, OFF_KR = 1536,
              OFF_QC = 1568, OFF_KC = 1824, OFF_VC = 2080, OFF_FC = 2336;
constexpr int ZP = 2560;
constexpr int Z_QA = 0, Z_KA = 384, Z_VA = 768, Z_QC = 1152, Z_KC = 1408, Z_VC = 1664, Z_CKV = 1920, Z_CQ = 2048, Z_KR = 2304, Z_FC = 2336;
constexpr int NQB = 576, NKVB = 768, NQBP = 768;
constexpr int N_EXPERTS = 32, D_EXPERT = 256, PLE_DIM = 256;
constexpr int MAX_SLOTS = 32768 + 32 * 256;
constexpr int NSLOT_TILES = MAX_SLOTS / 256;
constexpr float ALPHA = 1.4142135623730951f;
constexpr float LN_EPS = 1e-5f, RMS_EPS = 1e-6f;
constexpr int NTHREADS = 512;
constexpr int LDS_BYTES = 147456 + 256;

constexpr size_t MiB = 1u << 20;
constexpr size_t WS_CTL = 0;
constexpr size_t WS_COS = 1 * MiB, WS_SIN = 2 * MiB;
constexpr size_t WS_WIN = 3 * MiB;
constexpr size_t WS_WUQ = 8 * MiB;
constexpr size_t WS_WUKV = WS_WUQ + 393216;
constexpr size_t WS_WOUT = 9 * MiB;
constexpr size_t WS_WPG = 11 * MiB;
constexpr size_t WS_WPP = 13 * MiB;
constexpr size_t WS_WGU = 14 * MiB;
constexpr size_t WS_WD = 46 * MiB;
constexpr size_t WS_A16 = 62 * MiB;
constexpr size_t WS_P16 = 94 * MiB;
constexpr size_t WS_Z16 = 110 * MiB;
constexpr size_t WS_HS16 = WS_Z16;
constexpr size_t WS_OUTS16 = WS_Z16;
constexpr size_t WS_QB16 = 190 * MiB;
constexpr size_t WS_KVB16 = 214 * MiB;
constexpr size_t WS_KRR16 = 238 * MiB;
constexpr size_t WS_FC = 239 * MiB;
constexpr size_t WS_CUM = WS_FC + 256 * 1024;
constexpr size_t WS_LOGF = WS_CUM + 256 * 1024;
constexpr size_t WS_RQ = WS_LOGF + 256 * 1024;
constexpr size_t WS_RKV = WS_RQ + 64 * 1024;
constexpr size_t WS_MIX16 = 190 * MiB;
constexpr size_t WS_PP16 = 276 * MiB;
constexpr size_t WS_ACT16 = 222 * MiB;
constexpr size_t WS_MIXED16 = 242 * MiB;
constexpr size_t WS_PLE16 = 242 * MiB;
constexpr size_t WS_RT = 274 * MiB;
constexpr size_t WS_END = 308 * MiB;
constexpr size_t RT_IDS = 0, RT_WTS = 128 * 1024, RT_RANK = 256 * 1024, RT_SLOTOF = 384 * 1024, RT_TILEE = 768 * 1024, RT_TPMAX = 800 * 1024;
constexpr int CW_CNT = 0;
static_assert((WS_A16 - WS_HS16) % (256 * 1024 * 2) == 0 || true, "");

struct Args { const void* in[28]; float* out; unsigned char* ws; int ph_lo, ph_hi; };

#define LAS __attribute__((address_space(3)))
typedef unsigned short bf16;
typedef unsigned v4u __attribute__((ext_vector_type(4)));
typedef unsigned v2u __attribute__((ext_vector_type(2)));
typedef float f32x4_t __attribute__((ext_vector_type(4)));

__device__ __forceinline__ float wave_sum(float v) {
#define WS_DPP(ctrl, rmask) __builtin_bit_cast(float, __builtin_amdgcn_update_dpp(0, __builtin_bit_cast(int, v), (ctrl), (rmask), 0xf, true))
    v += WS_DPP(0x111, 0xf);
    v += WS_DPP(0x112, 0xf);
    v += WS_DPP(0x114, 0xf);
    v += WS_DPP(0x118, 0xf);
    v += WS_DPP(0x142, 0xa);
    v += WS_DPP(0x143, 0xc);
#undef WS_DPP
    return __builtin_bit_cast(float, __builtin_amdgcn_readlane(__builtin_bit_cast(int, v), 63));
}
__device__ __forceinline__ unsigned f2bf(float f) { unsigned u = __builtin_bit_cast(unsigned, f); return (u + 0x7fffu + ((u >> 16) & 1u)) >> 16; }
__device__ __forceinline__ unsigned pk2(float lo, float hi) { return f2bf(lo) | (f2bf(hi) << 16); }
__device__ __forceinline__ float bflo(unsigned w) { return __uint_as_float(w << 16); }
__device__ __forceinline__ float bfhi(unsigned w) { return __uint_as_float(w & 0xffff0000u); }
__device__ __forceinline__ void unpack8(const v4u w, float* f) { f[0] = bflo(w.x); f[1] = bfhi(w.x); f[2] = bflo(w.y); f[3] = bfhi(w.y); f[4] = bflo(w.z); f[5] = bfhi(w.z); f[6] = bflo(w.w); f[7] = bfhi(w.w); }
__device__ __forceinline__ int lane_id_now() { int l; asm volatile("v_mbcnt_lo_u32_b32 %0, -1, 0\n\tv_mbcnt_hi_u32_b32 %0, -1, %0" : "=v"(l)); return l; }
namespace pg8 {
#define PG8_LAS __attribute__((address_space(3)))
typedef unsigned short bf16_t;
typedef short bf16x8 __attribute__((ext_vector_type(8)));
typedef float f32x4 __attribute__((ext_vector_type(4)));
typedef unsigned u32x4 __attribute__((ext_vector_type(4)));
constexpr int BM = 256, BK = 64, HALF = 128, HTB = HALF * BK * 2  , STAGE_BYTES = 8 * HTB, NXCD = 8, WGM = 8;

__host__ __device__ __forceinline__ int lds_byte(int r, int c) { const int st = (r >> 4) * 2 + (c >> 5), rr = r & 15, cc = c & 31, ob = rr * 64 + cc * 2; return st * 1024 + (ob ^ (((ob >> 9) & 1) << 5)); }
__host__ __device__ __forceinline__ void stage_rc(int b, int& R, int& C) { const int st = b / 1024, sb = b % 1024, swz = sb ^ (((sb >> 9) & 1) << 5); R = (st >> 1) * 16 + swz / 64; C = (st & 1) * 32 + (swz % 64) / 2; }
__host__ __device__ __forceinline__ int perm32(int rho) { const int n = rho >> 4, i = rho & 15; return 8 * (i >> 2) + 4 * n + (i & 3); }

struct Unit { int pm, pn; };
struct Gemm { const bf16_t* A; const bf16_t* Bt; int M, N, K, lda, ldb; };

struct StaticOrder {
    int nM, nN, nwg, G, c;
    __host__ __device__ void init(int M, int N, int G_, int c_) { nM = M / BM; nN = N / BM; nwg = nM * nN; G = G_; c = c_; }
    __host__ __device__ bool next(int i, Unit& u) const {
        const long L = (long)i * G + c; if (L >= nwg) return false;
        int wgid = (int)L; { const int q = nwg / NXCD, r = nwg % NXCD, xcd = wgid % NXCD, off = wgid / NXCD; wgid = (xcd < r ? xcd * (q + 1) : r * (q + 1) + (xcd - r) * q) + off; }
        const int nig = WGM * nN, gid = wgid / nig, fm = gid * WGM, gsz = (nM - fm) < WGM ? (nM - fm) : WGM;
        u.pm = fm + ((wgid % nig) % gsz); u.pn = (wgid % nig) / gsz; return true;
    }
    __device__ __forceinline__ void a_ready(const Unit&) const {}
    __device__ __forceinline__ void done(const Unit&) const {}
};

__device__ __forceinline__ unsigned cvt_pk_bf16(float lo, float hi) { unsigned r; asm volatile("v_cvt_pk_bf16_f32 %0, %1, %2" : "=v"(r) : "v"(lo), "v"(hi)); return r; }
typedef float f32x2 __attribute__((ext_vector_type(2)));
__device__ __forceinline__ f32x2 gelu_pk(f32x2 v) {
    const f32x2 av = __builtin_elementwise_abs(v), d = av * 0.2316418882f + 1.0f;
    f32x2 t; t.x = __builtin_amdgcn_rcpf(d.x); t.y = __builtin_amdgcn_rcpf(d.y);
    f32x2 q = t * 0.5307027145f + (-0.7265760135f); q = q * t + 0.7107068705f; q = q * t + (-0.142248368f); q = q * t + 0.127414796f; q = q * t;
    const f32x2 s = (v * v) * (-0.72134752044f);
    f32x2 e; e.x = __builtin_amdgcn_exp2f(s.x); e.y = __builtin_amdgcn_exp2f(s.y);
    const f32x2 m = v * (q * e), r = v - m;
    f32x2 o; o.x = v.x < 0.f ? m.x : r.x; o.y = v.y < 0.f ? m.y : r.y; return o;
}

template <int ACT  > struct EpiBf16 {
    static constexpr bool PERM = true, AFTER_DRAIN = false; static_assert(ACT == 0 || ACT == 1, "EpiBf16: ACT is 0 (none) or 1 (gelu_pk)");
    bf16_t* O; int ldc; const float* bias; int split_cols; size_t split_stride; float scale0;
    __device__ __forceinline__ void operator()(const f32x4 (&acc)[2][2][4][2], const Unit& u, int wr, int wc, int fr, int fq) const {
        const int row0 = u.pm * BM + wr * 64 + fr; int colt = u.pn * BM; bf16_t* base = O;
        float sc = 1.f; if (split_cols) { const int t = colt / split_cols; base += (size_t)t * split_stride; colt -= t * split_cols; if (t == 0) sc = scale0; }
        const int col0 = colt + wc * 32 + 8 * fq, bcol0 = u.pn * BM + wc * 32 + 8 * fq;
        f32x4 bv[2][2];
#pragma unroll
        for (int bj = 0; bj < 2; ++bj)
#pragma unroll
            for (int n = 0; n < 2; ++n) bv[bj][n] = bias ? *(const f32x4*)(bias + bcol0 + bj * HALF + 4 * n) : (f32x4){0.f, 0.f, 0.f, 0.f};
#pragma unroll
        for (int ai = 0; ai < 2; ++ai)
#pragma unroll
            for (int m = 0; m < 4; ++m) { bf16_t* rowp = base + (size_t)(row0 + ai * HALF + m * 16) * ldc + col0;
#pragma unroll
                for (int bj = 0; bj < 2; ++bj) { f32x4 v0 = acc[ai][bj][m][0] + bv[bj][0], v1 = acc[ai][bj][m][1] + bv[bj][1];
                    if (ACT == 1) { f32x2 a = gelu_pk((f32x2){v0[0], v0[1]}), b = gelu_pk((f32x2){v0[2], v0[3]}), c = gelu_pk((f32x2){v1[0], v1[1]}), d = gelu_pk((f32x2){v1[2], v1[3]});
                        v0 = (f32x4){a.x, a.y, b.x, b.y}; v1 = (f32x4){c.x, c.y, d.x, d.y}; }
                    v0 = v0 * sc; v1 = v1 * sc; u32x4 w; w.x = cvt_pk_bf16(v0[0], v0[1]); w.y = cvt_pk_bf16(v0[2], v0[3]); w.z = cvt_pk_bf16(v1[0], v1[1]); w.w = cvt_pk_bf16(v1[2], v1[3]);
                    *(u32x4*)(rowp + bj * HALF) = w; } }
    }
};
template <class Epi, class Sched, bool ALIGN_EPI = false, bool SP2 = false>
__device__ __forceinline__ void gemm_phase(PG8_LAS unsigned char* lds, const Gemm g, const Sched& S, const Epi& E, const int tid) {
    const int wid = __builtin_amdgcn_readfirstlane(tid >> 6), lane = tid & 63, wr = wid >> 2, wc = wid & 3, fr = lane & 15, fq = lane >> 4;
    int K = g.K; asm volatile("" : "+s"(K));
    const int nt = K / BK;
    unsigned voffA[2], voffB[2];
#pragma unroll
    for (int i = 0; i < 2; ++i) { int R, C; stage_rc(tid * 16 + i * 8192, R, C); const int Rb = Epi::PERM ? ((R & ~31) + perm32(R & 31)) : R;
        voffA[i] = (unsigned)(R * g.lda + C) * 2u; voffB[i] = (unsigned)(Rb * g.ldb + C) * 2u; }
    const size_t kstep = (size_t)(BK * 2);
    const size_t hstepA = (size_t)HALF * g.lda * 2, hstepB = (size_t)HALF * g.ldb * 2;
    const size_t tstepA = 2 * hstepA, tstepB = 2 * hstepB;
    const unsigned ldsw = (unsigned)wid * 1024u;
    const int aoff = lds_byte(wr * 64 + fr, fq * 8), boff = lds_byte(wc * 32 + fr, fq * 8);
#define PG8_SA(b, h) (((b) * 2 + (h)) * HTB)
#define PG8_SB(b, h) ((4 + (b) * 2 + (h)) * HTB)
#define PG8_STAGE(bufoff, gbase, voff) do { _Pragma("unroll") for (int _i = 0; _i < 2; ++_i) \
        __builtin_amdgcn_global_load_lds((const unsigned*)((const char*)(gbase) + (voff)[_i]), (PG8_LAS unsigned*)(lds + (bufoff) + ldsw + _i * 8192), 16, 0, 0); } while (0)
#define PG8_LDA(dst, b, h) do { _Pragma("unroll") for (int m = 0; m < 4; ++m) _Pragma("unroll") for (int k = 0; k < 2; ++k) dst[m][k] = *(const PG8_LAS bf16x8*)(lds + PG8_SA(b, h) + aoff + m * 2048 + k * 1024); } while (0)
#define PG8_LDB(dst, b, h) do { _Pragma("unroll") for (int n = 0; n < 2; ++n) _Pragma("unroll") for (int k = 0; k < 2; ++k) dst[n][k] = *(const PG8_LAS bf16x8*)(lds + PG8_SB(b, h) + boff + n * 2048 + k * 1024); } while (0)
#define PG8_MMA(ai, bj, At, Bt) do { __builtin_amdgcn_s_setprio(1); _Pragma("unroll") for (int m = 0; m < 4; ++m) _Pragma("unroll") for (int n = 0; n < 2; ++n) _Pragma("unroll") for (int k = 0; k < 2; ++k) \
        acc[ai][bj][m][n] = __builtin_amdgcn_mfma_f32_16x16x32_bf16(Bt[n][k], At[m][k], acc[ai][bj][m][n], 0, 0, 0); __builtin_amdgcn_s_setprio(0); } while (0)
#define PG8_WAIT_V(n) asm volatile("s_waitcnt vmcnt(" #n ")" ::: "memory")
#define PG8_WAIT_L(n) asm volatile("s_waitcnt lgkmcnt(" #n ")" ::: "memory")
#define PG8_BAR __builtin_amdgcn_s_barrier()
#define PG8_SCHED __builtin_amdgcn_sched_barrier(0)
    Unit cur, nxt; int ui = 0;
    if (!S.next(0, cur)) return;
    f32x4 acc[2][2][4][2];
#pragma unroll
    for (int a = 0; a < 2; ++a)
#pragma unroll
        for (int b = 0; b < 2; ++b)
#pragma unroll
            for (int m = 0; m < 4; ++m)
#pragma unroll
                for (int n = 0; n < 2; ++n) acc[a][b][m][n] = (f32x4){0.f, 0.f, 0.f, 0.f};
    bf16x8 At[4][2], B0[2][2], B1[2][2];
    const char* cA = (const char*)g.A + (size_t)cur.pm * tstepA; const char* cB = (const char*)g.Bt + (size_t)cur.pn * tstepB;
    S.a_ready(cur);
    if constexpr (SP2) {
        PG8_STAGE(PG8_SB(0, 0), cB, voffB); PG8_STAGE(PG8_SB(0, 1), cB + hstepB, voffB); PG8_STAGE(PG8_SA(0, 0), cA, voffA); PG8_STAGE(PG8_SA(0, 1), cA + hstepA, voffA);
        if (wr == 1) PG8_BAR;
        PG8_WAIT_V(2); PG8_BAR;
        PG8_STAGE(PG8_SB(1, 0), cB + kstep, voffB); PG8_STAGE(PG8_SA(1, 0), cA + kstep, voffA); PG8_STAGE(PG8_SB(1, 1), cB + hstepB + kstep, voffB);
        PG8_WAIT_V(6); PG8_BAR;
    } else {
        PG8_STAGE(PG8_SB(0, 0), cB, voffB); PG8_STAGE(PG8_SA(0, 0), cA, voffA); PG8_STAGE(PG8_SB(0, 1), cB + hstepB, voffB); PG8_STAGE(PG8_SA(0, 1), cA + hstepA, voffA);
        if (wr == 1) PG8_BAR;
        PG8_WAIT_V(4); PG8_BAR;
        PG8_STAGE(PG8_SB(1, 0), cB + kstep, voffB); PG8_STAGE(PG8_SA(1, 0), cA + kstep, voffA); PG8_STAGE(PG8_SB(1, 1), cB + hstepB + kstep, voffB);
        PG8_WAIT_V(6); PG8_BAR;
    }
    for (;;) {
        const bool has_next = S.next(ui + 1, nxt);
        const char* nA = has_next ? (const char*)g.A + (size_t)nxt.pm * tstepA : cA; const char* nB = has_next ? (const char*)g.Bt + (size_t)nxt.pn * tstepB : cB;
        for (int t = 0; t < nt; t += 2) {
            const bool last = (t == nt - 2);
            const char* a1 = cA + (size_t)(t + 1) * kstep;
            const char* a2 = last ? nA : cA + (size_t)(t + 2) * kstep; const char* b2 = last ? nB : cB + (size_t)(t + 2) * kstep;
            const char* a3 = a2 + kstep; const char* b3 = b2 + kstep;
            if (last && has_next) S.a_ready(nxt);
            if constexpr (SP2) {
            PG8_LDB(B0, 0, 0); PG8_LDB(B1, 0, 1); PG8_SCHED; PG8_LDA(At, 0, 0); PG8_STAGE(PG8_SA(1, 1), a1 + hstepA, voffA);
            PG8_WAIT_V(8); PG8_WAIT_L(0); PG8_BAR; PG8_MMA(0, 0, At, B0); PG8_MMA(0, 1, At, B1); PG8_BAR; PG8_SCHED;
            PG8_LDA(At, 0, 1); PG8_STAGE(PG8_SB(0, 0), b2, voffB); PG8_STAGE(PG8_SB(0, 1), b2 + hstepB, voffB); PG8_STAGE(PG8_SA(0, 0), a2, voffA);
            PG8_WAIT_V(8); PG8_WAIT_L(0); PG8_BAR; PG8_MMA(1, 0, At, B0); PG8_MMA(1, 1, At, B1); PG8_BAR; PG8_SCHED;
            PG8_LDB(B0, 1, 0); PG8_LDB(B1, 1, 1); PG8_SCHED; PG8_LDA(At, 1, 0); PG8_STAGE(PG8_SA(0, 1), a2 + hstepA, voffA);
            PG8_WAIT_V(8); PG8_WAIT_L(0); PG8_BAR; PG8_MMA(0, 0, At, B0); PG8_MMA(0, 1, At, B1); PG8_BAR; PG8_SCHED;
            PG8_LDA(At, 1, 1); PG8_STAGE(PG8_SB(1, 0), b3, voffB); PG8_STAGE(PG8_SB(1, 1), b3 + hstepB, voffB); PG8_STAGE(PG8_SA(1, 0), a3, voffA);
            PG8_WAIT_V(8); PG8_WAIT_L(0); PG8_BAR; PG8_MMA(1, 0, At, B0); PG8_MMA(1, 1, At, B1); PG8_BAR; PG8_SCHED;
            } else {
            PG8_LDB(B0, 0, 0); PG8_SCHED; PG8_LDA(At, 0, 0); PG8_STAGE(PG8_SA(1, 1), a1 + hstepA, voffA);
            PG8_WAIT_L(8); PG8_BAR; PG8_WAIT_L(0); PG8_MMA(0, 0, At, B0); PG8_BAR; PG8_SCHED;
            PG8_LDB(B1, 0, 1); PG8_STAGE(PG8_SB(0, 0), b2, voffB);
            PG8_BAR; PG8_WAIT_L(0); PG8_MMA(0, 1, At, B1); PG8_BAR;
            PG8_LDA(At, 0, 1); PG8_STAGE(PG8_SA(0, 0), a2, voffA);
            PG8_BAR; PG8_WAIT_L(0); PG8_MMA(1, 0, At, B0); PG8_BAR; PG8_SCHED;
            PG8_STAGE(PG8_SB(0, 1), b2 + hstepB, voffB);
            PG8_WAIT_V(6); PG8_BAR; PG8_MMA(1, 1, At, B1); PG8_BAR;
            PG8_LDB(B0, 1, 0); PG8_SCHED; PG8_LDA(At, 1, 0); PG8_STAGE(PG8_SA(0, 1), a2 + hstepA, voffA);
            PG8_WAIT_L(8); PG8_BAR; PG8_WAIT_L(0); PG8_MMA(0, 0, At, B0); PG8_BAR; PG8_SCHED;
            PG8_LDB(B1, 1, 1); PG8_STAGE(PG8_SB(1, 0), b3, voffB);
            PG8_BAR; PG8_WAIT_L(0); PG8_MMA(0, 1, At, B1); PG8_BAR;
            PG8_LDA(At, 1, 1); PG8_STAGE(PG8_SA(1, 0), a3, voffA);
            PG8_BAR; PG8_WAIT_L(0); PG8_MMA(1, 0, At, B0); PG8_BAR; PG8_SCHED;
            PG8_STAGE(PG8_SB(1, 1), b3 + hstepB, voffB);
            PG8_WAIT_V(6); PG8_BAR; PG8_MMA(1, 1, At, B1); PG8_BAR;
            }
        }
        if constexpr (ALIGN_EPI) { if (wr == 0) PG8_BAR; }
        if constexpr (!Epi::AFTER_DRAIN) { E(acc, cur, wr, wc, fr, fq); S.done(cur); }
        if (!has_next) break;
#pragma unroll
        for (int a = 0; a < 2; ++a)
#pragma unroll
            for (int b = 0; b < 2; ++b)
#pragma unroll
                for (int m = 0; m < 4; ++m)
#pragma unroll
                    for (int n = 0; n < 2; ++n) acc[a][b][m][n] = (f32x4){0.f, 0.f, 0.f, 0.f};
        cur = nxt; cA = nA; cB = nB; ++ui;
        if constexpr (ALIGN_EPI) { if (wr == 1) PG8_BAR; }
    }
    PG8_WAIT_V(0);
    if constexpr (!ALIGN_EPI) { if (wr == 0) PG8_BAR; }
    PG8_BAR;
    if constexpr (Epi::AFTER_DRAIN) { E.fused(acc, cur, wr, wc, fr, fq, lds, wid, lane); S.done(cur); }
#undef PG8_SA
#undef PG8_SB
#undef PG8_STAGE
#undef PG8_LDA
#undef PG8_LDB
#undef PG8_MMA
#undef PG8_WAIT_V
#undef PG8_WAIT_L
#undef PG8_BAR
#undef PG8_SCHED
}
}
#define XB_TMO      128
#define XB_XCNT(j)  (256  + 64 * (j))
#define XB_XSUB(j)  (1280 + 64 * (j))
#define XB_XGEN(j)  (2304 + 64 * (j))
#define XB_TOP      3328
#define XB_TOPGEN   3392
#define XCD_BAR_WORDS 3456
#define XB_SPIN_CAP (1u << 18)

__device__ __forceinline__ unsigned xb_ld(unsigned* p)              { return __hip_atomic_load(p, __ATOMIC_RELAXED, __HIP_MEMORY_SCOPE_AGENT); }
__device__ __forceinline__ unsigned xb_add(unsigned* p, unsigned v) { return __hip_atomic_fetch_add(p, v, __ATOMIC_RELAXED, __HIP_MEMORY_SCOPE_AGENT); }
__device__ __forceinline__ unsigned xb_xcc_id() { return (unsigned)__builtin_amdgcn_s_getreg((3 << 11) | 20) & 0xFu; }
#define XB_SPIN(cond, bar) do { unsigned _sp = 0; while (cond) { __builtin_amdgcn_s_sleep(1); \
    if ((++_sp & 255u) == 0u) { if (xb_ld(&(bar)[XB_TMO])) break; if (_sp > XB_SPIN_CAP) { atomicAdd(&(bar)[XB_TMO], 1u); break; } } } } while (0)

struct XcdBarrier {
    unsigned* bar; unsigned x;
    volatile LAS unsigned* st;
};

__device__ __forceinline__ XcdBarrier xcd_barrier_post(unsigned* bar, volatile LAS unsigned* st) {
    XcdBarrier b; b.bar = bar; b.x = xb_xcc_id(); b.st = st;
    if (threadIdx.x == 0) (void)xb_add(&bar[XB_XCNT(b.x)], 1u);
    return b;
}
__device__ __forceinline__ void xcd_barrier_complete(unsigned* bar, unsigned x, unsigned& nloc, unsigned& nx) {
    const unsigned G = gridDim.x * gridDim.y * gridDim.z;
    unsigned sum, cnt, mine, sp = 0u;
    for (;;) {
        sum = 0u; cnt = 0u; mine = 0u;
#pragma unroll
        for (unsigned j = 0; j < 16; ++j) { const unsigned c = xb_ld(&bar[XB_XCNT(j)]); sum += c; cnt += (c > 0u) ? 1u : 0u; mine = (j == x) ? c : mine; }
        if (sum == G) break;
        __builtin_amdgcn_s_sleep(1);
        if ((++sp & 255u) == 0u) { if (xb_ld(&bar[XB_TMO])) break; if (sp > XB_SPIN_CAP) { atomicAdd(&bar[XB_TMO], 1u); break; } }
    }
    nloc = mine > 0u ? mine : 1u; nx = cnt > 0u ? cnt : 1u;
}

__device__ __forceinline__ void xcd_barrier(const XcdBarrier& b, const bool is_t0) {
    asm volatile("s_waitcnt vmcnt(0)" ::: "memory");
    __syncthreads();
    if (is_t0) {
        unsigned* bar = b.bar;
        __builtin_amdgcn_s_waitcnt(0);
        unsigned nloc = b.st[0], nx = b.st[1];
        if (nloc == 0u) { xcd_barrier_complete(bar, b.x, nloc, nx); b.st[0] = nloc; b.st[1] = nx; }
        const unsigned old = xb_add(&bar[XB_XSUB(b.x)], 1u);
        const unsigned gen = old / nloc;
        if (old + 1u == (gen + 1u) * nloc) {
            __builtin_amdgcn_fence(__ATOMIC_RELEASE, "agent");
            asm volatile("s_waitcnt vmcnt(0)" ::: "memory");
            const unsigned og = xb_add(&bar[XB_TOP], 1u);
            const unsigned tg = og / nx;
            if (og + 1u == (tg + 1u) * nx) xb_add(&bar[XB_TOPGEN], 1u);
            else XB_SPIN(xb_ld(&bar[XB_TOPGEN]) == tg, bar);
            __builtin_amdgcn_fence(__ATOMIC_ACQUIRE, "agent");
            xb_add(&bar[XB_XGEN(b.x)], 1u);
            asm volatile("s_waitcnt vmcnt(0)" ::: "memory");
        } else {
            XB_SPIN(xb_ld(&bar[XB_XGEN(b.x)]) == gen, bar);
            __builtin_amdgcn_fence(__ATOMIC_ACQUIRE, "agent");
            asm volatile("s_waitcnt vmcnt(0)" ::: "memory");
        }
    }
    __syncthreads();
}


namespace pg8 {
struct EpiZ {
    static constexpr bool PERM = true, AFTER_DRAIN = false;
    bf16_t* O; int ldc; float* fcbuf;
    __device__ __forceinline__ void operator()(const f32x4 (&acc)[2][2][4][2], const Unit& u, int wr, int wc, int fr, int fq) const {
        const int row0 = u.pm * BM + wr * 64 + fr, col0 = u.pn * BM + wc * 32 + 8 * fq;
        const bool fcl = (u.pn == 9) && (wc == 1) && (fq == 0);
#pragma unroll
        for (int ai = 0; ai < 2; ++ai)
#pragma unroll
            for (int m = 0; m < 4; ++m) {
                const int row = row0 + ai * HALF + m * 16;
                bf16_t* rowp = O + (size_t)row * ldc + col0;
#pragma unroll
                for (int bj = 0; bj < 2; ++bj) {
                    const f32x4 v0 = acc[ai][bj][m][0], v1 = acc[ai][bj][m][1];
                    u32x4 w; w.x = cvt_pk_bf16(v0[0], v0[1]); w.y = cvt_pk_bf16(v0[2], v0[3]); w.z = cvt_pk_bf16(v1[0], v1[1]); w.w = cvt_pk_bf16(v1[2], v1[3]);
                    *(u32x4*)(rowp + bj * HALF) = w;
                }
                if (fcl) *(f32x4*)(fcbuf + (size_t)row * 4) = acc[ai][0][m][0];
            }
    }
};
struct EpiRowScale {
    static constexpr bool PERM = true, AFTER_DRAIN = false;
    bf16_t* O; int ldc; const float* rs;
    __device__ __forceinline__ void operator()(const f32x4 (&acc)[2][2][4][2], const Unit& u, int wr, int wc, int fr, int fq) const {
        const int row0 = u.pm * BM + wr * 64 + fr, col0 = u.pn * BM + wc * 32 + 8 * fq;
#pragma unroll
        for (int ai = 0; ai < 2; ++ai)
#pragma unroll
            for (int m = 0; m < 4; ++m) {
                const int row = row0 + ai * HALF + m * 16;
                const float s = rs[row];
                bf16_t* rowp = O + (size_t)row * ldc + col0;
#pragma unroll
                for (int bj = 0; bj < 2; ++bj) {
                    const f32x4 v0 = acc[ai][bj][m][0] * s, v1 = acc[ai][bj][m][1] * s;
                    u32x4 w; w.x = cvt_pk_bf16(v0[0], v0[1]); w.y = cvt_pk_bf16(v0[2], v0[3]); w.z = cvt_pk_bf16(v1[0], v1[1]); w.w = cvt_pk_bf16(v1[2], v1[3]);
                    *(u32x4*)(rowp + bj * HALF) = w;
                }
            }
    }
};
struct EpiGU {
    static constexpr bool PERM = true, AFTER_DRAIN = false;
    bf16_t* O;
    __device__ __forceinline__ void operator()(const f32x4 (&acc)[2][2][4][2], const Unit& u, int wr, int wc, int fr, int fq) const {
        const int row0 = u.pm * BM + wr * 64 + fr, f0 = ((u.pn & 1) * BM + wc * 32 + 8 * fq) >> 1;
#pragma unroll
        for (int ai = 0; ai < 2; ++ai)
#pragma unroll
            for (int m = 0; m < 4; ++m) {
                bf16_t* rowp = O + (size_t)(row0 + ai * HALF + m * 16) * 256 + f0;
#pragma unroll
                for (int bj = 0; bj < 2; ++bj) {
                    const f32x4 v0 = acc[ai][bj][m][0], v1 = acc[ai][bj][m][1];
                    const float a0 = v0[0] / (1.f + __expf(-v0[0])) * v0[1], a1 = v0[2] / (1.f + __expf(-v0[2])) * v0[3];
                    const float a2 = v1[0] / (1.f + __expf(-v1[0])) * v1[1], a3 = v1[2] / (1.f + __expf(-v1[2])) * v1[3];
                    typedef unsigned u32x2 __attribute__((ext_vector_type(2)));
                    u32x2 w; w.x = cvt_pk_bf16(a0, a1); w.y = cvt_pk_bf16(a2, a3);
                    *(u32x2*)(rowp + bj * (HALF / 2)) = w;
                }
            }
    }
};
struct EpiPleGate {
    static constexpr bool PERM = true, AFTER_DRAIN = false;
    bf16_t* O; const bf16_t* PP;
    __device__ __forceinline__ void operator()(const f32x4 (&acc)[2][2][4][2], const Unit& u, int wr, int wc, int fr, int fq) const {
        const int row0 = u.pm * BM + wr * 64 + fr, col0 = u.pn * BM + wc * 32 + 8 * fq;
#pragma unroll
        for (int ai = 0; ai < 2; ++ai)
#pragma unroll
            for (int m = 0; m < 4; ++m) {
                const size_t off = (size_t)(row0 + ai * HALF + m * 16) * 1024 + col0;
#pragma unroll
                for (int bj = 0; bj < 2; ++bj) {
                    const f32x4 v0 = acc[ai][bj][m][0], v1 = acc[ai][bj][m][1];
                    const u32x4 pw = *(const u32x4*)(PP + off + bj * HALF);
                    float o[8];
                    o[0] = __uint_as_float(pw.x << 16) / (1.f + __expf(-v0[0])); o[1] = __uint_as_float(pw.x & 0xffff0000u) / (1.f + __expf(-v0[1]));
                    o[2] = __uint_as_float(pw.y << 16) / (1.f + __expf(-v0[2])); o[3] = __uint_as_float(pw.y & 0xffff0000u) / (1.f + __expf(-v0[3]));
                    o[4] = __uint_as_float(pw.z << 16) / (1.f + __expf(-v1[0])); o[5] = __uint_as_float(pw.z & 0xffff0000u) / (1.f + __expf(-v1[1]));
                    o[6] = __uint_as_float(pw.w << 16) / (1.f + __expf(-v1[2])); o[7] = __uint_as_float(pw.w & 0xffff0000u) / (1.f + __expf(-v1[3]));
                    u32x4 w; w.x = cvt_pk_bf16(o[0], o[1]); w.y = cvt_pk_bf16(o[2], o[3]); w.z = cvt_pk_bf16(o[4], o[5]); w.w = cvt_pk_bf16(o[6], o[7]);
                    *(u32x4*)(O + off + bj * HALF) = w;
                }
            }
    }
};
struct EpiDown {
    static constexpr bool PERM = true, AFTER_DRAIN = false;
    bf16_t* O;
    __device__ __forceinline__ void operator()(const f32x4 (&acc)[2][2][4][2], const Unit& u, int wr, int wc, int fr, int fq) const {
        const int row0 = u.pm * BM + wr * 64 + fr, col0 = (u.pn & 3) * BM + wc * 32 + 8 * fq;
#pragma unroll
        for (int ai = 0; ai < 2; ++ai)
#pragma unroll
            for (int m = 0; m < 4; ++m) {
                bf16_t* rowp = O + (size_t)(row0 + ai * HALF + m * 16) * 1024 + col0;
#pragma unroll
                for (int bj = 0; bj < 2; ++bj) {
                    const f32x4 v0 = acc[ai][bj][m][0], v1 = acc[ai][bj][m][1];
                    u32x4 w; w.x = cvt_pk_bf16(v0[0], v0[1]); w.y = cvt_pk_bf16(v0[2], v0[3]); w.z = cvt_pk_bf16(v1[0], v1[1]); w.w = cvt_pk_bf16(v1[2], v1[3]);
                    *(u32x4*)(rowp + bj * HALF) = w;
                }
            }
    }
};
struct GroupSched {
    const int* tile_e; int T, NJ, G, vc;
    __device__ __forceinline__ bool next(int i, Unit& u) const {
        const long L = (long)i * G + vc; if (L >= (long)T * NJ) return false;
        const int t = (int)(L / NJ), j = (int)(L % NJ);
        u.pm = t; u.pn = __builtin_amdgcn_readfirstlane(tile_e[t]) * NJ + j; return true;
    }
    __device__ __forceinline__ void a_ready(const Unit&) const {}
    __device__ __forceinline__ void done(const Unit&) const {}
};
}

template <class Map>
__device__ __forceinline__ void transpose_rows(const Map mp, const float* ks, int nrows_out, int K, bf16* WT, LAS float* scr, int gw, int NGW, int lane) {
    const int nblk = nrows_out / 32, nitems = (K / 64) * nblk;
    const int f = lane & 7, kr = lane >> 3;
    for (int it = gw; it < nitems; it += NGW) {
        const int kb = it / nblk, nb = it % nblk, k0 = 64 * kb, n0 = 32 * nb;
        const float* src; long pitch; float sc; int nl0, nls;
        mp.get4(n0, f, src, pitch, sc, nl0, nls);
        f32x4_t vals[8];
#pragma unroll
        for (int i = 0; i < 8; ++i) vals[i] = src ? *(const f32x4_t*)(src + (size_t)(k0 + kr + 8 * i) * pitch) : (f32x4_t){0.f, 0.f, 0.f, 0.f};
#pragma unroll
        for (int i = 0; i < 8; ++i) {
            const int kk = kr + 8 * i;
            float m = sc; if (ks) m *= ks[k0 + kk];
            scr[kk * 33 + nl0] = vals[i].x * m; scr[kk * 33 + nl0 + nls] = vals[i].y * m; scr[kk * 33 + nl0 + 2 * nls] = vals[i].z * m; scr[kk * 33 + nl0 + 3 * nls] = vals[i].w * m;
        }
        asm volatile("s_waitcnt lgkmcnt(0)" ::: "memory");
        const int c = lane & 7;
#pragma unroll
        for (int j = 0; j < 4; ++j) {
            const int n = (lane >> 3) + 8 * j; const LAS float* s = scr + (8 * c) * 33 + n;
            v4u o; o.x = pk2(s[0 * 33], s[1 * 33]); o.y = pk2(s[2 * 33], s[3 * 33]); o.z = pk2(s[4 * 33], s[5 * 33]); o.w = pk2(s[6 * 33], s[7 * 33]);
            *(v4u*)(WT + (size_t)(n0 + n) * K + k0 + 8 * c) = o;
        }
        asm volatile("s_waitcnt lgkmcnt(0)" ::: "memory");
    }
}
constexpr float LOG2E_W = 1.4426950408889634f;
struct MapIn {
    const float* w;
    __device__ __forceinline__ void get(int n, const float*& src, long& pitch, float& sc) const {
        int c;
        if (n < 1152) c = n;
        else if (n < Z_CKV) c = OFF_QC + (n - Z_QC);
        else if (n < Z_CQ) c = OFF_CKV + (n - Z_CKV);
        else if (n < Z_KR) c = OFF_CQ + (n - Z_CQ);
        else if (n < Z_FC) c = OFF_KR + (n - Z_KR);
        else if (n < Z_FC + 4) c = OFF_FC + (n - Z_FC);
        else c = -1;
        src = c >= 0 ? w + c : nullptr; pitch = D_IN;
        sc = n < Z_KA ? 0.17677669529663687f * LOG2E_W : ((n >= Z_QC && n < Z_KC) ? 0.125f * LOG2E_W : 1.f);
    }
    __device__ __forceinline__ void get4(int n0, int f, const float*& src, long& pitch, float& sc, int& nl0, int& nls) const { get(n0 + 4 * f, src, pitch, sc); nl0 = 4 * f; nls = 1; }
};
struct MapPlain {
    const float* w; int N, nvalid; float scale;
    __device__ __forceinline__ void get(int n, const float*& src, long& pitch, float& sc) const { src = n < nvalid ? w + n : nullptr; pitch = N; sc = scale; }
    __device__ __forceinline__ void get4(int n0, int f, const float*& src, long& pitch, float& sc, int& nl0, int& nls) const { get(n0 + 4 * f, src, pitch, sc); nl0 = 4 * f; nls = 1; }
};

struct MapGU {
    const float* wg; const float* wu;
    __device__ __forceinline__ void get(int n, const float*& src, long& pitch, float& sc) const {
        const int e = n >> 9, r = n & 511, f = r >> 1;
        const long dlt = (r & 1) ? (long)(wu - wg) : 0l;
        src = wg + dlt + (size_t)e * 1024 * 256 + f; pitch = 256; sc = 1.f;
    }
    __device__ __forceinline__ void get4(int n0, int f, const float*& src, long& pitch, float& sc, int& nl0, int& nls) const {
        const int e = n0 >> 9, f0 = (n0 & 511) >> 1;
        const long dlt = (f >> 2) ? (long)(wu - wg) : 0l;
        src = wg + dlt + (size_t)e * 1024 * 256 + f0 + 4 * (f & 3); pitch = 256; sc = 1.f; nl0 = 8 * (f & 3) + (f >> 2); nls = 2;
    }
};
struct MapD {
    const float* wd;
    __device__ __forceinline__ void get(int n, const float*& src, long& pitch, float& sc) const {
        const int e = n >> 10, c = n & 1023;
        src = wd + (size_t)e * 256 * 1024 + c; pitch = 1024; sc = 1.f;
    }
    __device__ __forceinline__ void get4(int n0, int f, const float*& src, long& pitch, float& sc, int& nl0, int& nls) const { get(n0 + 4 * f, src, pitch, sc); nl0 = 4 * f; nls = 1; }
};

struct AttnP {
    const bf16* z16; const bf16* qb16; const bf16* kvb16; const bf16* krr16; const float* cum; const float* cosT; const float* sinT;
    const int* pos; bf16* mixed16; const float* lq1; const float* lk1; const float* lq2; const float* lk2; const float* gdiff; int layer; unsigned* prof; const int* tpmax; float lam, lam_init;
};
typedef short bf16x8_t __attribute__((ext_vector_type(8)));
typedef float f32x16_t __attribute__((ext_vector_type(16)));
typedef short s16x4_t __attribute__((ext_vector_type(4)));
typedef float f32x2_t __attribute__((ext_vector_type(2)));
typedef __bf16 bf16x2_t __attribute__((ext_vector_type(2)));
__device__ __forceinline__ unsigned cvtpk(float lo, float hi) { f32x2_t v = {lo, hi}; bf16x2_t b = __builtin_convertvector(v, bf16x2_t); return __builtin_bit_cast(unsigned, b); }
__device__ __forceinline__ int crow(int r, int hi) { return (r & 3) + 8 * (r >> 2) + 4 * hi; }
__device__ __forceinline__ s16x4_t vtr(const LAS unsigned char* p) { typedef short v4i16_t __attribute__((ext_vector_type(4))); return __builtin_bit_cast(s16x4_t, __builtin_amdgcn_ds_read_tr16_b64_v4i16((LAS v4i16_t*)p)); }
constexpr float LOG2E = 1.4426950408889634f;

__device__ __forceinline__ float xhalf_max(float m) { auto rr = __builtin_amdgcn_permlane32_swap(__float_as_uint(m), __float_as_uint(m), false, false); return __builtin_fmaxf(__uint_as_float(rr[0]), __uint_as_float(rr[1])); }
__device__ __forceinline__ float xhalf_sum(float m) { auto rr = __builtin_amdgcn_permlane32_swap(__float_as_uint(m), __float_as_uint(m), false, false); return __uint_as_float(rr[0]) + __uint_as_float(rr[1]); }
__device__ __forceinline__ float max3f(float a, float b, float c) { return __builtin_fmaxf(__builtin_fmaxf(a, b), c); }
template <int MODE> __device__ __forceinline__ void attn_unit(const AttnP& p, int b, int h, int qblk, LAS unsigned char* lds, const int tid_in) {
    int tid = tid_in * 64 + lane_id_now(); asm volatile("" : "+v"(tid));
#ifdef PROF_SEL
    const unsigned long long pu0 = __builtin_amdgcn_s_memrealtime(); unsigned long long pt0 = 0, pl0 = 0, pacc_c = 0, pacc_b = 0;
#define PROF_T(acc) do { const unsigned long long t_ = __builtin_amdgcn_s_memrealtime(); acc += t_ - pt0; pt0 = t_; } while (0)
#else
#define PROF_T(acc) do {} while (0)
#endif
    constexpr int NF = MODE == 0 ? 2 : (MODE == 1 ? 6 : 4);
    constexpr int NC = MODE == 1 ? 12 : 8;
    constexpr int KB = NC * 1024, KBUF = KB + 256;
    constexpr int VOFF = 2 * KBUF;
    constexpr int KI = (NC * 64 + NTHREADS - 1) / NTHREADS;
    const int lane = tid & 63, w = __builtin_amdgcn_readfirstlane(tid >> 6), r32 = lane & 31, hi = lane >> 5;
    const int map = MODE == 0 ? (w >> 2) : 0, qg = MODE == 0 ? (w & 3) : w;
    const int c = MODE == 0 ? qblk * 2 + (qg >> 1) : qblk * 4 + (qg >> 1);
    const int ntiles = MODE == 0 ? qblk * 2 + 2 : qblk * 4 + 4;
    const long tok0 = (long)b * SEQ;
    const int q0u = MODE == 0 ? qblk * 128 : qblk * 256;
    const long qrow = tok0 + q0u + qg * 32 + r32;
    float slope2 = 0.f, sq = 0.f, refv = 0.f; int qpmin = 0;
    const bf16* ksrc[KI]; bool kok[KI];
#pragma unroll
    for (int i = 0; i < KI; ++i) {
        const int pidx0 = tid + i * NTHREADS;
        kok[i] = pidx0 < NC * 64;
        const int pidx = kok[i] ? pidx0 : pidx0 - NTHREADS, c8 = pidx >> 6, kv = pidx & 63;
        if (MODE == 0) ksrc[i] = p.z16 + (tok0 + kv) * ZP + Z_KA + h * 64 + c8 * 8;
        else if (MODE == 2) ksrc[i] = p.z16 + (tok0 + kv) * ZP + Z_KC + h * 64 + c8 * 8;
        else ksrc[i] = (c8 < 8) ? p.kvb16 + (tok0 + kv) * NKVB + h * 128 + c8 * 8 : p.krr16 + (tok0 + kv) * 32 + (c8 - 8) * 8;
    }
    const int kstride = MODE == 1 ? 0 : 64 * ZP;
    const int vcl = tid & 3, vkv = (tid >> 2) & 63, vch = tid >> 8;
    const bf16* vsrc = MODE == 0 ? p.z16 + (tok0 + vkv) * ZP + Z_VA + h * 64 + (vch * 4 + vcl) * 8
                     : (MODE == 1 ? p.kvb16 + (tok0 + vkv) * NKVB + h * 128 + 64 + (vch * 4 + vcl) * 8 : p.z16 + (tok0 + vkv) * ZP + Z_VC + h * 64 + (vch * 4 + vcl) * 8);
    const int vstride = MODE == 1 ? 64 * NKVB : 64 * ZP;
    LAS unsigned char* const vdstp = lds + VOFF + vch * 4096 + (vkv >> 3) * 512 + (vkv & 7) * 64 + vcl * 16;
    LAS unsigned char* const kdstp = lds + tid * 16;
    v4u kreg0[KI], kreg1[KI], vreg0, vreg1; unsigned breg0 = 0u, breg1 = 0u;
    auto load_k = [&](int kt_, v4u (&kreg)[KI], unsigned& breg) {
        const int kt = kt_ < ntiles ? kt_ : ntiles - 1;
#pragma unroll
        for (int i = 0; i < KI; ++i) {
            const int pidx = tid + i * NTHREADS;
            const long off = MODE == 1 ? (((kok[i] ? pidx : pidx - NTHREADS) >> 6) < 8 ? (long)kt * 64 * NKVB : (long)kt * 64 * 32) : (long)kt * kstride;
            kreg[i] = *(const v4u*)(ksrc[i] + off);
        }
        if (MODE == 0) breg = (unsigned)p.pos[tok0 + kt * 64 + (tid & 63)];
        if (MODE == 2) breg = __float_as_uint(p.cum[(tok0 + kt * 64 + (tid & 63)) * 4 + h]);
    };
    auto load_v = [&](int kt_, v4u& vreg) { const int kt = kt_ < ntiles ? kt_ : ntiles - 1; vreg = *(const v4u*)(vsrc + (long)kt * vstride); };
    auto write_k = [&](const int par, const v4u (&kreg)[KI], const unsigned& breg) {
#pragma unroll
        for (int i = 0; i < KI; ++i) if (kok[i]) *(LAS v4u*)(kdstp + par * KBUF + i * NTHREADS * 16) = kreg[i];
        if (MODE != 1 && tid < 64) *(LAS float*)(lds + par * KBUF + KB + tid * 4) = MODE == 0 ? slope2 * ((float)(int)breg - refv) : (refv - __uint_as_float(breg)) * LOG2E;
    };
    auto write_v = [&](const int par, const v4u& vreg) { *(LAS v4u*)(vdstp + par * 8192) = vreg; };
    load_k(0, kreg0, breg0); load_k(1, kreg1, breg1); load_v(0, vreg0); load_v(1, vreg1);
    bf16x8_t qf[NF];
    {
        const bf16* qsrc = MODE == 0 ? p.z16 + qrow * ZP + Z_QA + h * 64 + map * 32 : (MODE == 1 ? p.qb16 + qrow * NQBP + h * 96 : p.z16 + qrow * ZP + Z_QC + h * 64);
#pragma unroll
        for (int i = 0; i < NF; ++i) qf[i] = *(const bf16x8_t*)(qsrc + i * 16 + hi * 8);
    }
    if (MODE == 1) {
        const float4 c0 = *(const float4*)(p.cosT + qrow * 16 + hi * 8), c1 = *(const float4*)(p.cosT + qrow * 16 + hi * 8 + 4);
        const float4 s0 = *(const float4*)(p.sinT + qrow * 16 + hi * 8), s1 = *(const float4*)(p.sinT + qrow * 16 + hi * 8 + 4);
        const float cs[8] = {c0.x, c0.y, c0.z, c0.w, c1.x, c1.y, c1.z, c1.w}, sn[8] = {s0.x, s0.y, s0.z, s0.w, s1.x, s1.y, s1.z, s1.w};
        float n1[8], n2[8];
#pragma unroll
        for (int j = 0; j < 8; ++j) {
            const float x1 = __uint_as_float((unsigned)(unsigned short)qf[NF - 2][j] << 16), x2 = __uint_as_float((unsigned)(unsigned short)qf[NF - 1][j] << 16);
            n1[j] = x1 * cs[j] - x2 * sn[j]; n2[j] = x2 * cs[j] + x1 * sn[j];
        }
        v4u a, bb;
        a.x = cvtpk(n1[0], n1[1]); a.y = cvtpk(n1[2], n1[3]); a.z = cvtpk(n1[4], n1[5]); a.w = cvtpk(n1[6], n1[7]);
        bb.x = cvtpk(n2[0], n2[1]); bb.y = cvtpk(n2[2], n2[3]); bb.z = cvtpk(n2[4], n2[5]); bb.w = cvtpk(n2[6], n2[7]);
        qf[NF - 2] = __builtin_bit_cast(bf16x8_t, a); qf[NF - 1] = __builtin_bit_cast(bf16x8_t, bb);
    }
    if (MODE == 0) {
        slope2 = exp2f(-8.0f * (float)(h + 1) / 6.0f) * LOG2E;
        const int pref = p.pos[tok0 + q0u]; refv = (float)pref;
        const int pq = p.pos[qrow]; sq = slope2 * (float)(pq - pref);
        int mn = pq;
#pragma unroll
        for (int o_ = 1; o_ < 64; o_ <<= 1) mn = min(mn, __builtin_amdgcn_ds_bpermute((lane ^ o_) << 2, mn));
        qpmin = __builtin_amdgcn_readfirstlane(mn);
    }
    if (MODE == 2) refv = p.cum[(tok0 + q0u) * 4 + h];
    f32x16_t o[2];
    float mrun = -INFINITY, lsum = 0.f;
#pragma unroll
    for (int r = 0; r < 16; ++r) { o[0][r] = 0.f; o[1][r] = 0.f; }
    LAS unsigned char* const kfp = lds + (map * NF * 2 + hi) * 1024 + r32 * 16;
    LAS unsigned char* const bfp = lds + KB + 16 * hi;
    LAS unsigned char* const vfp = lds + VOFF + (4 * hi + ((lane & 15) >> 2)) * 64 + ((lane >> 4) & 1) * 32 + (lane & 3) * 8;
    auto compute_s = [&](const int kt, const int par, f32x16_t& p0, f32x16_t& p1) {
        constexpr int KG = NF > 4 ? 3 : NF;
        bf16x8_t kf0[KG], kf1[KG];
#pragma unroll
        for (int d0 = 0; d0 < KG; ++d0) { kf0[d0] = *(const LAS bf16x8_t*)(kfp + par * KBUF + d0 * 2048); kf1[d0] = *(const LAS bf16x8_t*)(kfp + par * KBUF + d0 * 2048 + 512); }
        if (MODE == 1) {
#pragma unroll
            for (int r = 0; r < 16; ++r) { p0[r] = 0.f; p1[r] = 0.f; }
        } else {
#pragma unroll
            for (int g = 0; g < 4; ++g) {
                const f32x4_t b0 = *(const LAS f32x4_t*)(bfp + par * KBUF + 32 * g), b1 = *(const LAS f32x4_t*)(bfp + par * KBUF + 128 + 32 * g);
                p0[4 * g] = b0.x; p0[4 * g + 1] = b0.y; p0[4 * g + 2] = b0.z; p0[4 * g + 3] = b0.w;
                p1[4 * g] = b1.x; p1[4 * g + 1] = b1.y; p1[4 * g + 2] = b1.z; p1[4 * g + 3] = b1.w;
            }
        }
        __builtin_amdgcn_sched_barrier(0);
#pragma unroll
        for (int d0 = 0; d0 < KG; ++d0) {
            p0 = __builtin_amdgcn_mfma_f32_32x32x16_bf16(kf0[d0], qf[d0], p0, 0, 0, 0);
            p1 = __builtin_amdgcn_mfma_f32_32x32x16_bf16(kf1[d0], qf[d0], p1, 0, 0, 0);
        }
        if (NF > KG) {
#pragma unroll
            for (int d0 = KG; d0 < NF; ++d0) { kf0[d0 - KG] = *(const LAS bf16x8_t*)(kfp + par * KBUF + d0 * 2048); kf1[d0 - KG] = *(const LAS bf16x8_t*)(kfp + par * KBUF + d0 * 2048 + 512); }
#pragma unroll
            for (int d0 = KG; d0 < NF; ++d0) {
                p0 = __builtin_amdgcn_mfma_f32_32x32x16_bf16(kf0[d0 - KG], qf[d0], p0, 0, 0, 0);
                p1 = __builtin_amdgcn_mfma_f32_32x32x16_bf16(kf1[d0 - KG], qf[d0], p1, 0, 0, 0);
            }
        }
        if (MODE == 0) {
            if (kt == c || p.tpmax[b * 32 + kt] > qpmin) {
#pragma unroll
                for (int g = 0; g < 4; ++g) {
                    const f32x4_t b0 = *(const LAS f32x4_t*)(bfp + par * KBUF + 32 * g), b1 = *(const LAS f32x4_t*)(bfp + par * KBUF + 128 + 32 * g);
                    p0[4 * g] += 2.f * fminf(sq - b0.x, 0.f); p0[4 * g + 1] += 2.f * fminf(sq - b0.y, 0.f); p0[4 * g + 2] += 2.f * fminf(sq - b0.z, 0.f); p0[4 * g + 3] += 2.f * fminf(sq - b0.w, 0.f);
                    p1[4 * g] += 2.f * fminf(sq - b1.x, 0.f); p1[4 * g + 1] += 2.f * fminf(sq - b1.y, 0.f); p1[4 * g + 2] += 2.f * fminf(sq - b1.z, 0.f); p1[4 * g + 3] += 2.f * fminf(sq - b1.w, 0.f);
                }
            }
        }
        if (MODE == 2) {
            if (kt == c) {
                const int qi = (qg & 1) * 32 + r32;
#pragma unroll
                for (int r = 0; r < 16; ++r) { const int kv = crow(r, hi); if (kv > qi) p0[r] = -INFINITY; if (kv + 32 > qi) p1[r] = -INFINITY; }
            }
        }
    };
    auto softmax_pv = [&](const int par, f32x16_t& p0, f32x16_t& p1) {
        constexpr int VE = 4;
        s16x4_t vlo[8], vhi[8];
#pragma unroll
        for (int i = 0; i < VE; ++i) { vlo[i] = vtr(vfp + par * 8192 + (i & 1) * 4096 + (i >> 1) * 1024); vhi[i] = vtr(vfp + par * 8192 + (i & 1) * 4096 + (i >> 1) * 1024 + 512); }
        __builtin_amdgcn_sched_barrier(0);
        float tm0 = max3f(p0[0], p0[1], p0[2]), tm1 = max3f(p1[0], p1[1], p1[2]);
#pragma unroll
        for (int r = 3; r < 15; r += 2) { tm0 = max3f(tm0, p0[r], p0[r + 1]); tm1 = max3f(tm1, p1[r], p1[r + 1]); }
        float tmax = max3f(tm0, tm1, p0[15]); tmax = __builtin_fmaxf(tmax, p1[15]);
        tmax = xhalf_max(tmax);
        const float mnew = __builtin_fmaxf(mrun, tmax);
        if (__any(mnew > mrun)) {
            const float f = __builtin_amdgcn_exp2f(mrun - mnew);
            lsum *= f;
#pragma unroll
            for (int r = 0; r < 16; ++r) { o[0][r] *= f; o[1][r] *= f; }
            mrun = mnew;
        }
        float ls0 = 0.f, ls1 = 0.f;
#pragma unroll
        for (int r = 0; r < 16; ++r) { p0[r] = __builtin_amdgcn_exp2f(p0[r] - mnew); p1[r] = __builtin_amdgcn_exp2f(p1[r] - mnew); ls0 += p0[r]; ls1 += p1[r]; }
        lsum += ls0 + ls1;
        bf16x8_t pa[4];
#pragma unroll
        for (int ks = 0; ks < 4; ++ks) {
            v4u wv;
            if (ks < 2) { wv.x = cvtpk(p0[8 * ks + 0], p0[8 * ks + 1]); wv.y = cvtpk(p0[8 * ks + 2], p0[8 * ks + 3]); wv.z = cvtpk(p0[8 * ks + 4], p0[8 * ks + 5]); wv.w = cvtpk(p0[8 * ks + 6], p0[8 * ks + 7]); }
            else { wv.x = cvtpk(p1[8 * (ks - 2) + 0], p1[8 * (ks - 2) + 1]); wv.y = cvtpk(p1[8 * (ks - 2) + 2], p1[8 * (ks - 2) + 3]); wv.z = cvtpk(p1[8 * (ks - 2) + 4], p1[8 * (ks - 2) + 5]); wv.w = cvtpk(p1[8 * (ks - 2) + 6], p1[8 * (ks - 2) + 7]); }
            pa[ks] = __builtin_bit_cast(bf16x8_t, wv);
        }
#pragma unroll
        for (int i = VE; i < 8; ++i) { vlo[i] = vtr(vfp + par * 8192 + (i & 1) * 4096 + (i >> 1) * 1024); vhi[i] = vtr(vfp + par * 8192 + (i & 1) * 4096 + (i >> 1) * 1024 + 512); }
#pragma unroll
        for (int ks = 0; ks < 4; ++ks)
#pragma unroll
            for (int blk = 0; blk < 2; ++blk) {
                const s16x4_t lo = vlo[ks * 2 + blk], hi4 = vhi[ks * 2 + blk];
                const bf16x8_t vf = {lo[0], lo[1], lo[2], lo[3], hi4[0], hi4[1], hi4[2], hi4[3]};
                o[blk] = __builtin_amdgcn_mfma_f32_32x32x16_bf16(vf, pa[ks], o[blk], 0, 0, 0);
            }
    };
    constexpr bool PIPE = (MODE == 2);
    f32x16_t pA0, pA1, pB0, pB1;
    if (PIPE) {
        write_k(0, kreg0, breg0); write_k(1, kreg1, breg1); write_v(0, vreg0);
        load_k(2, kreg0, breg0);
        __syncthreads();
        compute_s(0, 0, pA0, pA1);
        __syncthreads();
    } else {
        write_k(0, kreg0, breg0); write_v(0, vreg0);
        __syncthreads();
    }
#ifdef PROF_SEL
    pl0 = __builtin_amdgcn_s_memrealtime();
#endif
#pragma unroll 1
    for (int kt = 0; kt < ntiles; kt += 2) {
#ifdef PROF_SEL
        pt0 = __builtin_amdgcn_s_memrealtime();
#endif
        if (PIPE) {
            load_k(kt + 3, kreg1, breg1); load_v(kt + 2, vreg0);
            if (kt < c) { compute_s(kt + 1, 1, pB0, pB1); __builtin_amdgcn_sched_barrier(0); softmax_pv(0, pA0, pA1); }
            else if (kt == c) softmax_pv(0, pA0, pA1);
            write_k(0, kreg0, breg0); write_v(1, vreg1);
        } else {
            load_k(kt + 2, kreg0, breg0); load_v(kt + 2, vreg0);
            if (kt <= c) { compute_s(kt, 0, pA0, pA1); softmax_pv(0, pA0, pA1); }
            write_k(1, kreg1, breg1); write_v(1, vreg1);
        }
        PROF_T(pacc_c);
        __syncthreads();
        PROF_T(pacc_b);
        if (PIPE) {
            load_k(kt + 4, kreg0, breg0); load_v(kt + 3, vreg1);
            if (kt + 1 < c) { compute_s(kt + 2, 0, pA0, pA1); __builtin_amdgcn_sched_barrier(0); softmax_pv(1, pB0, pB1); }
            else if (kt + 1 == c) softmax_pv(1, pB0, pB1);
            write_k(1, kreg1, breg1); write_v(0, vreg0);
        } else {
            load_k(kt + 3, kreg1, breg1); load_v(kt + 3, vreg1);
            if (kt + 1 <= c) { compute_s(kt + 1, 1, pA0, pA1); softmax_pv(1, pA0, pA1); }
            write_k(0, kreg0, breg0); write_v(0, vreg0);
        }
        PROF_T(pacc_c);
        __syncthreads();
        PROF_T(pacc_b);
    }
#ifdef PROF_SEL
    const unsigned long long pl1 = __builtin_amdgcn_s_memrealtime();
#endif
    const float inv = 1.f / xhalf_sum(lsum);
    int tid2 = tid_in * 64 + lane_id_now(); asm volatile("" : "+v"(tid2));
    const int lane2 = tid2 & 63, hi2 = lane2 >> 5, qg2 = MODE == 0 ? ((tid2 >> 6) & 3) : (tid2 >> 6);
    const long qrow2 = tok0 + q0u + qg2 * 32 + (lane2 & 31);
    bf16* op = p.mixed16 + qrow2 * D_MODEL + (MODE == 0 ? 0 : (MODE == 1 ? 384 : 768)) + h * 64;
    if (MODE == 0) {
        LAS float* xb = (LAS float*)lds + qg2 * 2048 + lane2;
        if (map == 1) {
#pragma unroll
            for (int blk = 0; blk < 2; ++blk)
#pragma unroll
                for (int r = 0; r < 16; ++r) xb[(blk * 16 + r) * 64] = o[blk][r] * inv;
        }
        __syncthreads();
        if (map == 0) {
            const float lam_init = p.lam_init, lam = p.lam;
            float ss = 0.f;
#pragma unroll
            for (int blk = 0; blk < 2; ++blk)
#pragma unroll
                for (int r = 0; r < 16; ++r) { const float v = o[blk][r] * inv - lam * xb[(blk * 16 + r) * 64]; o[blk][r] = v; ss = fmaf(v, v, ss); }
            ss = xhalf_sum(ss);
            const float rr = rsqrtf(ss * (1.f / 64.f) + RMS_EPS) * (1.f - lam_init);
#pragma unroll
            for (int blk = 0; blk < 2; ++blk)
#pragma unroll
                for (int g = 0; g < 4; ++g) {
                    const int d = 32 * blk + 8 * g + 4 * hi2;
                    const float4 gv = *(const float4*)(p.gdiff + d);
                    v2u wv; wv.x = cvtpk(o[blk][4 * g] * rr * gv.x, o[blk][4 * g + 1] * rr * gv.y); wv.y = cvtpk(o[blk][4 * g + 2] * rr * gv.z, o[blk][4 * g + 3] * rr * gv.w);
                    *(v2u*)(op + d) = wv;
                }
        }
        __syncthreads();
    } else {
#pragma unroll
        for (int blk = 0; blk < 2; ++blk)
#pragma unroll
            for (int g = 0; g < 4; ++g) {
                const int d = 32 * blk + 8 * g + 4 * hi2;
                v2u wv; wv.x = cvtpk(o[blk][4 * g] * inv, o[blk][4 * g + 1] * inv); wv.y = cvtpk(o[blk][4 * g + 2] * inv, o[blk][4 * g + 3] * inv);
                *(v2u*)(op + d) = wv;
            }
    }
#ifdef PROF_SEL
    if (p.layer == 0 && blockIdx.x == 7 && w == PROF_WAVE && lane == 0) {
        unsigned* pw = p.prof; const unsigned long long pu1 = __builtin_amdgcn_s_memrealtime();
        atomicAdd(pw + 0, (unsigned)(pu1 - pu0)); atomicAdd(pw + 1, (unsigned)(pl1 - pl0)); atomicAdd(pw + 2, (unsigned)pacc_c); atomicAdd(pw + 3, (unsigned)pacc_b);
        atomicAdd(pw + 4, (unsigned)ntiles * 100u); atomicAdd(pw + 5, 10000u); atomicAdd(pw + 6, (unsigned)(c + 1) * 100u);
    }
#endif
}

__device__ __forceinline__ void convert_layer_weights(const Args& a, int l, unsigned char* ws, LAS float* scr, int gw, int NGW, int lane) {
    const float* w_in = (const float*)a.in[3] + (size_t)l * D_MODEL * D_IN;
    const float* w_uq = (const float*)a.in[4] + (size_t)l * 256 * NQB;
    const float* w_ukv = (const float*)a.in[5] + (size_t)l * 128 * NKVB;
    const float* g_cq = (const float*)a.in[6] + l * 256;
    const float* g_ckv = (const float*)a.in[7] + l * 128;
    const float* w_out = (const float*)a.in[14] + (size_t)l * 1024 * 1024;
    transpose_rows(MapIn{w_in}, nullptr, ZP, 1024, (bf16*)(ws + WS_WIN), scr, gw, NGW, lane);
    transpose_rows(MapPlain{w_uq, NQB, NQB, 0.10206207261596575f * LOG2E_W}, g_cq, NQBP, 256, (bf16*)(ws + WS_WUQ), scr, gw, NGW, lane);
    transpose_rows(MapPlain{w_ukv, NKVB, NKVB, 1.f}, g_ckv, NKVB, 128, (bf16*)(ws + WS_WUKV), scr, gw, NGW, lane);
    transpose_rows(MapPlain{w_out, 1024, 1024, 1.f}, nullptr, 1024, 1024, (bf16*)(ws + WS_WOUT), scr, gw, NGW, lane);
    transpose_rows(MapPlain{(const float*)a.in[24] + (size_t)l * 1024 * 1024, 1024, 1024, 1.f}, nullptr, 1024, 1024, (bf16*)(ws + WS_WPG), scr, gw, NGW, lane);
    transpose_rows(MapPlain{(const float*)a.in[25] + (size_t)l * 256 * 1024, 1024, 1024, 1.f}, nullptr, 1024, 256, (bf16*)(ws + WS_WPP), scr, gw, NGW, lane);
    transpose_rows(MapGU{(const float*)a.in[21] + (size_t)l * 32 * 1024 * 256, (const float*)a.in[22] + (size_t)l * 32 * 1024 * 256}, nullptr, 32 * 512, 1024, (bf16*)(ws + WS_WGU), scr, gw, NGW, lane);
    transpose_rows(MapD{(const float*)a.in[23] + (size_t)l * 32 * 256 * 1024}, nullptr, 32 * 1024, 256, (bf16*)(ws + WS_WD), scr, gw, NGW, lane);
}

constexpr int LDS_MISC = 147456;
constexpr int PH_PER_LAYER = 10, NPH = 1 + DEPTH * PH_PER_LAYER;
template <int PH, bool DUMMY = false> __device__ __forceinline__ void run_phase(const Args& a, unsigned char* lds_raw, const int wave_s) {
    float* sm = (float*)lds_raw;
    const int G = gridDim.x, NGW = G * 8, NGT = G * NTHREADS;
    unsigned char* ws = a.ws;
    const float* x0 = (const float*)a.in[0];
    const float* pin = (const float*)a.in[1];
    const int* pos = (const int*)a.in[2];
    float* cosT = (float*)(ws + WS_COS); float* sinT = (float*)(ws + WS_SIN);
    bf16* a16 = (bf16*)(ws + WS_A16); bf16* z16 = (bf16*)(ws + WS_Z16); bf16* qb16 = (bf16*)(ws + WS_QB16); bf16* kvb16 = (bf16*)(ws + WS_KVB16);
    bf16* krr16 = (bf16*)(ws + WS_KRR16); float* fcbuf = (float*)(ws + WS_FC); float* cum = (float*)(ws + WS_CUM); float* logf = (float*)(ws + WS_LOGF);
    float* rq = (float*)(ws + WS_RQ); float* rkv = (float*)(ws + WS_RKV);
    bf16* mixed16 = (bf16*)(ws + WS_MIXED16); bf16* mix16 = (bf16*)(ws + WS_MIX16);
    bf16* hs16 = (bf16*)(ws + WS_HS16); bf16* act16 = (bf16*)(ws + WS_ACT16); bf16* outs16 = (bf16*)(ws + WS_OUTS16); bf16* ple16 = (bf16*)(ws + WS_PLE16); bf16* pp16 = (bf16*)(ws + WS_PP16); bf16* p16 = (bf16*)(ws + WS_P16);
    int* ids = (int*)(ws + WS_RT + RT_IDS); float* wts = (float*)(ws + WS_RT + RT_WTS); int* rank = (int*)(ws + WS_RT + RT_RANK);
    int* slot_of = (int*)(ws + WS_RT + RT_SLOTOF); int* tile_e = (int*)(ws + WS_RT + RT_TILEE);
    unsigned* ctl = (unsigned*)(ws + WS_CTL);

        int tid = wave_s * 64 + lane_id_now(); asm volatile("" : "+v"(tid));
        const int lane = tid & 63, wave = __builtin_amdgcn_readfirstlane(tid >> 6);
        const int gw = blockIdx.x * 8 + wave, gtid = blockIdx.x * NTHREADS + tid;
        LAS float* scr = (LAS float*)((LAS unsigned char*)lds_raw + wave * 16384);
        if constexpr (PH == 0) {
            for (int i = gtid; i < NTOK * 16; i += NGT) {
                const int tk = i >> 4, j = i & 15;
                const int j4 = j >> 2, jr = j & 3;
                const double inv = (j4 == 0 ? 1.0 : (j4 == 1 ? 0.1 : (j4 == 2 ? 0.01 : 0.001))) * (jr == 0 ? 1.0 : (jr == 1 ? 0.5623413251903491 : (jr == 2 ? 0.31622776601683794 : 0.1778279410038923)));
                const double ang = (double)pos[tk] * inv;
                const double k = rint(ang * 0.15915494309189535);
                const double r = fma(-k, 6.283185307179586, ang) - k * 2.4492935982947064e-16;
                cosT[i] = cosf((float)r); sinT[i] = sinf((float)r);
            }
            auto cvt_stream = [&](const float* sp, bf16* dp, int n8) {
                for (int i = gtid; i < n8; i += 4 * NGT) {
                    f32x4_t v[8];
#pragma unroll
                    for (int u = 0; u < 4; ++u) { v[2 * u] = *(const f32x4_t*)(sp + (size_t)(i + u * NGT) * 8); v[2 * u + 1] = *(const f32x4_t*)(sp + (size_t)(i + u * NGT) * 8 + 4); }
#pragma unroll
                    for (int u = 0; u < 4; ++u) { v4u o; o.x = pk2(v[2 * u].x, v[2 * u].y); o.y = pk2(v[2 * u].z, v[2 * u].w); o.z = pk2(v[2 * u + 1].x, v[2 * u + 1].y); o.w = pk2(v[2 * u + 1].z, v[2 * u + 1].w);
                        *(v4u*)(dp + (size_t)(i + u * NGT) * 8) = o; }
                }
            };
            for (int i = gw; i < BATCH * 32; i += NGW) {
                int v = pos[i * 64 + lane];
#pragma unroll
                for (int o_ = 1; o_ < 64; o_ <<= 1) v = max(v, __shfl_xor(v, o_));
                if (lane == 0) ((int*)(ws + WS_RT + RT_TPMAX))[i] = v;
            }
            cvt_stream(x0, a16, NTOK * D_MODEL / 8);
            cvt_stream(pin, p16, DEPTH * NTOK * PLE_DIM / 8);
            convert_layer_weights(a, 0, ws, scr, gw, NGW, lane);
        } else {
            constexpr int l = (PH - 1) / PH_PER_LAYER, sp = (PH - 1) % PH_PER_LAYER;
            const float* b_forget = (const float*)a.in[13] + l * 4;
            const float* ln1_g = (const float*)a.in[15] + l * 1024; const float* ln1_b = (const float*)a.in[16] + l * 1024;
            const float* w_group = (const float*)a.in[17] + l * 1024 * 4; const float* b_group = (const float*)a.in[18] + l * 4;
            const float* w_er = (const float*)a.in[19] + (size_t)l * 4 * 1024 * 8; const float* b_er = (const float*)a.in[20] + l * 32;
            const float* ln2_g = (const float*)a.in[26] + l * 1024; const float* ln2_b = (const float*)a.in[27] + l * 1024;
            unsigned* cnt = ctl + CW_CNT + l * 2048 + (DUMMY ? 8192 : 0);
            if (DUMMY) rank = (int*)(ws + WS_RT + 512 * 1024);
            if constexpr (sp == 0) {
                pg8::Gemm g{a16, (const bf16*)(ws + WS_WIN), NTOK, ZP, 1024, 1024, 1024};
                pg8::StaticOrder S; S.init(NTOK, ZP, G, (int)blockIdx.x);
                pg8::EpiZ E{z16, ZP, fcbuf};
                pg8::gemm_phase<pg8::EpiZ, pg8::StaticOrder, true, true>((LAS unsigned char*)lds_raw, g, S, E, tid);
                {
                    pg8::Gemm g2{p16 + (size_t)l * NTOK * PLE_DIM, (const bf16*)(ws + WS_WPP), NTOK, 1024, 256, 256, 256};
                    const int bx = (int)blockIdx.x;
                    pg8::StaticOrder S2; S2.init(NTOK, 1024, G / 2, bx >= G / 2 ? bx - G / 2 : 1 << 20);
                    pg8::EpiBf16<0> E2{pp16, 1024, nullptr, 0, 0, 1.f};
                    pg8::gemm_phase<pg8::EpiBf16<0>, pg8::StaticOrder, true, true>((LAS unsigned char*)lds_raw, g2, S2, E2, tid);
                }
            } else if constexpr (sp == 1) {
                const int g16 = lane >> 4, l16 = lane & 15;
                for (int tk = gw * 4 + g16; tk < NTOK; tk += NGW * 4) {
                    const bf16* zr = z16 + (size_t)tk * ZP;
                    const v4u ca = *(const v4u*)(zr + Z_CQ + l16 * 16), cb = *(const v4u*)(zr + Z_CQ + l16 * 16 + 8);
                    const v4u ka = *(const v4u*)(zr + Z_CKV + l16 * 8);
                    const unsigned short kr1 = zr[Z_KR + l16], kr2 = zr[Z_KR + 16 + l16];
                    const float cs = cosT[tk * 16 + l16], sn = sinT[tk * 16 + l16];
                    const float fcv = fcbuf[tk * 4 + (l16 & 3)];
                    float f[8]; float ss = 0.f;
                    unpack8(ca, f);
#pragma unroll
                    for (int i = 0; i < 8; ++i) ss = fmaf(f[i], f[i], ss);
                    unpack8(cb, f);
#pragma unroll
                    for (int i = 0; i < 8; ++i) ss = fmaf(f[i], f[i], ss);
                    float s2 = 0.f;
                    unpack8(ka, f);
#pragma unroll
                    for (int i = 0; i < 8; ++i) s2 = fmaf(f[i], f[i], s2);
#pragma unroll
                    for (int o = 1; o < 16; o <<= 1) { ss += __shfl_xor(ss, o); s2 += __shfl_xor(s2, o); }
                    if (l16 == 0) { rq[tk] = rsqrtf(ss * (1.f / 256.f) + RMS_EPS); rkv[tk] = rsqrtf(s2 * (1.f / 128.f) + RMS_EPS); }
                    const float x1 = __uint_as_float((unsigned)kr1 << 16), x2 = __uint_as_float((unsigned)kr2 << 16);
                    krr16[tk * 32 + l16] = (bf16)f2bf(x1 * cs - x2 * sn); krr16[tk * 32 + 16 + l16] = (bf16)f2bf(x2 * cs + x1 * sn);
                    if (l16 < 4) {
                        const float xf = fcv + b_forget[l16];
                        logf[tk * 4 + l16] = fminf(xf, 0.f) - log1pf(expf(-fabsf(xf)));
                    }
                }
            } else if constexpr (sp == 2) {
                {
                    pg8::Gemm g{z16 + Z_CQ, (const bf16*)(ws + WS_WUQ), NTOK, NQBP, 256, ZP, 256};
                    pg8::StaticOrder S; S.init(NTOK, NQBP, G, (int)blockIdx.x);
                    pg8::EpiRowScale E{qb16, NQBP, rq};
                    pg8::gemm_phase<pg8::EpiRowScale, pg8::StaticOrder, true, true>((LAS unsigned char*)lds_raw, g, S, E, tid);
                }
                {
                    pg8::Gemm g{z16 + Z_CKV, (const bf16*)(ws + WS_WUKV), NTOK, NKVB, 128, ZP, 128};
                    pg8::StaticOrder S; S.init(NTOK, NKVB, G, (int)((blockIdx.x + 128) % G));
                    pg8::EpiRowScale E{kvb16, NKVB, rkv};
                    pg8::gemm_phase<pg8::EpiRowScale, pg8::StaticOrder, true, true>((LAS unsigned char*)lds_raw, g, S, E, tid);
                }
                const int cw = NGW - 1 - gw;
                if (cw < 32) {
                    const int b = cw >> 2, hh = cw & 3;
                    float* cp = cum + ((size_t)b * SEQ) * 4 + hh; const float* lp = logf + ((size_t)b * SEQ) * 4 + hh;
                    float loc[32]; float run = 0.f;
#pragma unroll
                    for (int i = 0; i < 32; ++i) { run += lp[(size_t)(lane * 32 + i) * 4]; loc[i] = run; }
                    float pre = run;
#pragma unroll
                    for (int o = 1; o < 64; o <<= 1) { const float n = __shfl_up(pre, o); if (lane >= o) pre += n; }
                    pre -= run;
#pragma unroll
                    for (int i = 0; i < 32; ++i) cp[(size_t)(lane * 32 + i) * 4] = loc[i] + pre;
                }
            } else if constexpr (sp == 3) {
                float lam_init_, lam_;
                {
                    const float* lq1 = (const float*)a.in[8] + l * 32; const float* lk1 = (const float*)a.in[9] + l * 32; const float* lq2 = (const float*)a.in[10] + l * 32; const float* lk2 = (const float*)a.in[11] + l * 32;
                    lam_init_ = 0.8f - 0.6f * expf(-0.3f * (float)l);
                    float s1 = 0.f, s2 = 0.f;
                    for (int i = 0; i < 32; ++i) { s1 += lq1[i] * lk1[i]; s2 += lq2[i] * lk2[i]; }
                    lam_ = expf(s1) - expf(s2) + lam_init_;
                }
                AttnP p{z16, qb16, kvb16, krr16, cum, cosT, sinT, pos, mixed16,
                        (const float*)a.in[8] + l * 32, (const float*)a.in[9] + l * 32, (const float*)a.in[10] + l * 32, (const float*)a.in[11] + l * 32,
                        (const float*)a.in[12] + l * 64, l, ctl + 14000, (const int*)(ws + WS_RT + RT_TPMAX), lam_, lam_init_};
                volatile LAS int* qslot = (volatile LAS int*)((LAS unsigned char*)lds_raw + LDS_MISC) + 48;
                unsigned* qctr = ctl + 12288 + l * 64 + (DUMMY ? 32 : 0);
                int idx = (int)blockIdx.x;
                for (;;) {
                    if (idx >= 1408) break;
                    int nxt_idx = 0;
                    if (wave_s == 0 && lane_id_now() == 0) nxt_idx = G + (int)atomicAdd(qctr, 1u);
                    const int pi = idx / 176, r = idx % 176, thi = 32 - 4 * pi;
                    if (r < 48) attn_unit<0>(p, r / 6, r % 6, thi / 2 - 1, (LAS unsigned char*)lds_raw, wave_s);
                    else if (r < 96) attn_unit<1>(p, (r - 48) / 6, (r - 48) % 6, thi / 4 - 1, (LAS unsigned char*)lds_raw, wave_s);
                    else if (r < 128) attn_unit<2>(p, (r - 96) / 4, (r - 96) % 4, thi / 4 - 1, (LAS unsigned char*)lds_raw, wave_s);
                    else attn_unit<0>(p, (r - 128) / 6, (r - 128) % 6, (thi - 2) / 2 - 1, (LAS unsigned char*)lds_raw, wave_s);
                    __syncthreads();
                    if (wave_s == 0 && lane_id_now() == 0) *qslot = nxt_idx;
                    __syncthreads();
                    idx = __builtin_amdgcn_readfirstlane(*qslot);
                }
            } else if constexpr (sp == 4) {
                pg8::Gemm g{mixed16, (const bf16*)(ws + WS_WOUT), NTOK, 1024, 1024, 1024, 1024};
                pg8::StaticOrder S; S.init(NTOK, 1024, G, (int)blockIdx.x);
                pg8::EpiBf16<0> E{mix16, 1024, nullptr, 0, 0, 1.f};
                pg8::gemm_phase<pg8::EpiBf16<0>, pg8::StaticOrder, true, true>((LAS unsigned char*)lds_raw, g, S, E, tid);
            } else if constexpr (sp == 5) {
#ifdef PROF_LN1
                if (l == 0 && blockIdx.x == 0 && tid == 0) ctl[14000 + 19] = (unsigned)(__builtin_amdgcn_s_memrealtime() & 0xffffffffu);
#endif
                LAS f32x4_t* Lg = (LAS f32x4_t*)lds_raw; LAS f32x4_t* Le = Lg + 1024;
                LAS unsigned* lcnt = (LAS unsigned*)((LAS unsigned char*)lds_raw + LDS_MISC) + 16;
                __syncthreads();
                if (tid < 32) lcnt[tid] = 0u;
                for (int k = tid; k < 1024; k += NTHREADS) { const int j = k >> 8, ln = (k & 255) >> 2, i = k & 3; Lg[(j * 4 + i) * 64 + ln] = *(const f32x4_t*)(w_group + (size_t)k * 4); }
                for (int q = tid; q < 4 * 1024 * 2; q += NTHREADS) { const int g = q >> 11, k = (q >> 1) & 1023, half = q & 1; const int j = k >> 8, ln = (k & 255) >> 2, i = k & 3;
                    Le[((g * 16 + j * 4 + i) * 2 + half) * 64 + ln] = *(const f32x4_t*)(w_er + (size_t)q * 4); }
                __syncthreads();
#ifdef PROF_LN1
                if (l == 0 && blockIdx.x == 0 && tid == 0) ctl[14000 + 20] = (unsigned)(__builtin_amdgcn_s_memrealtime() & 0xffffffffu);
#endif
                float4 xvA[4], xvB[4]; v2u mwA[4], mwB[4];
                auto ld_x = [&](int tk, int j) -> float4 {
                    if (l == 0) return *(const float4*)(x0 + (size_t)tk * D_MODEL + j * 256 + lane * 4);
                    const v2u xw = *(const v2u*)(a16 + (size_t)tk * D_MODEL + j * 256 + lane * 4);
                    return make_float4(bflo(xw.x), bfhi(xw.x), bflo(xw.y), bfhi(xw.y));
                };
                auto ld_tok = [&](int tk, float4 (&xv)[4], v2u (&mw)[4]) {
                    if (tk < NTOK) {
#pragma unroll
                        for (int j = 0; j < 4; ++j) { xv[j] = ld_x(tk, j); mw[j] = *(const v2u*)(mix16 + (size_t)tk * D_MODEL + j * 256 + lane * 4); }
                    }
                };
                auto do_tok = [&](int tk, float4 (&xv)[4], v2u (&mw)[4]) {
                    float4 v[4]; float s = 0.f;
#pragma unroll
                    for (int j = 0; j < 4; ++j) {
                        v[j] = make_float4(ALPHA * xv[j].x + bflo(mw[j].x), ALPHA * xv[j].y + bfhi(mw[j].x), ALPHA * xv[j].z + bflo(mw[j].y), ALPHA * xv[j].w + bfhi(mw[j].y));
                        s += (v[j].x + v[j].y) + (v[j].z + v[j].w);
                    }
                    ld_tok(tk + 2 * NGW, xv, mw);
                    const float mean = wave_sum(s) * (1.f / 1024.f); float s2 = 0.f;
#pragma unroll
                    for (int j = 0; j < 4; ++j) { v[j].x -= mean; v[j].y -= mean; v[j].z -= mean; v[j].w -= mean; s2 += (v[j].x * v[j].x + v[j].y * v[j].y) + (v[j].z * v[j].z + v[j].w * v[j].w); }
                    const float rstd = rsqrtf(wave_sum(s2) * (1.f / 1024.f) + LN_EPS);
                    float gl[4] = {0.f, 0.f, 0.f, 0.f};
#pragma unroll
                    for (int j = 0; j < 4; ++j) {
                        const int d0 = j * 256 + lane * 4;
                        const float4 gg = *(const float4*)(ln1_g + d0), bb = *(const float4*)(ln1_b + d0);
                        v[j] = make_float4(v[j].x * rstd * gg.x + bb.x, v[j].y * rstd * gg.y + bb.y, v[j].z * rstd * gg.z + bb.z, v[j].w * rstd * gg.w + bb.w);
                        { v2u hb; hb.x = pk2(v[j].x, v[j].y); hb.y = pk2(v[j].z, v[j].w); *(v2u*)(a16 + (size_t)tk * D_MODEL + d0) = hb; }
                        const float hv[4] = {v[j].x, v[j].y, v[j].z, v[j].w};
#pragma unroll
                        for (int i = 0; i < 4; ++i) {
                            const f32x4_t wg = Lg[(j * 4 + i) * 64 + lane];
                            gl[0] = fmaf(hv[i], wg.x, gl[0]); gl[1] = fmaf(hv[i], wg.y, gl[1]); gl[2] = fmaf(hv[i], wg.z, gl[2]); gl[3] = fmaf(hv[i], wg.w, gl[3]);
                        }
                    }
#pragma unroll
                    for (int i = 0; i < 4; ++i) gl[i] = wave_sum(gl[i]) + b_group[i];
                    int gi = 0; float gm = gl[0];
#pragma unroll
                    for (int i = 1; i < 4; ++i) if (gl[i] > gm) { gm = gl[i]; gi = i; }
                    gi = __builtin_amdgcn_readfirstlane(gi);
                    float gden = 0.f;
#pragma unroll
                    for (int i = 0; i < 4; ++i) gden += __expf(gl[i] - gm);
                    const float gwt = 1.f / gden;
                    float el[8] = {0.f, 0.f, 0.f, 0.f, 0.f, 0.f, 0.f, 0.f};
                    const LAS f32x4_t* we = Le + gi * 2048;
#pragma unroll
                    for (int j = 0; j < 4; ++j) {
                        const float hv[4] = {v[j].x, v[j].y, v[j].z, v[j].w};
#pragma unroll
                        for (int i = 0; i < 4; ++i) {
                            const f32x4_t w0 = we[((j * 4 + i) * 2) * 64 + lane], w1 = we[((j * 4 + i) * 2 + 1) * 64 + lane];
                            el[0] = fmaf(hv[i], w0.x, el[0]); el[1] = fmaf(hv[i], w0.y, el[1]); el[2] = fmaf(hv[i], w0.z, el[2]); el[3] = fmaf(hv[i], w0.w, el[3]);
                            el[4] = fmaf(hv[i], w1.x, el[4]); el[5] = fmaf(hv[i], w1.y, el[5]); el[6] = fmaf(hv[i], w1.z, el[6]); el[7] = fmaf(hv[i], w1.w, el[7]);
                        }
                    }
#pragma unroll
                    for (int i = 0; i < 8; ++i) el[i] = wave_sum(el[i]) + b_er[gi * 8 + i];
                    int i0 = 0; float v0 = el[0];
#pragma unroll
                    for (int i = 1; i < 8; ++i) if (el[i] > v0) { v0 = el[i]; i0 = i; }
                    int i1 = -1; float v1 = -INFINITY;
#pragma unroll
                    for (int i = 0; i < 8; ++i) if (i != i0 && el[i] > v1) { v1 = el[i]; i1 = i; }
                    const float e1 = __expf(v1 - v0);
                    const float w0 = gwt / (1.f + e1), w1 = gwt * e1 / (1.f + e1);
                    if (lane == 0) {
                        const int ea = gi * 8 + i0, eb = gi * 8 + i1;
                        ids[tk * 2] = ea; ids[tk * 2 + 1] = eb; wts[tk * 2] = w0; wts[tk * 2 + 1] = w1;
                        rank[tk * 2] = (int)__hip_atomic_fetch_add(lcnt + ea, 1u, __ATOMIC_RELAXED, __HIP_MEMORY_SCOPE_WORKGROUP);
                        rank[tk * 2 + 1] = (int)__hip_atomic_fetch_add(lcnt + eb, 1u, __ATOMIC_RELAXED, __HIP_MEMORY_SCOPE_WORKGROUP);
                    }
                };
                ld_tok(gw, xvA, mwA); ld_tok(gw + NGW, xvB, mwB);
                for (int tk = gw; tk < NTOK; tk += 2 * NGW) {
                    do_tok(tk, xvA, mwA);
                    if (tk + NGW < NTOK) do_tok(tk + NGW, xvB, mwB);
                }
#ifdef PROF_LN1
                if (l == 0 && blockIdx.x == 0 && tid == 0) ctl[14000 + 21] = (unsigned)(__builtin_amdgcn_s_memrealtime() & 0xffffffffu);
#endif
                __syncthreads();
                if (tid < 32) { const unsigned n = lcnt[tid]; lcnt[tid] = n ? atomicAdd(cnt + tid * 64, n) : 0u; }
                __syncthreads();
                if (lane == 0) for (int tk = gw; tk < NTOK; tk += NGW) { rank[tk * 2] += (int)lcnt[ids[tk * 2]]; rank[tk * 2 + 1] += (int)lcnt[ids[tk * 2 + 1]]; }
                __syncthreads();
            } else if constexpr (sp == 6) {
                int* offs = (int*)sm;
                __syncthreads();
                if (tid == 0) { int o = 0; for (int e = 0; e < 32; ++e) { offs[e] = o; o += ((int)cnt[e * 64] + 255) & ~255; } offs[32] = o; }
                __syncthreads();
                for (int i = gtid; i < NSLOT_TILES; i += NGT) { int e = -1; for (int k = 0; k < 32; ++k) if (i * 256 >= offs[k] && i * 256 < offs[k + 1]) e = k; tile_e[i] = e; }
                for (int i0 = gw * 4; i0 < NTOK * 2; i0 += NGW * 4) {
                    int sl[4]; v4u r0[4], r1[4];
#pragma unroll
                    for (int u = 0; u < 4; ++u) { const int i = i0 + u; sl[u] = offs[ids[i]] + rank[i]; }
#pragma unroll
                    for (int u = 0; u < 4; ++u) { const v4u* srow = (const v4u*)(a16 + (size_t)((i0 + u) >> 1) * D_MODEL); r0[u] = srow[lane]; r1[u] = srow[64 + lane]; }
                    if (lane < 4) slot_of[i0 + lane] = lane == 0 ? sl[0] : (lane == 1 ? sl[1] : (lane == 2 ? sl[2] : sl[3]));
#pragma unroll
                    for (int u = 0; u < 4; ++u) { v4u* drow = (v4u*)(hs16 + (size_t)sl[u] * D_MODEL); drow[lane] = r0[u]; drow[64 + lane] = r1[u]; }
                }
                __syncthreads();
                {
                    pg8::Gemm g{a16, (const bf16*)(ws + WS_WPG), NTOK, 1024, 1024, 1024, 1024};
                    pg8::StaticOrder S; S.init(NTOK, 1024, G, (int)blockIdx.x);
                    pg8::EpiPleGate E{ple16, pp16};
                    pg8::gemm_phase<pg8::EpiPleGate, pg8::StaticOrder, true, true>((LAS unsigned char*)lds_raw, g, S, E, tid);
                }
            } else if constexpr (sp == 7) {
                int T = 0; for (int e = 0; e < 32; ++e) T += ((int)cnt[e * 64] + 255) >> 8;
                T = __builtin_amdgcn_readfirstlane(T);
                pg8::Gemm g{hs16, (const bf16*)(ws + WS_WGU), MAX_SLOTS, 32 * 512, 1024, 1024, 1024};
                pg8::GroupSched S{tile_e, T, 2, G, (int)((blockIdx.x % 8) * (G / 8) + blockIdx.x / 8)};
                pg8::EpiGU E{act16};
                pg8::gemm_phase<pg8::EpiGU, pg8::GroupSched, true, true>((LAS unsigned char*)lds_raw, g, S, E, tid);
            } else if constexpr (sp == 8) {
                int T = 0; for (int e = 0; e < 32; ++e) T += ((int)cnt[e * 64] + 255) >> 8;
                T = __builtin_amdgcn_readfirstlane(T);
                pg8::Gemm g{act16, (const bf16*)(ws + WS_WD), MAX_SLOTS, 32 * 1024, 256, 256, 256};
                pg8::GroupSched S{tile_e, T, 4, G, (int)((blockIdx.x % 8) * (G / 8) + blockIdx.x / 8)};
                pg8::EpiDown E{outs16};
                pg8::gemm_phase<pg8::EpiDown, pg8::GroupSched, true, true>((LAS unsigned char*)lds_raw, g, S, E, tid);
            } else if constexpr (sp == 9) {
                struct Ln2Regs { v2u hv[4], oa[4], ob[4], pv[4]; float w0, w1; };
                Ln2Regs RA, RB;
                auto ld_rows = [&](int tk, Ln2Regs& R) {
                    if (tk < NTOK) {
                        const int s0 = slot_of[tk * 2], s1 = slot_of[tk * 2 + 1]; R.w0 = wts[tk * 2]; R.w1 = wts[tk * 2 + 1];
#pragma unroll
                        for (int j = 0; j < 4; ++j) {
                            const int d0 = j * 256 + lane * 4;
                            R.hv[j] = *(const v2u*)(a16 + (size_t)tk * D_MODEL + d0);
                            R.oa[j] = *(const v2u*)(outs16 + (size_t)s0 * D_MODEL + d0); R.ob[j] = *(const v2u*)(outs16 + (size_t)s1 * D_MODEL + d0);
                            R.pv[j] = *(const v2u*)(ple16 + (size_t)tk * D_MODEL + d0);
                        }
                    }
                };
                auto do_row = [&](int tk, Ln2Regs& R) {
                    float4 v[4]; float s = 0.f; const float w0 = R.w0, w1 = R.w1;
#pragma unroll
                    for (int j = 0; j < 4; ++j) {
                        v[j] = make_float4(ALPHA * bflo(R.hv[j].x) + w0 * bflo(R.oa[j].x) + w1 * bflo(R.ob[j].x) + bflo(R.pv[j].x), ALPHA * bfhi(R.hv[j].x) + w0 * bfhi(R.oa[j].x) + w1 * bfhi(R.ob[j].x) + bfhi(R.pv[j].x),
                                           ALPHA * bflo(R.hv[j].y) + w0 * bflo(R.oa[j].y) + w1 * bflo(R.ob[j].y) + bflo(R.pv[j].y), ALPHA * bfhi(R.hv[j].y) + w0 * bfhi(R.oa[j].y) + w1 * bfhi(R.ob[j].y) + bfhi(R.pv[j].y));
                        s += (v[j].x + v[j].y) + (v[j].z + v[j].w);
                    }
                    ld_rows(tk + 2 * NGW, R);
                    const float mean = wave_sum(s) * (1.f / 1024.f); float s2 = 0.f;
#pragma unroll
                    for (int j = 0; j < 4; ++j) { v[j].x -= mean; v[j].y -= mean; v[j].z -= mean; v[j].w -= mean; s2 += (v[j].x * v[j].x + v[j].y * v[j].y) + (v[j].z * v[j].z + v[j].w * v[j].w); }
                    const float rstd = rsqrtf(wave_sum(s2) * (1.f / 1024.f) + LN_EPS);
#pragma unroll
                    for (int j = 0; j < 4; ++j) {
                        const int d0 = j * 256 + lane * 4;
                        const float4 gg = *(const float4*)(ln2_g + d0), bb = *(const float4*)(ln2_b + d0);
                        const float4 o = make_float4(v[j].x * rstd * gg.x + bb.x, v[j].y * rstd * gg.y + bb.y, v[j].z * rstd * gg.z + bb.z, v[j].w * rstd * gg.w + bb.w);
                        if (!DUMMY || w0 == 12345.678f) {
                        if (l == DEPTH - 1) {
#ifdef PROF_SEL
#ifdef PROF_LN1
                        float4 oo = o; { const float dlt = sqrtf((float)(ctl[14000 + PROF_LN1 + 1] - ctl[14000 + PROF_LN1]) * 1e-8f);
#else
                        float4 oo = o; { const float dlt = sqrtf((float)ctl[14000 + PROF_SEL] * 1e-8f);
#endif
                        oo.x += dlt; oo.y += dlt; oo.z += dlt; oo.w += dlt; }
                        *(float4*)(a.out + (size_t)tk * D_MODEL + d0) = oo;
#else
                        *(float4*)(a.out + (size_t)tk * D_MODEL + d0) = o;
#endif
                        } else {
                        v2u ob16; ob16.x = pk2(o.x, o.y); ob16.y = pk2(o.z, o.w);
                        *(v2u*)(a16 + (size_t)tk * D_MODEL + d0) = ob16;
                        }
                        }
                    }
                };
                ld_rows(gw, RA); ld_rows(gw + NGW, RB);
                for (int tk = gw; tk < NTOK; tk += 2 * NGW) {
                    do_row(tk, RA);
                    if (tk + NGW < NTOK) do_row(tk + NGW, RB);
                }
                if (l + 1 < DEPTH) convert_layer_weights(a, l + 1, ws, scr, gw, NGW, lane);
            }
        }
}

constexpr int CW_BAR = 4096;
__global__ void __launch_bounds__(NTHREADS, 2) mega(Args a) {
    extern __shared__ __attribute__((aligned(16))) unsigned char lds_raw[];
    cg::grid_group grid = cg::this_grid();
    volatile LAS unsigned* misc = (volatile LAS unsigned*)((LAS unsigned char*)lds_raw + LDS_MISC);
    if (threadIdx.x < 16) misc[threadIdx.x] = 0u;
    __syncthreads();
    XcdBarrier bar = xcd_barrier_post((unsigned*)(a.ws + WS_CTL) + CW_BAR, misc + 8);
    const int wave_s = __builtin_amdgcn_readfirstlane(threadIdx.x >> 6);
#define IS_T0 (wave_s == 0 && lane_id_now() == 0)
#ifndef DUP_SP
#define DUP_SP -1
#endif
#ifndef DUP_X
#define DUP_X 0
#endif
    if (a.ph_hi < 0) grid.sync();
#define SEAM(ph) do { xcd_barrier(bar, IS_T0); } while (0)
#ifdef PROF_PH
    unsigned long long ph_t_prev = __builtin_amdgcn_s_memrealtime();
#define PHASE_STAMP(ph) do { const unsigned long long t_ = __builtin_amdgcn_s_memrealtime(); if ((ph) == PROF_PH && blockIdx.x == 0 && IS_T0) ((unsigned*)(a.ws + WS_CTL))[14000 + PROF_SEL] = (unsigned)(t_ - ph_t_prev); ph_t_prev = t_; } while (0)
#else
#define PHASE_STAMP(ph) do {} while (0)
#endif
#define RUN(ph) if (a.ph_lo <= (ph) && (ph) < a.ph_hi) { \
        if (DUP_X == 9 && (ph) > 0 && ((ph) - 1) % PH_PER_LAYER == 9) { run_phase<ph, true>(a, lds_raw, wave_s); xcd_barrier(bar, IS_T0); } \
        run_phase<ph>(a, lds_raw, wave_s); \
        if ((ph) > 0 && ((ph) - 1) % PH_PER_LAYER == DUP_SP) { xcd_barrier(bar, IS_T0); run_phase<ph>(a, lds_raw, wave_s); } \
        if (DUP_X == 100 && (ph) == 0) { xcd_barrier(bar, IS_T0); run_phase<ph>(a, lds_raw, wave_s); } \
        if (DUP_X == 5 && (ph) == 6) { xcd_barrier(bar, IS_T0); run_phase<ph, true>(a, lds_raw, wave_s); } \
        if (DUP_X == 3 && (ph) > 0 && ((ph) - 1) % PH_PER_LAYER == 3) { xcd_barrier(bar, IS_T0); run_phase<ph, true>(a, lds_raw, wave_s); } \
        if ((ph) + 1 < a.ph_hi && (ph) + 1 < NPH) SEAM(ph); PHASE_STAMP(ph); }
    RUN(0) RUN(1) RUN(2) RUN(3) RUN(4) RUN(5) RUN(6) RUN(7) RUN(8) RUN(9) RUN(10)
    RUN(11) RUN(12) RUN(13) RUN(14) RUN(15) RUN(16) RUN(17) RUN(18) RUN(19) RUN(20)
#undef RUN
#undef SEAM
}

extern "C" void kernel_launch(void* const* d_in, const int* in_sizes, int n_in, void* d_out, int out_size, void* d_ws, size_t ws_size, hipStream_t stream) {
    static int grid = 0;
    if (grid == 0) {
        if (n_in != 28 || ws_size < WS_END) { fprintf(stderr, "kernel_launch: unexpected n_in %d or ws_size %zu (< %zu)\n", n_in, ws_size, (size_t)WS_END); grid = -1; return; }
        int dev = 0, cus = 0, per_cu = 0;
        (void)hipGetDevice(&dev);
        (void)hipDeviceGetAttribute(&cus, hipDeviceAttributeMultiprocessorCount, dev);
        (void)hipFuncSetAttribute((const void*)mega, hipFuncAttributeMaxDynamicSharedMemorySize, LDS_BYTES);
        (void)hipOccupancyMaxActiveBlocksPerMultiprocessor(&per_cu, (const void*)mega, NTHREADS, LDS_BYTES);
        if (per_cu < 1) { fprintf(stderr, "kernel_launch: occupancy query says %d blocks/CU\n", per_cu); }
        (void)hipGetLastError();
        grid = cus;
    }
    if (grid < 0) return;
    (void)hipMemsetAsync((char*)d_ws + WS_CTL, 0, 64 * 1024, stream);
    Args a{};
    for (int i = 0; i < 28; ++i) a.in[i] = d_in[i];
    a.out = (float*)d_out; a.ws = (unsigned char*)d_ws; a.ph_lo = 0; a.ph_hi = NPH;
    void* params[] = {&a};
    hipError_t e = hipLaunchCooperativeKernel((const void*)mega, dim3(grid), dim3(NTHREADS), params, LDS_BYTES, stream);
    if (e != hipSuccess) fprintf(stderr, "cooperative launch failed: %s (grid %d)\n", hipGetErrorString(e), grid);
}
```

```cpp
#include <hip/hip_runtime.h>
#include <hip/hip_cooperative_groups.h>
#include <cstdio>
#include <cstdint>
namespace cg = cooperative_groups;

constexpr int D_MODEL = 1024, BATCH = 8, SEQ = 2048, NTOK = BATCH * SEQ, DEPTH = 2;
constexpr int D_IN = 2340;
constexpr int OFF_QA = 0, OFF_KA = 384, OFF_VA = 768, OFF_CQ = 1152, OFF_CKV = 1408, OFF_KR = 1536,
              OFF_QC = 1568, OFF_KC = 1824, OFF_VC = 2080, OFF_FC = 2336;
constexpr int ZP = 2560;
constexpr int Z_QA = 0, Z_KA = 384, Z_VA = 768, Z_QC = 1152, Z_KC = 1408, Z_VC = 1664, Z_CKV = 1920, Z_CQ = 2048, Z_KR = 2304, Z_FC = 2336;
constexpr int NQB = 576, NKVB = 768, NQBP = 768;
constexpr int N_EXPERTS = 32, D_EXPERT = 256, PLE_DIM = 256;
constexpr int MAX_SLOTS = 32768 + 32 * 256;
constexpr int NSLOT_TILES = MAX_SLOTS / 256;
constexpr float ALPHA = 1.4142135623730951f;
constexpr float LN_EPS = 1e-5f, RMS_EPS = 1e-6f;
constexpr int NTHREADS = 512;
constexpr int LDS_BYTES = 147456 + 256;

constexpr size_t MiB = 1u << 20;
constexpr size_t WS_CTL = 0;
constexpr size_t WS_COS = 1 * MiB, WS_SIN = 2 * MiB;
constexpr size_t WS_WIN = 3 * MiB;
constexpr size_t WS_WUQ = 8 * MiB;
constexpr size_t WS_WUKV = WS_WUQ + 393216;
constexpr size_t WS_WOUT = 9 * MiB;
constexpr size_t WS_WPG = 11 * MiB;
constexpr size_t WS_WPP = 13 * MiB;
constexpr size_t WS_WGU = 14 * MiB;
constexpr size_t WS_WD = 46 * MiB;
constexpr size_t WS_A16 = 62 * MiB;
constexpr size_t WS_P16 = 94 * MiB;
constexpr size_t WS_Z16 = 110 * MiB;
constexpr size_t WS_HS16 = WS_Z16;
constexpr size_t WS_OUTS16 = WS_Z16;
constexpr size_t WS_QB16 = 190 * MiB;
constexpr size_t WS_KVB16 = 214 * MiB;
constexpr size_t WS_KRR16 = 238 * MiB;
constexpr size_t WS_FC = 239 * MiB;
constexpr size_t WS_CUM = WS_FC + 256 * 1024;
constexpr size_t WS_LOGF = WS_CUM + 256 * 1024;
constexpr size_t WS_RQ = WS_LOGF + 256 * 1024;
constexpr size_t WS_RKV = WS_RQ + 64 * 1024;
constexpr size_t WS_MIX16 = 190 * MiB;
constexpr size_t WS_PP16 = 276 * MiB;
constexpr size_t WS_ACT16 = 222 * MiB;
constexpr size_t WS_MIXED16 = 242 * MiB;
constexpr size_t WS_PLE16 = 242 * MiB;
constexpr size_t WS_RT = 274 * MiB;
constexpr size_t WS_END = 308 * MiB;
constexpr size_t RT_IDS = 0, RT_WTS = 128 * 1024, RT_RANK = 256 * 1024, RT_SLOTOF = 384 * 1024, RT_TILEE = 768 * 1024, RT_TPMAX = 800 * 1024;
constexpr int CW_CNT = 0;
static_assert((WS_A16 - WS_HS16) % (256 * 1024 * 2) == 0 || true, "");

struct Args { const void* in[28]; float* out; unsigned char* ws; int ph_lo, ph_hi; };

#define LAS __attribute__((address_space(3)))
typedef unsigned short bf16;
typedef unsigned v4u __attribute__((ext_vector_type(4)));
typedef unsigned v2u __attribute__((ext_vector_type(2)));
typedef float f32x4_t __attribute__((ext_vector_type(4)));

__device__ __forceinline__ float wave_sum(float v) {
#define WS_DPP(ctrl, rmask) __builtin_bit_cast(float, __builtin_amdgcn_update_dpp(0, __builtin_bit_cast(int, v), (ctrl), (rmask), 0xf, true))
    v += WS_DPP(0x111, 0xf);
    v += WS_DPP(0x112, 0xf);
    v += WS_DPP(0x114, 0xf);
    v += WS_DPP(0x118, 0xf);
    v += WS_DPP(0x142, 0xa);
    v += WS_DPP(0x143, 0xc);
#undef WS_DPP
    return __builtin_bit_cast(float, __builtin_amdgcn_readlane(__builtin_bit_cast(int, v), 63));
}
__device__ __forceinline__ unsigned f2bf(float f) { unsigned u = __builtin_bit_cast(unsigned, f); return (u + 0x7fffu + ((u >> 16) & 1u)) >> 16; }
__device__ __forceinline__ unsigned pk2(float lo, float hi) { return f2bf(lo) | (f2bf(hi) << 16); }
__device__ __forceinline__ float bflo(unsigned w) { return __uint_as_float(w << 16); }
__device__ __forceinline__ float bfhi(unsigned w) { return __uint_as_float(w & 0xffff0000u); }
__device__ __forceinline__ void unpack8(const v4u w, float* f) { f[0] = bflo(w.x); f[1] = bfhi(w.x); f[2] = bflo(w.y); f[3] = bfhi(w.y); f[4] = bflo(w.z); f[5] = bfhi(w.z); f[6] = bflo(w.w); f[7] = bfhi(w.w); }
__device__ __forceinline__ int lane_id_now() { int l; asm volatile("v_mbcnt_lo_u32_b32 %0, -1, 0\n\tv_mbcnt_hi_u32_b32 %0, -1, %0" : "=v"(l)); return l; }
namespace pg8 {
#define PG8_LAS __attribute__((address_space(3)))
typedef unsigned short bf16_t;
typedef short bf16x8 __attribute__((ext_vector_type(8)));
typedef float f32x4 __attribute__((ext_vector_type(4)));
typedef unsigned u32x4 __attribute__((ext_vector_type(4)));
constexpr int BM = 256, BK = 64, HALF = 128, HTB = HALF * BK * 2  , STAGE_BYTES = 8 * HTB, NXCD = 8, WGM = 8;

__host__ __device__ __forceinline__ int lds_byte(int r, int c) { const int st = (r >> 4) * 2 + (c >> 5), rr = r & 15, cc = c & 31, ob = rr * 64 + cc * 2; return st * 1024 + (ob ^ (((ob >> 9) & 1) << 5)); }
__host__ __device__ __forceinline__ void stage_rc(int b, int& R, int& C) { const int st = b / 1024, sb = b % 1024, swz = sb ^ (((sb >> 9) & 1) << 5); R = (st >> 1) * 16 + swz / 64; C = (st & 1) * 32 + (swz % 64) / 2; }
__host__ __device__ __forceinline__ int perm32(int rho) { const int n = rho >> 4, i = rho & 15; return 8 * (i >> 2) + 4 * n + (i & 3); }

struct Unit { int pm, pn; };
struct Gemm { const bf16_t* A; const bf16_t* Bt; int M, N, K, lda, ldb; };

struct StaticOrder {
    int nM, nN, nwg, G, c;
    __host__ __device__ void init(int M, int N, int G_, int c_) { nM = M / BM; nN = N / BM; nwg = nM * nN; G = G_; c = c_; }
    __host__ __device__ bool next(int i, Unit& u) const {
        const long L = (long)i * G + c; if (L >= nwg) return false;
        int wgid = (int)L; { const int q = nwg / NXCD, r = nwg % NXCD, xcd = wgid % NXCD, off = wgid / NXCD; wgid = (xcd < r ? xcd * (q + 1) : r * (q + 1) + (xcd - r) * q) + off; }
        const int nig = WGM * nN, gid = wgid / nig, fm = gid * WGM, gsz = (nM - fm) < WGM ? (nM - fm) : WGM;
        u.pm = fm + ((wgid % nig) % gsz); u.pn = (wgid % nig) / gsz; return true;
    }
    __device__ __forceinline__ void a_ready(const Unit&) const {}
    __device__ __forceinline__ void done(const Unit&) const {}
};

__device__ __forceinline__ unsigned cvt_pk_bf16(float lo, float hi) { unsigned r; asm volatile("v_cvt_pk_bf16_f32 %0, %1, %2" : "=v"(r) : "v"(lo), "v"(hi)); return r; }
typedef float f32x2 __attribute__((ext_vector_type(2)));
__device__ __forceinline__ f32x2 gelu_pk(f32x2 v) {
    const f32x2 av = __builtin_elementwise_abs(v), d = av * 0.2316418882f + 1.0f;
    f32x2 t; t.x = __builtin_amdgcn_rcpf(d.x); t.y = __builtin_amdgcn_rcpf(d.y);
    f32x2 q = t * 0.5307027145f + (-0.7265760135f); q = q * t + 0.7107068705f; q = q * t + (-0.142248368f); q = q * t + 0.127414796f; q = q * t;
    const f32x2 s = (v * v) * (-0.72134752044f);
    f32x2 e; e.x = __builtin_amdgcn_exp2f(s.x); e.y = __builtin_amdgcn_exp2f(s.y);
    const f32x2 m = v * (q * e), r = v - m;
    f32x2 o; o.x = v.x < 0.f ? m.x : r.x; o.y = v.y < 0.f ? m.y : r.y; return o;
}

template <int ACT  > struct EpiBf16 {
    static constexpr bool PERM = true, AFTER_DRAIN = false; static_assert(ACT == 0 || ACT == 1, "EpiBf16: ACT is 0 (none) or 1 (gelu_pk)");
    bf16_t* O; int ldc; const float* bias; int split_cols; size_t split_stride; float scale0;
    __device__ __forceinline__ void operator()(const f32x4 (&acc)[2][2][4][2], const Unit& u, int wr, int wc, int fr, int fq) const {
        const int row0 = u.pm * BM + wr * 64 + fr; int colt = u.pn * BM; bf16_t* base = O;
        float sc = 1.f; if (split_cols) { const int t = colt / split_cols; base += (size_t)t * split_stride; colt -= t * split_cols; if (t == 0) sc = scale0; }
        const int col0 = colt + wc * 32 + 8 * fq, bcol0 = u.pn * BM + wc * 32 + 8 * fq;
        f32x4 bv[2][2];
#pragma unroll
        for (int bj = 0; bj < 2; ++bj)
#pragma unroll
            for (int n = 0; n < 2; ++n) bv[bj][n] = bias ? *(const f32x4*)(bias + bcol0 + bj * HALF + 4 * n) : (f32x4){0.f, 0.f, 0.f, 0.f};
#pragma unroll
        for (int ai = 0; ai < 2; ++ai)
#pragma unroll
            for (int m = 0; m < 4; ++m) { bf16_t* rowp = base + (size_t)(row0 + ai * HALF + m * 16) * ldc + col0;
#pragma unroll
                for (int bj = 0; bj < 2; ++bj) { f32x4 v0 = acc[ai][bj][m][0] + bv[bj][0], v1 = acc[ai][bj][m][1] + bv[bj][1];
                    if (ACT == 1) { f32x2 a = gelu_pk((f32x2){v0[0], v0[1]}), b = gelu_pk((f32x2){v0[2], v0[3]}), c = gelu_pk((f32x2){v1[0], v1[1]}), d = gelu_pk((f32x2){v1[2], v1[3]});
                        v0 = (f32x4){a.x, a.y, b.x, b.y}; v1 = (f32x4){c.x, c.y, d.x, d.y}; }
                    v0 = v0 * sc; v1 = v1 * sc; u32x4 w; w.x = cvt_pk_bf16(v0[0], v0[1]); w.y = cvt_pk_bf16(v0[2], v0[3]); w.z = cvt_pk_bf16(v1[0], v1[1]); w.w = cvt_pk_bf16(v1[2], v1[3]);
                    *(u32x4*)(rowp + bj * HALF) = w; } }
    }
};
template <class Epi, class Sched, bool ALIGN_EPI = false, bool SP2 = false>
__device__ __forceinline__ void gemm_phase(PG8_LAS unsigned char* lds, const Gemm g, const Sched& S, const Epi& E, const int tid) {
    const int wid = __builtin_amdgcn_readfirstlane(tid >> 6), lane = tid & 63, wr = wid >> 2, wc = wid & 3, fr = lane & 15, fq = lane >> 4;
    int K = g.K; asm volatile("" : "+s"(K));
    const int nt = K / BK;
    unsigned voffA[2], voffB[2];
#pragma unroll
    for (int i = 0; i < 2; ++i) { int R, C; stage_rc(tid * 16 + i * 8192, R, C); const int Rb = Epi::PERM ? ((R & ~31) + perm32(R & 31)) : R;
        voffA[i] = (unsigned)(R * g.lda + C) * 2u; voffB[i] = (unsigned)(Rb * g.ldb + C) * 2u; }
    const size_t kstep = (size_t)(BK * 2);
    const size_t hstepA = (size_t)HALF * g.lda * 2, hstepB = (size_t)HALF * g.ldb * 2;
    const size_t tstepA = 2 * hstepA, tstepB = 2 * hstepB;
    const unsigned ldsw = (unsigned)wid * 1024u;
    const int aoff = lds_byte(wr * 64 + fr, fq * 8), boff = lds_byte(wc * 32 + fr, fq * 8);
#define PG8_SA(b, h) (((b) * 2 + (h)) * HTB)
#define PG8_SB(b, h) ((4 + (b) * 2 + (h)) * HTB)
#define PG8_STAGE(bufoff, gbase, voff) do { _Pragma("unroll") for (int _i = 0; _i < 2; ++_i) \
        __builtin_amdgcn_global_load_lds((const unsigned*)((const char*)(gbase) + (voff)[_i]), (PG8_LAS unsigned*)(lds + (bufoff) + ldsw + _i * 8192), 16, 0, 0); } while (0)
#define PG8_LDA(dst, b, h) do { _Pragma("unroll") for (int m = 0; m < 4; ++m) _Pragma("unroll") for (int k = 0; k < 2; ++k) dst[m][k] = *(const PG8_LAS bf16x8*)(lds + PG8_SA(b, h) + aoff + m * 2048 + k * 1024); } while (0)
#define PG8_LDB(dst, b, h) do { _Pragma("unroll") for (int n = 0; n < 2; ++n) _Pragma("unroll") for (int k = 0; k < 2; ++k) dst[n][k] = *(const PG8_LAS bf16x8*)(lds + PG8_SB(b, h) + boff + n * 2048 + k * 1024); } while (0)
#define PG8_MMA(ai, bj, At, Bt) do { __builtin_amdgcn_s_setprio(1); _Pragma("unroll") for (int m = 0; m < 4; ++m) _Pragma("unroll") for (int n = 0; n < 2; ++n) _Pragma("unroll") for (int k = 0; k < 2; ++k) \
        acc[ai][bj][m][n] = __builtin_amdgcn_mfma_f32_16x16x32_bf16(Bt[n][k], At[m][k], acc[ai][bj][m][n], 0, 0, 0); __builtin_amdgcn_s_setprio(0); } while (0)
#define PG8_WAIT_V(n) asm volatile("s_waitcnt vmcnt(" #n ")" ::: "memory")
#define PG8_WAIT_L(n) asm volatile("s_waitcnt lgkmcnt(" #n ")" ::: "memory")
#define PG8_BAR __builtin_amdgcn_s_barrier()
#define PG8_SCHED __builtin_amdgcn_sched_barrier(0)
    Unit cur, nxt; int ui = 0;
    if (!S.next(0, cur)) return;
    f32x4 acc[2][2][4][2];
#pragma unroll
    for (int a = 0; a < 2; ++a)
#pragma unroll
        for (int b = 0; b < 2; ++b)
#pragma unroll
            for (int m = 0; m < 4; ++m)
#pragma unroll
                for (int n = 0; n < 2; ++n) acc[a][b][m][n] = (f32x4){0.f, 0.f, 0.f, 0.f};
    bf16x8 At[4][2], B0[2][2], B1[2][2];
    const char* cA = (const char*)g.A + (size_t)cur.pm * tstepA; const char* cB = (const char*)g.Bt + (size_t)cur.pn * tstepB;
    S.a_ready(cur);
    if constexpr (SP2) {
        PG8_STAGE(PG8_SB(0, 0), cB, voffB); PG8_STAGE(PG8_SB(0, 1), cB + hstepB, voffB); PG8_STAGE(PG8_SA(0, 0), cA, voffA); PG8_STAGE(PG8_SA(0, 1), cA + hstepA, voffA);
        if (wr == 1) PG8_BAR;
        PG8_WAIT_V(2); PG8_BAR;
        PG8_STAGE(PG8_SB(1, 0), cB + kstep, voffB); PG8_STAGE(PG8_SA(1, 0), cA + kstep, voffA); PG8_STAGE(PG8_SB(1, 1), cB + hstepB + kstep, voffB);
        PG8_WAIT_V(6); PG8_BAR;
    } else {
        PG8_STAGE(PG8_SB(0, 0), cB, voffB); PG8_STAGE(PG8_SA(0, 0), cA, voffA); PG8_STAGE(PG8_SB(0, 1), cB + hstepB, voffB); PG8_STAGE(PG8_SA(0, 1), cA + hstepA, voffA);
        if (wr == 1) PG8_BAR;
        PG8_WAIT_V(4); PG8_BAR;
        PG8_STAGE(PG8_SB(1, 0), cB + kstep, voffB); PG8_STAGE(PG8_SA(1, 0), cA + kstep, voffA); PG8_STAGE(PG8_SB(1, 1), cB + hstepB + kstep, voffB);
        PG8_WAIT_V(6); PG8_BAR;
    }
    for (;;) {
        const bool has_next = S.next(ui + 1, nxt);
        const char* nA = has_next ? (const char*)g.A + (size_t)nxt.pm * tstepA : cA; const char* nB = has_next ? (const char*)g.Bt + (size_t)nxt.pn * tstepB : cB;
        for (int t = 0; t < nt; t += 2) {
            const bool last = (t == nt - 2);
            const char* a1 = cA + (size_t)(t + 1) * kstep;
            const char* a2 = last ? nA : cA + (size_t)(t + 2) * kstep; const char* b2 = last ? nB : cB + (size_t)(t + 2) * kstep;
            const char* a3 = a2 + kstep; const char* b3 = b2 + kstep;
            if (last && has_next) S.a_ready(nxt);
            if constexpr (SP2) {
            PG8_LDB(B0, 0, 0); PG8_LDB(B1, 0, 1); PG8_SCHED; PG8_LDA(At, 0, 0); PG8_STAGE(PG8_SA(1, 1), a1 + hstepA, voffA);
            PG8_WAIT_V(8); PG8_WAIT_L(0); PG8_BAR; PG8_MMA(0, 0, At, B0); PG8_MMA(0, 1, At, B1); PG8_BAR; PG8_SCHED;
            PG8_LDA(At, 0, 1); PG8_STAGE(PG8_SB(0, 0), b2, voffB); PG8_STAGE(PG8_SB(0, 1), b2 + hstepB, voffB); PG8_STAGE(PG8_SA(0, 0), a2, voffA);
            PG8_WAIT_V(8); PG8_WAIT_L(0); PG8_BAR; PG8_MMA(1, 0, At, B0); PG8_MMA(1, 1, At, B1); PG8_BAR; PG8_SCHED;
            PG8_LDB(B0, 1, 0); PG8_LDB(B1, 1, 1); PG8_SCHED; PG8_LDA(At, 1, 0); PG8_STAGE(PG8_SA(0, 1), a2 + hstepA, voffA);
            PG8_WAIT_V(8); PG8_WAIT_L(0); PG8_BAR; PG8_MMA(0, 0, At, B0); PG8_MMA(0, 1, At, B1); PG8_BAR; PG8_SCHED;
            PG8_LDA(At, 1, 1); PG8_STAGE(PG8_SB(1, 0), b3, voffB); PG8_STAGE(PG8_SB(1, 1), b3 + hstepB, voffB); PG8_STAGE(PG8_SA(1, 0), a3, voffA);
            PG8_WAIT_V(8); PG8_WAIT_L(0); PG8_BAR; PG8_MMA(1, 0, At, B0); PG8_MMA(1, 1, At, B1); PG8_BAR; PG8_SCHED;
            } else {
            PG8_LDB(B0, 0, 0); PG8_SCHED; PG8_LDA(At, 0, 0); PG8_STAGE(PG8_SA(1, 1), a1 + hstepA, voffA);
            PG8_WAIT_L(8); PG8_BAR; PG8_WAIT_L(0); PG8_MMA(0, 0, At, B0); PG8_BAR; PG8_SCHED;
            PG8_LDB(B1, 0, 1); PG8_STAGE(PG8_SB(0, 0), b2, voffB);
            PG8_BAR; PG8_WAIT_L(0); PG8_MMA(0, 1, At, B1); PG8_BAR;
            PG8_LDA(At, 0, 1); PG8_STAGE(PG8_SA(0, 0), a2, voffA);
            PG8_BAR; PG8_WAIT_L(0); PG8_MMA(1, 0, At, B0); PG8_BAR; PG8_SCHED;
            PG8_STAGE(PG8_SB(0, 1), b2 + hstepB, voffB);
            PG8_WAIT_V(6); PG8_BAR; PG8_MMA(1, 1, At, B1); PG8_BAR;
            PG8_LDB(B0, 1, 0); PG8_SCHED; PG8_LDA(At, 1, 0); PG8_STAGE(PG8_SA(0, 1), a2 + hstepA, voffA);
            PG8_WAIT_L(8); PG8_BAR; PG8_WAIT_L(0); PG8_MMA(0, 0, At, B0); PG8_BAR; PG8_SCHED;
            PG8_LDB(B1, 1, 1); PG8_STAGE(PG8_SB(1, 0), b3, voffB);
            PG8_BAR; PG8_WAIT_L(0); PG8_MMA(0, 1, At, B1); PG8_BAR;
            PG8_LDA(At, 1, 1); PG8_STAGE(PG8_SA(1, 0), a3, voffA);
            PG8_BAR; PG8_WAIT_L(0); PG8_MMA(1, 0, At, B0); PG8_BAR; PG8_SCHED;
            PG8_STAGE(PG8_SB(1, 1), b3 + hstepB, voffB);
            PG8_WAIT_V(6); PG8_BAR; PG8_MMA(1, 1, At, B1); PG8_BAR;
            }
        }
        if constexpr (ALIGN_EPI) { if (wr == 0) PG8_BAR; }
        if constexpr (!Epi::AFTER_DRAIN) { E(acc, cur, wr, wc, fr, fq); S.done(cur); }
        if (!has_next) break;
#pragma unroll
        for (int a = 0; a < 2; ++a)
#pragma unroll
            for (int b = 0; b < 2; ++b)
#pragma unroll
                for (int m = 0; m < 4; ++m)
#pragma unroll
                    for (int n = 0; n < 2; ++n) acc[a][b][m][n] = (f32x4){0.f, 0.f, 0.f, 0.f};
        cur = nxt; cA = nA; cB = nB; ++ui;
        if constexpr (ALIGN_EPI) { if (wr == 1) PG8_BAR; }
    }
    PG8_WAIT_V(0);
    if constexpr (!ALIGN_EPI) { if (wr == 0) PG8_BAR; }
    PG8_BAR;
    if constexpr (Epi::AFTER_DRAIN) { E.fused(acc, cur, wr, wc, fr, fq, lds, wid, lane); S.done(cur); }
#undef PG8_SA
#undef PG8_SB
#undef PG8_STAGE
#undef PG8_LDA
#undef PG8_LDB
#undef PG8_MMA
#undef PG8_WAIT_V
#undef PG8_WAIT_L
#undef PG8_BAR
#undef PG8_SCHED
}
}
#define XB_TMO      128
#define XB_XCNT(j)  (256  + 64 * (j))
#define XB_XSUB(j)  (1280 + 64 * (j))
#define XB_XGEN(j)  (2304 + 64 * (j))
#define XB_TOP      3328
#define XB_TOPGEN   3392
#define XCD_BAR_WORDS 3456
#define XB_SPIN_CAP (1u << 18)

__device__ __forceinline__ unsigned xb_ld(unsigned* p)              { return __hip_atomic_load(p, __ATOMIC_RELAXED, __HIP_MEMORY_SCOPE_AGENT); }
__device__ __forceinline__ unsigned xb_add(unsigned* p, unsigned v) { return __hip_atomic_fetch_add(p, v, __ATOMIC_RELAXED, __HIP_MEMORY_SCOPE_AGENT); }
__device__ __forceinline__ unsigned xb_xcc_id() { return (unsigned)__builtin_amdgcn_s_getreg((3 << 11) | 20) & 0xFu; }
#define XB_SPIN(cond, bar) do { unsigned _sp = 0; while (cond) { __builtin_amdgcn_s_sleep(1); \
    if ((++_sp & 255u) == 0u) { if (xb_ld(&(bar)[XB_TMO])) break; if (_sp > XB_SPIN_CAP) { atomicAdd(&(bar)[XB_TMO], 1u); break; } } } } while (0)

struct XcdBarrier {
    unsigned* bar; unsigned x;
    volatile LAS unsigned* st;
};

__device__ __forceinline__ XcdBarrier xcd_barrier_post(unsigned* bar, volatile LAS unsigned* st) {
    XcdBarrier b; b.bar = bar; b.x = xb_xcc_id(); b.st = st;
    if (threadIdx.x == 0) (void)xb_add(&bar[XB_XCNT(b.x)], 1u);
    return b;
}
__device__ __forceinline__ void xcd_barrier_complete(unsigned* bar, unsigned x, unsigned& nloc, unsigned& nx) {
    const unsigned G = gridDim.x * gridDim.y * gridDim.z;
    unsigned sum, cnt, mine, sp = 0u;
    for (;;) {
        sum = 0u; cnt = 0u; mine = 0u;
#pragma unroll
        for (unsigned j = 0; j < 16; ++j) { const unsigned c = xb_ld(&bar[XB_XCNT(j)]); sum += c; cnt += (c > 0u) ? 1u : 0u; mine = (j == x) ? c : mine; }
        if (sum == G) break;
        __builtin_amdgcn_s_sleep(1);
        if ((++sp & 255u) == 0u) { if (xb_ld(&bar[XB_TMO])) break; if (sp > XB_SPIN_CAP) { atomicAdd(&bar[XB_TMO], 1u); break; } }
    }
    nloc = mine > 0u ? mine : 1u; nx = cnt > 0u ? cnt : 1u;
}

__device__ __forceinline__ void xcd_barrier(const XcdBarrier& b, const bool is_t0) {
    asm volatile("s_waitcnt vmcnt(0)" ::: "memory");
    __syncthreads();
    if (is_t0) {
        unsigned* bar = b.bar;
        __builtin_amdgcn_s_waitcnt(0);
        unsigned nloc = b.st[0], nx = b.st[1];
        if (nloc == 0u) { xcd_barrier_complete(bar, b.x, nloc, nx); b.st[0] = nloc; b.st[1] = nx; }
        const unsigned old = xb_add(&bar[XB_XSUB(b.x)], 1u);
        const unsigned gen = old / nloc;
        if (old + 1u == (gen + 1u) * nloc) {
            __builtin_amdgcn_fence(__ATOMIC_RELEASE, "agent");
            asm volatile("s_waitcnt vmcnt(0)" ::: "memory");
            const unsigned og = xb_add(&bar[XB_TOP], 1u);
            const unsigned tg = og / nx;
            if (og + 1u == (tg + 1u) * nx) xb_add(&bar[XB_TOPGEN], 1u);
            else XB_SPIN(xb_ld(&bar[XB_TOPGEN]) == tg, bar);
            __builtin_amdgcn_fence(__ATOMIC_ACQUIRE, "agent");
            xb_add(&bar[XB_XGEN(b.x)], 1u);
            asm volatile("s_waitcnt vmcnt(0)" ::: "memory");
        } else {
            XB_SPIN(xb_ld(&bar[XB_XGEN(b.x)]) == gen, bar);
            __builtin_amdgcn_fence(__ATOMIC_ACQUIRE, "agent");
            asm volatile("s_waitcnt vmcnt(0)" ::: "memory");
        }
    }
    __syncthreads();
}


namespace pg8 {
struct EpiZ {
    static constexpr bool PERM = true, AFTER_DRAIN = false;
    bf16_t* O; int ldc; float* fcbuf;
    __device__ __forceinline__ void operator()(const f32x4 (&acc)[2][2][4][2], const Unit& u, int wr, int wc, int fr, int fq) const {
        const int row0 = u.pm * BM + wr * 64 + fr, col0 = u.pn * BM + wc * 32 + 8 * fq;
        const bool fcl = (u.pn == 9) && (wc == 1) && (fq == 0);
#pragma unroll
        for (int ai = 0; ai < 2; ++ai)
#pragma unroll
            for (int m = 0; m < 4; ++m) {
                const int row = row0 + ai * HALF + m * 16;
                bf16_t* rowp = O + (size_t)row * ldc + col0;
#pragma unroll
                for (int bj = 0; bj < 2; ++bj) {
                    const f32x4 v0 = acc[ai][bj][m][0], v1 = acc[ai][bj][m][1];
                    u32x4 w; w.x = cvt_pk_bf16(v0[0], v0[1]); w.y = cvt_pk_bf16(v0[2], v0[3]); w.z = cvt_pk_bf16(v1[0], v1[1]); w.w = cvt_pk_bf16(v1[2], v1[3]);
                    *(u32x4*)(rowp + bj * HALF) = w;
                }
                if (fcl) *(f32x4*)(fcbuf + (size_t)row * 4) = acc[ai][0][m][0];
            }
    }
};
struct EpiRowScale {
    static constexpr bool PERM = true, AFTER_DRAIN = false;
    bf16_t* O; int ldc; const float* rs;
    __device__ __forceinline__ void operator()(const f32x4 (&acc)[2][2][4][2], const Unit& u, int wr, int wc, int fr, int fq) const {
        const int row0 = u.pm * BM + wr * 64 + fr, col0 = u.pn * BM + wc * 32 + 8 * fq;
#pragma unroll
        for (int ai = 0; ai < 2; ++ai)
#pragma unroll
            for (int m = 0; m < 4; ++m) {
                const int row = row0 + ai * HALF + m * 16;
                const float s = rs[row];
                bf16_t* rowp = O + (size_t)row * ldc + col0;
#pragma unroll
                for (int bj = 0; bj < 2; ++bj) {
                    const f32x4 v0 = acc[ai][bj][m][0] * s, v1 = acc[ai][bj][m][1] * s;
                    u32x4 w; w.x = cvt_pk_bf16(v0[0], v0[1]); w.y = cvt_pk_bf16(v0[2], v0[3]); w.z = cvt_pk_bf16(v1[0], v1[1]); w.w = cvt_pk_bf16(v1[2], v1[3]);
                    *(u32x4*)(rowp + bj * HALF) = w;
                }
            }
    }
};
struct EpiGU {
    static constexpr bool PERM = true, AFTER_DRAIN = false;
    bf16_t* O;
    __device__ __forceinline__ void operator()(const f32x4 (&acc)[2][2][4][2], const Unit& u, int wr, int wc, int fr, int fq) const {
        const int row0 = u.pm * BM + wr * 64 + fr, f0 = ((u.pn & 1) * BM + wc * 32 + 8 * fq) >> 1;
#pragma unroll
        for (int ai = 0; ai < 2; ++ai)
#pragma unroll
            for (int m = 0; m < 4; ++m) {
                bf16_t* rowp = O + (size_t)(row0 + ai * HALF + m * 16) * 256 + f0;
#pragma unroll
                for (int bj = 0; bj < 2; ++bj) {
                    const f32x4 v0 = acc[ai][bj][m][0], v1 = acc[ai][bj][m][1];
                    const float a0 = v0[0] / (1.f + __expf(-v0[0])) * v0[1], a1 = v0[2] / (1.f + __expf(-v0[2])) * v0[3];
                    const float a2 = v1[0] / (1.f + __expf(-v1[0])) * v1[1], a3 = v1[2] / (1.f + __expf(-v1[2])) * v1[3];
                    typedef unsigned u32x2 __attribute__((ext_vector_type(2)));
                    u32x2 w; w.x = cvt_pk_bf16(a0, a1); w.y = cvt_pk_bf16(a2, a3);
                    *(u32x2*)(rowp + bj * (HALF / 2)) = w;
                }
            }
    }
};
struct EpiPleGate {
    static constexpr bool PERM = true, AFTER_DRAIN = false;
    bf16_t* O; const bf16_t* PP;
    __device__ __forceinline__ void operator()(const f32x4 (&acc)[2][2][4][2], const Unit& u, int wr, int wc, int fr, int fq) const {
        const int row0 = u.pm * BM + wr * 64 + fr, col0 = u.pn * BM + wc * 32 + 8 * fq;
#pragma unroll
        for (int ai = 0; ai < 2; ++ai)
#pragma unroll
            for (int m = 0; m < 4; ++m) {
                const size_t off = (size_t)(row0 + ai * HALF + m * 16) * 1024 + col0;
#pragma unroll
                for (int bj = 0; bj < 2; ++bj) {
                    const f32x4 v0 = acc[ai][bj][m][0], v1 = acc[ai][bj][m][1];
                    const u32x4 pw = *(const u32x4*)(PP + off + bj * HALF);
                    float o[8];
                    o[0] = __uint_as_float(pw.x << 16) / (1.f + __expf(-v0[0])); o[1] = __uint_as_float(pw.x & 0xffff0000u) / (1.f + __expf(-v0[1]));
                    o[2] = __uint_as_float(pw.y << 16) / (1.f + __expf(-v0[2])); o[3] = __uint_as_float(pw.y & 0xffff0000u) / (1.f + __expf(-v0[3]));
                    o[4] = __uint_as_float(pw.z << 16) / (1.f + __expf(-v1[0])); o[5] = __uint_as_float(pw.z & 0xffff0000u) / (1.f + __expf(-v1[1]));
                    o[6] = __uint_as_float(pw.w << 16) / (1.f + __expf(-v1[2])); o[7] = __uint_as_float(pw.w & 0xffff0000u) / (1.f + __expf(-v1[3]));
                    u32x4 w; w.x = cvt_pk_bf16(o[0], o[1]); w.y = cvt_pk_bf16(o[2], o[3]); w.z = cvt_pk_bf16(o[4], o[5]); w.w = cvt_pk_bf16(o[6], o[7]);
                    *(u32x4*)(O + off + bj * HALF) = w;
                }
            }
    }
};
struct EpiDown {
    static constexpr bool PERM = true, AFTER_DRAIN = false;
    bf16_t* O;
    __device__ __forceinline__ void operator()(const f32x4 (&acc)[2][2][4][2], const Unit& u, int wr, int wc, int fr, int fq) const {
        const int row0 = u.pm * BM + wr * 64 + fr, col0 = (u.pn & 3) * BM + wc * 32 + 8 * fq;
#pragma unroll
        for (int ai = 0; ai < 2; ++ai)
#pragma unroll
            for (int m = 0; m < 4; ++m) {
                bf16_t* rowp = O + (size_t)(row0 + ai * HALF + m * 16) * 1024 + col0;
#pragma unroll
                for (int bj = 0; bj < 2; ++bj) {
                    const f32x4 v0 = acc[ai][bj][m][0], v1 = acc[ai][bj][m][1];
                    u32x4 w; w.x = cvt_pk_bf16(v0[0], v0[1]); w.y = cvt_pk_bf16(v0[2], v0[3]); w.z = cvt_pk_bf16(v1[0], v1[1]); w.w = cvt_pk_bf16(v1[2], v1[3]);
                    *(u32x4*)(rowp + bj * HALF) = w;
                }
            }
    }
};
struct OneUnit {
    int pm, pn;
    __device__ __forceinline__ bool next(int i, Unit& u) const { if (i) return false; u.pm = pm; u.pn = pn; return true; }
    __device__ __forceinline__ void a_ready(const Unit&) const {}
    __device__ __forceinline__ void done(const Unit&) const {}
};
struct GroupSched {
    const int* tile_e; int T, NJ, G, vc;
    __device__ __forceinline__ bool next(int i, Unit& u) const {
        const long L = (long)i * G + vc; if (L >= (long)T * NJ) return false;
        const int t = (int)(L / NJ), j = (int)(L % NJ);
        u.pm = t; u.pn = __builtin_amdgcn_readfirstlane(tile_e[t]) * NJ + j; return true;
    }
    __device__ __forceinline__ void a_ready(const Unit&) const {}
    __device__ __forceinline__ void done(const Unit&) const {}
};
}

template <class Map>
__device__ __forceinline__ void transpose_rows(const Map mp, const float* ks, int nrows_out, int K, bf16* WT, LAS float* scr, int gw, int NGW, int lane) {
    const int nblk = nrows_out / 32, nitems = (K / 64) * nblk;
    const int f = lane & 7, kr = lane >> 3;
    for (int it = gw; it < nitems; it += NGW) {
        const int kb = it / nblk, nb = it % nblk, k0 = 64 * kb, n0 = 32 * nb;
        const float* src; long pitch; float sc; int nl0, nls;
        mp.get4(n0, f, src, pitch, sc, nl0, nls);
        f32x4_t vals[8];
#pragma unroll
        for (int i = 0; i < 8; ++i) vals[i] = src ? *(const f32x4_t*)(src + (size_t)(k0 + kr + 8 * i) * pitch) : (f32x4_t){0.f, 0.f, 0.f, 0.f};
#pragma unroll
        for (int i = 0; i < 8; ++i) {
            const int kk = kr + 8 * i;
            float m = sc; if (ks) m *= ks[k0 + kk];
            scr[kk * 33 + nl0] = vals[i].x * m; scr[kk * 33 + nl0 + nls] = vals[i].y * m; scr[kk * 33 + nl0 + 2 * nls] = vals[i].z * m; scr[kk * 33 + nl0 + 3 * nls] = vals[i].w * m;
        }
        asm volatile("s_waitcnt lgkmcnt(0)" ::: "memory");
        const int c = lane & 7;
#pragma unroll
        for (int j = 0; j < 4; ++j) {
            const int n = (lane >> 3) + 8 * j; const LAS float* s = scr + (8 * c) * 33 + n;
            v4u o; o.x = pk2(s[0 * 33], s[1 * 33]); o.y = pk2(s[2 * 33], s[3 * 33]); o.z = pk2(s[4 * 33], s[5 * 33]); o.w = pk2(s[6 * 33], s[7 * 33]);
            *(v4u*)(WT + (size_t)(n0 + n) * K + k0 + 8 * c) = o;
        }
        asm volatile("s_waitcnt lgkmcnt(0)" ::: "memory");
    }
}
constexpr float LOG2E_W = 1.4426950408889634f;
struct MapIn {
    const float* w;
    __device__ __forceinline__ void get(int n, const float*& src, long& pitch, float& sc) const {
        int c;
        if (n < 1152) c = n;
        else if (n < Z_CKV) c = OFF_QC + (n - Z_QC);
        else if (n < Z_CQ) c = OFF_CKV + (n - Z_CKV);
        else if (n < Z_KR) c = OFF_CQ + (n - Z_CQ);
        else if (n < Z_FC) c = OFF_KR + (n - Z_KR);
        else if (n < Z_FC + 4) c = OFF_FC + (n - Z_FC);
        else c = -1;
        src = c >= 0 ? w + c : nullptr; pitch = D_IN;
        sc = n < Z_KA ? 0.17677669529663687f * LOG2E_W : ((n >= Z_QC && n < Z_KC) ? 0.125f * LOG2E_W : 1.f);
    }
    __device__ __forceinline__ void get4(int n0, int f, const float*& src, long& pitch, float& sc, int& nl0, int& nls) const { get(n0 + 4 * f, src, pitch, sc); nl0 = 4 * f; nls = 1; }
};
struct MapPlain {
    const float* w; int N, nvalid; float scale;
    __device__ __forceinline__ void get(int n, const float*& src, long& pitch, float& sc) const { src = n < nvalid ? w + n : nullptr; pitch = N; sc = scale; }
    __device__ __forceinline__ void get4(int n0, int f, const float*& src, long& pitch, float& sc, int& nl0, int& nls) const { get(n0 + 4 * f, src, pitch, sc); nl0 = 4 * f; nls = 1; }
};

struct MapGU {
    const float* wg; const float* wu;
    __device__ __forceinline__ void get(int n, const float*& src, long& pitch, float& sc) const {
        const int e = n >> 9, r = n & 511, f = r >> 1;
        const long dlt = (r & 1) ? (long)(wu - wg) : 0l;
        src = wg + dlt + (size_t)e * 1024 * 256 + f; pitch = 256; sc = 1.f;
    }
    __device__ __forceinline__ void get4(int n0, int f, const float*& src, long& pitch, float& sc, int& nl0, int& nls) const {
        const int e = n0 >> 9, f0 = (n0 & 511) >> 1;
        const long dlt = (f >> 2) ? (long)(wu - wg) : 0l;
        src = wg + dlt + (size_t)e * 1024 * 256 + f0 + 4 * (f & 3); pitch = 256; sc = 1.f; nl0 = 8 * (f & 3) + (f >> 2); nls = 2;
    }
};
struct MapD {
    const float* wd;
    __device__ __forceinline__ void get(int n, const float*& src, long& pitch, float& sc) const {
        const int e = n >> 10, c = n & 1023;
        src = wd + (size_t)e * 256 * 1024 + c; pitch = 1024; sc = 1.f;
    }
    __device__ __forceinline__ void get4(int n0, int f, const float*& src, long& pitch, float& sc, int& nl0, int& nls) const { get(n0 + 4 * f, src, pitch, sc); nl0 = 4 * f; nls = 1; }
};

struct AttnP {
    const bf16* z16; const bf16* qb16; const bf16* kvb16; const bf16* krr16; const float* cum; const float* cosT; const float* sinT;
    const int* pos; bf16* mixed16; const float* lq1; const float* lk1; const float* lq2; const float* lk2; const float* gdiff; int layer; unsigned* prof; const int* tpmax; float lam, lam_init;
};
typedef short bf16x8_t __attribute__((ext_vector_type(8)));
typedef float f32x16_t __attribute__((ext_vector_type(16)));
typedef short s16x4_t __attribute__((ext_vector_type(4)));
typedef float f32x2_t __attribute__((ext_vector_type(2)));
typedef __bf16 bf16x2_t __attribute__((ext_vector_type(2)));
__device__ __forceinline__ unsigned cvtpk(float lo, float hi) { f32x2_t v = {lo, hi}; bf16x2_t b = __builtin_convertvector(v, bf16x2_t); return __builtin_bit_cast(unsigned, b); }
__device__ __forceinline__ int crow(int r, int hi) { return (r & 3) + 8 * (r >> 2) + 4 * hi; }
__device__ __forceinline__ s16x4_t vtr(const LAS unsigned char* p) { typedef short v4i16_t __attribute__((ext_vector_type(4))); return __builtin_bit_cast(s16x4_t, __builtin_amdgcn_ds_read_tr16_b64_v4i16((LAS v4i16_t*)p)); }
constexpr float LOG2E = 1.4426950408889634f;

__device__ __forceinline__ float xhalf_max(float m) { auto rr = __builtin_amdgcn_permlane32_swap(__float_as_uint(m), __float_as_uint(m), false, false); return __builtin_fmaxf(__uint_as_float(rr[0]), __uint_as_float(rr[1])); }
__device__ __forceinline__ float xhalf_sum(float m) { auto rr = __builtin_amdgcn_permlane32_swap(__float_as_uint(m), __float_as_uint(m), false, false); return __uint_as_float(rr[0]) + __uint_as_float(rr[1]); }
__device__ __forceinline__ float max3f(float a, float b, float c) { return __builtin_fmaxf(__builtin_fmaxf(a, b), c); }
template <int MODE> __device__ __forceinline__ void attn_unit(const AttnP& p, int b, int h, int qblk, LAS unsigned char* lds, const int tid_in) {
    int tid = tid_in * 64 + lane_id_now(); asm volatile("" : "+v"(tid));
#ifdef PROF_SEL
    const unsigned long long pu0 = __builtin_amdgcn_s_memrealtime(); unsigned long long pt0 = 0, pl0 = 0, pacc_c = 0, pacc_b = 0;
#define PROF_T(acc) do { const unsigned long long t_ = __builtin_amdgcn_s_memrealtime(); acc += t_ - pt0; pt0 = t_; } while (0)
#else
#define PROF_T(acc) do {} while (0)
#endif
    constexpr int NF = MODE == 0 ? 2 : (MODE == 1 ? 6 : 4);
    constexpr int NC = MODE == 1 ? 12 : 8;
    constexpr int KB = NC * 1024, KBUF = KB + 256;
    constexpr int VOFF = 2 * KBUF;
    constexpr int KI = (NC * 64 + NTHREADS - 1) / NTHREADS;
    const int lane = tid & 63, w = __builtin_amdgcn_readfirstlane(tid >> 6), r32 = lane & 31, hi = lane >> 5;
    const int map = MODE == 0 ? (w >> 2) : 0, qg = MODE == 0 ? (w & 3) : w;
    const int c = MODE == 0 ? qblk * 2 + (qg >> 1) : qblk * 4 + (qg >> 1);
    const int ntiles = MODE == 0 ? qblk * 2 + 2 : qblk * 4 + 4;
    const long tok0 = (long)b * SEQ;
    const int q0u = MODE == 0 ? qblk * 128 : qblk * 256;
    const long qrow = tok0 + q0u + qg * 32 + r32;
    float slope2 = 0.f, sq = 0.f, refv = 0.f; int qpmin = 0;
    const bf16* ksrc[KI]; bool kok[KI];
#pragma unroll
    for (int i = 0; i < KI; ++i) {
        const int pidx0 = tid + i * NTHREADS;
        kok[i] = pidx0 < NC * 64;
        const int pidx = kok[i] ? pidx0 : pidx0 - NTHREADS, c8 = pidx >> 6, kv = pidx & 63;
        if (MODE == 0) ksrc[i] = p.z16 + (tok0 + kv) * ZP + Z_KA + h * 64 + c8 * 8;
        else if (MODE == 2) ksrc[i] = p.z16 + (tok0 + kv) * ZP + Z_KC + h * 64 + c8 * 8;
        else ksrc[i] = (c8 < 8) ? p.kvb16 + (tok0 + kv) * NKVB + h * 128 + c8 * 8 : p.krr16 + (tok0 + kv) * 32 + (c8 - 8) * 8;
    }
    const int kstride = MODE == 1 ? 0 : 64 * ZP;
    const int vcl = tid & 3, vkv = (tid >> 2) & 63, vch = tid >> 8;
    const bf16* vsrc = MODE == 0 ? p.z16 + (tok0 + vkv) * ZP + Z_VA + h * 64 + (vch * 4 + vcl) * 8
                     : (MODE == 1 ? p.kvb16 + (tok0 + vkv) * NKVB + h * 128 + 64 + (vch * 4 + vcl) * 8 : p.z16 + (tok0 + vkv) * ZP + Z_VC + h * 64 + (vch * 4 + vcl) * 8);
    const int vstride = MODE == 1 ? 64 * NKVB : 64 * ZP;
    LAS unsigned char* const vdstp = lds + VOFF + vch * 4096 + (vkv >> 3) * 512 + (vkv & 7) * 64 + vcl * 16;
    LAS unsigned char* const kdstp = lds + tid * 16;
    v4u kreg0[KI], kreg1[KI], vreg0, vreg1; unsigned breg0 = 0u, breg1 = 0u;
    auto load_k = [&](int kt_, v4u (&kreg)[KI], unsigned& breg) {
        const int kt = kt_ < ntiles ? kt_ : ntiles - 1;
#pragma unroll
        for (int i = 0; i < KI; ++i) {
            const int pidx = tid + i * NTHREADS;
            const long off = MODE == 1 ? (((kok[i] ? pidx : pidx - NTHREADS) >> 6) < 8 ? (long)kt * 64 * NKVB : (long)kt * 64 * 32) : (long)kt * kstride;
            kreg[i] = *(const v4u*)(ksrc[i] + off);
        }
        if (MODE == 0) breg = (unsigned)p.pos[tok0 + kt * 64 + (tid & 63)];
        if (MODE == 2) breg = __float_as_uint(p.cum[(tok0 + kt * 64 + (tid & 63)) * 4 + h]);
    };
    auto load_v = [&](int kt_, v4u& vreg) { const int kt = kt_ < ntiles ? kt_ : ntiles - 1; vreg = *(const v4u*)(vsrc + (long)kt * vstride); };
    auto write_k = [&](const int par, const v4u (&kreg)[KI], const unsigned& breg) {
#pragma unroll
        for (int i = 0; i < KI; ++i) if (kok[i]) *(LAS v4u*)(kdstp + par * KBUF + i * NTHREADS * 16) = kreg[i];
        if (MODE != 1 && tid < 64) *(LAS float*)(lds + par * KBUF + KB + tid * 4) = MODE == 0 ? slope2 * ((float)(int)breg - refv) : (refv - __uint_as_float(breg)) * LOG2E;
    };
    auto write_v = [&](const int par, const v4u& vreg) { *(LAS v4u*)(vdstp + par * 8192) = vreg; };
    load_k(0, kreg0, breg0); load_k(1, kreg1, breg1); load_v(0, vreg0); load_v(1, vreg1);
    bf16x8_t qf[NF];
    {
        const bf16* qsrc = MODE == 0 ? p.z16 + qrow * ZP + Z_QA + h * 64 + map * 32 : (MODE == 1 ? p.qb16 + qrow * NQBP + h * 96 : p.z16 + qrow * ZP + Z_QC + h * 64);
#pragma unroll
        for (int i = 0; i < NF; ++i) qf[i] = *(const bf16x8_t*)(qsrc + i * 16 + hi * 8);
    }
    if (MODE == 1) {
        const float4 c0 = *(const float4*)(p.cosT + qrow * 16 + hi * 8), c1 = *(const float4*)(p.cosT + qrow * 16 + hi * 8 + 4);
        const float4 s0 = *(const float4*)(p.sinT + qrow * 16 + hi * 8), s1 = *(const float4*)(p.sinT + qrow * 16 + hi * 8 + 4);
        const float cs[8] = {c0.x, c0.y, c0.z, c0.w, c1.x, c1.y, c1.z, c1.w}, sn[8] = {s0.x, s0.y, s0.z, s0.w, s1.x, s1.y, s1.z, s1.w};
        float n1[8], n2[8];
#pragma unroll
        for (int j = 0; j < 8; ++j) {
            const float x1 = __uint_as_float((unsigned)(unsigned short)qf[NF - 2][j] << 16), x2 = __uint_as_float((unsigned)(unsigned short)qf[NF - 1][j] << 16);
            n1[j] = x1 * cs[j] - x2 * sn[j]; n2[j] = x2 * cs[j] + x1 * sn[j];
        }
        v4u a, bb;
        a.x = cvtpk(n1[0], n1[1]); a.y = cvtpk(n1[2], n1[3]); a.z = cvtpk(n1[4], n1[5]); a.w = cvtpk(n1[6], n1[7]);
        bb.x = cvtpk(n2[0], n2[1]); bb.y = cvtpk(n2[2], n2[3]); bb.z = cvtpk(n2[4], n2[5]); bb.w = cvtpk(n2[6], n2[7]);
        qf[NF - 2] = __builtin_bit_cast(bf16x8_t, a); qf[NF - 1] = __builtin_bit_cast(bf16x8_t, bb);
    }
    if (MODE == 0) {
        slope2 = exp2f(-8.0f * (float)(h + 1) / 6.0f) * LOG2E;
        const int pref = p.pos[tok0 + q0u]; refv = (float)pref;
        const int pq = p.pos[qrow]; sq = slope2 * (float)(pq - pref);
        int mn = pq;
#pragma unroll
        for (int o_ = 1; o_ < 64; o_ <<= 1) mn = min(mn, __builtin_amdgcn_ds_bpermute((lane ^ o_) << 2, mn));
        qpmin = __builtin_amdgcn_readfirstlane(mn);
    }
    if (MODE == 2) refv = p.cum[(tok0 + q0u) * 4 + h];
    f32x16_t o[2];
    float mrun = -INFINITY, lsum = 0.f;
#pragma unroll
    for (int r = 0; r < 16; ++r) { o[0][r] = 0.f; o[1][r] = 0.f; }
    LAS unsigned char* const kfp = lds + (map * NF * 2 + hi) * 1024 + r32 * 16;
    LAS unsigned char* const bfp = lds + KB + 16 * hi;
    LAS unsigned char* const vfp = lds + VOFF + (4 * hi + ((lane & 15) >> 2)) * 64 + ((lane >> 4) & 1) * 32 + (lane & 3) * 8;
    auto compute_s = [&](const int kt, const int par, f32x16_t& p0, f32x16_t& p1) {
        constexpr int KG = NF > 4 ? 3 : NF;
        bf16x8_t kf0[KG], kf1[KG];
#pragma unroll
        for (int d0 = 0; d0 < KG; ++d0) { kf0[d0] = *(const LAS bf16x8_t*)(kfp + par * KBUF + d0 * 2048); kf1[d0] = *(const LAS bf16x8_t*)(kfp + par * KBUF + d0 * 2048 + 512); }
        if (MODE == 1) {
#pragma unroll
            for (int r = 0; r < 16; ++r) { p0[r] = 0.f; p1[r] = 0.f; }
        } else {
#pragma unroll
            for (int g = 0; g < 4; ++g) {
                const f32x4_t b0 = *(const LAS f32x4_t*)(bfp + par * KBUF + 32 * g), b1 = *(const LAS f32x4_t*)(bfp + par * KBUF + 128 + 32 * g);
                p0[4 * g] = b0.x; p0[4 * g + 1] = b0.y; p0[4 * g + 2] = b0.z; p0[4 * g + 3] = b0.w;
                p1[4 * g] = b1.x; p1[4 * g + 1] = b1.y; p1[4 * g + 2] = b1.z; p1[4 * g + 3] = b1.w;
            }
        }
        __builtin_amdgcn_sched_barrier(0);
#pragma unroll
        for (int d0 = 0; d0 < KG; ++d0) {
            p0 = __builtin_amdgcn_mfma_f32_32x32x16_bf16(kf0[d0], qf[d0], p0, 0, 0, 0);
            p1 = __builtin_amdgcn_mfma_f32_32x32x16_bf16(kf1[d0], qf[d0], p1, 0, 0, 0);
        }
        if (NF > KG) {
#pragma unroll
            for (int d0 = KG; d0 < NF; ++d0) { kf0[d0 - KG] = *(const LAS bf16x8_t*)(kfp + par * KBUF + d0 * 2048); kf1[d0 - KG] = *(const LAS bf16x8_t*)(kfp + par * KBUF + d0 * 2048 + 512); }
#pragma unroll
            for (int d0 = KG; d0 < NF; ++d0) {
                p0 = __builtin_amdgcn_mfma_f32_32x32x16_bf16(kf0[d0 - KG], qf[d0], p0, 0, 0, 0);
                p1 = __builtin_amdgcn_mfma_f32_32x32x16_bf16(kf1[d0 - KG], qf[d0], p1, 0, 0, 0);
            }
        }
        if (MODE == 0) {
            if (kt == c || p.tpmax[b * 32 + kt] > qpmin) {
#pragma unroll
                for (int g = 0; g < 4; ++g) {
                    const f32x4_t b0 = *(const LAS f32x4_t*)(bfp + par * KBUF + 32 * g), b1 = *(const LAS f32x4_t*)(bfp + par * KBUF + 128 + 32 * g);
                    p0[4 * g] += 2.f * fminf(sq - b0.x, 0.f); p0[4 * g + 1] += 2.f * fminf(sq - b0.y, 0.f); p0[4 * g + 2] += 2.f * fminf(sq - b0.z, 0.f); p0[4 * g + 3] += 2.f * fminf(sq - b0.w, 0.f);
                    p1[4 * g] += 2.f * fminf(sq - b1.x, 0.f); p1[4 * g + 1] += 2.f * fminf(sq - b1.y, 0.f); p1[4 * g + 2] += 2.f * fminf(sq - b1.z, 0.f); p1[4 * g + 3] += 2.f * fminf(sq - b1.w, 0.f);
                }
            }
        }
        if (MODE == 2) {
            if (kt == c) {
                const int qi = (qg & 1) * 32 + r32;
#pragma unroll
                for (int r = 0; r < 16; ++r) { const int kv = crow(r, hi); if (kv > qi) p0[r] = -INFINITY; if (kv + 32 > qi) p1[r] = -INFINITY; }
            }
        }
    };
    auto softmax_pv = [&](const int par, f32x16_t& p0, f32x16_t& p1) {
        constexpr int VE = 4;
        s16x4_t vlo[8], vhi[8];
#pragma unroll
        for (int i = 0; i < VE; ++i) { vlo[i] = vtr(vfp + par * 8192 + (i & 1) * 4096 + (i >> 1) * 1024); vhi[i] = vtr(vfp + par * 8192 + (i & 1) * 4096 + (i >> 1) * 1024 + 512); }
        __builtin_amdgcn_sched_barrier(0);
        float tm0 = max3f(p0[0], p0[1], p0[2]), tm1 = max3f(p1[0], p1[1], p1[2]);
#pragma unroll
        for (int r = 3; r < 15; r += 2) { tm0 = max3f(tm0, p0[r], p0[r + 1]); tm1 = max3f(tm1, p1[r], p1[r + 1]); }
        float tmax = max3f(tm0, tm1, p0[15]); tmax = __builtin_fmaxf(tmax, p1[15]);
        tmax = xhalf_max(tmax);
        const float mnew = __builtin_fmaxf(mrun, tmax);
        if (__any(mnew > mrun)) {
            const float f = __builtin_amdgcn_exp2f(mrun - mnew);
            lsum *= f;
#pragma unroll
            for (int r = 0; r < 16; ++r) { o[0][r] *= f; o[1][r] *= f; }
            mrun = mnew;
        }
        float ls0 = 0.f, ls1 = 0.f;
#pragma unroll
        for (int r = 0; r < 16; ++r) { p0[r] = __builtin_amdgcn_exp2f(p0[r] - mnew); p1[r] = __builtin_amdgcn_exp2f(p1[r] - mnew); ls0 += p0[r]; ls1 += p1[r]; }
        lsum += ls0 + ls1;
        bf16x8_t pa[4];
#pragma unroll
        for (int ks = 0; ks < 4; ++ks) {
            v4u wv;
            if (ks < 2) { wv.x = cvtpk(p0[8 * ks + 0], p0[8 * ks + 1]); wv.y = cvtpk(p0[8 * ks + 2], p0[8 * ks + 3]); wv.z = cvtpk(p0[8 * ks + 4], p0[8 * ks + 5]); wv.w = cvtpk(p0[8 * ks + 6], p0[8 * ks + 7]); }
            else { wv.x = cvtpk(p1[8 * (ks - 2) + 0], p1[8 * (ks - 2) + 1]); wv.y = cvtpk(p1[8 * (ks - 2) + 2], p1[8 * (ks - 2) + 3]); wv.z = cvtpk(p1[8 * (ks - 2) + 4], p1[8 * (ks - 2) + 5]); wv.w = cvtpk(p1[8 * (ks - 2) + 6], p1[8 * (ks - 2) + 7]); }
            pa[ks] = __builtin_bit_cast(bf16x8_t, wv);
        }
#pragma unroll
        for (int i = VE; i < 8; ++i) { vlo[i] = vtr(vfp + par * 8192 + (i & 1) * 4096 + (i >> 1) * 1024); vhi[i] = vtr(vfp + par * 8192 + (i & 1) * 4096 + (i >> 1) * 1024 + 512); }
#pragma unroll
        for (int ks = 0; ks < 4; ++ks)
#pragma unroll
            for (int blk = 0; blk < 2; ++blk) {
                const s16x4_t lo = vlo[ks * 2 + blk], hi4 = vhi[ks * 2 + blk];
                const bf16x8_t vf = {lo[0], lo[1], lo[2], lo[3], hi4[0], hi4[1], hi4[2], hi4[3]};
                o[blk] = __builtin_amdgcn_mfma_f32_32x32x16_bf16(vf, pa[ks], o[blk], 0, 0, 0);
            }
    };
    constexpr bool PIPE = false;
    f32x16_t pA0, pA1, pB0, pB1;
    if (PIPE) {
        write_k(0, kreg0, breg0); write_k(1, kreg1, breg1); write_v(0, vreg0);
        load_k(2, kreg0, breg0);
        __syncthreads();
        compute_s(0, 0, pA0, pA1);
        __syncthreads();
    } else {
        write_k(0, kreg0, breg0); write_v(0, vreg0);
        __syncthreads();
    }
#ifdef PROF_SEL
    pl0 = __builtin_amdgcn_s_memrealtime();
#endif
#pragma unroll 1
    for (int kt = 0; kt < ntiles; kt += 2) {
#ifdef PROF_SEL
        pt0 = __builtin_amdgcn_s_memrealtime();
#endif
        if (PIPE) {
            load_k(kt + 3, kreg1, breg1); load_v(kt + 2, vreg0);
            if (kt < c) { compute_s(kt + 1, 1, pB0, pB1); __builtin_amdgcn_sched_barrier(0); softmax_pv(0, pA0, pA1); }
            else if (kt == c) softmax_pv(0, pA0, pA1);
            write_k(0, kreg0, breg0); write_v(1, vreg1);
        } else {
            load_k(kt + 2, kreg0, breg0); load_v(kt + 2, vreg0);
            if (kt <= c) { compute_s(kt, 0, pA0, pA1); softmax_pv(0, pA0, pA1); }
            write_k(1, kreg1, breg1); write_v(1, vreg1);
        }
        PROF_T(pacc_c);
        __syncthreads();
        PROF_T(pacc_b);
        if (PIPE) {
            load_k(kt + 4, kreg0, breg0); load_v(kt + 3, vreg1);
            if (kt + 1 < c) { compute_s(kt + 2, 0, pA0, pA1); __builtin_amdgcn_sched_barrier(0); softmax_pv(1, pB0, pB1); }
            else if (kt + 1 == c) softmax_pv(1, pB0, pB1);
            write_k(1, kreg1, breg1); write_v(0, vreg0);
        } else {
            load_k(kt + 3, kreg1, breg1); load_v(kt + 3, vreg1);
            if (kt + 1 <= c) { compute_s(kt + 1, 1, pA0, pA1); softmax_pv(1, pA0, pA1); }
            write_k(0, kreg0, breg0); write_v(0, vreg0);
        }
        PROF_T(pacc_c);
        __syncthreads();
        PROF_T(pacc_b);
    }
#ifdef PROF_SEL
    const unsigned long long pl1 = __builtin_amdgcn_s_memrealtime();
#endif
    const float inv = 1.f / xhalf_sum(lsum);
    int tid2 = tid_in * 64 + lane_id_now(); asm volatile("" : "+v"(tid2));
    const int lane2 = tid2 & 63, hi2 = lane2 >> 5, qg2 = MODE == 0 ? ((tid2 >> 6) & 3) : (tid2 >> 6);
    const long qrow2 = tok0 + q0u + qg2 * 32 + (lane2 & 31);
    bf16* op = p.mixed16 + qrow2 * D_MODEL + (MODE == 0 ? 0 : (MODE == 1 ? 384 : 768)) + h * 64;
    if (MODE == 0) {
        LAS float* xb = (LAS float*)lds + qg2 * 2048 + lane2;
        if (map == 1) {
#pragma unroll
            for (int blk = 0; blk < 2; ++blk)
#pragma unroll
                for (int r = 0; r < 16; ++r) xb[(blk * 16 + r) * 64] = o[blk][r] * inv;
        }
        __syncthreads();
        if (map == 0) {
            const float lam_init = p.lam_init, lam = p.lam;
            float ss = 0.f;
#pragma unroll
            for (int blk = 0; blk < 2; ++blk)
#pragma unroll
                for (int r = 0; r < 16; ++r) { const float v = o[blk][r] * inv - lam * xb[(blk * 16 + r) * 64]; o[blk][r] = v; ss = fmaf(v, v, ss); }
            ss = xhalf_sum(ss);
            const float rr = rsqrtf(ss * (1.f / 64.f) + RMS_EPS) * (1.f - lam_init);
#pragma unroll
            for (int blk = 0; blk < 2; ++blk)
#pragma unroll
                for (int g = 0; g < 4; ++g) {
                    const int d = 32 * blk + 8 * g + 4 * hi2;
                    const float4 gv = *(const float4*)(p.gdiff + d);
                    v2u wv; wv.x = cvtpk(o[blk][4 * g] * rr * gv.x, o[blk][4 * g + 1] * rr * gv.y); wv.y = cvtpk(o[blk][4 * g + 2] * rr * gv.z, o[blk][4 * g + 3] * rr * gv.w);
                    *(v2u*)(op + d) = wv;
                }
        }
        __syncthreads();
    } else {
#pragma unroll
        for (int blk = 0; blk < 2; ++blk)
#pragma unroll
            for (int g = 0; g < 4; ++g) {
                const int d = 32 * blk + 8 * g + 4 * hi2;
                v2u wv; wv.x = cvtpk(o[blk][4 * g] * inv, o[blk][4 * g + 1] * inv); wv.y = cvtpk(o[blk][4 * g + 2] * inv, o[blk][4 * g + 3] * inv);
                *(v2u*)(op + d) = wv;
            }
    }
#ifdef PROF_SEL
    if (p.layer == 0 && blockIdx.x == 7 && w == PROF_WAVE && lane == 0) {
        unsigned* pw = p.prof; const unsigned long long pu1 = __builtin_amdgcn_s_memrealtime();
        atomicAdd(pw + 0, (unsigned)(pu1 - pu0)); atomicAdd(pw + 1, (unsigned)(pl1 - pl0)); atomicAdd(pw + 2, (unsigned)pacc_c); atomicAdd(pw + 3, (unsigned)pacc_b);
        atomicAdd(pw + 4, (unsigned)ntiles * 100u); atomicAdd(pw + 5, 10000u); atomicAdd(pw + 6, (unsigned)(c + 1) * 100u);
    }
#endif
}

typedef const __attribute__((address_space(4))) char* kargp_t;
__device__ __forceinline__ kargp_t karg_base() { kargp_t p = (kargp_t)__builtin_amdgcn_kernarg_segment_ptr(); asm volatile("" : "+s"(p)); return p; }
#define KARG(i) (*(const void* const __attribute__((address_space(4)))*)(kp + 8 * (i)))
#define KOUT (*(float* const __attribute__((address_space(4)))*)(kp + 224))
#define KWS (*(unsigned char* const __attribute__((address_space(4)))*)(kp + 232))
__device__ __forceinline__ void convert_layer_weights(const Args& a, int l, unsigned char* ws, LAS float* scr, int gw, int NGW, int lane) {
    const kargp_t kp = karg_base();
    const float* w_in = (const float*)KARG(3) + (size_t)l * D_MODEL * D_IN;
    const float* w_uq = (const float*)KARG(4) + (size_t)l * 256 * NQB;
    const float* w_ukv = (const float*)KARG(5) + (size_t)l * 128 * NKVB;
    const float* g_cq = (const float*)KARG(6) + l * 256;
    const float* g_ckv = (const float*)KARG(7) + l * 128;
    const float* w_out = (const float*)KARG(14) + (size_t)l * 1024 * 1024;
    transpose_rows(MapIn{w_in}, nullptr, ZP, 1024, (bf16*)(ws + WS_WIN), scr, gw, NGW, lane);
    transpose_rows(MapPlain{w_uq, NQB, NQB, 0.10206207261596575f * LOG2E_W}, g_cq, NQBP, 256, (bf16*)(ws + WS_WUQ), scr, gw, NGW, lane);
    transpose_rows(MapPlain{w_ukv, NKVB, NKVB, 1.f}, g_ckv, NKVB, 128, (bf16*)(ws + WS_WUKV), scr, gw, NGW, lane);
    transpose_rows(MapPlain{w_out, 1024, 1024, 1.f}, nullptr, 1024, 1024, (bf16*)(ws + WS_WOUT), scr, gw, NGW, lane);
    transpose_rows(MapPlain{(const float*)KARG(24) + (size_t)l * 1024 * 1024, 1024, 1024, 1.f}, nullptr, 1024, 1024, (bf16*)(ws + WS_WPG), scr, gw, NGW, lane);
    transpose_rows(MapPlain{(const float*)KARG(25) + (size_t)l * 256 * 1024, 1024, 1024, 1.f}, nullptr, 1024, 256, (bf16*)(ws + WS_WPP), scr, gw, NGW, lane);
    transpose_rows(MapGU{(const float*)KARG(21) + (size_t)l * 32 * 1024 * 256, (const float*)KARG(22) + (size_t)l * 32 * 1024 * 256}, nullptr, 32 * 512, 1024, (bf16*)(ws + WS_WGU), scr, gw, NGW, lane);
    transpose_rows(MapD{(const float*)KARG(23) + (size_t)l * 32 * 256 * 1024}, nullptr, 32 * 1024, 256, (bf16*)(ws + WS_WD), scr, gw, NGW, lane);
}

constexpr int LDS_MISC = 147456;
constexpr int PH_PER_LAYER = 10, NPH = 1 + DEPTH * PH_PER_LAYER;
template <int PH, bool DUMMY = false> __device__ __forceinline__ void run_phase(const Args& a, unsigned char* lds_raw, const int wave_s) {
    float* sm = (float*)lds_raw;
    const kargp_t kp = karg_base();
    const int G = gridDim.x, NGW = G * 8, NGT = G * NTHREADS;
    unsigned char* ws = KWS;
    const float* x0 = (const float*)KARG(0);
    const float* pin = (const float*)KARG(1);
    const int* pos = (const int*)KARG(2);
    float* cosT = (float*)(ws + WS_COS); float* sinT = (float*)(ws + WS_SIN);
    bf16* a16 = (bf16*)(ws + WS_A16); bf16* z16 = (bf16*)(ws + WS_Z16); bf16* qb16 = (bf16*)(ws + WS_QB16); bf16* kvb16 = (bf16*)(ws + WS_KVB16);
    bf16* krr16 = (bf16*)(ws + WS_KRR16); float* fcbuf = (float*)(ws + WS_FC); float* cum = (float*)(ws + WS_CUM); float* logf = (float*)(ws + WS_LOGF);
    float* rq = (float*)(ws + WS_RQ); float* rkv = (float*)(ws + WS_RKV);
    bf16* mixed16 = (bf16*)(ws + WS_MIXED16); bf16* mix16 = (bf16*)(ws + WS_MIX16);
    bf16* hs16 = (bf16*)(ws + WS_HS16); bf16* act16 = (bf16*)(ws + WS_ACT16); bf16* outs16 = (bf16*)(ws + WS_OUTS16); bf16* ple16 = (bf16*)(ws + WS_PLE16); bf16* pp16 = (bf16*)(ws + WS_PP16); bf16* p16 = (bf16*)(ws + WS_P16);
    int* ids = (int*)(ws + WS_RT + RT_IDS); float* wts = (float*)(ws + WS_RT + RT_WTS); int* rank = (int*)(ws + WS_RT + RT_RANK);
    int* slot_of = (int*)(ws + WS_RT + RT_SLOTOF); int* tile_e = (int*)(ws + WS_RT + RT_TILEE);
    unsigned* ctl = (unsigned*)(ws + WS_CTL);

        int tid = wave_s * 64 + lane_id_now(); asm volatile("" : "+v"(tid));
        const int lane = tid & 63, wave = __builtin_amdgcn_readfirstlane(tid >> 6);
        const int gw = blockIdx.x * 8 + wave, gtid = blockIdx.x * NTHREADS + tid;
        LAS float* scr = (LAS float*)((LAS unsigned char*)lds_raw + wave * 16384);
        if constexpr (PH == 0) {
            for (int i = gtid; i < NTOK * 16; i += NGT) {
                const int tk = i >> 4, j = i & 15;
                const int j4 = j >> 2, jr = j & 3;
                const double inv = (j4 == 0 ? 1.0 : (j4 == 1 ? 0.1 : (j4 == 2 ? 0.01 : 0.001))) * (jr == 0 ? 1.0 : (jr == 1 ? 0.5623413251903491 : (jr == 2 ? 0.31622776601683794 : 0.1778279410038923)));
                const double ang = (double)pos[tk] * inv;
                const double k = rint(ang * 0.15915494309189535);
                const double r = fma(-k, 6.283185307179586, ang) - k * 2.4492935982947064e-16;
                cosT[i] = cosf((float)r); sinT[i] = sinf((float)r);
            }
            auto cvt_stream = [&](const float* sp, bf16* dp, int n8) {
                for (int i = gtid; i < n8; i += 4 * NGT) {
                    f32x4_t v[8];
#pragma unroll
                    for (int u = 0; u < 4; ++u) { v[2 * u] = *(const f32x4_t*)(sp + (size_t)(i + u * NGT) * 8); v[2 * u + 1] = *(const f32x4_t*)(sp + (size_t)(i + u * NGT) * 8 + 4); }
#pragma unroll
                    for (int u = 0; u < 4; ++u) { v4u o; o.x = pk2(v[2 * u].x, v[2 * u].y); o.y = pk2(v[2 * u].z, v[2 * u].w); o.z = pk2(v[2 * u + 1].x, v[2 * u + 1].y); o.w = pk2(v[2 * u + 1].z, v[2 * u + 1].w);
                        *(v4u*)(dp + (size_t)(i + u * NGT) * 8) = o; }
                }
            };
            for (int i = gw; i < BATCH * 32; i += NGW) {
                int v = pos[i * 64 + lane];
#pragma unroll
                for (int o_ = 1; o_ < 64; o_ <<= 1) v = max(v, __shfl_xor(v, o_));
                if (lane == 0) ((int*)(ws + WS_RT + RT_TPMAX))[i] = v;
            }
            cvt_stream(x0, a16, NTOK * D_MODEL / 8);
            cvt_stream(pin, p16, DEPTH * NTOK * PLE_DIM / 8);
            convert_layer_weights(a, 0, ws, scr, gw, NGW, lane);
        } else {
            constexpr int l = (PH - 1) / PH_PER_LAYER, sp = (PH - 1) % PH_PER_LAYER;
            const float* b_forget = (const float*)KARG(13) + l * 4;
            const float* ln1_g = (const float*)KARG(15) + l * 1024; const float* ln1_b = (const float*)KARG(16) + l * 1024;
            const float* w_group = (const float*)KARG(17) + l * 1024 * 4; const float* b_group = (const float*)KARG(18) + l * 4;
            const float* w_er = (const float*)KARG(19) + (size_t)l * 4 * 1024 * 8; const float* b_er = (const float*)KARG(20) + l * 32;
            const float* ln2_g = (const float*)KARG(26) + l * 1024; const float* ln2_b = (const float*)KARG(27) + l * 1024;
            unsigned* cnt = ctl + CW_CNT + l * 2048 + (DUMMY ? 8192 : 0);
            if (DUMMY) rank = (int*)(ws + WS_RT + 512 * 1024);
            if constexpr (sp == 0) {
                pg8::Gemm g{a16, (const bf16*)(ws + WS_WIN), NTOK, ZP, 1024, 1024, 1024};
                pg8::StaticOrder S; S.init(NTOK, ZP, G, (int)blockIdx.x);
                pg8::EpiZ E{z16, ZP, fcbuf};
                pg8::gemm_phase<pg8::EpiZ, pg8::StaticOrder, true, true>((LAS unsigned char*)lds_raw, g, S, E, tid);
                {
                    pg8::Gemm g2{p16 + (size_t)l * NTOK * PLE_DIM, (const bf16*)(ws + WS_WPP), NTOK, 1024, 256, 256, 256};
                    const int bx = (int)blockIdx.x;
                    pg8::StaticOrder S2; S2.init(NTOK, 1024, G / 2, bx >= G / 2 ? bx - G / 2 : 1 << 20);
                    pg8::EpiBf16<0> E2{pp16, 1024, nullptr, 0, 0, 1.f};
                    pg8::gemm_phase<pg8::EpiBf16<0>, pg8::StaticOrder, true, true>((LAS unsigned char*)lds_raw, g2, S2, E2, tid);
                }
            } else if constexpr (sp == 1) {
                const int g16 = lane >> 4, l16 = lane & 15;
                for (int tk = gw * 4 + g16; tk < NTOK; tk += NGW * 4) {
                    const bf16* zr = z16 + (size_t)tk * ZP;
                    const v4u ca = *(const v4u*)(zr + Z_CQ + l16 * 16), cb = *(const v4u*)(zr + Z_CQ + l16 * 16 + 8);
                    const v4u ka = *(const v4u*)(zr + Z_CKV + l16 * 8);
                    const unsigned short kr1 = zr[Z_KR + l16], kr2 = zr[Z_KR + 16 + l16];
                    const float cs = cosT[tk * 16 + l16], sn = sinT[tk * 16 + l16];
                    const float fcv = fcbuf[tk * 4 + (l16 & 3)];
                    float f[8]; float ss = 0.f;
                    unpack8(ca, f);
#pragma unroll
                    for (int i = 0; i < 8; ++i) ss = fmaf(f[i], f[i], ss);
                    unpack8(cb, f);
#pragma unroll
                    for (int i = 0; i < 8; ++i) ss = fmaf(f[i], f[i], ss);
                    float s2 = 0.f;
                    unpack8(ka, f);
#pragma unroll
                    for (int i = 0; i < 8; ++i) s2 = fmaf(f[i], f[i], s2);
#pragma unroll
                    for (int o = 1; o < 16; o <<= 1) { ss += __shfl_xor(ss, o); s2 += __shfl_xor(s2, o); }
                    if (l16 == 0) { rq[tk] = rsqrtf(ss * (1.f / 256.f) + RMS_EPS); rkv[tk] = rsqrtf(s2 * (1.f / 128.f) + RMS_EPS); }
                    const float x1 = __uint_as_float((unsigned)kr1 << 16), x2 = __uint_as_float((unsigned)kr2 << 16);
                    krr16[tk * 32 + l16] = (bf16)f2bf(x1 * cs - x2 * sn); krr16[tk * 32 + 16 + l16] = (bf16)f2bf(x2 * cs + x1 * sn);
                    if (l16 < 4) {
                        const float xf = fcv + b_forget[l16];
                        logf[tk * 4 + l16] = fminf(xf, 0.f) - log1pf(expf(-fabsf(xf)));
                    }
                }
            } else if constexpr (sp == 2) {
                {
                    pg8::Gemm g{z16 + Z_CQ, (const bf16*)(ws + WS_WUQ), NTOK, NQBP, 256, ZP, 256};
                    pg8::StaticOrder S; S.init(NTOK, NQBP, G, (int)blockIdx.x);
                    pg8::EpiRowScale E{qb16, NQBP, rq};
                    pg8::gemm_phase<pg8::EpiRowScale, pg8::StaticOrder, true, true>((LAS unsigned char*)lds_raw, g, S, E, tid);
                }
                {
                    pg8::Gemm g{z16 + Z_CKV, (const bf16*)(ws + WS_WUKV), NTOK, NKVB, 128, ZP, 128};
                    pg8::StaticOrder S; S.init(NTOK, NKVB, G, (int)((blockIdx.x + 128) % G));
                    pg8::EpiRowScale E{kvb16, NKVB, rkv};
                    pg8::gemm_phase<pg8::EpiRowScale, pg8::StaticOrder, true, true>((LAS unsigned char*)lds_raw, g, S, E, tid);
                }
                const int cw = NGW - 1 - gw;
                if (cw < 32) {
                    const int b = cw >> 2, hh = cw & 3;
                    float* cp = cum + ((size_t)b * SEQ) * 4 + hh; const float* lp = logf + ((size_t)b * SEQ) * 4 + hh;
                    float loc[32]; float run = 0.f;
#pragma unroll
                    for (int i = 0; i < 32; ++i) { run += lp[(size_t)(lane * 32 + i) * 4]; loc[i] = run; }
                    float pre = run;
#pragma unroll
                    for (int o = 1; o < 64; o <<= 1) { const float n = __shfl_up(pre, o); if (lane >= o) pre += n; }
                    pre -= run;
#pragma unroll
                    for (int i = 0; i < 32; ++i) cp[(size_t)(lane * 32 + i) * 4] = loc[i] + pre;
                }
            } else if constexpr (sp == 3) {
                float lam_init_, lam_;
                {
                    const float* lq1 = (const float*)KARG(8) + l * 32; const float* lk1 = (const float*)KARG(9) + l * 32; const float* lq2 = (const float*)KARG(10) + l * 32; const float* lk2 = (const float*)KARG(11) + l * 32;
                    lam_init_ = 0.8f - 0.6f * expf(-0.3f * (float)l);
                    float s1 = 0.f, s2 = 0.f;
                    for (int i = 0; i < 32; ++i) { s1 += lq1[i] * lk1[i]; s2 += lq2[i] * lk2[i]; }
                    lam_ = expf(s1) - expf(s2) + lam_init_;
                }
                AttnP p{z16, qb16, kvb16, krr16, cum, cosT, sinT, pos, mixed16,
                        (const float*)KARG(8) + l * 32, (const float*)KARG(9) + l * 32, (const float*)KARG(10) + l * 32, (const float*)KARG(11) + l * 32,
                        (const float*)KARG(12) + l * 64, l, ctl + 14000, (const int*)(ws + WS_RT + RT_TPMAX), lam_, lam_init_};
                volatile LAS int* qslot = (volatile LAS int*)((LAS unsigned char*)lds_raw + LDS_MISC) + 48;
                unsigned* qctr = ctl + 12288 + l * 64 + (DUMMY ? 32 : 0);
                int idx = (int)blockIdx.x;
                for (;;) {
                    if (idx >= 1408) break;
                    int nxt_idx = 0;
                    if (wave_s == 0 && lane_id_now() == 0) nxt_idx = G + (int)atomicAdd(qctr, 1u);
                    const int pi = idx / 176, r = idx % 176, thi = 32 - 4 * pi;
                    if (r < 48) attn_unit<0>(p, r / 6, r % 6, thi / 2 - 1, (LAS unsigned char*)lds_raw, wave_s);
                    else if (r < 96) attn_unit<1>(p, (r - 48) / 6, (r - 48) % 6, thi / 4 - 1, (LAS unsigned char*)lds_raw, wave_s);
                    else if (r < 128) attn_unit<2>(p, (r - 96) / 4, (r - 96) % 4, thi / 4 - 1, (LAS unsigned char*)lds_raw, wave_s);
                    else attn_unit<0>(p, (r - 128) / 6, (r - 128) % 6, (thi - 2) / 2 - 1, (LAS unsigned char*)lds_raw, wave_s);
                    __syncthreads();
                    if (wave_s == 0 && lane_id_now() == 0) *qslot = nxt_idx;
                    __syncthreads();
                    idx = __builtin_amdgcn_readfirstlane(*qslot);
                }
            } else if constexpr (sp == 4) {
                pg8::Gemm g{mixed16, (const bf16*)(ws + WS_WOUT), NTOK, 1024, 1024, 1024, 1024};
                pg8::StaticOrder S; S.init(NTOK, 1024, G, (int)blockIdx.x);
                pg8::EpiBf16<0> E{mix16, 1024, nullptr, 0, 0, 1.f};
                pg8::gemm_phase<pg8::EpiBf16<0>, pg8::StaticOrder, true, true>((LAS unsigned char*)lds_raw, g, S, E, tid);
            } else if constexpr (sp == 5) {
#ifdef PROF_LN1
                if (l == 0 && blockIdx.x == 0 && tid == 0) ctl[14000 + 19] = (unsigned)(__builtin_amdgcn_s_memrealtime() & 0xffffffffu);
#endif
                LAS f32x4_t* Lg = (LAS f32x4_t*)lds_raw; LAS f32x4_t* Le = Lg + 1024;
                LAS unsigned* lcnt = (LAS unsigned*)((LAS unsigned char*)lds_raw + LDS_MISC) + 16;
                __syncthreads();
                if (tid < 32) lcnt[tid] = 0u;
                for (int k = tid; k < 1024; k += NTHREADS) { const int j = k >> 8, ln = (k & 255) >> 2, i = k & 3; Lg[(j * 4 + i) * 64 + ln] = *(const f32x4_t*)(w_group + (size_t)k * 4); }
                for (int q = tid; q < 4 * 1024 * 2; q += NTHREADS) { const int g = q >> 11, k = (q >> 1) & 1023, half = q & 1; const int j = k >> 8, ln = (k & 255) >> 2, i = k & 3;
                    Le[((g * 16 + j * 4 + i) * 2 + half) * 64 + ln] = *(const f32x4_t*)(w_er + (size_t)q * 4); }
                __syncthreads();
#ifdef PROF_LN1
                if (l == 0 && blockIdx.x == 0 && tid == 0) ctl[14000 + 20] = (unsigned)(__builtin_amdgcn_s_memrealtime() & 0xffffffffu);
#endif
                float4 xvA[4], xvB[4]; v2u mwA[4], mwB[4];
                auto ld_x = [&](int tk, int j) -> float4 {
                    if (l == 0) return *(const float4*)(x0 + (size_t)tk * D_MODEL + j * 256 + lane * 4);
                    const v2u xw = *(const v2u*)(a16 + (size_t)tk * D_MODEL + j * 256 + lane * 4);
                    return make_float4(bflo(xw.x), bfhi(xw.x), bflo(xw.y), bfhi(xw.y));
                };
                auto ld_tok = [&](int tk, float4 (&xv)[4], v2u (&mw)[4]) {
                    if (tk < NTOK) {
#pragma unroll
                        for (int j = 0; j < 4; ++j) { xv[j] = ld_x(tk, j); mw[j] = *(const v2u*)(mix16 + (size_t)tk * D_MODEL + j * 256 + lane * 4); }
                    }
                };
                auto do_tok = [&](int tk, float4 (&xv)[4], v2u (&mw)[4]) {
                    float4 v[4]; float s = 0.f;
#pragma unroll
                    for (int j = 0; j < 4; ++j) {
                        v[j] = make_float4(ALPHA * xv[j].x + bflo(mw[j].x), ALPHA * xv[j].y + bfhi(mw[j].x), ALPHA * xv[j].z + bflo(mw[j].y), ALPHA * xv[j].w + bfhi(mw[j].y));
                        s += (v[j].x + v[j].y) + (v[j].z + v[j].w);
                    }
                    ld_tok(tk + 2 * NGW, xv, mw);
                    const float mean = wave_sum(s) * (1.f / 1024.f); float s2 = 0.f;
#pragma unroll
                    for (int j = 0; j < 4; ++j) { v[j].x -= mean; v[j].y -= mean; v[j].z -= mean; v[j].w -= mean; s2 += (v[j].x * v[j].x + v[j].y * v[j].y) + (v[j].z * v[j].z + v[j].w * v[j].w); }
                    const float rstd = rsqrtf(wave_sum(s2) * (1.f / 1024.f) + LN_EPS);
                    float gl[4] = {0.f, 0.f, 0.f, 0.f};
#pragma unroll
                    for (int j = 0; j < 4; ++j) {
                        const int d0 = j * 256 + lane * 4;
                        const float4 gg = *(const float4*)(ln1_g + d0), bb = *(const float4*)(ln1_b + d0);
                        v[j] = make_float4(v[j].x * rstd * gg.x + bb.x, v[j].y * rstd * gg.y + bb.y, v[j].z * rstd * gg.z + bb.z, v[j].w * rstd * gg.w + bb.w);
                        { v2u hb; hb.x = pk2(v[j].x, v[j].y); hb.y = pk2(v[j].z, v[j].w); *(v2u*)(a16 + (size_t)tk * D_MODEL + d0) = hb; }
                        const float hv[4] = {v[j].x, v[j].y, v[j].z, v[j].w};
#pragma unroll
                        for (int i = 0; i < 4; ++i) {
                            const f32x4_t wg = Lg[(j * 4 + i) * 64 + lane];
                            gl[0] = fmaf(hv[i], wg.x, gl[0]); gl[1] = fmaf(hv[i], wg.y, gl[1]); gl[2] = fmaf(hv[i], wg.z, gl[2]); gl[3] = fmaf(hv[i], wg.w, gl[3]);
                        }
                    }
#pragma unroll
                    for (int i = 0; i < 4; ++i) gl[i] = wave_sum(gl[i]) + b_group[i];
                    int gi = 0; float gm = gl[0];
#pragma unroll
                    for (int i = 1; i < 4; ++i) if (gl[i] > gm) { gm = gl[i]; gi = i; }
                    gi = __builtin_amdgcn_readfirstlane(gi);
                    float gden = 0.f;
#pragma unroll
                    for (int i = 0; i < 4; ++i) gden += __expf(gl[i] - gm);
                    const float gwt = 1.f / gden;
                    float el[8] = {0.f, 0.f, 0.f, 0.f, 0.f, 0.f, 0.f, 0.f};
                    const LAS f32x4_t* we = Le + gi * 2048;
#pragma unroll
                    for (int j = 0; j < 4; ++j) {
                        const float hv[4] = {v[j].x, v[j].y, v[j].z, v[j].w};
#pragma unroll
                        for (int i = 0; i < 4; ++i) {
                            const f32x4_t w0 = we[((j * 4 + i) * 2) * 64 + lane], w1 = we[((j * 4 + i) * 2 + 1) * 64 + lane];
                            el[0] = fmaf(hv[i], w0.x, el[0]); el[1] = fmaf(hv[i], w0.y, el[1]); el[2] = fmaf(hv[i], w0.z, el[2]); el[3] = fmaf(hv[i], w0.w, el[3]);
                            el[4] = fmaf(hv[i], w1.x, el[4]); el[5] = fmaf(hv[i], w1.y, el[5]); el[6] = fmaf(hv[i], w1.z, el[6]); el[7] = fmaf(hv[i], w1.w, el[7]);
                        }
                    }
#pragma unroll
                    for (int i = 0; i < 8; ++i) el[i] = wave_sum(el[i]) + b_er[gi * 8 + i];
                    int i0 = 0; float v0 = el[0];
#pragma unroll
                    for (int i = 1; i < 8; ++i) if (el[i] > v0) { v0 = el[i]; i0 = i; }
                    int i1 = -1; float v1 = -INFINITY;
#pragma unroll
                    for (int i = 0; i < 8; ++i) if (i != i0 && el[i] > v1) { v1 = el[i]; i1 = i; }
                    const float e1 = __expf(v1 - v0);
                    const float w0 = gwt / (1.f + e1), w1 = gwt * e1 / (1.f + e1);
                    if (lane == 0) {
                        const int ea = gi * 8 + i0, eb = gi * 8 + i1;
                        ids[tk * 2] = ea; ids[tk * 2 + 1] = eb; wts[tk * 2] = w0; wts[tk * 2 + 1] = w1;
                        rank[tk * 2] = (int)__hip_atomic_fetch_add(lcnt + ea, 1u, __ATOMIC_RELAXED, __HIP_MEMORY_SCOPE_WORKGROUP);
                        rank[tk * 2 + 1] = (int)__hip_atomic_fetch_add(lcnt + eb, 1u, __ATOMIC_RELAXED, __HIP_MEMORY_SCOPE_WORKGROUP);
                    }
                };
                ld_tok(gw, xvA, mwA); ld_tok(gw + NGW, xvB, mwB);
                for (int tk = gw; tk < NTOK; tk += 2 * NGW) {
                    do_tok(tk, xvA, mwA);
                    if (tk + NGW < NTOK) do_tok(tk + NGW, xvB, mwB);
                }
#ifdef PROF_LN1
                if (l == 0 && blockIdx.x == 0 && tid == 0) ctl[14000 + 21] = (unsigned)(__builtin_amdgcn_s_memrealtime() & 0xffffffffu);
#endif
                __syncthreads();
                if (tid < 32) { const unsigned n = lcnt[tid]; lcnt[tid] = n ? atomicAdd(cnt + tid * 64, n) : 0u; }
                __syncthreads();
                if (lane == 0) for (int tk = gw; tk < NTOK; tk += NGW) { rank[tk * 2] += (int)lcnt[ids[tk * 2]]; rank[tk * 2 + 1] += (int)lcnt[ids[tk * 2 + 1]]; }
                __syncthreads();
            } else if constexpr (sp == 6) {
                int* offs = (int*)sm;
                __syncthreads();
                if (tid == 0) { int o = 0; for (int e = 0; e < 32; ++e) { offs[e] = o; o += ((int)cnt[e * 64] + 255) & ~255; } offs[32] = o; }
                __syncthreads();
                for (int i = gtid; i < NSLOT_TILES; i += NGT) { int e = -1; for (int k = 0; k < 32; ++k) if (i * 256 >= offs[k] && i * 256 < offs[k + 1]) e = k; tile_e[i] = e; }
                for (int i0 = gw * 4; i0 < NTOK * 2; i0 += NGW * 4) {
                    int sl[4]; v4u r0[4], r1[4];
#pragma unroll
                    for (int u = 0; u < 4; ++u) { const int i = i0 + u; sl[u] = offs[ids[i]] + rank[i]; }
#pragma unroll
                    for (int u = 0; u < 4; ++u) { const v4u* srow = (const v4u*)(a16 + (size_t)((i0 + u) >> 1) * D_MODEL); r0[u] = srow[lane]; r1[u] = srow[64 + lane]; }
                    if (lane < 4) slot_of[i0 + lane] = lane == 0 ? sl[0] : (lane == 1 ? sl[1] : (lane == 2 ? sl[2] : sl[3]));
#pragma unroll
                    for (int u = 0; u < 4; ++u) { v4u* drow = (v4u*)(hs16 + (size_t)sl[u] * D_MODEL); drow[lane] = r0[u]; drow[64 + lane] = r1[u]; }
                }
                __syncthreads();
            } else if constexpr (sp == 7) {
                int T = 0; for (int e = 0; e < 32; ++e) T += ((int)cnt[e * 64] + 255) >> 8;
                T = __builtin_amdgcn_readfirstlane(T);
                const int vc = (int)((blockIdx.x % 8) * (G / 8) + blockIdx.x / 8);
                int nB2 = 2 * T - G; nB2 = nB2 < 0 ? 0 : nB2;
                {
                    pg8::Gemm g{hs16, (const bf16*)(ws + WS_WGU), MAX_SLOTS, 32 * 512, 1024, 1024, 1024};
                    pg8::GroupSched S{tile_e, T, 2, G, vc};
                    pg8::EpiGU E{act16};
                    pg8::gemm_phase<pg8::EpiGU, pg8::GroupSched, true, true>((LAS unsigned char*)lds_raw, g, S, E, tid);
                }
                if (vc >= nB2) {
                    const int k = vc - nB2;
                    pg8::Gemm g{a16, (const bf16*)(ws + WS_WPG), NTOK, 1024, 1024, 1024, 1024};
                    pg8::OneUnit S{k >> 2, k & 3};
                    pg8::EpiPleGate E{ple16, pp16};
                    pg8::gemm_phase<pg8::EpiPleGate, pg8::OneUnit, true, true>((LAS unsigned char*)lds_raw, g, S, E, tid);
                }
            } else if constexpr (sp == 8) {
                int T = 0; for (int e = 0; e < 32; ++e) T += ((int)cnt[e * 64] + 255) >> 8;
                T = __builtin_amdgcn_readfirstlane(T);
                const int vc = (int)((blockIdx.x % 8) * (G / 8) + blockIdx.x / 8);
                int nB2 = 2 * T - G; nB2 = nB2 < 0 ? 0 : nB2;
                if (vc >= nB2) {
                    pg8::Gemm g{act16, (const bf16*)(ws + WS_WD), MAX_SLOTS, 32 * 1024, 256, 256, 256};
                    pg8::GroupSched S{tile_e, T, 4, G - nB2, vc - nB2};
                    pg8::EpiDown E{outs16};
                    pg8::gemm_phase<pg8::EpiDown, pg8::GroupSched, true, true>((LAS unsigned char*)lds_raw, g, S, E, tid);
                } else {
                    const int k = 256 - nB2 + vc;
                    pg8::Gemm g{a16, (const bf16*)(ws + WS_WPG), NTOK, 1024, 1024, 1024, 1024};
                    pg8::OneUnit S{k >> 2, k & 3};
                    pg8::EpiPleGate E{ple16, pp16};
                    pg8::gemm_phase<pg8::EpiPleGate, pg8::OneUnit, true, true>((LAS unsigned char*)lds_raw, g, S, E, tid);
                }
            } else if constexpr (sp == 9) {
                struct Ln2Regs { v2u hv[4], oa[4], ob[4], pv[4]; float w0, w1; };
                Ln2Regs RA, RB;
                auto ld_rows = [&](int tk, Ln2Regs& R) {
                    if (tk < NTOK) {
                        const int s0 = slot_of[tk * 2], s1 = slot_of[tk * 2 + 1]; R.w0 = wts[tk * 2]; R.w1 = wts[tk * 2 + 1];
#pragma unroll
                        for (int j = 0; j < 4; ++j) {
                            const int d0 = j * 256 + lane * 4;
                            R.hv[j] = *(const v2u*)(a16 + (size_t)tk * D_MODEL + d0);
                            R.oa[j] = *(const v2u*)(outs16 + (size_t)s0 * D_MODEL + d0); R.ob[j] = *(const v2u*)(outs16 + (size_t)s1 * D_MODEL + d0);
                            R.pv[j] = *(const v2u*)(ple16 + (size_t)tk * D_MODEL + d0);
                        }
                    }
                };
                auto do_row = [&](int tk, Ln2Regs& R) {
                    float4 v[4]; float s = 0.f; const float w0 = R.w0, w1 = R.w1;
#pragma unroll
                    for (int j = 0; j < 4; ++j) {
                        v[j] = make_float4(ALPHA * bflo(R.hv[j].x) + w0 * bflo(R.oa[j].x) + w1 * bflo(R.ob[j].x) + bflo(R.pv[j].x), ALPHA * bfhi(R.hv[j].x) + w0 * bfhi(R.oa[j].x) + w1 * bfhi(R.ob[j].x) + bfhi(R.pv[j].x),
                                           ALPHA * bflo(R.hv[j].y) + w0 * bflo(R.oa[j].y) + w1 * bflo(R.ob[j].y) + bflo(R.pv[j].y), ALPHA * bfhi(R.hv[j].y) + w0 * bfhi(R.oa[j].y) + w1 * bfhi(R.ob[j].y) + bfhi(R.pv[j].y));
                        s += (v[j].x + v[j].y) + (v[j].z + v[j].w);
                    }
                    ld_rows(tk + 2 * NGW, R);
                    const float mean = wave_sum(s) * (1.f / 1024.f); float s2 = 0.f;
#pragma unroll
                    for (int j = 0; j < 4; ++j) { v[j].x -= mean; v[j].y -= mean; v[j].z -= mean; v[j].w -= mean; s2 += (v[j].x * v[j].x + v[j].y * v[j].y) + (v[j].z * v[j].z + v[j].w * v[j].w); }
                    const float rstd = rsqrtf(wave_sum(s2) * (1.f / 1024.f) + LN_EPS);
#pragma unroll
                    for (int j = 0; j < 4; ++j) {
                        const int d0 = j * 256 + lane * 4;
                        const float4 gg = *(const float4*)(ln2_g + d0), bb = *(const float4*)(ln2_b + d0);
                        const float4 o = make_float4(v[j].x * rstd * gg.x + bb.x, v[j].y * rstd * gg.y + bb.y, v[j].z * rstd * gg.z + bb.z, v[j].w * rstd * gg.w + bb.w);
                        if (!DUMMY || w0 == 12345.678f) {
                        if (l == DEPTH - 1) {
#ifdef PROF_SEL
#ifdef PROF_LN1
                        float4 oo = o; { const float dlt = sqrtf((float)(ctl[14000 + PROF_LN1 + 1] - ctl[14000 + PROF_LN1]) * 1e-8f);
#else
                        float4 oo = o; { const float dlt = sqrtf((float)ctl[14000 + PROF_SEL] * 1e-8f);
#endif
                        oo.x += dlt; oo.y += dlt; oo.z += dlt; oo.w += dlt; }
                        *(float4*)(KOUT + (size_t)tk * D_MODEL + d0) = oo;
#else
                        *(float4*)(KOUT + (size_t)tk * D_MODEL + d0) = o;
#endif
                        } else {
                        v2u ob16; ob16.x = pk2(o.x, o.y); ob16.y = pk2(o.z, o.w);
                        *(v2u*)(a16 + (size_t)tk * D_MODEL + d0) = ob16;
                        }
                        }
                    }
                };
                ld_rows(gw, RA); ld_rows(gw + NGW, RB);
                for (int tk = gw; tk < NTOK; tk += 2 * NGW) {
                    do_row(tk, RA);
                    if (tk + NGW < NTOK) do_row(tk + NGW, RB);
                }
                if (l + 1 < DEPTH) convert_layer_weights(a, l + 1, ws, scr, gw, NGW, lane);
            }
        }
}

constexpr int CW_BAR = 4096;
__global__ void __launch_bounds__(NTHREADS, 2) mega(Args a) {
    extern __shared__ __attribute__((aligned(16))) unsigned char lds_raw[];
    cg::grid_group grid = cg::this_grid();
    volatile LAS unsigned* misc = (volatile LAS unsigned*)((LAS unsigned char*)lds_raw + LDS_MISC);
    if (threadIdx.x < 16) misc[threadIdx.x] = 0u;
    __syncthreads();
    XcdBarrier bar = xcd_barrier_post((unsigned*)(a.ws + WS_CTL) + CW_BAR, misc + 8);
    const int wave_s = __builtin_amdgcn_readfirstlane(threadIdx.x >> 6);
#define IS_T0 (wave_s == 0 && lane_id_now() == 0)
#ifndef DUP_SP
#define DUP_SP -1
#endif
#ifndef DUP_X
#define DUP_X 0
#endif
    if (a.ph_hi < 0) grid.sync();
#define SEAM(ph) do { xcd_barrier(bar, IS_T0); } while (0)
#ifdef PROF_PH
    unsigned long long ph_t_prev = __builtin_amdgcn_s_memrealtime();
#define PHASE_STAMP(ph) do { const unsigned long long t_ = __builtin_amdgcn_s_memrealtime(); if ((ph) == PROF_PH && blockIdx.x == 0 && IS_T0) ((unsigned*)(a.ws + WS_CTL))[14000 + PROF_SEL] = (unsigned)(t_ - ph_t_prev); ph_t_prev = t_; } while (0)
#else
#define PHASE_STAMP(ph) do {} while (0)
#endif
#define RUN(ph) if (a.ph_lo <= (ph) && (ph) < a.ph_hi) { \
        if (DUP_X == 9 && (ph) > 0 && ((ph) - 1) % PH_PER_LAYER == 9) { run_phase<ph, true>(a, lds_raw, wave_s); xcd_barrier(bar, IS_T0); } \
        run_phase<ph>(a, lds_raw, wave_s); \
        if ((ph) > 0 && ((ph) - 1) % PH_PER_LAYER == DUP_SP) { xcd_barrier(bar, IS_T0); run_phase<ph>(a, lds_raw, wave_s); } \
        if (DUP_X == 100 && (ph) == 0) { xcd_barrier(bar, IS_T0); run_phase<ph>(a, lds_raw, wave_s); } \
        if (DUP_X == 5 && (ph) == 6) { xcd_barrier(bar, IS_T0); run_phase<ph, true>(a, lds_raw, wave_s); } \
        if (DUP_X == 3 && (ph) > 0 && ((ph) - 1) % PH_PER_LAYER == 3) { xcd_barrier(bar, IS_T0); run_phase<ph, true>(a, lds_raw, wave_s); } \
        if ((ph) + 1 < a.ph_hi && (ph) + 1 < NPH) SEAM(ph); PHASE_STAMP(ph); }
    RUN(0) RUN(1) RUN(2) RUN(3) RUN(4) RUN(5) RUN(6) RUN(7) RUN(8) RUN(9) RUN(10)
    RUN(11) RUN(12) RUN(13) RUN(14) RUN(15) RUN(16) RUN(17) RUN(18) RUN(19) RUN(20)
#undef RUN
#undef SEAM
}

extern "C" void kernel_launch(void* const* d_in, const int* in_sizes, int n_in, void* d_out, int out_size, void* d_ws, size_t ws_size, hipStream_t stream) {
    static int grid = 0;
    if (grid == 0) {
        if (n_in != 28 || ws_size < WS_END) { fprintf(stderr, "kernel_launch: unexpected n_in %d or ws_size %zu (< %zu)\n", n_in, ws_size, (size_t)WS_END); grid = -1; return; }
        int dev = 0, cus = 0, per_cu = 0;
        (void)hipGetDevice(&dev);
        (void)hipDeviceGetAttribute(&cus, hipDeviceAttributeMultiprocessorCount, dev);
        (void)hipFuncSetAttribute((const void*)mega, hipFuncAttributeMaxDynamicSharedMemorySize, LDS_BYTES);
        (void)hipOccupancyMaxActiveBlocksPerMultiprocessor(&per_cu, (const void*)mega, NTHREADS, LDS_BYTES);
        if (per_cu < 1) { fprintf(stderr, "kernel_launch: occupancy query says %d blocks/CU\n", per_cu); }
        (void)hipGetLastError();
        grid = cus;
    }
    if (grid < 0) return;
    (void)hipMemsetAsync((char*)d_ws + WS_CTL, 0, 64 * 1024, stream);
    Args a{};
    for (int i = 0; i < 28; ++i) a.in[i] = d_in[i];
    a.out = (float*)d_out; a.ws = (unsigned char*)d_ws; a.ph_lo = 0; a.ph_hi = NPH;
    void* params[] = {&a};
    hipError_t e = hipLaunchCooperativeKernel((const void*)mega, dim3(grid), dim3(NTHREADS), params, LDS_BYTES, stream);
    if (e != hipSuccess) fprintf(stderr, "cooperative launch failed: %s (grid %d)\n", hipGetErrorString(e), grid);
}
```

```cpp
#include <hip/hip_runtime.h>
#include <hip/hip_cooperative_groups.h>
#include <cstdio>
#include <cstdint>
namespace cg = cooperative_groups;

constexpr int D_MODEL = 1024, BATCH = 8, SEQ = 2048, NTOK = BATCH * SEQ, DEPTH = 2;
constexpr int D_IN = 2340;
constexpr int OFF_QA = 0, OFF_KA = 384, OFF_VA = 768, OFF_CQ = 1152, OFF_CKV = 1408, OFF_KR = 1536,
              OFF_QC = 1568, OFF_KC = 1824, OFF_VC = 2080, OFF_FC = 2336;
constexpr int ZP = 2560;
constexpr int Z_QA = 0, Z_KA = 384, Z_VA = 768, Z_QC = 1152, Z_KC = 1408, Z_VC = 1664, Z_CKV = 1920, Z_CQ = 2048, Z_KR = 2304, Z_FC = 2336;
constexpr int NQB = 576, NKVB = 768, NQBP = 768;
constexpr int N_EXPERTS = 32, D_EXPERT = 256, PLE_DIM = 256;
constexpr int MAX_SLOTS = 32768 + 32 * 256;
constexpr int NSLOT_TILES = MAX_SLOTS / 256;
constexpr float ALPHA = 1.4142135623730951f;
constexpr float LN_EPS = 1e-5f, RMS_EPS = 1e-6f;
constexpr int NTHREADS = 512;
constexpr int LDS_BYTES = 147456 + 256;

constexpr size_t MiB = 1u << 20;
constexpr size_t WS_CTL = 0;
constexpr size_t WS_COS = 1 * MiB, WS_SIN = 2 * MiB;
constexpr size_t WS_WIN = 3 * MiB;
constexpr size_t WS_WUQ = 8 * MiB;
constexpr size_t WS_WUKV = WS_WUQ + 393216;
constexpr size_t WS_WOUT = 9 * MiB;
constexpr size_t WS_WPG = 11 * MiB;
constexpr size_t WS_WPP = 13 * MiB;
constexpr size_t WS_WGU = 14 * MiB;
constexpr size_t WS_WD = 46 * MiB;
constexpr size_t WS_A16 = 62 * MiB;
constexpr size_t WS_P16 = 94 * MiB;
constexpr size_t WS_Z16 = 110 * MiB;
constexpr size_t WS_HS16 = WS_Z16;
constexpr size_t WS_OUTS16 = WS_Z16;
constexpr size_t WS_QB16 = 190 * MiB;
constexpr size_t WS_KVB16 = 214 * MiB;
constexpr size_t WS_KRR16 = 238 * MiB;
constexpr size_t WS_FC = 239 * MiB;
constexpr size_t WS_CUM = WS_FC + 256 * 1024;
constexpr size_t WS_LOGF = WS_CUM + 256 * 1024;
constexpr size_t WS_RQ = WS_LOGF + 256 * 1024;
constexpr size_t WS_RKV = WS_RQ + 64 * 1024;
constexpr size_t WS_MIX16 = 190 * MiB;
constexpr size_t WS_PP16 = 276 * MiB;
constexpr size_t WS_ACT16 = 222 * MiB;
constexpr size_t WS_MIXED16 = 242 * MiB;
constexpr size_t WS_PLE16 = 242 * MiB;
constexpr size_t WS_RT = 274 * MiB;
constexpr size_t WS_END = 308 * MiB;
constexpr size_t RT_IDS = 0, RT_WTS = 128 * 1024, RT_RANK = 256 * 1024, RT_SLOTOF = 384 * 1024, RT_TILEE = 768 * 1024, RT_TPMAX = 800 * 1024;
constexpr int CW_CNT = 0;
static_assert((WS_A16 - WS_HS16) % (256 * 1024 * 2) == 0 || true, "");

struct Args { const void* in[28]; float* out; unsigned char* ws; int ph_lo, ph_hi; };

#define LAS __attribute__((address_space(3)))
typedef unsigned short bf16;
typedef unsigned v4u __attribute__((ext_vector_type(4)));
typedef unsigned v2u __attribute__((ext_vector_type(2)));
typedef float f32x4_t __attribute__((ext_vector_type(4)));

__device__ __forceinline__ float wave_sum(float v) {
#define WS_DPP(ctrl, rmask) __builtin_bit_cast(float, __builtin_amdgcn_update_dpp(0, __builtin_bit_cast(int, v), (ctrl), (rmask), 0xf, true))
    v += WS_DPP(0x111, 0xf);
    v += WS_DPP(0x112, 0xf);
    v += WS_DPP(0x114, 0xf);
    v += WS_DPP(0x118, 0xf);
    v += WS_DPP(0x142, 0xa);
    v += WS_DPP(0x143, 0xc);
#undef WS_DPP
    return __builtin_bit_cast(float, __builtin_amdgcn_readlane(__builtin_bit_cast(int, v), 63));
}
__device__ __forceinline__ unsigned f2bf(float f) { unsigned u = __builtin_bit_cast(unsigned, f); return (u + 0x7fffu + ((u >> 16) & 1u)) >> 16; }
__device__ __forceinline__ unsigned pk2(float lo, float hi) { return f2bf(lo) | (f2bf(hi) << 16); }
__device__ __forceinline__ float bflo(unsigned w) { return __uint_as_float(w << 16); }
__device__ __forceinline__ float bfhi(unsigned w) { return __uint_as_float(w & 0xffff0000u); }
__device__ __forceinline__ void unpack8(const v4u w, float* f) { f[0] = bflo(w.x); f[1] = bfhi(w.x); f[2] = bflo(w.y); f[3] = bfhi(w.y); f[4] = bflo(w.z); f[5] = bfhi(w.z); f[6] = bflo(w.w); f[7] = bfhi(w.w); }
__device__ __forceinline__ int lane_id_now() { int l; asm volatile("v_mbcnt_lo_u32_b32 %0, -1, 0\n\tv_mbcnt_hi_u32_b32 %0, -1, %0" : "=v"(l)); return l; }
namespace pg8 {
#define PG8_LAS __attribute__((address_space(3)))
typedef unsigned short bf16_t;
typedef short bf16x8 __attribute__((ext_vector_type(8)));
typedef float f32x4 __attribute__((ext_vector_type(4)));
typedef unsigned u32x4 __attribute__((ext_vector_type(4)));
constexpr int BM = 256, BK = 64, HALF = 128, HTB = HALF * BK * 2  , STAGE_BYTES = 8 * HTB, NXCD = 8, WGM = 8;

__host__ __device__ __forceinline__ int lds_byte(int r, int c) { const int st = (r >> 4) * 2 + (c >> 5), rr = r & 15, cc = c & 31, ob = rr * 64 + cc * 2; return st * 1024 + (ob ^ (((ob >> 9) & 1) << 5)); }
__host__ __device__ __forceinline__ void stage_rc(int b, int& R, int& C) { const int st = b / 1024, sb = b % 1024, swz = sb ^ (((sb >> 9) & 1) << 5); R = (st >> 1) * 16 + swz / 64; C = (st & 1) * 32 + (swz % 64) / 2; }
__host__ __device__ __forceinline__ int perm32(int rho) { const int n = rho >> 4, i = rho & 15; return 8 * (i >> 2) + 4 * n + (i & 3); }

struct Unit { int pm, pn; };
struct Gemm { const bf16_t* A; const bf16_t* Bt; int M, N, K, lda, ldb; };

struct StaticOrder {
    int nM, nN, nwg, G, c;
    __host__ __device__ void init(int M, int N, int G_, int c_) { nM = M / BM; nN = N / BM; nwg = nM * nN; G = G_; c = c_; }
    __host__ __device__ bool next(int i, Unit& u) const {
        const long L = (long)i * G + c; if (L >= nwg) return false;
        int wgid = (int)L; { const int q = nwg / NXCD, r = nwg % NXCD, xcd = wgid % NXCD, off = wgid / NXCD; wgid = (xcd < r ? xcd * (q + 1) : r * (q + 1) + (xcd - r) * q) + off; }
        const int nig = WGM * nN, gid = wgid / nig, fm = gid * WGM, gsz = (nM - fm) < WGM ? (nM - fm) : WGM;
        u.pm = fm + ((wgid % nig) % gsz); u.pn = (wgid % nig) / gsz; return true;
    }
    __device__ __forceinline__ void a_ready(const Unit&) const {}
    __device__ __forceinline__ void done(const Unit&) const {}
};

__device__ __forceinline__ unsigned cvt_pk_bf16(float lo, float hi) { unsigned r; asm volatile("v_cvt_pk_bf16_f32 %0, %1, %2" : "=v"(r) : "v"(lo), "v"(hi)); return r; }
typedef float f32x2 __attribute__((ext_vector_type(2)));
__device__ __forceinline__ f32x2 gelu_pk(f32x2 v) {
    const f32x2 av = __builtin_elementwise_abs(v), d = av * 0.2316418882f + 1.0f;
    f32x2 t; t.x = __builtin_amdgcn_rcpf(d.x); t.y = __builtin_amdgcn_rcpf(d.y);
    f32x2 q = t * 0.5307027145f + (-0.7265760135f); q = q * t + 0.7107068705f; q = q * t + (-0.142248368f); q = q * t + 0.127414796f; q = q * t;
    const f32x2 s = (v * v) * (-0.72134752044f);
    f32x2 e; e.x = __builtin_amdgcn_exp2f(s.x); e.y = __builtin_amdgcn_exp2f(s.y);
    const f32x2 m = v * (q * e), r = v - m;
    f32x2 o; o.x = v.x < 0.f ? m.x : r.x; o.y = v.y < 0.f ? m.y : r.y; return o;
}

template <int ACT  > struct EpiBf16 {
    static constexpr bool PERM = true, AFTER_DRAIN = false; static_assert(ACT == 0 || ACT == 1, "EpiBf16: ACT is 0 (none) or 1 (gelu_pk)");
    bf16_t* O; int ldc; const float* bias; int split_cols; size_t split_stride; float scale0;
    __device__ __forceinline__ void operator()(const f32x4 (&acc)[2][2][4][2], const Unit& u, int wr, int wc, int fr, int fq) const {
        const int row0 = u.pm * BM + wr * 64 + fr; int colt = u.pn * BM; bf16_t* base = O;
        float sc = 1.f; if (split_cols) { const int t = colt / split_cols; base += (size_t)t * split_stride; colt -= t * split_cols; if (t == 0) sc = scale0; }
        const int col0 = colt + wc * 32 + 8 * fq, bcol0 = u.pn * BM + wc * 32 + 8 * fq;
        f32x4 bv[2][2];
#pragma unroll
        for (int bj = 0; bj < 2; ++bj)
#pragma unroll
            for (int n = 0; n < 2; ++n) bv[bj][n] = bias ? *(const f32x4*)(bias + bcol0 + bj * HALF + 4 * n) : (f32x4){0.f, 0.f, 0.f, 0.f};
#pragma unroll
        for (int ai = 0; ai < 2; ++ai)
#pragma unroll
            for (int m = 0; m < 4; ++m) { bf16_t* rowp = base + (size_t)(row0 + ai * HALF + m * 16) * ldc + col0;
#pragma unroll
                for (int bj = 0; bj < 2; ++bj) { f32x4 v0 = acc[ai][bj][m][0] + bv[bj][0], v1 = acc[ai][bj][m][1] + bv[bj][1];
                    if (ACT == 1) { f32x2 a = gelu_pk((f32x2){v0[0], v0[1]}), b = gelu_pk((f32x2){v0[2], v0[3]}), c = gelu_pk((f32x2){v1[0], v1[1]}), d = gelu_pk((f32x2){v1[2], v1[3]});
                        v0 = (f32x4){a.x, a.y, b.x, b.y}; v1 = (f32x4){c.x, c.y, d.x, d.y}; }
                    v0 = v0 * sc; v1 = v1 * sc; u32x4 w; w.x = cvt_pk_bf16(v0[0], v0[1]); w.y = cvt_pk_bf16(v0[2], v0[3]); w.z = cvt_pk_bf16(v1[0], v1[1]); w.w = cvt_pk_bf16(v1[2], v1[3]);
                    *(u32x4*)(rowp + bj * HALF) = w; } }
    }
};
template <class Epi, class Sched, bool ALIGN_EPI = false, bool SP2 = false>
__device__ __forceinline__ void gemm_phase(PG8_LAS unsigned char* lds, const Gemm g, const Sched& S, const Epi& E, const int tid) {
    const int wid = __builtin_amdgcn_readfirstlane(tid >> 6), lane = tid & 63, wr = wid >> 2, wc = wid & 3, fr = lane & 15, fq = lane >> 4;
    int K = g.K; asm volatile("" : "+s"(K));
    const int nt = K / BK;
    unsigned voffA[2], voffB[2];
#pragma unroll
    for (int i = 0; i < 2; ++i) { int R, C; stage_rc(tid * 16 + i * 8192, R, C); const int Rb = Epi::PERM ? ((R & ~31) + perm32(R & 31)) : R;
        voffA[i] = (unsigned)(R * g.lda + C) * 2u; voffB[i] = (unsigned)(Rb * g.ldb + C) * 2u; }
    const size_t kstep = (size_t)(BK * 2);
    const size_t hstepA = (size_t)HALF * g.lda * 2, hstepB = (size_t)HALF * g.ldb * 2;
    const size_t tstepA = 2 * hstepA, tstepB = 2 * hstepB;
    const unsigned ldsw = (unsigned)wid * 1024u;
    const int aoff = lds_byte(wr * 64 + fr, fq * 8), boff = lds_byte(wc * 32 + fr, fq * 8);
#define PG8_SA(b, h) (((b) * 2 + (h)) * HTB)
#define PG8_SB(b, h) ((4 + (b) * 2 + (h)) * HTB)
#define PG8_STAGE(bufoff, gbase, voff) do { _Pragma("unroll") for (int _i = 0; _i < 2; ++_i) \
        __builtin_amdgcn_global_load_lds((const unsigned*)((const char*)(gbase) + (voff)[_i]), (PG8_LAS unsigned*)(lds + (bufoff) + ldsw + _i * 8192), 16, 0, 0); } while (0)
#define PG8_LDA(dst, b, h) do { _Pragma("unroll") for (int m = 0; m < 4; ++m) _Pragma("unroll") for (int k = 0; k < 2; ++k) dst[m][k] = *(const PG8_LAS bf16x8*)(lds + PG8_SA(b, h) + aoff + m * 2048 + k * 1024); } while (0)
#define PG8_LDB(dst, b, h) do { _Pragma("unroll") for (int n = 0; n < 2; ++n) _Pragma("unroll") for (int k = 0; k < 2; ++k) dst[n][k] = *(const PG8_LAS bf16x8*)(lds + PG8_SB(b, h) + boff + n * 2048 + k * 1024); } while (0)
#define PG8_MMA(ai, bj, At, Bt) do { __builtin_amdgcn_s_setprio(1); _Pragma("unroll") for (int m = 0; m < 4; ++m) _Pragma("unroll") for (int n = 0; n < 2; ++n) _Pragma("unroll") for (int k = 0; k < 2; ++k) \
        acc[ai][bj][m][n] = __builtin_amdgcn_mfma_f32_16x16x32_bf16(Bt[n][k], At[m][k], acc[ai][bj][m][n], 0, 0, 0); __builtin_amdgcn_s_setprio(0); } while (0)
#define PG8_WAIT_V(n) asm volatile("s_waitcnt vmcnt(" #n ")" ::: "memory")
#define PG8_WAIT_L(n) asm volatile("s_waitcnt lgkmcnt(" #n ")" ::: "memory")
#define PG8_BAR __builtin_amdgcn_s_barrier()
#define PG8_SCHED __builtin_amdgcn_sched_barrier(0)
    Unit cur, nxt; int ui = 0;
    if (!S.next(0, cur)) return;
    f32x4 acc[2][2][4][2];
#pragma unroll
    for (int a = 0; a < 2; ++a)
#pragma unroll
        for (int b = 0; b < 2; ++b)
#pragma unroll
            for (int m = 0; m < 4; ++m)
#pragma unroll
                for (int n = 0; n < 2; ++n) acc[a][b][m][n] = (f32x4){0.f, 0.f, 0.f, 0.f};
    bf16x8 At[4][2], B0[2][2], B1[2][2];
    const char* cA = (const char*)g.A + (size_t)cur.pm * tstepA; const char* cB = (const char*)g.Bt + (size_t)cur.pn * tstepB;
    S.a_ready(cur);
    if constexpr (SP2) {
        PG8_STAGE(PG8_SB(0, 0), cB, voffB); PG8_STAGE(PG8_SB(0, 1), cB + hstepB, voffB); PG8_STAGE(PG8_SA(0, 0), cA, voffA); PG8_STAGE(PG8_SA(0, 1), cA + hstepA, voffA);
        if (wr == 1) PG8_BAR;
        PG8_WAIT_V(2); PG8_BAR;
        PG8_STAGE(PG8_SB(1, 0), cB + kstep, voffB); PG8_STAGE(PG8_SA(1, 0), cA + kstep, voffA); PG8_STAGE(PG8_SB(1, 1), cB + hstepB + kstep, voffB);
        PG8_WAIT_V(6); PG8_BAR;
    } else {
        PG8_STAGE(PG8_SB(0, 0), cB, voffB); PG8_STAGE(PG8_SA(0, 0), cA, voffA); PG8_STAGE(PG8_SB(0, 1), cB + hstepB, voffB); PG8_STAGE(PG8_SA(0, 1), cA + hstepA, voffA);
        if (wr == 1) PG8_BAR;
        PG8_WAIT_V(4); PG8_BAR;
        PG8_STAGE(PG8_SB(1, 0), cB + kstep, voffB); PG8_STAGE(PG8_SA(1, 0), cA + kstep, voffA); PG8_STAGE(PG8_SB(1, 1), cB + hstepB + kstep, voffB);
        PG8_WAIT_V(6); PG8_BAR;
    }
    for (;;) {
        const bool has_next = S.next(ui + 1, nxt);
        const char* nA = has_next ? (const char*)g.A + (size_t)nxt.pm * tstepA : cA; const char* nB = has_next ? (const char*)g.Bt + (size_t)nxt.pn * tstepB : cB;
        for (int t = 0; t < nt; t += 2) {
            const bool last = (t == nt - 2);
            const char* a1 = cA + (size_t)(t + 1) * kstep;
            const char* a2 = last ? nA : cA + (size_t)(t + 2) * kstep; const char* b2 = last ? nB : cB + (size_t)(t + 2) * kstep;
            const char* a3 = a2 + kstep; const char* b3 = b2 + kstep;
            if (last && has_next) S.a_ready(nxt);
            if constexpr (SP2) {
            PG8_LDB(B0, 0, 0); PG8_LDB(B1, 0, 1); PG8_SCHED; PG8_LDA(At, 0, 0); PG8_STAGE(PG8_SA(1, 1), a1 + hstepA, voffA);
            PG8_WAIT_V(8); PG8_WAIT_L(0); PG8_BAR; PG8_MMA(0, 0, At, B0); PG8_MMA(0, 1, At, B1); PG8_BAR; PG8_SCHED;
            PG8_LDA(At, 0, 1); PG8_STAGE(PG8_SB(0, 0), b2, voffB); PG8_STAGE(PG8_SB(0, 1), b2 + hstepB, voffB); PG8_STAGE(PG8_SA(0, 0), a2, voffA);
            PG8_WAIT_V(8); PG8_WAIT_L(0); PG8_BAR; PG8_MMA(1, 0, At, B0); PG8_MMA(1, 1, At, B1); PG8_BAR; PG8_SCHED;
            PG8_LDB(B0, 1, 0); PG8_LDB(B1, 1, 1); PG8_SCHED; PG8_LDA(At, 1, 0); PG8_STAGE(PG8_SA(0, 1), a2 + hstepA, voffA);
            PG8_WAIT_V(8); PG8_WAIT_L(0); PG8_BAR; PG8_MMA(0, 0, At, B0); PG8_MMA(0, 1, At, B1); PG8_BAR; PG8_SCHED;
            PG8_LDA(At, 1, 1); PG8_STAGE(PG8_SB(1, 0), b3, voffB); PG8_STAGE(PG8_SB(1, 1), b3 + hstepB, voffB); PG8_STAGE(PG8_SA(1, 0), a3, voffA);
            PG8_WAIT_V(8); PG8_WAIT_L(0); PG8_BAR; PG8_MMA(1, 0, At, B0); PG8_MMA(1, 1, At, B1); PG8_BAR; PG8_SCHED;
            } else {
            PG8_LDB(B0, 0, 0); PG8_SCHED; PG8_LDA(At, 0, 0); PG8_STAGE(PG8_SA(1, 1), a1 + hstepA, voffA);
            PG8_WAIT_L(8); PG8_BAR; PG8_WAIT_L(0); PG8_MMA(0, 0, At, B0); PG8_BAR; PG8_SCHED;
            PG8_LDB(B1, 0, 1); PG8_STAGE(PG8_SB(0, 0), b2, voffB);
            PG8_BAR; PG8_WAIT_L(0); PG8_MMA(0, 1, At, B1); PG8_BAR;
            PG8_LDA(At, 0, 1); PG8_STAGE(PG8_SA(0, 0), a2, voffA);
            PG8_BAR; PG8_WAIT_L(0); PG8_MMA(1, 0, At, B0); PG8_BAR; PG8_SCHED;
            PG8_STAGE(PG8_SB(0, 1), b2 + hstepB, voffB);
            PG8_WAIT_V(6); PG8_BAR; PG8_MMA(1, 1, At, B1); PG8_BAR;
            PG8_LDB(B0, 1, 0); PG8_SCHED; PG8_LDA(At, 1, 0); PG8_STAGE(PG8_SA(0, 1), a2 + hstepA, voffA);
            PG8_WAIT_L(8); PG8_BAR; PG8_WAIT_L(0); PG8_MMA(0, 0, At, B0); PG8_BAR; PG8_SCHED;
            PG8_LDB(B1, 1, 1); PG8_STAGE(PG8_SB(1, 0), b3, voffB);
            PG8_BAR; PG8_WAIT_L(0); PG8_MMA(0, 1, At, B1); PG8_BAR;
            PG8_LDA(At, 1, 1); PG8_STAGE(PG8_SA(1, 0), a3, voffA);
            PG8_BAR; PG8_WAIT_L(0); PG8_MMA(1, 0, At, B0); PG8_BAR; PG8_SCHED;
            PG8_STAGE(PG8_SB(1, 1), b3 + hstepB, voffB);
            PG8_WAIT_V(6); PG8_BAR; PG8_MMA(1, 1, At, B1); PG8_BAR;
            }
        }
        if constexpr (ALIGN_EPI) { if (wr == 0) PG8_BAR; }
        if constexpr (!Epi::AFTER_DRAIN) { E(acc, cur, wr, wc, fr, fq); S.done(cur); }
        if (!has_next) break;
#pragma unroll
        for (int a = 0; a < 2; ++a)
#pragma unroll
            for (int b = 0; b < 2; ++b)
#pragma unroll
                for (int m = 0; m < 4; ++m)
#pragma unroll
                    for (int n = 0; n < 2; ++n) acc[a][b][m][n] = (f32x4){0.f, 0.f, 0.f, 0.f};
        cur = nxt; cA = nA; cB = nB; ++ui;
        if constexpr (ALIGN_EPI) { if (wr == 1) PG8_BAR; }
    }
    PG8_WAIT_V(0);
    if constexpr (!ALIGN_EPI) { if (wr == 0) PG8_BAR; }
    PG8_BAR;
    if constexpr (Epi::AFTER_DRAIN) { E.fused(acc, cur, wr, wc, fr, fq, lds, wid, lane); S.done(cur); }
#undef PG8_SA
#undef PG8_SB
#undef PG8_STAGE
#undef PG8_LDA
#undef PG8_LDB
#undef PG8_MMA
#undef PG8_WAIT_V
#undef PG8_WAIT_L
#undef PG8_BAR
#undef PG8_SCHED
}
}
#define XB_TMO      128
#define XB_XCNT(j)  (256  + 64 * (j))
#define XB_XSUB(j)  (1280 + 64 * (j))
#define XB_XGEN(j)  (2304 + 64 * (j))
#define XB_TOP      3328
#define XB_TOPGEN   3392
#define XCD_BAR_WORDS 3456
#define XB_SPIN_CAP (1u << 18)

__device__ __forceinline__ unsigned xb_ld(unsigned* p)              { return __hip_atomic_load(p, __ATOMIC_RELAXED, __HIP_MEMORY_SCOPE_AGENT); }
__device__ __forceinline__ unsigned xb_add(unsigned* p, unsigned v) { return __hip_atomic_fetch_add(p, v, __ATOMIC_RELAXED, __HIP_MEMORY_SCOPE_AGENT); }
__device__ __forceinline__ unsigned xb_xcc_id() { return (unsigned)__builtin_amdgcn_s_getreg((3 << 11) | 20) & 0xFu; }
#define XB_SPIN(cond, bar) do { unsigned _sp = 0; while (cond) { __builtin_amdgcn_s_sleep(1); \
    if ((++_sp & 255u) == 0u) { if (xb_ld(&(bar)[XB_TMO])) break; if (_sp > XB_SPIN_CAP) { atomicAdd(&(bar)[XB_TMO], 1u); break; } } } } while (0)

struct XcdBarrier {
    unsigned* bar; unsigned x;
    volatile LAS unsigned* st;
};

__device__ __forceinline__ XcdBarrier xcd_barrier_post(unsigned* bar, volatile LAS unsigned* st) {
    XcdBarrier b; b.bar = bar; b.x = xb_xcc_id(); b.st = st;
    if (threadIdx.x == 0) (void)xb_add(&bar[XB_XCNT(b.x)], 1u);
    return b;
}
__device__ __forceinline__ void xcd_barrier_complete(unsigned* bar, unsigned x, unsigned& nloc, unsigned& nx) {
    const unsigned G = gridDim.x * gridDim.y * gridDim.z;
    unsigned sum, cnt, mine, sp = 0u;
    for (;;) {
        sum = 0u; cnt = 0u; mine = 0u;
#pragma unroll
        for (unsigned j = 0; j < 16; ++j) { const unsigned c = xb_ld(&bar[XB_XCNT(j)]); sum += c; cnt += (c > 0u) ? 1u : 0u; mine = (j == x) ? c : mine; }
        if (sum == G) break;
        __builtin_amdgcn_s_sleep(1);
        if ((++sp & 255u) == 0u) { if (xb_ld(&bar[XB_TMO])) break; if (sp > XB_SPIN_CAP) { atomicAdd(&bar[XB_TMO], 1u); break; } }
    }
    nloc = mine > 0u ? mine : 1u; nx = cnt > 0u ? cnt : 1u;
}

__device__ __forceinline__ void xcd_barrier(const XcdBarrier& b, const bool is_t0) {
    asm volatile("s_waitcnt vmcnt(0)" ::: "memory");
    __syncthreads();
    if (is_t0) {
        unsigned* bar = b.bar;
        __builtin_amdgcn_s_waitcnt(0);
        unsigned nloc = b.st[0], nx = b.st[1];
        if (nloc == 0u) { xcd_barrier_complete(bar, b.x, nloc, nx); b.st[0] = nloc; b.st[1] = nx; }
        const unsigned old = xb_add(&bar[XB_XSUB(b.x)], 1u);
        const unsigned gen = old / nloc;
        if (old + 1u == (gen + 1u) * nloc) {
            __builtin_amdgcn_fence(__ATOMIC_RELEASE, "agent");
            asm volatile("s_waitcnt vmcnt(0)" ::: "memory");
            const unsigned og = xb_add(&bar[XB_TOP], 1u);
            const unsigned tg = og / nx;
            if (og + 1u == (tg + 1u) * nx) xb_add(&bar[XB_TOPGEN], 1u);
            else XB_SPIN(xb_ld(&bar[XB_TOPGEN]) == tg, bar);
            __builtin_amdgcn_fence(__ATOMIC_ACQUIRE, "agent");
            xb_add(&bar[XB_XGEN(b.x)], 1u);
            asm volatile("s_waitcnt vmcnt(0)" ::: "memory");
        } else {
            XB_SPIN(xb_ld(&bar[XB_XGEN(b.x)]) == gen, bar);
            __builtin_amdgcn_fence(__ATOMIC_ACQUIRE, "agent");
            asm volatile("s_waitcnt vmcnt(0)" ::: "memory");
        }
    }
    __syncthreads();
}


namespace pg8 {
struct EpiZ {
    static constexpr bool PERM = true, AFTER_DRAIN = false;
    bf16_t* O; int ldc; float* fcbuf;
    __device__ __forceinline__ void operator()(const f32x4 (&acc)[2][2][4][2], const Unit& u, int wr, int wc, int fr, int fq) const {
        const int row0 = u.pm * BM + wr * 64 + fr, col0 = u.pn * BM + wc * 32 + 8 * fq;
        const bool fcl = (u.pn == 9) && (wc == 1) && (fq == 0);
#pragma unroll
        for (int ai = 0; ai < 2; ++ai)
#pragma unroll
            for (int m = 0; m < 4; ++m) {
                const int row = row0 + ai * HALF + m * 16;
                bf16_t* rowp = O + (size_t)row * ldc + col0;
#pragma unroll
                for (int bj = 0; bj < 2; ++bj) {
                    const f32x4 v0 = acc[ai][bj][m][0], v1 = acc[ai][bj][m][1];
                    u32x4 w; w.x = cvt_pk_bf16(v0[0], v0[1]); w.y = cvt_pk_bf16(v0[2], v0[3]); w.z = cvt_pk_bf16(v1[0], v1[1]); w.w = cvt_pk_bf16(v1[2], v1[3]);
                    *(u32x4*)(rowp + bj * HALF) = w;
                }
                if (fcl) *(f32x4*)(fcbuf + (size_t)row * 4) = acc[ai][0][m][0];
            }
    }
};
struct EpiRowScale {
    static constexpr bool PERM = true, AFTER_DRAIN = false;
    bf16_t* O; int ldc; const float* rs;
    __device__ __forceinline__ void operator()(const f32x4 (&acc)[2][2][4][2], const Unit& u, int wr, int wc, int fr, int fq) const {
        const int row0 = u.pm * BM + wr * 64 + fr, col0 = u.pn * BM + wc * 32 + 8 * fq;
#pragma unroll
        for (int ai = 0; ai < 2; ++ai)
#pragma unroll
            for (int m = 0; m < 4; ++m) {
                const int row = row0 + ai * HALF + m * 16;
                const float s = rs[row];
                bf16_t* rowp = O + (size_t)row * ldc + col0;
#pragma unroll
                for (int bj = 0; bj < 2; ++bj) {
                    const f32x4 v0 = acc[ai][bj][m][0] * s, v1 = acc[ai][bj][m][1] * s;
                    u32x4 w; w.x = cvt_pk_bf16(v0[0], v0[1]); w.y = cvt_pk_bf16(v0[2], v0[3]); w.z = cvt_pk_bf16(v1[0], v1[1]); w.w = cvt_pk_bf16(v1[2], v1[3]);
                    *(u32x4*)(rowp + bj * HALF) = w;
                }
            }
    }
};
struct EpiGU {
    static constexpr bool PERM = true, AFTER_DRAIN = false;
    bf16_t* O;
    __device__ __forceinline__ void operator()(const f32x4 (&acc)[2][2][4][2], const Unit& u, int wr, int wc, int fr, int fq) const {
        const int row0 = u.pm * BM + wr * 64 + fr, f0 = ((u.pn & 1) * BM + wc * 32 + 8 * fq) >> 1;
#pragma unroll
        for (int ai = 0; ai < 2; ++ai)
#pragma unroll
            for (int m = 0; m < 4; ++m) {
                bf16_t* rowp = O + (size_t)(row0 + ai * HALF + m * 16) * 256 + f0;
#pragma unroll
                for (int bj = 0; bj < 2; ++bj) {
                    const f32x4 v0 = acc[ai][bj][m][0], v1 = acc[ai][bj][m][1];
                    const float a0 = v0[0] / (1.f + __expf(-v0[0])) * v0[1], a1 = v0[2] / (1.f + __expf(-v0[2])) * v0[3];
                    const float a2 = v1[0] / (1.f + __expf(-v1[0])) * v1[1], a3 = v1[2] / (1.f + __expf(-v1[2])) * v1[3];
                    typedef unsigned u32x2 __attribute__((ext_vector_type(2)));
                    u32x2 w; w.x = cvt_pk_bf16(a0, a1); w.y = cvt_pk_bf16(a2, a3);
                    *(u32x2*)(rowp + bj * (HALF / 2)) = w;
                }
            }
    }
};
struct EpiPleGate {
    static constexpr bool PERM = true, AFTER_DRAIN = false;
    bf16_t* O; const bf16_t* PP;
    __device__ __forceinline__ void operator()(const f32x4 (&acc)[2][2][4][2], const Unit& u, int wr, int wc, int fr, int fq) const {
        const int row0 = u.pm * BM + wr * 64 + fr, col0 = u.pn * BM + wc * 32 + 8 * fq;
#pragma unroll
        for (int ai = 0; ai < 2; ++ai)
#pragma unroll
            for (int m = 0; m < 4; ++m) {
                const size_t off = (size_t)(row0 + ai * HALF + m * 16) * 1024 + col0;
#pragma unroll
                for (int bj = 0; bj < 2; ++bj) {
                    const f32x4 v0 = acc[ai][bj][m][0], v1 = acc[ai][bj][m][1];
                    const u32x4 pw = *(const u32x4*)(PP + off + bj * HALF);
                    float o[8];
                    o[0] = __uint_as_float(pw.x << 16) / (1.f + __expf(-v0[0])); o[1] = __uint_as_float(pw.x & 0xffff0000u) / (1.f + __expf(-v0[1]));
                    o[2] = __uint_as_float(pw.y << 16) / (1.f + __expf(-v0[2])); o[3] = __uint_as_float(pw.y & 0xffff0000u) / (1.f + __expf(-v0[3]));
                    o[4] = __uint_as_float(pw.z << 16) / (1.f + __expf(-v1[0])); o[5] = __uint_as_float(pw.z & 0xffff0000u) / (1.f + __expf(-v1[1]));
                    o[6] = __uint_as_float(pw.w << 16) / (1.f + __expf(-v1[2])); o[7] = __uint_as_float(pw.w & 0xffff0000u) / (1.f + __expf(-v1[3]));
                    u32x4 w; w.x = cvt_pk_bf16(o[0], o[1]); w.y = cvt_pk_bf16(o[2], o[3]); w.z = cvt_pk_bf16(o[4], o[5]); w.w = cvt_pk_bf16(o[6], o[7]);
                    *(u32x4*)(O + off + bj * HALF) = w;
                }
            }
    }
};
struct EpiDown {
    static constexpr bool PERM = true, AFTER_DRAIN = false;
    bf16_t* O;
    __device__ __forceinline__ void operator()(const f32x4 (&acc)[2][2][4][2], const Unit& u, int wr, int wc, int fr, int fq) const {
        const int row0 = u.pm * BM + wr * 64 + fr, col0 = (u.pn & 3) * BM + wc * 32 + 8 * fq;
#pragma unroll
        for (int ai = 0; ai < 2; ++ai)
#pragma unroll
            for (int m = 0; m < 4; ++m) {
                bf16_t* rowp = O + (size_t)(row0 + ai * HALF + m * 16) * 1024 + col0;
#pragma unroll
                for (int bj = 0; bj < 2; ++bj) {
                    const f32x4 v0 = acc[ai][bj][m][0], v1 = acc[ai][bj][m][1];
                    u32x4 w; w.x = cvt_pk_bf16(v0[0], v0[1]); w.y = cvt_pk_bf16(v0[2], v0[3]); w.z = cvt_pk_bf16(v1[0], v1[1]); w.w = cvt_pk_bf16(v1[2], v1[3]);
                    *(u32x4*)(rowp + bj * HALF) = w;
                }
            }
    }
};
constexpr int XPM = (int)((WS_HS16 - WS_A16) / (256 * 1024 * 2)), XPN = (int)((WS_WGU - WS_WPG) / (256 * 1024 * 2));
static_assert((WS_HS16 - WS_A16) % (256 * 1024 * 2) == 0 && (WS_WGU - WS_WPG) % (256 * 1024 * 2) == 0 && XPM >= 64 && (XPN & 1) == 0, "virtual unit offsets");
struct EpiX {
    static constexpr bool PERM = true, AFTER_DRAIN = false;
    EpiGU gu; EpiPleGate pg;
    __device__ __forceinline__ void operator()(const f32x4 (&acc)[2][2][4][2], const Unit& u, int wr, int wc, int fr, int fq) const {
        if (u.pm >= XPM) { const Unit v{u.pm - XPM, u.pn - XPN}; gu(acc, v, wr, wc, fr, fq); }
        else pg(acc, u, wr, wc, fr, fq);
    }
};
struct XSched {
    const int* tile_e; int nU1, G, vc;
    __device__ __forceinline__ bool next(int i, Unit& u) const {
        if (i >= 2) return false;
        const int g = vc + i * G;
        if (g < nU1) { const int t = g >> 1; u.pm = t + XPM; u.pn = __builtin_amdgcn_readfirstlane(tile_e[t]) * 2 + (g & 1) + XPN; return true; }
        const int k = g - nU1; if (k >= 256) return false;
        u.pm = k >> 2; u.pn = k & 3; return true;
    }
    __device__ __forceinline__ void a_ready(const Unit&) const {}
    __device__ __forceinline__ void done(const Unit&) const {}
};
struct OneUnit {
    int pm, pn;
    __device__ __forceinline__ bool next(int i, Unit& u) const { if (i) return false; u.pm = pm; u.pn = pn; return true; }
    __device__ __forceinline__ void a_ready(const Unit&) const {}
    __device__ __forceinline__ void done(const Unit&) const {}
};
struct GroupSched {
    const int* tile_e; int T, NJ, G, vc;
    __device__ __forceinline__ bool next(int i, Unit& u) const {
        const long L = (long)i * G + vc; if (L >= (long)T * NJ) return false;
        const int t = (int)(L / NJ), j = (int)(L % NJ);
        u.pm = t; u.pn = __builtin_amdgcn_readfirstlane(tile_e[t]) * NJ + j; return true;
    }
    __device__ __forceinline__ void a_ready(const Unit&) const {}
    __device__ __forceinline__ void done(const Unit&) const {}
};
}

template <class Map>
__device__ __forceinline__ void transpose_rows(const Map mp, const float* ks, int nrows_out, int K, bf16* WT, LAS float* scr, int gw, int NGW, int lane) {
    const int nblk = nrows_out / 32, nitems = (K / 64) * nblk;
    const int f = lane & 7, kr = lane >> 3;
    for (int it = gw; it < nitems; it += NGW) {
        const int kb = it / nblk, nb = it % nblk, k0 = 64 * kb, n0 = 32 * nb;
        const float* src; long pitch; float sc; int nl0, nls;
        mp.get4(n0, f, src, pitch, sc, nl0, nls);
        f32x4_t vals[8];
#pragma unroll
        for (int i = 0; i < 8; ++i) vals[i] = src ? *(const f32x4_t*)(src + (size_t)(k0 + kr + 8 * i) * pitch) : (f32x4_t){0.f, 0.f, 0.f, 0.f};
#pragma unroll
        for (int i = 0; i < 8; ++i) {
            const int kk = kr + 8 * i;
            float m = sc; if (ks) m *= ks[k0 + kk];
            scr[kk * 33 + nl0] = vals[i].x * m; scr[kk * 33 + nl0 + nls] = vals[i].y * m; scr[kk * 33 + nl0 + 2 * nls] = vals[i].z * m; scr[kk * 33 + nl0 + 3 * nls] = vals[i].w * m;
        }
        asm volatile("s_waitcnt lgkmcnt(0)" ::: "memory");
        const int c = lane & 7;
#pragma unroll
        for (int j = 0; j < 4; ++j) {
            const int n = (lane >> 3) + 8 * j; const LAS float* s = scr + (8 * c) * 33 + n;
            v4u o; o.x = pk2(s[0 * 33], s[1 * 33]); o.y = pk2(s[2 * 33], s[3 * 33]); o.z = pk2(s[4 * 33], s[5 * 33]); o.w = pk2(s[6 * 33], s[7 * 33]);
            *(v4u*)(WT + (size_t)(n0 + n) * K + k0 + 8 * c) = o;
        }
        asm volatile("s_waitcnt lgkmcnt(0)" ::: "memory");
    }
}
constexpr float LOG2E_W = 1.4426950408889634f;
struct MapIn {
    const float* w;
    __device__ __forceinline__ void get(int n, const float*& src, long& pitch, float& sc) const {
        int c;
        if (n < 1152) c = n;
        else if (n < Z_CKV) c = OFF_QC + (n - Z_QC);
        else if (n < Z_CQ) c = OFF_CKV + (n - Z_CKV);
        else if (n < Z_KR) c = OFF_CQ + (n - Z_CQ);
        else if (n < Z_FC) c = OFF_KR + (n - Z_KR);
        else if (n < Z_FC + 4) c = OFF_FC + (n - Z_FC);
        else c = -1;
        src = c >= 0 ? w + c : nullptr; pitch = D_IN;
        sc = n < Z_KA ? 0.17677669529663687f * LOG2E_W : ((n >= Z_QC && n < Z_KC) ? 0.125f * LOG2E_W : 1.f);
    }
    __device__ __forceinline__ void get4(int n0, int f, const float*& src, long& pitch, float& sc, int& nl0, int& nls) const { get(n0 + 4 * f, src, pitch, sc); nl0 = 4 * f; nls = 1; }
};
struct MapPlain {
    const float* w; int N, nvalid; float scale;
    __device__ __forceinline__ void get(int n, const float*& src, long& pitch, float& sc) const { src = n < nvalid ? w + n : nullptr; pitch = N; sc = scale; }
    __device__ __forceinline__ void get4(int n0, int f, const float*& src, long& pitch, float& sc, int& nl0, int& nls) const { get(n0 + 4 * f, src, pitch, sc); nl0 = 4 * f; nls = 1; }
};

struct MapGU {
    const float* wg; const float* wu;
    __device__ __forceinline__ void get(int n, const float*& src, long& pitch, float& sc) const {
        const int e = n >> 9, r = n & 511, f = r >> 1;
        const long dlt = (r & 1) ? (long)(wu - wg) : 0l;
        src = wg + dlt + (size_t)e * 1024 * 256 + f; pitch = 256; sc = 1.f;
    }
    __device__ __forceinline__ void get4(int n0, int f, const float*& src, long& pitch, float& sc, int& nl0, int& nls) const {
        const int e = n0 >> 9, f0 = (n0 & 511) >> 1;
        const long dlt = (f >> 2) ? (long)(wu - wg) : 0l;
        src = wg + dlt + (size_t)e * 1024 * 256 + f0 + 4 * (f & 3); pitch = 256; sc = 1.f; nl0 = 8 * (f & 3) + (f >> 2); nls = 2;
    }
};
struct MapD {
    const float* wd;
    __device__ __forceinline__ void get(int n, const float*& src, long& pitch, float& sc) const {
        const int e = n >> 10, c = n & 1023;
        src = wd + (size_t)e * 256 * 1024 + c; pitch = 1024; sc = 1.f;
    }
    __device__ __forceinline__ void get4(int n0, int f, const float*& src, long& pitch, float& sc, int& nl0, int& nls) const { get(n0 + 4 * f, src, pitch, sc); nl0 = 4 * f; nls = 1; }
};

struct AttnP {
    const bf16* z16; const bf16* qb16; const bf16* kvb16; const bf16* krr16; const float* cum; const float* cosT; const float* sinT;
    const int* pos; bf16* mixed16; const float* lq1; const float* lk1; const float* lq2; const float* lk2; const float* gdiff; int layer; unsigned* prof; const int* tpmax; float lam, lam_init;
};
typedef short bf16x8_t __attribute__((ext_vector_type(8)));
typedef float f32x16_t __attribute__((ext_vector_type(16)));
typedef short s16x4_t __attribute__((ext_vector_type(4)));
typedef float f32x2_t __attribute__((ext_vector_type(2)));
typedef __bf16 bf16x2_t __attribute__((ext_vector_type(2)));
__device__ __forceinline__ unsigned cvtpk(float lo, float hi) { f32x2_t v = {lo, hi}; bf16x2_t b = __builtin_convertvector(v, bf16x2_t); return __builtin_bit_cast(unsigned, b); }
__device__ __forceinline__ int crow(int r, int hi) { return (r & 3) + 8 * (r >> 2) + 4 * hi; }
__device__ __forceinline__ s16x4_t vtr(const LAS unsigned char* p) { typedef short v4i16_t __attribute__((ext_vector_type(4))); return __builtin_bit_cast(s16x4_t, __builtin_amdgcn_ds_read_tr16_b64_v4i16((LAS v4i16_t*)p)); }
constexpr float LOG2E = 1.4426950408889634f;

__device__ __forceinline__ float xhalf_max(float m) { auto rr = __builtin_amdgcn_permlane32_swap(__float_as_uint(m), __float_as_uint(m), false, false); return __builtin_fmaxf(__uint_as_float(rr[0]), __uint_as_float(rr[1])); }
__device__ __forceinline__ float xhalf_sum(float m) { auto rr = __builtin_amdgcn_permlane32_swap(__float_as_uint(m), __float_as_uint(m), false, false); return __uint_as_float(rr[0]) + __uint_as_float(rr[1]); }
__device__ __forceinline__ float max3f(float a, float b, float c) { return __builtin_fmaxf(__builtin_fmaxf(a, b), c); }
template <int MODE> __device__ __forceinline__ void attn_unit(const AttnP& p, int b, int h, int qblk, LAS unsigned char* lds, const int tid_in) {
    int tid = tid_in * 64 + lane_id_now(); asm volatile("" : "+v"(tid));
#ifdef PROF_SEL
    const unsigned long long pu0 = __builtin_amdgcn_s_memrealtime(); unsigned long long pt0 = 0, pl0 = 0, pacc_c = 0, pacc_b = 0;
#define PROF_T(acc) do { const unsigned long long t_ = __builtin_amdgcn_s_memrealtime(); acc += t_ - pt0; pt0 = t_; } while (0)
#else
#define PROF_T(acc) do {} while (0)
#endif
    constexpr int NF = MODE == 0 ? 2 : (MODE == 1 ? 6 : 4);
    constexpr int NC = MODE == 1 ? 12 : 8;
    constexpr int NCX = MODE == 1 ? 0 : 2;
    constexpr int KB = (NC + NCX) * 1024, KBUF = KB + 256;
    constexpr int VOFF = 2 * KBUF;
    constexpr int KI = (NC * 64 + NTHREADS - 1) / NTHREADS;
    const int lane = tid & 63, w = __builtin_amdgcn_readfirstlane(tid >> 6), r32 = lane & 31, hi = lane >> 5;
    const int map = MODE == 0 ? (w >> 2) : 0, qg = MODE == 0 ? (w & 3) : w;
    const int c = MODE == 0 ? qblk * 2 + (qg >> 1) : qblk * 4 + (qg >> 1);
    const int ntiles = MODE == 0 ? qblk * 2 + 2 : qblk * 4 + 4;
    const long tok0 = (long)b * SEQ;
    const int q0u = MODE == 0 ? qblk * 128 : qblk * 256;
    const long qrow = tok0 + q0u + qg * 32 + r32;
    float slope2 = 0.f, sq = 0.f, refv = 0.f; int qpmin = 0;
    const bf16* ksrc[KI]; bool kok[KI];
#pragma unroll
    for (int i = 0; i < KI; ++i) {
        const int pidx0 = tid + i * NTHREADS;
        kok[i] = pidx0 < NC * 64;
        const int pidx = kok[i] ? pidx0 : pidx0 - NTHREADS, c8 = pidx >> 6, kv = pidx & 63;
        if (MODE == 0) ksrc[i] = p.z16 + (tok0 + kv) * ZP + Z_KA + h * 64 + c8 * 8;
        else if (MODE == 2) ksrc[i] = p.z16 + (tok0 + kv) * ZP + Z_KC + h * 64 + c8 * 8;
        else ksrc[i] = (c8 < 8) ? p.kvb16 + (tok0 + kv) * NKVB + h * 128 + c8 * 8 : p.krr16 + (tok0 + kv) * 32 + (c8 - 8) * 8;
    }
    const int kstride = MODE == 1 ? 0 : 64 * ZP;
    const int vcl = tid & 3, vkv = (tid >> 2) & 63, vch = tid >> 8;
    const bf16* vsrc = MODE == 0 ? p.z16 + (tok0 + vkv) * ZP + Z_VA + h * 64 + (vch * 4 + vcl) * 8
                     : (MODE == 1 ? p.kvb16 + (tok0 + vkv) * NKVB + h * 128 + 64 + (vch * 4 + vcl) * 8 : p.z16 + (tok0 + vkv) * ZP + Z_VC + h * 64 + (vch * 4 + vcl) * 8);
    const int vstride = MODE == 1 ? 64 * NKVB : 64 * ZP;
    LAS unsigned char* const vdstp = lds + VOFF + vch * 4096 + (vkv >> 3) * 512 + (vkv & 7) * 64 + vcl * 16;
    LAS unsigned char* const kdstp = lds + tid * 16;
    v4u kreg0[KI], kreg1[KI], vreg0, vreg1; unsigned breg0 = 0u, breg1 = 0u;
    auto load_k = [&](int kt_, v4u (&kreg)[KI], unsigned& breg) {
        const int kt = kt_ < ntiles ? kt_ : ntiles - 1;
#pragma unroll
        for (int i = 0; i < KI; ++i) {
            const int pidx = tid + i * NTHREADS;
            const long off = MODE == 1 ? (((kok[i] ? pidx : pidx - NTHREADS) >> 6) < 8 ? (long)kt * 64 * NKVB : (long)kt * 64 * 32) : (long)kt * kstride;
            kreg[i] = *(const v4u*)(ksrc[i] + off);
        }
        if (MODE == 0) breg = (unsigned)p.pos[tok0 + kt * 64 + (tid & 63)];
        if (MODE == 2) breg = __float_as_uint(p.cum[(tok0 + kt * 64 + (tid & 63)) * 4 + h]);
    };
    auto load_v = [&](int kt_, v4u& vreg) { const int kt = kt_ < ntiles ? kt_ : ntiles - 1; vreg = *(const v4u*)(vsrc + (long)kt * vstride); };
    auto write_k = [&](const int par, const v4u (&kreg)[KI], const unsigned& breg) {
#pragma unroll
        for (int i = 0; i < KI; ++i) if (kok[i]) *(LAS v4u*)(kdstp + par * KBUF + i * NTHREADS * 16) = kreg[i];
        if (MODE != 1 && tid < 64) {
            const float bv = MODE == 0 ? slope2 * ((float)(int)breg - refv) : (refv - __uint_as_float(breg)) * LOG2E;
            *(LAS float*)(lds + par * KBUF + KB + tid * 4) = bv;
            const unsigned e0 = f2bf(bv); const float r1 = bv - __uint_as_float(e0 << 16);
            const unsigned e1 = f2bf(r1); const float r2 = r1 - __uint_as_float(e1 << 16);
            const unsigned e2 = f2bf(r2);
            v4u ex; ex.x = e0 | (e1 << 16); ex.y = e2; ex.z = 0u; ex.w = 0u;
            *(LAS v4u*)(lds + par * KBUF + NC * 1024 + tid * 16) = ex;
        }
    };
    auto write_v = [&](const int par, const v4u& vreg) { *(LAS v4u*)(vdstp + par * 8192) = vreg; };
    load_k(0, kreg0, breg0); load_k(1, kreg1, breg1); load_v(0, vreg0); load_v(1, vreg1);
    bf16x8_t qf[NF];
    {
        const bf16* qsrc = MODE == 0 ? p.z16 + qrow * ZP + Z_QA + h * 64 + map * 32 : (MODE == 1 ? p.qb16 + qrow * NQBP + h * 96 : p.z16 + qrow * ZP + Z_QC + h * 64);
#pragma unroll
        for (int i = 0; i < NF; ++i) qf[i] = *(const bf16x8_t*)(qsrc + i * 16 + hi * 8);
    }
    if (MODE == 1) {
        const float4 c0 = *(const float4*)(p.cosT + qrow * 16 + hi * 8), c1 = *(const float4*)(p.cosT + qrow * 16 + hi * 8 + 4);
        const float4 s0 = *(const float4*)(p.sinT + qrow * 16 + hi * 8), s1 = *(const float4*)(p.sinT + qrow * 16 + hi * 8 + 4);
        const float cs[8] = {c0.x, c0.y, c0.z, c0.w, c1.x, c1.y, c1.z, c1.w}, sn[8] = {s0.x, s0.y, s0.z, s0.w, s1.x, s1.y, s1.z, s1.w};
        float n1[8], n2[8];
#pragma unroll
        for (int j = 0; j < 8; ++j) {
            const float x1 = __uint_as_float((unsigned)(unsigned short)qf[NF - 2][j] << 16), x2 = __uint_as_float((unsigned)(unsigned short)qf[NF - 1][j] << 16);
            n1[j] = x1 * cs[j] - x2 * sn[j]; n2[j] = x2 * cs[j] + x1 * sn[j];
        }
        v4u a, bb;
        a.x = cvtpk(n1[0], n1[1]); a.y = cvtpk(n1[2], n1[3]); a.z = cvtpk(n1[4], n1[5]); a.w = cvtpk(n1[6], n1[7]);
        bb.x = cvtpk(n2[0], n2[1]); bb.y = cvtpk(n2[2], n2[3]); bb.z = cvtpk(n2[4], n2[5]); bb.w = cvtpk(n2[6], n2[7]);
        qf[NF - 2] = __builtin_bit_cast(bf16x8_t, a); qf[NF - 1] = __builtin_bit_cast(bf16x8_t, bb);
    }
    if (MODE == 0) {
        slope2 = exp2f(-8.0f * (float)(h + 1) / 6.0f) * LOG2E;
        const int pref = p.pos[tok0 + q0u]; refv = (float)pref;
        const int pq = p.pos[qrow]; sq = slope2 * (float)(pq - pref);
        int mn = pq;
#pragma unroll
        for (int o_ = 1; o_ < 64; o_ <<= 1) mn = min(mn, __builtin_amdgcn_ds_bpermute((lane ^ o_) << 2, mn));
        qpmin = __builtin_amdgcn_readfirstlane(mn);
    }
    if (MODE == 2) refv = p.cum[(tok0 + q0u) * 4 + h];
    f32x16_t o[2], negm;
    float mref = 0.f, lsum = 0.f; bool first = true;
#pragma unroll
    for (int r = 0; r < 16; ++r) { o[0][r] = 0.f; o[1][r] = 0.f; negm[r] = 0.f; }
    bf16x8_t qext;
    { v4u q1; q1.x = hi == 0 ? 0x3f803f80u : 0u; q1.y = hi == 0 ? 0x00003f80u : 0u; q1.z = 0u; q1.w = 0u; qext = __builtin_bit_cast(bf16x8_t, q1); }
    LAS unsigned char* const kfp = lds + (map * NF * 2 + hi) * 1024 + r32 * 16;
    LAS unsigned char* const kxp = lds + (NC + hi) * 1024 + r32 * 16;
    LAS unsigned char* const bfp = lds + KB + 16 * hi;
    LAS unsigned char* const vfp = lds + VOFF + (4 * hi + ((lane & 15) >> 2)) * 64 + ((lane >> 4) & 1) * 32 + (lane & 3) * 8;
    auto compute_s = [&](const int kt, const int par, f32x16_t& p0, f32x16_t& p1) {
        constexpr int KG = NF;
        bf16x8_t kf0[KG], kf1[KG], kx0, kx1;
#pragma unroll
        for (int d0 = 0; d0 < KG; ++d0) { kf0[d0] = *(const LAS bf16x8_t*)(kfp + par * KBUF + d0 * 2048); kf1[d0] = *(const LAS bf16x8_t*)(kfp + par * KBUF + d0 * 2048 + 512); }
        if (MODE != 1) { kx0 = *(const LAS bf16x8_t*)(kxp + par * KBUF); kx1 = *(const LAS bf16x8_t*)(kxp + par * KBUF + 512); }
        __builtin_amdgcn_sched_barrier(0);
        if (MODE != 1) {
            p0 = __builtin_amdgcn_mfma_f32_32x32x16_bf16(kx0, qext, negm, 0, 0, 0);
            p1 = __builtin_amdgcn_mfma_f32_32x32x16_bf16(kx1, qext, negm, 0, 0, 0);
        }
#pragma unroll
        for (int d0 = 0; d0 < KG; ++d0) {
            p0 = __builtin_amdgcn_mfma_f32_32x32x16_bf16(kf0[d0], qf[d0], (MODE == 1 && d0 == 0) ? negm : p0, 0, 0, 0);
            p1 = __builtin_amdgcn_mfma_f32_32x32x16_bf16(kf1[d0], qf[d0], (MODE == 1 && d0 == 0) ? negm : p1, 0, 0, 0);
        }
        if (NF > KG) {
#pragma unroll
            for (int d0 = KG; d0 < NF; ++d0) { kf0[d0 - KG] = *(const LAS bf16x8_t*)(kfp + par * KBUF + d0 * 2048); kf1[d0 - KG] = *(const LAS bf16x8_t*)(kfp + par * KBUF + d0 * 2048 + 512); }
#pragma unroll
            for (int d0 = KG; d0 < NF; ++d0) {
                p0 = __builtin_amdgcn_mfma_f32_32x32x16_bf16(kf0[d0 - KG], qf[d0], p0, 0, 0, 0);
                p1 = __builtin_amdgcn_mfma_f32_32x32x16_bf16(kf1[d0 - KG], qf[d0], p1, 0, 0, 0);
            }
        }
        if (MODE == 0) {
            if (kt == c || p.tpmax[b * 32 + kt] > qpmin) {
#pragma unroll
                for (int g = 0; g < 4; ++g) {
                    const f32x4_t b0 = *(const LAS f32x4_t*)(bfp + par * KBUF + 32 * g), b1 = *(const LAS f32x4_t*)(bfp + par * KBUF + 128 + 32 * g);
                    p0[4 * g] += 2.f * fminf(sq - b0.x, 0.f); p0[4 * g + 1] += 2.f * fminf(sq - b0.y, 0.f); p0[4 * g + 2] += 2.f * fminf(sq - b0.z, 0.f); p0[4 * g + 3] += 2.f * fminf(sq - b0.w, 0.f);
                    p1[4 * g] += 2.f * fminf(sq - b1.x, 0.f); p1[4 * g + 1] += 2.f * fminf(sq - b1.y, 0.f); p1[4 * g + 2] += 2.f * fminf(sq - b1.z, 0.f); p1[4 * g + 3] += 2.f * fminf(sq - b1.w, 0.f);
                }
            }
        }
        if (MODE == 2) {
            if (kt == c) {
                const int qi = (qg & 1) * 32 + r32;
#pragma unroll
                for (int r = 0; r < 16; ++r) { const int kv = crow(r, hi); if (kv > qi) p0[r] = -INFINITY; if (kv + 32 > qi) p1[r] = -INFINITY; }
            }
        }
    };
    auto softmax_pv = [&](const int par, f32x16_t& p0, f32x16_t& p1) {
        constexpr int VE = MODE == 1 ? 4 : 8;
        s16x4_t vlo[8], vhi[8];
#pragma unroll
        for (int i = 0; i < VE; ++i) { vlo[i] = vtr(vfp + par * 8192 + (i & 1) * 4096 + (i >> 1) * 1024); vhi[i] = vtr(vfp + par * 8192 + (i & 1) * 4096 + (i >> 1) * 1024 + 512); }
        __builtin_amdgcn_sched_barrier(0);
        float tm0 = max3f(p0[0], p0[1], p0[2]), tm1 = max3f(p1[0], p1[1], p1[2]);
#pragma unroll
        for (int r = 3; r < 15; r += 2) { tm0 = max3f(tm0, p0[r], p0[r + 1]); tm1 = max3f(tm1, p1[r], p1[r + 1]); }
        float tmax = max3f(tm0, tm1, p0[15]); tmax = __builtin_fmaxf(tmax, p1[15]);
        tmax = xhalf_max(tmax);
        if (first || __any(tmax > 8.0f)) {
            const float dl = first ? tmax : __builtin_fmaxf(tmax, 0.f);
            mref += dl;
            const float f = first ? 1.f : __builtin_amdgcn_exp2f(-dl);
            lsum *= f;
#pragma unroll
            for (int r = 0; r < 16; ++r) { o[0][r] *= f; o[1][r] *= f; p0[r] -= dl; p1[r] -= dl; negm[r] = -mref; }
            first = false;
        }
        float ls0 = 0.f, ls1 = 0.f;
#pragma unroll
        for (int r = 0; r < 16; ++r) { p0[r] = __builtin_amdgcn_exp2f(p0[r]); p1[r] = __builtin_amdgcn_exp2f(p1[r]); ls0 += p0[r]; ls1 += p1[r]; }
        lsum += ls0 + ls1;
        bf16x8_t pa[4];
#pragma unroll
        for (int ks = 0; ks < 4; ++ks) {
            v4u wv;
            if (ks < 2) { wv.x = cvtpk(p0[8 * ks + 0], p0[8 * ks + 1]); wv.y = cvtpk(p0[8 * ks + 2], p0[8 * ks + 3]); wv.z = cvtpk(p0[8 * ks + 4], p0[8 * ks + 5]); wv.w = cvtpk(p0[8 * ks + 6], p0[8 * ks + 7]); }
            else { wv.x = cvtpk(p1[8 * (ks - 2) + 0], p1[8 * (ks - 2) + 1]); wv.y = cvtpk(p1[8 * (ks - 2) + 2], p1[8 * (ks - 2) + 3]); wv.z = cvtpk(p1[8 * (ks - 2) + 4], p1[8 * (ks - 2) + 5]); wv.w = cvtpk(p1[8 * (ks - 2) + 6], p1[8 * (ks - 2) + 7]); }
            pa[ks] = __builtin_bit_cast(bf16x8_t, wv);
        }
#pragma unroll
        for (int i = VE; i < 8; ++i) { vlo[i] = vtr(vfp + par * 8192 + (i & 1) * 4096 + (i >> 1) * 1024); vhi[i] = vtr(vfp + par * 8192 + (i & 1) * 4096 + (i >> 1) * 1024 + 512); }
#pragma unroll
        for (int ks = 0; ks < 4; ++ks)
#pragma unroll
            for (int blk = 0; blk < 2; ++blk) {
                const s16x4_t lo = vlo[ks * 2 + blk], hi4 = vhi[ks * 2 + blk];
                const bf16x8_t vf = {lo[0], lo[1], lo[2], lo[3], hi4[0], hi4[1], hi4[2], hi4[3]};
                o[blk] = __builtin_amdgcn_mfma_f32_32x32x16_bf16(vf, pa[ks], o[blk], 0, 0, 0);
            }
    };
    if (MODE != 1 && tid < 128) *(LAS v4u*)(lds + (tid >> 6) * KBUF + (NC + 1) * 1024 + (tid & 63) * 16) = (v4u){0u, 0u, 0u, 0u};
    constexpr bool PIPE = false;
    f32x16_t pA0, pA1, pB0, pB1;
    if (PIPE) {
        write_k(0, kreg0, breg0); write_k(1, kreg1, breg1); write_v(0, vreg0);
        load_k(2, kreg0, breg0);
        __syncthreads();
        compute_s(0, 0, pA0, pA1);
        __syncthreads();
    } else {
        write_k(0, kreg0, breg0); write_v(0, vreg0);
        __syncthreads();
    }
#ifdef PROF_SEL
    pl0 = __builtin_amdgcn_s_memrealtime();
#endif
#pragma unroll 1
    for (int kt = 0; kt < ntiles; kt += 2) {
#ifdef PROF_SEL
        pt0 = __builtin_amdgcn_s_memrealtime();
#endif
        if (PIPE) {
            load_k(kt + 3, kreg1, breg1); load_v(kt + 2, vreg0);
            if (kt < c) { compute_s(kt + 1, 1, pB0, pB1); __builtin_amdgcn_sched_barrier(0); softmax_pv(0, pA0, pA1); }
            else if (kt == c) softmax_pv(0, pA0, pA1);
            write_k(0, kreg0, breg0); write_v(1, vreg1);
        } else {
            load_k(kt + 2, kreg0, breg0); load_v(kt + 2, vreg0);
            if (kt <= c) { compute_s(kt, 0, pA0, pA1); softmax_pv(0, pA0, pA1); }
            write_k(1, kreg1, breg1); write_v(1, vreg1);
        }
        PROF_T(pacc_c);
        __syncthreads();
        PROF_T(pacc_b);
        if (PIPE) {
            load_k(kt + 4, kreg0, breg0); load_v(kt + 3, vreg1);
            if (kt + 1 < c) { compute_s(kt + 2, 0, pA0, pA1); __builtin_amdgcn_sched_barrier(0); softmax_pv(1, pB0, pB1); }
            else if (kt + 1 == c) softmax_pv(1, pB0, pB1);
            write_k(1, kreg1, breg1); write_v(0, vreg0);
        } else {
            load_k(kt + 3, kreg1, breg1); load_v(kt + 3, vreg1);
            if (kt + 1 <= c) { compute_s(kt + 1, 1, pA0, pA1); softmax_pv(1, pA0, pA1); }
            write_k(0, kreg0, breg0); write_v(0, vreg0);
        }
        PROF_T(pacc_c);
        __syncthreads();
        PROF_T(pacc_b);
    }
#ifdef PROF_SEL
    const unsigned long long pl1 = __builtin_amdgcn_s_memrealtime();
#endif
    const float inv = 1.f / xhalf_sum(lsum);
    int tid2 = tid_in * 64 + lane_id_now(); asm volatile("" : "+v"(tid2));
    const int lane2 = tid2 & 63, hi2 = lane2 >> 5, qg2 = MODE == 0 ? ((tid2 >> 6) & 3) : (tid2 >> 6);
    const long qrow2 = tok0 + q0u + qg2 * 32 + (lane2 & 31);
    bf16* op = p.mixed16 + qrow2 * D_MODEL + (MODE == 0 ? 0 : (MODE == 1 ? 384 : 768)) + h * 64;
    if (MODE == 0) {
        LAS float* xb = (LAS float*)lds + qg2 * 2048 + lane2;
        if (map == 1) {
#pragma unroll
            for (int blk = 0; blk < 2; ++blk)
#pragma unroll
                for (int r = 0; r < 16; ++r) xb[(blk * 16 + r) * 64] = o[blk][r] * inv;
        }
        __syncthreads();
        if (map == 0) {
            const float lam_init = p.lam_init, lam = p.lam;
            float ss = 0.f;
#pragma unroll
            for (int blk = 0; blk < 2; ++blk)
#pragma unroll
                for (int r = 0; r < 16; ++r) { const float v = o[blk][r] * inv - lam * xb[(blk * 16 + r) * 64]; o[blk][r] = v; ss = fmaf(v, v, ss); }
            ss = xhalf_sum(ss);
            const float rr = rsqrtf(ss * (1.f / 64.f) + RMS_EPS) * (1.f - lam_init);
#pragma unroll
            for (int blk = 0; blk < 2; ++blk)
#pragma unroll
                for (int g = 0; g < 4; ++g) {
                    const int d = 32 * blk + 8 * g + 4 * hi2;
                    const float4 gv = *(const float4*)(p.gdiff + d);
                    v2u wv; wv.x = cvtpk(o[blk][4 * g] * rr * gv.x, o[blk][4 * g + 1] * rr * gv.y); wv.y = cvtpk(o[blk][4 * g + 2] * rr * gv.z, o[blk][4 * g + 3] * rr * gv.w);
                    *(v2u*)(op + d) = wv;
                }
        }
        __syncthreads();
    } else {
#pragma unroll
        for (int blk = 0; blk < 2; ++blk)
#pragma unroll
            for (int g = 0; g < 4; ++g) {
                const int d = 32 * blk + 8 * g + 4 * hi2;
                v2u wv; wv.x = cvtpk(o[blk][4 * g] * inv, o[blk][4 * g + 1] * inv); wv.y = cvtpk(o[blk][4 * g + 2] * inv, o[blk][4 * g + 3] * inv);
                *(v2u*)(op + d) = wv;
            }
    }
#ifdef PROF_SEL
    if (p.layer == 0 && blockIdx.x == 7 && w == PROF_WAVE && lane == 0) {
        unsigned* pw = p.prof; const unsigned long long pu1 = __builtin_amdgcn_s_memrealtime();
        atomicAdd(pw + 0, (unsigned)(pu1 - pu0)); atomicAdd(pw + 1, (unsigned)(pl1 - pl0)); atomicAdd(pw + 2, (unsigned)pacc_c); atomicAdd(pw + 3, (unsigned)pacc_b);
        atomicAdd(pw + 4, (unsigned)ntiles * 100u); atomicAdd(pw + 5, 10000u); atomicAdd(pw + 6, (unsigned)(c + 1) * 100u);
    }
#endif
}

typedef const __attribute__((address_space(4))) char* kargp_t;
__device__ __forceinline__ kargp_t karg_base() { kargp_t p = (kargp_t)__builtin_amdgcn_kernarg_segment_ptr(); asm volatile("" : "+s"(p)); return p; }
#define KARG(i) (*(const void* const __attribute__((address_space(4)))*)(kp + 8 * (i)))
#define KOUT (*(float* const __attribute__((address_space(4)))*)(kp + 224))
#define KWS (*(unsigned char* const __attribute__((address_space(4)))*)(kp + 232))
__device__ __forceinline__ void convert_layer_weights(const Args& a, int l, unsigned char* ws, LAS float* scr, int gw, int NGW, int lane) {
    const kargp_t kp = karg_base();
    const float* w_in = (const float*)KARG(3) + (size_t)l * D_MODEL * D_IN;
    const float* w_uq = (const float*)KARG(4) + (size_t)l * 256 * NQB;
    const float* w_ukv = (const float*)KARG(5) + (size_t)l * 128 * NKVB;
    const float* g_cq = (const float*)KARG(6) + l * 256;
    const float* g_ckv = (const float*)KARG(7) + l * 128;
    const float* w_out = (const float*)KARG(14) + (size_t)l * 1024 * 1024;
    transpose_rows(MapIn{w_in}, nullptr, ZP, 1024, (bf16*)(ws + WS_WIN), scr, gw, NGW, lane);
    transpose_rows(MapPlain{w_uq, NQB, NQB, 0.10206207261596575f * LOG2E_W}, g_cq, NQBP, 256, (bf16*)(ws + WS_WUQ), scr, gw, NGW, lane);
    transpose_rows(MapPlain{w_ukv, NKVB, NKVB, 1.f}, g_ckv, NKVB, 128, (bf16*)(ws + WS_WUKV), scr, gw, NGW, lane);
    transpose_rows(MapPlain{w_out, 1024, 1024, 1.f}, nullptr, 1024, 1024, (bf16*)(ws + WS_WOUT), scr, gw, NGW, lane);
    transpose_rows(MapPlain{(const float*)KARG(24) + (size_t)l * 1024 * 1024, 1024, 1024, 1.f}, nullptr, 1024, 1024, (bf16*)(ws + WS_WPG), scr, gw, NGW, lane);
    transpose_rows(MapPlain{(const float*)KARG(25) + (size_t)l * 256 * 1024, 1024, 1024, 1.f}, nullptr, 1024, 256, (bf16*)(ws + WS_WPP), scr, gw, NGW, lane);
    transpose_rows(MapGU{(const float*)KARG(21) + (size_t)l * 32 * 1024 * 256, (const float*)KARG(22) + (size_t)l * 32 * 1024 * 256}, nullptr, 32 * 512, 1024, (bf16*)(ws + WS_WGU), scr, gw, NGW, lane);
    transpose_rows(MapD{(const float*)KARG(23) + (size_t)l * 32 * 256 * 1024}, nullptr, 32 * 1024, 256, (bf16*)(ws + WS_WD), scr, gw, NGW, lane);
}

constexpr int LDS_MISC = 147456;
constexpr int PH_PER_LAYER = 10, NPH = 1 + DEPTH * PH_PER_LAYER;
template <int PH, bool DUMMY = false> __device__ __forceinline__ void run_phase(const Args& a, unsigned char* lds_raw, const int wave_s) {
    float* sm = (float*)lds_raw;
    const kargp_t kp = karg_base();
    const int G = gridDim.x, NGW = G * 8, NGT = G * NTHREADS;
    unsigned char* ws = KWS;
    const float* x0 = (const float*)KARG(0);
    const float* pin = (const float*)KARG(1);
    const int* pos = (const int*)KARG(2);
    float* cosT = (float*)(ws + WS_COS); float* sinT = (float*)(ws + WS_SIN);
    bf16* a16 = (bf16*)(ws + WS_A16); bf16* z16 = (bf16*)(ws + WS_Z16); bf16* qb16 = (bf16*)(ws + WS_QB16); bf16* kvb16 = (bf16*)(ws + WS_KVB16);
    bf16* krr16 = (bf16*)(ws + WS_KRR16); float* fcbuf = (float*)(ws + WS_FC); float* cum = (float*)(ws + WS_CUM); float* logf = (float*)(ws + WS_LOGF);
    float* rq = (float*)(ws + WS_RQ); float* rkv = (float*)(ws + WS_RKV);
    bf16* mixed16 = (bf16*)(ws + WS_MIXED16); bf16* mix16 = (bf16*)(ws + WS_MIX16);
    bf16* hs16 = (bf16*)(ws + WS_HS16); bf16* act16 = (bf16*)(ws + WS_ACT16); bf16* outs16 = (bf16*)(ws + WS_OUTS16); bf16* ple16 = (bf16*)(ws + WS_PLE16); bf16* pp16 = (bf16*)(ws + WS_PP16); bf16* p16 = (bf16*)(ws + WS_P16);
    int* ids = (int*)(ws + WS_RT + RT_IDS); float* wts = (float*)(ws + WS_RT + RT_WTS); int* rank = (int*)(ws + WS_RT + RT_RANK);
    int* slot_of = (int*)(ws + WS_RT + RT_SLOTOF); int* tile_e = (int*)(ws + WS_RT + RT_TILEE);
    unsigned* ctl = (unsigned*)(ws + WS_CTL);

        int tid = wave_s * 64 + lane_id_now(); asm volatile("" : "+v"(tid));
        const int lane = tid & 63, wave = __builtin_amdgcn_readfirstlane(tid >> 6);
        const int gw = blockIdx.x * 8 + wave, gtid = blockIdx.x * NTHREADS + tid;
        LAS float* scr = (LAS float*)((LAS unsigned char*)lds_raw + wave * 16384);
        if constexpr (PH == 0) {
            for (int i = gtid; i < NTOK * 16; i += NGT) {
                const int tk = i >> 4, j = i & 15;
                const int j4 = j >> 2, jr = j & 3;
                const double inv = (j4 == 0 ? 1.0 : (j4 == 1 ? 0.1 : (j4 == 2 ? 0.01 : 0.001))) * (jr == 0 ? 1.0 : (jr == 1 ? 0.5623413251903491 : (jr == 2 ? 0.31622776601683794 : 0.1778279410038923)));
                const double ang = (double)pos[tk] * inv;
                const double k = rint(ang * 0.15915494309189535);
                const double r = fma(-k, 6.283185307179586, ang) - k * 2.4492935982947064e-16;
                cosT[i] = cosf((float)r); sinT[i] = sinf((float)r);
            }
            auto cvt_stream = [&](const float* sp, bf16* dp, int n8) {
                for (int i = gtid; i < n8; i += 4 * NGT) {
                    f32x4_t v[8];
#pragma unroll
                    for (int u = 0; u < 4; ++u) { v[2 * u] = *(const f32x4_t*)(sp + (size_t)(i + u * NGT) * 8); v[2 * u + 1] = *(const f32x4_t*)(sp + (size_t)(i + u * NGT) * 8 + 4); }
#pragma unroll
                    for (int u = 0; u < 4; ++u) { v4u o; o.x = pk2(v[2 * u].x, v[2 * u].y); o.y = pk2(v[2 * u].z, v[2 * u].w); o.z = pk2(v[2 * u + 1].x, v[2 * u + 1].y); o.w = pk2(v[2 * u + 1].z, v[2 * u + 1].w);
                        *(v4u*)(dp + (size_t)(i + u * NGT) * 8) = o; }
                }
            };
            for (int i = gw; i < BATCH * 32; i += NGW) {
                int v = pos[i * 64 + lane];
#pragma unroll
                for (int o_ = 1; o_ < 64; o_ <<= 1) v = max(v, __shfl_xor(v, o_));
                if (lane == 0) ((int*)(ws + WS_RT + RT_TPMAX))[i] = v;
            }
            cvt_stream(x0, a16, NTOK * D_MODEL / 8);
            cvt_stream(pin, p16, DEPTH * NTOK * PLE_DIM / 8);
            convert_layer_weights(a, 0, ws, scr, gw, NGW, lane);
        } else {
            constexpr int l = (PH - 1) / PH_PER_LAYER, sp = (PH - 1) % PH_PER_LAYER;
            const float* b_forget = (const float*)KARG(13) + l * 4;
            const float* ln1_g = (const float*)KARG(15) + l * 1024; const float* ln1_b = (const float*)KARG(16) + l * 1024;
            const float* w_group = (const float*)KARG(17) + l * 1024 * 4; const float* b_group = (const float*)KARG(18) + l * 4;
            const float* w_er = (const float*)KARG(19) + (size_t)l * 4 * 1024 * 8; const float* b_er = (const float*)KARG(20) + l * 32;
            const float* ln2_g = (const float*)KARG(26) + l * 1024; const float* ln2_b = (const float*)KARG(27) + l * 1024;
            unsigned* cnt = ctl + CW_CNT + l * 2048 + (DUMMY ? 8192 : 0);
            if (DUMMY) rank = (int*)(ws + WS_RT + 512 * 1024);
            if constexpr (sp == 0) {
                pg8::Gemm g{a16, (const bf16*)(ws + WS_WIN), NTOK, ZP, 1024, 1024, 1024};
                pg8::StaticOrder S; S.init(NTOK, ZP, G, (int)blockIdx.x);
                pg8::EpiZ E{z16, ZP, fcbuf};
                pg8::gemm_phase<pg8::EpiZ, pg8::StaticOrder, true, true>((LAS unsigned char*)lds_raw, g, S, E, tid);
                {
                    pg8::Gemm g2{p16 + (size_t)l * NTOK * PLE_DIM, (const bf16*)(ws + WS_WPP), NTOK, 1024, 256, 256, 256};
                    const int bx = (int)blockIdx.x;
                    pg8::StaticOrder S2; S2.init(NTOK, 1024, G / 2, bx >= G / 2 ? bx - G / 2 : 1 << 20);
                    pg8::EpiBf16<0> E2{pp16, 1024, nullptr, 0, 0, 1.f};
                    pg8::gemm_phase<pg8::EpiBf16<0>, pg8::StaticOrder, true, true>((LAS unsigned char*)lds_raw, g2, S2, E2, tid);
                }
            } else if constexpr (sp == 1) {
                const int g16 = lane >> 4, l16 = lane & 15;
                for (int tk = gw * 4 + g16; tk < NTOK; tk += NGW * 4) {
                    const bf16* zr = z16 + (size_t)tk * ZP;
                    const v4u ca = *(const v4u*)(zr + Z_CQ + l16 * 16), cb = *(const v4u*)(zr + Z_CQ + l16 * 16 + 8);
                    const v4u ka = *(const v4u*)(zr + Z_CKV + l16 * 8);
                    const unsigned short kr1 = zr[Z_KR + l16], kr2 = zr[Z_KR + 16 + l16];
                    const float cs = cosT[tk * 16 + l16], sn = sinT[tk * 16 + l16];
                    const float fcv = fcbuf[tk * 4 + (l16 & 3)];
                    float f[8]; float ss = 0.f;
                    unpack8(ca, f);
#pragma unroll
                    for (int i = 0; i < 8; ++i) ss = fmaf(f[i], f[i], ss);
                    unpack8(cb, f);
#pragma unroll
                    for (int i = 0; i < 8; ++i) ss = fmaf(f[i], f[i], ss);
                    float s2 = 0.f;
                    unpack8(ka, f);
#pragma unroll
                    for (int i = 0; i < 8; ++i) s2 = fmaf(f[i], f[i], s2);
#pragma unroll
                    for (int o = 1; o < 16; o <<= 1) { ss += __shfl_xor(ss, o); s2 += __shfl_xor(s2, o); }
                    if (l16 == 0) { rq[tk] = rsqrtf(ss * (1.f / 256.f) + RMS_EPS); rkv[tk] = rsqrtf(s2 * (1.f / 128.f) + RMS_EPS); }
                    const float x1 = __uint_as_float((unsigned)kr1 << 16), x2 = __uint_as_float((unsigned)kr2 << 16);
                    krr16[tk * 32 + l16] = (bf16)f2bf(x1 * cs - x2 * sn); krr16[tk * 32 + 16 + l16] = (bf16)f2bf(x2 * cs + x1 * sn);
                    if (l16 < 4) {
                        const float xf = fcv + b_forget[l16];
                        logf[tk * 4 + l16] = fminf(xf, 0.f) - log1pf(expf(-fabsf(xf)));
                    }
                }
            } else if constexpr (sp == 2) {
                {
                    pg8::Gemm g{z16 + Z_CQ, (const bf16*)(ws + WS_WUQ), NTOK, NQBP, 256, ZP, 256};
                    pg8::StaticOrder S; S.init(NTOK, NQBP, G, (int)blockIdx.x);
                    pg8::EpiRowScale E{qb16, NQBP, rq};
                    pg8::gemm_phase<pg8::EpiRowScale, pg8::StaticOrder, true, true>((LAS unsigned char*)lds_raw, g, S, E, tid);
                }
                {
                    pg8::Gemm g{z16 + Z_CKV, (const bf16*)(ws + WS_WUKV), NTOK, NKVB, 128, ZP, 128};
                    pg8::StaticOrder S; S.init(NTOK, NKVB, G, (int)((blockIdx.x + 128) % G));
                    pg8::EpiRowScale E{kvb16, NKVB, rkv};
                    pg8::gemm_phase<pg8::EpiRowScale, pg8::StaticOrder, true, true>((LAS unsigned char*)lds_raw, g, S, E, tid);
                }
                const int cw = NGW - 1 - gw;
                if (cw < 32) {
                    const int b = cw >> 2, hh = cw & 3;
                    float* cp = cum + ((size_t)b * SEQ) * 4 + hh; const float* lp = logf + ((size_t)b * SEQ) * 4 + hh;
                    float loc[32]; float run = 0.f;
#pragma unroll
                    for (int i = 0; i < 32; ++i) { run += lp[(size_t)(lane * 32 + i) * 4]; loc[i] = run; }
                    float pre = run;
#pragma unroll
                    for (int o = 1; o < 64; o <<= 1) { const float n = __shfl_up(pre, o); if (lane >= o) pre += n; }
                    pre -= run;
#pragma unroll
                    for (int i = 0; i < 32; ++i) cp[(size_t)(lane * 32 + i) * 4] = loc[i] + pre;
                }
            } else if constexpr (sp == 3) {
                float lam_init_, lam_;
                {
                    const float* lq1 = (const float*)KARG(8) + l * 32; const float* lk1 = (const float*)KARG(9) + l * 32; const float* lq2 = (const float*)KARG(10) + l * 32; const float* lk2 = (const float*)KARG(11) + l * 32;
                    lam_init_ = 0.8f - 0.6f * expf(-0.3f * (float)l);
                    float s1 = 0.f, s2 = 0.f;
                    for (int i = 0; i < 32; ++i) { s1 += lq1[i] * lk1[i]; s2 += lq2[i] * lk2[i]; }
                    lam_ = expf(s1) - expf(s2) + lam_init_;
                }
                AttnP p{z16, qb16, kvb16, krr16, cum, cosT, sinT, pos, mixed16,
                        (const float*)KARG(8) + l * 32, (const float*)KARG(9) + l * 32, (const float*)KARG(10) + l * 32, (const float*)KARG(11) + l * 32,
                        (const float*)KARG(12) + l * 64, l, ctl + 14000, (const int*)(ws + WS_RT + RT_TPMAX), lam_, lam_init_};
                volatile LAS int* qslot = (volatile LAS int*)((LAS unsigned char*)lds_raw + LDS_MISC) + 48;
                unsigned* qctr = ctl + 12288 + l * 64 + (DUMMY ? 32 : 0);
                int idx = (int)blockIdx.x;
                for (;;) {
                    if (idx >= 1408) break;
                    int nxt_idx = 0;
                    if (wave_s == 0 && lane_id_now() == 0) nxt_idx = G + (int)atomicAdd(qctr, 1u);
                    const int pi = idx / 176, r = idx % 176, thi = 32 - 4 * pi;
                    if (r < 48) attn_unit<0>(p, r / 6, r % 6, thi / 2 - 1, (LAS unsigned char*)lds_raw, wave_s);
                    else if (r < 96) attn_unit<1>(p, (r - 48) / 6, (r - 48) % 6, thi / 4 - 1, (LAS unsigned char*)lds_raw, wave_s);
                    else if (r < 128) attn_unit<2>(p, (r - 96) / 4, (r - 96) % 4, thi / 4 - 1, (LAS unsigned char*)lds_raw, wave_s);
                    else attn_unit<0>(p, (r - 128) / 6, (r - 128) % 6, (thi - 2) / 2 - 1, (LAS unsigned char*)lds_raw, wave_s);
                    __syncthreads();
                    if (wave_s == 0 && lane_id_now() == 0) *qslot = nxt_idx;
                    __syncthreads();
                    idx = __builtin_amdgcn_readfirstlane(*qslot);
                }
            } else if constexpr (sp == 4) {
                pg8::Gemm g{mixed16, (const bf16*)(ws + WS_WOUT), NTOK, 1024, 1024, 1024, 1024};
                pg8::StaticOrder S; S.init(NTOK, 1024, G, (int)blockIdx.x);
                pg8::EpiBf16<0> E{mix16, 1024, nullptr, 0, 0, 1.f};
                pg8::gemm_phase<pg8::EpiBf16<0>, pg8::StaticOrder, true, true>((LAS unsigned char*)lds_raw, g, S, E, tid);
            } else if constexpr (sp == 5) {
#ifdef PROF_LN1
                if (l == 0 && blockIdx.x == 0 && tid == 0) ctl[14000 + 19] = (unsigned)(__builtin_amdgcn_s_memrealtime() & 0xffffffffu);
#endif
                LAS f32x4_t* Lg = (LAS f32x4_t*)lds_raw; LAS f32x4_t* Le = Lg + 1024;
                LAS unsigned* lcnt = (LAS unsigned*)((LAS unsigned char*)lds_raw + LDS_MISC) + 16;
                __syncthreads();
                if (tid < 32) lcnt[tid] = 0u;
                for (int k = tid; k < 1024; k += NTHREADS) { const int j = k >> 8, ln = (k & 255) >> 2, i = k & 3; Lg[(j * 4 + i) * 64 + ln] = *(const f32x4_t*)(w_group + (size_t)k * 4); }
                for (int q = tid; q < 4 * 1024 * 2; q += NTHREADS) { const int g = q >> 11, k = (q >> 1) & 1023, half = q & 1; const int j = k >> 8, ln = (k & 255) >> 2, i = k & 3;
                    Le[((g * 16 + j * 4 + i) * 2 + half) * 64 + ln] = *(const f32x4_t*)(w_er + (size_t)q * 4); }
                __syncthreads();
#ifdef PROF_LN1
                if (l == 0 && blockIdx.x == 0 && tid == 0) ctl[14000 + 20] = (unsigned)(__builtin_amdgcn_s_memrealtime() & 0xffffffffu);
#endif
                float4 xvA[4], xvB[4]; v2u mwA[4], mwB[4];
                auto ld_x = [&](int tk, int j) -> float4 {
                    if (l == 0) return *(const float4*)(x0 + (size_t)tk * D_MODEL + j * 256 + lane * 4);
                    const v2u xw = *(const v2u*)(a16 + (size_t)tk * D_MODEL + j * 256 + lane * 4);
                    return make_float4(bflo(xw.x), bfhi(xw.x), bflo(xw.y), bfhi(xw.y));
                };
                auto ld_tok = [&](int tk, float4 (&xv)[4], v2u (&mw)[4]) {
                    if (tk < NTOK) {
#pragma unroll
                        for (int j = 0; j < 4; ++j) { xv[j] = ld_x(tk, j); mw[j] = *(const v2u*)(mix16 + (size_t)tk * D_MODEL + j * 256 + lane * 4); }
                    }
                };
                auto do_tok = [&](int tk, float4 (&xv)[4], v2u (&mw)[4]) {
                    float4 v[4]; float s = 0.f;
#pragma unroll
                    for (int j = 0; j < 4; ++j) {
                        v[j] = make_float4(ALPHA * xv[j].x + bflo(mw[j].x), ALPHA * xv[j].y + bfhi(mw[j].x), ALPHA * xv[j].z + bflo(mw[j].y), ALPHA * xv[j].w + bfhi(mw[j].y));
                        s += (v[j].x + v[j].y) + (v[j].z + v[j].w);
                    }
                    ld_tok(tk + 2 * NGW, xv, mw);
                    const float mean = wave_sum(s) * (1.f / 1024.f); float s2 = 0.f;
#pragma unroll
                    for (int j = 0; j < 4; ++j) { v[j].x -= mean; v[j].y -= mean; v[j].z -= mean; v[j].w -= mean; s2 += (v[j].x * v[j].x + v[j].y * v[j].y) + (v[j].z * v[j].z + v[j].w * v[j].w); }
                    const float rstd = rsqrtf(wave_sum(s2) * (1.f / 1024.f) + LN_EPS);
                    float gl[4] = {0.f, 0.f, 0.f, 0.f};
#pragma unroll
                    for (int j = 0; j < 4; ++j) {
                        const int d0 = j * 256 + lane * 4;
                        const float4 gg = *(const float4*)(ln1_g + d0), bb = *(const float4*)(ln1_b + d0);
                        v[j] = make_float4(v[j].x * rstd * gg.x + bb.x, v[j].y * rstd * gg.y + bb.y, v[j].z * rstd * gg.z + bb.z, v[j].w * rstd * gg.w + bb.w);
                        { v2u hb; hb.x = pk2(v[j].x, v[j].y); hb.y = pk2(v[j].z, v[j].w); *(v2u*)(a16 + (size_t)tk * D_MODEL + d0) = hb; }
                        const float hv[4] = {v[j].x, v[j].y, v[j].z, v[j].w};
#pragma unroll
                        for (int i = 0; i < 4; ++i) {
                            const f32x4_t wg = Lg[(j * 4 + i) * 64 + lane];
                            gl[0] = fmaf(hv[i], wg.x, gl[0]); gl[1] = fmaf(hv[i], wg.y, gl[1]); gl[2] = fmaf(hv[i], wg.z, gl[2]); gl[3] = fmaf(hv[i], wg.w, gl[3]);
                        }
                    }
#pragma unroll
                    for (int i = 0; i < 4; ++i) gl[i] = wave_sum(gl[i]) + b_group[i];
                    int gi = 0; float gm = gl[0];
#pragma unroll
                    for (int i = 1; i < 4; ++i) if (gl[i] > gm) { gm = gl[i]; gi = i; }
                    gi = __builtin_amdgcn_readfirstlane(gi);
                    float gden = 0.f;
#pragma unroll
                    for (int i = 0; i < 4; ++i) gden += __expf(gl[i] - gm);
                    const float gwt = 1.f / gden;
                    float el[8] = {0.f, 0.f, 0.f, 0.f, 0.f, 0.f, 0.f, 0.f};
                    const LAS f32x4_t* we = Le + gi * 2048;
#pragma unroll
                    for (int j = 0; j < 4; ++j) {
                        const float hv[4] = {v[j].x, v[j].y, v[j].z, v[j].w};
#pragma unroll
                        for (int i = 0; i < 4; ++i) {
                            const f32x4_t w0 = we[((j * 4 + i) * 2) * 64 + lane], w1 = we[((j * 4 + i) * 2 + 1) * 64 + lane];
                            el[0] = fmaf(hv[i], w0.x, el[0]); el[1] = fmaf(hv[i], w0.y, el[1]); el[2] = fmaf(hv[i], w0.z, el[2]); el[3] = fmaf(hv[i], w0.w, el[3]);
                            el[4] = fmaf(hv[i], w1.x, el[4]); el[5] = fmaf(hv[i], w1.y, el[5]); el[6] = fmaf(hv[i], w1.z, el[6]); el[7] = fmaf(hv[i], w1.w, el[7]);
                        }
                    }
#pragma unroll
                    for (int i = 0; i < 8; ++i) el[i] = wave_sum(el[i]) + b_er[gi * 8 + i];
                    int i0 = 0; float v0 = el[0];
#pragma unroll
                    for (int i = 1; i < 8; ++i) if (el[i] > v0) { v0 = el[i]; i0 = i; }
                    int i1 = -1; float v1 = -INFINITY;
#pragma unroll
                    for (int i = 0; i < 8; ++i) if (i != i0 && el[i] > v1) { v1 = el[i]; i1 = i; }
                    const float e1 = __expf(v1 - v0);
                    const float w0 = gwt / (1.f + e1), w1 = gwt * e1 / (1.f + e1);
                    if (lane == 0) {
                        const int ea = gi * 8 + i0, eb = gi * 8 + i1;
                        ids[tk * 2] = ea; ids[tk * 2 + 1] = eb; wts[tk * 2] = w0; wts[tk * 2 + 1] = w1;
                        rank[tk * 2] = (int)__hip_atomic_fetch_add(lcnt + ea, 1u, __ATOMIC_RELAXED, __HIP_MEMORY_SCOPE_WORKGROUP);
                        rank[tk * 2 + 1] = (int)__hip_atomic_fetch_add(lcnt + eb, 1u, __ATOMIC_RELAXED, __HIP_MEMORY_SCOPE_WORKGROUP);
                    }
                };
                ld_tok(gw, xvA, mwA); ld_tok(gw + NGW, xvB, mwB);
                for (int tk = gw; tk < NTOK; tk += 2 * NGW) {
                    do_tok(tk, xvA, mwA);
                    if (tk + NGW < NTOK) do_tok(tk + NGW, xvB, mwB);
                }
#ifdef PROF_LN1
                if (l == 0 && blockIdx.x == 0 && tid == 0) ctl[14000 + 21] = (unsigned)(__builtin_amdgcn_s_memrealtime() & 0xffffffffu);
#endif
                __syncthreads();
                if (tid < 32) { const unsigned n = lcnt[tid]; lcnt[tid] = n ? atomicAdd(cnt + tid * 64, n) : 0u; }
                __syncthreads();
                if (lane == 0) for (int tk = gw; tk < NTOK; tk += NGW) { rank[tk * 2] += (int)lcnt[ids[tk * 2]]; rank[tk * 2 + 1] += (int)lcnt[ids[tk * 2 + 1]]; }
                __syncthreads();
            } else if constexpr (sp == 6) {
                int* offs = (int*)sm;
                __syncthreads();
                if (tid == 0) { int o = 0; for (int e = 0; e < 32; ++e) { offs[e] = o; o += ((int)cnt[e * 64] + 255) & ~255; } offs[32] = o; }
                __syncthreads();
                for (int i = gtid; i < NSLOT_TILES; i += NGT) { int e = -1; for (int k = 0; k < 32; ++k) if (i * 256 >= offs[k] && i * 256 < offs[k + 1]) e = k; tile_e[i] = e; }
                for (int i0 = gw * 4; i0 < NTOK * 2; i0 += NGW * 4) {
                    int sl[4]; v4u r0[4], r1[4];
#pragma unroll
                    for (int u = 0; u < 4; ++u) { const int i = i0 + u; sl[u] = offs[ids[i]] + rank[i]; }
#pragma unroll
                    for (int u = 0; u < 4; ++u) { const v4u* srow = (const v4u*)(a16 + (size_t)((i0 + u) >> 1) * D_MODEL); r0[u] = srow[lane]; r1[u] = srow[64 + lane]; }
                    if (lane < 4) slot_of[i0 + lane] = lane == 0 ? sl[0] : (lane == 1 ? sl[1] : (lane == 2 ? sl[2] : sl[3]));
#pragma unroll
                    for (int u = 0; u < 4; ++u) { v4u* drow = (v4u*)(hs16 + (size_t)sl[u] * D_MODEL); drow[lane] = r0[u]; drow[64 + lane] = r1[u]; }
                }
                __syncthreads();
            } else if constexpr (sp == 7) {
                int T = 0; for (int e = 0; e < 32; ++e) T += ((int)cnt[e * 64] + 255) >> 8;
                T = __builtin_amdgcn_readfirstlane(T);
                const int vc = (int)((blockIdx.x % 8) * (G / 8) + blockIdx.x / 8);
                int nB2 = 2 * T - G; nB2 = nB2 < 0 ? 0 : nB2;
                {
                    pg8::Gemm g{a16, (const bf16*)(ws + WS_WPG), NTOK, 1024, 1024, 1024, 1024};
                    pg8::XSched S{tile_e, 2 * T, G, vc};
                    pg8::EpiX E{pg8::EpiGU{act16}, pg8::EpiPleGate{ple16, pp16}};
                    pg8::gemm_phase<pg8::EpiX, pg8::XSched, true, true>((LAS unsigned char*)lds_raw, g, S, E, tid);
                }
            } else if constexpr (sp == 8) {
                int T = 0; for (int e = 0; e < 32; ++e) T += ((int)cnt[e * 64] + 255) >> 8;
                T = __builtin_amdgcn_readfirstlane(T);
                const int vc = (int)((blockIdx.x % 8) * (G / 8) + blockIdx.x / 8);
                int nB2 = 2 * T - G; nB2 = nB2 < 0 ? 0 : nB2;
                if (vc >= nB2) {
                    pg8::Gemm g{act16, (const bf16*)(ws + WS_WD), MAX_SLOTS, 32 * 1024, 256, 256, 256};
                    pg8::GroupSched S{tile_e, T, 4, G - nB2, vc - nB2};
                    pg8::EpiDown E{outs16};
                    pg8::gemm_phase<pg8::EpiDown, pg8::GroupSched, true, true>((LAS unsigned char*)lds_raw, g, S, E, tid);
                } else {
                    const int k = 256 - nB2 + vc;
                    pg8::Gemm g{a16, (const bf16*)(ws + WS_WPG), NTOK, 1024, 1024, 1024, 1024};
                    pg8::OneUnit S{k >> 2, k & 3};
                    pg8::EpiPleGate E{ple16, pp16};
                    pg8::gemm_phase<pg8::EpiPleGate, pg8::OneUnit, true, true>((LAS unsigned char*)lds_raw, g, S, E, tid);
                }
            } else if constexpr (sp == 9) {
                struct Ln2Regs { v2u hv[4], oa[4], ob[4], pv[4]; float w0, w1; };
                Ln2Regs RA, RB;
                auto ld_rows = [&](int tk, Ln2Regs& R) {
                    if (tk < NTOK) {
                        const int s0 = slot_of[tk * 2], s1 = slot_of[tk * 2 + 1]; R.w0 = wts[tk * 2]; R.w1 = wts[tk * 2 + 1];
#pragma unroll
                        for (int j = 0; j < 4; ++j) {
                            const int d0 = j * 256 + lane * 4;
                            R.hv[j] = *(const v2u*)(a16 + (size_t)tk * D_MODEL + d0);
                            R.oa[j] = *(const v2u*)(outs16 + (size_t)s0 * D_MODEL + d0); R.ob[j] = *(const v2u*)(outs16 + (size_t)s1 * D_MODEL + d0);
                            R.pv[j] = *(const v2u*)(ple16 + (size_t)tk * D_MODEL + d0);
                        }
                    }
                };
                auto do_row = [&](int tk, Ln2Regs& R) {
                    float4 v[4]; float s = 0.f; const float w0 = R.w0, w1 = R.w1;
#pragma unroll
                    for (int j = 0; j < 4; ++j) {
                        v[j] = make_float4(ALPHA * bflo(R.hv[j].x) + w0 * bflo(R.oa[j].x) + w1 * bflo(R.ob[j].x) + bflo(R.pv[j].x), ALPHA * bfhi(R.hv[j].x) + w0 * bfhi(R.oa[j].x) + w1 * bfhi(R.ob[j].x) + bfhi(R.pv[j].x),
                                           ALPHA * bflo(R.hv[j].y) + w0 * bflo(R.oa[j].y) + w1 * bflo(R.ob[j].y) + bflo(R.pv[j].y), ALPHA * bfhi(R.hv[j].y) + w0 * bfhi(R.oa[j].y) + w1 * bfhi(R.ob[j].y) + bfhi(R.pv[j].y));
                        s += (v[j].x + v[j].y) + (v[j].z + v[j].w);
                    }
                    ld_rows(tk + 2 * NGW, R);
                    const float mean = wave_sum(s) * (1.f / 1024.f); float s2 = 0.f;
#pragma unroll
                    for (int j = 0; j < 4; ++j) { v[j].x -= mean; v[j].y -= mean; v[j].z -= mean; v[j].w -= mean; s2 += (v[j].x * v[j].x + v[j].y * v[j].y) + (v[j].z * v[j].z + v[j].w * v[j].w); }
                    const float rstd = rsqrtf(wave_sum(s2) * (1.f / 1024.f) + LN_EPS);
#pragma unroll
                    for (int j = 0; j < 4; ++j) {
                        const int d0 = j * 256 + lane * 4;
                        const float4 gg = *(const float4*)(ln2_g + d0), bb = *(const float4*)(ln2_b + d0);
                        const float4 o = make_float4(v[j].x * rstd * gg.x + bb.x, v[j].y * rstd * gg.y + bb.y, v[j].z * rstd * gg.z + bb.z, v[j].w * rstd * gg.w + bb.w);
                        if (!DUMMY || w0 == 12345.678f) {
                        if (l == DEPTH - 1) {
#ifdef PROF_SEL
#ifdef PROF_LN1
                        float4 oo = o; { const float dlt = sqrtf((float)(ctl[14000 + PROF_LN1 + 1] - ctl[14000 + PROF_LN1]) * 1e-8f);
#else
                        float4 oo = o; { const float dlt = sqrtf((float)ctl[14000 + PROF_SEL] * 1e-8f);
#endif
                        oo.x += dlt; oo.y += dlt; oo.z += dlt; oo.w += dlt; }
                        *(float4*)(KOUT + (size_t)tk * D_MODEL + d0) = oo;
#else
                        *(float4*)(KOUT + (size_t)tk * D_MODEL + d0) = o;
#endif
                        } else {
                        v2u ob16; ob16.x = pk2(o.x, o.y); ob16.y = pk2(o.z, o.w);
                        *(v2u*)(a16 + (size_t)tk * D_MODEL + d0) = ob16;
                        }
                        }
                    }
                };
                ld_rows(gw, RA); ld_rows(gw + NGW, RB);
                for (int tk = gw; tk < NTOK; tk += 2 * NGW) {
                    do_row(tk, RA);
                    if (tk + NGW < NTOK) do_row(tk + NGW, RB);
                }
                if (l + 1 < DEPTH) convert_layer_weights(a, l + 1, ws, scr, gw, NGW, lane);
            }
        }
}

constexpr int CW_BAR = 4096;
__global__ void __launch_bounds__(NTHREADS, 2) mega(Args a) {
    extern __shared__ __attribute__((aligned(16))) unsigned char lds_raw[];
    cg::grid_group grid = cg::this_grid();
    volatile LAS unsigned* misc = (volatile LAS unsigned*)((LAS unsigned char*)lds_raw + LDS_MISC);
    if (threadIdx.x < 16) misc[threadIdx.x] = 0u;
    __syncthreads();
    XcdBarrier bar = xcd_barrier_post((unsigned*)(a.ws + WS_CTL) + CW_BAR, misc + 8);
    const int wave_s = __builtin_amdgcn_readfirstlane(threadIdx.x >> 6);
#define IS_T0 (wave_s == 0 && lane_id_now() == 0)
#ifndef DUP_SP
#define DUP_SP -1
#endif
#ifndef DUP_X
#define DUP_X 0
#endif
    if (a.ph_hi < 0) grid.sync();
#define SEAM(ph) do { xcd_barrier(bar, IS_T0); } while (0)
#ifdef PROF_PH
    unsigned long long ph_t_prev = __builtin_amdgcn_s_memrealtime();
#define PHASE_STAMP(ph) do { const unsigned long long t_ = __builtin_amdgcn_s_memrealtime(); if ((ph) == PROF_PH && blockIdx.x == 0 && IS_T0) ((unsigned*)(a.ws + WS_CTL))[14000 + PROF_SEL] = (unsigned)(t_ - ph_t_prev); ph_t_prev = t_; } while (0)
#else
#define PHASE_STAMP(ph) do {} while (0)
#endif
#define RUN(ph) if (a.ph_lo <= (ph) && (ph) < a.ph_hi) { \
        if (DUP_X == 9 && (ph) > 0 && ((ph) - 1) % PH_PER_LAYER == 9) { run_phase<ph, true>(a, lds_raw, wave_s); xcd_barrier(bar, IS_T0); } \
        run_phase<ph>(a, lds_raw, wave_s); \
        if ((ph) > 0 && ((ph) - 1) % PH_PER_LAYER == DUP_SP) { xcd_barrier(bar, IS_T0); run_phase<ph>(a, lds_raw, wave_s); } \
        if (DUP_X == 100 && (ph) == 0) { xcd_barrier(bar, IS_T0); run_phase<ph>(a, lds_raw, wave_s); } \
        if (DUP_X == 5 && (ph) == 6) { xcd_barrier(bar, IS_T0); run_phase<ph, true>(a, lds_raw, wave_s); } \
        if (DUP_X == 3 && (ph) > 0 && ((ph) - 1) % PH_PER_LAYER == 3) { xcd_barrier(bar, IS_T0); run_phase<ph, true>(a, lds_raw, wave_s); } \
        if ((ph) + 1 < a.ph_hi && (ph) + 1 < NPH) SEAM(ph); PHASE_STAMP(ph); }
    RUN(0) RUN(1) RUN(2) RUN(3) RUN(4) RUN(5) RUN(6) RUN(7) RUN(8) RUN(9) RUN(10)
    RUN(11) RUN(12) RUN(13) RUN(14) RUN(15) RUN(16) RUN(17) RUN(18) RUN(19) RUN(20)
#undef RUN
#undef SEAM
}

extern "C" void kernel_launch(void* const* d_in, const int* in_sizes, int n_in, void* d_out, int out_size, void* d_ws, size_t ws_size, hipStream_t stream) {
    static int grid = 0;
    if (grid == 0) {
        if (n_in != 28 || ws_size < WS_END) { fprintf(stderr, "kernel_launch: unexpected n_in %d or ws_size %zu (< %zu)\n", n_in, ws_size, (size_t)WS_END); grid = -1; return; }
        int dev = 0, cus = 0, per_cu = 0;
        (void)hipGetDevice(&dev);
        (void)hipDeviceGetAttribute(&cus, hipDeviceAttributeMultiprocessorCount, dev);
        (void)hipFuncSetAttribute((const void*)mega, hipFuncAttributeMaxDynamicSharedMemorySize, LDS_BYTES);
        (void)hipOccupancyMaxActiveBlocksPerMultiprocessor(&per_cu, (const void*)mega, NTHREADS, LDS_BYTES);
        if (per_cu < 1) { fprintf(stderr, "kernel_launch: occupancy query says %d blocks/CU\n", per_cu); }
        (void)hipGetLastError();
        grid = cus;
    }
    if (grid < 0) return;
    (void)hipMemsetAsync((char*)d_ws + WS_CTL, 0, 64 * 1024, stream);
    Args a{};
    for (int i = 0; i < 28; ++i) a.in[i] = d_in[i];
    a.out = (float*)d_out; a.ws = (unsigned char*)d_ws; a.ph_lo = 0; a.ph_hi = NPH;
    void* params[] = {&a};
    hipError_t e = hipLaunchCooperativeKernel((const void*)mega, dim3(grid), dim3(NTHREADS), params, LDS_BYTES, stream);
    if (e != hipSuccess) fprintf(stderr, "cooperative launch failed: %s (grid %d)\n", hipGetErrorString(e), grid);
}
```

```cpp
#include <hip/hip_runtime.h>
#include <hip/hip_cooperative_groups.h>
#include <cstdio>
#include <cstdint>
namespace cg = cooperative_groups;

constexpr int D_MODEL = 1024, BATCH = 8, SEQ = 2048, NTOK = BATCH * SEQ, DEPTH = 2;
constexpr int D_IN = 2340;
constexpr int OFF_QA = 0, OFF_KA = 384, OFF_VA = 768, OFF_CQ = 1152, OFF_CKV = 1408, OFF_KR = 1536,
              OFF_QC = 1568, OFF_KC = 1824, OFF_VC = 2080, OFF_FC = 2336;
constexpr int ZP = 2560;
constexpr int Z_QA = 0, Z_KA = 384, Z_VA = 768, Z_QC = 1152, Z_KC = 1408, Z_VC = 1664, Z_CKV = 1920, Z_CQ = 2048, Z_KR = 2304, Z_FC = 2336;
constexpr int NQB = 576, NKVB = 768, NQBP = 768;
constexpr int N_EXPERTS = 32, D_EXPERT = 256, PLE_DIM = 256;
constexpr int MAX_SLOTS = 32768 + 32 * 256;
constexpr int NSLOT_TILES = MAX_SLOTS / 256;
constexpr float ALPHA = 1.4142135623730951f;
constexpr float LN_EPS = 1e-5f, RMS_EPS = 1e-6f;
constexpr int NTHREADS = 512;
constexpr int LDS_BYTES = 147456 + 256;

constexpr size_t MiB = 1u << 20;
constexpr size_t WS_CTL = 0;
constexpr size_t WS_COS = 1 * MiB, WS_SIN = 2 * MiB;
constexpr size_t WS_WIN = 3 * MiB;
constexpr size_t WS_WUQ = 8 * MiB;
constexpr size_t WS_WUKV = WS_WUQ + 393216;
constexpr size_t WS_WOUT = 9 * MiB;
constexpr size_t WS_WPG = 11 * MiB;
constexpr size_t WS_WPP = 13 * MiB;
constexpr size_t WS_WGU = 14 * MiB;
constexpr size_t WS_WD = 46 * MiB;
constexpr size_t WS_A16 = 62 * MiB;
constexpr size_t WS_P16 = 94 * MiB;
constexpr size_t WS_Z16 = 110 * MiB;
constexpr size_t WS_HS16 = WS_Z16;
constexpr size_t WS_OUTS16 = WS_Z16;
constexpr size_t WS_QB16 = 190 * MiB;
constexpr size_t WS_KVB16 = 214 * MiB;
constexpr size_t WS_KRR16 = 238 * MiB;
constexpr size_t WS_FC = 239 * MiB;
constexpr size_t WS_CUM = WS_FC + 256 * 1024;
constexpr size_t WS_LOGF = WS_CUM + 256 * 1024;
constexpr size_t WS_RQ = WS_LOGF + 256 * 1024;
constexpr size_t WS_RKV = WS_RQ + 64 * 1024;
constexpr size_t WS_MIX16 = 190 * MiB;
constexpr size_t WS_PP16 = 276 * MiB;
constexpr size_t WS_ACT16 = 222 * MiB;
constexpr size_t WS_MIXED16 = 242 * MiB;
constexpr size_t WS_PLE16 = 242 * MiB;
constexpr size_t WS_RT = 274 * MiB;
constexpr size_t WS_ETOK = 308 * MiB;
constexpr size_t WS_END = 310 * MiB;
constexpr size_t RT_IDS = 0, RT_WTS = 128 * 1024, RT_RANK = 256 * 1024, RT_SLOTOF = 384 * 1024, RT_TILEE = 768 * 1024, RT_TPMAX = 800 * 1024;
constexpr int CW_CNT = 0;
static_assert((WS_A16 - WS_HS16) % (256 * 1024 * 2) == 0 || true, "");

struct Args { const void* in[28]; float* out; unsigned char* ws; int ph_lo, ph_hi; };

#define LAS __attribute__((address_space(3)))
typedef unsigned short bf16;
typedef unsigned v4u __attribute__((ext_vector_type(4)));
typedef unsigned v2u __attribute__((ext_vector_type(2)));
typedef float f32x4_t __attribute__((ext_vector_type(4)));

__device__ __forceinline__ float wave_sum(float v) {
#define WS_DPP(ctrl, rmask) __builtin_bit_cast(float, __builtin_amdgcn_update_dpp(0, __builtin_bit_cast(int, v), (ctrl), (rmask), 0xf, true))
    v += WS_DPP(0x111, 0xf);
    v += WS_DPP(0x112, 0xf);
    v += WS_DPP(0x114, 0xf);
    v += WS_DPP(0x118, 0xf);
    v += WS_DPP(0x142, 0xa);
    v += WS_DPP(0x143, 0xc);
#undef WS_DPP
    return __builtin_bit_cast(float, __builtin_amdgcn_readlane(__builtin_bit_cast(int, v), 63));
}
__device__ __forceinline__ unsigned f2bf(float f) { unsigned u = __builtin_bit_cast(unsigned, f); return (u + 0x7fffu + ((u >> 16) & 1u)) >> 16; }
__device__ __forceinline__ unsigned pk2(float lo, float hi) { return f2bf(lo) | (f2bf(hi) << 16); }
__device__ __forceinline__ float bflo(unsigned w) { return __uint_as_float(w << 16); }
__device__ __forceinline__ float bfhi(unsigned w) { return __uint_as_float(w & 0xffff0000u); }
__device__ __forceinline__ void unpack8(const v4u w, float* f) { f[0] = bflo(w.x); f[1] = bfhi(w.x); f[2] = bflo(w.y); f[3] = bfhi(w.y); f[4] = bflo(w.z); f[5] = bfhi(w.z); f[6] = bflo(w.w); f[7] = bfhi(w.w); }
__device__ __forceinline__ int lane_id_now() { int l; asm volatile("v_mbcnt_lo_u32_b32 %0, -1, 0\n\tv_mbcnt_hi_u32_b32 %0, -1, %0" : "=v"(l)); return l; }
namespace pg8 {
#define PG8_LAS __attribute__((address_space(3)))
typedef unsigned short bf16_t;
typedef short bf16x8 __attribute__((ext_vector_type(8)));
typedef float f32x4 __attribute__((ext_vector_type(4)));
typedef unsigned u32x4 __attribute__((ext_vector_type(4)));
constexpr int BM = 256, BK = 64, HALF = 128, HTB = HALF * BK * 2  , STAGE_BYTES = 8 * HTB, NXCD = 8, WGM = 8;

__host__ __device__ __forceinline__ int lds_byte(int r, int c) { const int st = (r >> 4) * 2 + (c >> 5), rr = r & 15, cc = c & 31, ob = rr * 64 + cc * 2; return st * 1024 + (ob ^ (((ob >> 9) & 1) << 5)); }
__host__ __device__ __forceinline__ void stage_rc(int b, int& R, int& C) { const int st = b / 1024, sb = b % 1024, swz = sb ^ (((sb >> 9) & 1) << 5); R = (st >> 1) * 16 + swz / 64; C = (st & 1) * 32 + (swz % 64) / 2; }
__host__ __device__ __forceinline__ int perm32(int rho) { const int n = rho >> 4, i = rho & 15; return 8 * (i >> 2) + 4 * n + (i & 3); }

struct Unit { int pm, pn; };
struct Gemm { const bf16_t* A; const bf16_t* Bt; int M, N, K, lda, ldb; };

struct StaticOrder {
    int nM, nN, nwg, G, c;
    __host__ __device__ void init(int M, int N, int G_, int c_) { nM = M / BM; nN = N / BM; nwg = nM * nN; G = G_; c = c_; }
    __host__ __device__ bool next(int i, Unit& u) const {
        const long L = (long)i * G + c; if (L >= nwg) return false;
        int wgid = (int)L; { const int q = nwg / NXCD, r = nwg % NXCD, xcd = wgid % NXCD, off = wgid / NXCD; wgid = (xcd < r ? xcd * (q + 1) : r * (q + 1) + (xcd - r) * q) + off; }
        const int nig = WGM * nN, gid = wgid / nig, fm = gid * WGM, gsz = (nM - fm) < WGM ? (nM - fm) : WGM;
        u.pm = fm + ((wgid % nig) % gsz); u.pn = (wgid % nig) / gsz; return true;
    }
    __device__ __forceinline__ void a_ready(const Unit&) const {}
    __device__ __forceinline__ void done(const Unit&) const {}
};

__device__ __forceinline__ unsigned cvt_pk_bf16(float lo, float hi) { unsigned r; asm volatile("v_cvt_pk_bf16_f32 %0, %1, %2" : "=v"(r) : "v"(lo), "v"(hi)); return r; }
typedef float f32x2 __attribute__((ext_vector_type(2)));
__device__ __forceinline__ f32x2 gelu_pk(f32x2 v) {
    const f32x2 av = __builtin_elementwise_abs(v), d = av * 0.2316418882f + 1.0f;
    f32x2 t; t.x = __builtin_amdgcn_rcpf(d.x); t.y = __builtin_amdgcn_rcpf(d.y);
    f32x2 q = t * 0.5307027145f + (-0.7265760135f); q = q * t + 0.7107068705f; q = q * t + (-0.142248368f); q = q * t + 0.127414796f; q = q * t;
    const f32x2 s = (v * v) * (-0.72134752044f);
    f32x2 e; e.x = __builtin_amdgcn_exp2f(s.x); e.y = __builtin_amdgcn_exp2f(s.y);
    const f32x2 m = v * (q * e), r = v - m;
    f32x2 o; o.x = v.x < 0.f ? m.x : r.x; o.y = v.y < 0.f ? m.y : r.y; return o;
}

template <int ACT  > struct EpiBf16 {
    static constexpr bool PERM = true, AFTER_DRAIN = false; static_assert(ACT == 0 || ACT == 1, "EpiBf16: ACT is 0 (none) or 1 (gelu_pk)");
    bf16_t* O; int ldc; const float* bias; int split_cols; size_t split_stride; float scale0;
    __device__ __forceinline__ void operator()(const f32x4 (&acc)[2][2][4][2], const Unit& u, int wr, int wc, int fr, int fq) const {
        const int row0 = u.pm * BM + wr * 64 + fr; int colt = u.pn * BM; bf16_t* base = O;
        float sc = 1.f; if (split_cols) { const int t = colt / split_cols; base += (size_t)t * split_stride; colt -= t * split_cols; if (t == 0) sc = scale0; }
        const int col0 = colt + wc * 32 + 8 * fq, bcol0 = u.pn * BM + wc * 32 + 8 * fq;
        f32x4 bv[2][2];
#pragma unroll
        for (int bj = 0; bj < 2; ++bj)
#pragma unroll
            for (int n = 0; n < 2; ++n) bv[bj][n] = bias ? *(const f32x4*)(bias + bcol0 + bj * HALF + 4 * n) : (f32x4){0.f, 0.f, 0.f, 0.f};
#pragma unroll
        for (int ai = 0; ai < 2; ++ai)
#pragma unroll
            for (int m = 0; m < 4; ++m) { bf16_t* rowp = base + (size_t)(row0 + ai * HALF + m * 16) * ldc + col0;
#pragma unroll
                for (int bj = 0; bj < 2; ++bj) { f32x4 v0 = acc[ai][bj][m][0] + bv[bj][0], v1 = acc[ai][bj][m][1] + bv[bj][1];
                    if (ACT == 1) { f32x2 a = gelu_pk((f32x2){v0[0], v0[1]}), b = gelu_pk((f32x2){v0[2], v0[3]}), c = gelu_pk((f32x2){v1[0], v1[1]}), d = gelu_pk((f32x2){v1[2], v1[3]});
                        v0 = (f32x4){a.x, a.y, b.x, b.y}; v1 = (f32x4){c.x, c.y, d.x, d.y}; }
                    v0 = v0 * sc; v1 = v1 * sc; u32x4 w; w.x = cvt_pk_bf16(v0[0], v0[1]); w.y = cvt_pk_bf16(v0[2], v0[3]); w.z = cvt_pk_bf16(v1[0], v1[1]); w.w = cvt_pk_bf16(v1[2], v1[3]);
                    *(u32x4*)(rowp + bj * HALF) = w; } }
    }
};
template <class Epi, class Sched, bool ALIGN_EPI = false, bool SP2 = false>
__device__ __forceinline__ void gemm_phase(PG8_LAS unsigned char* lds, const Gemm g, const Sched& S, const Epi& E, const int tid) {
    const int wid = __builtin_amdgcn_readfirstlane(tid >> 6), lane = tid & 63, wr = wid >> 2, wc = wid & 3, fr = lane & 15, fq = lane >> 4;
    int K = g.K; asm volatile("" : "+s"(K));
    const int nt = K / BK;
    unsigned voffA[2], voffB[2];
#pragma unroll
    for (int i = 0; i < 2; ++i) { int R, C; stage_rc(tid * 16 + i * 8192, R, C); const int Rb = Epi::PERM ? ((R & ~31) + perm32(R & 31)) : R;
        voffA[i] = (unsigned)(R * g.lda + C) * 2u; voffB[i] = (unsigned)(Rb * g.ldb + C) * 2u; }
    const size_t kstep = (size_t)(BK * 2);
    const size_t hstepA = (size_t)HALF * g.lda * 2, hstepB = (size_t)HALF * g.ldb * 2;
    const size_t tstepA = 2 * hstepA, tstepB = 2 * hstepB;
    const unsigned ldsw = (unsigned)wid * 1024u;
    const int aoff = lds_byte(wr * 64 + fr, fq * 8), boff = lds_byte(wc * 32 + fr, fq * 8);
#define PG8_SA(b, h) (((b) * 2 + (h)) * HTB)
#define PG8_SB(b, h) ((4 + (b) * 2 + (h)) * HTB)
#define PG8_STAGE(bufoff, gbase, voff) do { _Pragma("unroll") for (int _i = 0; _i < 2; ++_i) \
        __builtin_amdgcn_global_load_lds((const unsigned*)((const char*)(gbase) + (voff)[_i]), (PG8_LAS unsigned*)(lds + (bufoff) + ldsw + _i * 8192), 16, 0, 0); } while (0)
#define PG8_LDA(dst, b, h) do { _Pragma("unroll") for (int m = 0; m < 4; ++m) _Pragma("unroll") for (int k = 0; k < 2; ++k) dst[m][k] = *(const PG8_LAS bf16x8*)(lds + PG8_SA(b, h) + aoff + m * 2048 + k * 1024); } while (0)
#define PG8_LDB(dst, b, h) do { _Pragma("unroll") for (int n = 0; n < 2; ++n) _Pragma("unroll") for (int k = 0; k < 2; ++k) dst[n][k] = *(const PG8_LAS bf16x8*)(lds + PG8_SB(b, h) + boff + n * 2048 + k * 1024); } while (0)
#define PG8_MMA(ai, bj, At, Bt) do { __builtin_amdgcn_s_setprio(1); _Pragma("unroll") for (int m = 0; m < 4; ++m) _Pragma("unroll") for (int n = 0; n < 2; ++n) _Pragma("unroll") for (int k = 0; k < 2; ++k) \
        acc[ai][bj][m][n] = __builtin_amdgcn_mfma_f32_16x16x32_bf16(Bt[n][k], At[m][k], acc[ai][bj][m][n], 0, 0, 0); __builtin_amdgcn_s_setprio(0); } while (0)
#define PG8_WAIT_V(n) asm volatile("s_waitcnt vmcnt(" #n ")" ::: "memory")
#define PG8_WAIT_L(n) asm volatile("s_waitcnt lgkmcnt(" #n ")" ::: "memory")
#define PG8_BAR __builtin_amdgcn_s_barrier()
#define PG8_SCHED __builtin_amdgcn_sched_barrier(0)
    Unit cur, nxt; int ui = 0;
    if (!S.next(0, cur)) return;
    f32x4 acc[2][2][4][2];
#pragma unroll
    for (int a = 0; a < 2; ++a)
#pragma unroll
        for (int b = 0; b < 2; ++b)
#pragma unroll
            for (int m = 0; m < 4; ++m)
#pragma unroll
                for (int n = 0; n < 2; ++n) acc[a][b][m][n] = (f32x4){0.f, 0.f, 0.f, 0.f};
    bf16x8 At[4][2], B0[2][2], B1[2][2];
    const char* cA = (const char*)g.A + (size_t)cur.pm * tstepA; const char* cB = (const char*)g.Bt + (size_t)cur.pn * tstepB;
    S.a_ready(cur);
    if constexpr (SP2) {
        PG8_STAGE(PG8_SB(0, 0), cB, voffB); PG8_STAGE(PG8_SB(0, 1), cB + hstepB, voffB); PG8_STAGE(PG8_SA(0, 0), cA, voffA); PG8_STAGE(PG8_SA(0, 1), cA + hstepA, voffA);
        if (wr == 1) PG8_BAR;
        PG8_WAIT_V(2); PG8_BAR;
        PG8_STAGE(PG8_SB(1, 0), cB + kstep, voffB); PG8_STAGE(PG8_SA(1, 0), cA + kstep, voffA); PG8_STAGE(PG8_SB(1, 1), cB + hstepB + kstep, voffB);
        PG8_WAIT_V(6); PG8_BAR;
    } else {
        PG8_STAGE(PG8_SB(0, 0), cB, voffB); PG8_STAGE(PG8_SA(0, 0), cA, voffA); PG8_STAGE(PG8_SB(0, 1), cB + hstepB, voffB); PG8_STAGE(PG8_SA(0, 1), cA + hstepA, voffA);
        if (wr == 1) PG8_BAR;
        PG8_WAIT_V(4); PG8_BAR;
        PG8_STAGE(PG8_SB(1, 0), cB + kstep, voffB); PG8_STAGE(PG8_SA(1, 0), cA + kstep, voffA); PG8_STAGE(PG8_SB(1, 1), cB + hstepB + kstep, voffB);
        PG8_WAIT_V(6); PG8_BAR;
    }
    for (;;) {
        const bool has_next = S.next(ui + 1, nxt);
        const char* nA = has_next ? (const char*)g.A + (size_t)nxt.pm * tstepA : cA; const char* nB = has_next ? (const char*)g.Bt + (size_t)nxt.pn * tstepB : cB;
        for (int t = 0; t < nt; t += 2) {
            const bool last = (t == nt - 2);
            const char* a1 = cA + (size_t)(t + 1) * kstep;
            const char* a2 = last ? nA : cA + (size_t)(t + 2) * kstep; const char* b2 = last ? nB : cB + (size_t)(t + 2) * kstep;
            const char* a3 = a2 + kstep; const char* b3 = b2 + kstep;
            if (last && has_next) S.a_ready(nxt);
            if constexpr (SP2) {
            PG8_LDB(B0, 0, 0); PG8_LDB(B1, 0, 1); PG8_SCHED; PG8_LDA(At, 0, 0); PG8_STAGE(PG8_SA(1, 1), a1 + hstepA, voffA);
            PG8_WAIT_V(8); PG8_WAIT_L(0); PG8_BAR; PG8_MMA(0, 0, At, B0); PG8_MMA(0, 1, At, B1); PG8_BAR; PG8_SCHED;
            PG8_LDA(At, 0, 1); PG8_STAGE(PG8_SB(0, 0), b2, voffB); PG8_STAGE(PG8_SB(0, 1), b2 + hstepB, voffB); PG8_STAGE(PG8_SA(0, 0), a2, voffA);
            PG8_WAIT_V(8); PG8_WAIT_L(0); PG8_BAR; PG8_MMA(1, 0, At, B0); PG8_MMA(1, 1, At, B1); PG8_BAR; PG8_SCHED;
            PG8_LDB(B0, 1, 0); PG8_LDB(B1, 1, 1); PG8_SCHED; PG8_LDA(At, 1, 0); PG8_STAGE(PG8_SA(0, 1), a2 + hstepA, voffA);
            PG8_WAIT_V(8); PG8_WAIT_L(0); PG8_BAR; PG8_MMA(0, 0, At, B0); PG8_MMA(0, 1, At, B1); PG8_BAR; PG8_SCHED;
            PG8_LDA(At, 1, 1); PG8_STAGE(PG8_SB(1, 0), b3, voffB); PG8_STAGE(PG8_SB(1, 1), b3 + hstepB, voffB); PG8_STAGE(PG8_SA(1, 0), a3, voffA);
            PG8_WAIT_V(8); PG8_WAIT_L(0); PG8_BAR; PG8_MMA(1, 0, At, B0); PG8_MMA(1, 1, At, B1); PG8_BAR; PG8_SCHED;
            } else {
            PG8_LDB(B0, 0, 0); PG8_SCHED; PG8_LDA(At, 0, 0); PG8_STAGE(PG8_SA(1, 1), a1 + hstepA, voffA);
            PG8_WAIT_L(8); PG8_BAR; PG8_WAIT_L(0); PG8_MMA(0, 0, At, B0); PG8_BAR; PG8_SCHED;
            PG8_LDB(B1, 0, 1); PG8_STAGE(PG8_SB(0, 0), b2, voffB);
            PG8_BAR; PG8_WAIT_L(0); PG8_MMA(0, 1, At, B1); PG8_BAR;
            PG8_LDA(At, 0, 1); PG8_STAGE(PG8_SA(0, 0), a2, voffA);
            PG8_BAR; PG8_WAIT_L(0); PG8_MMA(1, 0, At, B0); PG8_BAR; PG8_SCHED;
            PG8_STAGE(PG8_SB(0, 1), b2 + hstepB, voffB);
            PG8_WAIT_V(6); PG8_BAR; PG8_MMA(1, 1, At, B1); PG8_BAR;
            PG8_LDB(B0, 1, 0); PG8_SCHED; PG8_LDA(At, 1, 0); PG8_STAGE(PG8_SA(0, 1), a2 + hstepA, voffA);
            PG8_WAIT_L(8); PG8_BAR; PG8_WAIT_L(0); PG8_MMA(0, 0, At, B0); PG8_BAR; PG8_SCHED;
            PG8_LDB(B1, 1, 1); PG8_STAGE(PG8_SB(1, 0), b3, voffB);
            PG8_BAR; PG8_WAIT_L(0); PG8_MMA(0, 1, At, B1); PG8_BAR;
            PG8_LDA(At, 1, 1); PG8_STAGE(PG8_SA(1, 0), a3, voffA);
            PG8_BAR; PG8_WAIT_L(0); PG8_MMA(1, 0, At, B0); PG8_BAR; PG8_SCHED;
            PG8_STAGE(PG8_SB(1, 1), b3 + hstepB, voffB);
            PG8_WAIT_V(6); PG8_BAR; PG8_MMA(1, 1, At, B1); PG8_BAR;
            }
        }
        if constexpr (ALIGN_EPI) { if (wr == 0) PG8_BAR; }
        if constexpr (!Epi::AFTER_DRAIN) { E(acc, cur, wr, wc, fr, fq); S.done(cur); }
        if (!has_next) break;
#pragma unroll
        for (int a = 0; a < 2; ++a)
#pragma unroll
            for (int b = 0; b < 2; ++b)
#pragma unroll
                for (int m = 0; m < 4; ++m)
#pragma unroll
                    for (int n = 0; n < 2; ++n) acc[a][b][m][n] = (f32x4){0.f, 0.f, 0.f, 0.f};
        cur = nxt; cA = nA; cB = nB; ++ui;
        if constexpr (ALIGN_EPI) { if (wr == 1) PG8_BAR; }
    }
    PG8_WAIT_V(0);
    if constexpr (!ALIGN_EPI) { if (wr == 0) PG8_BAR; }
    PG8_BAR;
    if constexpr (Epi::AFTER_DRAIN) { E.fused(acc, cur, wr, wc, fr, fq, lds, wid, lane); S.done(cur); }
#undef PG8_SA
#undef PG8_SB
#undef PG8_STAGE
#undef PG8_LDA
#undef PG8_LDB
#undef PG8_MMA
#undef PG8_WAIT_V
#undef PG8_WAIT_L
#undef PG8_BAR
#undef PG8_SCHED
}
template <class Epi, class Sched, bool ALIGN_EPI = false, bool SP2 = false>
__device__ __forceinline__ void gemm_phase_ga(PG8_LAS unsigned char* lds, const Gemm g, const Sched& S, const Epi& E, const int tid, const unsigned (&g0)[2][2], const unsigned (&g1)[2][2]) {
    unsigned ca0[2] = {g0[0][0], g0[0][1]}, ca1[2] = {g0[1][0], g0[1][1]}; const unsigned na0[2] = {g1[0][0], g1[0][1]}, na1[2] = {g1[1][0], g1[1][1]};
    const int wid = __builtin_amdgcn_readfirstlane(tid >> 6), lane = tid & 63, wr = wid >> 2, wc = wid & 3, fr = lane & 15, fq = lane >> 4;
    int K = g.K; asm volatile("" : "+s"(K));
    const int nt = K / BK;
    unsigned voffA[2], voffB[2];
#pragma unroll
    for (int i = 0; i < 2; ++i) { int R, C; stage_rc(tid * 16 + i * 8192, R, C); const int Rb = Epi::PERM ? ((R & ~31) + perm32(R & 31)) : R;
        voffA[i] = (unsigned)(R * g.lda + C) * 2u; voffB[i] = (unsigned)(Rb * g.ldb + C) * 2u; }
    const size_t kstep = (size_t)(BK * 2);
    const size_t hstepA = (size_t)HALF * g.lda * 2, hstepB = (size_t)HALF * g.ldb * 2;
    const size_t tstepA = 2 * hstepA, tstepB = 2 * hstepB;
    const unsigned ldsw = (unsigned)wid * 1024u;
    const int aoff = lds_byte(wr * 64 + fr, fq * 8), boff = lds_byte(wc * 32 + fr, fq * 8);
#define PG8_SA(b, h) (((b) * 2 + (h)) * HTB)
#define PG8_SB(b, h) ((4 + (b) * 2 + (h)) * HTB)
#define PG8_STAGE(bufoff, gbase, voff) do { _Pragma("unroll") for (int _i = 0; _i < 2; ++_i) \
        __builtin_amdgcn_global_load_lds((const unsigned*)((const char*)(gbase) + (voff)[_i]), (PG8_LAS unsigned*)(lds + (bufoff) + ldsw + _i * 8192), 16, 0, 0); } while (0)
#define PG8_LDA(dst, b, h) do { _Pragma("unroll") for (int m = 0; m < 4; ++m) _Pragma("unroll") for (int k = 0; k < 2; ++k) dst[m][k] = *(const PG8_LAS bf16x8*)(lds + PG8_SA(b, h) + aoff + m * 2048 + k * 1024); } while (0)
#define PG8_LDB(dst, b, h) do { _Pragma("unroll") for (int n = 0; n < 2; ++n) _Pragma("unroll") for (int k = 0; k < 2; ++k) dst[n][k] = *(const PG8_LAS bf16x8*)(lds + PG8_SB(b, h) + boff + n * 2048 + k * 1024); } while (0)
#define PG8_MMA(ai, bj, At, Bt) do { __builtin_amdgcn_s_setprio(1); _Pragma("unroll") for (int m = 0; m < 4; ++m) _Pragma("unroll") for (int n = 0; n < 2; ++n) _Pragma("unroll") for (int k = 0; k < 2; ++k) \
        acc[ai][bj][m][n] = __builtin_amdgcn_mfma_f32_16x16x32_bf16(Bt[n][k], At[m][k], acc[ai][bj][m][n], 0, 0, 0); __builtin_amdgcn_s_setprio(0); } while (0)
#define PG8_WAIT_V(n) asm volatile("s_waitcnt vmcnt(" #n ")" ::: "memory")
#define PG8_WAIT_L(n) asm volatile("s_waitcnt lgkmcnt(" #n ")" ::: "memory")
#define PG8_BAR __builtin_amdgcn_s_barrier()
#define PG8_SCHED __builtin_amdgcn_sched_barrier(0)
    Unit cur, nxt; int ui = 0;
    if (!S.next(0, cur)) return;
    f32x4 acc[2][2][4][2];
#pragma unroll
    for (int a = 0; a < 2; ++a)
#pragma unroll
        for (int b = 0; b < 2; ++b)
#pragma unroll
            for (int m = 0; m < 4; ++m)
#pragma unroll
                for (int n = 0; n < 2; ++n) acc[a][b][m][n] = (f32x4){0.f, 0.f, 0.f, 0.f};
    bf16x8 At[4][2], B0[2][2], B1[2][2];
    const char* cA = (const char*)g.A; const char* cB = (const char*)g.Bt + (size_t)cur.pn * tstepB;
    S.a_ready(cur);
    if constexpr (SP2) {
        PG8_STAGE(PG8_SB(0, 0), cB, voffB); PG8_STAGE(PG8_SB(0, 1), cB + hstepB, voffB); PG8_STAGE(PG8_SA(0, 0), cA, ca0); PG8_STAGE(PG8_SA(0, 1), cA, ca1);
        if (wr == 1) PG8_BAR;
        PG8_WAIT_V(2); PG8_BAR;
        PG8_STAGE(PG8_SB(1, 0), cB + kstep, voffB); PG8_STAGE(PG8_SA(1, 0), cA + kstep, ca0); PG8_STAGE(PG8_SB(1, 1), cB + hstepB + kstep, voffB);
        PG8_WAIT_V(6); PG8_BAR;
    } else {
        PG8_STAGE(PG8_SB(0, 0), cB, voffB); PG8_STAGE(PG8_SA(0, 0), cA, ca0); PG8_STAGE(PG8_SB(0, 1), cB + hstepB, voffB); PG8_STAGE(PG8_SA(0, 1), cA, ca1);
        if (wr == 1) PG8_BAR;
        PG8_WAIT_V(4); PG8_BAR;
        PG8_STAGE(PG8_SB(1, 0), cB + kstep, voffB); PG8_STAGE(PG8_SA(1, 0), cA + kstep, ca0); PG8_STAGE(PG8_SB(1, 1), cB + hstepB + kstep, voffB);
        PG8_WAIT_V(6); PG8_BAR;
    }
    for (;;) {
        const bool has_next = S.next(ui + 1, nxt);
        const char* nA = cA; const char* nB = has_next ? (const char*)g.Bt + (size_t)nxt.pn * tstepB : cB;
        for (int t = 0; t < nt; t += 2) {
            const bool last = (t == nt - 2);
            const unsigned o20[2] = {last ? na0[0] : ca0[0], last ? na0[1] : ca0[1]}, o21[2] = {last ? na1[0] : ca1[0], last ? na1[1] : ca1[1]};
            const char* a1 = cA + (size_t)(t + 1) * kstep;
            const char* a2 = last ? nA : cA + (size_t)(t + 2) * kstep; const char* b2 = last ? nB : cB + (size_t)(t + 2) * kstep;
            const char* a3 = a2 + kstep; const char* b3 = b2 + kstep;
            if (last && has_next) S.a_ready(nxt);
            if constexpr (SP2) {
            PG8_LDB(B0, 0, 0); PG8_LDB(B1, 0, 1); PG8_SCHED; PG8_LDA(At, 0, 0); PG8_STAGE(PG8_SA(1, 1), a1, ca1);
            PG8_WAIT_V(8); PG8_WAIT_L(0); PG8_BAR; PG8_MMA(0, 0, At, B0); PG8_MMA(0, 1, At, B1); PG8_BAR; PG8_SCHED;
            PG8_LDA(At, 0, 1); PG8_STAGE(PG8_SB(0, 0), b2, voffB); PG8_STAGE(PG8_SB(0, 1), b2 + hstepB, voffB); PG8_STAGE(PG8_SA(0, 0), a2, o20);
            PG8_WAIT_V(8); PG8_WAIT_L(0); PG8_BAR; PG8_MMA(1, 0, At, B0); PG8_MMA(1, 1, At, B1); PG8_BAR; PG8_SCHED;
            PG8_LDB(B0, 1, 0); PG8_LDB(B1, 1, 1); PG8_SCHED; PG8_LDA(At, 1, 0); PG8_STAGE(PG8_SA(0, 1), a2, o21);
            PG8_WAIT_V(8); PG8_WAIT_L(0); PG8_BAR; PG8_MMA(0, 0, At, B0); PG8_MMA(0, 1, At, B1); PG8_BAR; PG8_SCHED;
            PG8_LDA(At, 1, 1); PG8_STAGE(PG8_SB(1, 0), b3, voffB); PG8_STAGE(PG8_SB(1, 1), b3 + hstepB, voffB); PG8_STAGE(PG8_SA(1, 0), a3, o20);
            PG8_WAIT_V(8); PG8_WAIT_L(0); PG8_BAR; PG8_MMA(1, 0, At, B0); PG8_MMA(1, 1, At, B1); PG8_BAR; PG8_SCHED;
            } else {
            PG8_LDB(B0, 0, 0); PG8_SCHED; PG8_LDA(At, 0, 0); PG8_STAGE(PG8_SA(1, 1), a1, ca1);
            PG8_WAIT_L(8); PG8_BAR; PG8_WAIT_L(0); PG8_MMA(0, 0, At, B0); PG8_BAR; PG8_SCHED;
            PG8_LDB(B1, 0, 1); PG8_STAGE(PG8_SB(0, 0), b2, voffB);
            PG8_BAR; PG8_WAIT_L(0); PG8_MMA(0, 1, At, B1); PG8_BAR;
            PG8_LDA(At, 0, 1); PG8_STAGE(PG8_SA(0, 0), a2, o20);
            PG8_BAR; PG8_WAIT_L(0); PG8_MMA(1, 0, At, B0); PG8_BAR; PG8_SCHED;
            PG8_STAGE(PG8_SB(0, 1), b2 + hstepB, voffB);
            PG8_WAIT_V(6); PG8_BAR; PG8_MMA(1, 1, At, B1); PG8_BAR;
            PG8_LDB(B0, 1, 0); PG8_SCHED; PG8_LDA(At, 1, 0); PG8_STAGE(PG8_SA(0, 1), a2, o21);
            PG8_WAIT_L(8); PG8_BAR; PG8_WAIT_L(0); PG8_MMA(0, 0, At, B0); PG8_BAR; PG8_SCHED;
            PG8_LDB(B1, 1, 1); PG8_STAGE(PG8_SB(1, 0), b3, voffB);
            PG8_BAR; PG8_WAIT_L(0); PG8_MMA(0, 1, At, B1); PG8_BAR;
            PG8_LDA(At, 1, 1); PG8_STAGE(PG8_SA(1, 0), a3, o20);
            PG8_BAR; PG8_WAIT_L(0); PG8_MMA(1, 0, At, B0); PG8_BAR; PG8_SCHED;
            PG8_STAGE(PG8_SB(1, 1), b3 + hstepB, voffB);
            PG8_WAIT_V(6); PG8_BAR; PG8_MMA(1, 1, At, B1); PG8_BAR;
            }
        }
        if constexpr (ALIGN_EPI) { if (wr == 0) PG8_BAR; }
        if constexpr (!Epi::AFTER_DRAIN) { E(acc, cur, wr, wc, fr, fq); S.done(cur); }
        if (!has_next) break;
#pragma unroll
        for (int a = 0; a < 2; ++a)
#pragma unroll
            for (int b = 0; b < 2; ++b)
#pragma unroll
                for (int m = 0; m < 4; ++m)
#pragma unroll
                    for (int n = 0; n < 2; ++n) acc[a][b][m][n] = (f32x4){0.f, 0.f, 0.f, 0.f};
        cur = nxt; cA = nA; cB = nB; ++ui;
        ca0[0] = na0[0]; ca0[1] = na0[1]; ca1[0] = na1[0]; ca1[1] = na1[1];
        if constexpr (ALIGN_EPI) { if (wr == 1) PG8_BAR; }
    }
    PG8_WAIT_V(0);
    if constexpr (!ALIGN_EPI) { if (wr == 0) PG8_BAR; }
    PG8_BAR;
    if constexpr (Epi::AFTER_DRAIN) { E.fused(acc, cur, wr, wc, fr, fq, lds, wid, lane); S.done(cur); }
#undef PG8_SA
#undef PG8_SB
#undef PG8_STAGE
#undef PG8_LDA
#undef PG8_LDB
#undef PG8_MMA
#undef PG8_WAIT_V
#undef PG8_WAIT_L
#undef PG8_BAR
#undef PG8_SCHED
}
}
#define XB_TMO      128
#define XB_XCNT(j)  (256  + 64 * (j))
#define XB_XSUB(j)  (1280 + 64 * (j))
#define XB_XGEN(j)  (2304 + 64 * (j))
#define XB_TOP      3328
#define XB_TOPGEN   3392
#define XCD_BAR_WORDS 3456
#define XB_SPIN_CAP (1u << 18)

__device__ __forceinline__ unsigned xb_ld(unsigned* p)              { return __hip_atomic_load(p, __ATOMIC_RELAXED, __HIP_MEMORY_SCOPE_AGENT); }
__device__ __forceinline__ unsigned xb_add(unsigned* p, unsigned v) { return __hip_atomic_fetch_add(p, v, __ATOMIC_RELAXED, __HIP_MEMORY_SCOPE_AGENT); }
__device__ __forceinline__ unsigned xb_xcc_id() { return (unsigned)__builtin_amdgcn_s_getreg((3 << 11) | 20) & 0xFu; }
#define XB_SPIN(cond, bar) do { unsigned _sp = 0; while (cond) { __builtin_amdgcn_s_sleep(1); \
    if ((++_sp & 255u) == 0u) { if (xb_ld(&(bar)[XB_TMO])) break; if (_sp > XB_SPIN_CAP) { atomicAdd(&(bar)[XB_TMO], 1u); break; } } } } while (0)

struct XcdBarrier {
    unsigned* bar; unsigned x;
    volatile LAS unsigned* st;
};

__device__ __forceinline__ XcdBarrier xcd_barrier_post(unsigned* bar, volatile LAS unsigned* st) {
    XcdBarrier b; b.bar = bar; b.x = xb_xcc_id(); b.st = st;
    if (threadIdx.x == 0) (void)xb_add(&bar[XB_XCNT(b.x)], 1u);
    return b;
}
__device__ __forceinline__ void xcd_barrier_complete(unsigned* bar, unsigned x, unsigned& nloc, unsigned& nx) {
    const unsigned G = gridDim.x * gridDim.y * gridDim.z;
    unsigned sum, cnt, mine, sp = 0u;
    for (;;) {
        sum = 0u; cnt = 0u; mine = 0u;
#pragma unroll
        for (unsigned j = 0; j < 16; ++j) { const unsigned c = xb_ld(&bar[XB_XCNT(j)]); sum += c; cnt += (c > 0u) ? 1u : 0u; mine = (j == x) ? c : mine; }
        if (sum == G) break;
        __builtin_amdgcn_s_sleep(1);
        if ((++sp & 255u) == 0u) { if (xb_ld(&bar[XB_TMO])) break; if (sp > XB_SPIN_CAP) { atomicAdd(&bar[XB_TMO], 1u); break; } }
    }
    nloc = mine > 0u ? mine : 1u; nx = cnt > 0u ? cnt : 1u;
}

__device__ __forceinline__ void xcd_barrier(const XcdBarrier& b, const bool is_t0) {
    asm volatile("s_waitcnt vmcnt(0)" ::: "memory");
    __syncthreads();
    if (is_t0) {
        unsigned* bar = b.bar;
        __builtin_amdgcn_s_waitcnt(0);
        unsigned nloc = b.st[0], nx = b.st[1];
        if (nloc == 0u) { xcd_barrier_complete(bar, b.x, nloc, nx); b.st[0] = nloc; b.st[1] = nx; }
        const unsigned old = xb_add(&bar[XB_XSUB(b.x)], 1u);
        const unsigned gen = old / nloc;
        if (old + 1u == (gen + 1u) * nloc) {
            __builtin_amdgcn_fence(__ATOMIC_RELEASE, "agent");
            asm volatile("s_waitcnt vmcnt(0)" ::: "memory");
            const unsigned og = xb_add(&bar[XB_TOP], 1u);
            const unsigned tg = og / nx;
            if (og + 1u == (tg + 1u) * nx) xb_add(&bar[XB_TOPGEN], 1u);
            else XB_SPIN(xb_ld(&bar[XB_TOPGEN]) == tg, bar);
            __builtin_amdgcn_fence(__ATOMIC_ACQUIRE, "agent");
            xb_add(&bar[XB_XGEN(b.x)], 1u);
            asm volatile("s_waitcnt vmcnt(0)" ::: "memory");
        } else {
            XB_SPIN(xb_ld(&bar[XB_XGEN(b.x)]) == gen, bar);
            __builtin_amdgcn_fence(__ATOMIC_ACQUIRE, "agent");
            asm volatile("s_waitcnt vmcnt(0)" ::: "memory");
        }
    }
    __syncthreads();
}


namespace pg8 {
struct EpiZ {
    static constexpr bool PERM = true, AFTER_DRAIN = false;
    bf16_t* O; int ldc; float* fcbuf;
    __device__ __forceinline__ void operator()(const f32x4 (&acc)[2][2][4][2], const Unit& u, int wr, int wc, int fr, int fq) const {
        const int row0 = u.pm * BM + wr * 64 + fr, col0 = u.pn * BM + wc * 32 + 8 * fq;
        const bool fcl = (u.pn == 9) && (wc == 1) && (fq == 0);
#pragma unroll
        for (int ai = 0; ai < 2; ++ai)
#pragma unroll
            for (int m = 0; m < 4; ++m) {
                const int row = row0 + ai * HALF + m * 16;
                bf16_t* rowp = O + (size_t)row * ldc + col0;
#pragma unroll
                for (int bj = 0; bj < 2; ++bj) {
                    const f32x4 v0 = acc[ai][bj][m][0], v1 = acc[ai][bj][m][1];
                    u32x4 w; w.x = cvt_pk_bf16(v0[0], v0[1]); w.y = cvt_pk_bf16(v0[2], v0[3]); w.z = cvt_pk_bf16(v1[0], v1[1]); w.w = cvt_pk_bf16(v1[2], v1[3]);
                    *(u32x4*)(rowp + bj * HALF) = w;
                }
                if (fcl) *(f32x4*)(fcbuf + (size_t)row * 4) = acc[ai][0][m][0];
            }
    }
};
struct EpiRowScale {
    static constexpr bool PERM = true, AFTER_DRAIN = false;
    bf16_t* O; int ldc; const float* rs;
    __device__ __forceinline__ void operator()(const f32x4 (&acc)[2][2][4][2], const Unit& u, int wr, int wc, int fr, int fq) const {
        const int row0 = u.pm * BM + wr * 64 + fr, col0 = u.pn * BM + wc * 32 + 8 * fq;
#pragma unroll
        for (int ai = 0; ai < 2; ++ai)
#pragma unroll
            for (int m = 0; m < 4; ++m) {
                const int row = row0 + ai * HALF + m * 16;
                const float s = rs[row];
                bf16_t* rowp = O + (size_t)row * ldc + col0;
#pragma unroll
                for (int bj = 0; bj < 2; ++bj) {
                    const f32x4 v0 = acc[ai][bj][m][0] * s, v1 = acc[ai][bj][m][1] * s;
                    u32x4 w; w.x = cvt_pk_bf16(v0[0], v0[1]); w.y = cvt_pk_bf16(v0[2], v0[3]); w.z = cvt_pk_bf16(v1[0], v1[1]); w.w = cvt_pk_bf16(v1[2], v1[3]);
                    *(u32x4*)(rowp + bj * HALF) = w;
                }
            }
    }
};
struct EpiGU {
    static constexpr bool PERM = true, AFTER_DRAIN = false;
    bf16_t* O;
    __device__ __forceinline__ void operator()(const f32x4 (&acc)[2][2][4][2], const Unit& u, int wr, int wc, int fr, int fq) const {
        const int row0 = u.pm * BM + wr * 64 + fr, f0 = ((u.pn & 1) * BM + wc * 32 + 8 * fq) >> 1;
#pragma unroll
        for (int ai = 0; ai < 2; ++ai)
#pragma unroll
            for (int m = 0; m < 4; ++m) {
                bf16_t* rowp = O + (size_t)(row0 + ai * HALF + m * 16) * 256 + f0;
#pragma unroll
                for (int bj = 0; bj < 2; ++bj) {
                    const f32x4 v0 = acc[ai][bj][m][0], v1 = acc[ai][bj][m][1];
                    const float a0 = v0[0] / (1.f + __expf(-v0[0])) * v0[1], a1 = v0[2] / (1.f + __expf(-v0[2])) * v0[3];
                    const float a2 = v1[0] / (1.f + __expf(-v1[0])) * v1[1], a3 = v1[2] / (1.f + __expf(-v1[2])) * v1[3];
                    typedef unsigned u32x2 __attribute__((ext_vector_type(2)));
                    u32x2 w; w.x = cvt_pk_bf16(a0, a1); w.y = cvt_pk_bf16(a2, a3);
                    *(u32x2*)(rowp + bj * (HALF / 2)) = w;
                }
            }
    }
};
struct EpiPleGate {
    static constexpr bool PERM = true, AFTER_DRAIN = false;
    bf16_t* O; const bf16_t* PP;
    __device__ __forceinline__ void operator()(const f32x4 (&acc)[2][2][4][2], const Unit& u, int wr, int wc, int fr, int fq) const {
        const int row0 = u.pm * BM + wr * 64 + fr, col0 = u.pn * BM + wc * 32 + 8 * fq;
#pragma unroll
        for (int ai = 0; ai < 2; ++ai)
#pragma unroll
            for (int m = 0; m < 4; ++m) {
                const size_t off = (size_t)(row0 + ai * HALF + m * 16) * 1024 + col0;
#pragma unroll
                for (int bj = 0; bj < 2; ++bj) {
                    const f32x4 v0 = acc[ai][bj][m][0], v1 = acc[ai][bj][m][1];
                    const u32x4 pw = *(const u32x4*)(PP + off + bj * HALF);
                    float o[8];
                    o[0] = __uint_as_float(pw.x << 16) / (1.f + __expf(-v0[0])); o[1] = __uint_as_float(pw.x & 0xffff0000u) / (1.f + __expf(-v0[1]));
                    o[2] = __uint_as_float(pw.y << 16) / (1.f + __expf(-v0[2])); o[3] = __uint_as_float(pw.y & 0xffff0000u) / (1.f + __expf(-v0[3]));
                    o[4] = __uint_as_float(pw.z << 16) / (1.f + __expf(-v1[0])); o[5] = __uint_as_float(pw.z & 0xffff0000u) / (1.f + __expf(-v1[1]));
                    o[6] = __uint_as_float(pw.w << 16) / (1.f + __expf(-v1[2])); o[7] = __uint_as_float(pw.w & 0xffff0000u) / (1.f + __expf(-v1[3]));
                    u32x4 w; w.x = cvt_pk_bf16(o[0], o[1]); w.y = cvt_pk_bf16(o[2], o[3]); w.z = cvt_pk_bf16(o[4], o[5]); w.w = cvt_pk_bf16(o[6], o[7]);
                    *(u32x4*)(O + off + bj * HALF) = w;
                }
            }
    }
};
struct EpiDown {
    static constexpr bool PERM = true, AFTER_DRAIN = false;
    bf16_t* O;
    __device__ __forceinline__ void operator()(const f32x4 (&acc)[2][2][4][2], const Unit& u, int wr, int wc, int fr, int fq) const {
        const int row0 = u.pm * BM + wr * 64 + fr, col0 = (u.pn & 3) * BM + wc * 32 + 8 * fq;
#pragma unroll
        for (int ai = 0; ai < 2; ++ai)
#pragma unroll
            for (int m = 0; m < 4; ++m) {
                bf16_t* rowp = O + (size_t)(row0 + ai * HALF + m * 16) * 1024 + col0;
#pragma unroll
                for (int bj = 0; bj < 2; ++bj) {
                    const f32x4 v0 = acc[ai][bj][m][0], v1 = acc[ai][bj][m][1];
                    u32x4 w; w.x = cvt_pk_bf16(v0[0], v0[1]); w.y = cvt_pk_bf16(v0[2], v0[3]); w.z = cvt_pk_bf16(v1[0], v1[1]); w.w = cvt_pk_bf16(v1[2], v1[3]);
                    *(u32x4*)(rowp + bj * HALF) = w;
                }
            }
    }
};
constexpr int XPM = (int)((WS_HS16 - WS_A16) / (256 * 1024 * 2)), XPN = (int)((WS_WGU - WS_WPG) / (256 * 1024 * 2));
static_assert((WS_HS16 - WS_A16) % (256 * 1024 * 2) == 0 && (WS_WGU - WS_WPG) % (256 * 1024 * 2) == 0 && XPM >= 64 && (XPN & 1) == 0, "virtual unit offsets");
struct EpiX {
    static constexpr bool PERM = true, AFTER_DRAIN = false;
    EpiGU gu; EpiPleGate pg;
    __device__ __forceinline__ void operator()(const f32x4 (&acc)[2][2][4][2], const Unit& u, int wr, int wc, int fr, int fq) const {
        if (u.pm >= XPM) { const Unit v{u.pm - XPM, u.pn - XPN}; gu(acc, v, wr, wc, fr, fq); }
        else pg(acc, u, wr, wc, fr, fq);
    }
};
struct XSched {
    const int* tile_e; int nU1, G, vc;
    __device__ __forceinline__ bool next(int i, Unit& u) const {
        if (i >= 2) return false;
        const int g = vc + i * G;
        if (g < nU1) { const int t = g >> 1; u.pm = t + XPM; u.pn = __builtin_amdgcn_readfirstlane(tile_e[t]) * 2 + (g & 1) + XPN; return true; }
        const int k = g - nU1; if (k >= 256) return false;
        u.pm = k >> 2; u.pn = k & 3; return true;
    }
    __device__ __forceinline__ void a_ready(const Unit&) const {}
    __device__ __forceinline__ void done(const Unit&) const {}
};
struct TwoUnits {
    int pm0, pn0, pm1, pn1, n;
    __device__ __forceinline__ bool next(int i, Unit& u) const { if (i >= n) return false; u.pm = i ? pm1 : pm0; u.pn = i ? pn1 : pn0; return true; }
    __device__ __forceinline__ void a_ready(const Unit&) const {}
    __device__ __forceinline__ void done(const Unit&) const {}
};
struct OneUnit {
    int pm, pn;
    __device__ __forceinline__ bool next(int i, Unit& u) const { if (i) return false; u.pm = pm; u.pn = pn; return true; }
    __device__ __forceinline__ void a_ready(const Unit&) const {}
    __device__ __forceinline__ void done(const Unit&) const {}
};
struct GroupSched {
    const int* tile_e; int T, NJ, G, vc;
    __device__ __forceinline__ bool next(int i, Unit& u) const {
        const long L = (long)i * G + vc; if (L >= (long)T * NJ) return false;
        const int t = (int)(L / NJ), j = (int)(L % NJ);
        u.pm = t; u.pn = __builtin_amdgcn_readfirstlane(tile_e[t]) * NJ + j; return true;
    }
    __device__ __forceinline__ void a_ready(const Unit&) const {}
    __device__ __forceinline__ void done(const Unit&) const {}
};
}

template <class Map>
__device__ __forceinline__ void transpose_rows(const Map mp, const float* ks, int nrows_out, int K, bf16* WT, LAS float* scr, int gw, int NGW, int lane) {
    const int nblk = nrows_out / 32, nitems = (K / 64) * nblk;
    const int f = lane & 7, kr = lane >> 3;
    for (int it = gw; it < nitems; it += NGW) {
        const int kb = it / nblk, nb = it % nblk, k0 = 64 * kb, n0 = 32 * nb;
        const float* src; long pitch; float sc; int nl0, nls;
        mp.get4(n0, f, src, pitch, sc, nl0, nls);
        f32x4_t vals[8];
#pragma unroll
        for (int i = 0; i < 8; ++i) vals[i] = src ? *(const f32x4_t*)(src + (size_t)(k0 + kr + 8 * i) * pitch) : (f32x4_t){0.f, 0.f, 0.f, 0.f};
#pragma unroll
        for (int i = 0; i < 8; ++i) {
            const int kk = kr + 8 * i;
            float m = sc; if (ks) m *= ks[k0 + kk];
            scr[kk * 33 + nl0] = vals[i].x * m; scr[kk * 33 + nl0 + nls] = vals[i].y * m; scr[kk * 33 + nl0 + 2 * nls] = vals[i].z * m; scr[kk * 33 + nl0 + 3 * nls] = vals[i].w * m;
        }
        asm volatile("s_waitcnt lgkmcnt(0)" ::: "memory");
        const int c = lane & 7;
#pragma unroll
        for (int j = 0; j < 4; ++j) {
            const int n = (lane >> 3) + 8 * j; const LAS float* s = scr + (8 * c) * 33 + n;
            v4u o; o.x = pk2(s[0 * 33], s[1 * 33]); o.y = pk2(s[2 * 33], s[3 * 33]); o.z = pk2(s[4 * 33], s[5 * 33]); o.w = pk2(s[6 * 33], s[7 * 33]);
            *(v4u*)(WT + (size_t)(n0 + n) * K + k0 + 8 * c) = o;
        }
        asm volatile("s_waitcnt lgkmcnt(0)" ::: "memory");
    }
}
constexpr float LOG2E_W = 1.4426950408889634f;
struct MapIn {
    const float* w;
    __device__ __forceinline__ void get(int n, const float*& src, long& pitch, float& sc) const {
        int c;
        if (n < 1152) c = n;
        else if (n < Z_CKV) c = OFF_QC + (n - Z_QC);
        else if (n < Z_CQ) c = OFF_CKV + (n - Z_CKV);
        else if (n < Z_KR) c = OFF_CQ + (n - Z_CQ);
        else if (n < Z_FC) c = OFF_KR + (n - Z_KR);
        else if (n < Z_FC + 4) c = OFF_FC + (n - Z_FC);
        else c = -1;
        src = c >= 0 ? w + c : nullptr; pitch = D_IN;
        sc = n < Z_KA ? 0.17677669529663687f * LOG2E_W : ((n >= Z_QC && n < Z_KC) ? 0.125f * LOG2E_W : 1.f);
    }
    __device__ __forceinline__ void get4(int n0, int f, const float*& src, long& pitch, float& sc, int& nl0, int& nls) const { get(n0 + 4 * f, src, pitch, sc); nl0 = 4 * f; nls = 1; }
};
struct MapPlain {
    const float* w; int N, nvalid; float scale;
    __device__ __forceinline__ void get(int n, const float*& src, long& pitch, float& sc) const { src = n < nvalid ? w + n : nullptr; pitch = N; sc = scale; }
    __device__ __forceinline__ void get4(int n0, int f, const float*& src, long& pitch, float& sc, int& nl0, int& nls) const { get(n0 + 4 * f, src, pitch, sc); nl0 = 4 * f; nls = 1; }
};

struct MapGU {
    const float* wg; const float* wu;
    __device__ __forceinline__ void get(int n, const float*& src, long& pitch, float& sc) const {
        const int e = n >> 9, r = n & 511, f = r >> 1;
        const long dlt = (r & 1) ? (long)(wu - wg) : 0l;
        src = wg + dlt + (size_t)e * 1024 * 256 + f; pitch = 256; sc = 1.f;
    }
    __device__ __forceinline__ void get4(int n0, int f, const float*& src, long& pitch, float& sc, int& nl0, int& nls) const {
        const int e = n0 >> 9, f0 = (n0 & 511) >> 1;
        const long dlt = (f >> 2) ? (long)(wu - wg) : 0l;
        src = wg + dlt + (size_t)e * 1024 * 256 + f0 + 4 * (f & 3); pitch = 256; sc = 1.f; nl0 = 8 * (f & 3) + (f >> 2); nls = 2;
    }
};
struct MapD {
    const float* wd;
    __device__ __forceinline__ void get(int n, const float*& src, long& pitch, float& sc) const {
        const int e = n >> 10, c = n & 1023;
        src = wd + (size_t)e * 256 * 1024 + c; pitch = 1024; sc = 1.f;
    }
    __device__ __forceinline__ void get4(int n0, int f, const float*& src, long& pitch, float& sc, int& nl0, int& nls) const { get(n0 + 4 * f, src, pitch, sc); nl0 = 4 * f; nls = 1; }
};

struct AttnP {
    const bf16* z16; const bf16* qb16; const bf16* kvb16; const bf16* krr16; const float* cum; const float* cosT; const float* sinT;
    const int* pos; bf16* mixed16; const float* lq1; const float* lk1; const float* lq2; const float* lk2; const float* gdiff; int layer; unsigned* prof; const int* tpmax; float lam, lam_init;
};
typedef short bf16x8_t __attribute__((ext_vector_type(8)));
typedef float f32x16_t __attribute__((ext_vector_type(16)));
typedef short s16x4_t __attribute__((ext_vector_type(4)));
typedef float f32x2_t __attribute__((ext_vector_type(2)));
typedef __bf16 bf16x2_t __attribute__((ext_vector_type(2)));
__device__ __forceinline__ unsigned cvtpk(float lo, float hi) { f32x2_t v = {lo, hi}; bf16x2_t b = __builtin_convertvector(v, bf16x2_t); return __builtin_bit_cast(unsigned, b); }
__device__ __forceinline__ int crow(int r, int hi) { return (r & 3) + 8 * (r >> 2) + 4 * hi; }
__device__ __forceinline__ s16x4_t vtr(const LAS unsigned char* p) { typedef short v4i16_t __attribute__((ext_vector_type(4))); return __builtin_bit_cast(s16x4_t, __builtin_amdgcn_ds_read_tr16_b64_v4i16((LAS v4i16_t*)p)); }
constexpr float LOG2E = 1.4426950408889634f;

__device__ __forceinline__ float xhalf_max(float m) { auto rr = __builtin_amdgcn_permlane32_swap(__float_as_uint(m), __float_as_uint(m), false, false); return __builtin_fmaxf(__uint_as_float(rr[0]), __uint_as_float(rr[1])); }
__device__ __forceinline__ float xhalf_sum(float m) { auto rr = __builtin_amdgcn_permlane32_swap(__float_as_uint(m), __float_as_uint(m), false, false); return __uint_as_float(rr[0]) + __uint_as_float(rr[1]); }
__device__ __forceinline__ float max3f(float a, float b, float c) { return __builtin_fmaxf(__builtin_fmaxf(a, b), c); }
template <int MODE> __device__ __forceinline__ void attn_unit(const AttnP& p, int b, int h, int qblk, LAS unsigned char* lds, const int tid_in) {
    int tid = tid_in * 64 + lane_id_now(); asm volatile("" : "+v"(tid));
#ifdef PROF_SEL
    const unsigned long long pu0 = __builtin_amdgcn_s_memrealtime(); unsigned long long pt0 = 0, pl0 = 0, pacc_c = 0, pacc_b = 0;
#define PROF_T(acc) do { const unsigned long long t_ = __builtin_amdgcn_s_memrealtime(); acc += t_ - pt0; pt0 = t_; } while (0)
#else
#define PROF_T(acc) do {} while (0)
#endif
    constexpr int NF = MODE == 0 ? 2 : (MODE == 1 ? 6 : 4);
    constexpr int NC = MODE == 1 ? 12 : 8;
    constexpr int NCX = MODE == 1 ? 0 : 2;
    constexpr int KB = (NC + NCX) * 1024, KBUF = KB + 256;
    constexpr int VOFF = 2 * KBUF;
    constexpr int KI = (NC * 64 + NTHREADS - 1) / NTHREADS;
    const int lane = tid & 63, w = __builtin_amdgcn_readfirstlane(tid >> 6), r32 = lane & 31, hi = lane >> 5;
    const int map = MODE == 0 ? (w >> 2) : 0, qg = MODE == 0 ? (w & 3) : w;
    const int c = MODE == 0 ? qblk * 2 + (qg >> 1) : qblk * 4 + (qg >> 1);
    const int ntiles = MODE == 0 ? qblk * 2 + 2 : qblk * 4 + 4;
    const long tok0 = (long)b * SEQ;
    const int q0u = MODE == 0 ? qblk * 128 : qblk * 256;
    const long qrow = tok0 + q0u + qg * 32 + r32;
    float slope2 = 0.f, sq = 0.f, refv = 0.f; int qpmin = 0;
    const bf16* ksrc[KI]; bool kok[KI];
#pragma unroll
    for (int i = 0; i < KI; ++i) {
        const int pidx0 = tid + i * NTHREADS;
        kok[i] = pidx0 < NC * 64;
        const int pidx = kok[i] ? pidx0 : pidx0 - NTHREADS, c8 = pidx >> 6, kv = pidx & 63;
        if (MODE == 0) ksrc[i] = p.z16 + (tok0 + kv) * ZP + Z_KA + h * 64 + c8 * 8;
        else if (MODE == 2) ksrc[i] = p.z16 + (tok0 + kv) * ZP + Z_KC + h * 64 + c8 * 8;
        else ksrc[i] = (c8 < 8) ? p.kvb16 + (tok0 + kv) * NKVB + h * 128 + c8 * 8 : p.krr16 + (tok0 + kv) * 32 + (c8 - 8) * 8;
    }
    const int kstride = MODE == 1 ? 0 : 64 * ZP;
    const int vcl = tid & 3, vkv = (tid >> 2) & 63, vch = tid >> 8;
    const bf16* vsrc = MODE == 0 ? p.z16 + (tok0 + vkv) * ZP + Z_VA + h * 64 + (vch * 4 + vcl) * 8
                     : (MODE == 1 ? p.kvb16 + (tok0 + vkv) * NKVB + h * 128 + 64 + (vch * 4 + vcl) * 8 : p.z16 + (tok0 + vkv) * ZP + Z_VC + h * 64 + (vch * 4 + vcl) * 8);
    const int vstride = MODE == 1 ? 64 * NKVB : 64 * ZP;
    LAS unsigned char* const vdstp = lds + VOFF + vch * 4096 + (vkv >> 3) * 512 + (vkv & 7) * 64 + vcl * 16;
    LAS unsigned char* const kdstp = lds + tid * 16;
    v4u kreg0[KI], kreg1[KI], vreg0, vreg1; unsigned breg0 = 0u, breg1 = 0u;
    auto load_k = [&](int kt_, v4u (&kreg)[KI], unsigned& breg) {
        const int kt = kt_ < ntiles ? kt_ : ntiles - 1;
#pragma unroll
        for (int i = 0; i < KI; ++i) {
            const int pidx = tid + i * NTHREADS;
            const long off = MODE == 1 ? (((kok[i] ? pidx : pidx - NTHREADS) >> 6) < 8 ? (long)kt * 64 * NKVB : (long)kt * 64 * 32) : (long)kt * kstride;
            kreg[i] = *(const v4u*)(ksrc[i] + off);
        }
        if (MODE == 0) breg = (unsigned)p.pos[tok0 + kt * 64 + (tid & 63)];
        if (MODE == 2) breg = __float_as_uint(p.cum[(tok0 + kt * 64 + (tid & 63)) * 4 + h]);
    };
    auto load_v = [&](int kt_, v4u& vreg) { const int kt = kt_ < ntiles ? kt_ : ntiles - 1; vreg = *(const v4u*)(vsrc + (long)kt * vstride); };
    auto write_k = [&](const int par, const v4u (&kreg)[KI], const unsigned& breg) {
#pragma unroll
        for (int i = 0; i < KI; ++i) if (kok[i]) *(LAS v4u*)(kdstp + par * KBUF + i * NTHREADS * 16) = kreg[i];
        if (MODE != 1 && tid < 64) {
            const float bv = MODE == 0 ? slope2 * ((float)(int)breg - refv) : (refv - __uint_as_float(breg)) * LOG2E;
            *(LAS float*)(lds + par * KBUF + KB + tid * 4) = bv;
            const unsigned e0 = f2bf(bv); const float r1 = bv - __uint_as_float(e0 << 16);
            const unsigned e1 = f2bf(r1); const float r2 = r1 - __uint_as_float(e1 << 16);
            const unsigned e2 = f2bf(r2);
            v4u ex; ex.x = e0 | (e1 << 16); ex.y = e2; ex.z = 0u; ex.w = 0u;
            *(LAS v4u*)(lds + par * KBUF + NC * 1024 + tid * 16) = ex;
        }
    };
    auto write_v = [&](const int par, const v4u& vreg) { *(LAS v4u*)(vdstp + par * 8192) = vreg; };
    load_k(0, kreg0, breg0); load_k(1, kreg1, breg1); load_v(0, vreg0); load_v(1, vreg1);
    bf16x8_t qf[NF];
    {
        const bf16* qsrc = MODE == 0 ? p.z16 + qrow * ZP + Z_QA + h * 64 + map * 32 : (MODE == 1 ? p.qb16 + qrow * NQBP + h * 96 : p.z16 + qrow * ZP + Z_QC + h * 64);
#pragma unroll
        for (int i = 0; i < NF; ++i) qf[i] = *(const bf16x8_t*)(qsrc + i * 16 + hi * 8);
    }
    if (MODE == 1) {
        const float4 c0 = *(const float4*)(p.cosT + qrow * 16 + hi * 8), c1 = *(const float4*)(p.cosT + qrow * 16 + hi * 8 + 4);
        const float4 s0 = *(const float4*)(p.sinT + qrow * 16 + hi * 8), s1 = *(const float4*)(p.sinT + qrow * 16 + hi * 8 + 4);
        const float cs[8] = {c0.x, c0.y, c0.z, c0.w, c1.x, c1.y, c1.z, c1.w}, sn[8] = {s0.x, s0.y, s0.z, s0.w, s1.x, s1.y, s1.z, s1.w};
        float n1[8], n2[8];
#pragma unroll
        for (int j = 0; j < 8; ++j) {
            const float x1 = __uint_as_float((unsigned)(unsigned short)qf[NF - 2][j] << 16), x2 = __uint_as_float((unsigned)(unsigned short)qf[NF - 1][j] << 16);
            n1[j] = x1 * cs[j] - x2 * sn[j]; n2[j] = x2 * cs[j] + x1 * sn[j];
        }
        v4u a, bb;
        a.x = cvtpk(n1[0], n1[1]); a.y = cvtpk(n1[2], n1[3]); a.z = cvtpk(n1[4], n1[5]); a.w = cvtpk(n1[6], n1[7]);
        bb.x = cvtpk(n2[0], n2[1]); bb.y = cvtpk(n2[2], n2[3]); bb.z = cvtpk(n2[4], n2[5]); bb.w = cvtpk(n2[6], n2[7]);
        qf[NF - 2] = __builtin_bit_cast(bf16x8_t, a); qf[NF - 1] = __builtin_bit_cast(bf16x8_t, bb);
    }
    if (MODE == 0) {
        slope2 = exp2f(-8.0f * (float)(h + 1) / 6.0f) * LOG2E;
        const int pref = p.pos[tok0 + q0u]; refv = (float)pref;
        const int pq = p.pos[qrow]; sq = slope2 * (float)(pq - pref);
        int mn = pq;
#pragma unroll
        for (int o_ = 1; o_ < 64; o_ <<= 1) mn = min(mn, __builtin_amdgcn_ds_bpermute((lane ^ o_) << 2, mn));
        qpmin = __builtin_amdgcn_readfirstlane(mn);
    }
    if (MODE == 2) refv = p.cum[(tok0 + q0u) * 4 + h];
    f32x16_t o[2], negm;
    float mref = 0.f, lsum = 0.f; bool first = true;
#pragma unroll
    for (int r = 0; r < 16; ++r) { o[0][r] = 0.f; o[1][r] = 0.f; negm[r] = 0.f; }
    bf16x8_t qext;
    { v4u q1; q1.x = hi == 0 ? 0x3f803f80u : 0u; q1.y = hi == 0 ? 0x00003f80u : 0u; q1.z = 0u; q1.w = 0u; qext = __builtin_bit_cast(bf16x8_t, q1); }
    LAS unsigned char* const kfp = lds + (map * NF * 2 + hi) * 1024 + r32 * 16;
    LAS unsigned char* const kxp = lds + (NC + hi) * 1024 + r32 * 16;
    LAS unsigned char* const bfp = lds + KB + 16 * hi;
    LAS unsigned char* const vfp = lds + VOFF + (4 * hi + ((lane & 15) >> 2)) * 64 + ((lane >> 4) & 1) * 32 + (lane & 3) * 8;
    auto compute_s = [&](const int kt, const int par, f32x16_t& p0, f32x16_t& p1) {
        constexpr int KG = NF;
        bf16x8_t kf0[KG], kf1[KG], kx0, kx1;
#pragma unroll
        for (int d0 = 0; d0 < KG; ++d0) { kf0[d0] = *(const LAS bf16x8_t*)(kfp + par * KBUF + d0 * 2048); kf1[d0] = *(const LAS bf16x8_t*)(kfp + par * KBUF + d0 * 2048 + 512); }
        if (MODE != 1) { kx0 = *(const LAS bf16x8_t*)(kxp + par * KBUF); kx1 = *(const LAS bf16x8_t*)(kxp + par * KBUF + 512); }
        __builtin_amdgcn_sched_barrier(0);
        if (MODE != 1) {
            p0 = __builtin_amdgcn_mfma_f32_32x32x16_bf16(kx0, qext, negm, 0, 0, 0);
            p1 = __builtin_amdgcn_mfma_f32_32x32x16_bf16(kx1, qext, negm, 0, 0, 0);
        }
#pragma unroll
        for (int d0 = 0; d0 < KG; ++d0) {
            p0 = __builtin_amdgcn_mfma_f32_32x32x16_bf16(kf0[d0], qf[d0], (MODE == 1 && d0 == 0) ? negm : p0, 0, 0, 0);
            p1 = __builtin_amdgcn_mfma_f32_32x32x16_bf16(kf1[d0], qf[d0], (MODE == 1 && d0 == 0) ? negm : p1, 0, 0, 0);
        }
        if (NF > KG) {
#pragma unroll
            for (int d0 = KG; d0 < NF; ++d0) { kf0[d0 - KG] = *(const LAS bf16x8_t*)(kfp + par * KBUF + d0 * 2048); kf1[d0 - KG] = *(const LAS bf16x8_t*)(kfp + par * KBUF + d0 * 2048 + 512); }
#pragma unroll
            for (int d0 = KG; d0 < NF; ++d0) {
                p0 = __builtin_amdgcn_mfma_f32_32x32x16_bf16(kf0[d0 - KG], qf[d0], p0, 0, 0, 0);
                p1 = __builtin_amdgcn_mfma_f32_32x32x16_bf16(kf1[d0 - KG], qf[d0], p1, 0, 0, 0);
            }
        }
        if (MODE == 0) {
            if (kt == c || p.tpmax[b * 32 + kt] > qpmin) {
#pragma unroll
                for (int g = 0; g < 4; ++g) {
                    const f32x4_t b0 = *(const LAS f32x4_t*)(bfp + par * KBUF + 32 * g), b1 = *(const LAS f32x4_t*)(bfp + par * KBUF + 128 + 32 * g);
                    p0[4 * g] += 2.f * fminf(sq - b0.x, 0.f); p0[4 * g + 1] += 2.f * fminf(sq - b0.y, 0.f); p0[4 * g + 2] += 2.f * fminf(sq - b0.z, 0.f); p0[4 * g + 3] += 2.f * fminf(sq - b0.w, 0.f);
                    p1[4 * g] += 2.f * fminf(sq - b1.x, 0.f); p1[4 * g + 1] += 2.f * fminf(sq - b1.y, 0.f); p1[4 * g + 2] += 2.f * fminf(sq - b1.z, 0.f); p1[4 * g + 3] += 2.f * fminf(sq - b1.w, 0.f);
                }
            }
        }
        if (MODE == 2) {
            if (kt == c) {
                const int qi = (qg & 1) * 32 + r32;
#pragma unroll
                for (int r = 0; r < 16; ++r) { const int kv = crow(r, hi); if (kv > qi) p0[r] = -INFINITY; if (kv + 32 > qi) p1[r] = -INFINITY; }
            }
        }
    };
    auto softmax_pv = [&](const int par, f32x16_t& p0, f32x16_t& p1) {
        constexpr int VE = MODE == 1 ? 4 : 8;
        s16x4_t vlo[8], vhi[8];
#pragma unroll
        for (int i = 0; i < VE; ++i) { vlo[i] = vtr(vfp + par * 8192 + (i & 1) * 4096 + (i >> 1) * 1024); vhi[i] = vtr(vfp + par * 8192 + (i & 1) * 4096 + (i >> 1) * 1024 + 512); }
        __builtin_amdgcn_sched_barrier(0);
        float tm0 = max3f(p0[0], p0[1], p0[2]), tm1 = max3f(p1[0], p1[1], p1[2]);
#pragma unroll
        for (int r = 3; r < 15; r += 2) { tm0 = max3f(tm0, p0[r], p0[r + 1]); tm1 = max3f(tm1, p1[r], p1[r + 1]); }
        float tmax = max3f(tm0, tm1, p0[15]); tmax = __builtin_fmaxf(tmax, p1[15]);
        tmax = xhalf_max(tmax);
        if (first || __any(tmax > 8.0f)) {
            const float dl = first ? tmax : __builtin_fmaxf(tmax, 0.f);
            mref += dl;
            const float f = first ? 1.f : __builtin_amdgcn_exp2f(-dl);
            lsum *= f;
#pragma unroll
            for (int r = 0; r < 16; ++r) { o[0][r] *= f; o[1][r] *= f; p0[r] -= dl; p1[r] -= dl; negm[r] = -mref; }
            first = false;
        }
        float ls0 = 0.f, ls1 = 0.f;
#pragma unroll
        for (int r = 0; r < 16; ++r) { p0[r] = __builtin_amdgcn_exp2f(p0[r]); p1[r] = __builtin_amdgcn_exp2f(p1[r]); ls0 += p0[r]; ls1 += p1[r]; }
        lsum += ls0 + ls1;
        bf16x8_t pa[4];
#pragma unroll
        for (int ks = 0; ks < 4; ++ks) {
            v4u wv;
            if (ks < 2) { wv.x = cvtpk(p0[8 * ks + 0], p0[8 * ks + 1]); wv.y = cvtpk(p0[8 * ks + 2], p0[8 * ks + 3]); wv.z = cvtpk(p0[8 * ks + 4], p0[8 * ks + 5]); wv.w = cvtpk(p0[8 * ks + 6], p0[8 * ks + 7]); }
            else { wv.x = cvtpk(p1[8 * (ks - 2) + 0], p1[8 * (ks - 2) + 1]); wv.y = cvtpk(p1[8 * (ks - 2) + 2], p1[8 * (ks - 2) + 3]); wv.z = cvtpk(p1[8 * (ks - 2) + 4], p1[8 * (ks - 2) + 5]); wv.w = cvtpk(p1[8 * (ks - 2) + 6], p1[8 * (ks - 2) + 7]); }
            pa[ks] = __builtin_bit_cast(bf16x8_t, wv);
        }
#pragma unroll
        for (int i = VE; i < 8; ++i) { vlo[i] = vtr(vfp + par * 8192 + (i & 1) * 4096 + (i >> 1) * 1024); vhi[i] = vtr(vfp + par * 8192 + (i & 1) * 4096 + (i >> 1) * 1024 + 512); }
#pragma unroll
        for (int ks = 0; ks < 4; ++ks)
#pragma unroll
            for (int blk = 0; blk < 2; ++blk) {
                const s16x4_t lo = vlo[ks * 2 + blk], hi4 = vhi[ks * 2 + blk];
                const bf16x8_t vf = {lo[0], lo[1], lo[2], lo[3], hi4[0], hi4[1], hi4[2], hi4[3]};
                o[blk] = __builtin_amdgcn_mfma_f32_32x32x16_bf16(vf, pa[ks], o[blk], 0, 0, 0);
            }
    };
    if (MODE != 1 && tid < 128) *(LAS v4u*)(lds + (tid >> 6) * KBUF + (NC + 1) * 1024 + (tid & 63) * 16) = (v4u){0u, 0u, 0u, 0u};
    constexpr bool PIPE = false;
    f32x16_t pA0, pA1, pB0, pB1;
    if (PIPE) {
        write_k(0, kreg0, breg0); write_k(1, kreg1, breg1); write_v(0, vreg0);
        load_k(2, kreg0, breg0);
        __syncthreads();
        compute_s(0, 0, pA0, pA1);
        __syncthreads();
    } else {
        write_k(0, kreg0, breg0); write_v(0, vreg0);
        __syncthreads();
    }
#ifdef PROF_SEL
    pl0 = __builtin_amdgcn_s_memrealtime();
#endif
#pragma unroll 1
    for (int kt = 0; kt < ntiles; kt += 2) {
#ifdef PROF_SEL
        pt0 = __builtin_amdgcn_s_memrealtime();
#endif
        if (PIPE) {
            load_k(kt + 3, kreg1, breg1); load_v(kt + 2, vreg0);
            if (kt < c) { compute_s(kt + 1, 1, pB0, pB1); __builtin_amdgcn_sched_barrier(0); softmax_pv(0, pA0, pA1); }
            else if (kt == c) softmax_pv(0, pA0, pA1);
            write_k(0, kreg0, breg0); write_v(1, vreg1);
        } else {
            load_k(kt + 2, kreg0, breg0); load_v(kt + 2, vreg0);
            if (kt <= c) { compute_s(kt, 0, pA0, pA1); softmax_pv(0, pA0, pA1); }
            write_k(1, kreg1, breg1); write_v(1, vreg1);
        }
        PROF_T(pacc_c);
        __syncthreads();
        PROF_T(pacc_b);
        if (PIPE) {
            load_k(kt + 4, kreg0, breg0); load_v(kt + 3, vreg1);
            if (kt + 1 < c) { compute_s(kt + 2, 0, pA0, pA1); __builtin_amdgcn_sched_barrier(0); softmax_pv(1, pB0, pB1); }
            else if (kt + 1 == c) softmax_pv(1, pB0, pB1);
            write_k(1, kreg1, breg1); write_v(0, vreg0);
        } else {
            load_k(kt + 3, kreg1, breg1); load_v(kt + 3, vreg1);
            if (kt + 1 <= c) { compute_s(kt + 1, 1, pA0, pA1); softmax_pv(1, pA0, pA1); }
            write_k(0, kreg0, breg0); write_v(0, vreg0);
        }
        PROF_T(pacc_c);
        __syncthreads();
        PROF_T(pacc_b);
    }
#ifdef PROF_SEL
    const unsigned long long pl1 = __builtin_amdgcn_s_memrealtime();
#endif
    const float inv = 1.f / xhalf_sum(lsum);
    int tid2 = tid_in * 64 + lane_id_now(); asm volatile("" : "+v"(tid2));
    const int lane2 = tid2 & 63, hi2 = lane2 >> 5, qg2 = MODE == 0 ? ((tid2 >> 6) & 3) : (tid2 >> 6);
    const long qrow2 = tok0 + q0u + qg2 * 32 + (lane2 & 31);
    bf16* op = p.mixed16 + qrow2 * D_MODEL + (MODE == 0 ? 0 : (MODE == 1 ? 384 : 768)) + h * 64;
    if (MODE == 0) {
        LAS float* xb = (LAS float*)lds + qg2 * 2048 + lane2;
        if (map == 1) {
#pragma unroll
            for (int blk = 0; blk < 2; ++blk)
#pragma unroll
                for (int r = 0; r < 16; ++r) xb[(blk * 16 + r) * 64] = o[blk][r] * inv;
        }
        __syncthreads();
        if (map == 0) {
            const float lam_init = p.lam_init, lam = p.lam;
            float ss = 0.f;
#pragma unroll
            for (int blk = 0; blk < 2; ++blk)
#pragma unroll
                for (int r = 0; r < 16; ++r) { const float v = o[blk][r] * inv - lam * xb[(blk * 16 + r) * 64]; o[blk][r] = v; ss = fmaf(v, v, ss); }
            ss = xhalf_sum(ss);
            const float rr = rsqrtf(ss * (1.f / 64.f) + RMS_EPS) * (1.f - lam_init);
#pragma unroll
            for (int blk = 0; blk < 2; ++blk)
#pragma unroll
                for (int g = 0; g < 4; ++g) {
                    const int d = 32 * blk + 8 * g + 4 * hi2;
                    const float4 gv = *(const float4*)(p.gdiff + d);
                    v2u wv; wv.x = cvtpk(o[blk][4 * g] * rr * gv.x, o[blk][4 * g + 1] * rr * gv.y); wv.y = cvtpk(o[blk][4 * g + 2] * rr * gv.z, o[blk][4 * g + 3] * rr * gv.w);
                    *(v2u*)(op + d) = wv;
                }
        }
        __syncthreads();
    } else {
#pragma unroll
        for (int blk = 0; blk < 2; ++blk)
#pragma unroll
            for (int g = 0; g < 4; ++g) {
                const int d = 32 * blk + 8 * g + 4 * hi2;
                v2u wv; wv.x = cvtpk(o[blk][4 * g] * inv, o[blk][4 * g + 1] * inv); wv.y = cvtpk(o[blk][4 * g + 2] * inv, o[blk][4 * g + 3] * inv);
                *(v2u*)(op + d) = wv;
            }
    }
#ifdef PROF_SEL
    if (p.layer == 0 && blockIdx.x == 7 && w == PROF_WAVE && lane == 0) {
        unsigned* pw = p.prof; const unsigned long long pu1 = __builtin_amdgcn_s_memrealtime();
        atomicAdd(pw + 0, (unsigned)(pu1 - pu0)); atomicAdd(pw + 1, (unsigned)(pl1 - pl0)); atomicAdd(pw + 2, (unsigned)pacc_c); atomicAdd(pw + 3, (unsigned)pacc_b);
        atomicAdd(pw + 4, (unsigned)ntiles * 100u); atomicAdd(pw + 5, 10000u); atomicAdd(pw + 6, (unsigned)(c + 1) * 100u);
    }
#endif
}

typedef const __attribute__((address_space(4))) char* kargp_t;
__device__ __forceinline__ kargp_t karg_base() { kargp_t p = (kargp_t)__builtin_amdgcn_kernarg_segment_ptr(); asm volatile("" : "+s"(p)); return p; }
#define KARG(i) (*(const void* const __attribute__((address_space(4)))*)(kp + 8 * (i)))
#define KOUT (*(float* const __attribute__((address_space(4)))*)(kp + 224))
#define KWS (*(unsigned char* const __attribute__((address_space(4)))*)(kp + 232))
__device__ __forceinline__ void convert_layer_weights(const Args& a, int l, unsigned char* ws, LAS float* scr, int gw, int NGW, int lane) {
    const kargp_t kp = karg_base();
    const float* w_in = (const float*)KARG(3) + (size_t)l * D_MODEL * D_IN;
    const float* w_uq = (const float*)KARG(4) + (size_t)l * 256 * NQB;
    const float* w_ukv = (const float*)KARG(5) + (size_t)l * 128 * NKVB;
    const float* g_cq = (const float*)KARG(6) + l * 256;
    const float* g_ckv = (const float*)KARG(7) + l * 128;
    const float* w_out = (const float*)KARG(14) + (size_t)l * 1024 * 1024;
    transpose_rows(MapIn{w_in}, nullptr, ZP, 1024, (bf16*)(ws + WS_WIN), scr, gw, NGW, lane);
    transpose_rows(MapPlain{w_uq, NQB, NQB, 0.10206207261596575f * LOG2E_W}, g_cq, NQBP, 256, (bf16*)(ws + WS_WUQ), scr, gw, NGW, lane);
    transpose_rows(MapPlain{w_ukv, NKVB, NKVB, 1.f}, g_ckv, NKVB, 128, (bf16*)(ws + WS_WUKV), scr, gw, NGW, lane);
    transpose_rows(MapPlain{w_out, 1024, 1024, 1.f}, nullptr, 1024, 1024, (bf16*)(ws + WS_WOUT), scr, gw, NGW, lane);
    transpose_rows(MapPlain{(const float*)KARG(24) + (size_t)l * 1024 * 1024, 1024, 1024, 1.f}, nullptr, 1024, 1024, (bf16*)(ws + WS_WPG), scr, gw, NGW, lane);
    transpose_rows(MapPlain{(const float*)KARG(25) + (size_t)l * 256 * 1024, 1024, 1024, 1.f}, nullptr, 1024, 256, (bf16*)(ws + WS_WPP), scr, gw, NGW, lane);
    transpose_rows(MapGU{(const float*)KARG(21) + (size_t)l * 32 * 1024 * 256, (const float*)KARG(22) + (size_t)l * 32 * 1024 * 256}, nullptr, 32 * 512, 1024, (bf16*)(ws + WS_WGU), scr, gw, NGW, lane);
    transpose_rows(MapD{(const float*)KARG(23) + (size_t)l * 32 * 256 * 1024}, nullptr, 32 * 1024, 256, (bf16*)(ws + WS_WD), scr, gw, NGW, lane);
}

constexpr int LDS_MISC = 147456;
constexpr int PH_PER_LAYER = 9, NPH = 1 + DEPTH * PH_PER_LAYER;
template <int PH, bool DUMMY = false> __device__ __forceinline__ void run_phase(const Args& a, unsigned char* lds_raw, const int wave_s) {
    float* sm = (float*)lds_raw;
    const kargp_t kp = karg_base();
    const int G = gridDim.x, NGW = G * 8, NGT = G * NTHREADS;
    unsigned char* ws = KWS;
    const float* x0 = (const float*)KARG(0);
    const float* pin = (const float*)KARG(1);
    const int* pos = (const int*)KARG(2);
    float* cosT = (float*)(ws + WS_COS); float* sinT = (float*)(ws + WS_SIN);
    bf16* a16 = (bf16*)(ws + WS_A16); bf16* z16 = (bf16*)(ws + WS_Z16); bf16* qb16 = (bf16*)(ws + WS_QB16); bf16* kvb16 = (bf16*)(ws + WS_KVB16);
    bf16* krr16 = (bf16*)(ws + WS_KRR16); float* fcbuf = (float*)(ws + WS_FC); float* cum = (float*)(ws + WS_CUM); float* logf = (float*)(ws + WS_LOGF);
    float* rq = (float*)(ws + WS_RQ); float* rkv = (float*)(ws + WS_RKV);
    bf16* mixed16 = (bf16*)(ws + WS_MIXED16); bf16* mix16 = (bf16*)(ws + WS_MIX16);
    bf16* hs16 = (bf16*)(ws + WS_HS16); bf16* act16 = (bf16*)(ws + WS_ACT16); bf16* outs16 = (bf16*)(ws + WS_OUTS16); bf16* ple16 = (bf16*)(ws + WS_PLE16); bf16* pp16 = (bf16*)(ws + WS_PP16); bf16* p16 = (bf16*)(ws + WS_P16);
    int* ids = (int*)(ws + WS_RT + RT_IDS); float* wts = (float*)(ws + WS_RT + RT_WTS); int* rank = (int*)(ws + WS_RT + RT_RANK);
    int* etok = (int*)(ws + WS_ETOK);
    unsigned* ctl = (unsigned*)(ws + WS_CTL);

        int tid = wave_s * 64 + lane_id_now(); asm volatile("" : "+v"(tid));
        const int lane = tid & 63, wave = __builtin_amdgcn_readfirstlane(tid >> 6);
        const int gw = blockIdx.x * 8 + wave, gtid = blockIdx.x * NTHREADS + tid;
        LAS float* scr = (LAS float*)((LAS unsigned char*)lds_raw + wave * 16384);
        if constexpr (PH == 0) {
            for (int i = gtid; i < NTOK * 16; i += NGT) {
                const int tk = i >> 4, j = i & 15;
                const int j4 = j >> 2, jr = j & 3;
                const double inv = (j4 == 0 ? 1.0 : (j4 == 1 ? 0.1 : (j4 == 2 ? 0.01 : 0.001))) * (jr == 0 ? 1.0 : (jr == 1 ? 0.5623413251903491 : (jr == 2 ? 0.31622776601683794 : 0.1778279410038923)));
                const double ang = (double)pos[tk] * inv;
                const double k = rint(ang * 0.15915494309189535);
                const double r = fma(-k, 6.283185307179586, ang) - k * 2.4492935982947064e-16;
                cosT[i] = cosf((float)r); sinT[i] = sinf((float)r);
            }
            auto cvt_stream = [&](const float* sp, bf16* dp, int n8) {
                for (int i = gtid; i < n8; i += 4 * NGT) {
                    f32x4_t v[8];
#pragma unroll
                    for (int u = 0; u < 4; ++u) { v[2 * u] = *(const f32x4_t*)(sp + (size_t)(i + u * NGT) * 8); v[2 * u + 1] = *(const f32x4_t*)(sp + (size_t)(i + u * NGT) * 8 + 4); }
#pragma unroll
                    for (int u = 0; u < 4; ++u) { v4u o; o.x = pk2(v[2 * u].x, v[2 * u].y); o.y = pk2(v[2 * u].z, v[2 * u].w); o.z = pk2(v[2 * u + 1].x, v[2 * u + 1].y); o.w = pk2(v[2 * u + 1].z, v[2 * u + 1].w);
                        *(v4u*)(dp + (size_t)(i + u * NGT) * 8) = o; }
                }
            };
            for (int i = gw; i < BATCH * 32; i += NGW) {
                int v = pos[i * 64 + lane];
#pragma unroll
                for (int o_ = 1; o_ < 64; o_ <<= 1) v = max(v, __shfl_xor(v, o_));
                if (lane == 0) ((int*)(ws + WS_RT + RT_TPMAX))[i] = v;
            }
            cvt_stream(x0, a16, NTOK * D_MODEL / 8);
            cvt_stream(pin, p16, DEPTH * NTOK * PLE_DIM / 8);
            convert_layer_weights(a, 0, ws, scr, gw, NGW, lane);
        } else {
            constexpr int l = (PH - 1) / PH_PER_LAYER, sp = (PH - 1) % PH_PER_LAYER;
            const float* b_forget = (const float*)KARG(13) + l * 4;
            const float* ln1_g = (const float*)KARG(15) + l * 1024; const float* ln1_b = (const float*)KARG(16) + l * 1024;
            const float* w_group = (const float*)KARG(17) + l * 1024 * 4; const float* b_group = (const float*)KARG(18) + l * 4;
            const float* w_er = (const float*)KARG(19) + (size_t)l * 4 * 1024 * 8; const float* b_er = (const float*)KARG(20) + l * 32;
            const float* ln2_g = (const float*)KARG(26) + l * 1024; const float* ln2_b = (const float*)KARG(27) + l * 1024;
            unsigned* cnt = ctl + CW_CNT + l * 2048 + (DUMMY ? 8192 : 0);
            if (DUMMY) rank = (int*)(ws + WS_RT + 512 * 1024);
            if constexpr (sp == 0) {
                pg8::Gemm g{a16, (const bf16*)(ws + WS_WIN), NTOK, ZP, 1024, 1024, 1024};
                pg8::StaticOrder S; S.init(NTOK, ZP, G, (int)blockIdx.x);
                pg8::EpiZ E{z16, ZP, fcbuf};
                pg8::gemm_phase<pg8::EpiZ, pg8::StaticOrder, true, true>((LAS unsigned char*)lds_raw, g, S, E, tid);
                {
                    pg8::Gemm g2{p16 + (size_t)l * NTOK * PLE_DIM, (const bf16*)(ws + WS_WPP), NTOK, 1024, 256, 256, 256};
                    const int bx = (int)blockIdx.x;
                    pg8::StaticOrder S2; S2.init(NTOK, 1024, G / 2, bx >= G / 2 ? bx - G / 2 : 1 << 20);
                    pg8::EpiBf16<0> E2{pp16, 1024, nullptr, 0, 0, 1.f};
                    pg8::gemm_phase<pg8::EpiBf16<0>, pg8::StaticOrder, true, true>((LAS unsigned char*)lds_raw, g2, S2, E2, tid);
                }
            } else if constexpr (sp == 1) {
                const int g16 = lane >> 4, l16 = lane & 15;
                for (int tk = gw * 4 + g16; tk < NTOK; tk += NGW * 4) {
                    const bf16* zr = z16 + (size_t)tk * ZP;
                    const v4u ca = *(const v4u*)(zr + Z_CQ + l16 * 16), cb = *(const v4u*)(zr + Z_CQ + l16 * 16 + 8);
                    const v4u ka = *(const v4u*)(zr + Z_CKV + l16 * 8);
                    const unsigned short kr1 = zr[Z_KR + l16], kr2 = zr[Z_KR + 16 + l16];
                    const float cs = cosT[tk * 16 + l16], sn = sinT[tk * 16 + l16];
                    const float fcv = fcbuf[tk * 4 + (l16 & 3)];
                    float f[8]; float ss = 0.f;
                    unpack8(ca, f);
#pragma unroll
                    for (int i = 0; i < 8; ++i) ss = fmaf(f[i], f[i], ss);
                    unpack8(cb, f);
#pragma unroll
                    for (int i = 0; i < 8; ++i) ss = fmaf(f[i], f[i], ss);
                    float s2 = 0.f;
                    unpack8(ka, f);
#pragma unroll
                    for (int i = 0; i < 8; ++i) s2 = fmaf(f[i], f[i], s2);
#pragma unroll
                    for (int o = 1; o < 16; o <<= 1) { ss += __shfl_xor(ss, o); s2 += __shfl_xor(s2, o); }
                    if (l16 == 0) { rq[tk] = rsqrtf(ss * (1.f / 256.f) + RMS_EPS); rkv[tk] = rsqrtf(s2 * (1.f / 128.f) + RMS_EPS); }
                    const float x1 = __uint_as_float((unsigned)kr1 << 16), x2 = __uint_as_float((unsigned)kr2 << 16);
                    krr16[tk * 32 + l16] = (bf16)f2bf(x1 * cs - x2 * sn); krr16[tk * 32 + 16 + l16] = (bf16)f2bf(x2 * cs + x1 * sn);
                    if (l16 < 4) {
                        const float xf = fcv + b_forget[l16];
                        logf[tk * 4 + l16] = fminf(xf, 0.f) - log1pf(expf(-fabsf(xf)));
                    }
                }
            } else if constexpr (sp == 2) {
                {
                    pg8::Gemm g{z16 + Z_CQ, (const bf16*)(ws + WS_WUQ), NTOK, NQBP, 256, ZP, 256};
                    pg8::StaticOrder S; S.init(NTOK, NQBP, G, (int)blockIdx.x);
                    pg8::EpiRowScale E{qb16, NQBP, rq};
                    pg8::gemm_phase<pg8::EpiRowScale, pg8::StaticOrder, true, true>((LAS unsigned char*)lds_raw, g, S, E, tid);
                }
                {
                    pg8::Gemm g{z16 + Z_CKV, (const bf16*)(ws + WS_WUKV), NTOK, NKVB, 128, ZP, 128};
                    pg8::StaticOrder S; S.init(NTOK, NKVB, G, (int)((blockIdx.x + 128) % G));
                    pg8::EpiRowScale E{kvb16, NKVB, rkv};
                    pg8::gemm_phase<pg8::EpiRowScale, pg8::StaticOrder, true, true>((LAS unsigned char*)lds_raw, g, S, E, tid);
                }
                const int cw = NGW - 1 - gw;
                if (cw < 32) {
                    const int b = cw >> 2, hh = cw & 3;
                    float* cp = cum + ((size_t)b * SEQ) * 4 + hh; const float* lp = logf + ((size_t)b * SEQ) * 4 + hh;
                    float loc[32]; float run = 0.f;
#pragma unroll
                    for (int i = 0; i < 32; ++i) { run += lp[(size_t)(lane * 32 + i) * 4]; loc[i] = run; }
                    float pre = run;
#pragma unroll
                    for (int o = 1; o < 64; o <<= 1) { const float n = __shfl_up(pre, o); if (lane >= o) pre += n; }
                    pre -= run;
#pragma unroll
                    for (int i = 0; i < 32; ++i) cp[(size_t)(lane * 32 + i) * 4] = loc[i] + pre;
                }
            } else if constexpr (sp == 3) {
                float lam_init_, lam_;
                {
                    const float* lq1 = (const float*)KARG(8) + l * 32; const float* lk1 = (const float*)KARG(9) + l * 32; const float* lq2 = (const float*)KARG(10) + l * 32; const float* lk2 = (const float*)KARG(11) + l * 32;
                    lam_init_ = 0.8f - 0.6f * expf(-0.3f * (float)l);
                    float s1 = 0.f, s2 = 0.f;
                    for (int i = 0; i < 32; ++i) { s1 += lq1[i] * lk1[i]; s2 += lq2[i] * lk2[i]; }
                    lam_ = expf(s1) - expf(s2) + lam_init_;
                }
                AttnP p{z16, qb16, kvb16, krr16, cum, cosT, sinT, pos, mixed16,
                        (const float*)KARG(8) + l * 32, (const float*)KARG(9) + l * 32, (const float*)KARG(10) + l * 32, (const float*)KARG(11) + l * 32,
                        (const float*)KARG(12) + l * 64, l, ctl + 14000, (const int*)(ws + WS_RT + RT_TPMAX), lam_, lam_init_};
                volatile LAS int* qslot = (volatile LAS int*)((LAS unsigned char*)lds_raw + LDS_MISC) + 48;
                unsigned* qctr = ctl + 12288 + l * 64 + (DUMMY ? 32 : 0);
                int idx = (int)blockIdx.x;
                for (;;) {
                    if (idx >= 1408) break;
                    int nxt_idx = 0;
                    if (wave_s == 0 && lane_id_now() == 0) nxt_idx = G + (int)atomicAdd(qctr, 1u);
                    const int pi = idx / 176, r = idx % 176, thi = 32 - 4 * pi;
                    if (r < 48) attn_unit<0>(p, r / 6, r % 6, thi / 2 - 1, (LAS unsigned char*)lds_raw, wave_s);
                    else if (r < 96) attn_unit<1>(p, (r - 48) / 6, (r - 48) % 6, thi / 4 - 1, (LAS unsigned char*)lds_raw, wave_s);
                    else if (r < 128) attn_unit<2>(p, (r - 96) / 4, (r - 96) % 4, thi / 4 - 1, (LAS unsigned char*)lds_raw, wave_s);
                    else attn_unit<0>(p, (r - 128) / 6, (r - 128) % 6, (thi - 2) / 2 - 1, (LAS unsigned char*)lds_raw, wave_s);
                    __syncthreads();
                    if (wave_s == 0 && lane_id_now() == 0) *qslot = nxt_idx;
                    __syncthreads();
                    idx = __builtin_amdgcn_readfirstlane(*qslot);
                }
            } else if constexpr (sp == 4) {
                pg8::Gemm g{mixed16, (const bf16*)(ws + WS_WOUT), NTOK, 1024, 1024, 1024, 1024};
                pg8::StaticOrder S; S.init(NTOK, 1024, G, (int)blockIdx.x);
                pg8::EpiBf16<0> E{mix16, 1024, nullptr, 0, 0, 1.f};
                pg8::gemm_phase<pg8::EpiBf16<0>, pg8::StaticOrder, true, true>((LAS unsigned char*)lds_raw, g, S, E, tid);
            } else if constexpr (sp == 5) {
#ifdef PROF_LN1
                if (l == 0 && blockIdx.x == 0 && tid == 0) ctl[14000 + 19] = (unsigned)(__builtin_amdgcn_s_memrealtime() & 0xffffffffu);
#endif
                LAS f32x4_t* Lg = (LAS f32x4_t*)lds_raw; LAS f32x4_t* Le = Lg + 1024;
                LAS unsigned* lcnt = (LAS unsigned*)((LAS unsigned char*)lds_raw + LDS_MISC) + 16;
                __syncthreads();
                if (tid < 32) lcnt[tid] = 0u;
                for (int k = tid; k < 1024; k += NTHREADS) { const int j = k >> 8, ln = (k & 255) >> 2, i = k & 3; Lg[(j * 4 + i) * 64 + ln] = *(const f32x4_t*)(w_group + (size_t)k * 4); }
                for (int q = tid; q < 4 * 1024 * 2; q += NTHREADS) { const int g = q >> 11, k = (q >> 1) & 1023, half = q & 1; const int j = k >> 8, ln = (k & 255) >> 2, i = k & 3;
                    Le[((g * 16 + j * 4 + i) * 2 + half) * 64 + ln] = *(const f32x4_t*)(w_er + (size_t)q * 4); }
                __syncthreads();
#ifdef PROF_LN1
                if (l == 0 && blockIdx.x == 0 && tid == 0) ctl[14000 + 20] = (unsigned)(__builtin_amdgcn_s_memrealtime() & 0xffffffffu);
#endif
                float4 xvA[4], xvB[4]; v2u mwA[4], mwB[4];
                auto ld_x = [&](int tk, int j) -> float4 {
                    if (l == 0) return *(const float4*)(x0 + (size_t)tk * D_MODEL + j * 256 + lane * 4);
                    const v2u xw = *(const v2u*)(a16 + (size_t)tk * D_MODEL + j * 256 + lane * 4);
                    return make_float4(bflo(xw.x), bfhi(xw.x), bflo(xw.y), bfhi(xw.y));
                };
                auto ld_tok = [&](int tk, float4 (&xv)[4], v2u (&mw)[4]) {
                    if (tk < NTOK) {
#pragma unroll
                        for (int j = 0; j < 4; ++j) { xv[j] = ld_x(tk, j); mw[j] = *(const v2u*)(mix16 + (size_t)tk * D_MODEL + j * 256 + lane * 4); }
                    }
                };
                auto do_tok = [&](int tk, float4 (&xv)[4], v2u (&mw)[4]) {
                    float4 v[4]; float s = 0.f;
#pragma unroll
                    for (int j = 0; j < 4; ++j) {
                        v[j] = make_float4(ALPHA * xv[j].x + bflo(mw[j].x), ALPHA * xv[j].y + bfhi(mw[j].x), ALPHA * xv[j].z + bflo(mw[j].y), ALPHA * xv[j].w + bfhi(mw[j].y));
                        s += (v[j].x + v[j].y) + (v[j].z + v[j].w);
                    }
                    ld_tok(tk + 2 * NGW, xv, mw);
                    const float mean = wave_sum(s) * (1.f / 1024.f); float s2 = 0.f;
#pragma unroll
                    for (int j = 0; j < 4; ++j) { v[j].x -= mean; v[j].y -= mean; v[j].z -= mean; v[j].w -= mean; s2 += (v[j].x * v[j].x + v[j].y * v[j].y) + (v[j].z * v[j].z + v[j].w * v[j].w); }
                    const float rstd = rsqrtf(wave_sum(s2) * (1.f / 1024.f) + LN_EPS);
                    float gl[4] = {0.f, 0.f, 0.f, 0.f};
#pragma unroll
                    for (int j = 0; j < 4; ++j) {
                        const int d0 = j * 256 + lane * 4;
                        const float4 gg = *(const float4*)(ln1_g + d0), bb = *(const float4*)(ln1_b + d0);
                        v[j] = make_float4(v[j].x * rstd * gg.x + bb.x, v[j].y * rstd * gg.y + bb.y, v[j].z * rstd * gg.z + bb.z, v[j].w * rstd * gg.w + bb.w);
                        { v2u hb; hb.x = pk2(v[j].x, v[j].y); hb.y = pk2(v[j].z, v[j].w); *(v2u*)(a16 + (size_t)tk * D_MODEL + d0) = hb; }
                        const float hv[4] = {v[j].x, v[j].y, v[j].z, v[j].w};
#pragma unroll
                        for (int i = 0; i < 4; ++i) {
                            const f32x4_t wg = Lg[(j * 4 + i) * 64 + lane];
                            gl[0] = fmaf(hv[i], wg.x, gl[0]); gl[1] = fmaf(hv[i], wg.y, gl[1]); gl[2] = fmaf(hv[i], wg.z, gl[2]); gl[3] = fmaf(hv[i], wg.w, gl[3]);
                        }
                    }
#pragma unroll
                    for (int i = 0; i < 4; ++i) gl[i] = wave_sum(gl[i]) + b_group[i];
                    int gi = 0; float gm = gl[0];
#pragma unroll
                    for (int i = 1; i < 4; ++i) if (gl[i] > gm) { gm = gl[i]; gi = i; }
                    gi = __builtin_amdgcn_readfirstlane(gi);
                    float gden = 0.f;
#pragma unroll
                    for (int i = 0; i < 4; ++i) gden += __expf(gl[i] - gm);
                    const float gwt = 1.f / gden;
                    float el[8] = {0.f, 0.f, 0.f, 0.f, 0.f, 0.f, 0.f, 0.f};
                    const LAS f32x4_t* we = Le + gi * 2048;
#pragma unroll
                    for (int j = 0; j < 4; ++j) {
                        const float hv[4] = {v[j].x, v[j].y, v[j].z, v[j].w};
#pragma unroll
                        for (int i = 0; i < 4; ++i) {
                            const f32x4_t w0 = we[((j * 4 + i) * 2) * 64 + lane], w1 = we[((j * 4 + i) * 2 + 1) * 64 + lane];
                            el[0] = fmaf(hv[i], w0.x, el[0]); el[1] = fmaf(hv[i], w0.y, el[1]); el[2] = fmaf(hv[i], w0.z, el[2]); el[3] = fmaf(hv[i], w0.w, el[3]);
                            el[4] = fmaf(hv[i], w1.x, el[4]); el[5] = fmaf(hv[i], w1.y, el[5]); el[6] = fmaf(hv[i], w1.z, el[6]); el[7] = fmaf(hv[i], w1.w, el[7]);
                        }
                    }
#pragma unroll
                    for (int i = 0; i < 8; ++i) el[i] = wave_sum(el[i]) + b_er[gi * 8 + i];
                    int i0 = 0; float v0 = el[0];
#pragma unroll
                    for (int i = 1; i < 8; ++i) if (el[i] > v0) { v0 = el[i]; i0 = i; }
                    int i1 = -1; float v1 = -INFINITY;
#pragma unroll
                    for (int i = 0; i < 8; ++i) if (i != i0 && el[i] > v1) { v1 = el[i]; i1 = i; }
                    const float e1 = __expf(v1 - v0);
                    const float w0 = gwt / (1.f + e1), w1 = gwt * e1 / (1.f + e1);
                    if (lane == 0) {
                        const int ea = gi * 8 + i0, eb = gi * 8 + i1;
                        ids[tk * 2] = ea; ids[tk * 2 + 1] = eb; wts[tk * 2] = w0; wts[tk * 2 + 1] = w1;
                        rank[tk * 2] = (int)__hip_atomic_fetch_add(lcnt + ea, 1u, __ATOMIC_RELAXED, __HIP_MEMORY_SCOPE_WORKGROUP);
                        rank[tk * 2 + 1] = (int)__hip_atomic_fetch_add(lcnt + eb, 1u, __ATOMIC_RELAXED, __HIP_MEMORY_SCOPE_WORKGROUP);
                    }
                };
                ld_tok(gw, xvA, mwA); ld_tok(gw + NGW, xvB, mwB);
                for (int tk = gw; tk < NTOK; tk += 2 * NGW) {
                    do_tok(tk, xvA, mwA);
                    if (tk + NGW < NTOK) do_tok(tk + NGW, xvB, mwB);
                }
#ifdef PROF_LN1
                if (l == 0 && blockIdx.x == 0 && tid == 0) ctl[14000 + 21] = (unsigned)(__builtin_amdgcn_s_memrealtime() & 0xffffffffu);
#endif
                __syncthreads();
                if (tid < 32) { const unsigned n = lcnt[tid]; lcnt[tid] = n ? atomicAdd(cnt + tid * 64, n) : 0u; }
                __syncthreads();
                if (lane == 0) for (int tk = gw; tk < NTOK; tk += NGW) {
                    const int ea = ids[tk * 2], eb = ids[tk * 2 + 1];
                    const int ra = rank[tk * 2] + (int)lcnt[ea], rb = rank[tk * 2 + 1] + (int)lcnt[eb];
                    rank[tk * 2] = ra; rank[tk * 2 + 1] = rb;
                    if (!DUMMY) { etok[ea * 16384 + ra] = tk; etok[eb * 16384 + rb] = tk; }
                }
                __syncthreads();
            } else if constexpr (sp == 6) {
                LAS int* xs = (LAS int*)((LAS unsigned char*)lds_raw + 131072); LAS int* te = xs + 80;
                __syncthreads();
                if (tid == 0) { int o = 0; for (int e = 0; e < 32; ++e) { xs[e] = o; o += ((int)cnt[e * 64] + 255) & ~255; } xs[32] = o; }
                if (tid < 32) xs[40 + tid] = (int)cnt[tid * 64];
                __syncthreads();
                if (tid < NSLOT_TILES) { int e = 31; for (int k = 31; k >= 0; --k) if (tid * 256 < xs[k + 1]) e = k; te[tid] = e; }
                __syncthreads();
                const int T = xs[32] >> 8, nU1 = 2 * T;
                const int vc = (int)((blockIdx.x % 8) * (G / 8) + blockIdx.x / 8);
                unsigned go[2][2][2]; int upm[2], upn[2]; int nun = 0;
#pragma unroll
                for (int i = 0; i < 2; ++i) {
                    const int g = vc + i * G;
                    upm[i] = 0; upn[i] = 0;
#pragma unroll
                    for (int h = 0; h < 2; ++h) { go[i][h][0] = 0u; go[i][h][1] = 0u; }
                    if (g < nU1) {
                        const int t = g >> 1, e = __builtin_amdgcn_readfirstlane(te[t]);
                        const int tl = t - (xs[e] >> 8), ce = xs[40 + e];
                        upm[i] = t + pg8::XPM; upn[i] = e * 2 + (g & 1) + pg8::XPN; nun = i + 1;
#pragma unroll
                        for (int pc = 0; pc < 2; ++pc) { int R, C; pg8::stage_rc(tid * 16 + pc * 8192, R, C);
#pragma unroll
                            for (int h = 0; h < 2; ++h) { const int rk = tl * 256 + h * 128 + R; const int tok = rk < ce ? etok[e * 16384 + rk] : 0; go[i][h][pc] = (unsigned)tok * 2048u + (unsigned)C * 2u; } }
                    } else if (g - nU1 < 256) {
                        const int k = g - nU1;
                        upm[i] = k >> 2; upn[i] = k & 3; nun = i + 1;
#pragma unroll
                        for (int pc = 0; pc < 2; ++pc) { int R, C; pg8::stage_rc(tid * 16 + pc * 8192, R, C);
#pragma unroll
                            for (int h = 0; h < 2; ++h) go[i][h][pc] = (unsigned)((k >> 2) * 256 + h * 128 + R) * 2048u + (unsigned)C * 2u; }
                    }
                }
                if (nun == 1) {
#pragma unroll
                    for (int h = 0; h < 2; ++h) { go[1][h][0] = go[0][h][0]; go[1][h][1] = go[0][h][1]; }
                }
                {
                    pg8::Gemm g{a16, (const bf16*)(ws + WS_WPG), NTOK, 1024, 1024, 1024, 1024};
                    pg8::TwoUnits S{upm[0], upn[0], upm[1], upn[1], nun};
                    pg8::EpiX E{pg8::EpiGU{act16}, pg8::EpiPleGate{ple16, pp16}};
                    pg8::gemm_phase_ga<pg8::EpiX, pg8::TwoUnits, true, true>((LAS unsigned char*)lds_raw, g, S, E, tid, go[0], go[1]);
                }
            } else if constexpr (sp == 7) {
                LAS int* xs = (LAS int*)((LAS unsigned char*)lds_raw + 131072); LAS int* te = xs + 80;
                __syncthreads();
                if (tid == 0) { int o = 0; for (int e = 0; e < 32; ++e) { xs[e] = o; o += ((int)cnt[e * 64] + 255) & ~255; } xs[32] = o; }
                __syncthreads();
                if (tid < NSLOT_TILES) { int e = 31; for (int k = 31; k >= 0; --k) if (tid * 256 < xs[k + 1]) e = k; te[tid] = e; }
                __syncthreads();
                const int T = xs[32] >> 8;
                const int vc = (int)((blockIdx.x % 8) * (G / 8) + blockIdx.x / 8);
                int nB2 = 2 * T - G; nB2 = nB2 < 0 ? 0 : nB2;
                if (vc >= nB2) {
                    pg8::Gemm g{act16, (const bf16*)(ws + WS_WD), MAX_SLOTS, 32 * 1024, 256, 256, 256};
                    pg8::GroupSched S{(const int*)te, T, 4, G - nB2, vc - nB2};
                    pg8::EpiDown E{outs16};
                    pg8::gemm_phase<pg8::EpiDown, pg8::GroupSched, true, true>((LAS unsigned char*)lds_raw, g, S, E, tid);
                } else {
                    const int k = 256 - nB2 + vc;
                    pg8::Gemm g{a16, (const bf16*)(ws + WS_WPG), NTOK, 1024, 1024, 1024, 1024};
                    pg8::OneUnit S{k >> 2, k & 3};
                    pg8::EpiPleGate E{ple16, pp16};
                    pg8::gemm_phase<pg8::EpiPleGate, pg8::OneUnit, true, true>((LAS unsigned char*)lds_raw, g, S, E, tid);
                }
            } else if constexpr (sp == 8) {
                LAS int* xs = (LAS int*)((LAS unsigned char*)lds_raw + 131072);
                __syncthreads();
                if (tid == 0) { int o = 0; for (int e = 0; e < 32; ++e) { xs[e] = o; o += ((int)cnt[e * 64] + 255) & ~255; } }
                __syncthreads();
                struct Ln2Regs { v2u hv[4], oa[4], ob[4], pv[4]; float w0, w1; };
                Ln2Regs RA, RB;
                auto ld_rows = [&](int tk, Ln2Regs& R) {
                    if (tk < NTOK) {
                        const int s0 = xs[ids[tk * 2]] + rank[tk * 2], s1 = xs[ids[tk * 2 + 1]] + rank[tk * 2 + 1]; R.w0 = wts[tk * 2]; R.w1 = wts[tk * 2 + 1];
#pragma unroll
                        for (int j = 0; j < 4; ++j) {
                            const int d0 = j * 256 + lane * 4;
                            R.hv[j] = *(const v2u*)(a16 + (size_t)tk * D_MODEL + d0);
                            R.oa[j] = *(const v2u*)(outs16 + (size_t)s0 * D_MODEL + d0); R.ob[j] = *(const v2u*)(outs16 + (size_t)s1 * D_MODEL + d0);
                            R.pv[j] = *(const v2u*)(ple16 + (size_t)tk * D_MODEL + d0);
                        }
                    }
                };
                auto do_row = [&](int tk, Ln2Regs& R) {
                    float4 v[4]; float s = 0.f; const float w0 = R.w0, w1 = R.w1;
#pragma unroll
                    for (int j = 0; j < 4; ++j) {
                        v[j] = make_float4(ALPHA * bflo(R.hv[j].x) + w0 * bflo(R.oa[j].x) + w1 * bflo(R.ob[j].x) + bflo(R.pv[j].x), ALPHA * bfhi(R.hv[j].x) + w0 * bfhi(R.oa[j].x) + w1 * bfhi(R.ob[j].x) + bfhi(R.pv[j].x),
                                           ALPHA * bflo(R.hv[j].y) + w0 * bflo(R.oa[j].y) + w1 * bflo(R.ob[j].y) + bflo(R.pv[j].y), ALPHA * bfhi(R.hv[j].y) + w0 * bfhi(R.oa[j].y) + w1 * bfhi(R.ob[j].y) + bfhi(R.pv[j].y));
                        s += (v[j].x + v[j].y) + (v[j].z + v[j].w);
                    }
                    ld_rows(tk + 2 * NGW, R);
                    const float mean = wave_sum(s) * (1.f / 1024.f); float s2 = 0.f;
#pragma unroll
                    for (int j = 0; j < 4; ++j) { v[j].x -= mean; v[j].y -= mean; v[j].z -= mean; v[j].w -= mean; s2 += (v[j].x * v[j].x + v[j].y * v[j].y) + (v[j].z * v[j].z + v[j].w * v[j].w); }
                    const float rstd = rsqrtf(wave_sum(s2) * (1.f / 1024.f) + LN_EPS);
#pragma unroll
                    for (int j = 0; j < 4; ++j) {
                        const int d0 = j * 256 + lane * 4;
                        const float4 gg = *(const float4*)(ln2_g + d0), bb = *(const float4*)(ln2_b + d0);
                        const float4 o = make_float4(v[j].x * rstd * gg.x + bb.x, v[j].y * rstd * gg.y + bb.y, v[j].z * rstd * gg.z + bb.z, v[j].w * rstd * gg.w + bb.w);
                        if (!DUMMY || w0 == 12345.678f) {
                        if (l == DEPTH - 1) {
#ifdef PROF_SEL
#ifdef PROF_LN1
                        float4 oo = o; { const float dlt = sqrtf((float)(ctl[14000 + PROF_LN1 + 1] - ctl[14000 + PROF_LN1]) * 1e-8f);
#else
                        float4 oo = o; { const float dlt = sqrtf((float)ctl[14000 + PROF_SEL] * 1e-8f);
#endif
                        oo.x += dlt; oo.y += dlt; oo.z += dlt; oo.w += dlt; }
                        *(float4*)(KOUT + (size_t)tk * D_MODEL + d0) = oo;
#else
                        *(float4*)(KOUT + (size_t)tk * D_MODEL + d0) = o;
#endif
                        } else {
                        v2u ob16; ob16.x = pk2(o.x, o.y); ob16.y = pk2(o.z, o.w);
                        *(v2u*)(a16 + (size_t)tk * D_MODEL + d0) = ob16;
                        }
                        }
                    }
                };
                ld_rows(gw, RA); ld_rows(gw + NGW, RB);
                for (int tk = gw; tk < NTOK; tk += 2 * NGW) {
                    do_row(tk, RA);
                    if (tk + NGW < NTOK) do_row(tk + NGW, RB);
                }
                if (l + 1 < DEPTH) convert_layer_weights(a, l + 1, ws, scr, gw, NGW, lane);
            }
        }
}

constexpr int CW_BAR = 4096;
__global__ void __launch_bounds__(NTHREADS, 2) mega(Args a) {
    extern __shared__ __attribute__((aligned(16))) unsigned char lds_raw[];
    cg::grid_group grid = cg::this_grid();
    volatile LAS unsigned* misc = (volatile LAS unsigned*)((LAS unsigned char*)lds_raw + LDS_MISC);
    if (threadIdx.x < 16) misc[threadIdx.x] = 0u;
    __syncthreads();
    XcdBarrier bar = xcd_barrier_post((unsigned*)(a.ws + WS_CTL) + CW_BAR, misc + 8);
    const int wave_s = __builtin_amdgcn_readfirstlane(threadIdx.x >> 6);
#define IS_T0 (wave_s == 0 && lane_id_now() == 0)
#ifndef DUP_SP
#define DUP_SP -1
#endif
#ifndef DUP_X
#define DUP_X 0
#endif
    if (a.ph_hi < 0) grid.sync();
#define SEAM(ph) do { xcd_barrier(bar, IS_T0); } while (0)
#ifdef PROF_PH
    unsigned long long ph_t_prev = __builtin_amdgcn_s_memrealtime();
#define PHASE_STAMP(ph) do { const unsigned long long t_ = __builtin_amdgcn_s_memrealtime(); if ((ph) == PROF_PH && blockIdx.x == 0 && IS_T0) ((unsigned*)(a.ws + WS_CTL))[14000 + PROF_SEL] = (unsigned)(t_ - ph_t_prev); ph_t_prev = t_; } while (0)
#else
#define PHASE_STAMP(ph) do {} while (0)
#endif
#define RUN(ph) if (a.ph_lo <= (ph) && (ph) < a.ph_hi) { \
        if (DUP_X == 9 && (ph) > 0 && ((ph) - 1) % PH_PER_LAYER == 9) { run_phase<ph, true>(a, lds_raw, wave_s); xcd_barrier(bar, IS_T0); } \
        run_phase<ph>(a, lds_raw, wave_s); \
        if ((ph) > 0 && ((ph) - 1) % PH_PER_LAYER == DUP_SP) { xcd_barrier(bar, IS_T0); run_phase<ph>(a, lds_raw, wave_s); } \
        if (DUP_X == 100 && (ph) == 0) { xcd_barrier(bar, IS_T0); run_phase<ph>(a, lds_raw, wave_s); } \
        if (DUP_X == 5 && (ph) == 6) { xcd_barrier(bar, IS_T0); run_phase<ph, true>(a, lds_raw, wave_s); } \
        if (DUP_X == 3 && (ph) > 0 && ((ph) - 1) % PH_PER_LAYER == 3) { xcd_barrier(bar, IS_T0); run_phase<ph, true>(a, lds_raw, wave_s); } \
        if ((ph) + 1 < a.ph_hi && (ph) + 1 < NPH) SEAM(ph); PHASE_STAMP(ph); }
    RUN(0) RUN(1) RUN(2) RUN(3) RUN(4) RUN(5) RUN(6) RUN(7) RUN(8) RUN(9)
    RUN(10) RUN(11) RUN(12) RUN(13) RUN(14) RUN(15) RUN(16) RUN(17) RUN(18)
#undef RUN
#undef SEAM
}

extern "C" void kernel_launch(void* const* d_in, const int* in_sizes, int n_in, void* d_out, int out_size, void* d_ws, size_t ws_size, hipStream_t stream) {
    static int grid = 0;
    if (grid == 0) {
        if (n_in != 28 || ws_size < WS_END) { fprintf(stderr, "kernel_launch: unexpected n_in %d or ws_size %zu (< %zu)\n", n_in, ws_size, (size_t)WS_END); grid = -1; return; }
        int dev = 0, cus = 0, per_cu = 0;
        (void)hipGetDevice(&dev);
        (void)hipDeviceGetAttribute(&cus, hipDeviceAttributeMultiprocessorCount, dev);
        (void)hipFuncSetAttribute((const void*)mega, hipFuncAttributeMaxDynamicSharedMemorySize, LDS_BYTES);
        (void)hipOccupancyMaxActiveBlocksPerMultiprocessor(&per_cu, (const void*)mega, NTHREADS, LDS_BYTES);
        if (per_cu < 1) { fprintf(stderr, "kernel_launch: occupancy query says %d blocks/CU\n", per_cu); }
        (void)hipGetLastError();
        grid = cus;
    }
    if (grid < 0) return;
    (void)hipMemsetAsync((char*)d_ws + WS_CTL, 0, 64 * 1024, stream);
    Args a{};
    for (int i = 0; i < 28; ++i) a.in[i] = d_in[i];
    a.out = (float*)d_out; a.ws = (unsigned char*)d_ws; a.ph_lo = 0; a.ph_hi = NPH;
    void* params[] = {&a};
    hipError_t e = hipLaunchCooperativeKernel((const void*)mega, dim3(grid), dim3(NTHREADS), params, LDS_BYTES, stream);
    if (e != hipSuccess) fprintf(stderr, "cooperative launch failed: %s (grid %d)\n", hipGetErrorString(e), grid);
}
```

```cpp
#include <hip/hip_runtime.h>
#include <hip/hip_cooperative_groups.h>
#include <cstdio>
#include <cstdint>
namespace cg = cooperative_groups;

constexpr int D_MODEL = 1024, BATCH = 8, SEQ = 2048, NTOK = BATCH * SEQ, DEPTH = 2;
constexpr int D_IN = 2340;
constexpr int OFF_QA = 0, OFF_KA = 384, OFF_VA = 768, OFF_CQ = 1152, OFF_CKV = 1408, OFF_KR = 1536,
              OFF_QC = 1568, OFF_KC = 1824, OFF_VC = 2080, OFF_FC = 2336;
constexpr int ZP = 2560;
constexpr int Z_QA = 0, Z_KA = 384, Z_VA = 768, Z_QC = 1152, Z_KC = 1408, Z_VC = 1664, Z_CKV = 1920, Z_CQ = 2048, Z_KR = 2304, Z_FC = 2336;
constexpr int NQB = 576, NKVB = 768, NQBP = 768;
constexpr int N_EXPERTS = 32, D_EXPERT = 256, PLE_DIM = 256;
constexpr int MAX_SLOTS = 32768 + 32 * 256;
constexpr int NSLOT_TILES = MAX_SLOTS / 256;
constexpr float ALPHA = 1.4142135623730951f;
constexpr float LN_EPS = 1e-5f, RMS_EPS = 1e-6f;
constexpr int NTHREADS = 512;
constexpr int LDS_BYTES = 147456 + 256;

constexpr size_t MiB = 1u << 20;
constexpr size_t WS_CTL = 0;
constexpr size_t WS_COS = 1 * MiB, WS_SIN = 2 * MiB;
constexpr size_t WS_WIN = 3 * MiB;
constexpr size_t WS_WUQ = 8 * MiB;
constexpr size_t WS_WUKV = WS_WUQ + 393216;
constexpr size_t WS_WOUT = 9 * MiB;
constexpr size_t WS_WPG = 11 * MiB;
constexpr size_t WS_WPP = 13 * MiB;
constexpr size_t WS_WGU = 14 * MiB;
constexpr size_t WS_WD = 46 * MiB;
constexpr size_t WS_A16 = 62 * MiB;
constexpr size_t WS_P16 = 94 * MiB;
constexpr size_t WS_Z16 = 110 * MiB;
constexpr size_t WS_HS16 = WS_Z16;
constexpr size_t WS_OUTS16 = WS_Z16;
constexpr size_t WS_QB16 = 190 * MiB;
constexpr size_t WS_KVB16 = 214 * MiB;
constexpr size_t WS_KRR16 = 238 * MiB;
constexpr size_t WS_FC = 239 * MiB;
constexpr size_t WS_CUM = WS_FC + 256 * 1024;
constexpr size_t WS_LOGF = WS_CUM + 256 * 1024;
constexpr size_t WS_RQ = WS_LOGF + 256 * 1024;
constexpr size_t WS_RKV = WS_RQ + 64 * 1024;
constexpr size_t WS_MIX16 = 190 * MiB;
constexpr size_t WS_PP16 = 276 * MiB;
constexpr size_t WS_ACT16 = 222 * MiB;
constexpr size_t WS_MIXED16 = 242 * MiB;
constexpr size_t WS_PLE16 = 242 * MiB;
constexpr size_t WS_RT = 274 * MiB;
constexpr size_t WS_ETOK = 308 * MiB;
constexpr size_t WS_END = 310 * MiB;
constexpr size_t RT_IDS = 0, RT_WTS = 128 * 1024, RT_RANK = 256 * 1024, RT_SLOTOF = 384 * 1024, RT_TILEE = 768 * 1024, RT_TPMAX = 800 * 1024;
constexpr int CW_CNT = 0;
static_assert((WS_A16 - WS_HS16) % (256 * 1024 * 2) == 0 || true, "");

struct Args { const void* in[28]; float* out; unsigned char* ws; int ph_lo, ph_hi; };

#define LAS __attribute__((address_space(3)))
typedef unsigned short bf16;
typedef unsigned v4u __attribute__((ext_vector_type(4)));
typedef unsigned v2u __attribute__((ext_vector_type(2)));
typedef float f32x4_t __attribute__((ext_vector_type(4)));

__device__ __forceinline__ float wave_sum(float v) {
#define WS_DPP(ctrl, rmask) __builtin_bit_cast(float, __builtin_amdgcn_update_dpp(0, __builtin_bit_cast(int, v), (ctrl), (rmask), 0xf, true))
    v += WS_DPP(0x111, 0xf);
    v += WS_DPP(0x112, 0xf);
    v += WS_DPP(0x114, 0xf);
    v += WS_DPP(0x118, 0xf);
    v += WS_DPP(0x142, 0xa);
    v += WS_DPP(0x143, 0xc);
#undef WS_DPP
    return __builtin_bit_cast(float, __builtin_amdgcn_readlane(__builtin_bit_cast(int, v), 63));
}
__device__ __forceinline__ unsigned f2bf(float f) { unsigned u = __builtin_bit_cast(unsigned, f); return (u + 0x7fffu + ((u >> 16) & 1u)) >> 16; }
__device__ __forceinline__ unsigned pk2(float lo, float hi) { return f2bf(lo) | (f2bf(hi) << 16); }
__device__ __forceinline__ float bflo(unsigned w) { return __uint_as_float(w << 16); }
__device__ __forceinline__ float bfhi(unsigned w) { return __uint_as_float(w & 0xffff0000u); }
__device__ __forceinline__ void unpack8(const v4u w, float* f) { f[0] = bflo(w.x); f[1] = bfhi(w.x); f[2] = bflo(w.y); f[3] = bfhi(w.y); f[4] = bflo(w.z); f[5] = bfhi(w.z); f[6] = bflo(w.w); f[7] = bfhi(w.w); }
__device__ __forceinline__ int lane_id_now() { int l; asm volatile("v_mbcnt_lo_u32_b32 %0, -1, 0\n\tv_mbcnt_hi_u32_b32 %0, -1, %0" : "=v"(l)); return l; }
namespace pg8 {
#define PG8_LAS __attribute__((address_space(3)))
typedef unsigned short bf16_t;
typedef short bf16x8 __attribute__((ext_vector_type(8)));
typedef float f32x4 __attribute__((ext_vector_type(4)));
typedef unsigned u32x4 __attribute__((ext_vector_type(4)));
constexpr int BM = 256, BK = 64, HALF = 128, HTB = HALF * BK * 2  , STAGE_BYTES = 8 * HTB, NXCD = 8, WGM = 8;

__host__ __device__ __forceinline__ int lds_byte(int r, int c) { const int st = (r >> 4) * 2 + (c >> 5), rr = r & 15, cc = c & 31, ob = rr * 64 + cc * 2; return st * 1024 + (ob ^ (((ob >> 9) & 1) << 5)); }
__host__ __device__ __forceinline__ void stage_rc(int b, int& R, int& C) { const int st = b / 1024, sb = b % 1024, swz = sb ^ (((sb >> 9) & 1) << 5); R = (st >> 1) * 16 + swz / 64; C = (st & 1) * 32 + (swz % 64) / 2; }
__host__ __device__ __forceinline__ int perm32(int rho) { const int n = rho >> 4, i = rho & 15; return 8 * (i >> 2) + 4 * n + (i & 3); }

struct Unit { int pm, pn; };
struct Gemm { const bf16_t* A; const bf16_t* Bt; int M, N, K, lda, ldb; };

struct StaticOrder {
    int nM, nN, nwg, G, c;
    __host__ __device__ void init(int M, int N, int G_, int c_) { nM = M / BM; nN = N / BM; nwg = nM * nN; G = G_; c = c_; }
    __host__ __device__ bool next(int i, Unit& u) const {
        const long L = (long)i * G + c; if (L >= nwg) return false;
        int wgid = (int)L; { const int q = nwg / NXCD, r = nwg % NXCD, xcd = wgid % NXCD, off = wgid / NXCD; wgid = (xcd < r ? xcd * (q + 1) : r * (q + 1) + (xcd - r) * q) + off; }
        const int nig = WGM * nN, gid = wgid / nig, fm = gid * WGM, gsz = (nM - fm) < WGM ? (nM - fm) : WGM;
        u.pm = fm + ((wgid % nig) % gsz); u.pn = (wgid % nig) / gsz; return true;
    }
    __device__ __forceinline__ void a_ready(const Unit&) const {}
    __device__ __forceinline__ void done(const Unit&) const {}
};

__device__ __forceinline__ unsigned cvt_pk_bf16(float lo, float hi) { unsigned r; asm volatile("v_cvt_pk_bf16_f32 %0, %1, %2" : "=v"(r) : "v"(lo), "v"(hi)); return r; }
typedef float f32x2 __attribute__((ext_vector_type(2)));
__device__ __forceinline__ f32x2 gelu_pk(f32x2 v) {
    const f32x2 av = __builtin_elementwise_abs(v), d = av * 0.2316418882f + 1.0f;
    f32x2 t; t.x = __builtin_amdgcn_rcpf(d.x); t.y = __builtin_amdgcn_rcpf(d.y);
    f32x2 q = t * 0.5307027145f + (-0.7265760135f); q = q * t + 0.7107068705f; q = q * t + (-0.142248368f); q = q * t + 0.127414796f; q = q * t;
    const f32x2 s = (v * v) * (-0.72134752044f);
    f32x2 e; e.x = __builtin_amdgcn_exp2f(s.x); e.y = __builtin_amdgcn_exp2f(s.y);
    const f32x2 m = v * (q * e), r = v - m;
    f32x2 o; o.x = v.x < 0.f ? m.x : r.x; o.y = v.y < 0.f ? m.y : r.y; return o;
}

template <int ACT  > struct EpiBf16 {
    static constexpr bool PERM = true, AFTER_DRAIN = false; static_assert(ACT == 0 || ACT == 1, "EpiBf16: ACT is 0 (none) or 1 (gelu_pk)");
    bf16_t* O; int ldc; const float* bias; int split_cols; size_t split_stride; float scale0;
    __device__ __forceinline__ void operator()(const f32x4 (&acc)[2][2][4][2], const Unit& u, int wr, int wc, int fr, int fq) const {
        const int row0 = u.pm * BM + wr * 64 + fr; int colt = u.pn * BM; bf16_t* base = O;
        float sc = 1.f; if (split_cols) { const int t = colt / split_cols; base += (size_t)t * split_stride; colt -= t * split_cols; if (t == 0) sc = scale0; }
        const int col0 = colt + wc * 32 + 8 * fq, bcol0 = u.pn * BM + wc * 32 + 8 * fq;
        f32x4 bv[2][2];
#pragma unroll
        for (int bj = 0; bj < 2; ++bj)
#pragma unroll
            for (int n = 0; n < 2; ++n) bv[bj][n] = bias ? *(const f32x4*)(bias + bcol0 + bj * HALF + 4 * n) : (f32x4){0.f, 0.f, 0.f, 0.f};
#pragma unroll
        for (int ai = 0; ai < 2; ++ai)
#pragma unroll
            for (int m = 0; m < 4; ++m) { bf16_t* rowp = base + (size_t)(row0 + ai * HALF + m * 16) * ldc + col0;
#pragma unroll
                for (int bj = 0; bj < 2; ++bj) { f32x4 v0 = acc[ai][bj][m][0] + bv[bj][0], v1 = acc[ai][bj][m][1] + bv[bj][1];
                    if (ACT == 1) { f32x2 a = gelu_pk((f32x2){v0[0], v0[1]}), b = gelu_pk((f32x2){v0[2], v0[3]}), c = gelu_pk((f32x2){v1[0], v1[1]}), d = gelu_pk((f32x2){v1[2], v1[3]});
                        v0 = (f32x4){a.x, a.y, b.x, b.y}; v1 = (f32x4){c.x, c.y, d.x, d.y}; }
                    v0 = v0 * sc; v1 = v1 * sc; u32x4 w; w.x = cvt_pk_bf16(v0[0], v0[1]); w.y = cvt_pk_bf16(v0[2], v0[3]); w.z = cvt_pk_bf16(v1[0], v1[1]); w.w = cvt_pk_bf16(v1[2], v1[3]);
                    *(u32x4*)(rowp + bj * HALF) = w; } }
    }
};
template <class Epi, class Sched, bool ALIGN_EPI = false, bool SP2 = false>
__device__ __forceinline__ void gemm_phase(PG8_LAS unsigned char* lds, const Gemm g, const Sched& S, const Epi& E, const int tid) {
    const int wid = __builtin_amdgcn_readfirstlane(tid >> 6), lane = tid & 63, wr = wid >> 2, wc = wid & 3, fr = lane & 15, fq = lane >> 4;
    int K = g.K; asm volatile("" : "+s"(K));
    const int nt = K / BK;
    unsigned voffA[2], voffB[2];
#pragma unroll
    for (int i = 0; i < 2; ++i) { int R, C; stage_rc(tid * 16 + i * 8192, R, C); const int Rb = Epi::PERM ? ((R & ~31) + perm32(R & 31)) : R;
        voffA[i] = (unsigned)(R * g.lda + C) * 2u; voffB[i] = (unsigned)(Rb * g.ldb + C) * 2u; }
    const size_t kstep = (size_t)(BK * 2);
    const size_t hstepA = (size_t)HALF * g.lda * 2, hstepB = (size_t)HALF * g.ldb * 2;
    const size_t tstepA = 2 * hstepA, tstepB = 2 * hstepB;
    const unsigned ldsw = (unsigned)wid * 1024u;
    const int aoff = lds_byte(wr * 64 + fr, fq * 8), boff = lds_byte(wc * 32 + fr, fq * 8);
#define PG8_SA(b, h) (((b) * 2 + (h)) * HTB)
#define PG8_SB(b, h) ((4 + (b) * 2 + (h)) * HTB)
#define PG8_STAGE(bufoff, gbase, voff) do { _Pragma("unroll") for (int _i = 0; _i < 2; ++_i) \
        __builtin_amdgcn_global_load_lds((const unsigned*)((const char*)(gbase) + (voff)[_i]), (PG8_LAS unsigned*)(lds + (bufoff) + ldsw + _i * 8192), 16, 0, 0); } while (0)
#define PG8_LDA(dst, b, h) do { _Pragma("unroll") for (int m = 0; m < 4; ++m) _Pragma("unroll") for (int k = 0; k < 2; ++k) dst[m][k] = *(const PG8_LAS bf16x8*)(lds + PG8_SA(b, h) + aoff + m * 2048 + k * 1024); } while (0)
#define PG8_LDB(dst, b, h) do { _Pragma("unroll") for (int n = 0; n < 2; ++n) _Pragma("unroll") for (int k = 0; k < 2; ++k) dst[n][k] = *(const PG8_LAS bf16x8*)(lds + PG8_SB(b, h) + boff + n * 2048 + k * 1024); } while (0)
#define PG8_MMA(ai, bj, At, Bt) do { __builtin_amdgcn_s_setprio(1); _Pragma("unroll") for (int m = 0; m < 4; ++m) _Pragma("unroll") for (int n = 0; n < 2; ++n) _Pragma("unroll") for (int k = 0; k < 2; ++k) \
        acc[ai][bj][m][n] = __builtin_amdgcn_mfma_f32_16x16x32_bf16(Bt[n][k], At[m][k], acc[ai][bj][m][n], 0, 0, 0); __builtin_amdgcn_s_setprio(0); } while (0)
#define PG8_WAIT_V(n) asm volatile("s_waitcnt vmcnt(" #n ")" ::: "memory")
#define PG8_WAIT_L(n) asm volatile("s_waitcnt lgkmcnt(" #n ")" ::: "memory")
#define PG8_BAR __builtin_amdgcn_s_barrier()
#define PG8_SCHED __builtin_amdgcn_sched_barrier(0)
    Unit cur, nxt; int ui = 0;
    if (!S.next(0, cur)) return;
    f32x4 acc[2][2][4][2];
#pragma unroll
    for (int a = 0; a < 2; ++a)
#pragma unroll
        for (int b = 0; b < 2; ++b)
#pragma unroll
            for (int m = 0; m < 4; ++m)
#pragma unroll
                for (int n = 0; n < 2; ++n) acc[a][b][m][n] = (f32x4){0.f, 0.f, 0.f, 0.f};
    bf16x8 At[4][2], B0[2][2], B1[2][2];
    const char* cA = (const char*)g.A + (size_t)cur.pm * tstepA; const char* cB = (const char*)g.Bt + (size_t)cur.pn * tstepB;
    S.a_ready(cur);
    if constexpr (SP2) {
        PG8_STAGE(PG8_SB(0, 0), cB, voffB); PG8_STAGE(PG8_SB(0, 1), cB + hstepB, voffB); PG8_STAGE(PG8_SA(0, 0), cA, voffA); PG8_STAGE(PG8_SA(0, 1), cA + hstepA, voffA);
        if (wr == 1) PG8_BAR;
        PG8_WAIT_V(2); PG8_BAR;
        PG8_STAGE(PG8_SB(1, 0), cB + kstep, voffB); PG8_STAGE(PG8_SA(1, 0), cA + kstep, voffA); PG8_STAGE(PG8_SB(1, 1), cB + hstepB + kstep, voffB);
        PG8_WAIT_V(6); PG8_BAR;
    } else {
        PG8_STAGE(PG8_SB(0, 0), cB, voffB); PG8_STAGE(PG8_SA(0, 0), cA, voffA); PG8_STAGE(PG8_SB(0, 1), cB + hstepB, voffB); PG8_STAGE(PG8_SA(0, 1), cA + hstepA, voffA);
        if (wr == 1) PG8_BAR;
        PG8_WAIT_V(4); PG8_BAR;
        PG8_STAGE(PG8_SB(1, 0), cB + kstep, voffB); PG8_STAGE(PG8_SA(1, 0), cA + kstep, voffA); PG8_STAGE(PG8_SB(1, 1), cB + hstepB + kstep, voffB);
        PG8_WAIT_V(6); PG8_BAR;
    }
    for (;;) {
        const bool has_next = S.next(ui + 1, nxt);
        const char* nA = has_next ? (const char*)g.A + (size_t)nxt.pm * tstepA : cA; const char* nB = has_next ? (const char*)g.Bt + (size_t)nxt.pn * tstepB : cB;
        for (int t = 0; t < nt; t += 2) {
            const bool last = (t == nt - 2);
            const char* a1 = cA + (size_t)(t + 1) * kstep;
            const char* a2 = last ? nA : cA + (size_t)(t + 2) * kstep; const char* b2 = last ? nB : cB + (size_t)(t + 2) * kstep;
            const char* a3 = a2 + kstep; const char* b3 = b2 + kstep;
            if (last && has_next) S.a_ready(nxt);
            if constexpr (SP2) {
            PG8_LDB(B0, 0, 0); PG8_LDB(B1, 0, 1); PG8_SCHED; PG8_LDA(At, 0, 0); PG8_STAGE(PG8_SA(1, 1), a1 + hstepA, voffA);
            PG8_WAIT_V(8); PG8_WAIT_L(0); PG8_BAR; PG8_MMA(0, 0, At, B0); PG8_MMA(0, 1, At, B1); PG8_BAR; PG8_SCHED;
            PG8_LDA(At, 0, 1); PG8_STAGE(PG8_SB(0, 0), b2, voffB); PG8_STAGE(PG8_SB(0, 1), b2 + hstepB, voffB); PG8_STAGE(PG8_SA(0, 0), a2, voffA);
            PG8_WAIT_V(8); PG8_WAIT_L(0); PG8_BAR; PG8_MMA(1, 0, At, B0); PG8_MMA(1, 1, At, B1); PG8_BAR; PG8_SCHED;
            PG8_LDB(B0, 1, 0); PG8_LDB(B1, 1, 1); PG8_SCHED; PG8_LDA(At, 1, 0); PG8_STAGE(PG8_SA(0, 1), a2 + hstepA, voffA);
            PG8_WAIT_V(8); PG8_WAIT_L(0); PG8_BAR; PG8_MMA(0, 0, At, B0); PG8_MMA(0, 1, At, B1); PG8_BAR; PG8_SCHED;
            PG8_LDA(At, 1, 1); PG8_STAGE(PG8_SB(1, 0), b3, voffB); PG8_STAGE(PG8_SB(1, 1), b3 + hstepB, voffB); PG8_STAGE(PG8_SA(1, 0), a3, voffA);
            PG8_WAIT_V(8); PG8_WAIT_L(0); PG8_BAR; PG8_MMA(1, 0, At, B0); PG8_MMA(1, 1, At, B1); PG8_BAR; PG8_SCHED;
            } else {
            PG8_LDB(B0, 0, 0); PG8_SCHED; PG8_LDA(At, 0, 0); PG8_STAGE(PG8_SA(1, 1), a1 + hstepA, voffA);
            PG8_WAIT_L(8); PG8_BAR; PG8_WAIT_L(0); PG8_MMA(0, 0, At, B0); PG8_BAR; PG8_SCHED;
            PG8_LDB(B1, 0, 1); PG8_STAGE(PG8_SB(0, 0), b2, voffB);
            PG8_BAR; PG8_WAIT_L(0); PG8_MMA(0, 1, At, B1); PG8_BAR;
            PG8_LDA(At, 0, 1); PG8_STAGE(PG8_SA(0, 0), a2, voffA);
            PG8_BAR; PG8_WAIT_L(0); PG8_MMA(1, 0, At, B0); PG8_BAR; PG8_SCHED;
            PG8_STAGE(PG8_SB(0, 1), b2 + hstepB, voffB);
            PG8_WAIT_V(6); PG8_BAR; PG8_MMA(1, 1, At, B1); PG8_BAR;
            PG8_LDB(B0, 1, 0); PG8_SCHED; PG8_LDA(At, 1, 0); PG8_STAGE(PG8_SA(0, 1), a2 + hstepA, voffA);
            PG8_WAIT_L(8); PG8_BAR; PG8_WAIT_L(0); PG8_MMA(0, 0, At, B0); PG8_BAR; PG8_SCHED;
            PG8_LDB(B1, 1, 1); PG8_STAGE(PG8_SB(1, 0), b3, voffB);
            PG8_BAR; PG8_WAIT_L(0); PG8_MMA(0, 1, At, B1); PG8_BAR;
            PG8_LDA(At, 1, 1); PG8_STAGE(PG8_SA(1, 0), a3, voffA);
            PG8_BAR; PG8_WAIT_L(0); PG8_MMA(1, 0, At, B0); PG8_BAR; PG8_SCHED;
            PG8_STAGE(PG8_SB(1, 1), b3 + hstepB, voffB);
            PG8_WAIT_V(6); PG8_BAR; PG8_MMA(1, 1, At, B1); PG8_BAR;
            }
        }
        if constexpr (ALIGN_EPI) { if (wr == 0) PG8_BAR; }
        if constexpr (!Epi::AFTER_DRAIN) { E(acc, cur, wr, wc, fr, fq); S.done(cur); }
        if (!has_next) break;
#pragma unroll
        for (int a = 0; a < 2; ++a)
#pragma unroll
            for (int b = 0; b < 2; ++b)
#pragma unroll
                for (int m = 0; m < 4; ++m)
#pragma unroll
                    for (int n = 0; n < 2; ++n) acc[a][b][m][n] = (f32x4){0.f, 0.f, 0.f, 0.f};
        cur = nxt; cA = nA; cB = nB; ++ui;
        if constexpr (ALIGN_EPI) { if (wr == 1) PG8_BAR; }
    }
    PG8_WAIT_V(0);
    if constexpr (!ALIGN_EPI) { if (wr == 0) PG8_BAR; }
    PG8_BAR;
    if constexpr (Epi::AFTER_DRAIN) { E.fused(acc, cur, wr, wc, fr, fq, lds, wid, lane); S.done(cur); }
#undef PG8_SA
#undef PG8_SB
#undef PG8_STAGE
#undef PG8_LDA
#undef PG8_LDB
#undef PG8_MMA
#undef PG8_WAIT_V
#undef PG8_WAIT_L
#undef PG8_BAR
#undef PG8_SCHED
}
template <class Epi, class Sched, bool ALIGN_EPI = false, bool SP2 = false>
__device__ __forceinline__ void gemm_phase_ga(PG8_LAS unsigned char* lds, const Gemm g, const Sched& S, const Epi& E, const int tid, const unsigned (&g0)[2][2], const unsigned (&g1)[2][2]) {
    unsigned ca0[2] = {g0[0][0], g0[0][1]}, ca1[2] = {g0[1][0], g0[1][1]}; const unsigned na0[2] = {g1[0][0], g1[0][1]}, na1[2] = {g1[1][0], g1[1][1]};
    const int wid = __builtin_amdgcn_readfirstlane(tid >> 6), lane = tid & 63, wr = wid >> 2, wc = wid & 3, fr = lane & 15, fq = lane >> 4;
    int K = g.K; asm volatile("" : "+s"(K));
    const int nt = K / BK;
    unsigned voffA[2], voffB[2];
#pragma unroll
    for (int i = 0; i < 2; ++i) { int R, C; stage_rc(tid * 16 + i * 8192, R, C); const int Rb = Epi::PERM ? ((R & ~31) + perm32(R & 31)) : R;
        voffA[i] = (unsigned)(R * g.lda + C) * 2u; voffB[i] = (unsigned)(Rb * g.ldb + C) * 2u; }
    const size_t kstep = (size_t)(BK * 2);
    const size_t hstepA = (size_t)HALF * g.lda * 2, hstepB = (size_t)HALF * g.ldb * 2;
    const size_t tstepA = 2 * hstepA, tstepB = 2 * hstepB;
    const unsigned ldsw = (unsigned)wid * 1024u;
    const int aoff = lds_byte(wr * 64 + fr, fq * 8), boff = lds_byte(wc * 32 + fr, fq * 8);
#define PG8_SA(b, h) (((b) * 2 + (h)) * HTB)
#define PG8_SB(b, h) ((4 + (b) * 2 + (h)) * HTB)
#define PG8_STAGE(bufoff, gbase, voff) do { _Pragma("unroll") for (int _i = 0; _i < 2; ++_i) \
        __builtin_amdgcn_global_load_lds((const unsigned*)((const char*)(gbase) + (voff)[_i]), (PG8_LAS unsigned*)(lds + (bufoff) + ldsw + _i * 8192), 16, 0, 0); } while (0)
#define PG8_LDA(dst, b, h) do { _Pragma("unroll") for (int m = 0; m < 4; ++m) _Pragma("unroll") for (int k = 0; k < 2; ++k) dst[m][k] = *(const PG8_LAS bf16x8*)(lds + PG8_SA(b, h) + aoff + m * 2048 + k * 1024); } while (0)
#define PG8_LDB(dst, b, h) do { _Pragma("unroll") for (int n = 0; n < 2; ++n) _Pragma("unroll") for (int k = 0; k < 2; ++k) dst[n][k] = *(const PG8_LAS bf16x8*)(lds + PG8_SB(b, h) + boff + n * 2048 + k * 1024); } while (0)
#define PG8_MMA(ai, bj, At, Bt) do { __builtin_amdgcn_s_setprio(1); _Pragma("unroll") for (int m = 0; m < 4; ++m) _Pragma("unroll") for (int n = 0; n < 2; ++n) _Pragma("unroll") for (int k = 0; k < 2; ++k) \
        acc[ai][bj][m][n] = __builtin_amdgcn_mfma_f32_16x16x32_bf16(Bt[n][k], At[m][k], acc[ai][bj][m][n], 0, 0, 0); __builtin_amdgcn_s_setprio(0); } while (0)
#define PG8_WAIT_V(n) asm volatile("s_waitcnt vmcnt(" #n ")" ::: "memory")
#define PG8_WAIT_L(n) asm volatile("s_waitcnt lgkmcnt(" #n ")" ::: "memory")
#define PG8_BAR __builtin_amdgcn_s_barrier()
#define PG8_SCHED __builtin_amdgcn_sched_barrier(0)
    Unit cur, nxt; int ui = 0;
    if (!S.next(0, cur)) return;
    f32x4 acc[2][2][4][2];
#pragma unroll
    for (int a = 0; a < 2; ++a)
#pragma unroll
        for (int b = 0; b < 2; ++b)
#pragma unroll
            for (int m = 0; m < 4; ++m)
#pragma unroll
                for (int n = 0; n < 2; ++n) acc[a][b][m][n] = (f32x4){0.f, 0.f, 0.f, 0.f};
    bf16x8 At[4][2], B0[2][2], B1[2][2];
    const char* cA = (const char*)g.A; const char* cB = (const char*)g.Bt + (size_t)cur.pn * tstepB;
    S.a_ready(cur);
    if constexpr (SP2) {
        PG8_STAGE(PG8_SB(0, 0), cB, voffB); PG8_STAGE(PG8_SB(0, 1), cB + hstepB, voffB); PG8_STAGE(PG8_SA(0, 0), cA, ca0); PG8_STAGE(PG8_SA(0, 1), cA, ca1);
        if (wr == 1) PG8_BAR;
        PG8_WAIT_V(2); PG8_BAR;
        PG8_STAGE(PG8_SB(1, 0), cB + kstep, voffB); PG8_STAGE(PG8_SA(1, 0), cA + kstep, ca0); PG8_STAGE(PG8_SB(1, 1), cB + hstepB + kstep, voffB);
        PG8_WAIT_V(6); PG8_BAR;
    } else {
        PG8_STAGE(PG8_SB(0, 0), cB, voffB); PG8_STAGE(PG8_SA(0, 0), cA, ca0); PG8_STAGE(PG8_SB(0, 1), cB + hstepB, voffB); PG8_STAGE(PG8_SA(0, 1), cA, ca1);
        if (wr == 1) PG8_BAR;
        PG8_WAIT_V(4); PG8_BAR;
        PG8_STAGE(PG8_SB(1, 0), cB + kstep, voffB); PG8_STAGE(PG8_SA(1, 0), cA + kstep, ca0); PG8_STAGE(PG8_SB(1, 1), cB + hstepB + kstep, voffB);
        PG8_WAIT_V(6); PG8_BAR;
    }
    for (;;) {
        const bool has_next = S.next(ui + 1, nxt);
        const char* nA = cA; const char* nB = has_next ? (const char*)g.Bt + (size_t)nxt.pn * tstepB : cB;
        for (int t = 0; t < nt; t += 2) {
            const bool last = (t == nt - 2);
            const unsigned o20[2] = {last ? na0[0] : ca0[0], last ? na0[1] : ca0[1]}, o21[2] = {last ? na1[0] : ca1[0], last ? na1[1] : ca1[1]};
            const char* a1 = cA + (size_t)(t + 1) * kstep;
            const char* a2 = last ? nA : cA + (size_t)(t + 2) * kstep; const char* b2 = last ? nB : cB + (size_t)(t + 2) * kstep;
            const char* a3 = a2 + kstep; const char* b3 = b2 + kstep;
            if (last && has_next) S.a_ready(nxt);
            if constexpr (SP2) {
            PG8_LDB(B0, 0, 0); PG8_LDB(B1, 0, 1); PG8_SCHED; PG8_LDA(At, 0, 0); PG8_STAGE(PG8_SA(1, 1), a1, ca1);
            PG8_WAIT_V(8); PG8_WAIT_L(0); PG8_BAR; PG8_MMA(0, 0, At, B0); PG8_MMA(0, 1, At, B1); PG8_BAR; PG8_SCHED;
            PG8_LDA(At, 0, 1); PG8_STAGE(PG8_SB(0, 0), b2, voffB); PG8_STAGE(PG8_SB(0, 1), b2 + hstepB, voffB); PG8_STAGE(PG8_SA(0, 0), a2, o20);
            PG8_WAIT_V(8); PG8_WAIT_L(0); PG8_BAR; PG8_MMA(1, 0, At, B0); PG8_MMA(1, 1, At, B1); PG8_BAR; PG8_SCHED;
            PG8_LDB(B0, 1, 0); PG8_LDB(B1, 1, 1); PG8_SCHED; PG8_LDA(At, 1, 0); PG8_STAGE(PG8_SA(0, 1), a2, o21);
            PG8_WAIT_V(8); PG8_WAIT_L(0); PG8_BAR; PG8_MMA(0, 0, At, B0); PG8_MMA(0, 1, At, B1); PG8_BAR; PG8_SCHED;
            PG8_LDA(At, 1, 1); PG8_STAGE(PG8_SB(1, 0), b3, voffB); PG8_STAGE(PG8_SB(1, 1), b3 + hstepB, voffB); PG8_STAGE(PG8_SA(1, 0), a3, o20);
            PG8_WAIT_V(8); PG8_WAIT_L(0); PG8_BAR; PG8_MMA(1, 0, At, B0); PG8_MMA(1, 1, At, B1); PG8_BAR; PG8_SCHED;
            } else {
            PG8_LDB(B0, 0, 0); PG8_SCHED; PG8_LDA(At, 0, 0); PG8_STAGE(PG8_SA(1, 1), a1, ca1);
            PG8_WAIT_L(8); PG8_BAR; PG8_WAIT_L(0); PG8_MMA(0, 0, At, B0); PG8_BAR; PG8_SCHED;
            PG8_LDB(B1, 0, 1); PG8_STAGE(PG8_SB(0, 0), b2, voffB);
            PG8_BAR; PG8_WAIT_L(0); PG8_MMA(0, 1, At, B1); PG8_BAR;
            PG8_LDA(At, 0, 1); PG8_STAGE(PG8_SA(0, 0), a2, o20);
            PG8_BAR; PG8_WAIT_L(0); PG8_MMA(1, 0, At, B0); PG8_BAR; PG8_SCHED;
            PG8_STAGE(PG8_SB(0, 1), b2 + hstepB, voffB);
            PG8_WAIT_V(6); PG8_BAR; PG8_MMA(1, 1, At, B1); PG8_BAR;
            PG8_LDB(B0, 1, 0); PG8_SCHED; PG8_LDA(At, 1, 0); PG8_STAGE(PG8_SA(0, 1), a2, o21);
            PG8_WAIT_L(8); PG8_BAR; PG8_WAIT_L(0); PG8_MMA(0, 0, At, B0); PG8_BAR; PG8_SCHED;
            PG8_LDB(B1, 1, 1); PG8_STAGE(PG8_SB(1, 0), b3, voffB);
            PG8_BAR; PG8_WAIT_L(0); PG8_MMA(0, 1, At, B1); PG8_BAR;
            PG8_LDA(At, 1, 1); PG8_STAGE(PG8_SA(1, 0), a3, o20);
            PG8_BAR; PG8_WAIT_L(0); PG8_MMA(1, 0, At, B0); PG8_BAR; PG8_SCHED;
            PG8_STAGE(PG8_SB(1, 1), b3 + hstepB, voffB);
            PG8_WAIT_V(6); PG8_BAR; PG8_MMA(1, 1, At, B1); PG8_BAR;
            }
        }
        if constexpr (ALIGN_EPI) { if (wr == 0) PG8_BAR; }
        if constexpr (!Epi::AFTER_DRAIN) { E(acc, cur, wr, wc, fr, fq); S.done(cur); }
        if (!has_next) break;
#pragma unroll
        for (int a = 0; a < 2; ++a)
#pragma unroll
            for (int b = 0; b < 2; ++b)
#pragma unroll
                for (int m = 0; m < 4; ++m)
#pragma unroll
                    for (int n = 0; n < 2; ++n) acc[a][b][m][n] = (f32x4){0.f, 0.f, 0.f, 0.f};
        cur = nxt; cA = nA; cB = nB; ++ui;
        ca0[0] = na0[0]; ca0[1] = na0[1]; ca1[0] = na1[0]; ca1[1] = na1[1];
        if constexpr (ALIGN_EPI) { if (wr == 1) PG8_BAR; }
    }
    PG8_WAIT_V(0);
    if constexpr (!ALIGN_EPI) { if (wr == 0) PG8_BAR; }
    PG8_BAR;
    if constexpr (Epi::AFTER_DRAIN) { E.fused(acc, cur, wr, wc, fr, fq, lds, wid, lane); S.done(cur); }
#undef PG8_SA
#undef PG8_SB
#undef PG8_STAGE
#undef PG8_LDA
#undef PG8_LDB
#undef PG8_MMA
#undef PG8_WAIT_V
#undef PG8_WAIT_L
#undef PG8_BAR
#undef PG8_SCHED
}
}
#define XB_TMO      128
#define XB_XCNT(j)  (256  + 64 * (j))
#define XB_XSUB(j)  (1280 + 64 * (j))
#define XB_XGEN(j)  (2304 + 64 * (j))
#define XB_TOP      3328
#define XB_TOPGEN   3392
#define XCD_BAR_WORDS 3456
#define XB_SPIN_CAP (1u << 18)

__device__ __forceinline__ unsigned xb_ld(unsigned* p)              { return __hip_atomic_load(p, __ATOMIC_RELAXED, __HIP_MEMORY_SCOPE_AGENT); }
__device__ __forceinline__ unsigned xb_add(unsigned* p, unsigned v) { return __hip_atomic_fetch_add(p, v, __ATOMIC_RELAXED, __HIP_MEMORY_SCOPE_AGENT); }
__device__ __forceinline__ unsigned xb_xcc_id() { return (unsigned)__builtin_amdgcn_s_getreg((3 << 11) | 20) & 0xFu; }
#define XB_SPIN(cond, bar) do { unsigned _sp = 0; while (cond) { __builtin_amdgcn_s_sleep(1); \
    if ((++_sp & 255u) == 0u) { if (xb_ld(&(bar)[XB_TMO])) break; if (_sp > XB_SPIN_CAP) { atomicAdd(&(bar)[XB_TMO], 1u); break; } } } } while (0)

struct XcdBarrier {
    unsigned* bar; unsigned x;
    volatile LAS unsigned* st;
};

__device__ __forceinline__ XcdBarrier xcd_barrier_post(unsigned* bar, volatile LAS unsigned* st) {
    XcdBarrier b; b.bar = bar; b.x = xb_xcc_id(); b.st = st;
    if (threadIdx.x == 0) (void)xb_add(&bar[XB_XCNT(b.x)], 1u);
    return b;
}
__device__ __forceinline__ void xcd_barrier_complete(unsigned* bar, unsigned x, unsigned& nloc, unsigned& nx) {
    const unsigned G = gridDim.x * gridDim.y * gridDim.z;
    unsigned sum, cnt, mine, sp = 0u;
    for (;;) {
        sum = 0u; cnt = 0u; mine = 0u;
#pragma unroll
        for (unsigned j = 0; j < 16; ++j) { const unsigned c = xb_ld(&bar[XB_XCNT(j)]); sum += c; cnt += (c > 0u) ? 1u : 0u; mine = (j == x) ? c : mine; }
        if (sum == G) break;
        __builtin_amdgcn_s_sleep(1);
        if ((++sp & 255u) == 0u) { if (xb_ld(&bar[XB_TMO])) break; if (sp > XB_SPIN_CAP) { atomicAdd(&bar[XB_TMO], 1u); break; } }
    }
    nloc = mine > 0u ? mine : 1u; nx = cnt > 0u ? cnt : 1u;
}

__device__ __forceinline__ void xcd_barrier(const XcdBarrier& b, const bool is_t0) {
    asm volatile("s_waitcnt vmcnt(0)" ::: "memory");
    __syncthreads();
    if (is_t0) {
        unsigned* bar = b.bar;
        __builtin_amdgcn_s_waitcnt(0);
        unsigned nloc = b.st[0], nx = b.st[1];
        if (nloc == 0u) { xcd_barrier_complete(bar, b.x, nloc, nx); b.st[0] = nloc; b.st[1] = nx; }
        const unsigned old = xb_add(&bar[XB_XSUB(b.x)], 1u);
        const unsigned gen = old / nloc;
        if (old + 1u == (gen + 1u) * nloc) {
            __builtin_amdgcn_fence(__ATOMIC_RELEASE, "agent");
            asm volatile("s_waitcnt vmcnt(0)" ::: "memory");
            const unsigned og = xb_add(&bar[XB_TOP], 1u);
            const unsigned tg = og / nx;
            if (og + 1u == (tg + 1u) * nx) xb_add(&bar[XB_TOPGEN], 1u);
            else XB_SPIN(xb_ld(&bar[XB_TOPGEN]) == tg, bar);
            __builtin_amdgcn_fence(__ATOMIC_ACQUIRE, "agent");
            xb_add(&bar[XB_XGEN(b.x)], 1u);
            asm volatile("s_waitcnt vmcnt(0)" ::: "memory");
        } else {
            XB_SPIN(xb_ld(&bar[XB_XGEN(b.x)]) == gen, bar);
            __builtin_amdgcn_fence(__ATOMIC_ACQUIRE, "agent");
            asm volatile("s_waitcnt vmcnt(0)" ::: "memory");
        }
    }
    __syncthreads();
}


namespace pg8 {
struct EpiZ {
    static constexpr bool PERM = true, AFTER_DRAIN = false;
    bf16_t* O; int ldc; float* fcbuf;
    __device__ __forceinline__ void operator()(const f32x4 (&acc)[2][2][4][2], const Unit& u, int wr, int wc, int fr, int fq) const {
        const int row0 = u.pm * BM + wr * 64 + fr, col0 = u.pn * BM + wc * 32 + 8 * fq;
        const bool fcl = (u.pn == 9) && (wc == 1) && (fq == 0);
#pragma unroll
        for (int ai = 0; ai < 2; ++ai)
#pragma unroll
            for (int m = 0; m < 4; ++m) {
                const int row = row0 + ai * HALF + m * 16;
                bf16_t* rowp = O + (size_t)row * ldc + col0;
#pragma unroll
                for (int bj = 0; bj < 2; ++bj) {
                    const f32x4 v0 = acc[ai][bj][m][0], v1 = acc[ai][bj][m][1];
                    u32x4 w; w.x = cvt_pk_bf16(v0[0], v0[1]); w.y = cvt_pk_bf16(v0[2], v0[3]); w.z = cvt_pk_bf16(v1[0], v1[1]); w.w = cvt_pk_bf16(v1[2], v1[3]);
                    *(u32x4*)(rowp + bj * HALF) = w;
                }
                if (fcl) *(f32x4*)(fcbuf + (size_t)row * 4) = acc[ai][0][m][0];
            }
    }
};
struct EpiRowScale {
    static constexpr bool PERM = true, AFTER_DRAIN = false;
    bf16_t* O; int ldc; const float* rs;
    __device__ __forceinline__ void operator()(const f32x4 (&acc)[2][2][4][2], const Unit& u, int wr, int wc, int fr, int fq) const {
        const int row0 = u.pm * BM + wr * 64 + fr, col0 = u.pn * BM + wc * 32 + 8 * fq;
#pragma unroll
        for (int ai = 0; ai < 2; ++ai)
#pragma unroll
            for (int m = 0; m < 4; ++m) {
                const int row = row0 + ai * HALF + m * 16;
                const float s = rs[row];
                bf16_t* rowp = O + (size_t)row * ldc + col0;
#pragma unroll
                for (int bj = 0; bj < 2; ++bj) {
                    const f32x4 v0 = acc[ai][bj][m][0] * s, v1 = acc[ai][bj][m][1] * s;
                    u32x4 w; w.x = cvt_pk_bf16(v0[0], v0[1]); w.y = cvt_pk_bf16(v0[2], v0[3]); w.z = cvt_pk_bf16(v1[0], v1[1]); w.w = cvt_pk_bf16(v1[2], v1[3]);
                    *(u32x4*)(rowp + bj * HALF) = w;
                }
            }
    }
};
struct EpiGU {
    static constexpr bool PERM = true, AFTER_DRAIN = false;
    bf16_t* O;
    __device__ __forceinline__ void operator()(const f32x4 (&acc)[2][2][4][2], const Unit& u, int wr, int wc, int fr, int fq) const {
        const int row0 = u.pm * BM + wr * 64 + fr, f0 = ((u.pn & 1) * BM + wc * 32 + 8 * fq) >> 1;
#pragma unroll
        for (int ai = 0; ai < 2; ++ai)
#pragma unroll
            for (int m = 0; m < 4; ++m) {
                bf16_t* rowp = O + (size_t)(row0 + ai * HALF + m * 16) * 256 + f0;
#pragma unroll
                for (int bj = 0; bj < 2; ++bj) {
                    const f32x4 v0 = acc[ai][bj][m][0], v1 = acc[ai][bj][m][1];
                    const float a0 = v0[0] * __builtin_amdgcn_rcpf(1.f + __expf(-v0[0])) * v0[1], a1 = v0[2] * __builtin_amdgcn_rcpf(1.f + __expf(-v0[2])) * v0[3];
                    const float a2 = v1[0] * __builtin_amdgcn_rcpf(1.f + __expf(-v1[0])) * v1[1], a3 = v1[2] * __builtin_amdgcn_rcpf(1.f + __expf(-v1[2])) * v1[3];
                    typedef unsigned u32x2 __attribute__((ext_vector_type(2)));
                    u32x2 w; w.x = cvt_pk_bf16(a0, a1); w.y = cvt_pk_bf16(a2, a3);
                    *(u32x2*)(rowp + bj * (HALF / 2)) = w;
                }
            }
    }
};
struct EpiPleGate {
    static constexpr bool PERM = true, AFTER_DRAIN = false;
    bf16_t* O; const bf16_t* PP;
    __device__ __forceinline__ void operator()(const f32x4 (&acc)[2][2][4][2], const Unit& u, int wr, int wc, int fr, int fq) const {
        const int row0 = u.pm * BM + wr * 64 + fr, col0 = u.pn * BM + wc * 32 + 8 * fq;
#pragma unroll
        for (int ai = 0; ai < 2; ++ai)
#pragma unroll
            for (int m = 0; m < 4; ++m) {
                const size_t off = (size_t)(row0 + ai * HALF + m * 16) * 1024 + col0;
#pragma unroll
                for (int bj = 0; bj < 2; ++bj) {
                    const f32x4 v0 = acc[ai][bj][m][0], v1 = acc[ai][bj][m][1];
                    const u32x4 pw = *(const u32x4*)(PP + off + bj * HALF);
                    float o[8];
                    o[0] = __uint_as_float(pw.x << 16) * __builtin_amdgcn_rcpf(1.f + __expf(-v0[0])); o[1] = __uint_as_float(pw.x & 0xffff0000u) * __builtin_amdgcn_rcpf(1.f + __expf(-v0[1]));
                    o[2] = __uint_as_float(pw.y << 16) * __builtin_amdgcn_rcpf(1.f + __expf(-v0[2])); o[3] = __uint_as_float(pw.y & 0xffff0000u) * __builtin_amdgcn_rcpf(1.f + __expf(-v0[3]));
                    o[4] = __uint_as_float(pw.z << 16) * __builtin_amdgcn_rcpf(1.f + __expf(-v1[0])); o[5] = __uint_as_float(pw.z & 0xffff0000u) * __builtin_amdgcn_rcpf(1.f + __expf(-v1[1]));
                    o[6] = __uint_as_float(pw.w << 16) * __builtin_amdgcn_rcpf(1.f + __expf(-v1[2])); o[7] = __uint_as_float(pw.w & 0xffff0000u) * __builtin_amdgcn_rcpf(1.f + __expf(-v1[3]));
                    u32x4 w; w.x = cvt_pk_bf16(o[0], o[1]); w.y = cvt_pk_bf16(o[2], o[3]); w.z = cvt_pk_bf16(o[4], o[5]); w.w = cvt_pk_bf16(o[6], o[7]);
                    *(u32x4*)(O + off + bj * HALF) = w;
                }
            }
    }
};
struct EpiDown {
    static constexpr bool PERM = true, AFTER_DRAIN = false;
    bf16_t* O;
    __device__ __forceinline__ void operator()(const f32x4 (&acc)[2][2][4][2], const Unit& u, int wr, int wc, int fr, int fq) const {
        const int row0 = u.pm * BM + wr * 64 + fr, col0 = (u.pn & 3) * BM + wc * 32 + 8 * fq;
#pragma unroll
        for (int ai = 0; ai < 2; ++ai)
#pragma unroll
            for (int m = 0; m < 4; ++m) {
                bf16_t* rowp = O + (size_t)(row0 + ai * HALF + m * 16) * 1024 + col0;
#pragma unroll
                for (int bj = 0; bj < 2; ++bj) {
                    const f32x4 v0 = acc[ai][bj][m][0], v1 = acc[ai][bj][m][1];
                    u32x4 w; w.x = cvt_pk_bf16(v0[0], v0[1]); w.y = cvt_pk_bf16(v0[2], v0[3]); w.z = cvt_pk_bf16(v1[0], v1[1]); w.w = cvt_pk_bf16(v1[2], v1[3]);
                    *(u32x4*)(rowp + bj * HALF) = w;
                }
            }
    }
};
constexpr int XPM = (int)((WS_HS16 - WS_A16) / (256 * 1024 * 2)), XPN = (int)((WS_WGU - WS_WPG) / (256 * 1024 * 2));
static_assert((WS_HS16 - WS_A16) % (256 * 1024 * 2) == 0 && (WS_WGU - WS_WPG) % (256 * 1024 * 2) == 0 && XPM >= 64 && (XPN & 1) == 0, "virtual unit offsets");
struct EpiX {
    static constexpr bool PERM = true, AFTER_DRAIN = false;
    EpiGU gu; EpiPleGate pg;
    __device__ __forceinline__ void operator()(const f32x4 (&acc)[2][2][4][2], const Unit& u, int wr, int wc, int fr, int fq) const {
        if (u.pm >= XPM) { const Unit v{u.pm - XPM, u.pn - XPN}; gu(acc, v, wr, wc, fr, fq); }
        else pg(acc, u, wr, wc, fr, fq);
    }
};
struct XSched {
    const int* tile_e; int nU1, G, vc;
    __device__ __forceinline__ bool next(int i, Unit& u) const {
        if (i >= 2) return false;
        const int g = vc + i * G;
        if (g < nU1) { const int t = g >> 1; u.pm = t + XPM; u.pn = __builtin_amdgcn_readfirstlane(tile_e[t]) * 2 + (g & 1) + XPN; return true; }
        const int k = g - nU1; if (k >= 256) return false;
        u.pm = k >> 2; u.pn = k & 3; return true;
    }
    __device__ __forceinline__ void a_ready(const Unit&) const {}
    __device__ __forceinline__ void done(const Unit&) const {}
};
struct TwoUnits {
    int pm0, pn0, pm1, pn1, n;
    __device__ __forceinline__ bool next(int i, Unit& u) const { if (i >= n) return false; u.pm = i ? pm1 : pm0; u.pn = i ? pn1 : pn0; return true; }
    __device__ __forceinline__ void a_ready(const Unit&) const {}
    __device__ __forceinline__ void done(const Unit&) const {}
};
struct OneUnit {
    int pm, pn;
    __device__ __forceinline__ bool next(int i, Unit& u) const { if (i) return false; u.pm = pm; u.pn = pn; return true; }
    __device__ __forceinline__ void a_ready(const Unit&) const {}
    __device__ __forceinline__ void done(const Unit&) const {}
};
struct GroupSched {
    const int* tile_e; int T, NJ, G, vc;
    __device__ __forceinline__ bool next(int i, Unit& u) const {
        const long L = (long)i * G + vc; if (L >= (long)T * NJ) return false;
        const int t = (int)(L / NJ), j = (int)(L % NJ);
        u.pm = t; u.pn = __builtin_amdgcn_readfirstlane(tile_e[t]) * NJ + j; return true;
    }
    __device__ __forceinline__ void a_ready(const Unit&) const {}
    __device__ __forceinline__ void done(const Unit&) const {}
};
}

template <class Map>
__device__ __forceinline__ void transpose_rows(const Map mp, const float* ks, int nrows_out, int K, bf16* WT, LAS float* scr, int gw, int NGW, int lane) {
    const int nblk = nrows_out / 32, nitems = (K / 64) * nblk;
    const int f = lane & 7, kr = lane >> 3;
    for (int it = gw; it < nitems; it += NGW) {
        const int kb = it / nblk, nb = it % nblk, k0 = 64 * kb, n0 = 32 * nb;
        const float* src; long pitch; float sc; int nl0, nls;
        mp.get4(n0, f, src, pitch, sc, nl0, nls);
        f32x4_t vals[8];
#pragma unroll
        for (int i = 0; i < 8; ++i) vals[i] = src ? *(const f32x4_t*)(src + (size_t)(k0 + kr + 8 * i) * pitch) : (f32x4_t){0.f, 0.f, 0.f, 0.f};
#pragma unroll
        for (int i = 0; i < 8; ++i) {
            const int kk = kr + 8 * i;
            float m = sc; if (ks) m *= ks[k0 + kk];
            scr[kk * 33 + nl0] = vals[i].x * m; scr[kk * 33 + nl0 + nls] = vals[i].y * m; scr[kk * 33 + nl0 + 2 * nls] = vals[i].z * m; scr[kk * 33 + nl0 + 3 * nls] = vals[i].w * m;
        }
        asm volatile("s_waitcnt lgkmcnt(0)" ::: "memory");
        const int c = lane & 7;
#pragma unroll
        for (int j = 0; j < 4; ++j) {
            const int n = (lane >> 3) + 8 * j; const LAS float* s = scr + (8 * c) * 33 + n;
            v4u o; o.x = pk2(s[0 * 33], s[1 * 33]); o.y = pk2(s[2 * 33], s[3 * 33]); o.z = pk2(s[4 * 33], s[5 * 33]); o.w = pk2(s[6 * 33], s[7 * 33]);
            *(v4u*)(WT + (size_t)(n0 + n) * K + k0 + 8 * c) = o;
        }
        asm volatile("s_waitcnt lgkmcnt(0)" ::: "memory");
    }
}
constexpr float LOG2E_W = 1.4426950408889634f;
struct MapIn {
    const float* w;
    __device__ __forceinline__ void get(int n, const float*& src, long& pitch, float& sc) const {
        int c;
        if (n < 1152) c = n;
        else if (n < Z_CKV) c = OFF_QC + (n - Z_QC);
        else if (n < Z_CQ) c = OFF_CKV + (n - Z_CKV);
        else if (n < Z_KR) c = OFF_CQ + (n - Z_CQ);
        else if (n < Z_FC) c = OFF_KR + (n - Z_KR);
        else if (n < Z_FC + 4) c = OFF_FC + (n - Z_FC);
        else c = -1;
        src = c >= 0 ? w + c : nullptr; pitch = D_IN;
        sc = n < Z_KA ? 0.17677669529663687f * LOG2E_W : ((n >= Z_QC && n < Z_KC) ? 0.125f * LOG2E_W : 1.f);
    }
    __device__ __forceinline__ void get4(int n0, int f, const float*& src, long& pitch, float& sc, int& nl0, int& nls) const { get(n0 + 4 * f, src, pitch, sc); nl0 = 4 * f; nls = 1; }
};
struct MapPlain {
    const float* w; int N, nvalid; float scale;
    __device__ __forceinline__ void get(int n, const float*& src, long& pitch, float& sc) const { src = n < nvalid ? w + n : nullptr; pitch = N; sc = scale; }
    __device__ __forceinline__ void get4(int n0, int f, const float*& src, long& pitch, float& sc, int& nl0, int& nls) const { get(n0 + 4 * f, src, pitch, sc); nl0 = 4 * f; nls = 1; }
};

struct MapGU {
    const float* wg; const float* wu;
    __device__ __forceinline__ void get(int n, const float*& src, long& pitch, float& sc) const {
        const int e = n >> 9, r = n & 511, f = r >> 1;
        const long dlt = (r & 1) ? (long)(wu - wg) : 0l;
        src = wg + dlt + (size_t)e * 1024 * 256 + f; pitch = 256; sc = 1.f;
    }
    __device__ __forceinline__ void get4(int n0, int f, const float*& src, long& pitch, float& sc, int& nl0, int& nls) const {
        const int e = n0 >> 9, f0 = (n0 & 511) >> 1;
        const long dlt = (f >> 2) ? (long)(wu - wg) : 0l;
        src = wg + dlt + (size_t)e * 1024 * 256 + f0 + 4 * (f & 3); pitch = 256; sc = 1.f; nl0 = 8 * (f & 3) + (f >> 2); nls = 2;
    }
};
struct MapD {
    const float* wd;
    __device__ __forceinline__ void get(int n, const float*& src, long& pitch, float& sc) const {
        const int e = n >> 10, c = n & 1023;
        src = wd + (size_t)e * 256 * 1024 + c; pitch = 1024; sc = 1.f;
    }
    __device__ __forceinline__ void get4(int n0, int f, const float*& src, long& pitch, float& sc, int& nl0, int& nls) const { get(n0 + 4 * f, src, pitch, sc); nl0 = 4 * f; nls = 1; }
};

struct AttnP {
    const bf16* z16; const bf16* qb16; const bf16* kvb16; const bf16* krr16; const float* cum; const float* cosT; const float* sinT;
    const int* pos; bf16* mixed16; const float* lq1; const float* lk1; const float* lq2; const float* lk2; const float* gdiff; int layer; unsigned* prof; const int* tpmax; float lam, lam_init;
};
typedef short bf16x8_t __attribute__((ext_vector_type(8)));
typedef float f32x16_t __attribute__((ext_vector_type(16)));
typedef short s16x4_t __attribute__((ext_vector_type(4)));
typedef float f32x2_t __attribute__((ext_vector_type(2)));
typedef __bf16 bf16x2_t __attribute__((ext_vector_type(2)));
__device__ __forceinline__ unsigned cvtpk(float lo, float hi) { f32x2_t v = {lo, hi}; bf16x2_t b = __builtin_convertvector(v, bf16x2_t); return __builtin_bit_cast(unsigned, b); }
__device__ __forceinline__ int crow(int r, int hi) { return (r & 3) + 8 * (r >> 2) + 4 * hi; }
__device__ __forceinline__ s16x4_t vtr(const LAS unsigned char* p) { typedef short v4i16_t __attribute__((ext_vector_type(4))); return __builtin_bit_cast(s16x4_t, __builtin_amdgcn_ds_read_tr16_b64_v4i16((LAS v4i16_t*)p)); }
constexpr float LOG2E = 1.4426950408889634f;

__device__ __forceinline__ float xhalf_max(float m) { auto rr = __builtin_amdgcn_permlane32_swap(__float_as_uint(m), __float_as_uint(m), false, false); return __builtin_fmaxf(__uint_as_float(rr[0]), __uint_as_float(rr[1])); }
__device__ __forceinline__ float xhalf_sum(float m) { auto rr = __builtin_amdgcn_permlane32_swap(__float_as_uint(m), __float_as_uint(m), false, false); return __uint_as_float(rr[0]) + __uint_as_float(rr[1]); }
__device__ __forceinline__ float max3f(float a, float b, float c) { return __builtin_fmaxf(__builtin_fmaxf(a, b), c); }
template <int MODE> __device__ __forceinline__ void attn_unit(const AttnP& p, int b, int h, int qblk, LAS unsigned char* lds, const int tid_in) {
    int tid = tid_in * 64 + lane_id_now(); asm volatile("" : "+v"(tid));
#ifdef PROF_SEL
    const unsigned long long pu0 = __builtin_amdgcn_s_memrealtime(); unsigned long long pt0 = 0, pl0 = 0, pacc_c = 0, pacc_b = 0;
#define PROF_T(acc) do { const unsigned long long t_ = __builtin_amdgcn_s_memrealtime(); acc += t_ - pt0; pt0 = t_; } while (0)
#else
#define PROF_T(acc) do {} while (0)
#endif
    constexpr int NF = MODE == 0 ? 2 : (MODE == 1 ? 6 : 4);
    constexpr int NC = MODE == 1 ? 12 : 8;
    constexpr int NCX = MODE == 1 ? 0 : 2;
    constexpr int KB = (NC + NCX) * 1024, KBUF = KB + 256;
    constexpr int VOFF = 2 * KBUF;
    constexpr int KI = (NC * 64 + NTHREADS - 1) / NTHREADS;
    const int lane = tid & 63, w = __builtin_amdgcn_readfirstlane(tid >> 6), r32 = lane & 31, hi = lane >> 5;
    const int map = MODE == 0 ? (w >> 2) : 0, qg = MODE == 0 ? (w & 3) : w;
    const int c = MODE == 0 ? qblk * 2 + (qg >> 1) : qblk * 4 + (qg >> 1);
    const int ntiles = MODE == 0 ? qblk * 2 + 2 : qblk * 4 + 4;
    const long tok0 = (long)b * SEQ;
    const int q0u = MODE == 0 ? qblk * 128 : qblk * 256;
    const long qrow = tok0 + q0u + qg * 32 + r32;
    float slope2 = 0.f, sq = 0.f, refv = 0.f; int qpmin = 0;
    const bf16* ksrc[KI]; bool kok[KI];
#pragma unroll
    for (int i = 0; i < KI; ++i) {
        const int pidx0 = tid + i * NTHREADS;
        kok[i] = pidx0 < NC * 64;
        const int pidx = kok[i] ? pidx0 : pidx0 - NTHREADS, c8 = pidx >> 6, kv = pidx & 63;
        if (MODE == 0) ksrc[i] = p.z16 + (tok0 + kv) * ZP + Z_KA + h * 64 + c8 * 8;
        else if (MODE == 2) ksrc[i] = p.z16 + (tok0 + kv) * ZP + Z_KC + h * 64 + c8 * 8;
        else ksrc[i] = (c8 < 8) ? p.kvb16 + (tok0 + kv) * NKVB + h * 128 + c8 * 8 : p.krr16 + (tok0 + kv) * 32 + (c8 - 8) * 8;
    }
    const int kstride = MODE == 1 ? 0 : 64 * ZP;
    const int vcl = tid & 3, vkv = (tid >> 2) & 63, vch = tid >> 8;
    const bf16* vsrc = MODE == 0 ? p.z16 + (tok0 + vkv) * ZP + Z_VA + h * 64 + (vch * 4 + vcl) * 8
                     : (MODE == 1 ? p.kvb16 + (tok0 + vkv) * NKVB + h * 128 + 64 + (vch * 4 + vcl) * 8 : p.z16 + (tok0 + vkv) * ZP + Z_VC + h * 64 + (vch * 4 + vcl) * 8);
    const int vstride = MODE == 1 ? 64 * NKVB : 64 * ZP;
    LAS unsigned char* const vdstp = lds + VOFF + vch * 4096 + (vkv >> 3) * 512 + (vkv & 7) * 64 + vcl * 16;
    LAS unsigned char* const kdstp = lds + tid * 16;
    v4u kreg0[KI], kreg1[KI], vreg0, vreg1; unsigned breg0 = 0u, breg1 = 0u;
    auto load_k = [&](int kt_, v4u (&kreg)[KI], unsigned& breg) {
        const int kt = kt_ < ntiles ? kt_ : ntiles - 1;
#pragma unroll
        for (int i = 0; i < KI; ++i) {
            const int pidx = tid + i * NTHREADS;
            const long off = MODE == 1 ? (((kok[i] ? pidx : pidx - NTHREADS) >> 6) < 8 ? (long)kt * 64 * NKVB : (long)kt * 64 * 32) : (long)kt * kstride;
            kreg[i] = *(const v4u*)(ksrc[i] + off);
        }
        if (MODE == 0) breg = (unsigned)p.pos[tok0 + kt * 64 + (tid & 63)];
        if (MODE == 2) breg = __float_as_uint(p.cum[(tok0 + kt * 64 + (tid & 63)) * 4 + h]);
    };
    auto load_v = [&](int kt_, v4u& vreg) { const int kt = kt_ < ntiles ? kt_ : ntiles - 1; vreg = *(const v4u*)(vsrc + (long)kt * vstride); };
    auto write_k = [&](const int par, const v4u (&kreg)[KI], const unsigned& breg) {
#pragma unroll
        for (int i = 0; i < KI; ++i) if (kok[i]) *(LAS v4u*)(kdstp + par * KBUF + i * NTHREADS * 16) = kreg[i];
        if (MODE != 1 && tid < 64) {
            const float bv = MODE == 0 ? slope2 * ((float)(int)breg - refv) : (refv - __uint_as_float(breg)) * LOG2E;
            *(LAS float*)(lds + par * KBUF + KB + tid * 4) = bv;
            const unsigned e0 = f2bf(bv); const float r1 = bv - __uint_as_float(e0 << 16);
            const unsigned e1 = f2bf(r1); const float r2 = r1 - __uint_as_float(e1 << 16);
            const unsigned e2 = f2bf(r2);
            v4u ex; ex.x = e0 | (e1 << 16); ex.y = e2; ex.z = 0u; ex.w = 0u;
            *(LAS v4u*)(lds + par * KBUF + NC * 1024 + tid * 16) = ex;
        }
    };
    auto write_v = [&](const int par, const v4u& vreg) { *(LAS v4u*)(vdstp + par * 8192) = vreg; };
    load_k(0, kreg0, breg0); load_k(1, kreg1, breg1); load_v(0, vreg0); load_v(1, vreg1);
    bf16x8_t qf[NF];
    {
        const bf16* qsrc = MODE == 0 ? p.z16 + qrow * ZP + Z_QA + h * 64 + map * 32 : (MODE == 1 ? p.qb16 + qrow * NQBP + h * 96 : p.z16 + qrow * ZP + Z_QC + h * 64);
#pragma unroll
        for (int i = 0; i < NF; ++i) qf[i] = *(const bf16x8_t*)(qsrc + i * 16 + hi * 8);
    }
    if (MODE == 1) {
        const float4 c0 = *(const float4*)(p.cosT + qrow * 16 + hi * 8), c1 = *(const float4*)(p.cosT + qrow * 16 + hi * 8 + 4);
        const float4 s0 = *(const float4*)(p.sinT + qrow * 16 + hi * 8), s1 = *(const float4*)(p.sinT + qrow * 16 + hi * 8 + 4);
        const float cs[8] = {c0.x, c0.y, c0.z, c0.w, c1.x, c1.y, c1.z, c1.w}, sn[8] = {s0.x, s0.y, s0.z, s0.w, s1.x, s1.y, s1.z, s1.w};
        float n1[8], n2[8];
#pragma unroll
        for (int j = 0; j < 8; ++j) {
            const float x1 = __uint_as_float((unsigned)(unsigned short)qf[NF - 2][j] << 16), x2 = __uint_as_float((unsigned)(unsigned short)qf[NF - 1][j] << 16);
            n1[j] = x1 * cs[j] - x2 * sn[j]; n2[j] = x2 * cs[j] + x1 * sn[j];
        }
        v4u a, bb;
        a.x = cvtpk(n1[0], n1[1]); a.y = cvtpk(n1[2], n1[3]); a.z = cvtpk(n1[4], n1[5]); a.w = cvtpk(n1[6], n1[7]);
        bb.x = cvtpk(n2[0], n2[1]); bb.y = cvtpk(n2[2], n2[3]); bb.z = cvtpk(n2[4], n2[5]); bb.w = cvtpk(n2[6], n2[7]);
        qf[NF - 2] = __builtin_bit_cast(bf16x8_t, a); qf[NF - 1] = __builtin_bit_cast(bf16x8_t, bb);
    }
    if (MODE == 0) {
        slope2 = exp2f(-8.0f * (float)(h + 1) / 6.0f) * LOG2E;
        const int pref = p.pos[tok0 + q0u]; refv = (float)pref;
        const int pq = p.pos[qrow]; sq = slope2 * (float)(pq - pref);
        int mn = pq;
#pragma unroll
        for (int o_ = 1; o_ < 64; o_ <<= 1) mn = min(mn, __builtin_amdgcn_ds_bpermute((lane ^ o_) << 2, mn));
        qpmin = __builtin_amdgcn_readfirstlane(mn);
    }
    if (MODE == 2) refv = p.cum[(tok0 + q0u) * 4 + h];
    f32x16_t o[2], negm;
    float mref = 0.f, lsum = 0.f; bool first = true;
#pragma unroll
    for (int r = 0; r < 16; ++r) { o[0][r] = 0.f; o[1][r] = 0.f; negm[r] = 0.f; }
    bf16x8_t qext;
    { v4u q1; q1.x = hi == 0 ? 0x3f803f80u : 0u; q1.y = hi == 0 ? 0x00003f80u : 0u; q1.z = 0u; q1.w = 0u; qext = __builtin_bit_cast(bf16x8_t, q1); }
    LAS unsigned char* const kfp = lds + (map * NF * 2 + hi) * 1024 + r32 * 16;
    LAS unsigned char* const kxp = lds + (NC + hi) * 1024 + r32 * 16;
    LAS unsigned char* const bfp = lds + KB + 16 * hi;
    LAS unsigned char* const vfp = lds + VOFF + (4 * hi + ((lane & 15) >> 2)) * 64 + ((lane >> 4) & 1) * 32 + (lane & 3) * 8;
    auto compute_s = [&](const int kt, const int par, f32x16_t& p0, f32x16_t& p1) {
        constexpr int KG = NF;
        bf16x8_t kf0[KG], kf1[KG], kx0, kx1;
#pragma unroll
        for (int d0 = 0; d0 < KG; ++d0) { kf0[d0] = *(const LAS bf16x8_t*)(kfp + par * KBUF + d0 * 2048); kf1[d0] = *(const LAS bf16x8_t*)(kfp + par * KBUF + d0 * 2048 + 512); }
        if (MODE != 1) { kx0 = *(const LAS bf16x8_t*)(kxp + par * KBUF); kx1 = *(const LAS bf16x8_t*)(kxp + par * KBUF + 512); }
        __builtin_amdgcn_sched_barrier(0);
        if (MODE != 1) {
            p0 = __builtin_amdgcn_mfma_f32_32x32x16_bf16(kx0, qext, negm, 0, 0, 0);
            p1 = __builtin_amdgcn_mfma_f32_32x32x16_bf16(kx1, qext, negm, 0, 0, 0);
        }
#pragma unroll
        for (int d0 = 0; d0 < KG; ++d0) {
            p0 = __builtin_amdgcn_mfma_f32_32x32x16_bf16(kf0[d0], qf[d0], (MODE == 1 && d0 == 0) ? negm : p0, 0, 0, 0);
            p1 = __builtin_amdgcn_mfma_f32_32x32x16_bf16(kf1[d0], qf[d0], (MODE == 1 && d0 == 0) ? negm : p1, 0, 0, 0);
        }
        if (NF > KG) {
#pragma unroll
            for (int d0 = KG; d0 < NF; ++d0) { kf0[d0 - KG] = *(const LAS bf16x8_t*)(kfp + par * KBUF + d0 * 2048); kf1[d0 - KG] = *(const LAS bf16x8_t*)(kfp + par * KBUF + d0 * 2048 + 512); }
#pragma unroll
            for (int d0 = KG; d0 < NF; ++d0) {
                p0 = __builtin_amdgcn_mfma_f32_32x32x16_bf16(kf0[d0 - KG], qf[d0], p0, 0, 0, 0);
                p1 = __builtin_amdgcn_mfma_f32_32x32x16_bf16(kf1[d0 - KG], qf[d0], p1, 0, 0, 0);
            }
        }
        if (MODE == 0) {
            if (kt == c || p.tpmax[b * 32 + kt] > qpmin) {
#pragma unroll
                for (int g = 0; g < 4; ++g) {
                    const f32x4_t b0 = *(const LAS f32x4_t*)(bfp + par * KBUF + 32 * g), b1 = *(const LAS f32x4_t*)(bfp + par * KBUF + 128 + 32 * g);
                    p0[4 * g] += 2.f * fminf(sq - b0.x, 0.f); p0[4 * g + 1] += 2.f * fminf(sq - b0.y, 0.f); p0[4 * g + 2] += 2.f * fminf(sq - b0.z, 0.f); p0[4 * g + 3] += 2.f * fminf(sq - b0.w, 0.f);
                    p1[4 * g] += 2.f * fminf(sq - b1.x, 0.f); p1[4 * g + 1] += 2.f * fminf(sq - b1.y, 0.f); p1[4 * g + 2] += 2.f * fminf(sq - b1.z, 0.f); p1[4 * g + 3] += 2.f * fminf(sq - b1.w, 0.f);
                }
            }
        }
        if (MODE == 2) {
            if (kt == c) {
                const int qi = (qg & 1) * 32 + r32;
#pragma unroll
                for (int r = 0; r < 16; ++r) { const int kv = crow(r, hi); if (kv > qi) p0[r] = -INFINITY; if (kv + 32 > qi) p1[r] = -INFINITY; }
            }
        }
    };
    auto softmax_pv = [&](const int par, f32x16_t& p0, f32x16_t& p1) {
        constexpr int VE = MODE == 1 ? 4 : 8;
        s16x4_t vlo[8], vhi[8];
#pragma unroll
        for (int i = 0; i < VE; ++i) { vlo[i] = vtr(vfp + par * 8192 + (i & 1) * 4096 + (i >> 1) * 1024); vhi[i] = vtr(vfp + par * 8192 + (i & 1) * 4096 + (i >> 1) * 1024 + 512); }
        __builtin_amdgcn_sched_barrier(0);
        float tm0 = max3f(p0[0], p0[1], p0[2]), tm1 = max3f(p1[0], p1[1], p1[2]);
#pragma unroll
        for (int r = 3; r < 15; r += 2) { tm0 = max3f(tm0, p0[r], p0[r + 1]); tm1 = max3f(tm1, p1[r], p1[r + 1]); }
        float tmax = max3f(tm0, tm1, p0[15]); tmax = __builtin_fmaxf(tmax, p1[15]);
        tmax = xhalf_max(tmax);
        if (first || __any(tmax > 8.0f)) {
            const float dl = first ? tmax : __builtin_fmaxf(tmax, 0.f);
            mref += dl;
            const float f = first ? 1.f : __builtin_amdgcn_exp2f(-dl);
            lsum *= f;
#pragma unroll
            for (int r = 0; r < 16; ++r) { o[0][r] *= f; o[1][r] *= f; p0[r] -= dl; p1[r] -= dl; negm[r] = -mref; }
            first = false;
        }
        float ls0 = 0.f, ls1 = 0.f;
#pragma unroll
        for (int r = 0; r < 16; ++r) { p0[r] = __builtin_amdgcn_exp2f(p0[r]); p1[r] = __builtin_amdgcn_exp2f(p1[r]); ls0 += p0[r]; ls1 += p1[r]; }
        lsum += ls0 + ls1;
        bf16x8_t pa[4];
#pragma unroll
        for (int ks = 0; ks < 4; ++ks) {
            v4u wv;
            if (ks < 2) { wv.x = cvtpk(p0[8 * ks + 0], p0[8 * ks + 1]); wv.y = cvtpk(p0[8 * ks + 2], p0[8 * ks + 3]); wv.z = cvtpk(p0[8 * ks + 4], p0[8 * ks + 5]); wv.w = cvtpk(p0[8 * ks + 6], p0[8 * ks + 7]); }
            else { wv.x = cvtpk(p1[8 * (ks - 2) + 0], p1[8 * (ks - 2) + 1]); wv.y = cvtpk(p1[8 * (ks - 2) + 2], p1[8 * (ks - 2) + 3]); wv.z = cvtpk(p1[8 * (ks - 2) + 4], p1[8 * (ks - 2) + 5]); wv.w = cvtpk(p1[8 * (ks - 2) + 6], p1[8 * (ks - 2) + 7]); }
            pa[ks] = __builtin_bit_cast(bf16x8_t, wv);
        }
#pragma unroll
        for (int i = VE; i < 8; ++i) { vlo[i] = vtr(vfp + par * 8192 + (i & 1) * 4096 + (i >> 1) * 1024); vhi[i] = vtr(vfp + par * 8192 + (i & 1) * 4096 + (i >> 1) * 1024 + 512); }
#pragma unroll
        for (int ks = 0; ks < 4; ++ks)
#pragma unroll
            for (int blk = 0; blk < 2; ++blk) {
                const s16x4_t lo = vlo[ks * 2 + blk], hi4 = vhi[ks * 2 + blk];
                const bf16x8_t vf = {lo[0], lo[1], lo[2], lo[3], hi4[0], hi4[1], hi4[2], hi4[3]};
                o[blk] = __builtin_amdgcn_mfma_f32_32x32x16_bf16(vf, pa[ks], o[blk], 0, 0, 0);
            }
    };
    if (MODE != 1 && tid < 128) *(LAS v4u*)(lds + (tid >> 6) * KBUF + (NC + 1) * 1024 + (tid & 63) * 16) = (v4u){0u, 0u, 0u, 0u};
    constexpr bool PIPE = false;
    f32x16_t pA0, pA1, pB0, pB1;
    if (PIPE) {
        write_k(0, kreg0, breg0); write_k(1, kreg1, breg1); write_v(0, vreg0);
        load_k(2, kreg0, breg0);
        __syncthreads();
        compute_s(0, 0, pA0, pA1);
        __syncthreads();
    } else {
        write_k(0, kreg0, breg0); write_v(0, vreg0);
        __syncthreads();
    }
#ifdef PROF_SEL
    pl0 = __builtin_amdgcn_s_memrealtime();
#endif
#pragma unroll 1
    for (int kt = 0; kt < ntiles; kt += 2) {
#ifdef PROF_SEL
        pt0 = __builtin_amdgcn_s_memrealtime();
#endif
        if (PIPE) {
            load_k(kt + 3, kreg1, breg1); load_v(kt + 2, vreg0);
            if (kt < c) { compute_s(kt + 1, 1, pB0, pB1); __builtin_amdgcn_sched_barrier(0); softmax_pv(0, pA0, pA1); }
            else if (kt == c) softmax_pv(0, pA0, pA1);
            write_k(0, kreg0, breg0); write_v(1, vreg1);
        } else {
            load_k(kt + 2, kreg0, breg0); load_v(kt + 2, vreg0);
            if (kt <= c) { compute_s(kt, 0, pA0, pA1); softmax_pv(0, pA0, pA1); }
            write_k(1, kreg1, breg1); write_v(1, vreg1);
        }
        PROF_T(pacc_c);
        __syncthreads();
        PROF_T(pacc_b);
        if (PIPE) {
            load_k(kt + 4, kreg0, breg0); load_v(kt + 3, vreg1);
            if (kt + 1 < c) { compute_s(kt + 2, 0, pA0, pA1); __builtin_amdgcn_sched_barrier(0); softmax_pv(1, pB0, pB1); }
            else if (kt + 1 == c) softmax_pv(1, pB0, pB1);
            write_k(1, kreg1, breg1); write_v(0, vreg0);
        } else {
            load_k(kt + 3, kreg1, breg1); load_v(kt + 3, vreg1);
            if (kt + 1 <= c) { compute_s(kt + 1, 1, pA0, pA1); softmax_pv(1, pA0, pA1); }
            write_k(0, kreg0, breg0); write_v(0, vreg0);
        }
        PROF_T(pacc_c);
        __syncthreads();
        PROF_T(pacc_b);
    }
#ifdef PROF_SEL
    const unsigned long long pl1 = __builtin_amdgcn_s_memrealtime();
#endif
    const float inv = 1.f / xhalf_sum(lsum);
    int tid2 = tid_in * 64 + lane_id_now(); asm volatile("" : "+v"(tid2));
    const int lane2 = tid2 & 63, hi2 = lane2 >> 5, qg2 = MODE == 0 ? ((tid2 >> 6) & 3) : (tid2 >> 6);
    const long qrow2 = tok0 + q0u + qg2 * 32 + (lane2 & 31);
    bf16* op = p.mixed16 + qrow2 * D_MODEL + (MODE == 0 ? 0 : (MODE == 1 ? 384 : 768)) + h * 64;
    if (MODE == 0) {
        LAS float* xb = (LAS float*)lds + qg2 * 2048 + lane2;
        if (map == 1) {
#pragma unroll
            for (int blk = 0; blk < 2; ++blk)
#pragma unroll
                for (int r = 0; r < 16; ++r) xb[(blk * 16 + r) * 64] = o[blk][r] * inv;
        }
        __syncthreads();
        if (map == 0) {
            const float lam_init = p.lam_init, lam = p.lam;
            float ss = 0.f;
#pragma unroll
            for (int blk = 0; blk < 2; ++blk)
#pragma unroll
                for (int r = 0; r < 16; ++r) { const float v = o[blk][r] * inv - lam * xb[(blk * 16 + r) * 64]; o[blk][r] = v; ss = fmaf(v, v, ss); }
            ss = xhalf_sum(ss);
            const float rr = rsqrtf(ss * (1.f / 64.f) + RMS_EPS) * (1.f - lam_init);
#pragma unroll
            for (int blk = 0; blk < 2; ++blk)
#pragma unroll
                for (int g = 0; g < 4; ++g) {
                    const int d = 32 * blk + 8 * g + 4 * hi2;
                    const float4 gv = *(const float4*)(p.gdiff + d);
                    v2u wv; wv.x = cvtpk(o[blk][4 * g] * rr * gv.x, o[blk][4 * g + 1] * rr * gv.y); wv.y = cvtpk(o[blk][4 * g + 2] * rr * gv.z, o[blk][4 * g + 3] * rr * gv.w);
                    *(v2u*)(op + d) = wv;
                }
        }
        __syncthreads();
    } else {
#pragma unroll
        for (int blk = 0; blk < 2; ++blk)
#pragma unroll
            for (int g = 0; g < 4; ++g) {
                const int d = 32 * blk + 8 * g + 4 * hi2;
                v2u wv; wv.x = cvtpk(o[blk][4 * g] * inv, o[blk][4 * g + 1] * inv); wv.y = cvtpk(o[blk][4 * g + 2] * inv, o[blk][4 * g + 3] * inv);
                *(v2u*)(op + d) = wv;
            }
    }
#ifdef PROF_SEL
    if (p.layer == 0 && blockIdx.x == 7 && w == PROF_WAVE && lane == 0) {
        unsigned* pw = p.prof; const unsigned long long pu1 = __builtin_amdgcn_s_memrealtime();
        atomicAdd(pw + 0, (unsigned)(pu1 - pu0)); atomicAdd(pw + 1, (unsigned)(pl1 - pl0)); atomicAdd(pw + 2, (unsigned)pacc_c); atomicAdd(pw + 3, (unsigned)pacc_b);
        atomicAdd(pw + 4, (unsigned)ntiles * 100u); atomicAdd(pw + 5, 10000u); atomicAdd(pw + 6, (unsigned)(c + 1) * 100u);
    }
#endif
}

typedef const __attribute__((address_space(4))) char* kargp_t;
__device__ __forceinline__ kargp_t karg_base() { kargp_t p = (kargp_t)__builtin_amdgcn_kernarg_segment_ptr(); asm volatile("" : "+s"(p)); return p; }
#define KARG(i) (*(const void* const __attribute__((address_space(4)))*)(kp + 8 * (i)))
#define KOUT (*(float* const __attribute__((address_space(4)))*)(kp + 224))
#define KWS (*(unsigned char* const __attribute__((address_space(4)))*)(kp + 232))
__device__ __forceinline__ void convert_layer_weights(const Args& a, int l, unsigned char* ws, LAS float* scr, int gw, int NGW, int lane) {
    const kargp_t kp = karg_base();
    const float* w_in = (const float*)KARG(3) + (size_t)l * D_MODEL * D_IN;
    const float* w_uq = (const float*)KARG(4) + (size_t)l * 256 * NQB;
    const float* w_ukv = (const float*)KARG(5) + (size_t)l * 128 * NKVB;
    const float* g_cq = (const float*)KARG(6) + l * 256;
    const float* g_ckv = (const float*)KARG(7) + l * 128;
    const float* w_out = (const float*)KARG(14) + (size_t)l * 1024 * 1024;
    transpose_rows(MapIn{w_in}, nullptr, ZP, 1024, (bf16*)(ws + WS_WIN), scr, gw, NGW, lane);
    transpose_rows(MapPlain{w_uq, NQB, NQB, 0.10206207261596575f * LOG2E_W}, g_cq, NQBP, 256, (bf16*)(ws + WS_WUQ), scr, gw, NGW, lane);
    transpose_rows(MapPlain{w_ukv, NKVB, NKVB, 1.f}, g_ckv, NKVB, 128, (bf16*)(ws + WS_WUKV), scr, gw, NGW, lane);
    transpose_rows(MapPlain{w_out, 1024, 1024, 1.f}, nullptr, 1024, 1024, (bf16*)(ws + WS_WOUT), scr, gw, NGW, lane);
    transpose_rows(MapPlain{(const float*)KARG(24) + (size_t)l * 1024 * 1024, 1024, 1024, 1.f}, nullptr, 1024, 1024, (bf16*)(ws + WS_WPG), scr, gw, NGW, lane);
    transpose_rows(MapPlain{(const float*)KARG(25) + (size_t)l * 256 * 1024, 1024, 1024, 1.f}, nullptr, 1024, 256, (bf16*)(ws + WS_WPP), scr, gw, NGW, lane);
    transpose_rows(MapGU{(const float*)KARG(21) + (size_t)l * 32 * 1024 * 256, (const float*)KARG(22) + (size_t)l * 32 * 1024 * 256}, nullptr, 32 * 512, 1024, (bf16*)(ws + WS_WGU), scr, gw, NGW, lane);
    transpose_rows(MapD{(const float*)KARG(23) + (size_t)l * 32 * 256 * 1024}, nullptr, 32 * 1024, 256, (bf16*)(ws + WS_WD), scr, gw, NGW, lane);
}

__device__ __forceinline__ void expert_prefix(const unsigned* cnt, LAS int* xs, int tid) {
    if (tid < 64) {
        const int pc = tid < 32 ? (((int)cnt[tid * 64] + 255) & ~255) : 0;
        int inc = pc;
#pragma unroll
        for (int o = 1; o < 32; o <<= 1) { const int n = __shfl_up(inc, o); if ((tid & 63) >= o) inc += n; }
        if (tid < 32) xs[tid] = inc - pc;
        if (tid == 31) xs[32] = inc;
    }
}
constexpr int LDS_MISC = 147456;
constexpr int PH_PER_LAYER = 9, NPH = 1 + DEPTH * PH_PER_LAYER;
template <int PH, bool DUMMY = false> __device__ __forceinline__ void run_phase(const Args& a, unsigned char* lds_raw, const int wave_s) {
    float* sm = (float*)lds_raw;
    const kargp_t kp = karg_base();
    const int G = gridDim.x, NGW = G * 8, NGT = G * NTHREADS;
    unsigned char* ws = KWS;
    const float* x0 = (const float*)KARG(0);
    const float* pin = (const float*)KARG(1);
    const int* pos = (const int*)KARG(2);
    float* cosT = (float*)(ws + WS_COS); float* sinT = (float*)(ws + WS_SIN);
    bf16* a16 = (bf16*)(ws + WS_A16); bf16* z16 = (bf16*)(ws + WS_Z16); bf16* qb16 = (bf16*)(ws + WS_QB16); bf16* kvb16 = (bf16*)(ws + WS_KVB16);
    bf16* krr16 = (bf16*)(ws + WS_KRR16); float* fcbuf = (float*)(ws + WS_FC); float* cum = (float*)(ws + WS_CUM); float* logf = (float*)(ws + WS_LOGF);
    float* rq = (float*)(ws + WS_RQ); float* rkv = (float*)(ws + WS_RKV);
    bf16* mixed16 = (bf16*)(ws + WS_MIXED16); bf16* mix16 = (bf16*)(ws + WS_MIX16);
    bf16* hs16 = (bf16*)(ws + WS_HS16); bf16* act16 = (bf16*)(ws + WS_ACT16); bf16* outs16 = (bf16*)(ws + WS_OUTS16); bf16* ple16 = (bf16*)(ws + WS_PLE16); bf16* pp16 = (bf16*)(ws + WS_PP16); bf16* p16 = (bf16*)(ws + WS_P16);
    int* ids = (int*)(ws + WS_RT + RT_IDS); float* wts = (float*)(ws + WS_RT + RT_WTS); int* rank = (int*)(ws + WS_RT + RT_RANK);
    int* etok = (int*)(ws + WS_ETOK);
    unsigned* ctl = (unsigned*)(ws + WS_CTL);

        int tid = wave_s * 64 + lane_id_now(); asm volatile("" : "+v"(tid));
        const int lane = tid & 63, wave = __builtin_amdgcn_readfirstlane(tid >> 6);
        const int gw = blockIdx.x * 8 + wave, gtid = blockIdx.x * NTHREADS + tid;
        LAS float* scr = (LAS float*)((LAS unsigned char*)lds_raw + wave * 16384);
        if constexpr (PH == 0) {
            for (int i = gtid; i < NTOK * 16; i += NGT) {
                const int tk = i >> 4, j = i & 15;
                const int j4 = j >> 2, jr = j & 3;
                const double inv = (j4 == 0 ? 1.0 : (j4 == 1 ? 0.1 : (j4 == 2 ? 0.01 : 0.001))) * (jr == 0 ? 1.0 : (jr == 1 ? 0.5623413251903491 : (jr == 2 ? 0.31622776601683794 : 0.1778279410038923)));
                const double ang = (double)pos[tk] * inv;
                const double k = rint(ang * 0.15915494309189535);
                const double r = fma(-k, 6.283185307179586, ang) - k * 2.4492935982947064e-16;
                cosT[i] = cosf((float)r); sinT[i] = sinf((float)r);
            }
            auto cvt_stream = [&](const float* sp, bf16* dp, int n8) {
                for (int i = gtid; i < n8; i += 4 * NGT) {
                    f32x4_t v[8];
#pragma unroll
                    for (int u = 0; u < 4; ++u) { v[2 * u] = *(const f32x4_t*)(sp + (size_t)(i + u * NGT) * 8); v[2 * u + 1] = *(const f32x4_t*)(sp + (size_t)(i + u * NGT) * 8 + 4); }
#pragma unroll
                    for (int u = 0; u < 4; ++u) { v4u o; o.x = pk2(v[2 * u].x, v[2 * u].y); o.y = pk2(v[2 * u].z, v[2 * u].w); o.z = pk2(v[2 * u + 1].x, v[2 * u + 1].y); o.w = pk2(v[2 * u + 1].z, v[2 * u + 1].w);
                        *(v4u*)(dp + (size_t)(i + u * NGT) * 8) = o; }
                }
            };
            for (int i = gw; i < BATCH * 32; i += NGW) {
                int v = pos[i * 64 + lane];
#pragma unroll
                for (int o_ = 1; o_ < 64; o_ <<= 1) v = max(v, __shfl_xor(v, o_));
                if (lane == 0) ((int*)(ws + WS_RT + RT_TPMAX))[i] = v;
            }
            cvt_stream(x0, a16, NTOK * D_MODEL / 8);
            cvt_stream(pin, p16, DEPTH * NTOK * PLE_DIM / 8);
            convert_layer_weights(a, 0, ws, scr, gw, NGW, lane);
        } else {
            constexpr int l = (PH - 1) / PH_PER_LAYER, sp = (PH - 1) % PH_PER_LAYER;
            const float* b_forget = (const float*)KARG(13) + l * 4;
            const float* ln1_g = (const float*)KARG(15) + l * 1024; const float* ln1_b = (const float*)KARG(16) + l * 1024;
            const float* w_group = (const float*)KARG(17) + l * 1024 * 4; const float* b_group = (const float*)KARG(18) + l * 4;
            const float* w_er = (const float*)KARG(19) + (size_t)l * 4 * 1024 * 8; const float* b_er = (const float*)KARG(20) + l * 32;
            const float* ln2_g = (const float*)KARG(26) + l * 1024; const float* ln2_b = (const float*)KARG(27) + l * 1024;
            unsigned* cnt = ctl + CW_CNT + l * 2048 + (DUMMY ? 8192 : 0);
            if (DUMMY) rank = (int*)(ws + WS_RT + 512 * 1024);
            if constexpr (sp == 0) {
                pg8::Gemm g{a16, (const bf16*)(ws + WS_WIN), NTOK, ZP, 1024, 1024, 1024};
                pg8::StaticOrder S; S.init(NTOK, ZP, G, (int)blockIdx.x);
                pg8::EpiZ E{z16, ZP, fcbuf};
                pg8::gemm_phase<pg8::EpiZ, pg8::StaticOrder, true, true>((LAS unsigned char*)lds_raw, g, S, E, tid);
                {
                    pg8::Gemm g2{p16 + (size_t)l * NTOK * PLE_DIM, (const bf16*)(ws + WS_WPP), NTOK, 1024, 256, 256, 256};
                    const int bx = (int)blockIdx.x;
                    pg8::StaticOrder S2; S2.init(NTOK, 1024, G / 2, bx >= G / 2 ? bx - G / 2 : 1 << 20);
                    pg8::EpiBf16<0> E2{pp16, 1024, nullptr, 0, 0, 1.f};
                    pg8::gemm_phase<pg8::EpiBf16<0>, pg8::StaticOrder, true, true>((LAS unsigned char*)lds_raw, g2, S2, E2, tid);
                }
            } else if constexpr (sp == 1) {
                const int g16 = lane >> 4, l16 = lane & 15;
                for (int tk = gw * 4 + g16; tk < NTOK; tk += NGW * 4) {
                    const bf16* zr = z16 + (size_t)tk * ZP;
                    const v4u ca = *(const v4u*)(zr + Z_CQ + l16 * 16), cb = *(const v4u*)(zr + Z_CQ + l16 * 16 + 8);
                    const v4u ka = *(const v4u*)(zr + Z_CKV + l16 * 8);
                    const unsigned short kr1 = zr[Z_KR + l16], kr2 = zr[Z_KR + 16 + l16];
                    const float cs = cosT[tk * 16 + l16], sn = sinT[tk * 16 + l16];
                    const float fcv = fcbuf[tk * 4 + (l16 & 3)];
                    float f[8]; float ss = 0.f;
                    unpack8(ca, f);
#pragma unroll
                    for (int i = 0; i < 8; ++i) ss = fmaf(f[i], f[i], ss);
                    unpack8(cb, f);
#pragma unroll
                    for (int i = 0; i < 8; ++i) ss = fmaf(f[i], f[i], ss);
                    float s2 = 0.f;
                    unpack8(ka, f);
#pragma unroll
                    for (int i = 0; i < 8; ++i) s2 = fmaf(f[i], f[i], s2);
#pragma unroll
                    for (int o = 1; o < 16; o <<= 1) { ss += __shfl_xor(ss, o); s2 += __shfl_xor(s2, o); }
                    if (l16 == 0) { rq[tk] = rsqrtf(ss * (1.f / 256.f) + RMS_EPS); rkv[tk] = rsqrtf(s2 * (1.f / 128.f) + RMS_EPS); }
                    const float x1 = __uint_as_float((unsigned)kr1 << 16), x2 = __uint_as_float((unsigned)kr2 << 16);
                    krr16[tk * 32 + l16] = (bf16)f2bf(x1 * cs - x2 * sn); krr16[tk * 32 + 16 + l16] = (bf16)f2bf(x2 * cs + x1 * sn);
                    if (l16 < 4) {
                        const float xf = fcv + b_forget[l16];
                        logf[tk * 4 + l16] = fminf(xf, 0.f) - log1pf(expf(-fabsf(xf)));
                    }
                }
            } else if constexpr (sp == 2) {
                {
                    pg8::Gemm g{z16 + Z_CQ, (const bf16*)(ws + WS_WUQ), NTOK, NQBP, 256, ZP, 256};
                    pg8::StaticOrder S; S.init(NTOK, NQBP, G, (int)blockIdx.x);
                    pg8::EpiRowScale E{qb16, NQBP, rq};
                    pg8::gemm_phase<pg8::EpiRowScale, pg8::StaticOrder, true, true>((LAS unsigned char*)lds_raw, g, S, E, tid);
                }
                {
                    pg8::Gemm g{z16 + Z_CKV, (const bf16*)(ws + WS_WUKV), NTOK, NKVB, 128, ZP, 128};
                    pg8::StaticOrder S; S.init(NTOK, NKVB, G, (int)((blockIdx.x + 128) % G));
                    pg8::EpiRowScale E{kvb16, NKVB, rkv};
                    pg8::gemm_phase<pg8::EpiRowScale, pg8::StaticOrder, true, true>((LAS unsigned char*)lds_raw, g, S, E, tid);
                }
                const int cw = NGW - 1 - gw;
                if (cw < 32) {
                    const int b = cw >> 2, hh = cw & 3;
                    float* cp = cum + ((size_t)b * SEQ) * 4 + hh; const float* lp = logf + ((size_t)b * SEQ) * 4 + hh;
                    float loc[32]; float run = 0.f;
#pragma unroll
                    for (int i = 0; i < 32; ++i) { run += lp[(size_t)(lane * 32 + i) * 4]; loc[i] = run; }
                    float pre = run;
#pragma unroll
                    for (int o = 1; o < 64; o <<= 1) { const float n = __shfl_up(pre, o); if (lane >= o) pre += n; }
                    pre -= run;
#pragma unroll
                    for (int i = 0; i < 32; ++i) cp[(size_t)(lane * 32 + i) * 4] = loc[i] + pre;
                }
            } else if constexpr (sp == 3) {
                float lam_init_, lam_;
                {
                    const float* lq1 = (const float*)KARG(8) + l * 32; const float* lk1 = (const float*)KARG(9) + l * 32; const float* lq2 = (const float*)KARG(10) + l * 32; const float* lk2 = (const float*)KARG(11) + l * 32;
                    lam_init_ = 0.8f - 0.6f * expf(-0.3f * (float)l);
                    float s1 = 0.f, s2 = 0.f;
                    for (int i = 0; i < 32; ++i) { s1 += lq1[i] * lk1[i]; s2 += lq2[i] * lk2[i]; }
                    lam_ = expf(s1) - expf(s2) + lam_init_;
                }
                AttnP p{z16, qb16, kvb16, krr16, cum, cosT, sinT, pos, mixed16,
                        (const float*)KARG(8) + l * 32, (const float*)KARG(9) + l * 32, (const float*)KARG(10) + l * 32, (const float*)KARG(11) + l * 32,
                        (const float*)KARG(12) + l * 64, l, ctl + 14000, (const int*)(ws + WS_RT + RT_TPMAX), lam_, lam_init_};
                volatile LAS int* qslot = (volatile LAS int*)((LAS unsigned char*)lds_raw + LDS_MISC) + 48;
                unsigned* qctr = ctl + 12288 + l * 64 + (DUMMY ? 32 : 0);
                int idx = (int)blockIdx.x;
                for (;;) {
                    if (idx >= 1408) break;
                    int nxt_idx = 0;
                    if (wave_s == 0 && lane_id_now() == 0) nxt_idx = G + (int)atomicAdd(qctr, 1u);
                    const int pi = idx / 176, r = idx % 176, thi = 32 - 4 * pi;
                    if (r < 48) attn_unit<0>(p, r / 6, r % 6, thi / 2 - 1, (LAS unsigned char*)lds_raw, wave_s);
                    else if (r < 96) attn_unit<1>(p, (r - 48) / 6, (r - 48) % 6, thi / 4 - 1, (LAS unsigned char*)lds_raw, wave_s);
                    else if (r < 128) attn_unit<2>(p, (r - 96) / 4, (r - 96) % 4, thi / 4 - 1, (LAS unsigned char*)lds_raw, wave_s);
                    else attn_unit<0>(p, (r - 128) / 6, (r - 128) % 6, (thi - 2) / 2 - 1, (LAS unsigned char*)lds_raw, wave_s);
                    __syncthreads();
                    if (wave_s == 0 && lane_id_now() == 0) *qslot = nxt_idx;
                    __syncthreads();
                    idx = __builtin_amdgcn_readfirstlane(*qslot);
                }
            } else if constexpr (sp == 4) {
                pg8::Gemm g{mixed16, (const bf16*)(ws + WS_WOUT), NTOK, 1024, 1024, 1024, 1024};
                pg8::StaticOrder S; S.init(NTOK, 1024, G, (int)blockIdx.x);
                pg8::EpiBf16<0> E{mix16, 1024, nullptr, 0, 0, 1.f};
                pg8::gemm_phase<pg8::EpiBf16<0>, pg8::StaticOrder, true, true>((LAS unsigned char*)lds_raw, g, S, E, tid);
            } else if constexpr (sp == 5) {
#ifdef PROF_LN1
                if (l == 0 && blockIdx.x == 0 && tid == 0) ctl[14000 + 19] = (unsigned)(__builtin_amdgcn_s_memrealtime() & 0xffffffffu);
#endif
                LAS f32x4_t* Lg = (LAS f32x4_t*)lds_raw; LAS f32x4_t* Le = Lg + 1024;
                LAS unsigned* lcnt = (LAS unsigned*)((LAS unsigned char*)lds_raw + LDS_MISC) + 16;
                __syncthreads();
                if (tid < 32) lcnt[tid] = 0u;
                for (int k = tid; k < 1024; k += NTHREADS) { const int j = k >> 8, ln = (k & 255) >> 2, i = k & 3; Lg[(j * 4 + i) * 64 + ln] = *(const f32x4_t*)(w_group + (size_t)k * 4); }
                {
                    f32x4_t wv[16];
#pragma unroll
                    for (int u = 0; u < 16; ++u) wv[u] = *(const f32x4_t*)(w_er + (size_t)(tid + u * NTHREADS) * 4);
#pragma unroll
                    for (int u = 0; u < 16; ++u) { const int q = tid + u * NTHREADS; const int g = q >> 11, k = (q >> 1) & 1023, half = q & 1; const int j = k >> 8, ln = (k & 255) >> 2, i = k & 3;
                        Le[((g * 16 + j * 4 + i) * 2 + half) * 64 + ln] = wv[u]; }
                }
                __syncthreads();
#ifdef PROF_LN1
                if (l == 0 && blockIdx.x == 0 && tid == 0) ctl[14000 + 20] = (unsigned)(__builtin_amdgcn_s_memrealtime() & 0xffffffffu);
#endif
                float4 xvA[4], xvB[4]; v2u mwA[4], mwB[4];
                auto ld_x = [&](int tk, int j) -> float4 {
                    if (l == 0) return *(const float4*)(x0 + (size_t)tk * D_MODEL + j * 256 + lane * 4);
                    const v2u xw = *(const v2u*)(a16 + (size_t)tk * D_MODEL + j * 256 + lane * 4);
                    return make_float4(bflo(xw.x), bfhi(xw.x), bflo(xw.y), bfhi(xw.y));
                };
                auto ld_tok = [&](int tk, float4 (&xv)[4], v2u (&mw)[4]) {
                    if (tk < NTOK) {
#pragma unroll
                        for (int j = 0; j < 4; ++j) { xv[j] = ld_x(tk, j); mw[j] = *(const v2u*)(mix16 + (size_t)tk * D_MODEL + j * 256 + lane * 4); }
                    }
                };
                auto do_tok = [&](int tk, float4 (&xv)[4], v2u (&mw)[4]) {
                    float4 v[4]; float s = 0.f;
#pragma unroll
                    for (int j = 0; j < 4; ++j) {
                        v[j] = make_float4(ALPHA * xv[j].x + bflo(mw[j].x), ALPHA * xv[j].y + bfhi(mw[j].x), ALPHA * xv[j].z + bflo(mw[j].y), ALPHA * xv[j].w + bfhi(mw[j].y));
                        s += (v[j].x + v[j].y) + (v[j].z + v[j].w);
                    }
                    ld_tok(tk + 2 * NGW, xv, mw);
                    const float mean = wave_sum(s) * (1.f / 1024.f); float s2 = 0.f;
#pragma unroll
                    for (int j = 0; j < 4; ++j) { v[j].x -= mean; v[j].y -= mean; v[j].z -= mean; v[j].w -= mean; s2 += (v[j].x * v[j].x + v[j].y * v[j].y) + (v[j].z * v[j].z + v[j].w * v[j].w); }
                    const float rstd = rsqrtf(wave_sum(s2) * (1.f / 1024.f) + LN_EPS);
                    float gl[4] = {0.f, 0.f, 0.f, 0.f};
#pragma unroll
                    for (int j = 0; j < 4; ++j) {
                        const int d0 = j * 256 + lane * 4;
                        const float4 gg = *(const float4*)(ln1_g + d0), bb = *(const float4*)(ln1_b + d0);
                        v[j] = make_float4(v[j].x * rstd * gg.x + bb.x, v[j].y * rstd * gg.y + bb.y, v[j].z * rstd * gg.z + bb.z, v[j].w * rstd * gg.w + bb.w);
                        { v2u hb; hb.x = pk2(v[j].x, v[j].y); hb.y = pk2(v[j].z, v[j].w); *(v2u*)(a16 + (size_t)tk * D_MODEL + d0) = hb; }
                        const float hv[4] = {v[j].x, v[j].y, v[j].z, v[j].w};
#pragma unroll
                        for (int i = 0; i < 4; ++i) {
                            const f32x4_t wg = Lg[(j * 4 + i) * 64 + lane];
                            gl[0] = fmaf(hv[i], wg.x, gl[0]); gl[1] = fmaf(hv[i], wg.y, gl[1]); gl[2] = fmaf(hv[i], wg.z, gl[2]); gl[3] = fmaf(hv[i], wg.w, gl[3]);
                        }
                    }
#pragma unroll
                    for (int i = 0; i < 4; ++i) gl[i] = wave_sum(gl[i]) + b_group[i];
                    int gi = 0; float gm = gl[0];
#pragma unroll
                    for (int i = 1; i < 4; ++i) if (gl[i] > gm) { gm = gl[i]; gi = i; }
                    gi = __builtin_amdgcn_readfirstlane(gi);
                    float gden = 0.f;
#pragma unroll
                    for (int i = 0; i < 4; ++i) gden += __expf(gl[i] - gm);
                    const float gwt = 1.f / gden;
                    float el[8] = {0.f, 0.f, 0.f, 0.f, 0.f, 0.f, 0.f, 0.f};
                    const LAS f32x4_t* we = Le + gi * 2048;
#pragma unroll
                    for (int j = 0; j < 4; ++j) {
                        const float hv[4] = {v[j].x, v[j].y, v[j].z, v[j].w};
#pragma unroll
                        for (int i = 0; i < 4; ++i) {
                            const f32x4_t w0 = we[((j * 4 + i) * 2) * 64 + lane], w1 = we[((j * 4 + i) * 2 + 1) * 64 + lane];
                            el[0] = fmaf(hv[i], w0.x, el[0]); el[1] = fmaf(hv[i], w0.y, el[1]); el[2] = fmaf(hv[i], w0.z, el[2]); el[3] = fmaf(hv[i], w0.w, el[3]);
                            el[4] = fmaf(hv[i], w1.x, el[4]); el[5] = fmaf(hv[i], w1.y, el[5]); el[6] = fmaf(hv[i], w1.z, el[6]); el[7] = fmaf(hv[i], w1.w, el[7]);
                        }
                    }
#pragma unroll
                    for (int i = 0; i < 8; ++i) el[i] = wave_sum(el[i]) + b_er[gi * 8 + i];
                    int i0 = 0; float v0 = el[0];
#pragma unroll
                    for (int i = 1; i < 8; ++i) if (el[i] > v0) { v0 = el[i]; i0 = i; }
                    int i1 = -1; float v1 = -INFINITY;
#pragma unroll
                    for (int i = 0; i < 8; ++i) if (i != i0 && el[i] > v1) { v1 = el[i]; i1 = i; }
                    const float e1 = __expf(v1 - v0);
                    const float w0 = gwt / (1.f + e1), w1 = gwt * e1 / (1.f + e1);
                    if (lane == 0) {
                        const int ea = gi * 8 + i0, eb = gi * 8 + i1;
                        ids[tk * 2] = ea; ids[tk * 2 + 1] = eb; wts[tk * 2] = w0; wts[tk * 2 + 1] = w1;
                        rank[tk * 2] = (int)__hip_atomic_fetch_add(lcnt + ea, 1u, __ATOMIC_RELAXED, __HIP_MEMORY_SCOPE_WORKGROUP);
                        rank[tk * 2 + 1] = (int)__hip_atomic_fetch_add(lcnt + eb, 1u, __ATOMIC_RELAXED, __HIP_MEMORY_SCOPE_WORKGROUP);
                    }
                };
                ld_tok(gw, xvA, mwA); ld_tok(gw + NGW, xvB, mwB);
                for (int tk = gw; tk < NTOK; tk += 2 * NGW) {
                    do_tok(tk, xvA, mwA);
                    if (tk + NGW < NTOK) do_tok(tk + NGW, xvB, mwB);
                }
#ifdef PROF_LN1
                if (l == 0 && blockIdx.x == 0 && tid == 0) ctl[14000 + 21] = (unsigned)(__builtin_amdgcn_s_memrealtime() & 0xffffffffu);
#endif
                __syncthreads();
                if (tid < 32) { const unsigned n = lcnt[tid]; lcnt[tid] = n ? atomicAdd(cnt + tid * 64, n) : 0u; }
                __syncthreads();
                for (int base = 0; gw + base * NGW < NTOK; base += 32) {
                    const int tk = gw + (base + (lane >> 1)) * NGW;
                    if (tk < NTOK) {
                        const int pi = tk * 2 + (lane & 1);
                        const int ee = ids[pi];
                        const int rr = rank[pi] + (int)lcnt[ee];
                        rank[pi] = rr;
                        if (!DUMMY) etok[ee * 16384 + rr] = tk;
                    }
                }
                __syncthreads();
            } else if constexpr (sp == 6) {
                LAS int* xs = (LAS int*)((LAS unsigned char*)lds_raw + 131072); LAS int* te = xs + 80;
                __syncthreads();
                expert_prefix(cnt, xs, tid);
                if (tid < 32) xs[40 + tid] = (int)cnt[tid * 64];
                __syncthreads();
                if (tid < NSLOT_TILES) { int e = 31; for (int k = 31; k >= 0; --k) if (tid * 256 < xs[k + 1]) e = k; te[tid] = e; }
                __syncthreads();
                const int T = xs[32] >> 8, nU1 = 2 * T;
                const int vc = (int)((blockIdx.x % 8) * (G / 8) + blockIdx.x / 8);
                unsigned go[2][2][2]; int upm[2], upn[2]; int nun = 0;
#pragma unroll
                for (int i = 0; i < 2; ++i) {
                    const int g = vc + i * G;
                    upm[i] = 0; upn[i] = 0;
#pragma unroll
                    for (int h = 0; h < 2; ++h) { go[i][h][0] = 0u; go[i][h][1] = 0u; }
                    if (g < nU1) {
                        const int t = g >> 1, e = __builtin_amdgcn_readfirstlane(te[t]);
                        const int tl = t - (xs[e] >> 8), ce = xs[40 + e];
                        upm[i] = t + pg8::XPM; upn[i] = e * 2 + (g & 1) + pg8::XPN; nun = i + 1;
#pragma unroll
                        for (int pc = 0; pc < 2; ++pc) { int R, C; pg8::stage_rc(tid * 16 + pc * 8192, R, C);
#pragma unroll
                            for (int h = 0; h < 2; ++h) { const int rk = tl * 256 + h * 128 + R; const int tok = rk < ce ? etok[e * 16384 + rk] : 0; go[i][h][pc] = (unsigned)tok * 2048u + (unsigned)C * 2u; } }
                    } else if (g - nU1 < 256) {
                        const int k = g - nU1;
                        upm[i] = k >> 2; upn[i] = k & 3; nun = i + 1;
#pragma unroll
                        for (int pc = 0; pc < 2; ++pc) { int R, C; pg8::stage_rc(tid * 16 + pc * 8192, R, C);
#pragma unroll
                            for (int h = 0; h < 2; ++h) go[i][h][pc] = (unsigned)((k >> 2) * 256 + h * 128 + R) * 2048u + (unsigned)C * 2u; }
                    }
                }
                if (nun == 1) {
#pragma unroll
                    for (int h = 0; h < 2; ++h) { go[1][h][0] = go[0][h][0]; go[1][h][1] = go[0][h][1]; }
                }
                {
                    pg8::Gemm g{a16, (const bf16*)(ws + WS_WPG), NTOK, 1024, 1024, 1024, 1024};
                    pg8::TwoUnits S{upm[0], upn[0], upm[1], upn[1], nun};
                    pg8::EpiX E{pg8::EpiGU{act16}, pg8::EpiPleGate{ple16, pp16}};
                    pg8::gemm_phase_ga<pg8::EpiX, pg8::TwoUnits, true, true>((LAS unsigned char*)lds_raw, g, S, E, tid, go[0], go[1]);
                }
            } else if constexpr (sp == 7) {
                LAS int* xs = (LAS int*)((LAS unsigned char*)lds_raw + 131072); LAS int* te = xs + 80;
                __syncthreads();
                expert_prefix(cnt, xs, tid);
                __syncthreads();
                if (tid < NSLOT_TILES) { int e = 31; for (int k = 31; k >= 0; --k) if (tid * 256 < xs[k + 1]) e = k; te[tid] = e; }
                __syncthreads();
                const int T = xs[32] >> 8;
                const int vc = (int)((blockIdx.x % 8) * (G / 8) + blockIdx.x / 8);
                int nB2 = 2 * T - G; nB2 = nB2 < 0 ? 0 : nB2;
                if (vc >= nB2) {
                    pg8::Gemm g{act16, (const bf16*)(ws + WS_WD), MAX_SLOTS, 32 * 1024, 256, 256, 256};
                    pg8::GroupSched S{(const int*)te, T, 4, G - nB2, vc - nB2};
                    pg8::EpiDown E{outs16};
                    pg8::gemm_phase<pg8::EpiDown, pg8::GroupSched, true, true>((LAS unsigned char*)lds_raw, g, S, E, tid);
                } else {
                    const int k = 256 - nB2 + vc;
                    pg8::Gemm g{a16, (const bf16*)(ws + WS_WPG), NTOK, 1024, 1024, 1024, 1024};
                    pg8::OneUnit S{k >> 2, k & 3};
                    pg8::EpiPleGate E{ple16, pp16};
                    pg8::gemm_phase<pg8::EpiPleGate, pg8::OneUnit, true, true>((LAS unsigned char*)lds_raw, g, S, E, tid);
                }
            } else if constexpr (sp == 8) {
                LAS int* xs = (LAS int*)((LAS unsigned char*)lds_raw + 131072);
                __syncthreads();
                expert_prefix(cnt, xs, tid);
                __syncthreads();
                struct Ln2Regs { v2u hv[4], oa[4], ob[4], pv[4]; float w0, w1; };
                Ln2Regs RA, RB;
                auto ld_rows = [&](int tk, Ln2Regs& R) {
                    if (tk < NTOK) {
                        const int s0 = xs[ids[tk * 2]] + rank[tk * 2], s1 = xs[ids[tk * 2 + 1]] + rank[tk * 2 + 1]; R.w0 = wts[tk * 2]; R.w1 = wts[tk * 2 + 1];
#pragma unroll
                        for (int j = 0; j < 4; ++j) {
                            const int d0 = j * 256 + lane * 4;
                            R.hv[j] = *(const v2u*)(a16 + (size_t)tk * D_MODEL + d0);
                            R.oa[j] = *(const v2u*)(outs16 + (size_t)s0 * D_MODEL + d0); R.ob[j] = *(const v2u*)(outs16 + (size_t)s1 * D_MODEL + d0);
                            R.pv[j] = *(const v2u*)(ple16 + (size_t)tk * D_MODEL + d0);
                        }
                    }
                };
                auto do_row = [&](int tk, Ln2Regs& R) {
                    float4 v[4]; float s = 0.f; const float w0 = R.w0, w1 = R.w1;
#pragma unroll
                    for (int j = 0; j < 4; ++j) {
                        v[j] = make_float4(ALPHA * bflo(R.hv[j].x) + w0 * bflo(R.oa[j].x) + w1 * bflo(R.ob[j].x) + bflo(R.pv[j].x), ALPHA * bfhi(R.hv[j].x) + w0 * bfhi(R.oa[j].x) + w1 * bfhi(R.ob[j].x) + bfhi(R.pv[j].x),
                                           ALPHA * bflo(R.hv[j].y) + w0 * bflo(R.oa[j].y) + w1 * bflo(R.ob[j].y) + bflo(R.pv[j].y), ALPHA * bfhi(R.hv[j].y) + w0 * bfhi(R.oa[j].y) + w1 * bfhi(R.ob[j].y) + bfhi(R.pv[j].y));
                        s += (v[j].x + v[j].y) + (v[j].z + v[j].w);
                    }
                    ld_rows(tk + 2 * NGW, R);
                    const float mean = wave_sum(s) * (1.f / 1024.f); float s2 = 0.f;
#pragma unroll
                    for (int j = 0; j < 4; ++j) { v[j].x -= mean; v[j].y -= mean; v[j].z -= mean; v[j].w -= mean; s2 += (v[j].x * v[j].x + v[j].y * v[j].y) + (v[j].z * v[j].z + v[j].w * v[j].w); }
                    const float rstd = rsqrtf(wave_sum(s2) * (1.f / 1024.f) + LN_EPS);
#pragma unroll
                    for (int j = 0; j < 4; ++j) {
                        const int d0 = j * 256 + lane * 4;
                        const float4 gg = *(const float4*)(ln2_g + d0), bb = *(const float4*)(ln2_b + d0);
                        const float4 o = make_float4(v[j].x * rstd * gg.x + bb.x, v[j].y * rstd * gg.y + bb.y, v[j].z * rstd * gg.z + bb.z, v[j].w * rstd * gg.w + bb.w);
                        if (!DUMMY || w0 == 12345.678f) {
                        if (l == DEPTH - 1) {
#ifdef PROF_SEL
#ifdef PROF_LN1
                        float4 oo = o; { const float dlt = sqrtf((float)(ctl[14000 + PROF_LN1 + 1] - ctl[14000 + PROF_LN1]) * 1e-8f);
#else
                        float4 oo = o; { const float dlt = sqrtf((float)ctl[14000 + PROF_SEL] * 1e-8f);
#endif
                        oo.x += dlt; oo.y += dlt; oo.z += dlt; oo.w += dlt; }
                        *(float4*)(KOUT + (size_t)tk * D_MODEL + d0) = oo;
#else
                        *(float4*)(KOUT + (size_t)tk * D_MODEL + d0) = o;
#endif
                        } else {
                        v2u ob16; ob16.x = pk2(o.x, o.y); ob16.y = pk2(o.z, o.w);
                        *(v2u*)(a16 + (size_t)tk * D_MODEL + d0) = ob16;
                        }
                        }
                    }
                };
                ld_rows(gw, RA); ld_rows(gw + NGW, RB);
                for (int tk = gw; tk < NTOK; tk += 2 * NGW) {
                    do_row(tk, RA);
                    if (tk + NGW < NTOK) do_row(tk + NGW, RB);
                }
                if (l + 1 < DEPTH) convert_layer_weights(a, l + 1, ws, scr, gw, NGW, lane);
            }
        }
}

constexpr int CW_BAR = 4096;
__global__ void __launch_bounds__(NTHREADS, 2) mega(Args a) {
    extern __shared__ __attribute__((aligned(16))) unsigned char lds_raw[];
    cg::grid_group grid = cg::this_grid();
    volatile LAS unsigned* misc = (volatile LAS unsigned*)((LAS unsigned char*)lds_raw + LDS_MISC);
    if (threadIdx.x < 16) misc[threadIdx.x] = 0u;
    __syncthreads();
    XcdBarrier bar = xcd_barrier_post((unsigned*)(a.ws + WS_CTL) + CW_BAR, misc + 8);
    const int wave_s = __builtin_amdgcn_readfirstlane(threadIdx.x >> 6);
#define IS_T0 (wave_s == 0 && lane_id_now() == 0)
#ifndef DUP_SP
#define DUP_SP -1
#endif
#ifndef DUP_X
#define DUP_X 0
#endif
    if (a.ph_hi < 0) grid.sync();
#define SEAM(ph) do { xcd_barrier(bar, IS_T0); } while (0)
#ifdef PROF_PH
    unsigned long long ph_t_prev = __builtin_amdgcn_s_memrealtime();
#define PHASE_STAMP(ph) do { const unsigned long long t_ = __builtin_amdgcn_s_memrealtime(); if ((ph) == PROF_PH && blockIdx.x == 0 && IS_T0) ((unsigned*)(a.ws + WS_CTL))[14000 + PROF_SEL] = (unsigned)(t_ - ph_t_prev); ph_t_prev = t_; } while (0)
#else
#define PHASE_STAMP(ph) do {} while (0)
#endif
#define RUN(ph) if (a.ph_lo <= (ph) && (ph) < a.ph_hi) { \
        if (DUP_X == 9 && (ph) > 0 && ((ph) - 1) % PH_PER_LAYER == 9) { run_phase<ph, true>(a, lds_raw, wave_s); xcd_barrier(bar, IS_T0); } \
        run_phase<ph>(a, lds_raw, wave_s); \
        if ((ph) > 0 && ((ph) - 1) % PH_PER_LAYER == DUP_SP) { xcd_barrier(bar, IS_T0); run_phase<ph>(a, lds_raw, wave_s); } \
        if (DUP_X == 100 && (ph) == 0) { xcd_barrier(bar, IS_T0); run_phase<ph>(a, lds_raw, wave_s); } \
        if (DUP_X == 5 && (ph) == 6) { xcd_barrier(bar, IS_T0); run_phase<ph, true>(a, lds_raw, wave_s); } \
        if (DUP_X == 3 && (ph) > 0 && ((ph) - 1) % PH_PER_LAYER == 3) { xcd_barrier(bar, IS_T0); run_phase<ph, true>(a, lds_raw, wave_s); } \
        if ((ph) + 1 < a.ph_hi && (ph) + 1 < NPH) SEAM(ph); PHASE_STAMP(ph); }
    RUN(0) RUN(1) RUN(2) RUN(3) RUN(4) RUN(5) RUN(6) RUN(7) RUN(8) RUN(9)
    RUN(10) RUN(11) RUN(12) RUN(13) RUN(14) RUN(15) RUN(16) RUN(17) RUN(18)
#undef RUN
#undef SEAM
}

extern "C" void kernel_launch(void* const* d_in, const int* in_sizes, int n_in, void* d_out, int out_size, void* d_ws, size_t ws_size, hipStream_t stream) {
    static int grid = 0;
    if (grid == 0) {
        if (n_in != 28 || ws_size < WS_END) { fprintf(stderr, "kernel_launch: unexpected n_in %d or ws_size %zu (< %zu)\n", n_in, ws_size, (size_t)WS_END); grid = -1; return; }
        int dev = 0, cus = 0, per_cu = 0;
        (void)hipGetDevice(&dev);
        (void)hipDeviceGetAttribute(&cus, hipDeviceAttributeMultiprocessorCount, dev);
        (void)hipFuncSetAttribute((const void*)mega, hipFuncAttributeMaxDynamicSharedMemorySize, LDS_BYTES);
        (void)hipOccupancyMaxActiveBlocksPerMultiprocessor(&per_cu, (const void*)mega, NTHREADS, LDS_BYTES);
        if (per_cu < 1) { fprintf(stderr, "kernel_launch: occupancy query says %d blocks/CU\n", per_cu); }
        (void)hipGetLastError();
        grid = cus;
    }
    if (grid < 0) return;
    (void)hipMemsetAsync((char*)d_ws + WS_CTL, 0, 64 * 1024, stream);
    Args a{};
    for (int i = 0; i < 28; ++i) a.in[i] = d_in[i];
    a.out = (float*)d_out; a.ws = (unsigned char*)d_ws; a.ph_lo = 0; a.ph_hi = NPH;
    void* params[] = {&a};
    hipError_t e = hipLaunchCooperativeKernel((const void*)mega, dim3(grid), dim3(NTHREADS), params, LDS_BYTES, stream);
    if (e != hipSuccess) fprintf(stderr, "cooperative launch failed: %s (grid %d)\n", hipGetErrorString(e), grid);
}
```

```cpp
#include <hip/hip_runtime.h>
#include <hip/hip_cooperative_groups.h>
#include <cstdio>
#include <cstdint>
namespace cg = cooperative_groups;

constexpr int D_MODEL = 1024, BATCH = 8, SEQ = 2048, NTOK = BATCH * SEQ, DEPTH = 2;
constexpr int D_IN = 2340;
constexpr int OFF_QA = 0, OFF_KA = 384, OFF_VA = 768, OFF_CQ = 1152, OFF_CKV = 1408, OFF_KR = 1536,
              OFF_QC = 1568, OFF_KC = 1824, OFF_VC = 2080, OFF_FC = 2336;
constexpr int ZP = 2560;
constexpr int Z_QA = 0, Z_KA = 384, Z_VA = 768, Z_QC = 1152, Z_KC = 1408, Z_VC = 1664, Z_CKV = 1920, Z_CQ = 2048, Z_KR = 2304, Z_FC = 2336;
constexpr int NQB = 576, NKVB = 768, NQBP = 768;
constexpr int N_EXPERTS = 32, D_EXPERT = 256, PLE_DIM = 256;
constexpr int MAX_SLOTS = 32768 + 32 * 256;
constexpr int NSLOT_TILES = MAX_SLOTS / 256;
constexpr float ALPHA = 1.4142135623730951f;
constexpr float LN_EPS = 1e-5f, RMS_EPS = 1e-6f;
constexpr int NTHREADS = 512;
constexpr int LDS_BYTES = 147456 + 256;

constexpr size_t MiB = 1u << 20;
constexpr size_t WS_CTL = 0;
constexpr size_t WS_COS = 1 * MiB, WS_SIN = 2 * MiB;
constexpr size_t WS_WIN = 3 * MiB;
constexpr size_t WS_WUQ = 8 * MiB;
constexpr size_t WS_WUKV = WS_WUQ + 393216;
constexpr size_t WS_WOUT = 9 * MiB;
constexpr size_t WS_WPG = 11 * MiB;
constexpr size_t WS_WPP = 13 * MiB;
constexpr size_t WS_WGU = 14 * MiB;
constexpr size_t WS_WD = 46 * MiB;
constexpr size_t WS_A16 = 62 * MiB;
constexpr size_t WS_P16 = 94 * MiB;
constexpr size_t WS_Z16 = 110 * MiB;
constexpr size_t WS_HS16 = WS_Z16;
constexpr size_t WS_OUTS16 = WS_Z16;
constexpr size_t WS_QB16 = 190 * MiB;
constexpr size_t WS_KVB16 = 214 * MiB;
constexpr size_t WS_KRR16 = 238 * MiB;
constexpr size_t WS_FC = 239 * MiB;
constexpr size_t WS_CUM = WS_FC + 256 * 1024;
constexpr size_t WS_LOGF = WS_CUM + 256 * 1024;
constexpr size_t WS_RQ = WS_LOGF + 256 * 1024;
constexpr size_t WS_RKV = WS_RQ + 64 * 1024;
constexpr size_t WS_MIX16 = 190 * MiB;
constexpr size_t WS_PP16 = 276 * MiB;
constexpr size_t WS_ACT16 = 222 * MiB;
constexpr size_t WS_MIXED16 = 242 * MiB;
constexpr size_t WS_PLE16 = 242 * MiB;
constexpr size_t WS_RT = 274 * MiB;
constexpr size_t WS_ETOK = 308 * MiB;
constexpr size_t WS_END = 310 * MiB;
constexpr size_t RT_IDS = 0, RT_WTS = 128 * 1024, RT_RANK = 256 * 1024, RT_SLOTOF = 384 * 1024, RT_TILEE = 768 * 1024, RT_TPMAX = 800 * 1024;
constexpr int CW_CNT = 0;
static_assert((WS_A16 - WS_HS16) % (256 * 1024 * 2) == 0 || true, "");

struct Args { const void* in[28]; float* out; unsigned char* ws; int ph_lo, ph_hi; };

#define LAS __attribute__((address_space(3)))
typedef unsigned short bf16;
typedef unsigned v4u __attribute__((ext_vector_type(4)));
typedef unsigned v2u __attribute__((ext_vector_type(2)));
typedef float f32x4_t __attribute__((ext_vector_type(4)));

__device__ __forceinline__ float wave_sum(float v) {
#define WS_DPP(ctrl, rmask) __builtin_bit_cast(float, __builtin_amdgcn_update_dpp(0, __builtin_bit_cast(int, v), (ctrl), (rmask), 0xf, true))
    v += WS_DPP(0x111, 0xf);
    v += WS_DPP(0x112, 0xf);
    v += WS_DPP(0x114, 0xf);
    v += WS_DPP(0x118, 0xf);
    v += WS_DPP(0x142, 0xa);
    v += WS_DPP(0x143, 0xc);
#undef WS_DPP
    return __builtin_bit_cast(float, __builtin_amdgcn_readlane(__builtin_bit_cast(int, v), 63));
}
__device__ __forceinline__ unsigned f2bf(float f) { unsigned u = __builtin_bit_cast(unsigned, f); return (u + 0x7fffu + ((u >> 16) & 1u)) >> 16; }
__device__ __forceinline__ unsigned pk2(float lo, float hi) { return f2bf(lo) | (f2bf(hi) << 16); }
__device__ __forceinline__ float bflo(unsigned w) { return __uint_as_float(w << 16); }
__device__ __forceinline__ float bfhi(unsigned w) { return __uint_as_float(w & 0xffff0000u); }
__device__ __forceinline__ void unpack8(const v4u w, float* f) { f[0] = bflo(w.x); f[1] = bfhi(w.x); f[2] = bflo(w.y); f[3] = bfhi(w.y); f[4] = bflo(w.z); f[5] = bfhi(w.z); f[6] = bflo(w.w); f[7] = bfhi(w.w); }
__device__ __forceinline__ int lane_id_now() { int l; asm volatile("v_mbcnt_lo_u32_b32 %0, -1, 0\n\tv_mbcnt_hi_u32_b32 %0, -1, %0" : "=v"(l)); return l; }
namespace pg8 {
#define PG8_LAS __attribute__((address_space(3)))
typedef unsigned short bf16_t;
typedef short bf16x8 __attribute__((ext_vector_type(8)));
typedef float f32x4 __attribute__((ext_vector_type(4)));
typedef unsigned u32x4 __attribute__((ext_vector_type(4)));
constexpr int BM = 256, BK = 64, HALF = 128, HTB = HALF * BK * 2  , STAGE_BYTES = 8 * HTB, NXCD = 8, WGM = 8;

__host__ __device__ __forceinline__ int lds_byte(int r, int c) { const int st = (r >> 4) * 2 + (c >> 5), rr = r & 15, cc = c & 31, ob = rr * 64 + cc * 2; return st * 1024 + (ob ^ (((ob >> 9) & 1) << 5)); }
__host__ __device__ __forceinline__ void stage_rc(int b, int& R, int& C) { const int st = b / 1024, sb = b % 1024, swz = sb ^ (((sb >> 9) & 1) << 5); R = (st >> 1) * 16 + swz / 64; C = (st & 1) * 32 + (swz % 64) / 2; }
__host__ __device__ __forceinline__ int perm32(int rho) { const int n = rho >> 4, i = rho & 15; return 8 * (i >> 2) + 4 * n + (i & 3); }

struct Unit { int pm, pn; };
struct Gemm { const bf16_t* A; const bf16_t* Bt; int M, N, K, lda, ldb; };

struct StaticOrder {
    int nM, nN, nwg, G, c;
    __host__ __device__ void init(int M, int N, int G_, int c_) { nM = M / BM; nN = N / BM; nwg = nM * nN; G = G_; c = c_; }
    __host__ __device__ bool next(int i, Unit& u) const {
        const long L = (long)i * G + c; if (L >= nwg) return false;
        int wgid = (int)L; { const int q = nwg / NXCD, r = nwg % NXCD, xcd = wgid % NXCD, off = wgid / NXCD; wgid = (xcd < r ? xcd * (q + 1) : r * (q + 1) + (xcd - r) * q) + off; }
        const int nig = WGM * nN, gid = wgid / nig, fm = gid * WGM, gsz = (nM - fm) < WGM ? (nM - fm) : WGM;
        u.pm = fm + ((wgid % nig) % gsz); u.pn = (wgid % nig) / gsz; return true;
    }
    __device__ __forceinline__ void a_ready(const Unit&) const {}
    __device__ __forceinline__ void done(const Unit&) const {}
};

__device__ __forceinline__ unsigned cvt_pk_bf16(float lo, float hi) { unsigned r; asm volatile("v_cvt_pk_bf16_f32 %0, %1, %2" : "=v"(r) : "v"(lo), "v"(hi)); return r; }
typedef float f32x2 __attribute__((ext_vector_type(2)));
__device__ __forceinline__ f32x2 gelu_pk(f32x2 v) {
    const f32x2 av = __builtin_elementwise_abs(v), d = av * 0.2316418882f + 1.0f;
    f32x2 t; t.x = __builtin_amdgcn_rcpf(d.x); t.y = __builtin_amdgcn_rcpf(d.y);
    f32x2 q = t * 0.5307027145f + (-0.7265760135f); q = q * t + 0.7107068705f; q = q * t + (-0.142248368f); q = q * t + 0.127414796f; q = q * t;
    const f32x2 s = (v * v) * (-0.72134752044f);
    f32x2 e; e.x = __builtin_amdgcn_exp2f(s.x); e.y = __builtin_amdgcn_exp2f(s.y);
    const f32x2 m = v * (q * e), r = v - m;
    f32x2 o; o.x = v.x < 0.f ? m.x : r.x; o.y = v.y < 0.f ? m.y : r.y; return o;
}

template <int ACT  > struct EpiBf16 {
    static constexpr bool PERM = true, AFTER_DRAIN = false; static_assert(ACT == 0 || ACT == 1, "EpiBf16: ACT is 0 (none) or 1 (gelu_pk)");
    bf16_t* O; int ldc; const float* bias; int split_cols; size_t split_stride; float scale0;
    __device__ __forceinline__ void operator()(const f32x4 (&acc)[2][2][4][2], const Unit& u, int wr, int wc, int fr, int fq) const {
        const int row0 = u.pm * BM + wr * 64 + fr; int colt = u.pn * BM; bf16_t* base = O;
        float sc = 1.f; if (split_cols) { const int t = colt / split_cols; base += (size_t)t * split_stride; colt -= t * split_cols; if (t == 0) sc = scale0; }
        const int col0 = colt + wc * 32 + 8 * fq, bcol0 = u.pn * BM + wc * 32 + 8 * fq;
        f32x4 bv[2][2];
#pragma unroll
        for (int bj = 0; bj < 2; ++bj)
#pragma unroll
            for (int n = 0; n < 2; ++n) bv[bj][n] = bias ? *(const f32x4*)(bias + bcol0 + bj * HALF + 4 * n) : (f32x4){0.f, 0.f, 0.f, 0.f};
#pragma unroll
        for (int ai = 0; ai < 2; ++ai)
#pragma unroll
            for (int m = 0; m < 4; ++m) { bf16_t* rowp = base + (size_t)(row0 + ai * HALF + m * 16) * ldc + col0;
#pragma unroll
                for (int bj = 0; bj < 2; ++bj) { f32x4 v0 = acc[ai][bj][m][0] + bv[bj][0], v1 = acc[ai][bj][m][1] + bv[bj][1];
                    if (ACT == 1) { f32x2 a = gelu_pk((f32x2){v0[0], v0[1]}), b = gelu_pk((f32x2){v0[2], v0[3]}), c = gelu_pk((f32x2){v1[0], v1[1]}), d = gelu_pk((f32x2){v1[2], v1[3]});
                        v0 = (f32x4){a.x, a.y, b.x, b.y}; v1 = (f32x4){c.x, c.y, d.x, d.y}; }
                    v0 = v0 * sc; v1 = v1 * sc; u32x4 w; w.x = cvt_pk_bf16(v0[0], v0[1]); w.y = cvt_pk_bf16(v0[2], v0[3]); w.z = cvt_pk_bf16(v1[0], v1[1]); w.w = cvt_pk_bf16(v1[2], v1[3]);
                    *(u32x4*)(rowp + bj * HALF) = w; } }
    }
};
template <class Epi, class Sched, bool ALIGN_EPI = false, bool SP2 = false>
__device__ __forceinline__ void gemm_phase(PG8_LAS unsigned char* lds, const Gemm g, const Sched& S, const Epi& E, const int tid) {
    const int wid = __builtin_amdgcn_readfirstlane(tid >> 6), lane = tid & 63, wr = wid >> 2, wc = wid & 3, fr = lane & 15, fq = lane >> 4;
    int K = g.K; asm volatile("" : "+s"(K));
    const int nt = K / BK;
    unsigned voffA[2], voffB[2];
#pragma unroll
    for (int i = 0; i < 2; ++i) { int R, C; stage_rc(tid * 16 + i * 8192, R, C); const int Rb = Epi::PERM ? ((R & ~31) + perm32(R & 31)) : R;
        voffA[i] = (unsigned)(R * g.lda + C) * 2u; voffB[i] = (unsigned)(Rb * g.ldb + C) * 2u; }
    const size_t kstep = (size_t)(BK * 2);
    const size_t hstepA = (size_t)HALF * g.lda * 2, hstepB = (size_t)HALF * g.ldb * 2;
    const size_t tstepA = 2 * hstepA, tstepB = 2 * hstepB;
    const unsigned ldsw = (unsigned)wid * 1024u;
    const int aoff = lds_byte(wr * 64 + fr, fq * 8), boff = lds_byte(wc * 32 + fr, fq * 8);
#define PG8_SA(b, h) (((b) * 2 + (h)) * HTB)
#define PG8_SB(b, h) ((4 + (b) * 2 + (h)) * HTB)
#define PG8_STAGE(bufoff, gbase, voff) do { _Pragma("unroll") for (int _i = 0; _i < 2; ++_i) \
        __builtin_amdgcn_global_load_lds((const unsigned*)((const char*)(gbase) + (voff)[_i]), (PG8_LAS unsigned*)(lds + (bufoff) + ldsw + _i * 8192), 16, 0, 0); } while (0)
#define PG8_LDA(dst, b, h) do { _Pragma("unroll") for (int m = 0; m < 4; ++m) _Pragma("unroll") for (int k = 0; k < 2; ++k) dst[m][k] = *(const PG8_LAS bf16x8*)(lds + PG8_SA(b, h) + aoff + m * 2048 + k * 1024); } while (0)
#define PG8_LDB(dst, b, h) do { _Pragma("unroll") for (int n = 0; n < 2; ++n) _Pragma("unroll") for (int k = 0; k < 2; ++k) dst[n][k] = *(const PG8_LAS bf16x8*)(lds + PG8_SB(b, h) + boff + n * 2048 + k * 1024); } while (0)
#define PG8_MMA(ai, bj, At, Bt) do { __builtin_amdgcn_s_setprio(1); _Pragma("unroll") for (int m = 0; m < 4; ++m) _Pragma("unroll") for (int n = 0; n < 2; ++n) _Pragma("unroll") for (int k = 0; k < 2; ++k) \
        acc[ai][bj][m][n] = __builtin_amdgcn_mfma_f32_16x16x32_bf16(Bt[n][k], At[m][k], acc[ai][bj][m][n], 0, 0, 0); __builtin_amdgcn_s_setprio(0); } while (0)
#define PG8_WAIT_V(n) asm volatile("s_waitcnt vmcnt(" #n ")" ::: "memory")
#define PG8_WAIT_L(n) asm volatile("s_waitcnt lgkmcnt(" #n ")" ::: "memory")
#define PG8_BAR __builtin_amdgcn_s_barrier()
#define PG8_SCHED __builtin_amdgcn_sched_barrier(0)
    Unit cur, nxt; int ui = 0;
    if (!S.next(0, cur)) return;
    f32x4 acc[2][2][4][2];
#pragma unroll
    for (int a = 0; a < 2; ++a)
#pragma unroll
        for (int b = 0; b < 2; ++b)
#pragma unroll
            for (int m = 0; m < 4; ++m)
#pragma unroll
                for (int n = 0; n < 2; ++n) acc[a][b][m][n] = (f32x4){0.f, 0.f, 0.f, 0.f};
    bf16x8 At[4][2], B0[2][2], B1[2][2];
    const char* cA = (const char*)g.A + (size_t)cur.pm * tstepA; const char* cB = (const char*)g.Bt + (size_t)cur.pn * tstepB;
    S.a_ready(cur);
    if constexpr (SP2) {
        PG8_STAGE(PG8_SB(0, 0), cB, voffB); PG8_STAGE(PG8_SB(0, 1), cB + hstepB, voffB); PG8_STAGE(PG8_SA(0, 0), cA, voffA); PG8_STAGE(PG8_SA(0, 1), cA + hstepA, voffA);
        if (wr == 1) PG8_BAR;
        PG8_WAIT_V(2); PG8_BAR;
        PG8_STAGE(PG8_SB(1, 0), cB + kstep, voffB); PG8_STAGE(PG8_SA(1, 0), cA + kstep, voffA); PG8_STAGE(PG8_SB(1, 1), cB + hstepB + kstep, voffB);
        PG8_WAIT_V(6); PG8_BAR;
    } else {
        PG8_STAGE(PG8_SB(0, 0), cB, voffB); PG8_STAGE(PG8_SA(0, 0), cA, voffA); PG8_STAGE(PG8_SB(0, 1), cB + hstepB, voffB); PG8_STAGE(PG8_SA(0, 1), cA + hstepA, voffA);
        if (wr == 1) PG8_BAR;
        PG8_WAIT_V(4); PG8_BAR;
        PG8_STAGE(PG8_SB(1, 0), cB + kstep, voffB); PG8_STAGE(PG8_SA(1, 0), cA + kstep, voffA); PG8_STAGE(PG8_SB(1, 1), cB + hstepB + kstep, voffB);
        PG8_WAIT_V(6); PG8_BAR;
    }
    for (;;) {
        const bool has_next = S.next(ui + 1, nxt);
        const char* nA = has_next ? (const char*)g.A + (size_t)nxt.pm * tstepA : cA; const char* nB = has_next ? (const char*)g.Bt + (size_t)nxt.pn * tstepB : cB;
        for (int t = 0; t < nt; t += 2) {
            const bool last = (t == nt - 2);
            const char* a1 = cA + (size_t)(t + 1) * kstep;
            const char* a2 = last ? nA : cA + (size_t)(t + 2) * kstep; const char* b2 = last ? nB : cB + (size_t)(t + 2) * kstep;
            const char* a3 = a2 + kstep; const char* b3 = b2 + kstep;
            if (last && has_next) S.a_ready(nxt);
            if constexpr (SP2) {
            PG8_LDB(B0, 0, 0); PG8_LDB(B1, 0, 1); PG8_SCHED; PG8_LDA(At, 0, 0); PG8_STAGE(PG8_SA(1, 1), a1 + hstepA, voffA);
            PG8_WAIT_V(8); PG8_WAIT_L(0); PG8_BAR; PG8_MMA(0, 0, At, B0); PG8_MMA(0, 1, At, B1); PG8_BAR; PG8_SCHED;
            PG8_LDA(At, 0, 1); PG8_STAGE(PG8_SB(0, 0), b2, voffB); PG8_STAGE(PG8_SB(0, 1), b2 + hstepB, voffB); PG8_STAGE(PG8_SA(0, 0), a2, voffA);
            PG8_WAIT_V(8); PG8_WAIT_L(0); PG8_BAR; PG8_MMA(1, 0, At, B0); PG8_MMA(1, 1, At, B1); PG8_BAR; PG8_SCHED;
            PG8_LDB(B0, 1, 0); PG8_LDB(B1, 1, 1); PG8_SCHED; PG8_LDA(At, 1, 0); PG8_STAGE(PG8_SA(0, 1), a2 + hstepA, voffA);
            PG8_WAIT_V(8); PG8_WAIT_L(0); PG8_BAR; PG8_MMA(0, 0, At, B0); PG8_MMA(0, 1, At, B1); PG8_BAR; PG8_SCHED;
            PG8_LDA(At, 1, 1); PG8_STAGE(PG8_SB(1, 0), b3, voffB); PG8_STAGE(PG8_SB(1, 1), b3 + hstepB, voffB); PG8_STAGE(PG8_SA(1, 0), a3, voffA);
            PG8_WAIT_V(8); PG8_WAIT_L(0); PG8_BAR; PG8_MMA(1, 0, At, B0); PG8_MMA(1, 1, At, B1); PG8_BAR; PG8_SCHED;
            } else {
            PG8_LDB(B0, 0, 0); PG8_SCHED; PG8_LDA(At, 0, 0); PG8_STAGE(PG8_SA(1, 1), a1 + hstepA, voffA);
            PG8_WAIT_L(8); PG8_BAR; PG8_WAIT_L(0); PG8_MMA(0, 0, At, B0); PG8_BAR; PG8_SCHED;
            PG8_LDB(B1, 0, 1); PG8_STAGE(PG8_SB(0, 0), b2, voffB);
            PG8_BAR; PG8_WAIT_L(0); PG8_MMA(0, 1, At, B1); PG8_BAR;
            PG8_LDA(At, 0, 1); PG8_STAGE(PG8_SA(0, 0), a2, voffA);
            PG8_BAR; PG8_WAIT_L(0); PG8_MMA(1, 0, At, B0); PG8_BAR; PG8_SCHED;
            PG8_STAGE(PG8_SB(0, 1), b2 + hstepB, voffB);
            PG8_WAIT_V(6); PG8_BAR; PG8_MMA(1, 1, At, B1); PG8_BAR;
            PG8_LDB(B0, 1, 0); PG8_SCHED; PG8_LDA(At, 1, 0); PG8_STAGE(PG8_SA(0, 1), a2 + hstepA, voffA);
            PG8_WAIT_L(8); PG8_BAR; PG8_WAIT_L(0); PG8_MMA(0, 0, At, B0); PG8_BAR; PG8_SCHED;
            PG8_LDB(B1, 1, 1); PG8_STAGE(PG8_SB(1, 0), b3, voffB);
            PG8_BAR; PG8_WAIT_L(0); PG8_MMA(0, 1, At, B1); PG8_BAR;
            PG8_LDA(At, 1, 1); PG8_STAGE(PG8_SA(1, 0), a3, voffA);
            PG8_BAR; PG8_WAIT_L(0); PG8_MMA(1, 0, At, B0); PG8_BAR; PG8_SCHED;
            PG8_STAGE(PG8_SB(1, 1), b3 + hstepB, voffB);
            PG8_WAIT_V(6); PG8_BAR; PG8_MMA(1, 1, At, B1); PG8_BAR;
            }
        }
        if constexpr (ALIGN_EPI) { if (wr == 0) PG8_BAR; }
        if constexpr (!Epi::AFTER_DRAIN) { E(acc, cur, wr, wc, fr, fq); S.done(cur); }
        if (!has_next) break;
#pragma unroll
        for (int a = 0; a < 2; ++a)
#pragma unroll
            for (int b = 0; b < 2; ++b)
#pragma unroll
                for (int m = 0; m < 4; ++m)
#pragma unroll
                    for (int n = 0; n < 2; ++n) acc[a][b][m][n] = (f32x4){0.f, 0.f, 0.f, 0.f};
        cur = nxt; cA = nA; cB = nB; ++ui;
        if constexpr (ALIGN_EPI) { if (wr == 1) PG8_BAR; }
    }
    PG8_WAIT_V(0);
    if constexpr (!ALIGN_EPI) { if (wr == 0) PG8_BAR; }
    PG8_BAR;
    if constexpr (Epi::AFTER_DRAIN) { E.fused(acc, cur, wr, wc, fr, fq, lds, wid, lane); S.done(cur); }
#undef PG8_SA
#undef PG8_SB
#undef PG8_STAGE
#undef PG8_LDA
#undef PG8_LDB
#undef PG8_MMA
#undef PG8_WAIT_V
#undef PG8_WAIT_L
#undef PG8_BAR
#undef PG8_SCHED
}
template <class Epi, class Sched, bool ALIGN_EPI = false, bool SP2 = false>
__device__ __forceinline__ void gemm_phase_ga(PG8_LAS unsigned char* lds, const Gemm g, const Sched& S, const Epi& E, const int tid, const unsigned (&g0)[2][2], const unsigned (&g1)[2][2]) {
    unsigned ca0[2] = {g0[0][0], g0[0][1]}, ca1[2] = {g0[1][0], g0[1][1]}; const unsigned na0[2] = {g1[0][0], g1[0][1]}, na1[2] = {g1[1][0], g1[1][1]};
    const int wid = __builtin_amdgcn_readfirstlane(tid >> 6), lane = tid & 63, wr = wid >> 2, wc = wid & 3, fr = lane & 15, fq = lane >> 4;
    int K = g.K; asm volatile("" : "+s"(K));
    const int nt = K / BK;
    unsigned voffA[2], voffB[2];
#pragma unroll
    for (int i = 0; i < 2; ++i) { int R, C; stage_rc(tid * 16 + i * 8192, R, C); const int Rb = Epi::PERM ? ((R & ~31) + perm32(R & 31)) : R;
        voffA[i] = (unsigned)(R * g.lda + C) * 2u; voffB[i] = (unsigned)(Rb * g.ldb + C) * 2u; }
    const size_t kstep = (size_t)(BK * 2);
    const size_t hstepA = (size_t)HALF * g.lda * 2, hstepB = (size_t)HALF * g.ldb * 2;
    const size_t tstepA = 2 * hstepA, tstepB = 2 * hstepB;
    const unsigned ldsw = (unsigned)wid * 1024u;
    const int aoff = lds_byte(wr * 64 + fr, fq * 8), boff = lds_byte(wc * 32 + fr, fq * 8);
#define PG8_SA(b, h) (((b) * 2 + (h)) * HTB)
#define PG8_SB(b, h) ((4 + (b) * 2 + (h)) * HTB)
#define PG8_STAGE(bufoff, gbase, voff) do { _Pragma("unroll") for (int _i = 0; _i < 2; ++_i) \
        __builtin_amdgcn_global_load_lds((const unsigned*)((const char*)(gbase) + (voff)[_i]), (PG8_LAS unsigned*)(lds + (bufoff) + ldsw + _i * 8192), 16, 0, 0); } while (0)
#define PG8_LDA(dst, b, h) do { _Pragma("unroll") for (int m = 0; m < 4; ++m) _Pragma("unroll") for (int k = 0; k < 2; ++k) dst[m][k] = *(const PG8_LAS bf16x8*)(lds + PG8_SA(b, h) + aoff + m * 2048 + k * 1024); } while (0)
#define PG8_LDB(dst, b, h) do { _Pragma("unroll") for (int n = 0; n < 2; ++n) _Pragma("unroll") for (int k = 0; k < 2; ++k) dst[n][k] = *(const PG8_LAS bf16x8*)(lds + PG8_SB(b, h) + boff + n * 2048 + k * 1024); } while (0)
#define PG8_MMA(ai, bj, At, Bt) do { __builtin_amdgcn_s_setprio(1); _Pragma("unroll") for (int m = 0; m < 4; ++m) _Pragma("unroll") for (int n = 0; n < 2; ++n) _Pragma("unroll") for (int k = 0; k < 2; ++k) \
        acc[ai][bj][m][n] = __builtin_amdgcn_mfma_f32_16x16x32_bf16(Bt[n][k], At[m][k], acc[ai][bj][m][n], 0, 0, 0); __builtin_amdgcn_s_setprio(0); } while (0)
#define PG8_WAIT_V(n) asm volatile("s_waitcnt vmcnt(" #n ")" ::: "memory")
#define PG8_WAIT_L(n) asm volatile("s_waitcnt lgkmcnt(" #n ")" ::: "memory")
#define PG8_BAR __builtin_amdgcn_s_barrier()
#define PG8_SCHED __builtin_amdgcn_sched_barrier(0)
    Unit cur, nxt; int ui = 0;
    if (!S.next(0, cur)) return;
    f32x4 acc[2][2][4][2];
#pragma unroll
    for (int a = 0; a < 2; ++a)
#pragma unroll
        for (int b = 0; b < 2; ++b)
#pragma unroll
            for (int m = 0; m < 4; ++m)
#pragma unroll
                for (int n = 0; n < 2; ++n) acc[a][b][m][n] = (f32x4){0.f, 0.f, 0.f, 0.f};
    bf16x8 At[4][2], B0[2][2], B1[2][2];
    const char* cA = (const char*)g.A; const char* cB = (const char*)g.Bt + (size_t)cur.pn * tstepB;
    S.a_ready(cur);
    if constexpr (SP2) {
        PG8_STAGE(PG8_SB(0, 0), cB, voffB); PG8_STAGE(PG8_SB(0, 1), cB + hstepB, voffB); PG8_STAGE(PG8_SA(0, 0), cA, ca0); PG8_STAGE(PG8_SA(0, 1), cA, ca1);
        if (wr == 1) PG8_BAR;
        PG8_WAIT_V(2); PG8_BAR;
        PG8_STAGE(PG8_SB(1, 0), cB + kstep, voffB); PG8_STAGE(PG8_SA(1, 0), cA + kstep, ca0); PG8_STAGE(PG8_SB(1, 1), cB + hstepB + kstep, voffB);
        PG8_WAIT_V(6); PG8_BAR;
    } else {
        PG8_STAGE(PG8_SB(0, 0), cB, voffB); PG8_STAGE(PG8_SA(0, 0), cA, ca0); PG8_STAGE(PG8_SB(0, 1), cB + hstepB, voffB); PG8_STAGE(PG8_SA(0, 1), cA, ca1);
        if (wr == 1) PG8_BAR;
        PG8_WAIT_V(4); PG8_BAR;
        PG8_STAGE(PG8_SB(1, 0), cB + kstep, voffB); PG8_STAGE(PG8_SA(1, 0), cA + kstep, ca0); PG8_STAGE(PG8_SB(1, 1), cB + hstepB + kstep, voffB);
        PG8_WAIT_V(6); PG8_BAR;
    }
    for (;;) {
        const bool has_next = S.next(ui + 1, nxt);
        const char* nA = cA; const char* nB = has_next ? (const char*)g.Bt + (size_t)nxt.pn * tstepB : cB;
        for (int t = 0; t < nt; t += 2) {
            const bool last = (t == nt - 2);
            const unsigned o20[2] = {last ? na0[0] : ca0[0], last ? na0[1] : ca0[1]}, o21[2] = {last ? na1[0] : ca1[0], last ? na1[1] : ca1[1]};
            const char* a1 = cA + (size_t)(t + 1) * kstep;
            const char* a2 = last ? nA : cA + (size_t)(t + 2) * kstep; const char* b2 = last ? nB : cB + (size_t)(t + 2) * kstep;
            const char* a3 = a2 + kstep; const char* b3 = b2 + kstep;
            if (last && has_next) S.a_ready(nxt);
            if constexpr (SP2) {
            PG8_LDB(B0, 0, 0); PG8_LDB(B1, 0, 1); PG8_SCHED; PG8_LDA(At, 0, 0); PG8_STAGE(PG8_SA(1, 1), a1, ca1);
            PG8_WAIT_V(8); PG8_WAIT_L(0); PG8_BAR; PG8_MMA(0, 0, At, B0); PG8_MMA(0, 1, At, B1); PG8_BAR; PG8_SCHED;
            PG8_LDA(At, 0, 1); PG8_STAGE(PG8_SB(0, 0), b2, voffB); PG8_STAGE(PG8_SB(0, 1), b2 + hstepB, voffB); PG8_STAGE(PG8_SA(0, 0), a2, o20);
            PG8_WAIT_V(8); PG8_WAIT_L(0); PG8_BAR; PG8_MMA(1, 0, At, B0); PG8_MMA(1, 1, At, B1); PG8_BAR; PG8_SCHED;
            PG8_LDB(B0, 1, 0); PG8_LDB(B1, 1, 1); PG8_SCHED; PG8_LDA(At, 1, 0); PG8_STAGE(PG8_SA(0, 1), a2, o21);
            PG8_WAIT_V(8); PG8_WAIT_L(0); PG8_BAR; PG8_MMA(0, 0, At, B0); PG8_MMA(0, 1, At, B1); PG8_BAR; PG8_SCHED;
            PG8_LDA(At, 1, 1); PG8_STAGE(PG8_SB(1, 0), b3, voffB); PG8_STAGE(PG8_SB(1, 1), b3 + hstepB, voffB); PG8_STAGE(PG8_SA(1, 0), a3, o20);
            PG8_WAIT_V(8); PG8_WAIT_L(0); PG8_BAR; PG8_MMA(1, 0, At, B0); PG8_MMA(1, 1, At, B1); PG8_BAR; PG8_SCHED;
            } else {
            PG8_LDB(B0, 0, 0); PG8_SCHED; PG8_LDA(At, 0, 0); PG8_STAGE(PG8_SA(1, 1), a1, ca1);
            PG8_WAIT_L(8); PG8_BAR; PG8_WAIT_L(0); PG8_MMA(0, 0, At, B0); PG8_BAR; PG8_SCHED;
            PG8_LDB(B1, 0, 1); PG8_STAGE(PG8_SB(0, 0), b2, voffB);
            PG8_BAR; PG8_WAIT_L(0); PG8_MMA(0, 1, At, B1); PG8_BAR;
            PG8_LDA(At, 0, 1); PG8_STAGE(PG8_SA(0, 0), a2, o20);
            PG8_BAR; PG8_WAIT_L(0); PG8_MMA(1, 0, At, B0); PG8_BAR; PG8_SCHED;
            PG8_STAGE(PG8_SB(0, 1), b2 + hstepB, voffB);
            PG8_WAIT_V(6); PG8_BAR; PG8_MMA(1, 1, At, B1); PG8_BAR;
            PG8_LDB(B0, 1, 0); PG8_SCHED; PG8_LDA(At, 1, 0); PG8_STAGE(PG8_SA(0, 1), a2, o21);
            PG8_WAIT_L(8); PG8_BAR; PG8_WAIT_L(0); PG8_MMA(0, 0, At, B0); PG8_BAR; PG8_SCHED;
            PG8_LDB(B1, 1, 1); PG8_STAGE(PG8_SB(1, 0), b3, voffB);
            PG8_BAR; PG8_WAIT_L(0); PG8_MMA(0, 1, At, B1); PG8_BAR;
            PG8_LDA(At, 1, 1); PG8_STAGE(PG8_SA(1, 0), a3, o20);
            PG8_BAR; PG8_WAIT_L(0); PG8_MMA(1, 0, At, B0); PG8_BAR; PG8_SCHED;
            PG8_STAGE(PG8_SB(1, 1), b3 + hstepB, voffB);
            PG8_WAIT_V(6); PG8_BAR; PG8_MMA(1, 1, At, B1); PG8_BAR;
            }
        }
        if constexpr (ALIGN_EPI) { if (wr == 0) PG8_BAR; }
        if constexpr (!Epi::AFTER_DRAIN) { E(acc, cur, wr, wc, fr, fq); S.done(cur); }
        if (!has_next) break;
#pragma unroll
        for (int a = 0; a < 2; ++a)
#pragma unroll
            for (int b = 0; b < 2; ++b)
#pragma unroll
                for (int m = 0; m < 4; ++m)
#pragma unroll
                    for (int n = 0; n < 2; ++n) acc[a][b][m][n] = (f32x4){0.f, 0.f, 0.f, 0.f};
        cur = nxt; cA = nA; cB = nB; ++ui;
        ca0[0] = na0[0]; ca0[1] = na0[1]; ca1[0] = na1[0]; ca1[1] = na1[1];
        if constexpr (ALIGN_EPI) { if (wr == 1) PG8_BAR; }
    }
    PG8_WAIT_V(0);
    if constexpr (!ALIGN_EPI) { if (wr == 0) PG8_BAR; }
    PG8_BAR;
    if constexpr (Epi::AFTER_DRAIN) { E.fused(acc, cur, wr, wc, fr, fq, lds, wid, lane); S.done(cur); }
#undef PG8_SA
#undef PG8_SB
#undef PG8_STAGE
#undef PG8_LDA
#undef PG8_LDB
#undef PG8_MMA
#undef PG8_WAIT_V
#undef PG8_WAIT_L
#undef PG8_BAR
#undef PG8_SCHED
}
}
#define XB_TMO      128
#define XB_XCNT(j)  (256  + 64 * (j))
#define XB_XSUB(j)  (1280 + 64 * (j))
#define XB_XGEN(j)  (2304 + 64 * (j))
#define XB_TOP      3328
#define XB_TOPGEN   3392
#define XCD_BAR_WORDS 3456
#define XB_SPIN_CAP (1u << 18)

__device__ __forceinline__ unsigned xb_ld(unsigned* p)              { return __hip_atomic_load(p, __ATOMIC_RELAXED, __HIP_MEMORY_SCOPE_AGENT); }
__device__ __forceinline__ unsigned xb_add(unsigned* p, unsigned v) { return __hip_atomic_fetch_add(p, v, __ATOMIC_RELAXED, __HIP_MEMORY_SCOPE_AGENT); }
__device__ __forceinline__ unsigned xb_xcc_id() { return (unsigned)__builtin_amdgcn_s_getreg((3 << 11) | 20) & 0xFu; }
#define XB_SPIN(cond, bar) do { unsigned _sp = 0; while (cond) { __builtin_amdgcn_s_sleep(1); \
    if ((++_sp & 255u) == 0u) { if (xb_ld(&(bar)[XB_TMO])) break; if (_sp > XB_SPIN_CAP) { atomicAdd(&(bar)[XB_TMO], 1u); break; } } } } while (0)

struct XcdBarrier {
    unsigned* bar; unsigned x;
    volatile LAS unsigned* st;
};

__device__ __forceinline__ XcdBarrier xcd_barrier_post(unsigned* bar, volatile LAS unsigned* st) {
    XcdBarrier b; b.bar = bar; b.x = xb_xcc_id(); b.st = st;
    if (threadIdx.x == 0) (void)xb_add(&bar[XB_XCNT(b.x)], 1u);
    return b;
}
__device__ __forceinline__ void xcd_barrier_complete(unsigned* bar, unsigned x, unsigned& nloc, unsigned& nx) {
    const unsigned G = gridDim.x * gridDim.y * gridDim.z;
    unsigned sum, cnt, mine, sp = 0u;
    for (;;) {
        sum = 0u; cnt = 0u; mine = 0u;
#pragma unroll
        for (unsigned j = 0; j < 16; ++j) { const unsigned c = xb_ld(&bar[XB_XCNT(j)]); sum += c; cnt += (c > 0u) ? 1u : 0u; mine = (j == x) ? c : mine; }
        if (sum == G) break;
        __builtin_amdgcn_s_sleep(1);
        if ((++sp & 255u) == 0u) { if (xb_ld(&bar[XB_TMO])) break; if (sp > XB_SPIN_CAP) { atomicAdd(&bar[XB_TMO], 1u); break; } }
    }
    nloc = mine > 0u ? mine : 1u; nx = cnt > 0u ? cnt : 1u;
}

__device__ __forceinline__ void xcd_barrier(const XcdBarrier& b, const bool is_t0) {
    asm volatile("s_waitcnt vmcnt(0)" ::: "memory");
    __syncthreads();
    if (is_t0) {
        unsigned* bar = b.bar;
        __builtin_amdgcn_s_waitcnt(0);
        unsigned nloc = b.st[0], nx = b.st[1];
        if (nloc == 0u) { xcd_barrier_complete(bar, b.x, nloc, nx); b.st[0] = nloc; b.st[1] = nx; }
        const unsigned old = xb_add(&bar[XB_XSUB(b.x)], 1u);
        const unsigned gen = old / nloc;
        if (old + 1u == (gen + 1u) * nloc) {
            __builtin_amdgcn_fence(__ATOMIC_RELEASE, "agent");
            asm volatile("s_waitcnt vmcnt(0)" ::: "memory");
            const unsigned og = xb_add(&bar[XB_TOP], 1u);
            const unsigned tg = og / nx;
            if (og + 1u == (tg + 1u) * nx) xb_add(&bar[XB_TOPGEN], 1u);
            else XB_SPIN(xb_ld(&bar[XB_TOPGEN]) == tg, bar);
            __builtin_amdgcn_fence(__ATOMIC_ACQUIRE, "agent");
            xb_add(&bar[XB_XGEN(b.x)], 1u);
            asm volatile("s_waitcnt vmcnt(0)" ::: "memory");
        } else {
            XB_SPIN(xb_ld(&bar[XB_XGEN(b.x)]) == gen, bar);
            __builtin_amdgcn_fence(__ATOMIC_ACQUIRE, "agent");
            asm volatile("s_waitcnt vmcnt(0)" ::: "memory");
        }
    }
    __syncthreads();
}


namespace pg8 {
struct EpiZ {
    static constexpr bool PERM = true, AFTER_DRAIN = false;
    bf16_t* O; int ldc; float* fcbuf;
    __device__ __forceinline__ void operator()(const f32x4 (&acc)[2][2][4][2], const Unit& u, int wr, int wc, int fr, int fq) const {
        const int row0 = u.pm * BM + wr * 64 + fr, col0 = u.pn * BM + wc * 32 + 8 * fq;
        const bool fcl = (u.pn == 9) && (wc == 1) && (fq == 0);
#pragma unroll
        for (int ai = 0; ai < 2; ++ai)
#pragma unroll
            for (int m = 0; m < 4; ++m) {
                const int row = row0 + ai * HALF + m * 16;
                bf16_t* rowp = O + (size_t)row * ldc + col0;
#pragma unroll
                for (int bj = 0; bj < 2; ++bj) {
                    const f32x4 v0 = acc[ai][bj][m][0], v1 = acc[ai][bj][m][1];
                    u32x4 w; w.x = cvt_pk_bf16(v0[0], v0[1]); w.y = cvt_pk_bf16(v0[2], v0[3]); w.z = cvt_pk_bf16(v1[0], v1[1]); w.w = cvt_pk_bf16(v1[2], v1[3]);
                    *(u32x4*)(rowp + bj * HALF) = w;
                }
                if (fcl) *(f32x4*)(fcbuf + (size_t)row * 4) = acc[ai][0][m][0];
            }
    }
};
struct EpiRowScale {
    static constexpr bool PERM = true, AFTER_DRAIN = false;
    bf16_t* O; int ldc; const float* rs;
    __device__ __forceinline__ void operator()(const f32x4 (&acc)[2][2][4][2], const Unit& u, int wr, int wc, int fr, int fq) const {
        const int row0 = u.pm * BM + wr * 64 + fr, col0 = u.pn * BM + wc * 32 + 8 * fq;
#pragma unroll
        for (int ai = 0; ai < 2; ++ai)
#pragma unroll
            for (int m = 0; m < 4; ++m) {
                const int row = row0 + ai * HALF + m * 16;
                const float s = rs[row];
                bf16_t* rowp = O + (size_t)row * ldc + col0;
#pragma unroll
                for (int bj = 0; bj < 2; ++bj) {
                    const f32x4 v0 = acc[ai][bj][m][0] * s, v1 = acc[ai][bj][m][1] * s;
                    u32x4 w; w.x = cvt_pk_bf16(v0[0], v0[1]); w.y = cvt_pk_bf16(v0[2], v0[3]); w.z = cvt_pk_bf16(v1[0], v1[1]); w.w = cvt_pk_bf16(v1[2], v1[3]);
                    *(u32x4*)(rowp + bj * HALF) = w;
                }
            }
    }
};
struct EpiGU {
    static constexpr bool PERM = true, AFTER_DRAIN = false;
    bf16_t* O;
    __device__ __forceinline__ void operator()(const f32x4 (&acc)[2][2][4][2], const Unit& u, int wr, int wc, int fr, int fq) const {
        const int row0 = u.pm * BM + wr * 64 + fr, f0 = ((u.pn & 1) * BM + wc * 32 + 8 * fq) >> 1;
#pragma unroll
        for (int ai = 0; ai < 2; ++ai)
#pragma unroll
            for (int m = 0; m < 4; ++m) {
                bf16_t* rowp = O + (size_t)(row0 + ai * HALF + m * 16) * 256 + f0;
#pragma unroll
                for (int bj = 0; bj < 2; ++bj) {
                    const f32x4 v0 = acc[ai][bj][m][0], v1 = acc[ai][bj][m][1];
                    const float a0 = v0[0] * __builtin_amdgcn_rcpf(1.f + __expf(-v0[0])) * v0[1], a1 = v0[2] * __builtin_amdgcn_rcpf(1.f + __expf(-v0[2])) * v0[3];
                    const float a2 = v1[0] * __builtin_amdgcn_rcpf(1.f + __expf(-v1[0])) * v1[1], a3 = v1[2] * __builtin_amdgcn_rcpf(1.f + __expf(-v1[2])) * v1[3];
                    typedef unsigned u32x2 __attribute__((ext_vector_type(2)));
                    u32x2 w; w.x = cvt_pk_bf16(a0, a1); w.y = cvt_pk_bf16(a2, a3);
                    *(u32x2*)(rowp + bj * (HALF / 2)) = w;
                }
            }
    }
};
struct EpiPleGate {
    static constexpr bool PERM = true, AFTER_DRAIN = false;
    bf16_t* O; const bf16_t* PP;
    __device__ __forceinline__ void operator()(const f32x4 (&acc)[2][2][4][2], const Unit& u, int wr, int wc, int fr, int fq) const {
        const int row0 = u.pm * BM + wr * 64 + fr, col0 = u.pn * BM + wc * 32 + 8 * fq;
#pragma unroll
        for (int ai = 0; ai < 2; ++ai)
#pragma unroll
            for (int m = 0; m < 4; ++m) {
                const size_t off = (size_t)(row0 + ai * HALF + m * 16) * 1024 + col0;
#pragma unroll
                for (int bj = 0; bj < 2; ++bj) {
                    const f32x4 v0 = acc[ai][bj][m][0], v1 = acc[ai][bj][m][1];
                    const u32x4 pw = *(const u32x4*)(PP + off + bj * HALF);
                    float o[8];
                    o[0] = __uint_as_float(pw.x << 16) * __builtin_amdgcn_rcpf(1.f + __expf(-v0[0])); o[1] = __uint_as_float(pw.x & 0xffff0000u) * __builtin_amdgcn_rcpf(1.f + __expf(-v0[1]));
                    o[2] = __uint_as_float(pw.y << 16) * __builtin_amdgcn_rcpf(1.f + __expf(-v0[2])); o[3] = __uint_as_float(pw.y & 0xffff0000u) * __builtin_amdgcn_rcpf(1.f + __expf(-v0[3]));
                    o[4] = __uint_as_float(pw.z << 16) * __builtin_amdgcn_rcpf(1.f + __expf(-v1[0])); o[5] = __uint_as_float(pw.z & 0xffff0000u) * __builtin_amdgcn_rcpf(1.f + __expf(-v1[1]));
                    o[6] = __uint_as_float(pw.w << 16) * __builtin_amdgcn_rcpf(1.f + __expf(-v1[2])); o[7] = __uint_as_float(pw.w & 0xffff0000u) * __builtin_amdgcn_rcpf(1.f + __expf(-v1[3]));
                    u32x4 w; w.x = cvt_pk_bf16(o[0], o[1]); w.y = cvt_pk_bf16(o[2], o[3]); w.z = cvt_pk_bf16(o[4], o[5]); w.w = cvt_pk_bf16(o[6], o[7]);
                    *(u32x4*)(O + off + bj * HALF) = w;
                }
            }
    }
};
struct EpiDown {
    static constexpr bool PERM = true, AFTER_DRAIN = false;
    bf16_t* O;
    __device__ __forceinline__ void operator()(const f32x4 (&acc)[2][2][4][2], const Unit& u, int wr, int wc, int fr, int fq) const {
        const int row0 = u.pm * BM + wr * 64 + fr, col0 = (u.pn & 3) * BM + wc * 32 + 8 * fq;
#pragma unroll
        for (int ai = 0; ai < 2; ++ai)
#pragma unroll
            for (int m = 0; m < 4; ++m) {
                bf16_t* rowp = O + (size_t)(row0 + ai * HALF + m * 16) * 1024 + col0;
#pragma unroll
                for (int bj = 0; bj < 2; ++bj) {
                    const f32x4 v0 = acc[ai][bj][m][0], v1 = acc[ai][bj][m][1];
                    u32x4 w; w.x = cvt_pk_bf16(v0[0], v0[1]); w.y = cvt_pk_bf16(v0[2], v0[3]); w.z = cvt_pk_bf16(v1[0], v1[1]); w.w = cvt_pk_bf16(v1[2], v1[3]);
                    *(u32x4*)(rowp + bj * HALF) = w;
                }
            }
    }
};
constexpr int XPM = (int)((WS_HS16 - WS_A16) / (256 * 1024 * 2)), XPN = (int)((WS_WGU - WS_WPG) / (256 * 1024 * 2));
static_assert((WS_HS16 - WS_A16) % (256 * 1024 * 2) == 0 && (WS_WGU - WS_WPG) % (256 * 1024 * 2) == 0 && XPM >= 64 && (XPN & 1) == 0, "virtual unit offsets");
struct EpiX {
    static constexpr bool PERM = true, AFTER_DRAIN = false;
    EpiGU gu; EpiPleGate pg;
    __device__ __forceinline__ void operator()(const f32x4 (&acc)[2][2][4][2], const Unit& u, int wr, int wc, int fr, int fq) const {
        if (u.pm >= XPM) { const Unit v{u.pm - XPM, u.pn - XPN}; gu(acc, v, wr, wc, fr, fq); }
        else pg(acc, u, wr, wc, fr, fq);
    }
};
struct XSched {
    const int* tile_e; int nU1, G, vc;
    __device__ __forceinline__ bool next(int i, Unit& u) const {
        if (i >= 2) return false;
        const int g = vc + i * G;
        if (g < nU1) { const int t = g >> 1; u.pm = t + XPM; u.pn = __builtin_amdgcn_readfirstlane(tile_e[t]) * 2 + (g & 1) + XPN; return true; }
        const int k = g - nU1; if (k >= 256) return false;
        u.pm = k >> 2; u.pn = k & 3; return true;
    }
    __device__ __forceinline__ void a_ready(const Unit&) const {}
    __device__ __forceinline__ void done(const Unit&) const {}
};
struct TwoUnits {
    int pm0, pn0, pm1, pn1, n;
    __device__ __forceinline__ bool next(int i, Unit& u) const { if (i >= n) return false; u.pm = i ? pm1 : pm0; u.pn = i ? pn1 : pn0; return true; }
    __device__ __forceinline__ void a_ready(const Unit&) const {}
    __device__ __forceinline__ void done(const Unit&) const {}
};
struct OneUnit {
    int pm, pn;
    __device__ __forceinline__ bool next(int i, Unit& u) const { if (i) return false; u.pm = pm; u.pn = pn; return true; }
    __device__ __forceinline__ void a_ready(const Unit&) const {}
    __device__ __forceinline__ void done(const Unit&) const {}
};
struct GroupSched {
    const int* tile_e; int T, NJ, G, vc;
    __device__ __forceinline__ bool next(int i, Unit& u) const {
        const long L = (long)i * G + vc; if (L >= (long)T * NJ) return false;
        const int t = (int)(L / NJ), j = (int)(L % NJ);
        u.pm = t; u.pn = __builtin_amdgcn_readfirstlane(tile_e[t]) * NJ + j; return true;
    }
    __device__ __forceinline__ void a_ready(const Unit&) const {}
    __device__ __forceinline__ void done(const Unit&) const {}
};
}

template <class Map>
__device__ __forceinline__ void transpose_rows(const Map mp, const float* ks, int nrows_out, int K, bf16* WT, LAS float* scr, int gw, int NGW, int lane) {
    const int nblk = nrows_out / 32, nitems = (K / 64) * nblk;
    const int f = lane & 7, kr = lane >> 3;
    for (int it = gw; it < nitems; it += NGW) {
        const int kb = it / nblk, nb = it % nblk, k0 = 64 * kb, n0 = 32 * nb;
        const float* src; long pitch; float sc; int nl0, nls;
        mp.get4(n0, f, src, pitch, sc, nl0, nls);
        f32x4_t vals[8];
#pragma unroll
        for (int i = 0; i < 8; ++i) vals[i] = src ? *(const f32x4_t*)(src + (size_t)(k0 + kr + 8 * i) * pitch) : (f32x4_t){0.f, 0.f, 0.f, 0.f};
#pragma unroll
        for (int i = 0; i < 8; ++i) {
            const int kk = kr + 8 * i;
            float m = sc; if (ks) m *= ks[k0 + kk];
            scr[kk * 33 + nl0] = vals[i].x * m; scr[kk * 33 + nl0 + nls] = vals[i].y * m; scr[kk * 33 + nl0 + 2 * nls] = vals[i].z * m; scr[kk * 33 + nl0 + 3 * nls] = vals[i].w * m;
        }
        asm volatile("s_waitcnt lgkmcnt(0)" ::: "memory");
        const int c = lane & 7;
#pragma unroll
        for (int j = 0; j < 4; ++j) {
            const int n = (lane >> 3) + 8 * j; const LAS float* s = scr + (8 * c) * 33 + n;
            v4u o; o.x = pk2(s[0 * 33], s[1 * 33]); o.y = pk2(s[2 * 33], s[3 * 33]); o.z = pk2(s[4 * 33], s[5 * 33]); o.w = pk2(s[6 * 33], s[7 * 33]);
            *(v4u*)(WT + (size_t)(n0 + n) * K + k0 + 8 * c) = o;
        }
        asm volatile("s_waitcnt lgkmcnt(0)" ::: "memory");
    }
}
constexpr float LOG2E_W = 1.4426950408889634f;
struct MapIn {
    const float* w;
    __device__ __forceinline__ void get(int n, const float*& src, long& pitch, float& sc) const {
        int c;
        if (n < 1152) c = n;
        else if (n < Z_CKV) c = OFF_QC + (n - Z_QC);
        else if (n < Z_CQ) c = OFF_CKV + (n - Z_CKV);
        else if (n < Z_KR) c = OFF_CQ + (n - Z_CQ);
        else if (n < Z_FC) c = OFF_KR + (n - Z_KR);
        else if (n < Z_FC + 4) c = OFF_FC + (n - Z_FC);
        else c = -1;
        src = c >= 0 ? w + c : nullptr; pitch = D_IN;
        sc = n < Z_KA ? 0.17677669529663687f * LOG2E_W : ((n >= Z_QC && n < Z_KC) ? 0.125f * LOG2E_W : 1.f);
    }
    __device__ __forceinline__ void get4(int n0, int f, const float*& src, long& pitch, float& sc, int& nl0, int& nls) const { get(n0 + 4 * f, src, pitch, sc); nl0 = 4 * f; nls = 1; }
};
struct MapPlain {
    const float* w; int N, nvalid; float scale;
    __device__ __forceinline__ void get(int n, const float*& src, long& pitch, float& sc) const { src = n < nvalid ? w + n : nullptr; pitch = N; sc = scale; }
    __device__ __forceinline__ void get4(int n0, int f, const float*& src, long& pitch, float& sc, int& nl0, int& nls) const { get(n0 + 4 * f, src, pitch, sc); nl0 = 4 * f; nls = 1; }
};

struct MapGU {
    const float* wg; const float* wu;
    __device__ __forceinline__ void get(int n, const float*& src, long& pitch, float& sc) const {
        const int e = n >> 9, r = n & 511, f = r >> 1;
        const long dlt = (r & 1) ? (long)(wu - wg) : 0l;
        src = wg + dlt + (size_t)e * 1024 * 256 + f; pitch = 256; sc = 1.f;
    }
    __device__ __forceinline__ void get4(int n0, int f, const float*& src, long& pitch, float& sc, int& nl0, int& nls) const {
        const int e = n0 >> 9, f0 = (n0 & 511) >> 1;
        const long dlt = (f >> 2) ? (long)(wu - wg) : 0l;
        src = wg + dlt + (size_t)e * 1024 * 256 + f0 + 4 * (f & 3); pitch = 256; sc = 1.f; nl0 = 8 * (f & 3) + (f >> 2); nls = 2;
    }
};
struct MapD {
    const float* wd;
    __device__ __forceinline__ void get(int n, const float*& src, long& pitch, float& sc) const {
        const int e = n >> 10, c = n & 1023;
        src = wd + (size_t)e * 256 * 1024 + c; pitch = 1024; sc = 1.f;
    }
    __device__ __forceinline__ void get4(int n0, int f, const float*& src, long& pitch, float& sc, int& nl0, int& nls) const { get(n0 + 4 * f, src, pitch, sc); nl0 = 4 * f; nls = 1; }
};

struct AttnP {
    const bf16* z16; const bf16* qb16; const bf16* kvb16; const bf16* krr16; const float* cum; const float* cosT; const float* sinT;
    const int* pos; bf16* mixed16; const float* lq1; const float* lk1; const float* lq2; const float* lk2; const float* gdiff; int layer; unsigned* prof; const int* tpmax; float lam, lam_init;
};
typedef short bf16x8_t __attribute__((ext_vector_type(8)));
typedef float f32x16_t __attribute__((ext_vector_type(16)));
typedef short s16x4_t __attribute__((ext_vector_type(4)));
typedef float f32x2_t __attribute__((ext_vector_type(2)));
typedef __bf16 bf16x2_t __attribute__((ext_vector_type(2)));
__device__ __forceinline__ unsigned cvtpk(float lo, float hi) { f32x2_t v = {lo, hi}; bf16x2_t b = __builtin_convertvector(v, bf16x2_t); return __builtin_bit_cast(unsigned, b); }
__device__ __forceinline__ int crow(int r, int hi) { return (r & 3) + 8 * (r >> 2) + 4 * hi; }
__device__ __forceinline__ s16x4_t vtr(const LAS unsigned char* p) { typedef short v4i16_t __attribute__((ext_vector_type(4))); return __builtin_bit_cast(s16x4_t, __builtin_amdgcn_ds_read_tr16_b64_v4i16((LAS v4i16_t*)p)); }
constexpr float LOG2E = 1.4426950408889634f;

__device__ __forceinline__ float xhalf_max(float m) { auto rr = __builtin_amdgcn_permlane32_swap(__float_as_uint(m), __float_as_uint(m), false, false); return __builtin_fmaxf(__uint_as_float(rr[0]), __uint_as_float(rr[1])); }
__device__ __forceinline__ float xhalf_sum(float m) { auto rr = __builtin_amdgcn_permlane32_swap(__float_as_uint(m), __float_as_uint(m), false, false); return __uint_as_float(rr[0]) + __uint_as_float(rr[1]); }
__device__ __forceinline__ float max3f(float a, float b, float c) { return __builtin_fmaxf(__builtin_fmaxf(a, b), c); }
__device__ __forceinline__ void glds16(const void* gsrc, unsigned lds_dst) { unsigned keep;
    asm volatile("s_mov_b32 %0, m0\n\ts_mov_b32 m0, %2\n\ts_nop 0\n\tglobal_load_lds_dwordx4 %1, off\n\ts_mov_b32 m0, %0" : "=&s"(keep) : "v"(gsrc), "s"(lds_dst) : "memory"); }
__device__ __forceinline__ void glds4(const void* gsrc, unsigned lds_dst) { unsigned keep;
    asm volatile("s_mov_b32 %0, m0\n\ts_mov_b32 m0, %2\n\ts_nop 0\n\tglobal_load_lds_dword %1, off\n\ts_mov_b32 m0, %0" : "=&s"(keep) : "v"(gsrc), "s"(lds_dst) : "memory"); }
template <int MODE> __device__ __forceinline__ void attn_unit(const AttnP& p, int b, int h, int qblk, LAS unsigned char* lds, const int tid_in) {
    int tid = tid_in * 64 + lane_id_now(); asm volatile("" : "+v"(tid));
#ifdef PROF_SEL
    const unsigned long long pu0 = __builtin_amdgcn_s_memrealtime(); unsigned long long pt0 = 0, pl0 = 0, pacc_c = 0, pacc_b = 0;
#define PROF_T(acc) do { const unsigned long long t_ = __builtin_amdgcn_s_memrealtime(); acc += t_ - pt0; pt0 = t_; } while (0)
#else
#define PROF_T(acc) do {} while (0)
#endif
    constexpr int NF = MODE == 0 ? 2 : (MODE == 1 ? 6 : 4);
    constexpr int NC = MODE == 1 ? 12 : 8;
    constexpr int NCX = MODE == 1 ? 0 : 2;
    constexpr int KB = (NC + NCX) * 1024, KBUF = KB + 512;
    constexpr int VOFF = 3 * KBUF;
    const int lane = tid & 63, w = __builtin_amdgcn_readfirstlane(tid >> 6), r32 = lane & 31, hi = lane >> 5;
    const int map = MODE == 0 ? (w >> 2) : 0, qg = MODE == 0 ? (w & 3) : w;
    const int c = MODE == 0 ? qblk * 2 + (qg >> 1) : qblk * 4 + (qg >> 1);
    const int ntiles = MODE == 0 ? qblk * 2 + 2 : qblk * 4 + 4;
    const long tok0 = (long)b * SEQ;
    const int q0u = MODE == 0 ? qblk * 128 : qblk * 256;
    const long qrow = tok0 + q0u + qg * 32 + r32;
    float slope2 = 0.f, sq = 0.f, refv = 0.f; int qpmin = 0;
    const bf16* k1src = MODE == 0 ? p.z16 + (tok0 + lane) * ZP + Z_KA + h * 64 + w * 8 : (MODE == 2 ? p.z16 + (tok0 + lane) * ZP + Z_KC + h * 64 + w * 8 : p.kvb16 + (tok0 + lane) * NKVB + h * 128 + w * 8);
    const bf16* k2src = p.krr16 + (tok0 + lane) * 32 + (w & 3) * 8;
    const bf16* vsrc = (MODE == 0 ? p.z16 + Z_VA + h * 64 : (MODE == 1 ? p.kvb16 + h * 128 + 64 : p.z16 + Z_VC + h * 64)) + (tok0 + (w & 3) * 16 + (lane >> 2)) * (MODE == 1 ? NKVB : ZP) + ((w >> 2) * 4 + (lane & 3)) * 8;
    const void* bsrc = MODE == 0 ? (const void*)(p.pos + tok0 + lane) : (const void*)(p.cum + (tok0 + lane) * 4 + h);
    const unsigned lbase = (unsigned)(size_t)lds;
    const int tpv = MODE == 0 ? p.tpmax[b * 32 + (lane & 31)] : 0;
    constexpr int DPT = 3;
    auto issue = [&](int kt_) {
        const int kt = kt_ < ntiles ? kt_ : ntiles - 1; const int slot = kt_ % 3;
        const unsigned ks = __builtin_amdgcn_readfirstlane(lbase + slot * KBUF), vs = __builtin_amdgcn_readfirstlane(lbase + VOFF + slot * 8192 + w * 1024);
        glds16(k1src + (long)kt * 64 * (MODE == 1 ? NKVB : ZP), ks + w * 1024);
        if (MODE == 1) glds16(k2src + (long)kt * 64 * 32, ks + (8 + (w & 3)) * 1024);
        glds16(vsrc + (long)kt * 64 * (MODE == 1 ? NKVB : ZP), vs);
        if (MODE == 0) glds4((const char*)bsrc + (long)kt * 64 * 4, ks + KB + 256);
        if (MODE == 2) glds4((const char*)bsrc + (long)kt * 64 * 16, ks + KB + 256);
    };
    auto convert_bias = [&](int kt_) {
        if (MODE != 1 && tid < 64) {
            LAS unsigned char* sp = lds + (kt_ % 3) * KBUF;
            const unsigned raw = *(LAS unsigned*)(sp + KB + 256 + tid * 4);
            const float bv = MODE == 0 ? slope2 * ((float)(int)raw - refv) : (refv - __uint_as_float(raw)) * LOG2E;
            *(LAS float*)(sp + KB + tid * 4) = bv;
            const unsigned e0 = f2bf(bv); const float r1 = bv - __uint_as_float(e0 << 16);
            const unsigned e1 = f2bf(r1); const float r2 = r1 - __uint_as_float(e1 << 16);
            const unsigned e2 = f2bf(r2);
            v4u ex; ex.x = e0 | (e1 << 16); ex.y = e2; ex.z = 0u; ex.w = 0u;
            *(LAS v4u*)(sp + NC * 1024 + tid * 16) = ex;
        }
    };
    issue(0); issue(1);
    bf16x8_t qf[NF];
    {
        const bf16* qsrc = MODE == 0 ? p.z16 + qrow * ZP + Z_QA + h * 64 + map * 32 : (MODE == 1 ? p.qb16 + qrow * NQBP + h * 96 : p.z16 + qrow * ZP + Z_QC + h * 64);
#pragma unroll
        for (int i = 0; i < NF; ++i) qf[i] = *(const bf16x8_t*)(qsrc + i * 16 + hi * 8);
    }
    if (MODE == 1) {
        const float4 c0 = *(const float4*)(p.cosT + qrow * 16 + hi * 8), c1 = *(const float4*)(p.cosT + qrow * 16 + hi * 8 + 4);
        const float4 s0 = *(const float4*)(p.sinT + qrow * 16 + hi * 8), s1 = *(const float4*)(p.sinT + qrow * 16 + hi * 8 + 4);
        const float cs[8] = {c0.x, c0.y, c0.z, c0.w, c1.x, c1.y, c1.z, c1.w}, sn[8] = {s0.x, s0.y, s0.z, s0.w, s1.x, s1.y, s1.z, s1.w};
        float n1[8], n2[8];
#pragma unroll
        for (int j = 0; j < 8; ++j) {
            const float x1 = __uint_as_float((unsigned)(unsigned short)qf[NF - 2][j] << 16), x2 = __uint_as_float((unsigned)(unsigned short)qf[NF - 1][j] << 16);
            n1[j] = x1 * cs[j] - x2 * sn[j]; n2[j] = x2 * cs[j] + x1 * sn[j];
        }
        v4u a, bb;
        a.x = cvtpk(n1[0], n1[1]); a.y = cvtpk(n1[2], n1[3]); a.z = cvtpk(n1[4], n1[5]); a.w = cvtpk(n1[6], n1[7]);
        bb.x = cvtpk(n2[0], n2[1]); bb.y = cvtpk(n2[2], n2[3]); bb.z = cvtpk(n2[4], n2[5]); bb.w = cvtpk(n2[6], n2[7]);
        qf[NF - 2] = __builtin_bit_cast(bf16x8_t, a); qf[NF - 1] = __builtin_bit_cast(bf16x8_t, bb);
    }
    if (MODE == 0) {
        slope2 = exp2f(-8.0f * (float)(h + 1) / 6.0f) * LOG2E;
        const int pref = p.pos[tok0 + q0u]; refv = (float)pref;
        const int pq = p.pos[qrow]; sq = slope2 * (float)(pq - pref);
        int mn = pq;
#pragma unroll
        for (int o_ = 1; o_ < 64; o_ <<= 1) mn = min(mn, __builtin_amdgcn_ds_bpermute((lane ^ o_) << 2, mn));
        qpmin = __builtin_amdgcn_readfirstlane(mn);
    }
    if (MODE == 2) refv = p.cum[(tok0 + q0u) * 4 + h];
    f32x16_t o[2], negm;
    float mref = 0.f, lsum = 0.f; bool first = true;
#pragma unroll
    for (int r = 0; r < 16; ++r) { o[0][r] = 0.f; o[1][r] = 0.f; negm[r] = 0.f; }
    bf16x8_t qext;
    { v4u q1; q1.x = hi == 0 ? 0x3f803f80u : 0u; q1.y = hi == 0 ? 0x00003f80u : 0u; q1.z = 0u; q1.w = 0u; qext = __builtin_bit_cast(bf16x8_t, q1); }
    LAS unsigned char* const kfp = lds + (map * NF * 2 + hi) * 1024 + r32 * 16;
    LAS unsigned char* const kxp = lds + (NC + hi) * 1024 + r32 * 16;
    LAS unsigned char* const bfp = lds + KB + 16 * hi;
    LAS unsigned char* const vfp = lds + VOFF + (4 * hi + ((lane & 15) >> 2)) * 64 + ((lane >> 4) & 1) * 32 + (lane & 3) * 8;
    auto compute_s = [&](const int kt, const int par, f32x16_t& p0, f32x16_t& p1) {
        constexpr int KG = NF;
        bf16x8_t kf0[KG], kf1[KG], kx0, kx1;
#pragma unroll
        for (int d0 = 0; d0 < KG; ++d0) { kf0[d0] = *(const LAS bf16x8_t*)(kfp + par * KBUF + d0 * 2048); kf1[d0] = *(const LAS bf16x8_t*)(kfp + par * KBUF + d0 * 2048 + 512); }
        if (MODE != 1) { kx0 = *(const LAS bf16x8_t*)(kxp + par * KBUF); kx1 = *(const LAS bf16x8_t*)(kxp + par * KBUF + 512); }
        __builtin_amdgcn_sched_barrier(0);
        if (MODE != 1) {
            p0 = __builtin_amdgcn_mfma_f32_32x32x16_bf16(kx0, qext, negm, 0, 0, 0);
            p1 = __builtin_amdgcn_mfma_f32_32x32x16_bf16(kx1, qext, negm, 0, 0, 0);
        }
#pragma unroll
        for (int d0 = 0; d0 < KG; ++d0) {
            p0 = __builtin_amdgcn_mfma_f32_32x32x16_bf16(kf0[d0], qf[d0], (MODE == 1 && d0 == 0) ? negm : p0, 0, 0, 0);
            p1 = __builtin_amdgcn_mfma_f32_32x32x16_bf16(kf1[d0], qf[d0], (MODE == 1 && d0 == 0) ? negm : p1, 0, 0, 0);
        }
        if (NF > KG) {
#pragma unroll
            for (int d0 = KG; d0 < NF; ++d0) { kf0[d0 - KG] = *(const LAS bf16x8_t*)(kfp + par * KBUF + d0 * 2048); kf1[d0 - KG] = *(const LAS bf16x8_t*)(kfp + par * KBUF + d0 * 2048 + 512); }
#pragma unroll
            for (int d0 = KG; d0 < NF; ++d0) {
                p0 = __builtin_amdgcn_mfma_f32_32x32x16_bf16(kf0[d0 - KG], qf[d0], p0, 0, 0, 0);
                p1 = __builtin_amdgcn_mfma_f32_32x32x16_bf16(kf1[d0 - KG], qf[d0], p1, 0, 0, 0);
            }
        }
        if (MODE == 0) {
            if (kt == c || __builtin_amdgcn_readlane(tpv, kt) > qpmin) {
#pragma unroll
                for (int g = 0; g < 4; ++g) {
                    const f32x4_t b0 = *(const LAS f32x4_t*)(bfp + par * KBUF + 32 * g), b1 = *(const LAS f32x4_t*)(bfp + par * KBUF + 128 + 32 * g);
                    p0[4 * g] += 2.f * fminf(sq - b0.x, 0.f); p0[4 * g + 1] += 2.f * fminf(sq - b0.y, 0.f); p0[4 * g + 2] += 2.f * fminf(sq - b0.z, 0.f); p0[4 * g + 3] += 2.f * fminf(sq - b0.w, 0.f);
                    p1[4 * g] += 2.f * fminf(sq - b1.x, 0.f); p1[4 * g + 1] += 2.f * fminf(sq - b1.y, 0.f); p1[4 * g + 2] += 2.f * fminf(sq - b1.z, 0.f); p1[4 * g + 3] += 2.f * fminf(sq - b1.w, 0.f);
                }
            }
        }
        if (MODE == 2) {
            if (kt == c) {
                const int qi = (qg & 1) * 32 + r32;
#pragma unroll
                for (int r = 0; r < 16; ++r) { const int kv = crow(r, hi); if (kv > qi) p0[r] = -INFINITY; if (kv + 32 > qi) p1[r] = -INFINITY; }
            }
        }
    };
    auto softmax_pv = [&](const int par, f32x16_t& p0, f32x16_t& p1) {
        constexpr int VE = MODE == 1 ? 4 : 8;
        s16x4_t vlo[8], vhi[8];
#pragma unroll
        for (int i = 0; i < VE; ++i) { vlo[i] = vtr(vfp + par * 8192 + (i & 1) * 4096 + (i >> 1) * 1024); vhi[i] = vtr(vfp + par * 8192 + (i & 1) * 4096 + (i >> 1) * 1024 + 512); }
        __builtin_amdgcn_sched_barrier(0);
        float tm0 = max3f(p0[0], p0[1], p0[2]), tm1 = max3f(p1[0], p1[1], p1[2]);
#pragma unroll
        for (int r = 3; r < 15; r += 2) { tm0 = max3f(tm0, p0[r], p0[r + 1]); tm1 = max3f(tm1, p1[r], p1[r + 1]); }
        float tmax = max3f(tm0, tm1, p0[15]); tmax = __builtin_fmaxf(tmax, p1[15]);
        tmax = xhalf_max(tmax);
        if (first || __any(tmax > 8.0f)) {
            const float dl = first ? tmax : __builtin_fmaxf(tmax, 0.f);
            mref += dl;
            const float f = first ? 1.f : __builtin_amdgcn_exp2f(-dl);
            lsum *= f;
#pragma unroll
            for (int r = 0; r < 16; ++r) { o[0][r] *= f; o[1][r] *= f; p0[r] -= dl; p1[r] -= dl; negm[r] = -mref; }
            first = false;
        }
        float ls0 = 0.f, ls1 = 0.f;
#pragma unroll
        for (int r = 0; r < 16; ++r) { p0[r] = __builtin_amdgcn_exp2f(p0[r]); p1[r] = __builtin_amdgcn_exp2f(p1[r]); ls0 += p0[r]; ls1 += p1[r]; }
        lsum += ls0 + ls1;
        bf16x8_t pa[4];
#pragma unroll
        for (int ks = 0; ks < 4; ++ks) {
            v4u wv;
            if (ks < 2) { wv.x = cvtpk(p0[8 * ks + 0], p0[8 * ks + 1]); wv.y = cvtpk(p0[8 * ks + 2], p0[8 * ks + 3]); wv.z = cvtpk(p0[8 * ks + 4], p0[8 * ks + 5]); wv.w = cvtpk(p0[8 * ks + 6], p0[8 * ks + 7]); }
            else { wv.x = cvtpk(p1[8 * (ks - 2) + 0], p1[8 * (ks - 2) + 1]); wv.y = cvtpk(p1[8 * (ks - 2) + 2], p1[8 * (ks - 2) + 3]); wv.z = cvtpk(p1[8 * (ks - 2) + 4], p1[8 * (ks - 2) + 5]); wv.w = cvtpk(p1[8 * (ks - 2) + 6], p1[8 * (ks - 2) + 7]); }
            pa[ks] = __builtin_bit_cast(bf16x8_t, wv);
        }
#pragma unroll
        for (int i = VE; i < 8; ++i) { vlo[i] = vtr(vfp + par * 8192 + (i & 1) * 4096 + (i >> 1) * 1024); vhi[i] = vtr(vfp + par * 8192 + (i & 1) * 4096 + (i >> 1) * 1024 + 512); }
#pragma unroll
        for (int ks = 0; ks < 4; ++ks)
#pragma unroll
            for (int blk = 0; blk < 2; ++blk) {
                const s16x4_t lo = vlo[ks * 2 + blk], hi4 = vhi[ks * 2 + blk];
                const bf16x8_t vf = {lo[0], lo[1], lo[2], lo[3], hi4[0], hi4[1], hi4[2], hi4[3]};
                o[blk] = __builtin_amdgcn_mfma_f32_32x32x16_bf16(vf, pa[ks], o[blk], 0, 0, 0);
            }
    };
    if (MODE != 1 && tid < 192) *(LAS v4u*)(lds + (tid >> 6) * KBUF + (NC + 1) * 1024 + (tid & 63) * 16) = (v4u){0u, 0u, 0u, 0u};
    f32x16_t pA0, pA1;
    { int tpu = tpv; asm volatile("" : "+v"(tpu)); }
    asm volatile("s_waitcnt vmcnt(0)" ::: "memory");
    convert_bias(0); convert_bias(1);
    asm volatile("s_waitcnt lgkmcnt(0)\n\ts_barrier" ::: "memory");
#ifdef PROF_SEL
    pl0 = __builtin_amdgcn_s_memrealtime();
#endif
#pragma unroll 1
    for (int kt = 0; kt < ntiles; ++kt) {
#ifdef PROF_SEL
        pt0 = __builtin_amdgcn_s_memrealtime();
#endif
        issue(kt + 2);
        if (kt <= c) { const int slot = kt % 3; compute_s(kt, slot, pA0, pA1); softmax_pv(slot, pA0, pA1); }
        asm volatile("s_waitcnt vmcnt(3)" ::: "memory");
        convert_bias(kt + 1);
        PROF_T(pacc_c);
        asm volatile("s_waitcnt lgkmcnt(0)\n\ts_barrier" ::: "memory");
        PROF_T(pacc_b);
    }
    asm volatile("s_waitcnt vmcnt(0)\n\ts_barrier" ::: "memory");
#ifdef PROF_SEL
    const unsigned long long pl1 = __builtin_amdgcn_s_memrealtime();
#endif
    const float inv = 1.f / xhalf_sum(lsum);
    int tid2 = tid_in * 64 + lane_id_now(); asm volatile("" : "+v"(tid2));
    const int lane2 = tid2 & 63, hi2 = lane2 >> 5, qg2 = MODE == 0 ? ((tid2 >> 6) & 3) : (tid2 >> 6);
    const long qrow2 = tok0 + q0u + qg2 * 32 + (lane2 & 31);
    bf16* op = p.mixed16 + qrow2 * D_MODEL + (MODE == 0 ? 0 : (MODE == 1 ? 384 : 768)) + h * 64;
    if (MODE == 0) {
        LAS float* xb = (LAS float*)lds + qg2 * 2048 + lane2;
        if (map == 1) {
#pragma unroll
            for (int blk = 0; blk < 2; ++blk)
#pragma unroll
                for (int r = 0; r < 16; ++r) xb[(blk * 16 + r) * 64] = o[blk][r] * inv;
        }
        __syncthreads();
        if (map == 0) {
            const float lam_init = p.lam_init, lam = p.lam;
            float ss = 0.f;
#pragma unroll
            for (int blk = 0; blk < 2; ++blk)
#pragma unroll
                for (int r = 0; r < 16; ++r) { const float v = o[blk][r] * inv - lam * xb[(blk * 16 + r) * 64]; o[blk][r] = v; ss = fmaf(v, v, ss); }
            ss = xhalf_sum(ss);
            const float rr = rsqrtf(ss * (1.f / 64.f) + RMS_EPS) * (1.f - lam_init);
#pragma unroll
            for (int blk = 0; blk < 2; ++blk)
#pragma unroll
                for (int g = 0; g < 4; ++g) {
                    const int d = 32 * blk + 8 * g + 4 * hi2;
                    const float4 gv = *(const float4*)(p.gdiff + d);
                    v2u wv; wv.x = cvtpk(o[blk][4 * g] * rr * gv.x, o[blk][4 * g + 1] * rr * gv.y); wv.y = cvtpk(o[blk][4 * g + 2] * rr * gv.z, o[blk][4 * g + 3] * rr * gv.w);
                    *(v2u*)(op + d) = wv;
                }
        }
        __syncthreads();
    } else {
#pragma unroll
        for (int blk = 0; blk < 2; ++blk)
#pragma unroll
            for (int g = 0; g < 4; ++g) {
                const int d = 32 * blk + 8 * g + 4 * hi2;
                v2u wv; wv.x = cvtpk(o[blk][4 * g] * inv, o[blk][4 * g + 1] * inv); wv.y = cvtpk(o[blk][4 * g + 2] * inv, o[blk][4 * g + 3] * inv);
                *(v2u*)(op + d) = wv;
            }
    }
#ifdef PROF_SEL
    if (p.layer == 0 && blockIdx.x == 7 && w == PROF_WAVE && lane == 0) {
        unsigned* pw = p.prof; const unsigned long long pu1 = __builtin_amdgcn_s_memrealtime();
        atomicAdd(pw + 0, (unsigned)(pu1 - pu0)); atomicAdd(pw + 1, (unsigned)(pl1 - pl0)); atomicAdd(pw + 2, (unsigned)pacc_c); atomicAdd(pw + 3, (unsigned)pacc_b);
        atomicAdd(pw + 4, (unsigned)ntiles * 100u); atomicAdd(pw + 5, 10000u); atomicAdd(pw + 6, (unsigned)(c + 1) * 100u);
    }
#endif
}

typedef const __attribute__((address_space(4))) char* kargp_t;
__device__ __forceinline__ kargp_t karg_base() { kargp_t p = (kargp_t)__builtin_amdgcn_kernarg_segment_ptr(); asm volatile("" : "+s"(p)); return p; }
#define KARG(i) (*(const void* const __attribute__((address_space(4)))*)(kp + 8 * (i)))
#define KOUT (*(float* const __attribute__((address_space(4)))*)(kp + 224))
#define KWS (*(unsigned char* const __attribute__((address_space(4)))*)(kp + 232))
__device__ __forceinline__ void convert_layer_weights(const Args& a, int l, unsigned char* ws, LAS float* scr, int gw, int NGW, int lane) {
    const kargp_t kp = karg_base();
    const float* w_in = (const float*)KARG(3) + (size_t)l * D_MODEL * D_IN;
    const float* w_uq = (const float*)KARG(4) + (size_t)l * 256 * NQB;
    const float* w_ukv = (const float*)KARG(5) + (size_t)l * 128 * NKVB;
    const float* g_cq = (const float*)KARG(6) + l * 256;
    const float* g_ckv = (const float*)KARG(7) + l * 128;
    const float* w_out = (const float*)KARG(14) + (size_t)l * 1024 * 1024;
    transpose_rows(MapIn{w_in}, nullptr, ZP, 1024, (bf16*)(ws + WS_WIN), scr, gw, NGW, lane);
    transpose_rows(MapPlain{w_uq, NQB, NQB, 0.10206207261596575f * LOG2E_W}, g_cq, NQBP, 256, (bf16*)(ws + WS_WUQ), scr, gw, NGW, lane);
    transpose_rows(MapPlain{w_ukv, NKVB, NKVB, 1.f}, g_ckv, NKVB, 128, (bf16*)(ws + WS_WUKV), scr, gw, NGW, lane);
    transpose_rows(MapPlain{w_out, 1024, 1024, 1.f}, nullptr, 1024, 1024, (bf16*)(ws + WS_WOUT), scr, gw, NGW, lane);
    transpose_rows(MapPlain{(const float*)KARG(24) + (size_t)l * 1024 * 1024, 1024, 1024, 1.f}, nullptr, 1024, 1024, (bf16*)(ws + WS_WPG), scr, gw, NGW, lane);
    transpose_rows(MapPlain{(const float*)KARG(25) + (size_t)l * 256 * 1024, 1024, 1024, 1.f}, nullptr, 1024, 256, (bf16*)(ws + WS_WPP), scr, gw, NGW, lane);
    transpose_rows(MapGU{(const float*)KARG(21) + (size_t)l * 32 * 1024 * 256, (const float*)KARG(22) + (size_t)l * 32 * 1024 * 256}, nullptr, 32 * 512, 1024, (bf16*)(ws + WS_WGU), scr, gw, NGW, lane);
    transpose_rows(MapD{(const float*)KARG(23) + (size_t)l * 32 * 256 * 1024}, nullptr, 32 * 1024, 256, (bf16*)(ws + WS_WD), scr, gw, NGW, lane);
}

__device__ __forceinline__ void expert_prefix(const unsigned* cnt, LAS int* xs, int tid) {
    if (tid < 64) {
        const int pc = tid < 32 ? (((int)cnt[tid * 64] + 255) & ~255) : 0;
        int inc = pc;
#pragma unroll
        for (int o = 1; o < 32; o <<= 1) { const int n = __shfl_up(inc, o); if ((tid & 63) >= o) inc += n; }
        if (tid < 32) xs[tid] = inc - pc;
        if (tid == 31) xs[32] = inc;
    }
}
constexpr int LDS_MISC = 147456;
constexpr int PH_PER_LAYER = 9, NPH = 1 + DEPTH * PH_PER_LAYER;
template <int PH, bool DUMMY = false> __device__ __forceinline__ void run_phase(const Args& a, unsigned char* lds_raw, const int wave_s) {
    float* sm = (float*)lds_raw;
    const kargp_t kp = karg_base();
    const int G = gridDim.x, NGW = G * 8, NGT = G * NTHREADS;
    unsigned char* ws = KWS;
    const float* x0 = (const float*)KARG(0);
    const float* pin = (const float*)KARG(1);
    const int* pos = (const int*)KARG(2);
    float* cosT = (float*)(ws + WS_COS); float* sinT = (float*)(ws + WS_SIN);
    bf16* a16 = (bf16*)(ws + WS_A16); bf16* z16 = (bf16*)(ws + WS_Z16); bf16* qb16 = (bf16*)(ws + WS_QB16); bf16* kvb16 = (bf16*)(ws + WS_KVB16);
    bf16* krr16 = (bf16*)(ws + WS_KRR16); float* fcbuf = (float*)(ws + WS_FC); float* cum = (float*)(ws + WS_CUM); float* logf = (float*)(ws + WS_LOGF);
    float* rq = (float*)(ws + WS_RQ); float* rkv = (float*)(ws + WS_RKV);
    bf16* mixed16 = (bf16*)(ws + WS_MIXED16); bf16* mix16 = (bf16*)(ws + WS_MIX16);
    bf16* hs16 = (bf16*)(ws + WS_HS16); bf16* act16 = (bf16*)(ws + WS_ACT16); bf16* outs16 = (bf16*)(ws + WS_OUTS16); bf16* ple16 = (bf16*)(ws + WS_PLE16); bf16* pp16 = (bf16*)(ws + WS_PP16); bf16* p16 = (bf16*)(ws + WS_P16);
    int* ids = (int*)(ws + WS_RT + RT_IDS); float* wts = (float*)(ws + WS_RT + RT_WTS); int* rank = (int*)(ws + WS_RT + RT_RANK);
    int* etok = (int*)(ws + WS_ETOK);
    unsigned* ctl = (unsigned*)(ws + WS_CTL);

        int tid = wave_s * 64 + lane_id_now(); asm volatile("" : "+v"(tid));
        const int lane = tid & 63, wave = __builtin_amdgcn_readfirstlane(tid >> 6);
        const int gw = blockIdx.x * 8 + wave, gtid = blockIdx.x * NTHREADS + tid;
        LAS float* scr = (LAS float*)((LAS unsigned char*)lds_raw + wave * 16384);
        if constexpr (PH == 0) {
            for (int i = gtid; i < NTOK * 16; i += NGT) {
                const int tk = i >> 4, j = i & 15;
                const int j4 = j >> 2, jr = j & 3;
                const double inv = (j4 == 0 ? 1.0 : (j4 == 1 ? 0.1 : (j4 == 2 ? 0.01 : 0.001))) * (jr == 0 ? 1.0 : (jr == 1 ? 0.5623413251903491 : (jr == 2 ? 0.31622776601683794 : 0.1778279410038923)));
                const double ang = (double)pos[tk] * inv;
                const double k = rint(ang * 0.15915494309189535);
                const double r = fma(-k, 6.283185307179586, ang) - k * 2.4492935982947064e-16;
                cosT[i] = cosf((float)r); sinT[i] = sinf((float)r);
            }
            auto cvt_stream = [&](const float* sp, bf16* dp, int n8) {
                for (int i = gtid; i < n8; i += 4 * NGT) {
                    f32x4_t v[8];
#pragma unroll
                    for (int u = 0; u < 4; ++u) { v[2 * u] = *(const f32x4_t*)(sp + (size_t)(i + u * NGT) * 8); v[2 * u + 1] = *(const f32x4_t*)(sp + (size_t)(i + u * NGT) * 8 + 4); }
#pragma unroll
                    for (int u = 0; u < 4; ++u) { v4u o; o.x = pk2(v[2 * u].x, v[2 * u].y); o.y = pk2(v[2 * u].z, v[2 * u].w); o.z = pk2(v[2 * u + 1].x, v[2 * u + 1].y); o.w = pk2(v[2 * u + 1].z, v[2 * u + 1].w);
                        *(v4u*)(dp + (size_t)(i + u * NGT) * 8) = o; }
                }
            };
            for (int i = gw; i < BATCH * 32; i += NGW) {
                int v = pos[i * 64 + lane];
#pragma unroll
                for (int o_ = 1; o_ < 64; o_ <<= 1) v = max(v, __shfl_xor(v, o_));
                if (lane == 0) ((int*)(ws + WS_RT + RT_TPMAX))[i] = v;
            }
            cvt_stream(x0, a16, NTOK * D_MODEL / 8);
            cvt_stream(pin, p16, DEPTH * NTOK * PLE_DIM / 8);
            convert_layer_weights(a, 0, ws, scr, gw, NGW, lane);
        } else {
            constexpr int l = (PH - 1) / PH_PER_LAYER, sp = (PH - 1) % PH_PER_LAYER;
            const float* b_forget = (const float*)KARG(13) + l * 4;
            const float* ln1_g = (const float*)KARG(15) + l * 1024; const float* ln1_b = (const float*)KARG(16) + l * 1024;
            const float* w_group = (const float*)KARG(17) + l * 1024 * 4; const float* b_group = (const float*)KARG(18) + l * 4;
            const float* w_er = (const float*)KARG(19) + (size_t)l * 4 * 1024 * 8; const float* b_er = (const float*)KARG(20) + l * 32;
            const float* ln2_g = (const float*)KARG(26) + l * 1024; const float* ln2_b = (const float*)KARG(27) + l * 1024;
            unsigned* cnt = ctl + CW_CNT + l * 2048 + (DUMMY ? 8192 : 0);
            if (DUMMY) rank = (int*)(ws + WS_RT + 512 * 1024);
            if constexpr (sp == 0) {
                pg8::Gemm g{a16, (const bf16*)(ws + WS_WIN), NTOK, ZP, 1024, 1024, 1024};
                pg8::StaticOrder S; S.init(NTOK, ZP, G, (int)blockIdx.x);
                pg8::EpiZ E{z16, ZP, fcbuf};
                pg8::gemm_phase<pg8::EpiZ, pg8::StaticOrder, true, true>((LAS unsigned char*)lds_raw, g, S, E, tid);
                {
                    pg8::Gemm g2{p16 + (size_t)l * NTOK * PLE_DIM, (const bf16*)(ws + WS_WPP), NTOK, 1024, 256, 256, 256};
                    const int bx = (int)blockIdx.x;
                    pg8::StaticOrder S2; S2.init(NTOK, 1024, G / 2, bx >= G / 2 ? bx - G / 2 : 1 << 20);
                    pg8::EpiBf16<0> E2{pp16, 1024, nullptr, 0, 0, 1.f};
                    pg8::gemm_phase<pg8::EpiBf16<0>, pg8::StaticOrder, true, true>((LAS unsigned char*)lds_raw, g2, S2, E2, tid);
                }
            } else if constexpr (sp == 1) {
                const int g16 = lane >> 4, l16 = lane & 15;
                for (int tk = gw * 4 + g16; tk < NTOK; tk += NGW * 4) {
                    const bf16* zr = z16 + (size_t)tk * ZP;
                    const v4u ca = *(const v4u*)(zr + Z_CQ + l16 * 16), cb = *(const v4u*)(zr + Z_CQ + l16 * 16 + 8);
                    const v4u ka = *(const v4u*)(zr + Z_CKV + l16 * 8);
                    const unsigned short kr1 = zr[Z_KR + l16], kr2 = zr[Z_KR + 16 + l16];
                    const float cs = cosT[tk * 16 + l16], sn = sinT[tk * 16 + l16];
                    const float fcv = fcbuf[tk * 4 + (l16 & 3)];
                    float f[8]; float ss = 0.f;
                    unpack8(ca, f);
#pragma unroll
                    for (int i = 0; i < 8; ++i) ss = fmaf(f[i], f[i], ss);
                    unpack8(cb, f);
#pragma unroll
                    for (int i = 0; i < 8; ++i) ss = fmaf(f[i], f[i], ss);
                    float s2 = 0.f;
                    unpack8(ka, f);
#pragma unroll
                    for (int i = 0; i < 8; ++i) s2 = fmaf(f[i], f[i], s2);
#pragma unroll
                    for (int o = 1; o < 16; o <<= 1) { ss += __shfl_xor(ss, o); s2 += __shfl_xor(s2, o); }
                    if (l16 == 0) { rq[tk] = rsqrtf(ss * (1.f / 256.f) + RMS_EPS); rkv[tk] = rsqrtf(s2 * (1.f / 128.f) + RMS_EPS); }
                    const float x1 = __uint_as_float((unsigned)kr1 << 16), x2 = __uint_as_float((unsigned)kr2 << 16);
                    krr16[tk * 32 + l16] = (bf16)f2bf(x1 * cs - x2 * sn); krr16[tk * 32 + 16 + l16] = (bf16)f2bf(x2 * cs + x1 * sn);
                    if (l16 < 4) {
                        const float xf = fcv + b_forget[l16];
                        logf[tk * 4 + l16] = fminf(xf, 0.f) - log1pf(expf(-fabsf(xf)));
                    }
                }
            } else if constexpr (sp == 2) {
                {
                    pg8::Gemm g{z16 + Z_CQ, (const bf16*)(ws + WS_WUQ), NTOK, NQBP, 256, ZP, 256};
                    pg8::StaticOrder S; S.init(NTOK, NQBP, G, (int)blockIdx.x);
                    pg8::EpiRowScale E{qb16, NQBP, rq};
                    pg8::gemm_phase<pg8::EpiRowScale, pg8::StaticOrder, true, true>((LAS unsigned char*)lds_raw, g, S, E, tid);
                }
                {
                    pg8::Gemm g{z16 + Z_CKV, (const bf16*)(ws + WS_WUKV), NTOK, NKVB, 128, ZP, 128};
                    pg8::StaticOrder S; S.init(NTOK, NKVB, G, (int)((blockIdx.x + 128) % G));
                    pg8::EpiRowScale E{kvb16, NKVB, rkv};
                    pg8::gemm_phase<pg8::EpiRowScale, pg8::StaticOrder, true, true>((LAS unsigned char*)lds_raw, g, S, E, tid);
                }
                const int cw = NGW - 1 - gw;
                if (cw < 32) {
                    const int b = cw >> 2, hh = cw & 3;
                    float* cp = cum + ((size_t)b * SEQ) * 4 + hh; const float* lp = logf + ((size_t)b * SEQ) * 4 + hh;
                    float loc[32]; float run = 0.f;
#pragma unroll
                    for (int i = 0; i < 32; ++i) { run += lp[(size_t)(lane * 32 + i) * 4]; loc[i] = run; }
                    float pre = run;
#pragma unroll
                    for (int o = 1; o < 64; o <<= 1) { const float n = __shfl_up(pre, o); if (lane >= o) pre += n; }
                    pre -= run;
#pragma unroll
                    for (int i = 0; i < 32; ++i) cp[(size_t)(lane * 32 + i) * 4] = loc[i] + pre;
                }
            } else if constexpr (sp == 3) {
                float lam_init_, lam_;
                {
                    const float* lq1 = (const float*)KARG(8) + l * 32; const float* lk1 = (const float*)KARG(9) + l * 32; const float* lq2 = (const float*)KARG(10) + l * 32; const float* lk2 = (const float*)KARG(11) + l * 32;
                    lam_init_ = 0.8f - 0.6f * expf(-0.3f * (float)l);
                    float s1 = 0.f, s2 = 0.f;
                    for (int i = 0; i < 32; ++i) { s1 += lq1[i] * lk1[i]; s2 += lq2[i] * lk2[i]; }
                    lam_ = expf(s1) - expf(s2) + lam_init_;
                }
                AttnP p{z16, qb16, kvb16, krr16, cum, cosT, sinT, pos, mixed16,
                        (const float*)KARG(8) + l * 32, (const float*)KARG(9) + l * 32, (const float*)KARG(10) + l * 32, (const float*)KARG(11) + l * 32,
                        (const float*)KARG(12) + l * 64, l, ctl + 14000, (const int*)(ws + WS_RT + RT_TPMAX), lam_, lam_init_};
                volatile LAS int* qslot = (volatile LAS int*)((LAS unsigned char*)lds_raw + LDS_MISC) + 48;
                unsigned* qctr = ctl + 12288 + l * 64 + (DUMMY ? 32 : 0);
                int idx = (int)blockIdx.x;
                for (;;) {
                    if (idx >= 1408) break;
                    int nxt_idx = 0;
                    if (wave_s == 0 && lane_id_now() == 0) nxt_idx = G + (int)atomicAdd(qctr, 1u);
                    const int pi = idx / 176, r = idx % 176, thi = 32 - 4 * pi;
                    if (r < 48) attn_unit<0>(p, r / 6, r % 6, thi / 2 - 1, (LAS unsigned char*)lds_raw, wave_s);
                    else if (r < 96) attn_unit<1>(p, (r - 48) / 6, (r - 48) % 6, thi / 4 - 1, (LAS unsigned char*)lds_raw, wave_s);
                    else if (r < 128) attn_unit<2>(p, (r - 96) / 4, (r - 96) % 4, thi / 4 - 1, (LAS unsigned char*)lds_raw, wave_s);
                    else attn_unit<0>(p, (r - 128) / 6, (r - 128) % 6, (thi - 2) / 2 - 1, (LAS unsigned char*)lds_raw, wave_s);
                    __syncthreads();
                    if (wave_s == 0 && lane_id_now() == 0) *qslot = nxt_idx;
                    __syncthreads();
                    idx = __builtin_amdgcn_readfirstlane(*qslot);
                }
            } else if constexpr (sp == 4) {
                pg8::Gemm g{mixed16, (const bf16*)(ws + WS_WOUT), NTOK, 1024, 1024, 1024, 1024};
                pg8::StaticOrder S; S.init(NTOK, 1024, G, (int)blockIdx.x);
                pg8::EpiBf16<0> E{mix16, 1024, nullptr, 0, 0, 1.f};
                pg8::gemm_phase<pg8::EpiBf16<0>, pg8::StaticOrder, true, true>((LAS unsigned char*)lds_raw, g, S, E, tid);
            } else if constexpr (sp == 5) {
#ifdef PROF_LN1
                if (l == 0 && blockIdx.x == 0 && tid == 0) ctl[14000 + 19] = (unsigned)(__builtin_amdgcn_s_memrealtime() & 0xffffffffu);
#endif
                LAS f32x4_t* Lg = (LAS f32x4_t*)lds_raw; LAS f32x4_t* Le = Lg + 1024;
                LAS unsigned* lcnt = (LAS unsigned*)((LAS unsigned char*)lds_raw + LDS_MISC) + 16;
                __syncthreads();
                if (tid < 32) lcnt[tid] = 0u;
                for (int k = tid; k < 1024; k += NTHREADS) { const int j = k >> 8, ln = (k & 255) >> 2, i = k & 3; Lg[(j * 4 + i) * 64 + ln] = *(const f32x4_t*)(w_group + (size_t)k * 4); }
                {
                    f32x4_t wv[16];
#pragma unroll
                    for (int u = 0; u < 16; ++u) wv[u] = *(const f32x4_t*)(w_er + (size_t)(tid + u * NTHREADS) * 4);
#pragma unroll
                    for (int u = 0; u < 16; ++u) { const int q = tid + u * NTHREADS; const int g = q >> 11, k = (q >> 1) & 1023, half = q & 1; const int j = k >> 8, ln = (k & 255) >> 2, i = k & 3;
                        Le[((g * 16 + j * 4 + i) * 2 + half) * 64 + ln] = wv[u]; }
                }
                __syncthreads();
#ifdef PROF_LN1
                if (l == 0 && blockIdx.x == 0 && tid == 0) ctl[14000 + 20] = (unsigned)(__builtin_amdgcn_s_memrealtime() & 0xffffffffu);
#endif
                float4 xvA[4], xvB[4]; v2u mwA[4], mwB[4];
                auto ld_x = [&](int tk, int j) -> float4 {
                    if (l == 0) return *(const float4*)(x0 + (size_t)tk * D_MODEL + j * 256 + lane * 4);
                    const v2u xw = *(const v2u*)(a16 + (size_t)tk * D_MODEL + j * 256 + lane * 4);
                    return make_float4(bflo(xw.x), bfhi(xw.x), bflo(xw.y), bfhi(xw.y));
                };
                auto ld_tok = [&](int tk, float4 (&xv)[4], v2u (&mw)[4]) {
                    if (tk < NTOK) {
#pragma unroll
                        for (int j = 0; j < 4; ++j) { xv[j] = ld_x(tk, j); mw[j] = *(const v2u*)(mix16 + (size_t)tk * D_MODEL + j * 256 + lane * 4); }
                    }
                };
                auto do_tok = [&](int tk, float4 (&xv)[4], v2u (&mw)[4]) {
                    float4 v[4]; float s = 0.f;
#pragma unroll
                    for (int j = 0; j < 4; ++j) {
                        v[j] = make_float4(ALPHA * xv[j].x + bflo(mw[j].x), ALPHA * xv[j].y + bfhi(mw[j].x), ALPHA * xv[j].z + bflo(mw[j].y), ALPHA * xv[j].w + bfhi(mw[j].y));
                        s += (v[j].x + v[j].y) + (v[j].z + v[j].w);
                    }
                    ld_tok(tk + 2 * NGW, xv, mw);
                    const float mean = wave_sum(s) * (1.f / 1024.f); float s2 = 0.f;
#pragma unroll
                    for (int j = 0; j < 4; ++j) { v[j].x -= mean; v[j].y -= mean; v[j].z -= mean; v[j].w -= mean; s2 += (v[j].x * v[j].x + v[j].y * v[j].y) + (v[j].z * v[j].z + v[j].w * v[j].w); }
                    const float rstd = rsqrtf(wave_sum(s2) * (1.f / 1024.f) + LN_EPS);
                    float gl[4] = {0.f, 0.f, 0.f, 0.f};
#pragma unroll
                    for (int j = 0; j < 4; ++j) {
                        const int d0 = j * 256 + lane * 4;
                        const float4 gg = *(const float4*)(ln1_g + d0), bb = *(const float4*)(ln1_b + d0);
                        v[j] = make_float4(v[j].x * rstd * gg.x + bb.x, v[j].y * rstd * gg.y + bb.y, v[j].z * rstd * gg.z + bb.z, v[j].w * rstd * gg.w + bb.w);
                        { v2u hb; hb.x = pk2(v[j].x, v[j].y); hb.y = pk2(v[j].z, v[j].w); *(v2u*)(a16 + (size_t)tk * D_MODEL + d0) = hb; }
                        const float hv[4] = {v[j].x, v[j].y, v[j].z, v[j].w};
#pragma unroll
                        for (int i = 0; i < 4; ++i) {
                            const f32x4_t wg = Lg[(j * 4 + i) * 64 + lane];
                            gl[0] = fmaf(hv[i], wg.x, gl[0]); gl[1] = fmaf(hv[i], wg.y, gl[1]); gl[2] = fmaf(hv[i], wg.z, gl[2]); gl[3] = fmaf(hv[i], wg.w, gl[3]);
                        }
                    }
#pragma unroll
                    for (int i = 0; i < 4; ++i) gl[i] = wave_sum(gl[i]) + b_group[i];
                    int gi = 0; float gm = gl[0];
#pragma unroll
                    for (int i = 1; i < 4; ++i) if (gl[i] > gm) { gm = gl[i]; gi = i; }
                    gi = __builtin_amdgcn_readfirstlane(gi);
                    float gden = 0.f;
#pragma unroll
                    for (int i = 0; i < 4; ++i) gden += __expf(gl[i] - gm);
                    const float gwt = 1.f / gden;
                    float el[8] = {0.f, 0.f, 0.f, 0.f, 0.f, 0.f, 0.f, 0.f};
                    const LAS f32x4_t* we = Le + gi * 2048;
#pragma unroll
                    for (int j = 0; j < 4; ++j) {
                        const float hv[4] = {v[j].x, v[j].y, v[j].z, v[j].w};
#pragma unroll
                        for (int i = 0; i < 4; ++i) {
                            const f32x4_t w0 = we[((j * 4 + i) * 2) * 64 + lane], w1 = we[((j * 4 + i) * 2 + 1) * 64 + lane];
                            el[0] = fmaf(hv[i], w0.x, el[0]); el[1] = fmaf(hv[i], w0.y, el[1]); el[2] = fmaf(hv[i], w0.z, el[2]); el[3] = fmaf(hv[i], w0.w, el[3]);
                            el[4] = fmaf(hv[i], w1.x, el[4]); el[5] = fmaf(hv[i], w1.y, el[5]); el[6] = fmaf(hv[i], w1.z, el[6]); el[7] = fmaf(hv[i], w1.w, el[7]);
                        }
                    }
#pragma unroll
                    for (int i = 0; i < 8; ++i) el[i] = wave_sum(el[i]) + b_er[gi * 8 + i];
                    int i0 = 0; float v0 = el[0];
#pragma unroll
                    for (int i = 1; i < 8; ++i) if (el[i] > v0) { v0 = el[i]; i0 = i; }
                    int i1 = -1; float v1 = -INFINITY;
#pragma unroll
                    for (int i = 0; i < 8; ++i) if (i != i0 && el[i] > v1) { v1 = el[i]; i1 = i; }
                    const float e1 = __expf(v1 - v0);
                    const float w0 = gwt / (1.f + e1), w1 = gwt * e1 / (1.f + e1);
                    if (lane == 0) {
                        const int ea = gi * 8 + i0, eb = gi * 8 + i1;
                        ids[tk * 2] = ea; ids[tk * 2 + 1] = eb; wts[tk * 2] = w0; wts[tk * 2 + 1] = w1;
                        rank[tk * 2] = (int)__hip_atomic_fetch_add(lcnt + ea, 1u, __ATOMIC_RELAXED, __HIP_MEMORY_SCOPE_WORKGROUP);
                        rank[tk * 2 + 1] = (int)__hip_atomic_fetch_add(lcnt + eb, 1u, __ATOMIC_RELAXED, __HIP_MEMORY_SCOPE_WORKGROUP);
                    }
                };
                ld_tok(gw, xvA, mwA); ld_tok(gw + NGW, xvB, mwB);
                for (int tk = gw; tk < NTOK; tk += 2 * NGW) {
                    do_tok(tk, xvA, mwA);
                    if (tk + NGW < NTOK) do_tok(tk + NGW, xvB, mwB);
                }
#ifdef PROF_LN1
                if (l == 0 && blockIdx.x == 0 && tid == 0) ctl[14000 + 21] = (unsigned)(__builtin_amdgcn_s_memrealtime() & 0xffffffffu);
#endif
                __syncthreads();
                if (tid < 32) { const unsigned n = lcnt[tid]; lcnt[tid] = n ? atomicAdd(cnt + tid * 64, n) : 0u; }
                __syncthreads();
                for (int base = 0; gw + base * NGW < NTOK; base += 32) {
                    const int tk = gw + (base + (lane >> 1)) * NGW;
                    if (tk < NTOK) {
                        const int pi = tk * 2 + (lane & 1);
                        const int ee = ids[pi];
                        const int rr = rank[pi] + (int)lcnt[ee];
                        rank[pi] = rr;
                        if (!DUMMY) etok[ee * 16384 + rr] = tk;
                    }
                }
                __syncthreads();
            } else if constexpr (sp == 6) {
                LAS int* xs = (LAS int*)((LAS unsigned char*)lds_raw + 131072); LAS int* te = xs + 80;
                __syncthreads();
                expert_prefix(cnt, xs, tid);
                if (tid < 32) xs[40 + tid] = (int)cnt[tid * 64];
                __syncthreads();
                if (tid < NSLOT_TILES) { int e = 31; for (int k = 31; k >= 0; --k) if (tid * 256 < xs[k + 1]) e = k; te[tid] = e; }
                __syncthreads();
                const int T = xs[32] >> 8, nU1 = 2 * T;
                const int vc = (int)((blockIdx.x % 8) * (G / 8) + blockIdx.x / 8);
                unsigned go[2][2][2]; int upm[2], upn[2]; int nun = 0;
#pragma unroll
                for (int i = 0; i < 2; ++i) {
                    const int g = vc + i * G;
                    upm[i] = 0; upn[i] = 0;
#pragma unroll
                    for (int h = 0; h < 2; ++h) { go[i][h][0] = 0u; go[i][h][1] = 0u; }
                    if (g < nU1) {
                        const int t = g >> 1, e = __builtin_amdgcn_readfirstlane(te[t]);
                        const int tl = t - (xs[e] >> 8), ce = xs[40 + e];
                        upm[i] = t + pg8::XPM; upn[i] = e * 2 + (g & 1) + pg8::XPN; nun = i + 1;
#pragma unroll
                        for (int pc = 0; pc < 2; ++pc) { int R, C; pg8::stage_rc(tid * 16 + pc * 8192, R, C);
#pragma unroll
                            for (int h = 0; h < 2; ++h) { const int rk = tl * 256 + h * 128 + R; const int tok = rk < ce ? etok[e * 16384 + rk] : 0; go[i][h][pc] = (unsigned)tok * 2048u + (unsigned)C * 2u; } }
                    } else if (g - nU1 < 256) {
                        const int k = g - nU1;
                        upm[i] = k >> 2; upn[i] = k & 3; nun = i + 1;
#pragma unroll
                        for (int pc = 0; pc < 2; ++pc) { int R, C; pg8::stage_rc(tid * 16 + pc * 8192, R, C);
#pragma unroll
                            for (int h = 0; h < 2; ++h) go[i][h][pc] = (unsigned)((k >> 2) * 256 + h * 128 + R) * 2048u + (unsigned)C * 2u; }
                    }
                }
                if (nun == 1) {
#pragma unroll
                    for (int h = 0; h < 2; ++h) { go[1][h][0] = go[0][h][0]; go[1][h][1] = go[0][h][1]; }
                }
                {
                    pg8::Gemm g{a16, (const bf16*)(ws + WS_WPG), NTOK, 1024, 1024, 1024, 1024};
                    pg8::TwoUnits S{upm[0], upn[0], upm[1], upn[1], nun};
                    pg8::EpiX E{pg8::EpiGU{act16}, pg8::EpiPleGate{ple16, pp16}};
                    pg8::gemm_phase_ga<pg8::EpiX, pg8::TwoUnits, true, true>((LAS unsigned char*)lds_raw, g, S, E, tid, go[0], go[1]);
                }
            } else if constexpr (sp == 7) {
                LAS int* xs = (LAS int*)((LAS unsigned char*)lds_raw + 131072); LAS int* te = xs + 80;
                __syncthreads();
                expert_prefix(cnt, xs, tid);
                __syncthreads();
                if (tid < NSLOT_TILES) { int e = 31; for (int k = 31; k >= 0; --k) if (tid * 256 < xs[k + 1]) e = k; te[tid] = e; }
                __syncthreads();
                const int T = xs[32] >> 8;
                const int vc = (int)((blockIdx.x % 8) * (G / 8) + blockIdx.x / 8);
                int nB2 = 2 * T - G; nB2 = nB2 < 0 ? 0 : nB2;
                if (vc >= nB2) {
                    pg8::Gemm g{act16, (const bf16*)(ws + WS_WD), MAX_SLOTS, 32 * 1024, 256, 256, 256};
                    pg8::GroupSched S{(const int*)te, T, 4, G - nB2, vc - nB2};
                    pg8::EpiDown E{outs16};
                    pg8::gemm_phase<pg8::EpiDown, pg8::GroupSched, true, true>((LAS unsigned char*)lds_raw, g, S, E, tid);
                } else {
                    const int k = 256 - nB2 + vc;
                    pg8::Gemm g{a16, (const bf16*)(ws + WS_WPG), NTOK, 1024, 1024, 1024, 1024};
                    pg8::OneUnit S{k >> 2, k & 3};
                    pg8::EpiPleGate E{ple16, pp16};
                    pg8::gemm_phase<pg8::EpiPleGate, pg8::OneUnit, true, true>((LAS unsigned char*)lds_raw, g, S, E, tid);
                }
            } else if constexpr (sp == 8) {
                LAS int* xs = (LAS int*)((LAS unsigned char*)lds_raw + 131072);
                __syncthreads();
                expert_prefix(cnt, xs, tid);
                __syncthreads();
                struct Ln2Regs { v2u hv[4], oa[4], ob[4], pv[4]; float w0, w1; };
                Ln2Regs RA, RB;
                auto ld_rows = [&](int tk, Ln2Regs& R) {
                    if (tk < NTOK) {
                        const int s0 = xs[ids[tk * 2]] + rank[tk * 2], s1 = xs[ids[tk * 2 + 1]] + rank[tk * 2 + 1]; R.w0 = wts[tk * 2]; R.w1 = wts[tk * 2 + 1];
#pragma unroll
                        for (int j = 0; j < 4; ++j) {
                            const int d0 = j * 256 + lane * 4;
                            R.hv[j] = *(const v2u*)(a16 + (size_t)tk * D_MODEL + d0);
                            R.oa[j] = *(const v2u*)(outs16 + (size_t)s0 * D_MODEL + d0); R.ob[j] = *(const v2u*)(outs16 + (size_t)s1 * D_MODEL + d0);
                            R.pv[j] = *(const v2u*)(ple16 + (size_t)tk * D_MODEL + d0);
                        }
                    }
                };
                auto do_row = [&](int tk, Ln2Regs& R) {
                    float4 v[4]; float s = 0.f; const float w0 = R.w0, w1 = R.w1;
#pragma unroll
                    for (int j = 0; j < 4; ++j) {
                        v[j] = make_float4(ALPHA * bflo(R.hv[j].x) + w0 * bflo(R.oa[j].x) + w1 * bflo(R.ob[j].x) + bflo(R.pv[j].x), ALPHA * bfhi(R.hv[j].x) + w0 * bfhi(R.oa[j].x) + w1 * bfhi(R.ob[j].x) + bfhi(R.pv[j].x),
                                           ALPHA * bflo(R.hv[j].y) + w0 * bflo(R.oa[j].y) + w1 * bflo(R.ob[j].y) + bflo(R.pv[j].y), ALPHA * bfhi(R.hv[j].y) + w0 * bfhi(R.oa[j].y) + w1 * bfhi(R.ob[j].y) + bfhi(R.pv[j].y));
                        s += (v[j].x + v[j].y) + (v[j].z + v[j].w);
                    }
                    ld_rows(tk + 2 * NGW, R);
                    const float mean = wave_sum(s) * (1.f / 1024.f); float s2 = 0.f;
#pragma unroll
                    for (int j = 0; j < 4; ++j) { v[j].x -= mean; v[j].y -= mean; v[j].z -= mean; v[j].w -= mean; s2 += (v[j].x * v[j].x + v[j].y * v[j].y) + (v[j].z * v[j].z + v[j].w * v[j].w); }
                    const float rstd = rsqrtf(wave_sum(s2) * (1.f / 1024.f) + LN_EPS);
#pragma unroll
                    for (int j = 0; j < 4; ++j) {
                        const int d0 = j * 256 + lane * 4;
                        const float4 gg = *(const float4*)(ln2_g + d0), bb = *(const float4*)(ln2_b + d0);
                        const float4 o = make_float4(v[j].x * rstd * gg.x + bb.x, v[j].y * rstd * gg.y + bb.y, v[j].z * rstd * gg.z + bb.z, v[j].w * rstd * gg.w + bb.w);
                        if (!DUMMY || w0 == 12345.678f) {
                        if (l == DEPTH - 1) {
#ifdef PROF_SEL
#ifdef PROF_LN1
                        float4 oo = o; { const float dlt = sqrtf((float)(ctl[14000 + PROF_LN1 + 1] - ctl[14000 + PROF_LN1]) * 1e-8f);
#else
                        float4 oo = o; { const float dlt = sqrtf((float)ctl[14000 + PROF_SEL] * 1e-8f);
#endif
                        oo.x += dlt; oo.y += dlt; oo.z += dlt; oo.w += dlt; }
                        *(float4*)(KOUT + (size_t)tk * D_MODEL + d0) = oo;
#else
                        *(float4*)(KOUT + (size_t)tk * D_MODEL + d0) = o;
#endif
                        } else {
                        v2u ob16; ob16.x = pk2(o.x, o.y); ob16.y = pk2(o.z, o.w);
                        *(v2u*)(a16 + (size_t)tk * D_MODEL + d0) = ob16;
                        }
                        }
                    }
                };
                ld_rows(gw, RA); ld_rows(gw + NGW, RB);
                for (int tk = gw; tk < NTOK; tk += 2 * NGW) {
                    do_row(tk, RA);
                    if (tk + NGW < NTOK) do_row(tk + NGW, RB);
                }
                if (l + 1 < DEPTH) convert_layer_weights(a, l + 1, ws, scr, gw, NGW, lane);
            }
        }
}

constexpr int CW_BAR = 4096;
__global__ void __launch_bounds__(NTHREADS, 2) mega(Args a) {
    extern __shared__ __attribute__((aligned(16))) unsigned char lds_raw[];
    cg::grid_group grid = cg::this_grid();
    volatile LAS unsigned* misc = (volatile LAS unsigned*)((LAS unsigned char*)lds_raw + LDS_MISC);
    if (threadIdx.x < 16) misc[threadIdx.x] = 0u;
    __syncthreads();
    XcdBarrier bar = xcd_barrier_post((unsigned*)(a.ws + WS_CTL) + CW_BAR, misc + 8);
    const int wave_s = __builtin_amdgcn_readfirstlane(threadIdx.x >> 6);
#define IS_T0 (wave_s == 0 && lane_id_now() == 0)
#ifndef DUP_SP
#define DUP_SP -1
#endif
#ifndef DUP_X
#define DUP_X 0
#endif
    if (a.ph_hi < 0) grid.sync();
#define SEAM(ph) do { xcd_barrier(bar, IS_T0); } while (0)
#ifdef PROF_PH
    unsigned long long ph_t_prev = __builtin_amdgcn_s_memrealtime();
#define PHASE_STAMP(ph) do { const unsigned long long t_ = __builtin_amdgcn_s_memrealtime(); if ((ph) == PROF_PH && blockIdx.x == 0 && IS_T0) ((unsigned*)(a.ws + WS_CTL))[14000 + PROF_SEL] = (unsigned)(t_ - ph_t_prev); ph_t_prev = t_; } while (0)
#else
#define PHASE_STAMP(ph) do {} while (0)
#endif
#define RUN(ph) if (a.ph_lo <= (ph) && (ph) < a.ph_hi) { \
        if (DUP_X == 9 && (ph) > 0 && ((ph) - 1) % PH_PER_LAYER == 9) { run_phase<ph, true>(a, lds_raw, wave_s); xcd_barrier(bar, IS_T0); } \
        run_phase<ph>(a, lds_raw, wave_s); \
        if ((ph) > 0 && ((ph) - 1) % PH_PER_LAYER == DUP_SP) { xcd_barrier(bar, IS_T0); run_phase<ph>(a, lds_raw, wave_s); } \
        if (DUP_X == 100 && (ph) == 0) { xcd_barrier(bar, IS_T0); run_phase<ph>(a, lds_raw, wave_s); } \
        if (DUP_X == 5 && (ph) == 6) { xcd_barrier(bar, IS_T0); run_phase<ph, true>(a, lds_raw, wave_s); } \
        if (DUP_X == 3 && (ph) > 0 && ((ph) - 1) % PH_PER_LAYER == 3) { xcd_barrier(bar, IS_T0); run_phase<ph, true>(a, lds_raw, wave_s); } \
        if ((ph) + 1 < a.ph_hi && (ph) + 1 < NPH) SEAM(ph); PHASE_STAMP(ph); }
    RUN(0) RUN(1) RUN(2) RUN(3) RUN(4) RUN(5) RUN(6) RUN(7) RUN(8) RUN(9)
    RUN(10) RUN(11) RUN(12) RUN(13) RUN(14) RUN(15) RUN(16) RUN(17) RUN(18)
#undef RUN
#undef SEAM
}

extern "C" void kernel_launch(void* const* d_in, const int* in_sizes, int n_in, void* d_out, int out_size, void* d_ws, size_t ws_size, hipStream_t stream) {
    static int grid = 0;
    if (grid == 0) {
        if (n_in != 28 || ws_size < WS_END) { fprintf(stderr, "kernel_launch: unexpected n_in %d or ws_size %zu (< %zu)\n", n_in, ws_size, (size_t)WS_END); grid = -1; return; }
        int dev = 0, cus = 0, per_cu = 0;
        (void)hipGetDevice(&dev);
        (void)hipDeviceGetAttribute(&cus, hipDeviceAttributeMultiprocessorCount, dev);
        (void)hipFuncSetAttribute((const void*)mega, hipFuncAttributeMaxDynamicSharedMemorySize, LDS_BYTES);
        (void)hipOccupancyMaxActiveBlocksPerMultiprocessor(&per_cu, (const void*)mega, NTHREADS, LDS_BYTES);
        if (per_cu < 1) { fprintf(stderr, "kernel_launch: occupancy query says %d blocks/CU\n", per_cu); }
        (void)hipGetLastError();
        grid = cus;
    }
    if (grid < 0) return;
    (void)hipMemsetAsync((char*)d_ws + WS_CTL, 0, 64 * 1024, stream);
    Args a{};
    for (int i = 0; i < 28; ++i) a.in[i] = d_in[i];
    a.out = (float*)d_out; a.ws = (unsigned char*)d_ws; a.ph_lo = 0; a.ph_hi = NPH;
    void* params[] = {&a};
    hipError_t e = hipLaunchCooperativeKernel((const void*)mega, dim3(grid), dim3(NTHREADS), params, LDS_BYTES, stream);
    if (e != hipSuccess) fprintf(stderr, "cooperative launch failed: %s (grid %d)\n", hipGetErrorString(e), grid);
}
```

```cpp
#include <hip/hip_runtime.h>
#include <hip/hip_cooperative_groups.h>
#include <cstdio>
#include <cstdint>
namespace cg = cooperative_groups;

constexpr int D_MODEL = 1024, BATCH = 8, SEQ = 2048, NTOK = BATCH * SEQ, DEPTH = 2;
constexpr int D_IN = 2340;
constexpr int OFF_QA = 0, OFF_KA = 384, OFF_VA = 768, OFF_CQ = 1152, OFF_CKV = 1408, OFF_KR = 1536,
              OFF_QC = 1568, OFF_KC = 1824, OFF_VC = 2080, OFF_FC = 2336;
constexpr int ZP = 2560;
constexpr int Z_QA = 0, Z_KA = 384, Z_VA = 768, Z_QC = 1152, Z_KC = 1408, Z_VC = 1664, Z_CKV = 1920, Z_CQ = 2048, Z_KR = 2304, Z_FC = 2336;
constexpr int NQB = 576, NKVB = 768, NQBP = 768;
constexpr int N_EXPERTS = 32, D_EXPERT = 256, PLE_DIM = 256;
constexpr int MAX_SLOTS = 32768 + 32 * 256;
constexpr int NSLOT_TILES = MAX_SLOTS / 256;
constexpr float ALPHA = 1.4142135623730951f;
constexpr float LN_EPS = 1e-5f, RMS_EPS = 1e-6f;
constexpr int NTHREADS = 512;
constexpr int LDS_BYTES = 147456 + 256;

constexpr size_t MiB = 1u << 20;
constexpr size_t WS_CTL = 0;
constexpr size_t WS_COS = 1 * MiB, WS_SIN = 2 * MiB;
constexpr size_t WS_WIN = 3 * MiB;
constexpr size_t WS_WUQ = 8 * MiB;
constexpr size_t WS_WUKV = WS_WUQ + 393216;
constexpr size_t WS_WOUT = 9 * MiB;
constexpr size_t WS_WPG = 11 * MiB;
constexpr size_t WS_WPP = 13 * MiB;
constexpr size_t WS_WGU = 14 * MiB;
constexpr size_t WS_WD = 46 * MiB;
constexpr size_t WS_A16 = 62 * MiB;
constexpr size_t WS_P16 = 94 * MiB;
constexpr size_t WS_Z16 = 110 * MiB;
constexpr size_t WS_HS16 = WS_Z16;
constexpr size_t WS_OUTS16 = WS_Z16;
constexpr size_t WS_QB16 = 190 * MiB;
constexpr size_t WS_KVB16 = 214 * MiB;
constexpr size_t WS_KRR16 = 238 * MiB;
constexpr size_t WS_FC = 239 * MiB;
constexpr size_t WS_CUM = WS_FC + 256 * 1024;
constexpr size_t WS_LOGF = WS_CUM + 256 * 1024;
constexpr size_t WS_RQ = WS_LOGF + 256 * 1024;
constexpr size_t WS_RKV = WS_RQ + 64 * 1024;
constexpr size_t WS_MIX16 = 190 * MiB;
constexpr size_t WS_PP16 = 276 * MiB;
constexpr size_t WS_ACT16 = 222 * MiB;
constexpr size_t WS_MIXED16 = 242 * MiB;
constexpr size_t WS_PLE16 = 242 * MiB;
constexpr size_t WS_RT = 274 * MiB;
constexpr size_t WS_ETOK = 308 * MiB;
constexpr size_t WS_END = 310 * MiB;
constexpr size_t RT_IDS = 0, RT_WTS = 128 * 1024, RT_RANK = 256 * 1024, RT_SLOTOF = 384 * 1024, RT_TILEE = 768 * 1024, RT_TPMAX = 800 * 1024;
constexpr int CW_CNT = 0;
static_assert((WS_A16 - WS_HS16) % (256 * 1024 * 2) == 0 || true, "");

struct Args { const void* in[28]; float* out; unsigned char* ws; int ph_lo, ph_hi; };

#define LAS __attribute__((address_space(3)))
typedef unsigned short bf16;
typedef unsigned v4u __attribute__((ext_vector_type(4)));
typedef unsigned v2u __attribute__((ext_vector_type(2)));
typedef float f32x4_t __attribute__((ext_vector_type(4)));

__device__ __forceinline__ float wave_sum(float v) {
#define WS_DPP(ctrl, rmask) __builtin_bit_cast(float, __builtin_amdgcn_update_dpp(0, __builtin_bit_cast(int, v), (ctrl), (rmask), 0xf, true))
    v += WS_DPP(0x111, 0xf);
    v += WS_DPP(0x112, 0xf);
    v += WS_DPP(0x114, 0xf);
    v += WS_DPP(0x118, 0xf);
    v += WS_DPP(0x142, 0xa);
    v += WS_DPP(0x143, 0xc);
#undef WS_DPP
    return __builtin_bit_cast(float, __builtin_amdgcn_readlane(__builtin_bit_cast(int, v), 63));
}
__device__ __forceinline__ unsigned f2bf(float f) { unsigned u = __builtin_bit_cast(unsigned, f); return (u + 0x7fffu + ((u >> 16) & 1u)) >> 16; }
__device__ __forceinline__ unsigned pk2(float lo, float hi) { return f2bf(lo) | (f2bf(hi) << 16); }
__device__ __forceinline__ float bflo(unsigned w) { return __uint_as_float(w << 16); }
__device__ __forceinline__ float bfhi(unsigned w) { return __uint_as_float(w & 0xffff0000u); }
__device__ __forceinline__ void unpack8(const v4u w, float* f) { f[0] = bflo(w.x); f[1] = bfhi(w.x); f[2] = bflo(w.y); f[3] = bfhi(w.y); f[4] = bflo(w.z); f[5] = bfhi(w.z); f[6] = bflo(w.w); f[7] = bfhi(w.w); }
__device__ __forceinline__ int lane_id_now() { int l; asm volatile("v_mbcnt_lo_u32_b32 %0, -1, 0\n\tv_mbcnt_hi_u32_b32 %0, -1, %0" : "=v"(l)); return l; }
namespace pg8 {
#define PG8_LAS __attribute__((address_space(3)))
typedef unsigned short bf16_t;
typedef short bf16x8 __attribute__((ext_vector_type(8)));
typedef float f32x4 __attribute__((ext_vector_type(4)));
typedef unsigned u32x4 __attribute__((ext_vector_type(4)));
constexpr int BM = 256, BK = 64, HALF = 128, HTB = HALF * BK * 2  , STAGE_BYTES = 8 * HTB, NXCD = 8, WGM = 8;

__host__ __device__ __forceinline__ int lds_byte(int r, int c) { const int st = (r >> 4) * 2 + (c >> 5), rr = r & 15, cc = c & 31, ob = rr * 64 + cc * 2; return st * 1024 + (ob ^ (((ob >> 9) & 1) << 5)); }
__host__ __device__ __forceinline__ void stage_rc(int b, int& R, int& C) { const int st = b / 1024, sb = b % 1024, swz = sb ^ (((sb >> 9) & 1) << 5); R = (st >> 1) * 16 + swz / 64; C = (st & 1) * 32 + (swz % 64) / 2; }
__host__ __device__ __forceinline__ int perm32(int rho) { const int n = rho >> 4, i = rho & 15; return 8 * (i >> 2) + 4 * n + (i & 3); }

struct Unit { int pm, pn; };
struct Gemm { const bf16_t* A; const bf16_t* Bt; int M, N, K, lda, ldb; };

struct StaticOrder {
    int nM, nN, nwg, G, c;
    __host__ __device__ void init(int M, int N, int G_, int c_) { nM = M / BM; nN = N / BM; nwg = nM * nN; G = G_; c = c_; }
    __host__ __device__ bool next(int i, Unit& u) const {
        const long L = (long)i * G + c; if (L >= nwg) return false;
        int wgid = (int)L; { const int q = nwg / NXCD, r = nwg % NXCD, xcd = wgid % NXCD, off = wgid / NXCD; wgid = (xcd < r ? xcd * (q + 1) : r * (q + 1) + (xcd - r) * q) + off; }
        const int nig = WGM * nN, gid = wgid / nig, fm = gid * WGM, gsz = (nM - fm) < WGM ? (nM - fm) : WGM;
        u.pm = fm + ((wgid % nig) % gsz); u.pn = (wgid % nig) / gsz; return true;
    }
    __device__ __forceinline__ void a_ready(const Unit&) const {}
    __device__ __forceinline__ void done(const Unit&) const {}
};

__device__ __forceinline__ unsigned cvt_pk_bf16(float lo, float hi) { unsigned r; asm volatile("v_cvt_pk_bf16_f32 %0, %1, %2" : "=v"(r) : "v"(lo), "v"(hi)); return r; }
typedef float f32x2 __attribute__((ext_vector_type(2)));
__device__ __forceinline__ f32x2 gelu_pk(f32x2 v) {
    const f32x2 av = __builtin_elementwise_abs(v), d = av * 0.2316418882f + 1.0f;
    f32x2 t; t.x = __builtin_amdgcn_rcpf(d.x); t.y = __builtin_amdgcn_rcpf(d.y);
    f32x2 q = t * 0.5307027145f + (-0.7265760135f); q = q * t + 0.7107068705f; q = q * t + (-0.142248368f); q = q * t + 0.127414796f; q = q * t;
    const f32x2 s = (v * v) * (-0.72134752044f);
    f32x2 e; e.x = __builtin_amdgcn_exp2f(s.x); e.y = __builtin_amdgcn_exp2f(s.y);
    const f32x2 m = v * (q * e), r = v - m;
    f32x2 o; o.x = v.x < 0.f ? m.x : r.x; o.y = v.y < 0.f ? m.y : r.y; return o;
}

template <int ACT  > struct EpiBf16 {
    static constexpr bool PERM = true, AFTER_DRAIN = false; static_assert(ACT == 0 || ACT == 1, "EpiBf16: ACT is 0 (none) or 1 (gelu_pk)");
    bf16_t* O; int ldc; const float* bias; int split_cols; size_t split_stride; float scale0;
    __device__ __forceinline__ void operator()(const f32x4 (&acc)[2][2][4][2], const Unit& u, int wr, int wc, int fr, int fq) const {
        const int row0 = u.pm * BM + wr * 64 + fr; int colt = u.pn * BM; bf16_t* base = O;
        float sc = 1.f; if (split_cols) { const int t = colt / split_cols; base += (size_t)t * split_stride; colt -= t * split_cols; if (t == 0) sc = scale0; }
        const int col0 = colt + wc * 32 + 8 * fq, bcol0 = u.pn * BM + wc * 32 + 8 * fq;
        f32x4 bv[2][2];
#pragma unroll
        for (int bj = 0; bj < 2; ++bj)
#pragma unroll
            for (int n = 0; n < 2; ++n) bv[bj][n] = bias ? *(const f32x4*)(bias + bcol0 + bj * HALF + 4 * n) : (f32x4){0.f, 0.f, 0.f, 0.f};
#pragma unroll
        for (int ai = 0; ai < 2; ++ai)
#pragma unroll
            for (int m = 0; m < 4; ++m) { bf16_t* rowp = base + (size_t)(row0 + ai * HALF + m * 16) * ldc + col0;
#pragma unroll
                for (int bj = 0; bj < 2; ++bj) { f32x4 v0 = acc[ai][bj][m][0] + bv[bj][0], v1 = acc[ai][bj][m][1] + bv[bj][1];
                    if (ACT == 1) { f32x2 a = gelu_pk((f32x2){v0[0], v0[1]}), b = gelu_pk((f32x2){v0[2], v0[3]}), c = gelu_pk((f32x2){v1[0], v1[1]}), d = gelu_pk((f32x2){v1[2], v1[3]});
                        v0 = (f32x4){a.x, a.y, b.x, b.y}; v1 = (f32x4){c.x, c.y, d.x, d.y}; }
                    v0 = v0 * sc; v1 = v1 * sc; u32x4 w; w.x = cvt_pk_bf16(v0[0], v0[1]); w.y = cvt_pk_bf16(v0[2], v0[3]); w.z = cvt_pk_bf16(v1[0], v1[1]); w.w = cvt_pk_bf16(v1[2], v1[3]);
                    *(u32x4*)(rowp + bj * HALF) = w; } }
    }
};
template <class Epi, class Sched, bool ALIGN_EPI = false, bool SP2 = false>
__device__ __forceinline__ void gemm_phase(PG8_LAS unsigned char* lds, const Gemm g, const Sched& S, const Epi& E, const int tid) {
    const int wid = __builtin_amdgcn_readfirstlane(tid >> 6), lane = tid & 63, wr = wid >> 2, wc = wid & 3, fr = lane & 15, fq = lane >> 4;
    int K = g.K; asm volatile("" : "+s"(K));
    const int nt = K / BK;
    unsigned voffA[2], voffB[2];
#pragma unroll
    for (int i = 0; i < 2; ++i) { int R, C; stage_rc(tid * 16 + i * 8192, R, C); const int Rb = Epi::PERM ? ((R & ~31) + perm32(R & 31)) : R;
        voffA[i] = (unsigned)(R * g.lda + C) * 2u; voffB[i] = (unsigned)(Rb * g.ldb + C) * 2u; }
    const size_t kstep = (size_t)(BK * 2);
    const size_t hstepA = (size_t)HALF * g.lda * 2, hstepB = (size_t)HALF * g.ldb * 2;
    const size_t tstepA = 2 * hstepA, tstepB = 2 * hstepB;
    const unsigned ldsw = (unsigned)wid * 1024u;
    const int aoff = lds_byte(wr * 64 + fr, fq * 8), boff = lds_byte(wc * 32 + fr, fq * 8);
#define PG8_SA(b, h) (((b) * 2 + (h)) * HTB)
#define PG8_SB(b, h) ((4 + (b) * 2 + (h)) * HTB)
#define PG8_STAGE(bufoff, gbase, voff) do { _Pragma("unroll") for (int _i = 0; _i < 2; ++_i) \
        __builtin_amdgcn_global_load_lds((const unsigned*)((const char*)(gbase) + (voff)[_i]), (PG8_LAS unsigned*)(lds + (bufoff) + ldsw + _i * 8192), 16, 0, 0); } while (0)
#define PG8_LDA(dst, b, h) do { _Pragma("unroll") for (int m = 0; m < 4; ++m) _Pragma("unroll") for (int k = 0; k < 2; ++k) dst[m][k] = *(const PG8_LAS bf16x8*)(lds + PG8_SA(b, h) + aoff + m * 2048 + k * 1024); } while (0)
#define PG8_LDB(dst, b, h) do { _Pragma("unroll") for (int n = 0; n < 2; ++n) _Pragma("unroll") for (int k = 0; k < 2; ++k) dst[n][k] = *(const PG8_LAS bf16x8*)(lds + PG8_SB(b, h) + boff + n * 2048 + k * 1024); } while (0)
#define PG8_MMA(ai, bj, At, Bt) do { __builtin_amdgcn_s_setprio(1); _Pragma("unroll") for (int m = 0; m < 4; ++m) _Pragma("unroll") for (int n = 0; n < 2; ++n) _Pragma("unroll") for (int k = 0; k < 2; ++k) \
        acc[ai][bj][m][n] = __builtin_amdgcn_mfma_f32_16x16x32_bf16(Bt[n][k], At[m][k], acc[ai][bj][m][n], 0, 0, 0); __builtin_amdgcn_s_setprio(0); } while (0)
#define PG8_WAIT_V(n) asm volatile("s_waitcnt vmcnt(" #n ")" ::: "memory")
#define PG8_WAIT_L(n) asm volatile("s_waitcnt lgkmcnt(" #n ")" ::: "memory")
#define PG8_BAR __builtin_amdgcn_s_barrier()
#define PG8_SCHED __builtin_amdgcn_sched_barrier(0)
    Unit cur, nxt; int ui = 0;
    if (!S.next(0, cur)) return;
    f32x4 acc[2][2][4][2];
#pragma unroll
    for (int a = 0; a < 2; ++a)
#pragma unroll
        for (int b = 0; b < 2; ++b)
#pragma unroll
            for (int m = 0; m < 4; ++m)
#pragma unroll
                for (int n = 0; n < 2; ++n) acc[a][b][m][n] = (f32x4){0.f, 0.f, 0.f, 0.f};
    bf16x8 At[4][2], B0[2][2], B1[2][2];
    const char* cA = (const char*)g.A + (size_t)cur.pm * tstepA; const char* cB = (const char*)g.Bt + (size_t)cur.pn * tstepB;
    S.a_ready(cur);
    if constexpr (SP2) {
        PG8_STAGE(PG8_SB(0, 0), cB, voffB); PG8_STAGE(PG8_SB(0, 1), cB + hstepB, voffB); PG8_STAGE(PG8_SA(0, 0), cA, voffA); PG8_STAGE(PG8_SA(0, 1), cA + hstepA, voffA);
        if (wr == 1) PG8_BAR;
        PG8_WAIT_V(2); PG8_BAR;
        PG8_STAGE(PG8_SB(1, 0), cB + kstep, voffB); PG8_STAGE(PG8_SA(1, 0), cA + kstep, voffA); PG8_STAGE(PG8_SB(1, 1), cB + hstepB + kstep, voffB);
        PG8_WAIT_V(6); PG8_BAR;
    } else {
        PG8_STAGE(PG8_SB(0, 0), cB, voffB); PG8_STAGE(PG8_SA(0, 0), cA, voffA); PG8_STAGE(PG8_SB(0, 1), cB + hstepB, voffB); PG8_STAGE(PG8_SA(0, 1), cA + hstepA, voffA);
        if (wr == 1) PG8_BAR;
        PG8_WAIT_V(4); PG8_BAR;
        PG8_STAGE(PG8_SB(1, 0), cB + kstep, voffB); PG8_STAGE(PG8_SA(1, 0), cA + kstep, voffA); PG8_STAGE(PG8_SB(1, 1), cB + hstepB + kstep, voffB);
        PG8_WAIT_V(6); PG8_BAR;
    }
    for (;;) {
        const bool has_next = S.next(ui + 1, nxt);
        const char* nA = has_next ? (const char*)g.A + (size_t)nxt.pm * tstepA : cA; const char* nB = has_next ? (const char*)g.Bt + (size_t)nxt.pn * tstepB : cB;
        for (int t = 0; t < nt; t += 2) {
            const bool last = (t == nt - 2);
            const char* a1 = cA + (size_t)(t + 1) * kstep;
            const char* a2 = last ? nA : cA + (size_t)(t + 2) * kstep; const char* b2 = last ? nB : cB + (size_t)(t + 2) * kstep;
            const char* a3 = a2 + kstep; const char* b3 = b2 + kstep;
            if (last && has_next) S.a_ready(nxt);
            if constexpr (SP2) {
            PG8_LDB(B0, 0, 0); PG8_LDB(B1, 0, 1); PG8_SCHED; PG8_LDA(At, 0, 0); PG8_STAGE(PG8_SA(1, 1), a1 + hstepA, voffA);
            PG8_WAIT_V(8); PG8_WAIT_L(0); PG8_BAR; PG8_MMA(0, 0, At, B0); PG8_MMA(0, 1, At, B1); PG8_BAR; PG8_SCHED;
            PG8_LDA(At, 0, 1); PG8_STAGE(PG8_SB(0, 0), b2, voffB); PG8_STAGE(PG8_SB(0, 1), b2 + hstepB, voffB); PG8_STAGE(PG8_SA(0, 0), a2, voffA);
            PG8_WAIT_V(8); PG8_WAIT_L(0); PG8_BAR; PG8_MMA(1, 0, At, B0); PG8_MMA(1, 1, At, B1); PG8_BAR; PG8_SCHED;
            PG8_LDB(B0, 1, 0); PG8_LDB(B1, 1, 1); PG8_SCHED; PG8_LDA(At, 1, 0); PG8_STAGE(PG8_SA(0, 1), a2 + hstepA, voffA);
            PG8_WAIT_V(8); PG8_WAIT_L(0); PG8_BAR; PG8_MMA(0, 0, At, B0); PG8_MMA(0, 1, At, B1); PG8_BAR; PG8_SCHED;
            PG8_LDA(At, 1, 1); PG8_STAGE(PG8_SB(1, 0), b3, voffB); PG8_STAGE(PG8_SB(1, 1), b3 + hstepB, voffB); PG8_STAGE(PG8_SA(1, 0), a3, voffA);
            PG8_WAIT_V(8); PG8_WAIT_L(0); PG8_BAR; PG8_MMA(1, 0, At, B0); PG8_MMA(1, 1, At, B1); PG8_BAR; PG8_SCHED;
            } else {
            PG8_LDB(B0, 0, 0); PG8_SCHED; PG8_LDA(At, 0, 0); PG8_STAGE(PG8_SA(1, 1), a1 + hstepA, voffA);
            PG8_WAIT_L(8); PG8_BAR; PG8_WAIT_L(0); PG8_MMA(0, 0, At, B0); PG8_BAR; PG8_SCHED;
            PG8_LDB(B1, 0, 1); PG8_STAGE(PG8_SB(0, 0), b2, voffB);
            PG8_BAR; PG8_WAIT_L(0); PG8_MMA(0, 1, At, B1); PG8_BAR;
            PG8_LDA(At, 0, 1); PG8_STAGE(PG8_SA(0, 0), a2, voffA);
            PG8_BAR; PG8_WAIT_L(0); PG8_MMA(1, 0, At, B0); PG8_BAR; PG8_SCHED;
            PG8_STAGE(PG8_SB(0, 1), b2 + hstepB, voffB);
            PG8_WAIT_V(6); PG8_BAR; PG8_MMA(1, 1, At, B1); PG8_BAR;
            PG8_LDB(B0, 1, 0); PG8_SCHED; PG8_LDA(At, 1, 0); PG8_STAGE(PG8_SA(0, 1), a2 + hstepA, voffA);
            PG8_WAIT_L(8); PG8_BAR; PG8_WAIT_L(0); PG8_MMA(0, 0, At, B0); PG8_BAR; PG8_SCHED;
            PG8_LDB(B1, 1, 1); PG8_STAGE(PG8_SB(1, 0), b3, voffB);
            PG8_BAR; PG8_WAIT_L(0); PG8_MMA(0, 1, At, B1); PG8_BAR;
            PG8_LDA(At, 1, 1); PG8_STAGE(PG8_SA(1, 0), a3, voffA);
            PG8_BAR; PG8_WAIT_L(0); PG8_MMA(1, 0, At, B0); PG8_BAR; PG8_SCHED;
            PG8_STAGE(PG8_SB(1, 1), b3 + hstepB, voffB);
            PG8_WAIT_V(6); PG8_BAR; PG8_MMA(1, 1, At, B1); PG8_BAR;
            }
        }
        if constexpr (ALIGN_EPI) { if (wr == 0) PG8_BAR; }
        if constexpr (!Epi::AFTER_DRAIN) { E(acc, cur, wr, wc, fr, fq); S.done(cur); }
        if (!has_next) break;
#pragma unroll
        for (int a = 0; a < 2; ++a)
#pragma unroll
            for (int b = 0; b < 2; ++b)
#pragma unroll
                for (int m = 0; m < 4; ++m)
#pragma unroll
                    for (int n = 0; n < 2; ++n) acc[a][b][m][n] = (f32x4){0.f, 0.f, 0.f, 0.f};
        cur = nxt; cA = nA; cB = nB; ++ui;
        if constexpr (ALIGN_EPI) { if (wr == 1) PG8_BAR; }
    }
    PG8_WAIT_V(0);
    if constexpr (!ALIGN_EPI) { if (wr == 0) PG8_BAR; }
    PG8_BAR;
    if constexpr (Epi::AFTER_DRAIN) { E.fused(acc, cur, wr, wc, fr, fq, lds, wid, lane); S.done(cur); }
#undef PG8_SA
#undef PG8_SB
#undef PG8_STAGE
#undef PG8_LDA
#undef PG8_LDB
#undef PG8_MMA
#undef PG8_WAIT_V
#undef PG8_WAIT_L
#undef PG8_BAR
#undef PG8_SCHED
}
template <class Epi, class Sched, bool ALIGN_EPI = false, bool SP2 = false>
__device__ __forceinline__ void gemm_phase_ga(PG8_LAS unsigned char* lds, const Gemm g, const Sched& S, const Epi& E, const int tid, const unsigned (&g0)[2][2], const unsigned (&g1)[2][2]) {
    unsigned ca0[2] = {g0[0][0], g0[0][1]}, ca1[2] = {g0[1][0], g0[1][1]}; const unsigned na0[2] = {g1[0][0], g1[0][1]}, na1[2] = {g1[1][0], g1[1][1]};
    const int wid = __builtin_amdgcn_readfirstlane(tid >> 6), lane = tid & 63, wr = wid >> 2, wc = wid & 3, fr = lane & 15, fq = lane >> 4;
    int K = g.K; asm volatile("" : "+s"(K));
    const int nt = K / BK;
    unsigned voffA[2], voffB[2];
#pragma unroll
    for (int i = 0; i < 2; ++i) { int R, C; stage_rc(tid * 16 + i * 8192, R, C); const int Rb = Epi::PERM ? ((R & ~31) + perm32(R & 31)) : R;
        voffA[i] = (unsigned)(R * g.lda + C) * 2u; voffB[i] = (unsigned)(Rb * g.ldb + C) * 2u; }
    const size_t kstep = (size_t)(BK * 2);
    const size_t hstepA = (size_t)HALF * g.lda * 2, hstepB = (size_t)HALF * g.ldb * 2;
    const size_t tstepA = 2 * hstepA, tstepB = 2 * hstepB;
    const unsigned ldsw = (unsigned)wid * 1024u;
    const int aoff = lds_byte(wr * 64 + fr, fq * 8), boff = lds_byte(wc * 32 + fr, fq * 8);
#define PG8_SA(b, h) (((b) * 2 + (h)) * HTB)
#define PG8_SB(b, h) ((4 + (b) * 2 + (h)) * HTB)
#define PG8_STAGE(bufoff, gbase, voff) do { _Pragma("unroll") for (int _i = 0; _i < 2; ++_i) \
        __builtin_amdgcn_global_load_lds((const unsigned*)((const char*)(gbase) + (voff)[_i]), (PG8_LAS unsigned*)(lds + (bufoff) + ldsw + _i * 8192), 16, 0, 0); } while (0)
#define PG8_LDA(dst, b, h) do { _Pragma("unroll") for (int m = 0; m < 4; ++m) _Pragma("unroll") for (int k = 0; k < 2; ++k) dst[m][k] = *(const PG8_LAS bf16x8*)(lds + PG8_SA(b, h) + aoff + m * 2048 + k * 1024); } while (0)
#define PG8_LDB(dst, b, h) do { _Pragma("unroll") for (int n = 0; n < 2; ++n) _Pragma("unroll") for (int k = 0; k < 2; ++k) dst[n][k] = *(const PG8_LAS bf16x8*)(lds + PG8_SB(b, h) + boff + n * 2048 + k * 1024); } while (0)
#define PG8_MMA(ai, bj, At, Bt) do { __builtin_amdgcn_s_setprio(1); _Pragma("unroll") for (int m = 0; m < 4; ++m) _Pragma("unroll") for (int n = 0; n < 2; ++n) _Pragma("unroll") for (int k = 0; k < 2; ++k) \
        acc[ai][bj][m][n] = __builtin_amdgcn_mfma_f32_16x16x32_bf16(Bt[n][k], At[m][k], acc[ai][bj][m][n], 0, 0, 0); __builtin_amdgcn_s_setprio(0); } while (0)
#define PG8_WAIT_V(n) asm volatile("s_waitcnt vmcnt(" #n ")" ::: "memory")
#define PG8_WAIT_L(n) asm volatile("s_waitcnt lgkmcnt(" #n ")" ::: "memory")
#define PG8_BAR __builtin_amdgcn_s_barrier()
#define PG8_SCHED __builtin_amdgcn_sched_barrier(0)
    Unit cur, nxt; int ui = 0;
    if (!S.next(0, cur)) return;
    f32x4 acc[2][2][4][2];
#pragma unroll
    for (int a = 0; a < 2; ++a)
#pragma unroll
        for (int b = 0; b < 2; ++b)
#pragma unroll
            for (int m = 0; m < 4; ++m)
#pragma unroll
                for (int n = 0; n < 2; ++n) acc[a][b][m][n] = (f32x4){0.f, 0.f, 0.f, 0.f};
    bf16x8 At[4][2], B0[2][2], B1[2][2];
    const char* cA = (const char*)g.A; const char* cB = (const char*)g.Bt + (size_t)cur.pn * tstepB;
    S.a_ready(cur);
    if constexpr (SP2) {
        PG8_STAGE(PG8_SB(0, 0), cB, voffB); PG8_STAGE(PG8_SB(0, 1), cB + hstepB, voffB); PG8_STAGE(PG8_SA(0, 0), cA, ca0); PG8_STAGE(PG8_SA(0, 1), cA, ca1);
        if (wr == 1) PG8_BAR;
        PG8_WAIT_V(2); PG8_BAR;
        PG8_STAGE(PG8_SB(1, 0), cB + kstep, voffB); PG8_STAGE(PG8_SA(1, 0), cA + kstep, ca0); PG8_STAGE(PG8_SB(1, 1), cB + hstepB + kstep, voffB);
        PG8_WAIT_V(6); PG8_BAR;
    } else {
        PG8_STAGE(PG8_SB(0, 0), cB, voffB); PG8_STAGE(PG8_SA(0, 0), cA, ca0); PG8_STAGE(PG8_SB(0, 1), cB + hstepB, voffB); PG8_STAGE(PG8_SA(0, 1), cA, ca1);
        if (wr == 1) PG8_BAR;
        PG8_WAIT_V(4); PG8_BAR;
        PG8_STAGE(PG8_SB(1, 0), cB + kstep, voffB); PG8_STAGE(PG8_SA(1, 0), cA + kstep, ca0); PG8_STAGE(PG8_SB(1, 1), cB + hstepB + kstep, voffB);
        PG8_WAIT_V(6); PG8_BAR;
    }
    for (;;) {
        const bool has_next = S.next(ui + 1, nxt);
        const char* nA = cA; const char* nB = has_next ? (const char*)g.Bt + (size_t)nxt.pn * tstepB : cB;
        for (int t = 0; t < nt; t += 2) {
            const bool last = (t == nt - 2);
            const unsigned o20[2] = {last ? na0[0] : ca0[0], last ? na0[1] : ca0[1]}, o21[2] = {last ? na1[0] : ca1[0], last ? na1[1] : ca1[1]};
            const char* a1 = cA + (size_t)(t + 1) * kstep;
            const char* a2 = last ? nA : cA + (size_t)(t + 2) * kstep; const char* b2 = last ? nB : cB + (size_t)(t + 2) * kstep;
            const char* a3 = a2 + kstep; const char* b3 = b2 + kstep;
            if (last && has_next) S.a_ready(nxt);
            if constexpr (SP2) {
            PG8_LDB(B0, 0, 0); PG8_LDB(B1, 0, 1); PG8_SCHED; PG8_LDA(At, 0, 0); PG8_STAGE(PG8_SA(1, 1), a1, ca1);
            PG8_WAIT_V(8); PG8_WAIT_L(0); PG8_BAR; PG8_MMA(0, 0, At, B0); PG8_MMA(0, 1, At, B1); PG8_BAR; PG8_SCHED;
            PG8_LDA(At, 0, 1); PG8_STAGE(PG8_SB(0, 0), b2, voffB); PG8_STAGE(PG8_SB(0, 1), b2 + hstepB, voffB); PG8_STAGE(PG8_SA(0, 0), a2, o20);
            PG8_WAIT_V(8); PG8_WAIT_L(0); PG8_BAR; PG8_MMA(1, 0, At, B0); PG8_MMA(1, 1, At, B1); PG8_BAR; PG8_SCHED;
            PG8_LDB(B0, 1, 0); PG8_LDB(B1, 1, 1); PG8_SCHED; PG8_LDA(At, 1, 0); PG8_STAGE(PG8_SA(0, 1), a2, o21);
            PG8_WAIT_V(8); PG8_WAIT_L(0); PG8_BAR; PG8_MMA(0, 0, At, B0); PG8_MMA(0, 1, At, B1); PG8_BAR; PG8_SCHED;
            PG8_LDA(At, 1, 1); PG8_STAGE(PG8_SB(1, 0), b3, voffB); PG8_STAGE(PG8_SB(1, 1), b3 + hstepB, voffB); PG8_STAGE(PG8_SA(1, 0), a3, o20);
            PG8_WAIT_V(8); PG8_WAIT_L(0); PG8_BAR; PG8_MMA(1, 0, At, B0); PG8_MMA(1, 1, At, B1); PG8_BAR; PG8_SCHED;
            } else {
            PG8_LDB(B0, 0, 0); PG8_SCHED; PG8_LDA(At, 0, 0); PG8_STAGE(PG8_SA(1, 1), a1, ca1);
            PG8_WAIT_L(8); PG8_BAR; PG8_WAIT_L(0); PG8_MMA(0, 0, At, B0); PG8_BAR; PG8_SCHED;
            PG8_LDB(B1, 0, 1); PG8_STAGE(PG8_SB(0, 0), b2, voffB);
            PG8_BAR; PG8_WAIT_L(0); PG8_MMA(0, 1, At, B1); PG8_BAR;
            PG8_LDA(At, 0, 1); PG8_STAGE(PG8_SA(0, 0), a2, o20);
            PG8_BAR; PG8_WAIT_L(0); PG8_MMA(1, 0, At, B0); PG8_BAR; PG8_SCHED;
            PG8_STAGE(PG8_SB(0, 1), b2 + hstepB, voffB);
            PG8_WAIT_V(6); PG8_BAR; PG8_MMA(1, 1, At, B1); PG8_BAR;
            PG8_LDB(B0, 1, 0); PG8_SCHED; PG8_LDA(At, 1, 0); PG8_STAGE(PG8_SA(0, 1), a2, o21);
            PG8_WAIT_L(8); PG8_BAR; PG8_WAIT_L(0); PG8_MMA(0, 0, At, B0); PG8_BAR; PG8_SCHED;
            PG8_LDB(B1, 1, 1); PG8_STAGE(PG8_SB(1, 0), b3, voffB);
            PG8_BAR; PG8_WAIT_L(0); PG8_MMA(0, 1, At, B1); PG8_BAR;
            PG8_LDA(At, 1, 1); PG8_STAGE(PG8_SA(1, 0), a3, o20);
            PG8_BAR; PG8_WAIT_L(0); PG8_MMA(1, 0, At, B0); PG8_BAR; PG8_SCHED;
            PG8_STAGE(PG8_SB(1, 1), b3 + hstepB, voffB);
            PG8_WAIT_V(6); PG8_BAR; PG8_MMA(1, 1, At, B1); PG8_BAR;
            }
        }
        if constexpr (ALIGN_EPI) { if (wr == 0) PG8_BAR; }
        if constexpr (!Epi::AFTER_DRAIN) { E(acc, cur, wr, wc, fr, fq); S.done(cur); }
        if (!has_next) break;
#pragma unroll
        for (int a = 0; a < 2; ++a)
#pragma unroll
            for (int b = 0; b < 2; ++b)
#pragma unroll
                for (int m = 0; m < 4; ++m)
#pragma unroll
                    for (int n = 0; n < 2; ++n) acc[a][b][m][n] = (f32x4){0.f, 0.f, 0.f, 0.f};
        cur = nxt; cA = nA; cB = nB; ++ui;
        ca0[0] = na0[0]; ca0[1] = na0[1]; ca1[0] = na1[0]; ca1[1] = na1[1];
        if constexpr (ALIGN_EPI) { if (wr == 1) PG8_BAR; }
    }
    PG8_WAIT_V(0);
    if constexpr (!ALIGN_EPI) { if (wr == 0) PG8_BAR; }
    PG8_BAR;
    if constexpr (Epi::AFTER_DRAIN) { E.fused(acc, cur, wr, wc, fr, fq, lds, wid, lane); S.done(cur); }
#undef PG8_SA
#undef PG8_SB
#undef PG8_STAGE
#undef PG8_LDA
#undef PG8_LDB
#undef PG8_MMA
#undef PG8_WAIT_V
#undef PG8_WAIT_L
#undef PG8_BAR
#undef PG8_SCHED
}
}
#define XB_TMO      128
#define XB_XCNT(j)  (256  + 64 * (j))
#define XB_XSUB(j)  (1280 + 64 * (j))
#define XB_XGEN(j)  (2304 + 64 * (j))
#define XB_TOP      3328
#define XB_TOPGEN   3392
#define XCD_BAR_WORDS 3456
#define XB_SPIN_CAP (1u << 18)

__device__ __forceinline__ unsigned xb_ld(unsigned* p)              { return __hip_atomic_load(p, __ATOMIC_RELAXED, __HIP_MEMORY_SCOPE_AGENT); }
__device__ __forceinline__ unsigned xb_add(unsigned* p, unsigned v) { return __hip_atomic_fetch_add(p, v, __ATOMIC_RELAXED, __HIP_MEMORY_SCOPE_AGENT); }
__device__ __forceinline__ unsigned xb_xcc_id() { return (unsigned)__builtin_amdgcn_s_getreg((3 << 11) | 20) & 0xFu; }
#define XB_SPIN(cond, bar) do { unsigned _sp = 0; while (cond) { __builtin_amdgcn_s_sleep(1); \
    if ((++_sp & 255u) == 0u) { if (xb_ld(&(bar)[XB_TMO])) break; if (_sp > XB_SPIN_CAP) { atomicAdd(&(bar)[XB_TMO], 1u); break; } } } } while (0)

struct XcdBarrier {
    unsigned* bar; unsigned x;
    volatile LAS unsigned* st;
};

__device__ __forceinline__ XcdBarrier xcd_barrier_post(unsigned* bar, volatile LAS unsigned* st) {
    XcdBarrier b; b.bar = bar; b.x = xb_xcc_id(); b.st = st;
    if (threadIdx.x == 0) (void)xb_add(&bar[XB_XCNT(b.x)], 1u);
    return b;
}
__device__ __forceinline__ void xcd_barrier_complete(unsigned* bar, unsigned x, unsigned& nloc, unsigned& nx) {
    const unsigned G = gridDim.x * gridDim.y * gridDim.z;
    unsigned sum, cnt, mine, sp = 0u;
    for (;;) {
        sum = 0u; cnt = 0u; mine = 0u;
#pragma unroll
        for (unsigned j = 0; j < 16; ++j) { const unsigned c = xb_ld(&bar[XB_XCNT(j)]); sum += c; cnt += (c > 0u) ? 1u : 0u; mine = (j == x) ? c : mine; }
        if (sum == G) break;
        __builtin_amdgcn_s_sleep(1);
        if ((++sp & 255u) == 0u) { if (xb_ld(&bar[XB_TMO])) break; if (sp > XB_SPIN_CAP) { atomicAdd(&bar[XB_TMO], 1u); break; } }
    }
    nloc = mine > 0u ? mine : 1u; nx = cnt > 0u ? cnt : 1u;
}

__device__ __forceinline__ void xcd_barrier(const XcdBarrier& b, const bool is_t0) {
    asm volatile("s_waitcnt vmcnt(0)" ::: "memory");
    __syncthreads();
    if (is_t0) {
        unsigned* bar = b.bar;
        __builtin_amdgcn_s_waitcnt(0);
        unsigned nloc = b.st[0], nx = b.st[1];
        if (nloc == 0u) { xcd_barrier_complete(bar, b.x, nloc, nx); b.st[0] = nloc; b.st[1] = nx; }
        const unsigned old = xb_add(&bar[XB_XSUB(b.x)], 1u);
        const unsigned gen = old / nloc;
        if (old + 1u == (gen + 1u) * nloc) {
            __builtin_amdgcn_fence(__ATOMIC_RELEASE, "agent");
            asm volatile("s_waitcnt vmcnt(0)" ::: "memory");
            const unsigned og = xb_add(&bar[XB_TOP], 1u);
            const unsigned tg = og / nx;
            if (og + 1u == (tg + 1u) * nx) xb_add(&bar[XB_TOPGEN], 1u);
            else XB_SPIN(xb_ld(&bar[XB_TOPGEN]) == tg, bar);
            __builtin_amdgcn_fence(__ATOMIC_ACQUIRE, "agent");
            xb_add(&bar[XB_XGEN(b.x)], 1u);
            asm volatile("s_waitcnt vmcnt(0)" ::: "memory");
        } else {
            XB_SPIN(xb_ld(&bar[XB_XGEN(b.x)]) == gen, bar);
            __builtin_amdgcn_fence(__ATOMIC_ACQUIRE, "agent");
            asm volatile("s_waitcnt vmcnt(0)" ::: "memory");
        }
    }
    __syncthreads();
}


namespace pg8 {
struct EpiZ {
    static constexpr bool PERM = true, AFTER_DRAIN = false;
    bf16_t* O; int ldc; float* fcbuf;
    __device__ __forceinline__ void operator()(const f32x4 (&acc)[2][2][4][2], const Unit& u, int wr, int wc, int fr, int fq) const {
        const int row0 = u.pm * BM + wr * 64 + fr, col0 = u.pn * BM + wc * 32 + 8 * fq;
        const bool fcl = (u.pn == 9) && (wc == 1) && (fq == 0);
#pragma unroll
        for (int ai = 0; ai < 2; ++ai)
#pragma unroll
            for (int m = 0; m < 4; ++m) {
                const int row = row0 + ai * HALF + m * 16;
                bf16_t* rowp = O + (size_t)row * ldc + col0;
#pragma unroll
                for (int bj = 0; bj < 2; ++bj) {
                    const f32x4 v0 = acc[ai][bj][m][0], v1 = acc[ai][bj][m][1];
                    u32x4 w; w.x = cvt_pk_bf16(v0[0], v0[1]); w.y = cvt_pk_bf16(v0[2], v0[3]); w.z = cvt_pk_bf16(v1[0], v1[1]); w.w = cvt_pk_bf16(v1[2], v1[3]);
                    *(u32x4*)(rowp + bj * HALF) = w;
                }
                if (fcl) *(f32x4*)(fcbuf + (size_t)row * 4) = acc[ai][0][m][0];
            }
    }
};
struct EpiRowScale {
    static constexpr bool PERM = true, AFTER_DRAIN = false;
    bf16_t* O; int ldc; const float* rs;
    __device__ __forceinline__ void operator()(const f32x4 (&acc)[2][2][4][2], const Unit& u, int wr, int wc, int fr, int fq) const {
        const int row0 = u.pm * BM + wr * 64 + fr, col0 = u.pn * BM + wc * 32 + 8 * fq;
#pragma unroll
        for (int ai = 0; ai < 2; ++ai)
#pragma unroll
            for (int m = 0; m < 4; ++m) {
                const int row = row0 + ai * HALF + m * 16;
                const float s = rs[row];
                bf16_t* rowp = O + (size_t)row * ldc + col0;
#pragma unroll
                for (int bj = 0; bj < 2; ++bj) {
                    const f32x4 v0 = acc[ai][bj][m][0] * s, v1 = acc[ai][bj][m][1] * s;
                    u32x4 w; w.x = cvt_pk_bf16(v0[0], v0[1]); w.y = cvt_pk_bf16(v0[2], v0[3]); w.z = cvt_pk_bf16(v1[0], v1[1]); w.w = cvt_pk_bf16(v1[2], v1[3]);
                    *(u32x4*)(rowp + bj * HALF) = w;
                }
            }
    }
};
struct EpiGU {
    static constexpr bool PERM = true, AFTER_DRAIN = false;
    bf16_t* O;
    __device__ __forceinline__ void operator()(const f32x4 (&acc)[2][2][4][2], const Unit& u, int wr, int wc, int fr, int fq) const {
        const int row0 = u.pm * BM + wr * 64 + fr, f0 = ((u.pn & 1) * BM + wc * 32 + 8 * fq) >> 1;
#pragma unroll
        for (int ai = 0; ai < 2; ++ai)
#pragma unroll
            for (int m = 0; m < 4; ++m) {
                bf16_t* rowp = O + (size_t)(row0 + ai * HALF + m * 16) * 256 + f0;
#pragma unroll
                for (int bj = 0; bj < 2; ++bj) {
                    const f32x4 v0 = acc[ai][bj][m][0], v1 = acc[ai][bj][m][1];
                    const float a0 = v0[0] * __builtin_amdgcn_rcpf(1.f + __expf(-v0[0])) * v0[1], a1 = v0[2] * __builtin_amdgcn_rcpf(1.f + __expf(-v0[2])) * v0[3];
                    const float a2 = v1[0] * __builtin_amdgcn_rcpf(1.f + __expf(-v1[0])) * v1[1], a3 = v1[2] * __builtin_amdgcn_rcpf(1.f + __expf(-v1[2])) * v1[3];
                    typedef unsigned u32x2 __attribute__((ext_vector_type(2)));
                    u32x2 w; w.x = cvt_pk_bf16(a0, a1); w.y = cvt_pk_bf16(a2, a3);
                    *(u32x2*)(rowp + bj * (HALF / 2)) = w;
                }
            }
    }
};
struct EpiPleGate {
    static constexpr bool PERM = true, AFTER_DRAIN = false;
    bf16_t* O; const bf16_t* PP;
    __device__ __forceinline__ void operator()(const f32x4 (&acc)[2][2][4][2], const Unit& u, int wr, int wc, int fr, int fq) const {
        const int row0 = u.pm * BM + wr * 64 + fr, col0 = u.pn * BM + wc * 32 + 8 * fq;
#pragma unroll
        for (int ai = 0; ai < 2; ++ai)
#pragma unroll
            for (int m = 0; m < 4; ++m) {
                const size_t off = (size_t)(row0 + ai * HALF + m * 16) * 1024 + col0;
#pragma unroll
                for (int bj = 0; bj < 2; ++bj) {
                    const f32x4 v0 = acc[ai][bj][m][0], v1 = acc[ai][bj][m][1];
                    const u32x4 pw = *(const u32x4*)(PP + off + bj * HALF);
                    float o[8];
                    o[0] = __uint_as_float(pw.x << 16) * __builtin_amdgcn_rcpf(1.f + __expf(-v0[0])); o[1] = __uint_as_float(pw.x & 0xffff0000u) * __builtin_amdgcn_rcpf(1.f + __expf(-v0[1]));
                    o[2] = __uint_as_float(pw.y << 16) * __builtin_amdgcn_rcpf(1.f + __expf(-v0[2])); o[3] = __uint_as_float(pw.y & 0xffff0000u) * __builtin_amdgcn_rcpf(1.f + __expf(-v0[3]));
                    o[4] = __uint_as_float(pw.z << 16) * __builtin_amdgcn_rcpf(1.f + __expf(-v1[0])); o[5] = __uint_as_float(pw.z & 0xffff0000u) * __builtin_amdgcn_rcpf(1.f + __expf(-v1[1]));
                    o[6] = __uint_as_float(pw.w << 16) * __builtin_amdgcn_rcpf(1.f + __expf(-v1[2])); o[7] = __uint_as_float(pw.w & 0xffff0000u) * __builtin_amdgcn_rcpf(1.f + __expf(-v1[3]));
                    u32x4 w; w.x = cvt_pk_bf16(o[0], o[1]); w.y = cvt_pk_bf16(o[2], o[3]); w.z = cvt_pk_bf16(o[4], o[5]); w.w = cvt_pk_bf16(o[6], o[7]);
                    *(u32x4*)(O + off + bj * HALF) = w;
                }
            }
    }
};
struct EpiDown {
    static constexpr bool PERM = true, AFTER_DRAIN = false;
    bf16_t* O;
    __device__ __forceinline__ void operator()(const f32x4 (&acc)[2][2][4][2], const Unit& u, int wr, int wc, int fr, int fq) const {
        const int row0 = u.pm * BM + wr * 64 + fr, col0 = (u.pn & 3) * BM + wc * 32 + 8 * fq;
#pragma unroll
        for (int ai = 0; ai < 2; ++ai)
#pragma unroll
            for (int m = 0; m < 4; ++m) {
                bf16_t* rowp = O + (size_t)(row0 + ai * HALF + m * 16) * 1024 + col0;
#pragma unroll
                for (int bj = 0; bj < 2; ++bj) {
                    const f32x4 v0 = acc[ai][bj][m][0], v1 = acc[ai][bj][m][1];
                    u32x4 w; w.x = cvt_pk_bf16(v0[0], v0[1]); w.y = cvt_pk_bf16(v0[2], v0[3]); w.z = cvt_pk_bf16(v1[0], v1[1]); w.w = cvt_pk_bf16(v1[2], v1[3]);
                    *(u32x4*)(rowp + bj * HALF) = w;
                }
            }
    }
};
constexpr int XPM = (int)((WS_HS16 - WS_A16) / (256 * 1024 * 2)), XPN = (int)((WS_WGU - WS_WPG) / (256 * 1024 * 2));
static_assert((WS_HS16 - WS_A16) % (256 * 1024 * 2) == 0 && (WS_WGU - WS_WPG) % (256 * 1024 * 2) == 0 && XPM >= 64 && (XPN & 1) == 0, "virtual unit offsets");
struct EpiX {
    static constexpr bool PERM = true, AFTER_DRAIN = false;
    EpiGU gu; EpiPleGate pg;
    __device__ __forceinline__ void operator()(const f32x4 (&acc)[2][2][4][2], const Unit& u, int wr, int wc, int fr, int fq) const {
        if (u.pm >= XPM) { const Unit v{u.pm - XPM, u.pn - XPN}; gu(acc, v, wr, wc, fr, fq); }
        else pg(acc, u, wr, wc, fr, fq);
    }
};
struct XSched {
    const int* tile_e; int nU1, G, vc;
    __device__ __forceinline__ bool next(int i, Unit& u) const {
        if (i >= 2) return false;
        const int g = vc + i * G;
        if (g < nU1) { const int t = g >> 1; u.pm = t + XPM; u.pn = __builtin_amdgcn_readfirstlane(tile_e[t]) * 2 + (g & 1) + XPN; return true; }
        const int k = g - nU1; if (k >= 256) return false;
        u.pm = k >> 2; u.pn = k & 3; return true;
    }
    __device__ __forceinline__ void a_ready(const Unit&) const {}
    __device__ __forceinline__ void done(const Unit&) const {}
};
struct TwoUnits {
    int pm0, pn0, pm1, pn1, n;
    __device__ __forceinline__ bool next(int i, Unit& u) const { if (i >= n) return false; u.pm = i ? pm1 : pm0; u.pn = i ? pn1 : pn0; return true; }
    __device__ __forceinline__ void a_ready(const Unit&) const {}
    __device__ __forceinline__ void done(const Unit&) const {}
};
struct OneUnit {
    int pm, pn;
    __device__ __forceinline__ bool next(int i, Unit& u) const { if (i) return false; u.pm = pm; u.pn = pn; return true; }
    __device__ __forceinline__ void a_ready(const Unit&) const {}
    __device__ __forceinline__ void done(const Unit&) const {}
};
struct GroupSched {
    const int* tile_e; int T, NJ, G, vc;
    __device__ __forceinline__ bool next(int i, Unit& u) const {
        const long L = (long)i * G + vc; if (L >= (long)T * NJ) return false;
        const int t = (int)(L / NJ), j = (int)(L % NJ);
        u.pm = t; u.pn = __builtin_amdgcn_readfirstlane(tile_e[t]) * NJ + j; return true;
    }
    __device__ __forceinline__ void a_ready(const Unit&) const {}
    __device__ __forceinline__ void done(const Unit&) const {}
};
}

template <class Map>
__device__ __forceinline__ void transpose_rows(const Map mp, const float* ks, int nrows_out, int K, bf16* WT, LAS float* scr, int gw, int NGW, int lane) {
    const int nblk = nrows_out / 32, nitems = (K / 64) * nblk;
    const int f = lane & 7, kr = lane >> 3;
    for (int it = gw; it < nitems; it += NGW) {
        const int kb = it / nblk, nb = it % nblk, k0 = 64 * kb, n0 = 32 * nb;
        const float* src; long pitch; float sc; int nl0, nls;
        mp.get4(n0, f, src, pitch, sc, nl0, nls);
        f32x4_t vals[8];
#pragma unroll
        for (int i = 0; i < 8; ++i) vals[i] = src ? *(const f32x4_t*)(src + (size_t)(k0 + kr + 8 * i) * pitch) : (f32x4_t){0.f, 0.f, 0.f, 0.f};
#pragma unroll
        for (int i = 0; i < 8; ++i) {
            const int kk = kr + 8 * i;
            float m = sc; if (ks) m *= ks[k0 + kk];
            scr[kk * 33 + nl0] = vals[i].x * m; scr[kk * 33 + nl0 + nls] = vals[i].y * m; scr[kk * 33 + nl0 + 2 * nls] = vals[i].z * m; scr[kk * 33 + nl0 + 3 * nls] = vals[i].w * m;
        }
        asm volatile("s_waitcnt lgkmcnt(0)" ::: "memory");
        const int c = lane & 7;
#pragma unroll
        for (int j = 0; j < 4; ++j) {
            const int n = (lane >> 3) + 8 * j; const LAS float* s = scr + (8 * c) * 33 + n;
            v4u o; o.x = pk2(s[0 * 33], s[1 * 33]); o.y = pk2(s[2 * 33], s[3 * 33]); o.z = pk2(s[4 * 33], s[5 * 33]); o.w = pk2(s[6 * 33], s[7 * 33]);
            *(v4u*)(WT + (size_t)(n0 + n) * K + k0 + 8 * c) = o;
        }
        asm volatile("s_waitcnt lgkmcnt(0)" ::: "memory");
    }
}
constexpr float LOG2E_W = 1.4426950408889634f;
struct MapIn {
    const float* w;
    __device__ __forceinline__ void get(int n, const float*& src, long& pitch, float& sc) const {
        int c;
        if (n < 1152) c = n;
        else if (n < Z_CKV) c = OFF_QC + (n - Z_QC);
        else if (n < Z_CQ) c = OFF_CKV + (n - Z_CKV);
        else if (n < Z_KR) c = OFF_CQ + (n - Z_CQ);
        else if (n < Z_FC) c = OFF_KR + (n - Z_KR);
        else if (n < Z_FC + 4) c = OFF_FC + (n - Z_FC);
        else c = -1;
        src = c >= 0 ? w + c : nullptr; pitch = D_IN;
        sc = n < Z_KA ? 0.17677669529663687f * LOG2E_W : ((n >= Z_QC && n < Z_KC) ? 0.125f * LOG2E_W : 1.f);
    }
    __device__ __forceinline__ void get4(int n0, int f, const float*& src, long& pitch, float& sc, int& nl0, int& nls) const { get(n0 + 4 * f, src, pitch, sc); nl0 = 4 * f; nls = 1; }
};
struct MapPlain {
    const float* w; int N, nvalid; float scale;
    __device__ __forceinline__ void get(int n, const float*& src, long& pitch, float& sc) const { src = n < nvalid ? w + n : nullptr; pitch = N; sc = scale; }
    __device__ __forceinline__ void get4(int n0, int f, const float*& src, long& pitch, float& sc, int& nl0, int& nls) const { get(n0 + 4 * f, src, pitch, sc); nl0 = 4 * f; nls = 1; }
};

struct MapGU {
    const float* wg; const float* wu;
    __device__ __forceinline__ void get(int n, const float*& src, long& pitch, float& sc) const {
        const int e = n >> 9, r = n & 511, f = r >> 1;
        const long dlt = (r & 1) ? (long)(wu - wg) : 0l;
        src = wg + dlt + (size_t)e * 1024 * 256 + f; pitch = 256; sc = 1.f;
    }
    __device__ __forceinline__ void get4(int n0, int f, const float*& src, long& pitch, float& sc, int& nl0, int& nls) const {
        const int e = n0 >> 9, f0 = (n0 & 511) >> 1;
        const long dlt = (f >> 2) ? (long)(wu - wg) : 0l;
        src = wg + dlt + (size_t)e * 1024 * 256 + f0 + 4 * (f & 3); pitch = 256; sc = 1.f; nl0 = 8 * (f & 3) + (f >> 2); nls = 2;
    }
};
struct MapD {
    const float* wd;
    __device__ __forceinline__ void get(int n, const float*& src, long& pitch, float& sc) const {
        const int e = n >> 10, c = n & 1023;
        src = wd + (size_t)e * 256 * 1024 + c; pitch = 1024; sc = 1.f;
    }
    __device__ __forceinline__ void get4(int n0, int f, const float*& src, long& pitch, float& sc, int& nl0, int& nls) const { get(n0 + 4 * f, src, pitch, sc); nl0 = 4 * f; nls = 1; }
};

struct AttnP {
    const bf16* z16; const bf16* qb16; const bf16* kvb16; const bf16* krr16; const float* cum; const float* cosT; const float* sinT;
    const int* pos; bf16* mixed16; const float* lq1; const float* lk1; const float* lq2; const float* lk2; const float* gdiff; int layer; unsigned* prof; const int* tpmax; float lam, lam_init;
};
typedef short bf16x8_t __attribute__((ext_vector_type(8)));
typedef float f32x16_t __attribute__((ext_vector_type(16)));
typedef short s16x4_t __attribute__((ext_vector_type(4)));
typedef float f32x2_t __attribute__((ext_vector_type(2)));
typedef __bf16 bf16x2_t __attribute__((ext_vector_type(2)));
__device__ __forceinline__ unsigned cvtpk(float lo, float hi) { f32x2_t v = {lo, hi}; bf16x2_t b = __builtin_convertvector(v, bf16x2_t); return __builtin_bit_cast(unsigned, b); }
__device__ __forceinline__ int crow(int r, int hi) { return (r & 3) + 8 * (r >> 2) + 4 * hi; }
__device__ __forceinline__ s16x4_t vtr(const LAS unsigned char* p) { typedef short v4i16_t __attribute__((ext_vector_type(4))); return __builtin_bit_cast(s16x4_t, __builtin_amdgcn_ds_read_tr16_b64_v4i16((LAS v4i16_t*)p)); }
constexpr float LOG2E = 1.4426950408889634f;

__device__ __forceinline__ float xhalf_max(float m) { auto rr = __builtin_amdgcn_permlane32_swap(__float_as_uint(m), __float_as_uint(m), false, false); return __builtin_fmaxf(__uint_as_float(rr[0]), __uint_as_float(rr[1])); }
__device__ __forceinline__ float xhalf_sum(float m) { auto rr = __builtin_amdgcn_permlane32_swap(__float_as_uint(m), __float_as_uint(m), false, false); return __uint_as_float(rr[0]) + __uint_as_float(rr[1]); }
__device__ __forceinline__ float max3f(float a, float b, float c) { return __builtin_fmaxf(__builtin_fmaxf(a, b), c); }
__device__ __forceinline__ void glds16(const void* gsrc, unsigned lds_dst) { unsigned keep;
    asm volatile("s_mov_b32 %0, m0\n\ts_mov_b32 m0, %2\n\ts_nop 0\n\tglobal_load_lds_dwordx4 %1, off\n\ts_mov_b32 m0, %0" : "=&s"(keep) : "v"(gsrc), "s"(lds_dst) : "memory"); }
__device__ __forceinline__ void glds4(const void* gsrc, unsigned lds_dst) { unsigned keep;
    asm volatile("s_mov_b32 %0, m0\n\ts_mov_b32 m0, %2\n\ts_nop 0\n\tglobal_load_lds_dword %1, off\n\ts_mov_b32 m0, %0" : "=&s"(keep) : "v"(gsrc), "s"(lds_dst) : "memory"); }
template <int MODE> __device__ __forceinline__ void attn_unit(const AttnP& p, int b, int h, int qblk, LAS unsigned char* lds, const int tid_in) {
    int tid = tid_in * 64 + lane_id_now(); asm volatile("" : "+v"(tid));
#ifdef PROF_SEL
    const unsigned long long pu0 = __builtin_amdgcn_s_memrealtime(); unsigned long long pt0 = 0, pl0 = 0, pacc_c = 0, pacc_b = 0;
#define PROF_T(acc) do { const unsigned long long t_ = __builtin_amdgcn_s_memrealtime(); acc += t_ - pt0; pt0 = t_; } while (0)
#else
#define PROF_T(acc) do {} while (0)
#endif
    constexpr int NF = MODE == 0 ? 2 : (MODE == 1 ? 6 : 4);
    constexpr int NC = MODE == 1 ? 12 : 8;
    constexpr int NCX = MODE == 1 ? 0 : 2;
    constexpr int KB = (NC + NCX) * 1024, KBUF = KB + 512;
    constexpr int VOFF = 3 * KBUF;
    const int lane = tid & 63, w = __builtin_amdgcn_readfirstlane(tid >> 6), r32 = lane & 31, hi = lane >> 5;
    const int map = MODE == 0 ? (w >> 2) : 0, qg = MODE == 0 ? (w & 3) : w;
    const int c = MODE == 0 ? qblk * 2 + (qg >> 1) : qblk * 4 + (qg >> 1);
    const int ntiles = MODE == 0 ? qblk * 2 + 2 : qblk * 4 + 4;
    const long tok0 = (long)b * SEQ;
    const int q0u = MODE == 0 ? qblk * 128 : qblk * 256;
    const long qrow = tok0 + q0u + qg * 32 + r32;
    float slope2 = 0.f, sq = 0.f, refv = 0.f; int qpmin = 0;
    const bf16* k1src = MODE == 0 ? p.z16 + (tok0 + lane) * ZP + Z_KA + h * 64 + w * 8 : (MODE == 2 ? p.z16 + (tok0 + lane) * ZP + Z_KC + h * 64 + w * 8 : p.kvb16 + (tok0 + lane) * NKVB + h * 128 + w * 8);
    const bf16* k2src = p.krr16 + (tok0 + lane) * 32 + (w & 3) * 8;
    const bf16* vsrc = (MODE == 0 ? p.z16 + Z_VA + h * 64 : (MODE == 1 ? p.kvb16 + h * 128 + 64 : p.z16 + Z_VC + h * 64)) + (tok0 + (w & 3) * 16 + (lane >> 2)) * (MODE == 1 ? NKVB : ZP) + ((w >> 2) * 4 + (lane & 3)) * 8;
    const void* bsrc = MODE == 0 ? (const void*)(p.pos + tok0 + lane) : (const void*)(p.cum + (tok0 + lane) * 4 + h);
    const unsigned lbase = (unsigned)(size_t)lds;
    const int tpv = MODE == 0 ? p.tpmax[b * 32 + (lane & 31)] : 0;
    constexpr int DPT = 3;
    auto issue = [&](int kt_) {
        const int kt = kt_ < ntiles ? kt_ : ntiles - 1; const int slot = kt_ % 3;
        const unsigned ks = __builtin_amdgcn_readfirstlane(lbase + slot * KBUF), vs = __builtin_amdgcn_readfirstlane(lbase + VOFF + slot * 8192 + w * 1024);
        glds16(k1src + (long)kt * 64 * (MODE == 1 ? NKVB : ZP), ks + w * 1024);
        if (MODE == 1) glds16(k2src + (long)kt * 64 * 32, ks + (8 + (w & 3)) * 1024);
        glds16(vsrc + (long)kt * 64 * (MODE == 1 ? NKVB : ZP), vs);
        if (MODE == 0) glds4((const char*)bsrc + (long)kt * 64 * 4, ks + KB + 256);
        if (MODE == 2) glds4((const char*)bsrc + (long)kt * 64 * 16, ks + KB + 256);
    };
    auto convert_bias = [&](int kt_) {
        if (MODE != 1 && tid < 64) {
            LAS unsigned char* sp = lds + (kt_ % 3) * KBUF;
            const unsigned raw = *(LAS unsigned*)(sp + KB + 256 + tid * 4);
            const float bv = MODE == 0 ? slope2 * ((float)(int)raw - refv) : (refv - __uint_as_float(raw)) * LOG2E;
            *(LAS float*)(sp + KB + tid * 4) = bv;
            const unsigned e0 = f2bf(bv); const float r1 = bv - __uint_as_float(e0 << 16);
            const unsigned e1 = f2bf(r1); const float r2 = r1 - __uint_as_float(e1 << 16);
            const unsigned e2 = f2bf(r2);
            v4u ex; ex.x = e0 | (e1 << 16); ex.y = e2; ex.z = 0u; ex.w = 0u;
            *(LAS v4u*)(sp + NC * 1024 + tid * 16) = ex;
        }
    };
    issue(0); issue(1);
    bf16x8_t qf[NF];
    {
        const bf16* qsrc = MODE == 0 ? p.z16 + qrow * ZP + Z_QA + h * 64 + map * 32 : (MODE == 1 ? p.qb16 + qrow * NQBP + h * 96 : p.z16 + qrow * ZP + Z_QC + h * 64);
#pragma unroll
        for (int i = 0; i < NF; ++i) qf[i] = *(const bf16x8_t*)(qsrc + i * 16 + hi * 8);
    }
    if (MODE == 1) {
        const float4 c0 = *(const float4*)(p.cosT + qrow * 16 + hi * 8), c1 = *(const float4*)(p.cosT + qrow * 16 + hi * 8 + 4);
        const float4 s0 = *(const float4*)(p.sinT + qrow * 16 + hi * 8), s1 = *(const float4*)(p.sinT + qrow * 16 + hi * 8 + 4);
        const float cs[8] = {c0.x, c0.y, c0.z, c0.w, c1.x, c1.y, c1.z, c1.w}, sn[8] = {s0.x, s0.y, s0.z, s0.w, s1.x, s1.y, s1.z, s1.w};
        float n1[8], n2[8];
#pragma unroll
        for (int j = 0; j < 8; ++j) {
            const float x1 = __uint_as_float((unsigned)(unsigned short)qf[NF - 2][j] << 16), x2 = __uint_as_float((unsigned)(unsigned short)qf[NF - 1][j] << 16);
            n1[j] = x1 * cs[j] - x2 * sn[j]; n2[j] = x2 * cs[j] + x1 * sn[j];
        }
        v4u a, bb;
        a.x = cvtpk(n1[0], n1[1]); a.y = cvtpk(n1[2], n1[3]); a.z = cvtpk(n1[4], n1[5]); a.w = cvtpk(n1[6], n1[7]);
        bb.x = cvtpk(n2[0], n2[1]); bb.y = cvtpk(n2[2], n2[3]); bb.z = cvtpk(n2[4], n2[5]); bb.w = cvtpk(n2[6], n2[7]);
        qf[NF - 2] = __builtin_bit_cast(bf16x8_t, a); qf[NF - 1] = __builtin_bit_cast(bf16x8_t, bb);
    }
    if (MODE == 0) {
        slope2 = exp2f(-8.0f * (float)(h + 1) / 6.0f) * LOG2E;
        const int pref = p.pos[tok0 + q0u]; refv = (float)pref;
        const int pq = p.pos[qrow]; sq = slope2 * (float)(pq - pref);
        int mn = pq;
#pragma unroll
        for (int o_ = 1; o_ < 64; o_ <<= 1) mn = min(mn, __builtin_amdgcn_ds_bpermute((lane ^ o_) << 2, mn));
        qpmin = __builtin_amdgcn_readfirstlane(mn);
    }
    if (MODE == 2) refv = p.cum[(tok0 + q0u) * 4 + h];
    f32x16_t o[2], negm;
    float mref = 0.f, lsum = 0.f; bool first = true;
#pragma unroll
    for (int r = 0; r < 16; ++r) { o[0][r] = 0.f; o[1][r] = 0.f; negm[r] = 0.f; }
    bf16x8_t qext;
    { v4u q1; q1.x = hi == 0 ? 0x3f803f80u : 0u; q1.y = hi == 0 ? 0x00003f80u : 0u; q1.z = 0u; q1.w = 0u; qext = __builtin_bit_cast(bf16x8_t, q1); }
    LAS unsigned char* const kfp = lds + (map * NF * 2 + hi) * 1024 + r32 * 16;
    LAS unsigned char* const kxp = lds + (NC + hi) * 1024 + r32 * 16;
    LAS unsigned char* const bfp = lds + KB + 16 * hi;
    LAS unsigned char* const vfp = lds + VOFF + (4 * hi + ((lane & 15) >> 2)) * 64 + ((lane >> 4) & 1) * 32 + (lane & 3) * 8;
    auto compute_s = [&](const int kt, const int par, f32x16_t& p0, f32x16_t& p1) {
        constexpr int KG = NF;
        bf16x8_t kf0[KG], kf1[KG], kx0, kx1;
#pragma unroll
        for (int d0 = 0; d0 < KG; ++d0) { kf0[d0] = *(const LAS bf16x8_t*)(kfp + par * KBUF + d0 * 2048); kf1[d0] = *(const LAS bf16x8_t*)(kfp + par * KBUF + d0 * 2048 + 512); }
        if (MODE != 1) { kx0 = *(const LAS bf16x8_t*)(kxp + par * KBUF); kx1 = *(const LAS bf16x8_t*)(kxp + par * KBUF + 512); }
        __builtin_amdgcn_sched_barrier(0);
        if (MODE != 1) {
            p0 = __builtin_amdgcn_mfma_f32_32x32x16_bf16(kx0, qext, negm, 0, 0, 0);
            p1 = __builtin_amdgcn_mfma_f32_32x32x16_bf16(kx1, qext, negm, 0, 0, 0);
        }
#pragma unroll
        for (int d0 = 0; d0 < KG; ++d0) {
            p0 = __builtin_amdgcn_mfma_f32_32x32x16_bf16(kf0[d0], qf[d0], (MODE == 1 && d0 == 0) ? negm : p0, 0, 0, 0);
            p1 = __builtin_amdgcn_mfma_f32_32x32x16_bf16(kf1[d0], qf[d0], (MODE == 1 && d0 == 0) ? negm : p1, 0, 0, 0);
        }
        if (NF > KG) {
#pragma unroll
            for (int d0 = KG; d0 < NF; ++d0) { kf0[d0 - KG] = *(const LAS bf16x8_t*)(kfp + par * KBUF + d0 * 2048); kf1[d0 - KG] = *(const LAS bf16x8_t*)(kfp + par * KBUF + d0 * 2048 + 512); }
#pragma unroll
            for (int d0 = KG; d0 < NF; ++d0) {
                p0 = __builtin_amdgcn_mfma_f32_32x32x16_bf16(kf0[d0 - KG], qf[d0], p0, 0, 0, 0);
                p1 = __builtin_amdgcn_mfma_f32_32x32x16_bf16(kf1[d0 - KG], qf[d0], p1, 0, 0, 0);
            }
        }
        if (MODE == 0) {
            if (kt == c || __builtin_amdgcn_readlane(tpv, kt) > qpmin) {
#pragma unroll
                for (int g = 0; g < 4; ++g) {
                    const f32x4_t b0 = *(const LAS f32x4_t*)(bfp + par * KBUF + 32 * g), b1 = *(const LAS f32x4_t*)(bfp + par * KBUF + 128 + 32 * g);
                    p0[4 * g] += 2.f * fminf(sq - b0.x, 0.f); p0[4 * g + 1] += 2.f * fminf(sq - b0.y, 0.f); p0[4 * g + 2] += 2.f * fminf(sq - b0.z, 0.f); p0[4 * g + 3] += 2.f * fminf(sq - b0.w, 0.f);
                    p1[4 * g] += 2.f * fminf(sq - b1.x, 0.f); p1[4 * g + 1] += 2.f * fminf(sq - b1.y, 0.f); p1[4 * g + 2] += 2.f * fminf(sq - b1.z, 0.f); p1[4 * g + 3] += 2.f * fminf(sq - b1.w, 0.f);
                }
            }
        }
        if (MODE == 2) {
            if (kt == c) {
                const int qi = (qg & 1) * 32 + r32;
#pragma unroll
                for (int r = 0; r < 16; ++r) { const int kv = crow(r, hi); if (kv > qi) p0[r] = -INFINITY; if (kv + 32 > qi) p1[r] = -INFINITY; }
            }
        }
    };
    auto softmax_pv = [&](const int par, f32x16_t& p0, f32x16_t& p1) {
        constexpr int VE = MODE == 1 ? 4 : 8;
        s16x4_t vlo[8], vhi[8];
#pragma unroll
        for (int i = 0; i < VE; ++i) { vlo[i] = vtr(vfp + par * 8192 + (i & 1) * 4096 + (i >> 1) * 1024); vhi[i] = vtr(vfp + par * 8192 + (i & 1) * 4096 + (i >> 1) * 1024 + 512); }
        __builtin_amdgcn_sched_barrier(0);
        float tm0 = max3f(p0[0], p0[1], p0[2]), tm1 = max3f(p1[0], p1[1], p1[2]);
#pragma unroll
        for (int r = 3; r < 15; r += 2) { tm0 = max3f(tm0, p0[r], p0[r + 1]); tm1 = max3f(tm1, p1[r], p1[r + 1]); }
        float tmax = max3f(tm0, tm1, p0[15]); tmax = __builtin_fmaxf(tmax, p1[15]);
        tmax = xhalf_max(tmax);
        if (first || __any(tmax > 8.0f)) {
            const float dl = first ? tmax : __builtin_fmaxf(tmax, 0.f);
            mref += dl;
            const float f = first ? 1.f : __builtin_amdgcn_exp2f(-dl);
            lsum *= f;
#pragma unroll
            for (int r = 0; r < 16; ++r) { o[0][r] *= f; o[1][r] *= f; p0[r] -= dl; p1[r] -= dl; negm[r] = -mref; }
            first = false;
        }
        float ls0 = 0.f, ls1 = 0.f;
#pragma unroll
        for (int r = 0; r < 16; ++r) { p0[r] = __builtin_amdgcn_exp2f(p0[r]); p1[r] = __builtin_amdgcn_exp2f(p1[r]); ls0 += p0[r]; ls1 += p1[r]; }
        lsum += ls0 + ls1;
        bf16x8_t pa[4];
#pragma unroll
        for (int ks = 0; ks < 4; ++ks) {
            v4u wv;
            if (ks < 2) { wv.x = cvtpk(p0[8 * ks + 0], p0[8 * ks + 1]); wv.y = cvtpk(p0[8 * ks + 2], p0[8 * ks + 3]); wv.z = cvtpk(p0[8 * ks + 4], p0[8 * ks + 5]); wv.w = cvtpk(p0[8 * ks + 6], p0[8 * ks + 7]); }
            else { wv.x = cvtpk(p1[8 * (ks - 2) + 0], p1[8 * (ks - 2) + 1]); wv.y = cvtpk(p1[8 * (ks - 2) + 2], p1[8 * (ks - 2) + 3]); wv.z = cvtpk(p1[8 * (ks - 2) + 4], p1[8 * (ks - 2) + 5]); wv.w = cvtpk(p1[8 * (ks - 2) + 6], p1[8 * (ks - 2) + 7]); }
            pa[ks] = __builtin_bit_cast(bf16x8_t, wv);
        }
#pragma unroll
        for (int i = VE; i < 8; ++i) { vlo[i] = vtr(vfp + par * 8192 + (i & 1) * 4096 + (i >> 1) * 1024); vhi[i] = vtr(vfp + par * 8192 + (i & 1) * 4096 + (i >> 1) * 1024 + 512); }
#pragma unroll
        for (int ks = 0; ks < 4; ++ks)
#pragma unroll
            for (int blk = 0; blk < 2; ++blk) {
                const s16x4_t lo = vlo[ks * 2 + blk], hi4 = vhi[ks * 2 + blk];
                const bf16x8_t vf = {lo[0], lo[1], lo[2], lo[3], hi4[0], hi4[1], hi4[2], hi4[3]};
                o[blk] = __builtin_amdgcn_mfma_f32_32x32x16_bf16(vf, pa[ks], o[blk], 0, 0, 0);
            }
    };
    if (MODE != 1 && tid < 192) *(LAS v4u*)(lds + (tid >> 6) * KBUF + (NC + 1) * 1024 + (tid & 63) * 16) = (v4u){0u, 0u, 0u, 0u};
    f32x16_t pA0, pA1;
    { int tpu = tpv; asm volatile("" : "+v"(tpu)); }
    asm volatile("s_waitcnt vmcnt(0)" ::: "memory");
    convert_bias(0); convert_bias(1);
    asm volatile("s_waitcnt lgkmcnt(0)\n\ts_barrier" ::: "memory");
#ifdef PROF_SEL
    pl0 = __builtin_amdgcn_s_memrealtime();
#endif
#pragma unroll 1
    for (int kt = 0; kt < ntiles; ++kt) {
#ifdef PROF_SEL
        pt0 = __builtin_amdgcn_s_memrealtime();
#endif
        issue(kt + 2);
        if (kt <= c) { const int slot = kt % 3; compute_s(kt, slot, pA0, pA1); softmax_pv(slot, pA0, pA1); }
        asm volatile("s_waitcnt vmcnt(3)" ::: "memory");
        convert_bias(kt + 1);
        PROF_T(pacc_c);
        asm volatile("s_waitcnt lgkmcnt(0)\n\ts_barrier" ::: "memory");
        PROF_T(pacc_b);
    }
    asm volatile("s_waitcnt vmcnt(0)\n\ts_barrier" ::: "memory");
#ifdef PROF_SEL
    const unsigned long long pl1 = __builtin_amdgcn_s_memrealtime();
#endif
    const float inv = 1.f / xhalf_sum(lsum);
    int tid2 = tid_in * 64 + lane_id_now(); asm volatile("" : "+v"(tid2));
    const int lane2 = tid2 & 63, hi2 = lane2 >> 5, qg2 = MODE == 0 ? ((tid2 >> 6) & 3) : (tid2 >> 6);
    const long qrow2 = tok0 + q0u + qg2 * 32 + (lane2 & 31);
    bf16* op = p.mixed16 + qrow2 * D_MODEL + (MODE == 0 ? 0 : (MODE == 1 ? 384 : 768)) + h * 64;
    if (MODE == 0) {
        LAS float* xb = (LAS float*)lds + qg2 * 2048 + lane2;
        if (map == 1) {
#pragma unroll
            for (int blk = 0; blk < 2; ++blk)
#pragma unroll
                for (int r = 0; r < 16; ++r) xb[(blk * 16 + r) * 64] = o[blk][r] * inv;
        }
        __syncthreads();
        if (map == 0) {
            const float lam_init = p.lam_init, lam = p.lam;
            float ss = 0.f;
#pragma unroll
            for (int blk = 0; blk < 2; ++blk)
#pragma unroll
                for (int r = 0; r < 16; ++r) { const float v = o[blk][r] * inv - lam * xb[(blk * 16 + r) * 64]; o[blk][r] = v; ss = fmaf(v, v, ss); }
            ss = xhalf_sum(ss);
            const float rr = rsqrtf(ss * (1.f / 64.f) + RMS_EPS) * (1.f - lam_init);
#pragma unroll
            for (int blk = 0; blk < 2; ++blk)
#pragma unroll
                for (int g = 0; g < 4; ++g) {
                    const int d = 32 * blk + 8 * g + 4 * hi2;
                    const float4 gv = *(const float4*)(p.gdiff + d);
                    v2u wv; wv.x = cvtpk(o[blk][4 * g] * rr * gv.x, o[blk][4 * g + 1] * rr * gv.y); wv.y = cvtpk(o[blk][4 * g + 2] * rr * gv.z, o[blk][4 * g + 3] * rr * gv.w);
                    *(v2u*)(op + d) = wv;
                }
        }
        __syncthreads();
    } else {
#pragma unroll
        for (int blk = 0; blk < 2; ++blk)
#pragma unroll
            for (int g = 0; g < 4; ++g) {
                const int d = 32 * blk + 8 * g + 4 * hi2;
                v2u wv; wv.x = cvtpk(o[blk][4 * g] * inv, o[blk][4 * g + 1] * inv); wv.y = cvtpk(o[blk][4 * g + 2] * inv, o[blk][4 * g + 3] * inv);
                *(v2u*)(op + d) = wv;
            }
    }
#ifdef PROF_SEL
    if (p.layer == 0 && blockIdx.x == 7 && w == PROF_WAVE && lane == 0) {
        unsigned* pw = p.prof; const unsigned long long pu1 = __builtin_amdgcn_s_memrealtime();
        atomicAdd(pw + 0, (unsigned)(pu1 - pu0)); atomicAdd(pw + 1, (unsigned)(pl1 - pl0)); atomicAdd(pw + 2, (unsigned)pacc_c); atomicAdd(pw + 3, (unsigned)pacc_b);
        atomicAdd(pw + 4, (unsigned)ntiles * 100u); atomicAdd(pw + 5, 10000u); atomicAdd(pw + 6, (unsigned)(c + 1) * 100u);
    }
#endif
}

typedef const __attribute__((address_space(4))) char* kargp_t;
__device__ __forceinline__ kargp_t karg_base() { kargp_t p = (kargp_t)__builtin_amdgcn_kernarg_segment_ptr(); asm volatile("" : "+s"(p)); return p; }
#define KARG(i) (*(const void* const __attribute__((address_space(4)))*)(kp + 8 * (i)))
#define KOUT (*(float* const __attribute__((address_space(4)))*)(kp + 224))
#define KWS (*(unsigned char* const __attribute__((address_space(4)))*)(kp + 232))
__device__ __forceinline__ void convert_layer_weights(const Args& a, int l, unsigned char* ws, LAS float* scr, int gw, int NGW, int lane) {
    const kargp_t kp = karg_base();
    const float* w_in = (const float*)KARG(3) + (size_t)l * D_MODEL * D_IN;
    const float* w_uq = (const float*)KARG(4) + (size_t)l * 256 * NQB;
    const float* w_ukv = (const float*)KARG(5) + (size_t)l * 128 * NKVB;
    const float* g_cq = (const float*)KARG(6) + l * 256;
    const float* g_ckv = (const float*)KARG(7) + l * 128;
    const float* w_out = (const float*)KARG(14) + (size_t)l * 1024 * 1024;
    transpose_rows(MapIn{w_in}, nullptr, ZP, 1024, (bf16*)(ws + WS_WIN), scr, gw, NGW, lane);
    transpose_rows(MapPlain{w_uq, NQB, NQB, 0.10206207261596575f * LOG2E_W}, g_cq, NQBP, 256, (bf16*)(ws + WS_WUQ), scr, gw, NGW, lane);
    transpose_rows(MapPlain{w_ukv, NKVB, NKVB, 1.f}, g_ckv, NKVB, 128, (bf16*)(ws + WS_WUKV), scr, gw, NGW, lane);
    transpose_rows(MapPlain{w_out, 1024, 1024, 1.f}, nullptr, 1024, 1024, (bf16*)(ws + WS_WOUT), scr, gw, NGW, lane);
    transpose_rows(MapPlain{(const float*)KARG(24) + (size_t)l * 1024 * 1024, 1024, 1024, 1.f}, nullptr, 1024, 1024, (bf16*)(ws + WS_WPG), scr, gw, NGW, lane);
    transpose_rows(MapPlain{(const float*)KARG(25) + (size_t)l * 256 * 1024, 1024, 1024, 1.f}, nullptr, 1024, 256, (bf16*)(ws + WS_WPP), scr, gw, NGW, lane);
    transpose_rows(MapGU{(const float*)KARG(21) + (size_t)l * 32 * 1024 * 256, (const float*)KARG(22) + (size_t)l * 32 * 1024 * 256}, nullptr, 32 * 512, 1024, (bf16*)(ws + WS_WGU), scr, gw, NGW, lane);
    transpose_rows(MapD{(const float*)KARG(23) + (size_t)l * 32 * 256 * 1024}, nullptr, 32 * 1024, 256, (bf16*)(ws + WS_WD), scr, gw, NGW, lane);
}

__device__ __forceinline__ void expert_prefix(const unsigned* cnt, LAS int* xs, int tid) {
    if (tid < 64) {
        const int pc = tid < 32 ? (((int)cnt[tid * 64] + 255) & ~255) : 0;
        int inc = pc;
#pragma unroll
        for (int o = 1; o < 32; o <<= 1) { const int n = __shfl_up(inc, o); if ((tid & 63) >= o) inc += n; }
        if (tid < 32) xs[tid] = inc - pc;
        if (tid == 31) xs[32] = inc;
    }
}
constexpr int LDS_MISC = 147456;
constexpr int PH_PER_LAYER = 9, NPH = 1 + DEPTH * PH_PER_LAYER;
template <int PH, bool DUMMY = false> __device__ __forceinline__ void run_phase(const Args& a, unsigned char* lds_raw, const int wave_s) {
    float* sm = (float*)lds_raw;
    const kargp_t kp = karg_base();
    const int G = gridDim.x, NGW = G * 8, NGT = G * NTHREADS;
    unsigned char* ws = KWS;
    const float* x0 = (const float*)KARG(0);
    const float* pin = (const float*)KARG(1);
    const int* pos = (const int*)KARG(2);
    float* cosT = (float*)(ws + WS_COS); float* sinT = (float*)(ws + WS_SIN);
    bf16* a16 = (bf16*)(ws + WS_A16); bf16* z16 = (bf16*)(ws + WS_Z16); bf16* qb16 = (bf16*)(ws + WS_QB16); bf16* kvb16 = (bf16*)(ws + WS_KVB16);
    bf16* krr16 = (bf16*)(ws + WS_KRR16); float* fcbuf = (float*)(ws + WS_FC); float* cum = (float*)(ws + WS_CUM); float* logf = (float*)(ws + WS_LOGF);
    float* rq = (float*)(ws + WS_RQ); float* rkv = (float*)(ws + WS_RKV);
    bf16* mixed16 = (bf16*)(ws + WS_MIXED16); bf16* mix16 = (bf16*)(ws + WS_MIX16);
    bf16* hs16 = (bf16*)(ws + WS_HS16); bf16* act16 = (bf16*)(ws + WS_ACT16); bf16* outs16 = (bf16*)(ws + WS_OUTS16); bf16* ple16 = (bf16*)(ws + WS_PLE16); bf16* pp16 = (bf16*)(ws + WS_PP16); bf16* p16 = (bf16*)(ws + WS_P16);
    int* ids = (int*)(ws + WS_RT + RT_IDS); float* wts = (float*)(ws + WS_RT + RT_WTS); int* rank = (int*)(ws + WS_RT + RT_RANK);
    int* etok = (int*)(ws + WS_ETOK);
    unsigned* ctl = (unsigned*)(ws + WS_CTL);

        int tid = wave_s * 64 + lane_id_now(); asm volatile("" : "+v"(tid));
        const int lane = tid & 63, wave = __builtin_amdgcn_readfirstlane(tid >> 6);
        const int gw = blockIdx.x * 8 + wave, gtid = blockIdx.x * NTHREADS + tid;
        LAS float* scr = (LAS float*)((LAS unsigned char*)lds_raw + wave * 16384);
        if constexpr (PH == 0) {
            if (blockIdx.x == 0) for (int i = tid; i < 16384; i += NTHREADS) ctl[i] = 0u;
            for (int i = gtid; i < NTOK * 16; i += NGT) {
                const int tk = i >> 4, j = i & 15;
                const int j4 = j >> 2, jr = j & 3;
                const double inv = (j4 == 0 ? 1.0 : (j4 == 1 ? 0.1 : (j4 == 2 ? 0.01 : 0.001))) * (jr == 0 ? 1.0 : (jr == 1 ? 0.5623413251903491 : (jr == 2 ? 0.31622776601683794 : 0.1778279410038923)));
                const double ang = (double)pos[tk] * inv;
                const double k = rint(ang * 0.15915494309189535);
                const double r = fma(-k, 6.283185307179586, ang) - k * 2.4492935982947064e-16;
                cosT[i] = cosf((float)r); sinT[i] = sinf((float)r);
            }
            auto cvt_stream = [&](const float* sp, bf16* dp, int n8) {
                for (int i = gtid; i < n8; i += 4 * NGT) {
                    f32x4_t v[8];
#pragma unroll
                    for (int u = 0; u < 4; ++u) { v[2 * u] = *(const f32x4_t*)(sp + (size_t)(i + u * NGT) * 8); v[2 * u + 1] = *(const f32x4_t*)(sp + (size_t)(i + u * NGT) * 8 + 4); }
#pragma unroll
                    for (int u = 0; u < 4; ++u) { v4u o; o.x = pk2(v[2 * u].x, v[2 * u].y); o.y = pk2(v[2 * u].z, v[2 * u].w); o.z = pk2(v[2 * u + 1].x, v[2 * u + 1].y); o.w = pk2(v[2 * u + 1].z, v[2 * u + 1].w);
                        *(v4u*)(dp + (size_t)(i + u * NGT) * 8) = o; }
                }
            };
            for (int i = gw; i < BATCH * 32; i += NGW) {
                int v = pos[i * 64 + lane];
#pragma unroll
                for (int o_ = 1; o_ < 64; o_ <<= 1) v = max(v, __shfl_xor(v, o_));
                if (lane == 0) ((int*)(ws + WS_RT + RT_TPMAX))[i] = v;
            }
            cvt_stream(x0, a16, NTOK * D_MODEL / 8);
            cvt_stream(pin, p16, DEPTH * NTOK * PLE_DIM / 8);
            convert_layer_weights(a, 0, ws, scr, gw, NGW, lane);
        } else {
            constexpr int l = (PH - 1) / PH_PER_LAYER, sp = (PH - 1) % PH_PER_LAYER;
            const float* b_forget = (const float*)KARG(13) + l * 4;
            const float* ln1_g = (const float*)KARG(15) + l * 1024; const float* ln1_b = (const float*)KARG(16) + l * 1024;
            const float* w_group = (const float*)KARG(17) + l * 1024 * 4; const float* b_group = (const float*)KARG(18) + l * 4;
            const float* w_er = (const float*)KARG(19) + (size_t)l * 4 * 1024 * 8; const float* b_er = (const float*)KARG(20) + l * 32;
            const float* ln2_g = (const float*)KARG(26) + l * 1024; const float* ln2_b = (const float*)KARG(27) + l * 1024;
            unsigned* cnt = ctl + CW_CNT + l * 2048 + (DUMMY ? 8192 : 0);
            if (DUMMY) rank = (int*)(ws + WS_RT + 512 * 1024);
            if constexpr (sp == 0) {
                pg8::Gemm g{a16, (const bf16*)(ws + WS_WIN), NTOK, ZP, 1024, 1024, 1024};
                pg8::StaticOrder S; S.init(NTOK, ZP, G, (int)blockIdx.x);
                pg8::EpiZ E{z16, ZP, fcbuf};
                pg8::gemm_phase<pg8::EpiZ, pg8::StaticOrder, true, true>((LAS unsigned char*)lds_raw, g, S, E, tid);
                {
                    pg8::Gemm g2{p16 + (size_t)l * NTOK * PLE_DIM, (const bf16*)(ws + WS_WPP), NTOK, 1024, 256, 256, 256};
                    const int bx = (int)blockIdx.x;
                    pg8::StaticOrder S2; S2.init(NTOK, 1024, G / 2, bx >= G / 2 ? bx - G / 2 : 1 << 20);
                    pg8::EpiBf16<0> E2{pp16, 1024, nullptr, 0, 0, 1.f};
                    pg8::gemm_phase<pg8::EpiBf16<0>, pg8::StaticOrder, true, true>((LAS unsigned char*)lds_raw, g2, S2, E2, tid);
                }
            } else if constexpr (sp == 1) {
                const int g16 = lane >> 4, l16 = lane & 15;
                for (int tk = gw * 4 + g16; tk < NTOK; tk += NGW * 4) {
                    const bf16* zr = z16 + (size_t)tk * ZP;
                    const v4u ca = *(const v4u*)(zr + Z_CQ + l16 * 16), cb = *(const v4u*)(zr + Z_CQ + l16 * 16 + 8);
                    const v4u ka = *(const v4u*)(zr + Z_CKV + l16 * 8);
                    const unsigned short kr1 = zr[Z_KR + l16], kr2 = zr[Z_KR + 16 + l16];
                    const float cs = cosT[tk * 16 + l16], sn = sinT[tk * 16 + l16];
                    const float fcv = fcbuf[tk * 4 + (l16 & 3)];
                    float f[8]; float ss = 0.f;
                    unpack8(ca, f);
#pragma unroll
                    for (int i = 0; i < 8; ++i) ss = fmaf(f[i], f[i], ss);
                    unpack8(cb, f);
#pragma unroll
                    for (int i = 0; i < 8; ++i) ss = fmaf(f[i], f[i], ss);
                    float s2 = 0.f;
                    unpack8(ka, f);
#pragma unroll
                    for (int i = 0; i < 8; ++i) s2 = fmaf(f[i], f[i], s2);
#pragma unroll
                    for (int o = 1; o < 16; o <<= 1) { ss += __shfl_xor(ss, o); s2 += __shfl_xor(s2, o); }
                    if (l16 == 0) { rq[tk] = rsqrtf(ss * (1.f / 256.f) + RMS_EPS); rkv[tk] = rsqrtf(s2 * (1.f / 128.f) + RMS_EPS); }
                    const float x1 = __uint_as_float((unsigned)kr1 << 16), x2 = __uint_as_float((unsigned)kr2 << 16);
                    krr16[tk * 32 + l16] = (bf16)f2bf(x1 * cs - x2 * sn); krr16[tk * 32 + 16 + l16] = (bf16)f2bf(x2 * cs + x1 * sn);
                    if (l16 < 4) {
                        const float xf = fcv + b_forget[l16];
                        logf[tk * 4 + l16] = fminf(xf, 0.f) - log1pf(expf(-fabsf(xf)));
                    }
                }
            } else if constexpr (sp == 2) {
                {
                    pg8::Gemm g{z16 + Z_CQ, (const bf16*)(ws + WS_WUQ), NTOK, NQBP, 256, ZP, 256};
                    pg8::StaticOrder S; S.init(NTOK, NQBP, G, (int)blockIdx.x);
                    pg8::EpiRowScale E{qb16, NQBP, rq};
                    pg8::gemm_phase<pg8::EpiRowScale, pg8::StaticOrder, true, true>((LAS unsigned char*)lds_raw, g, S, E, tid);
                }
                {
                    pg8::Gemm g{z16 + Z_CKV, (const bf16*)(ws + WS_WUKV), NTOK, NKVB, 128, ZP, 128};
                    pg8::StaticOrder S; S.init(NTOK, NKVB, G, (int)((blockIdx.x + 128) % G));
                    pg8::EpiRowScale E{kvb16, NKVB, rkv};
                    pg8::gemm_phase<pg8::EpiRowScale, pg8::StaticOrder, true, true>((LAS unsigned char*)lds_raw, g, S, E, tid);
                }
                const int cw = NGW - 1 - gw;
                if (cw < 32) {
                    const int b = cw >> 2, hh = cw & 3;
                    float* cp = cum + ((size_t)b * SEQ) * 4 + hh; const float* lp = logf + ((size_t)b * SEQ) * 4 + hh;
                    float loc[32]; float run = 0.f;
#pragma unroll
                    for (int i = 0; i < 32; ++i) { run += lp[(size_t)(lane * 32 + i) * 4]; loc[i] = run; }
                    float pre = run;
#pragma unroll
                    for (int o = 1; o < 64; o <<= 1) { const float n = __shfl_up(pre, o); if (lane >= o) pre += n; }
                    pre -= run;
#pragma unroll
                    for (int i = 0; i < 32; ++i) cp[(size_t)(lane * 32 + i) * 4] = loc[i] + pre;
                }
            } else if constexpr (sp == 3) {
                float lam_init_, lam_;
                {
                    const float* lq1 = (const float*)KARG(8) + l * 32; const float* lk1 = (const float*)KARG(9) + l * 32; const float* lq2 = (const float*)KARG(10) + l * 32; const float* lk2 = (const float*)KARG(11) + l * 32;
                    lam_init_ = 0.8f - 0.6f * expf(-0.3f * (float)l);
                    float s1 = 0.f, s2 = 0.f;
                    for (int i = 0; i < 32; ++i) { s1 += lq1[i] * lk1[i]; s2 += lq2[i] * lk2[i]; }
                    lam_ = expf(s1) - expf(s2) + lam_init_;
                }
                AttnP p{z16, qb16, kvb16, krr16, cum, cosT, sinT, pos, mixed16,
                        (const float*)KARG(8) + l * 32, (const float*)KARG(9) + l * 32, (const float*)KARG(10) + l * 32, (const float*)KARG(11) + l * 32,
                        (const float*)KARG(12) + l * 64, l, ctl + 14000, (const int*)(ws + WS_RT + RT_TPMAX), lam_, lam_init_};
                volatile LAS int* qslot = (volatile LAS int*)((LAS unsigned char*)lds_raw + LDS_MISC) + 48;
                unsigned* qctr = ctl + 12288 + l * 64 + (DUMMY ? 32 : 0);
                int idx = (int)blockIdx.x;
                for (;;) {
                    if (idx >= 1408) break;
                    int nxt_idx = 0;
                    if (wave_s == 0 && lane_id_now() == 0) nxt_idx = G + (int)atomicAdd(qctr, 1u);
                    const int pi = idx / 176, r = idx % 176, thi = 32 - 4 * pi;
                    if (r < 48) attn_unit<0>(p, r / 6, r % 6, thi / 2 - 1, (LAS unsigned char*)lds_raw, wave_s);
                    else if (r < 96) attn_unit<1>(p, (r - 48) / 6, (r - 48) % 6, thi / 4 - 1, (LAS unsigned char*)lds_raw, wave_s);
                    else if (r < 128) attn_unit<2>(p, (r - 96) / 4, (r - 96) % 4, thi / 4 - 1, (LAS unsigned char*)lds_raw, wave_s);
                    else attn_unit<0>(p, (r - 128) / 6, (r - 128) % 6, (thi - 2) / 2 - 1, (LAS unsigned char*)lds_raw, wave_s);
                    __syncthreads();
                    if (wave_s == 0 && lane_id_now() == 0) *qslot = nxt_idx;
                    __syncthreads();
                    idx = __builtin_amdgcn_readfirstlane(*qslot);
                }
            } else if constexpr (sp == 4) {
                pg8::Gemm g{mixed16, (const bf16*)(ws + WS_WOUT), NTOK, 1024, 1024, 1024, 1024};
                pg8::StaticOrder S; S.init(NTOK, 1024, G, (int)blockIdx.x);
                pg8::EpiBf16<0> E{mix16, 1024, nullptr, 0, 0, 1.f};
                pg8::gemm_phase<pg8::EpiBf16<0>, pg8::StaticOrder, true, true>((LAS unsigned char*)lds_raw, g, S, E, tid);
            } else if constexpr (sp == 5) {
#ifdef PROF_LN1
                if (l == 0 && blockIdx.x == 0 && tid == 0) ctl[14000 + 19] = (unsigned)(__builtin_amdgcn_s_memrealtime() & 0xffffffffu);
#endif
                LAS f32x4_t* Lg = (LAS f32x4_t*)lds_raw; LAS f32x4_t* Le = Lg + 1024;
                LAS unsigned* lcnt = (LAS unsigned*)((LAS unsigned char*)lds_raw + LDS_MISC) + 16;
                __syncthreads();
                if (tid < 32) lcnt[tid] = 0u;
                for (int k = tid; k < 1024; k += NTHREADS) { const int j = k >> 8, ln = (k & 255) >> 2, i = k & 3; Lg[(j * 4 + i) * 64 + ln] = *(const f32x4_t*)(w_group + (size_t)k * 4); }
                {
                    f32x4_t wv[16];
#pragma unroll
                    for (int u = 0; u < 16; ++u) wv[u] = *(const f32x4_t*)(w_er + (size_t)(tid + u * NTHREADS) * 4);
#pragma unroll
                    for (int u = 0; u < 16; ++u) { const int q = tid + u * NTHREADS; const int g = q >> 11, k = (q >> 1) & 1023, half = q & 1; const int j = k >> 8, ln = (k & 255) >> 2, i = k & 3;
                        Le[((g * 16 + j * 4 + i) * 2 + half) * 64 + ln] = wv[u]; }
                }
                __syncthreads();
#ifdef PROF_LN1
                if (l == 0 && blockIdx.x == 0 && tid == 0) ctl[14000 + 20] = (unsigned)(__builtin_amdgcn_s_memrealtime() & 0xffffffffu);
#endif
                float4 xvA[4], xvB[4]; v2u mwA[4], mwB[4];
                auto ld_x = [&](int tk, int j) -> float4 {
                    if (l == 0) return *(const float4*)(x0 + (size_t)tk * D_MODEL + j * 256 + lane * 4);
                    const v2u xw = *(const v2u*)(a16 + (size_t)tk * D_MODEL + j * 256 + lane * 4);
                    return make_float4(bflo(xw.x), bfhi(xw.x), bflo(xw.y), bfhi(xw.y));
                };
                auto ld_tok = [&](int tk, float4 (&xv)[4], v2u (&mw)[4]) {
                    if (tk < NTOK) {
#pragma unroll
                        for (int j = 0; j < 4; ++j) { xv[j] = ld_x(tk, j); mw[j] = *(const v2u*)(mix16 + (size_t)tk * D_MODEL + j * 256 + lane * 4); }
                    }
                };
                auto do_tok = [&](int tk, float4 (&xv)[4], v2u (&mw)[4]) {
                    float4 v[4]; float s = 0.f;
#pragma unroll
                    for (int j = 0; j < 4; ++j) {
                        v[j] = make_float4(ALPHA * xv[j].x + bflo(mw[j].x), ALPHA * xv[j].y + bfhi(mw[j].x), ALPHA * xv[j].z + bflo(mw[j].y), ALPHA * xv[j].w + bfhi(mw[j].y));
                        s += (v[j].x + v[j].y) + (v[j].z + v[j].w);
                    }
                    ld_tok(tk + 2 * NGW, xv, mw);
                    const float mean = wave_sum(s) * (1.f / 1024.f); float s2 = 0.f;
#pragma unroll
                    for (int j = 0; j < 4; ++j) { v[j].x -= mean; v[j].y -= mean; v[j].z -= mean; v[j].w -= mean; s2 += (v[j].x * v[j].x + v[j].y * v[j].y) + (v[j].z * v[j].z + v[j].w * v[j].w); }
                    const float rstd = rsqrtf(wave_sum(s2) * (1.f / 1024.f) + LN_EPS);
                    float gl[4] = {0.f, 0.f, 0.f, 0.f};
#pragma unroll
                    for (int j = 0; j < 4; ++j) {
                        const int d0 = j * 256 + lane * 4;
                        const float4 gg = *(const float4*)(ln1_g + d0), bb = *(const float4*)(ln1_b + d0);
                        v[j] = make_float4(v[j].x * rstd * gg.x + bb.x, v[j].y * rstd * gg.y + bb.y, v[j].z * rstd * gg.z + bb.z, v[j].w * rstd * gg.w + bb.w);
                        { v2u hb; hb.x = pk2(v[j].x, v[j].y); hb.y = pk2(v[j].z, v[j].w); *(v2u*)(a16 + (size_t)tk * D_MODEL + d0) = hb; }
                        const float hv[4] = {v[j].x, v[j].y, v[j].z, v[j].w};
#pragma unroll
                        for (int i = 0; i < 4; ++i) {
                            const f32x4_t wg = Lg[(j * 4 + i) * 64 + lane];
                            gl[0] = fmaf(hv[i], wg.x, gl[0]); gl[1] = fmaf(hv[i], wg.y, gl[1]); gl[2] = fmaf(hv[i], wg.z, gl[2]); gl[3] = fmaf(hv[i], wg.w, gl[3]);
                        }
                    }
#pragma unroll
                    for (int i = 0; i < 4; ++i) gl[i] = wave_sum(gl[i]) + b_group[i];
                    int gi = 0; float gm = gl[0];
#pragma unroll
                    for (int i = 1; i < 4; ++i) if (gl[i] > gm) { gm = gl[i]; gi = i; }
                    gi = __builtin_amdgcn_readfirstlane(gi);
                    float gden = 0.f;
#pragma unroll
                    for (int i = 0; i < 4; ++i) gden += __expf(gl[i] - gm);
                    const float gwt = 1.f / gden;
                    float el[8] = {0.f, 0.f, 0.f, 0.f, 0.f, 0.f, 0.f, 0.f};
                    const LAS f32x4_t* we = Le + gi * 2048;
#pragma unroll
                    for (int j = 0; j < 4; ++j) {
                        const float hv[4] = {v[j].x, v[j].y, v[j].z, v[j].w};
#pragma unroll
                        for (int i = 0; i < 4; ++i) {
                            const f32x4_t w0 = we[((j * 4 + i) * 2) * 64 + lane], w1 = we[((j * 4 + i) * 2 + 1) * 64 + lane];
                            el[0] = fmaf(hv[i], w0.x, el[0]); el[1] = fmaf(hv[i], w0.y, el[1]); el[2] = fmaf(hv[i], w0.z, el[2]); el[3] = fmaf(hv[i], w0.w, el[3]);
                            el[4] = fmaf(hv[i], w1.x, el[4]); el[5] = fmaf(hv[i], w1.y, el[5]); el[6] = fmaf(hv[i], w1.z, el[6]); el[7] = fmaf(hv[i], w1.w, el[7]);
                        }
                    }
#pragma unroll
                    for (int i = 0; i < 8; ++i) el[i] = wave_sum(el[i]) + b_er[gi * 8 + i];
                    int i0 = 0; float v0 = el[0];
#pragma unroll
                    for (int i = 1; i < 8; ++i) if (el[i] > v0) { v0 = el[i]; i0 = i; }
                    int i1 = -1; float v1 = -INFINITY;
#pragma unroll
                    for (int i = 0; i < 8; ++i) if (i != i0 && el[i] > v1) { v1 = el[i]; i1 = i; }
                    const float e1 = __expf(v1 - v0);
                    const float w0 = gwt / (1.f + e1), w1 = gwt * e1 / (1.f + e1);
                    if (lane == 0) {
                        const int ea = gi * 8 + i0, eb = gi * 8 + i1;
                        ids[tk * 2] = ea; ids[tk * 2 + 1] = eb; wts[tk * 2] = w0; wts[tk * 2 + 1] = w1;
                        rank[tk * 2] = (int)__hip_atomic_fetch_add(lcnt + ea, 1u, __ATOMIC_RELAXED, __HIP_MEMORY_SCOPE_WORKGROUP);
                        rank[tk * 2 + 1] = (int)__hip_atomic_fetch_add(lcnt + eb, 1u, __ATOMIC_RELAXED, __HIP_MEMORY_SCOPE_WORKGROUP);
                    }
                };
                ld_tok(gw, xvA, mwA); ld_tok(gw + NGW, xvB, mwB);
                for (int tk = gw; tk < NTOK; tk += 2 * NGW) {
                    do_tok(tk, xvA, mwA);
                    if (tk + NGW < NTOK) do_tok(tk + NGW, xvB, mwB);
                }
#ifdef PROF_LN1
                if (l == 0 && blockIdx.x == 0 && tid == 0) ctl[14000 + 21] = (unsigned)(__builtin_amdgcn_s_memrealtime() & 0xffffffffu);
#endif
                __syncthreads();
                if (tid < 32) { const unsigned n = lcnt[tid]; lcnt[tid] = n ? atomicAdd(cnt + tid * 64, n) : 0u; }
                __syncthreads();
                for (int base = 0; gw + base * NGW < NTOK; base += 32) {
                    const int tk = gw + (base + (lane >> 1)) * NGW;
                    if (tk < NTOK) {
                        const int pi = tk * 2 + (lane & 1);
                        const int ee = ids[pi];
                        const int rr = rank[pi] + (int)lcnt[ee];
                        rank[pi] = rr;
                        if (!DUMMY) etok[ee * 16384 + rr] = tk;
                    }
                }
                __syncthreads();
            } else if constexpr (sp == 6) {
                LAS int* xs = (LAS int*)((LAS unsigned char*)lds_raw + 131072); LAS int* te = xs + 80;
                __syncthreads();
                expert_prefix(cnt, xs, tid);
                if (tid < 32) xs[40 + tid] = (int)cnt[tid * 64];
                __syncthreads();
                if (tid < NSLOT_TILES) { int e = 31; for (int k = 31; k >= 0; --k) if (tid * 256 < xs[k + 1]) e = k; te[tid] = e; }
                __syncthreads();
                const int T = xs[32] >> 8, nU1 = 2 * T;
                const int vc = (int)((blockIdx.x % 8) * (G / 8) + blockIdx.x / 8);
                unsigned go[2][2][2]; int upm[2], upn[2]; int nun = 0;
#pragma unroll
                for (int i = 0; i < 2; ++i) {
                    const int g = vc + i * G;
                    upm[i] = 0; upn[i] = 0;
#pragma unroll
                    for (int h = 0; h < 2; ++h) { go[i][h][0] = 0u; go[i][h][1] = 0u; }
                    if (g < nU1) {
                        const int t = g >> 1, e = __builtin_amdgcn_readfirstlane(te[t]);
                        const int tl = t - (xs[e] >> 8), ce = xs[40 + e];
                        upm[i] = t + pg8::XPM; upn[i] = e * 2 + (g & 1) + pg8::XPN; nun = i + 1;
#pragma unroll
                        for (int pc = 0; pc < 2; ++pc) { int R, C; pg8::stage_rc(tid * 16 + pc * 8192, R, C);
#pragma unroll
                            for (int h = 0; h < 2; ++h) { const int rk = tl * 256 + h * 128 + R; const int tok = rk < ce ? etok[e * 16384 + rk] : 0; go[i][h][pc] = (unsigned)tok * 2048u + (unsigned)C * 2u; } }
                    } else if (g - nU1 < 256) {
                        const int k = g - nU1;
                        upm[i] = k >> 2; upn[i] = k & 3; nun = i + 1;
#pragma unroll
                        for (int pc = 0; pc < 2; ++pc) { int R, C; pg8::stage_rc(tid * 16 + pc * 8192, R, C);
#pragma unroll
                            for (int h = 0; h < 2; ++h) go[i][h][pc] = (unsigned)((k >> 2) * 256 + h * 128 + R) * 2048u + (unsigned)C * 2u; }
                    }
                }
                if (nun == 1) {
#pragma unroll
                    for (int h = 0; h < 2; ++h) { go[1][h][0] = go[0][h][0]; go[1][h][1] = go[0][h][1]; }
                }
                {
                    pg8::Gemm g{a16, (const bf16*)(ws + WS_WPG), NTOK, 1024, 1024, 1024, 1024};
                    pg8::TwoUnits S{upm[0], upn[0], upm[1], upn[1], nun};
                    pg8::EpiX E{pg8::EpiGU{act16}, pg8::EpiPleGate{ple16, pp16}};
                    pg8::gemm_phase_ga<pg8::EpiX, pg8::TwoUnits, true, true>((LAS unsigned char*)lds_raw, g, S, E, tid, go[0], go[1]);
                }
            } else if constexpr (sp == 7) {
                LAS int* xs = (LAS int*)((LAS unsigned char*)lds_raw + 131072); LAS int* te = xs + 80;
                __syncthreads();
                expert_prefix(cnt, xs, tid);
                __syncthreads();
                if (tid < NSLOT_TILES) { int e = 31; for (int k = 31; k >= 0; --k) if (tid * 256 < xs[k + 1]) e = k; te[tid] = e; }
                __syncthreads();
                const int T = xs[32] >> 8;
                const int vc = (int)((blockIdx.x % 8) * (G / 8) + blockIdx.x / 8);
                int nB2 = 2 * T - G; nB2 = nB2 < 0 ? 0 : nB2;
                if (vc >= nB2) {
                    pg8::Gemm g{act16, (const bf16*)(ws + WS_WD), MAX_SLOTS, 32 * 1024, 256, 256, 256};
                    pg8::GroupSched S{(const int*)te, T, 4, G - nB2, vc - nB2};
                    pg8::EpiDown E{outs16};
                    pg8::gemm_phase<pg8::EpiDown, pg8::GroupSched, true, true>((LAS unsigned char*)lds_raw, g, S, E, tid);
                } else {
                    const int k = 256 - nB2 + vc;
                    pg8::Gemm g{a16, (const bf16*)(ws + WS_WPG), NTOK, 1024, 1024, 1024, 1024};
                    pg8::OneUnit S{k >> 2, k & 3};
                    pg8::EpiPleGate E{ple16, pp16};
                    pg8::gemm_phase<pg8::EpiPleGate, pg8::OneUnit, true, true>((LAS unsigned char*)lds_raw, g, S, E, tid);
                }
            } else if constexpr (sp == 8) {
                LAS int* xs = (LAS int*)((LAS unsigned char*)lds_raw + 131072);
                __syncthreads();
                expert_prefix(cnt, xs, tid);
                __syncthreads();
                struct Ln2Regs { v2u hv[4], oa[4], ob[4], pv[4]; float w0, w1; };
                Ln2Regs RA, RB;
                auto ld_rows = [&](int tk, Ln2Regs& R) {
                    if (tk < NTOK) {
                        const int s0 = xs[ids[tk * 2]] + rank[tk * 2], s1 = xs[ids[tk * 2 + 1]] + rank[tk * 2 + 1]; R.w0 = wts[tk * 2]; R.w1 = wts[tk * 2 + 1];
#pragma unroll
                        for (int j = 0; j < 4; ++j) {
                            const int d0 = j * 256 + lane * 4;
                            R.hv[j] = *(const v2u*)(a16 + (size_t)tk * D_MODEL + d0);
                            R.oa[j] = *(const v2u*)(outs16 + (size_t)s0 * D_MODEL + d0); R.ob[j] = *(const v2u*)(outs16 + (size_t)s1 * D_MODEL + d0);
                            R.pv[j] = *(const v2u*)(ple16 + (size_t)tk * D_MODEL + d0);
                        }
                    }
                };
                auto do_row = [&](int tk, Ln2Regs& R) {
                    float4 v[4]; float s = 0.f; const float w0 = R.w0, w1 = R.w1;
#pragma unroll
                    for (int j = 0; j < 4; ++j) {
                        v[j] = make_float4(ALPHA * bflo(R.hv[j].x) + w0 * bflo(R.oa[j].x) + w1 * bflo(R.ob[j].x) + bflo(R.pv[j].x), ALPHA * bfhi(R.hv[j].x) + w0 * bfhi(R.oa[j].x) + w1 * bfhi(R.ob[j].x) + bfhi(R.pv[j].x),
                                           ALPHA * bflo(R.hv[j].y) + w0 * bflo(R.oa[j].y) + w1 * bflo(R.ob[j].y) + bflo(R.pv[j].y), ALPHA * bfhi(R.hv[j].y) + w0 * bfhi(R.oa[j].y) + w1 * bfhi(R.ob[j].y) + bfhi(R.pv[j].y));
                        s += (v[j].x + v[j].y) + (v[j].z + v[j].w);
                    }
                    ld_rows(tk + 2 * NGW, R);
                    const float mean = wave_sum(s) * (1.f / 1024.f); float s2 = 0.f;
#pragma unroll
                    for (int j = 0; j < 4; ++j) { v[j].x -= mean; v[j].y -= mean; v[j].z -= mean; v[j].w -= mean; s2 += (v[j].x * v[j].x + v[j].y * v[j].y) + (v[j].z * v[j].z + v[j].w * v[j].w); }
                    const float rstd = rsqrtf(wave_sum(s2) * (1.f / 1024.f) + LN_EPS);
#pragma unroll
                    for (int j = 0; j < 4; ++j) {
                        const int d0 = j * 256 + lane * 4;
                        const float4 gg = *(const float4*)(ln2_g + d0), bb = *(const float4*)(ln2_b + d0);
                        const float4 o = make_float4(v[j].x * rstd * gg.x + bb.x, v[j].y * rstd * gg.y + bb.y, v[j].z * rstd * gg.z + bb.z, v[j].w * rstd * gg.w + bb.w);
                        if (!DUMMY || w0 == 12345.678f) {
                        if (l == DEPTH - 1) {
#ifdef PROF_SEL
#ifdef PROF_LN1
                        float4 oo = o; { const float dlt = sqrtf((float)(ctl[14000 + PROF_LN1 + 1] - ctl[14000 + PROF_LN1]) * 1e-8f);
#else
                        float4 oo = o; { const float dlt = sqrtf((float)ctl[14000 + PROF_SEL] * 1e-8f);
#endif
                        oo.x += dlt; oo.y += dlt; oo.z += dlt; oo.w += dlt; }
                        *(float4*)(KOUT + (size_t)tk * D_MODEL + d0) = oo;
#else
                        *(float4*)(KOUT + (size_t)tk * D_MODEL + d0) = o;
#endif
                        } else {
                        v2u ob16; ob16.x = pk2(o.x, o.y); ob16.y = pk2(o.z, o.w);
                        *(v2u*)(a16 + (size_t)tk * D_MODEL + d0) = ob16;
                        }
                        }
                    }
                };
                ld_rows(gw, RA); ld_rows(gw + NGW, RB);
                for (int tk = gw; tk < NTOK; tk += 2 * NGW) {
                    do_row(tk, RA);
                    if (tk + NGW < NTOK) do_row(tk + NGW, RB);
                }
                if (l + 1 < DEPTH) convert_layer_weights(a, l + 1, ws, scr, gw, NGW, lane);
            }
        }
}

#define XB_DONE 3456
__device__ unsigned g_bar[XCD_BAR_WORDS + 64];
__global__ void __launch_bounds__(NTHREADS, 2) mega(Args a) {
    extern __shared__ __attribute__((aligned(16))) unsigned char lds_raw[];
    cg::grid_group grid = cg::this_grid();
    volatile LAS unsigned* misc = (volatile LAS unsigned*)((LAS unsigned char*)lds_raw + LDS_MISC);
    if (threadIdx.x < 16) misc[threadIdx.x] = 0u;
    __syncthreads();
    XcdBarrier bar = xcd_barrier_post(g_bar, misc + 8);
    const int wave_s = __builtin_amdgcn_readfirstlane(threadIdx.x >> 6);
#define IS_T0 (wave_s == 0 && lane_id_now() == 0)
#ifndef DUP_SP
#define DUP_SP -1
#endif
#ifndef DUP_X
#define DUP_X 0
#endif
    if (a.ph_hi < 0) grid.sync();
#define SEAM(ph) do { xcd_barrier(bar, IS_T0); } while (0)
#ifdef PROF_PH
    unsigned long long ph_t_prev = __builtin_amdgcn_s_memrealtime();
#define PHASE_STAMP(ph) do { const unsigned long long t_ = __builtin_amdgcn_s_memrealtime(); if ((ph) == PROF_PH && blockIdx.x == 0 && IS_T0) ((unsigned*)(a.ws + WS_CTL))[14000 + PROF_SEL] = (unsigned)(t_ - ph_t_prev); ph_t_prev = t_; } while (0)
#else
#define PHASE_STAMP(ph) do {} while (0)
#endif
#define RUN(ph) if (a.ph_lo <= (ph) && (ph) < a.ph_hi) { \
        if (DUP_X == 9 && (ph) > 0 && ((ph) - 1) % PH_PER_LAYER == 9) { run_phase<ph, true>(a, lds_raw, wave_s); xcd_barrier(bar, IS_T0); } \
        run_phase<ph>(a, lds_raw, wave_s); \
        if ((ph) > 0 && ((ph) - 1) % PH_PER_LAYER == DUP_SP) { xcd_barrier(bar, IS_T0); run_phase<ph>(a, lds_raw, wave_s); } \
        if (DUP_X == 100 && (ph) == 0) { xcd_barrier(bar, IS_T0); run_phase<ph>(a, lds_raw, wave_s); } \
        if (DUP_X == 5 && (ph) == 6) { xcd_barrier(bar, IS_T0); run_phase<ph, true>(a, lds_raw, wave_s); } \
        if (DUP_X == 3 && (ph) > 0 && ((ph) - 1) % PH_PER_LAYER == 3) { xcd_barrier(bar, IS_T0); run_phase<ph, true>(a, lds_raw, wave_s); } \
        if ((ph) + 1 < a.ph_hi && (ph) + 1 < NPH) SEAM(ph); PHASE_STAMP(ph); }
    RUN(0) RUN(1) RUN(2) RUN(3) RUN(4) RUN(5) RUN(6) RUN(7) RUN(8) RUN(9)
    RUN(10) RUN(11) RUN(12) RUN(13) RUN(14) RUN(15) RUN(16) RUN(17) RUN(18)
#undef RUN
#undef SEAM
    if (IS_T0) {
        const unsigned old = xb_add(&g_bar[XB_DONE], 1u);
        if (old + 1u == gridDim.x) {
#pragma unroll 1
            for (unsigned j = 0; j < 16; ++j) {
                __hip_atomic_store(&g_bar[XB_XCNT(j)], 0u, __ATOMIC_RELAXED, __HIP_MEMORY_SCOPE_AGENT);
                __hip_atomic_store(&g_bar[XB_XSUB(j)], 0u, __ATOMIC_RELAXED, __HIP_MEMORY_SCOPE_AGENT);
                __hip_atomic_store(&g_bar[XB_XGEN(j)], 0u, __ATOMIC_RELAXED, __HIP_MEMORY_SCOPE_AGENT);
            }
            __hip_atomic_store(&g_bar[XB_TOP], 0u, __ATOMIC_RELAXED, __HIP_MEMORY_SCOPE_AGENT);
            __hip_atomic_store(&g_bar[XB_TOPGEN], 0u, __ATOMIC_RELAXED, __HIP_MEMORY_SCOPE_AGENT);
            __hip_atomic_store(&g_bar[XB_DONE], 0u, __ATOMIC_RELAXED, __HIP_MEMORY_SCOPE_AGENT);
        }
    }
}

extern "C" void kernel_launch(void* const* d_in, const int* in_sizes, int n_in, void* d_out, int out_size, void* d_ws, size_t ws_size, hipStream_t stream) {
    static int grid = 0;
    if (grid == 0) {
        if (n_in != 28 || ws_size < WS_END) { fprintf(stderr, "kernel_launch: unexpected n_in %d or ws_size %zu (< %zu)\n", n_in, ws_size, (size_t)WS_END); grid = -1; return; }
        int dev = 0, cus = 0, per_cu = 0;
        (void)hipGetDevice(&dev);
        (void)hipDeviceGetAttribute(&cus, hipDeviceAttributeMultiprocessorCount, dev);
        (void)hipFuncSetAttribute((const void*)mega, hipFuncAttributeMaxDynamicSharedMemorySize, LDS_BYTES);
        (void)hipOccupancyMaxActiveBlocksPerMultiprocessor(&per_cu, (const void*)mega, NTHREADS, LDS_BYTES);
        if (per_cu < 1) { fprintf(stderr, "kernel_launch: occupancy query says %d blocks/CU\n", per_cu); }
        (void)hipGetLastError();
        grid = cus;
    }
    if (grid < 0) return;
    Args a{};
    for (int i = 0; i < 28; ++i) a.in[i] = d_in[i];
    a.out = (float*)d_out; a.ws = (unsigned char*)d_ws; a.ph_lo = 0; a.ph_hi = NPH;
    void* params[] = {&a};
    hipError_t e = hipLaunchCooperativeKernel((const void*)mega, dim3(grid), dim3(NTHREADS), params, LDS_BYTES, stream);
    if (e != hipSuccess) fprintf(stderr, "cooperative launch failed: %s (grid %d)\n", hipGetErrorString(e), grid);
}
```

```cpp
#include <hip/hip_runtime.h>
#include <hip/hip_cooperative_groups.h>
#include <cstdio>
#include <cstdint>
namespace cg = cooperative_groups;

constexpr int D_MODEL = 1024, BATCH = 8, SEQ = 2048, NTOK = BATCH * SEQ, DEPTH = 2;
constexpr int D_IN = 2340;
constexpr int OFF_QA = 0, OFF_KA = 384, OFF_VA = 768, OFF_CQ = 1152, OFF_CKV = 1408, OFF_KR = 1536,
              OFF_QC = 1568, OFF_KC = 1824, OFF_VC = 2080, OFF_FC = 2336;
constexpr int ZP = 2560;
constexpr int Z_QA = 0, Z_KA = 384, Z_VA = 768, Z_QC = 1152, Z_KC = 1408, Z_VC = 1664, Z_CKV = 1920, Z_CQ = 2048, Z_KR = 2304, Z_FC = 2336;
constexpr int NQB = 576, NKVB = 768, NQBP = 768;
constexpr int N_EXPERTS = 32, D_EXPERT = 256, PLE_DIM = 256;
constexpr int MAX_SLOTS = 32768 + 32 * 256;
constexpr int NSLOT_TILES = MAX_SLOTS / 256;
constexpr float ALPHA = 1.4142135623730951f;
constexpr float LN_EPS = 1e-5f, RMS_EPS = 1e-6f;
constexpr int NTHREADS = 512;
constexpr int LDS_BYTES = 147456 + 256;

constexpr size_t MiB = 1u << 20;
constexpr size_t WS_CTL = 0;
constexpr size_t WS_COS = 1 * MiB, WS_SIN = 2 * MiB;
constexpr size_t WS_WIN = 3 * MiB;
constexpr size_t WS_WUQ = 8 * MiB;
constexpr size_t WS_WUKV = WS_WUQ + 393216;
constexpr size_t WS_WOUT = 9 * MiB;
constexpr size_t WS_WPG = 11 * MiB;
constexpr size_t WS_WPP = 13 * MiB;
constexpr size_t WS_WGU = 14 * MiB;
constexpr size_t WS_WD = 46 * MiB;
constexpr size_t WS_A16 = 62 * MiB;
constexpr size_t WS_P16 = 94 * MiB;
constexpr size_t WS_Z16 = 110 * MiB;
constexpr size_t WS_HS16 = WS_Z16;
constexpr size_t WS_OUTS16 = WS_Z16;
constexpr size_t WS_QB16 = 190 * MiB;
constexpr size_t WS_KVB16 = 214 * MiB;
constexpr size_t WS_KRR16 = 238 * MiB;
constexpr size_t WS_FC = 239 * MiB;
constexpr size_t WS_CUM = WS_FC + 256 * 1024;
constexpr size_t WS_LOGF = WS_CUM + 256 * 1024;
constexpr size_t WS_RQ = WS_LOGF + 256 * 1024;
constexpr size_t WS_RKV = WS_RQ + 64 * 1024;
constexpr size_t WS_MIX16 = 190 * MiB;
constexpr size_t WS_PP16 = 276 * MiB;
constexpr size_t WS_ACT16 = 222 * MiB;
constexpr size_t WS_MIXED16 = 242 * MiB;
constexpr size_t WS_PLE16 = 242 * MiB;
constexpr size_t WS_RT = 274 * MiB;
constexpr size_t WS_ETOK = 308 * MiB;
constexpr size_t WS_END = 310 * MiB;
constexpr size_t RT_IDS = 0, RT_WTS = 128 * 1024, RT_RANK = 256 * 1024, RT_SLOTOF = 384 * 1024, RT_TILEE = 768 * 1024, RT_TPMAX = 800 * 1024;
constexpr int CW_CNT = 0;
static_assert((WS_A16 - WS_HS16) % (256 * 1024 * 2) == 0 || true, "");

struct Args { const void* in[28]; float* out; unsigned char* ws; int ph_lo, ph_hi; };

#define LAS __attribute__((address_space(3)))
typedef unsigned short bf16;
typedef unsigned v4u __attribute__((ext_vector_type(4)));
typedef unsigned v2u __attribute__((ext_vector_type(2)));
typedef float f32x4_t __attribute__((ext_vector_type(4)));

__device__ __forceinline__ float wave_sum(float v) {
#define WS_DPP(ctrl, rmask) __builtin_bit_cast(float, __builtin_amdgcn_update_dpp(0, __builtin_bit_cast(int, v), (ctrl), (rmask), 0xf, true))
    v += WS_DPP(0x111, 0xf);
    v += WS_DPP(0x112, 0xf);
    v += WS_DPP(0x114, 0xf);
    v += WS_DPP(0x118, 0xf);
    v += WS_DPP(0x142, 0xa);
    v += WS_DPP(0x143, 0xc);
#undef WS_DPP
    return __builtin_bit_cast(float, __builtin_amdgcn_readlane(__builtin_bit_cast(int, v), 63));
}
__device__ __forceinline__ unsigned f2bf(float f) { unsigned u = __builtin_bit_cast(unsigned, f); return (u + 0x7fffu + ((u >> 16) & 1u)) >> 16; }
__device__ __forceinline__ unsigned pk2(float lo, float hi) { return f2bf(lo) | (f2bf(hi) << 16); }
__device__ __forceinline__ float bflo(unsigned w) { return __uint_as_float(w << 16); }
__device__ __forceinline__ float bfhi(unsigned w) { return __uint_as_float(w & 0xffff0000u); }
__device__ __forceinline__ void unpack8(const v4u w, float* f) { f[0] = bflo(w.x); f[1] = bfhi(w.x); f[2] = bflo(w.y); f[3] = bfhi(w.y); f[4] = bflo(w.z); f[5] = bfhi(w.z); f[6] = bflo(w.w); f[7] = bfhi(w.w); }
__device__ __forceinline__ int lane_id_now() { int l; asm volatile("v_mbcnt_lo_u32_b32 %0, -1, 0\n\tv_mbcnt_hi_u32_b32 %0, -1, %0" : "=v"(l)); return l; }
namespace pg8 {
#define PG8_LAS __attribute__((address_space(3)))
typedef unsigned short bf16_t;
typedef short bf16x8 __attribute__((ext_vector_type(8)));
typedef float f32x4 __attribute__((ext_vector_type(4)));
typedef unsigned u32x4 __attribute__((ext_vector_type(4)));
constexpr int BM = 256, BK = 64, HALF = 128, HTB = HALF * BK * 2  , STAGE_BYTES = 8 * HTB, NXCD = 8, WGM = 8;

__host__ __device__ __forceinline__ int lds_byte(int r, int c) { const int st = (r >> 4) * 2 + (c >> 5), rr = r & 15, cc = c & 31, ob = rr * 64 + cc * 2; return st * 1024 + (ob ^ (((ob >> 9) & 1) << 5)); }
__host__ __device__ __forceinline__ void stage_rc(int b, int& R, int& C) { const int st = b / 1024, sb = b % 1024, swz = sb ^ (((sb >> 9) & 1) << 5); R = (st >> 1) * 16 + swz / 64; C = (st & 1) * 32 + (swz % 64) / 2; }
__host__ __device__ __forceinline__ int perm32(int rho) { const int n = rho >> 4, i = rho & 15; return 8 * (i >> 2) + 4 * n + (i & 3); }

struct Unit { int pm, pn; };
struct Gemm { const bf16_t* A; const bf16_t* Bt; int M, N, K, lda, ldb; };

struct StaticOrder {
    int nM, nN, nwg, G, c;
    __host__ __device__ void init(int M, int N, int G_, int c_) { nM = M / BM; nN = N / BM; nwg = nM * nN; G = G_; c = c_; }
    __host__ __device__ bool next(int i, Unit& u) const {
        const long L = (long)i * G + c; if (L >= nwg) return false;
        int wgid = (int)L; { const int q = nwg / NXCD, r = nwg % NXCD, xcd = wgid % NXCD, off = wgid / NXCD; wgid = (xcd < r ? xcd * (q + 1) : r * (q + 1) + (xcd - r) * q) + off; }
        const int nig = WGM * nN, gid = wgid / nig, fm = gid * WGM, gsz = (nM - fm) < WGM ? (nM - fm) : WGM;
        u.pm = fm + ((wgid % nig) % gsz); u.pn = (wgid % nig) / gsz; return true;
    }
    __device__ __forceinline__ void a_ready(const Unit&) const {}
    __device__ __forceinline__ void done(const Unit&) const {}
};

__device__ __forceinline__ unsigned cvt_pk_bf16(float lo, float hi) { unsigned r; asm volatile("v_cvt_pk_bf16_f32 %0, %1, %2" : "=v"(r) : "v"(lo), "v"(hi)); return r; }
typedef float f32x2 __attribute__((ext_vector_type(2)));
__device__ __forceinline__ f32x2 gelu_pk(f32x2 v) {
    const f32x2 av = __builtin_elementwise_abs(v), d = av * 0.2316418882f + 1.0f;
    f32x2 t; t.x = __builtin_amdgcn_rcpf(d.x); t.y = __builtin_amdgcn_rcpf(d.y);
    f32x2 q = t * 0.5307027145f + (-0.7265760135f); q = q * t + 0.7107068705f; q = q * t + (-0.142248368f); q = q * t + 0.127414796f; q = q * t;
    const f32x2 s = (v * v) * (-0.72134752044f);
    f32x2 e; e.x = __builtin_amdgcn_exp2f(s.x); e.y = __builtin_amdgcn_exp2f(s.y);
    const f32x2 m = v * (q * e), r = v - m;
    f32x2 o; o.x = v.x < 0.f ? m.x : r.x; o.y = v.y < 0.f ? m.y : r.y; return o;
}

template <int ACT  > struct EpiBf16 {
    static constexpr bool PERM = true, AFTER_DRAIN = false; static_assert(ACT == 0 || ACT == 1, "EpiBf16: ACT is 0 (none) or 1 (gelu_pk)");
    bf16_t* O; int ldc; const float* bias; int split_cols; size_t split_stride; float scale0;
    __device__ __forceinline__ void operator()(const f32x4 (&acc)[2][2][4][2], const Unit& u, int wr, int wc, int fr, int fq) const {
        const int row0 = u.pm * BM + wr * 64 + fr; int colt = u.pn * BM; bf16_t* base = O;
        float sc = 1.f; if (split_cols) { const int t = colt / split_cols; base += (size_t)t * split_stride; colt -= t * split_cols; if (t == 0) sc = scale0; }
        const int col0 = colt + wc * 32 + 8 * fq, bcol0 = u.pn * BM + wc * 32 + 8 * fq;
        f32x4 bv[2][2];
#pragma unroll
        for (int bj = 0; bj < 2; ++bj)
#pragma unroll
            for (int n = 0; n < 2; ++n) bv[bj][n] = bias ? *(const f32x4*)(bias + bcol0 + bj * HALF + 4 * n) : (f32x4){0.f, 0.f, 0.f, 0.f};
#pragma unroll
        for (int ai = 0; ai < 2; ++ai)
#pragma unroll
            for (int m = 0; m < 4; ++m) { bf16_t* rowp = base + (size_t)(row0 + ai * HALF + m * 16) * ldc + col0;
#pragma unroll
                for (int bj = 0; bj < 2; ++bj) { f32x4 v0 = acc[ai][bj][m][0] + bv[bj][0], v1 = acc[ai][bj][m][1] + bv[bj][1];
                    if (ACT == 1) { f32x2 a = gelu_pk((f32x2){v0[0], v0[1]}), b = gelu_pk((f32x2){v0[2], v0[3]}), c = gelu_pk((f32x2){v1[0], v1[1]}), d = gelu_pk((f32x2){v1[2], v1[3]});
                        v0 = (f32x4){a.x, a.y, b.x, b.y}; v1 = (f32x4){c.x, c.y, d.x, d.y}; }
                    v0 = v0 * sc; v1 = v1 * sc; u32x4 w; w.x = cvt_pk_bf16(v0[0], v0[1]); w.y = cvt_pk_bf16(v0[2], v0[3]); w.z = cvt_pk_bf16(v1[0], v1[1]); w.w = cvt_pk_bf16(v1[2], v1[3]);
                    *(u32x4*)(rowp + bj * HALF) = w; } }
    }
};
template <class Epi, class Sched, bool ALIGN_EPI = false, bool SP2 = false>
__device__ __forceinline__ void gemm_phase(PG8_LAS unsigned char* lds, const Gemm g, const Sched& S, const Epi& E, const int tid) {
    const int wid = __builtin_amdgcn_readfirstlane(tid >> 6), lane = tid & 63, wr = wid >> 2, wc = wid & 3, fr = lane & 15, fq = lane >> 4;
    int K = g.K; asm volatile("" : "+s"(K));
    const int nt = K / BK;
    unsigned voffA[2], voffB[2];
#pragma unroll
    for (int i = 0; i < 2; ++i) { int R, C; stage_rc(tid * 16 + i * 8192, R, C); const int Rb = Epi::PERM ? ((R & ~31) + perm32(R & 31)) : R;
        voffA[i] = (unsigned)(R * g.lda + C) * 2u; voffB[i] = (unsigned)(Rb * g.ldb + C) * 2u; }
    const size_t kstep = (size_t)(BK * 2);
    const size_t hstepA = (size_t)HALF * g.lda * 2, hstepB = (size_t)HALF * g.ldb * 2;
    const size_t tstepA = 2 * hstepA, tstepB = 2 * hstepB;
    const unsigned ldsw = (unsigned)wid * 1024u;
    const int aoff = lds_byte(wr * 64 + fr, fq * 8), boff = lds_byte(wc * 32 + fr, fq * 8);
#define PG8_SA(b, h) (((b) * 2 + (h)) * HTB)
#define PG8_SB(b, h) ((4 + (b) * 2 + (h)) * HTB)
#define PG8_STAGE(bufoff, gbase, voff) do { _Pragma("unroll") for (int _i = 0; _i < 2; ++_i) \
        __builtin_amdgcn_global_load_lds((const unsigned*)((const char*)(gbase) + (voff)[_i]), (PG8_LAS unsigned*)(lds + (bufoff) + ldsw + _i * 8192), 16, 0, 0); } while (0)
#define PG8_LDA(dst, b, h) do { _Pragma("unroll") for (int m = 0; m < 4; ++m) _Pragma("unroll") for (int k = 0; k < 2; ++k) dst[m][k] = *(const PG8_LAS bf16x8*)(lds + PG8_SA(b, h) + aoff + m * 2048 + k * 1024); } while (0)
#define PG8_LDB(dst, b, h) do { _Pragma("unroll") for (int n = 0; n < 2; ++n) _Pragma("unroll") for (int k = 0; k < 2; ++k) dst[n][k] = *(const PG8_LAS bf16x8*)(lds + PG8_SB(b, h) + boff + n * 2048 + k * 1024); } while (0)
#define PG8_MMA(ai, bj, At, Bt) do { __builtin_amdgcn_s_setprio(1); _Pragma("unroll") for (int m = 0; m < 4; ++m) _Pragma("unroll") for (int n = 0; n < 2; ++n) _Pragma("unroll") for (int k = 0; k < 2; ++k) \
        acc[ai][bj][m][n] = __builtin_amdgcn_mfma_f32_16x16x32_bf16(Bt[n][k], At[m][k], acc[ai][bj][m][n], 0, 0, 0); __builtin_amdgcn_s_setprio(0); } while (0)
#define PG8_WAIT_V(n) asm volatile("s_waitcnt vmcnt(" #n ")" ::: "memory")
#define PG8_WAIT_L(n) asm volatile("s_waitcnt lgkmcnt(" #n ")" ::: "memory")
#define PG8_BAR __builtin_amdgcn_s_barrier()
#define PG8_SCHED __builtin_amdgcn_sched_barrier(0)
    Unit cur, nxt; int ui = 0;
    if (!S.next(0, cur)) return;
    f32x4 acc[2][2][4][2];
#pragma unroll
    for (int a = 0; a < 2; ++a)
#pragma unroll
        for (int b = 0; b < 2; ++b)
#pragma unroll
            for (int m = 0; m < 4; ++m)
#pragma unroll
                for (int n = 0; n < 2; ++n) acc[a][b][m][n] = (f32x4){0.f, 0.f, 0.f, 0.f};
    bf16x8 At[4][2], B0[2][2], B1[2][2];
    const char* cA = (const char*)g.A + (size_t)cur.pm * tstepA; const char* cB = (const char*)g.Bt + (size_t)cur.pn * tstepB;
    S.a_ready(cur);
    if constexpr (SP2) {
        PG8_STAGE(PG8_SB(0, 0), cB, voffB); PG8_STAGE(PG8_SB(0, 1), cB + hstepB, voffB); PG8_STAGE(PG8_SA(0, 0), cA, voffA); PG8_STAGE(PG8_SA(0, 1), cA + hstepA, voffA);
        if (wr == 1) PG8_BAR;
        PG8_WAIT_V(2); PG8_BAR;
        PG8_STAGE(PG8_SB(1, 0), cB + kstep, voffB); PG8_STAGE(PG8_SA(1, 0), cA + kstep, voffA); PG8_STAGE(PG8_SB(1, 1), cB + hstepB + kstep, voffB);
        PG8_WAIT_V(6); PG8_BAR;
    } else {
        PG8_STAGE(PG8_SB(0, 0), cB, voffB); PG8_STAGE(PG8_SA(0, 0), cA, voffA); PG8_STAGE(PG8_SB(0, 1), cB + hstepB, voffB); PG8_STAGE(PG8_SA(0, 1), cA + hstepA, voffA);
        if (wr == 1) PG8_BAR;
        PG8_WAIT_V(4); PG8_BAR;
        PG8_STAGE(PG8_SB(1, 0), cB + kstep, voffB); PG8_STAGE(PG8_SA(1, 0), cA + kstep, voffA); PG8_STAGE(PG8_SB(1, 1), cB + hstepB + kstep, voffB);
        PG8_WAIT_V(6); PG8_BAR;
    }
    for (;;) {
        const bool has_next = S.next(ui + 1, nxt);
        const char* nA = has_next ? (const char*)g.A + (size_t)nxt.pm * tstepA : cA; const char* nB = has_next ? (const char*)g.Bt + (size_t)nxt.pn * tstepB : cB;
        for (int t = 0; t < nt; t += 2) {
            const bool last = (t == nt - 2);
            const char* a1 = cA + (size_t)(t + 1) * kstep;
            const char* a2 = last ? nA : cA + (size_t)(t + 2) * kstep; const char* b2 = last ? nB : cB + (size_t)(t + 2) * kstep;
            const char* a3 = a2 + kstep; const char* b3 = b2 + kstep;
            if (last && has_next) S.a_ready(nxt);
            if constexpr (SP2) {
            PG8_LDB(B0, 0, 0); PG8_LDB(B1, 0, 1); PG8_SCHED; PG8_LDA(At, 0, 0); PG8_STAGE(PG8_SA(1, 1), a1 + hstepA, voffA);
            PG8_WAIT_V(8); PG8_WAIT_L(0); PG8_BAR; PG8_MMA(0, 0, At, B0); PG8_MMA(0, 1, At, B1); PG8_BAR; PG8_SCHED;
            PG8_LDA(At, 0, 1); PG8_STAGE(PG8_SB(0, 0), b2, voffB); PG8_STAGE(PG8_SB(0, 1), b2 + hstepB, voffB); PG8_STAGE(PG8_SA(0, 0), a2, voffA);
            PG8_WAIT_V(8); PG8_WAIT_L(0); PG8_BAR; PG8_MMA(1, 0, At, B0); PG8_MMA(1, 1, At, B1); PG8_BAR; PG8_SCHED;
            PG8_LDB(B0, 1, 0); PG8_LDB(B1, 1, 1); PG8_SCHED; PG8_LDA(At, 1, 0); PG8_STAGE(PG8_SA(0, 1), a2 + hstepA, voffA);
            PG8_WAIT_V(8); PG8_WAIT_L(0); PG8_BAR; PG8_MMA(0, 0, At, B0); PG8_MMA(0, 1, At, B1); PG8_BAR; PG8_SCHED;
            PG8_LDA(At, 1, 1); PG8_STAGE(PG8_SB(1, 0), b3, voffB); PG8_STAGE(PG8_SB(1, 1), b3 + hstepB, voffB); PG8_STAGE(PG8_SA(1, 0), a3, voffA);
            PG8_WAIT_V(8); PG8_WAIT_L(0); PG8_BAR; PG8_MMA(1, 0, At, B0); PG8_MMA(1, 1, At, B1); PG8_BAR; PG8_SCHED;
            } else {
            PG8_LDB(B0, 0, 0); PG8_SCHED; PG8_LDA(At, 0, 0); PG8_STAGE(PG8_SA(1, 1), a1 + hstepA, voffA);
            PG8_WAIT_L(8); PG8_BAR; PG8_WAIT_L(0); PG8_MMA(0, 0, At, B0); PG8_BAR; PG8_SCHED;
            PG8_LDB(B1, 0, 1); PG8_STAGE(PG8_SB(0, 0), b2, voffB);
            PG8_BAR; PG8_WAIT_L(0); PG8_MMA(0, 1, At, B1); PG8_BAR;
            PG8_LDA(At, 0, 1); PG8_STAGE(PG8_SA(0, 0), a2, voffA);
            PG8_BAR; PG8_WAIT_L(0); PG8_MMA(1, 0, At, B0); PG8_BAR; PG8_SCHED;
            PG8_STAGE(PG8_SB(0, 1), b2 + hstepB, voffB);
            PG8_WAIT_V(6); PG8_BAR; PG8_MMA(1, 1, At, B1); PG8_BAR;
            PG8_LDB(B0, 1, 0); PG8_SCHED; PG8_LDA(At, 1, 0); PG8_STAGE(PG8_SA(0, 1), a2 + hstepA, voffA);
            PG8_WAIT_L(8); PG8_BAR; PG8_WAIT_L(0); PG8_MMA(0, 0, At, B0); PG8_BAR; PG8_SCHED;
            PG8_LDB(B1, 1, 1); PG8_STAGE(PG8_SB(1, 0), b3, voffB);
            PG8_BAR; PG8_WAIT_L(0); PG8_MMA(0, 1, At, B1); PG8_BAR;
            PG8_LDA(At, 1, 1); PG8_STAGE(PG8_SA(1, 0), a3, voffA);
            PG8_BAR; PG8_WAIT_L(0); PG8_MMA(1, 0, At, B0); PG8_BAR; PG8_SCHED;
            PG8_STAGE(PG8_SB(1, 1), b3 + hstepB, voffB);
            PG8_WAIT_V(6); PG8_BAR; PG8_MMA(1, 1, At, B1); PG8_BAR;
            }
        }
        if constexpr (ALIGN_EPI) { if (wr == 0) PG8_BAR; }
        if constexpr (!Epi::AFTER_DRAIN) { E(acc, cur, wr, wc, fr, fq); S.done(cur); }
        if (!has_next) break;
#pragma unroll
        for (int a = 0; a < 2; ++a)
#pragma unroll
            for (int b = 0; b < 2; ++b)
#pragma unroll
                for (int m = 0; m < 4; ++m)
#pragma unroll
                    for (int n = 0; n < 2; ++n) acc[a][b][m][n] = (f32x4){0.f, 0.f, 0.f, 0.f};
        cur = nxt; cA = nA; cB = nB; ++ui;
        if constexpr (ALIGN_EPI) { if (wr == 1) PG8_BAR; }
    }
    PG8_WAIT_V(0);
    if constexpr (!ALIGN_EPI) { if (wr == 0) PG8_BAR; }
    PG8_BAR;
    if constexpr (Epi::AFTER_DRAIN) { E.fused(acc, cur, wr, wc, fr, fq, lds, wid, lane); S.done(cur); }
#undef PG8_SA
#undef PG8_SB
#undef PG8_STAGE
#undef PG8_LDA
#undef PG8_LDB
#undef PG8_MMA
#undef PG8_WAIT_V
#undef PG8_WAIT_L
#undef PG8_BAR
#undef PG8_SCHED
}
template <class Epi, class Sched, bool ALIGN_EPI = false, bool SP2 = false>
__device__ __forceinline__ void gemm_phase_ga(PG8_LAS unsigned char* lds, const Gemm g, const Sched& S, const Epi& E, const int tid, const unsigned (&g0)[2][2], const unsigned (&g1)[2][2]) {
    unsigned ca0[2] = {g0[0][0], g0[0][1]}, ca1[2] = {g0[1][0], g0[1][1]}; const unsigned na0[2] = {g1[0][0], g1[0][1]}, na1[2] = {g1[1][0], g1[1][1]};
    const int wid = __builtin_amdgcn_readfirstlane(tid >> 6), lane = tid & 63, wr = wid >> 2, wc = wid & 3, fr = lane & 15, fq = lane >> 4;
    int K = g.K; asm volatile("" : "+s"(K));
    const int nt = K / BK;
    unsigned voffA[2], voffB[2];
#pragma unroll
    for (int i = 0; i < 2; ++i) { int R, C; stage_rc(tid * 16 + i * 8192, R, C); const int Rb = Epi::PERM ? ((R & ~31) + perm32(R & 31)) : R;
        voffA[i] = (unsigned)(R * g.lda + C) * 2u; voffB[i] = (unsigned)(Rb * g.ldb + C) * 2u; }
    const size_t kstep = (size_t)(BK * 2);
    const size_t hstepA = (size_t)HALF * g.lda * 2, hstepB = (size_t)HALF * g.ldb * 2;
    const size_t tstepA = 2 * hstepA, tstepB = 2 * hstepB;
    const unsigned ldsw = (unsigned)wid * 1024u;
    const int aoff = lds_byte(wr * 64 + fr, fq * 8), boff = lds_byte(wc * 32 + fr, fq * 8);
#define PG8_SA(b, h) (((b) * 2 + (h)) * HTB)
#define PG8_SB(b, h) ((4 + (b) * 2 + (h)) * HTB)
#define PG8_STAGE(bufoff, gbase, voff) do { _Pragma("unroll") for (int _i = 0; _i < 2; ++_i) \
        __builtin_amdgcn_global_load_lds((const unsigned*)((const char*)(gbase) + (voff)[_i]), (PG8_LAS unsigned*)(lds + (bufoff) + ldsw + _i * 8192), 16, 0, 0); } while (0)
#define PG8_LDA(dst, b, h) do { _Pragma("unroll") for (int m = 0; m < 4; ++m) _Pragma("unroll") for (int k = 0; k < 2; ++k) dst[m][k] = *(const PG8_LAS bf16x8*)(lds + PG8_SA(b, h) + aoff + m * 2048 + k * 1024); } while (0)
#define PG8_LDB(dst, b, h) do { _Pragma("unroll") for (int n = 0; n < 2; ++n) _Pragma("unroll") for (int k = 0; k < 2; ++k) dst[n][k] = *(const PG8_LAS bf16x8*)(lds + PG8_SB(b, h) + boff + n * 2048 + k * 1024); } while (0)
#define PG8_MMA(ai, bj, At, Bt) do { __builtin_amdgcn_s_setprio(1); _Pragma("unroll") for (int m = 0; m < 4; ++m) _Pragma("unroll") for (int n = 0; n < 2; ++n) _Pragma("unroll") for (int k = 0; k < 2; ++k) \
        acc[ai][bj][m][n] = __builtin_amdgcn_mfma_f32_16x16x32_bf16(Bt[n][k], At[m][k], acc[ai][bj][m][n], 0, 0, 0); __builtin_amdgcn_s_setprio(0); } while (0)
#define PG8_WAIT_V(n) asm volatile("s_waitcnt vmcnt(" #n ")" ::: "memory")
#define PG8_WAIT_L(n) asm volatile("s_waitcnt lgkmcnt(" #n ")" ::: "memory")
#define PG8_BAR __builtin_amdgcn_s_barrier()
#define PG8_SCHED __builtin_amdgcn_sched_barrier(0)
    Unit cur, nxt; int ui = 0;
    if (!S.next(0, cur)) return;
    f32x4 acc[2][2][4][2];
#pragma unroll
    for (int a = 0; a < 2; ++a)
#pragma unroll
        for (int b = 0; b < 2; ++b)
#pragma unroll
            for (int m = 0; m < 4; ++m)
#pragma unroll
                for (int n = 0; n < 2; ++n) acc[a][b][m][n] = (f32x4){0.f, 0.f, 0.f, 0.f};
    bf16x8 At[4][2], B0[2][2], B1[2][2];
    const char* cA = (const char*)g.A; const char* cB = (const char*)g.Bt + (size_t)cur.pn * tstepB;
    S.a_ready(cur);
    if constexpr (SP2) {
        PG8_STAGE(PG8_SB(0, 0), cB, voffB); PG8_STAGE(PG8_SB(0, 1), cB + hstepB, voffB); PG8_STAGE(PG8_SA(0, 0), cA, ca0); PG8_STAGE(PG8_SA(0, 1), cA, ca1);
        if (wr == 1) PG8_BAR;
        PG8_WAIT_V(2); PG8_BAR;
        PG8_STAGE(PG8_SB(1, 0), cB + kstep, voffB); PG8_STAGE(PG8_SA(1, 0), cA + kstep, ca0); PG8_STAGE(PG8_SB(1, 1), cB + hstepB + kstep, voffB);
        PG8_WAIT_V(6); PG8_BAR;
    } else {
        PG8_STAGE(PG8_SB(0, 0), cB, voffB); PG8_STAGE(PG8_SA(0, 0), cA, ca0); PG8_STAGE(PG8_SB(0, 1), cB + hstepB, voffB); PG8_STAGE(PG8_SA(0, 1), cA, ca1);
        if (wr == 1) PG8_BAR;
        PG8_WAIT_V(4); PG8_BAR;
        PG8_STAGE(PG8_SB(1, 0), cB + kstep, voffB); PG8_STAGE(PG8_SA(1, 0), cA + kstep, ca0); PG8_STAGE(PG8_SB(1, 1), cB + hstepB + kstep, voffB);
        PG8_WAIT_V(6); PG8_BAR;
    }
    for (;;) {
        const bool has_next = S.next(ui + 1, nxt);
        const char* nA = cA; const char* nB = has_next ? (const char*)g.Bt + (size_t)nxt.pn * tstepB : cB;
        for (int t = 0; t < nt; t += 2) {
            const bool last = (t == nt - 2);
            const unsigned o20[2] = {last ? na0[0] : ca0[0], last ? na0[1] : ca0[1]}, o21[2] = {last ? na1[0] : ca1[0], last ? na1[1] : ca1[1]};
            const char* a1 = cA + (size_t)(t + 1) * kstep;
            const char* a2 = last ? nA : cA + (size_t)(t + 2) * kstep; const char* b2 = last ? nB : cB + (size_t)(t + 2) * kstep;
            const char* a3 = a2 + kstep; const char* b3 = b2 + kstep;
            if (last && has_next) S.a_ready(nxt);
            if constexpr (SP2) {
            PG8_LDB(B0, 0, 0); PG8_LDB(B1, 0, 1); PG8_SCHED; PG8_LDA(At, 0, 0); PG8_STAGE(PG8_SA(1, 1), a1, ca1);
            PG8_WAIT_V(8); PG8_WAIT_L(0); PG8_BAR; PG8_MMA(0, 0, At, B0); PG8_MMA(0, 1, At, B1); PG8_BAR; PG8_SCHED;
            PG8_LDA(At, 0, 1); PG8_STAGE(PG8_SB(0, 0), b2, voffB); PG8_STAGE(PG8_SB(0, 1), b2 + hstepB, voffB); PG8_STAGE(PG8_SA(0, 0), a2, o20);
            PG8_WAIT_V(8); PG8_WAIT_L(0); PG8_BAR; PG8_MMA(1, 0, At, B0); PG8_MMA(1, 1, At, B1); PG8_BAR; PG8_SCHED;
            PG8_LDB(B0, 1, 0); PG8_LDB(B1, 1, 1); PG8_SCHED; PG8_LDA(At, 1, 0); PG8_STAGE(PG8_SA(0, 1), a2, o21);
            PG8_WAIT_V(8); PG8_WAIT_L(0); PG8_BAR; PG8_MMA(0, 0, At, B0); PG8_MMA(0, 1, At, B1); PG8_BAR; PG8_SCHED;
            PG8_LDA(At, 1, 1); PG8_STAGE(PG8_SB(1, 0), b3, voffB); PG8_STAGE(PG8_SB(1, 1), b3 + hstepB, voffB); PG8_STAGE(PG8_SA(1, 0), a3, o20);
            PG8_WAIT_V(8); PG8_WAIT_L(0); PG8_BAR; PG8_MMA(1, 0, At, B0); PG8_MMA(1, 1, At, B1); PG8_BAR; PG8_SCHED;
            } else {
            PG8_LDB(B0, 0, 0); PG8_SCHED; PG8_LDA(At, 0, 0); PG8_STAGE(PG8_SA(1, 1), a1, ca1);
            PG8_WAIT_L(8); PG8_BAR; PG8_WAIT_L(0); PG8_MMA(0, 0, At, B0); PG8_BAR; PG8_SCHED;
            PG8_LDB(B1, 0, 1); PG8_STAGE(PG8_SB(0, 0), b2, voffB);
            PG8_BAR; PG8_WAIT_L(0); PG8_MMA(0, 1, At, B1); PG8_BAR;
            PG8_LDA(At, 0, 1); PG8_STAGE(PG8_SA(0, 0), a2, o20);
            PG8_BAR; PG8_WAIT_L(0); PG8_MMA(1, 0, At, B0); PG8_BAR; PG8_SCHED;
            PG8_STAGE(PG8_SB(0, 1), b2 + hstepB, voffB);
            PG8_WAIT_V(6); PG8_BAR; PG8_MMA(1, 1, At, B1); PG8_BAR;
            PG8_LDB(B0, 1, 0); PG8_SCHED; PG8_LDA(At, 1, 0); PG8_STAGE(PG8_SA(0, 1), a2, o21);
            PG8_WAIT_L(8); PG8_BAR; PG8_WAIT_L(0); PG8_MMA(0, 0, At, B0); PG8_BAR; PG8_SCHED;
            PG8_LDB(B1, 1, 1); PG8_STAGE(PG8_SB(1, 0), b3, voffB);
            PG8_BAR; PG8_WAIT_L(0); PG8_MMA(0, 1, At, B1); PG8_BAR;
            PG8_LDA(At, 1, 1); PG8_STAGE(PG8_SA(1, 0), a3, o20);
            PG8_BAR; PG8_WAIT_L(0); PG8_MMA(1, 0, At, B0); PG8_BAR; PG8_SCHED;
            PG8_STAGE(PG8_SB(1, 1), b3 + hstepB, voffB);
            PG8_WAIT_V(6); PG8_BAR; PG8_MMA(1, 1, At, B1); PG8_BAR;
            }
        }
        if constexpr (ALIGN_EPI) { if (wr == 0) PG8_BAR; }
        if constexpr (!Epi::AFTER_DRAIN) { E(acc, cur, wr, wc, fr, fq); S.done(cur); }
        if (!has_next) break;
#pragma unroll
        for (int a = 0; a < 2; ++a)
#pragma unroll
            for (int b = 0; b < 2; ++b)
#pragma unroll
                for (int m = 0; m < 4; ++m)
#pragma unroll
                    for (int n = 0; n < 2; ++n) acc[a][b][m][n] = (f32x4){0.f, 0.f, 0.f, 0.f};
        cur = nxt; cA = nA; cB = nB; ++ui;
        ca0[0] = na0[0]; ca0[1] = na0[1]; ca1[0] = na1[0]; ca1[1] = na1[1];
        if constexpr (ALIGN_EPI) { if (wr == 1) PG8_BAR; }
    }
    PG8_WAIT_V(0);
    if constexpr (!ALIGN_EPI) { if (wr == 0) PG8_BAR; }
    PG8_BAR;
    if constexpr (Epi::AFTER_DRAIN) { E.fused(acc, cur, wr, wc, fr, fq, lds, wid, lane); S.done(cur); }
#undef PG8_SA
#undef PG8_SB
#undef PG8_STAGE
#undef PG8_LDA
#undef PG8_LDB
#undef PG8_MMA
#undef PG8_WAIT_V
#undef PG8_WAIT_L
#undef PG8_BAR
#undef PG8_SCHED
}
}
#define XB_TMO      128
#define XB_XCNT(j)  (256  + 64 * (j))
#define XB_XSUB(j)  (1280 + 64 * (j))
#define XB_XGEN(j)  (2304 + 64 * (j))
#define XB_TOP      3328
#define XB_TOPGEN   3392
#define XCD_BAR_WORDS 3456
#define XB_SPIN_CAP (1u << 18)

__device__ __forceinline__ unsigned xb_ld(unsigned* p)              { return __hip_atomic_load(p, __ATOMIC_RELAXED, __HIP_MEMORY_SCOPE_AGENT); }
__device__ __forceinline__ unsigned xb_add(unsigned* p, unsigned v) { return __hip_atomic_fetch_add(p, v, __ATOMIC_RELAXED, __HIP_MEMORY_SCOPE_AGENT); }
__device__ __forceinline__ unsigned xb_xcc_id() { return (unsigned)__builtin_amdgcn_s_getreg((3 << 11) | 20) & 0xFu; }
#define XB_SPIN(cond, bar) do { unsigned _sp = 0; while (cond) { __builtin_amdgcn_s_sleep(1); \
    if ((++_sp & 255u) == 0u) { if (xb_ld(&(bar)[XB_TMO])) break; if (_sp > XB_SPIN_CAP) { atomicAdd(&(bar)[XB_TMO], 1u); break; } } } } while (0)

struct XcdBarrier {
    unsigned* bar; unsigned x;
    volatile LAS unsigned* st;
};

__device__ __forceinline__ XcdBarrier xcd_barrier_post(unsigned* bar, volatile LAS unsigned* st) {
    XcdBarrier b; b.bar = bar; b.x = xb_xcc_id(); b.st = st;
    if (threadIdx.x == 0) (void)xb_add(&bar[XB_XCNT(b.x)], 1u);
    return b;
}
__device__ __forceinline__ void xcd_barrier_complete(unsigned* bar, unsigned x, unsigned& nloc, unsigned& nx) {
    const unsigned G = gridDim.x * gridDim.y * gridDim.z;
    unsigned sum, cnt, mine, sp = 0u;
    for (;;) {
        sum = 0u; cnt = 0u; mine = 0u;
#pragma unroll
        for (unsigned j = 0; j < 16; ++j) { const unsigned c = xb_ld(&bar[XB_XCNT(j)]); sum += c; cnt += (c > 0u) ? 1u : 0u; mine = (j == x) ? c : mine; }
        if (sum == G) break;
        __builtin_amdgcn_s_sleep(1);
        if ((++sp & 255u) == 0u) { if (xb_ld(&bar[XB_TMO])) break; if (sp > XB_SPIN_CAP) { atomicAdd(&bar[XB_TMO], 1u); break; } }
    }
    nloc = mine > 0u ? mine : 1u; nx = cnt > 0u ? cnt : 1u;
}

__device__ __forceinline__ void xcd_barrier(const XcdBarrier& b, const bool is_t0, const bool is_t1 = false) {
    asm volatile("s_waitcnt vmcnt(0)" ::: "memory");
    __syncthreads();
    if (is_t1) {
        __builtin_amdgcn_fence(__ATOMIC_ACQUIRE, "agent");
        asm volatile("s_waitcnt vmcnt(0)" ::: "memory");
    }
    if (is_t0) {
        unsigned* bar = b.bar;
        __builtin_amdgcn_s_waitcnt(0);
        unsigned nloc = b.st[0], nx = b.st[1];
        if (nloc == 0u) { xcd_barrier_complete(bar, b.x, nloc, nx); b.st[0] = nloc; b.st[1] = nx; }
        const unsigned old = xb_add(&bar[XB_XSUB(b.x)], 1u);
        const unsigned gen = old / nloc;
        if (old + 1u == (gen + 1u) * nloc) {
            __builtin_amdgcn_fence(__ATOMIC_RELEASE, "agent");
            asm volatile("s_waitcnt vmcnt(0)" ::: "memory");
            const unsigned og = xb_add(&bar[XB_TOP], 1u);
            const unsigned tg = og / nx;
            if (og + 1u == (tg + 1u) * nx) xb_add(&bar[XB_TOPGEN], 1u);
            else XB_SPIN(xb_ld(&bar[XB_TOPGEN]) == tg, bar);
            asm volatile("" ::: "memory");
            xb_add(&bar[XB_XGEN(b.x)], 1u);
            asm volatile("s_waitcnt vmcnt(0)" ::: "memory");
        } else {
            XB_SPIN(xb_ld(&bar[XB_XGEN(b.x)]) == gen, bar);
            asm volatile("" ::: "memory");
            asm volatile("s_waitcnt vmcnt(0)" ::: "memory");
        }
    }
    __syncthreads();
}

#define XB2_FLAG(r) (64 * (r))
__device__ __forceinline__ void xcd_barrier_complete2(unsigned* bar, unsigned x, unsigned& nloc, unsigned& mask) {
    const unsigned G = gridDim.x * gridDim.y * gridDim.z;
    unsigned sum, msk, mine, sp = 0u;
    for (;;) {
        sum = 0u; msk = 0u; mine = 0u;
#pragma unroll
        for (unsigned j = 0; j < 16; ++j) { const unsigned c = xb_ld(&bar[XB_XCNT(j)]); sum += c; msk |= (c > 0u) ? (1u << j) : 0u; mine = (j == x) ? c : mine; }
        if (sum == G) break;
        __builtin_amdgcn_s_sleep(1);
        if ((++sp & 255u) == 0u) { if (xb_ld(&bar[XB_TMO])) break; if (sp > XB_SPIN_CAP) { atomicAdd(&bar[XB_TMO], 1u); break; } }
    }
    nloc = mine > 0u ? mine : 1u; mask = msk | (1u << x);
}
__device__ __forceinline__ void xcd_barrier2(const XcdBarrier& b, unsigned* flags, const int wave_s) {
    asm volatile("s_waitcnt vmcnt(0)" ::: "memory");
    __syncthreads();
    if (wave_s == 1) {
        if (lane_id_now() == 0) { __builtin_amdgcn_fence(__ATOMIC_ACQUIRE, "agent"); asm volatile("s_waitcnt vmcnt(0)" ::: "memory"); }
    }
    if (wave_s == 0) {
        unsigned* bar = b.bar;
        const int lane = lane_id_now();
        if (lane == 0) {
            __builtin_amdgcn_s_waitcnt(0);
            unsigned nloc = b.st[0], mask = b.st[1];
            if (nloc == 0u) { xcd_barrier_complete2(bar, b.x, nloc, mask); b.st[0] = nloc; b.st[1] = mask; }
            const unsigned gen = b.st[2] + 1u; b.st[2] = gen;
            const unsigned old = xb_add(&bar[XB_XSUB(b.x)], 1u);
            if (old + 1u == gen * nloc) {
                __builtin_amdgcn_fence(__ATOMIC_RELEASE, "agent");
                asm volatile("s_waitcnt vmcnt(0)" ::: "memory");
#pragma unroll 1
                for (unsigned r = 0; r < 16; ++r) if ((mask >> r) & 1u) __hip_atomic_store(&flags[XB2_FLAG(r) + b.x], gen, __ATOMIC_RELAXED, __HIP_MEMORY_SCOPE_AGENT);
            }
        }
        const unsigned gen = b.st[2], mask = b.st[1];
        if (lane < 16) {
            const bool need = (mask >> lane) & 1u;
            unsigned sp = 0u;
            for (;;) {
                const unsigned v = xb_ld(&flags[XB2_FLAG(b.x) + lane]);
                const bool ok = !need || (int)(v - gen) >= 0;
                if (__builtin_amdgcn_ballot_w64(!ok) == 0ull) break;
                __builtin_amdgcn_s_sleep(1);
                if ((++sp & 255u) == 0u) { if (xb_ld(&bar[XB_TMO])) break; if (sp > XB_SPIN_CAP) { if (lane == 0) atomicAdd(&bar[XB_TMO], 1u); break; } }
            }
        }
        asm volatile("s_waitcnt vmcnt(0)" ::: "memory");
    }
    __syncthreads();
}

namespace pg8 {
struct EpiZ {
    static constexpr bool PERM = true, AFTER_DRAIN = false;
    bf16_t* O; int ldc; float* fcbuf;
    __device__ __forceinline__ void operator()(const f32x4 (&acc)[2][2][4][2], const Unit& u, int wr, int wc, int fr, int fq) const {
        const int row0 = u.pm * BM + wr * 64 + fr, col0 = u.pn * BM + wc * 32 + 8 * fq;
        const bool fcl = (u.pn == 9) && (wc == 1) && (fq == 0);
#pragma unroll
        for (int ai = 0; ai < 2; ++ai)
#pragma unroll
            for (int m = 0; m < 4; ++m) {
                const int row = row0 + ai * HALF + m * 16;
                bf16_t* rowp = O + (size_t)row * ldc + col0;
#pragma unroll
                for (int bj = 0; bj < 2; ++bj) {
                    const f32x4 v0 = acc[ai][bj][m][0], v1 = acc[ai][bj][m][1];
                    u32x4 w; w.x = cvt_pk_bf16(v0[0], v0[1]); w.y = cvt_pk_bf16(v0[2], v0[3]); w.z = cvt_pk_bf16(v1[0], v1[1]); w.w = cvt_pk_bf16(v1[2], v1[3]);
                    *(u32x4*)(rowp + bj * HALF) = w;
                }
                if (fcl) *(f32x4*)(fcbuf + (size_t)row * 4) = acc[ai][0][m][0];
            }
    }
};
struct EpiRowScale {
    static constexpr bool PERM = true, AFTER_DRAIN = false;
    bf16_t* O; int ldc; const float* rs;
    __device__ __forceinline__ void operator()(const f32x4 (&acc)[2][2][4][2], const Unit& u, int wr, int wc, int fr, int fq) const {
        const int row0 = u.pm * BM + wr * 64 + fr, col0 = u.pn * BM + wc * 32 + 8 * fq;
        float sc[2][4];
#pragma unroll
        for (int ai = 0; ai < 2; ++ai)
#pragma unroll
            for (int m = 0; m < 4; ++m) sc[ai][m] = rs[row0 + ai * HALF + m * 16];
        __builtin_amdgcn_sched_barrier(0);
#pragma unroll
        for (int ai = 0; ai < 2; ++ai)
#pragma unroll
            for (int m = 0; m < 4; ++m) {
                const int row = row0 + ai * HALF + m * 16;
                const float s = sc[ai][m];
                bf16_t* rowp = O + (size_t)row * ldc + col0;
#pragma unroll
                for (int bj = 0; bj < 2; ++bj) {
                    const f32x4 v0 = acc[ai][bj][m][0] * s, v1 = acc[ai][bj][m][1] * s;
                    u32x4 w; w.x = cvt_pk_bf16(v0[0], v0[1]); w.y = cvt_pk_bf16(v0[2], v0[3]); w.z = cvt_pk_bf16(v1[0], v1[1]); w.w = cvt_pk_bf16(v1[2], v1[3]);
                    *(u32x4*)(rowp + bj * HALF) = w;
                }
            }
    }
};
struct EpiGU {
    static constexpr bool PERM = true, AFTER_DRAIN = false;
    bf16_t* O;
    __device__ __forceinline__ void operator()(const f32x4 (&acc)[2][2][4][2], const Unit& u, int wr, int wc, int fr, int fq) const {
        const int row0 = u.pm * BM + wr * 64 + fr, f0 = ((u.pn & 1) * BM + wc * 32 + 8 * fq) >> 1;
#pragma unroll
        for (int ai = 0; ai < 2; ++ai)
#pragma unroll
            for (int m = 0; m < 4; ++m) {
                bf16_t* rowp = O + (size_t)(row0 + ai * HALF + m * 16) * 256 + f0;
#pragma unroll
                for (int bj = 0; bj < 2; ++bj) {
                    const f32x4 v0 = acc[ai][bj][m][0], v1 = acc[ai][bj][m][1];
                    const float a0 = v0[0] * __builtin_amdgcn_rcpf(1.f + __expf(-v0[0])) * v0[1], a1 = v0[2] * __builtin_amdgcn_rcpf(1.f + __expf(-v0[2])) * v0[3];
                    const float a2 = v1[0] * __builtin_amdgcn_rcpf(1.f + __expf(-v1[0])) * v1[1], a3 = v1[2] * __builtin_amdgcn_rcpf(1.f + __expf(-v1[2])) * v1[3];
                    typedef unsigned u32x2 __attribute__((ext_vector_type(2)));
                    u32x2 w; w.x = cvt_pk_bf16(a0, a1); w.y = cvt_pk_bf16(a2, a3);
                    *(u32x2*)(rowp + bj * (HALF / 2)) = w;
                }
            }
    }
};
struct EpiPleGate {
    static constexpr bool PERM = true, AFTER_DRAIN = false;
    bf16_t* O; const bf16_t* PP;
    __device__ __forceinline__ void operator()(const f32x4 (&acc)[2][2][4][2], const Unit& u, int wr, int wc, int fr, int fq) const {
        const int row0 = u.pm * BM + wr * 64 + fr, col0 = u.pn * BM + wc * 32 + 8 * fq;
#pragma unroll
        for (int ai = 0; ai < 2; ++ai) {
            u32x4 pw[4][2];
#pragma unroll
            for (int m = 0; m < 4; ++m)
#pragma unroll
                for (int bj = 0; bj < 2; ++bj) pw[m][bj] = *(const u32x4*)(PP + (size_t)(row0 + ai * HALF + m * 16) * 1024 + col0 + bj * HALF);
            __builtin_amdgcn_sched_barrier(0);
#pragma unroll
            for (int m = 0; m < 4; ++m) {
                const size_t off = (size_t)(row0 + ai * HALF + m * 16) * 1024 + col0;
#pragma unroll
                for (int bj = 0; bj < 2; ++bj) {
                    const f32x4 v0 = acc[ai][bj][m][0], v1 = acc[ai][bj][m][1];
                    const u32x4 q = pw[m][bj];
                    float o[8];
                    o[0] = __uint_as_float(q.x << 16) * __builtin_amdgcn_rcpf(1.f + __expf(-v0[0])); o[1] = __uint_as_float(q.x & 0xffff0000u) * __builtin_amdgcn_rcpf(1.f + __expf(-v0[1]));
                    o[2] = __uint_as_float(q.y << 16) * __builtin_amdgcn_rcpf(1.f + __expf(-v0[2])); o[3] = __uint_as_float(q.y & 0xffff0000u) * __builtin_amdgcn_rcpf(1.f + __expf(-v0[3]));
                    o[4] = __uint_as_float(q.z << 16) * __builtin_amdgcn_rcpf(1.f + __expf(-v1[0])); o[5] = __uint_as_float(q.z & 0xffff0000u) * __builtin_amdgcn_rcpf(1.f + __expf(-v1[1]));
                    o[6] = __uint_as_float(q.w << 16) * __builtin_amdgcn_rcpf(1.f + __expf(-v1[2])); o[7] = __uint_as_float(q.w & 0xffff0000u) * __builtin_amdgcn_rcpf(1.f + __expf(-v1[3]));
                    u32x4 w; w.x = cvt_pk_bf16(o[0], o[1]); w.y = cvt_pk_bf16(o[2], o[3]); w.z = cvt_pk_bf16(o[4], o[5]); w.w = cvt_pk_bf16(o[6], o[7]);
                    *(u32x4*)(O + off + bj * HALF) = w;
                }
            }
            __builtin_amdgcn_sched_barrier(0);
        }
    }
};
struct EpiDown {
    static constexpr bool PERM = true, AFTER_DRAIN = false;
    bf16_t* O;
    __device__ __forceinline__ void operator()(const f32x4 (&acc)[2][2][4][2], const Unit& u, int wr, int wc, int fr, int fq) const {
        const int row0 = u.pm * BM + wr * 64 + fr, col0 = (u.pn & 3) * BM + wc * 32 + 8 * fq;
#pragma unroll
        for (int ai = 0; ai < 2; ++ai)
#pragma unroll
            for (int m = 0; m < 4; ++m) {
                bf16_t* rowp = O + (size_t)(row0 + ai * HALF + m * 16) * 1024 + col0;
#pragma unroll
                for (int bj = 0; bj < 2; ++bj) {
                    const f32x4 v0 = acc[ai][bj][m][0], v1 = acc[ai][bj][m][1];
                    u32x4 w; w.x = cvt_pk_bf16(v0[0], v0[1]); w.y = cvt_pk_bf16(v0[2], v0[3]); w.z = cvt_pk_bf16(v1[0], v1[1]); w.w = cvt_pk_bf16(v1[2], v1[3]);
                    *(u32x4*)(rowp + bj * HALF) = w;
                }
            }
    }
};
constexpr int XPM = (int)((WS_HS16 - WS_A16) / (256 * 1024 * 2)), XPN = (int)((WS_WGU - WS_WPG) / (256 * 1024 * 2));
static_assert((WS_HS16 - WS_A16) % (256 * 1024 * 2) == 0 && (WS_WGU - WS_WPG) % (256 * 1024 * 2) == 0 && XPM >= 64 && (XPN & 1) == 0, "virtual unit offsets");
struct EpiX {
    static constexpr bool PERM = true, AFTER_DRAIN = false;
    EpiGU gu; EpiPleGate pg;
    __device__ __forceinline__ void operator()(const f32x4 (&acc)[2][2][4][2], const Unit& u, int wr, int wc, int fr, int fq) const {
        if (u.pm >= XPM) { const Unit v{u.pm - XPM, u.pn - XPN}; gu(acc, v, wr, wc, fr, fq); }
        else pg(acc, u, wr, wc, fr, fq);
    }
};
struct XSched {
    const int* tile_e; int nU1, G, vc;
    __device__ __forceinline__ bool next(int i, Unit& u) const {
        if (i >= 2) return false;
        const int g = vc + i * G;
        if (g < nU1) { const int t = g >> 1; u.pm = t + XPM; u.pn = __builtin_amdgcn_readfirstlane(tile_e[t]) * 2 + (g & 1) + XPN; return true; }
        const int k = g - nU1; if (k >= 256) return false;
        u.pm = k >> 2; u.pn = k & 3; return true;
    }
    __device__ __forceinline__ void a_ready(const Unit&) const {}
    __device__ __forceinline__ void done(const Unit&) const {}
};
struct TwoUnits {
    int pm0, pn0, pm1, pn1, n;
    __device__ __forceinline__ bool next(int i, Unit& u) const { if (i >= n) return false; u.pm = i ? pm1 : pm0; u.pn = i ? pn1 : pn0; return true; }
    __device__ __forceinline__ void a_ready(const Unit&) const {}
    __device__ __forceinline__ void done(const Unit&) const {}
};
struct OneUnit {
    int pm, pn;
    __device__ __forceinline__ bool next(int i, Unit& u) const { if (i) return false; u.pm = pm; u.pn = pn; return true; }
    __device__ __forceinline__ void a_ready(const Unit&) const {}
    __device__ __forceinline__ void done(const Unit&) const {}
};
struct GroupSched {
    const int* tile_e; int T, NJ, G, vc;
    __device__ __forceinline__ bool next(int i, Unit& u) const {
        const long L = (long)i * G + vc; if (L >= (long)T * NJ) return false;
        const int t = (int)(L / NJ), j = (int)(L % NJ);
        u.pm = t; u.pn = __builtin_amdgcn_readfirstlane(tile_e[t]) * NJ + j; return true;
    }
    __device__ __forceinline__ void a_ready(const Unit&) const {}
    __device__ __forceinline__ void done(const Unit&) const {}
};
}

template <class Map>
__device__ __forceinline__ void transpose_rows(const Map mp, const float* ks, int nrows_out, int K, bf16* WT, LAS float* scr, int gw, int NGW, int lane) {
    const int nblk = nrows_out / 32, nitems = (K / 64) * nblk;
    const int f = lane & 7, kr = lane >> 3;
    for (int it = gw; it < nitems; it += NGW) {
        const int kb = it / nblk, nb = it % nblk, k0 = 64 * kb, n0 = 32 * nb;
        const float* src; long pitch; float sc; int nl0, nls;
        mp.get4(n0, f, src, pitch, sc, nl0, nls);
        f32x4_t vals[8];
#pragma unroll
        for (int i = 0; i < 8; ++i) vals[i] = src ? *(const f32x4_t*)(src + (size_t)(k0 + kr + 8 * i) * pitch) : (f32x4_t){0.f, 0.f, 0.f, 0.f};
#pragma unroll
        for (int i = 0; i < 8; ++i) {
            const int kk = kr + 8 * i;
            float m = sc; if (ks) m *= ks[k0 + kk];
            scr[kk * 33 + nl0] = vals[i].x * m; scr[kk * 33 + nl0 + nls] = vals[i].y * m; scr[kk * 33 + nl0 + 2 * nls] = vals[i].z * m; scr[kk * 33 + nl0 + 3 * nls] = vals[i].w * m;
        }
        asm volatile("s_waitcnt lgkmcnt(0)" ::: "memory");
        const int c = lane & 7;
#pragma unroll
        for (int j = 0; j < 4; ++j) {
            const int n = (lane >> 3) + 8 * j; const LAS float* s = scr + (8 * c) * 33 + n;
            v4u o; o.x = pk2(s[0 * 33], s[1 * 33]); o.y = pk2(s[2 * 33], s[3 * 33]); o.z = pk2(s[4 * 33], s[5 * 33]); o.w = pk2(s[6 * 33], s[7 * 33]);
            *(v4u*)(WT + (size_t)(n0 + n) * K + k0 + 8 * c) = o;
        }
        asm volatile("s_waitcnt lgkmcnt(0)" ::: "memory");
    }
}
constexpr float LOG2E_W = 1.4426950408889634f;
struct MapIn {
    const float* w;
    __device__ __forceinline__ void get(int n, const float*& src, long& pitch, float& sc) const {
        int c;
        if (n < 1152) c = n;
        else if (n < Z_CKV) c = OFF_QC + (n - Z_QC);
        else if (n < Z_CQ) c = OFF_CKV + (n - Z_CKV);
        else if (n < Z_KR) c = OFF_CQ + (n - Z_CQ);
        else if (n < Z_FC) c = OFF_KR + (n - Z_KR);
        else if (n < Z_FC + 4) c = OFF_FC + (n - Z_FC);
        else c = -1;
        src = c >= 0 ? w + c : nullptr; pitch = D_IN;
        sc = n < Z_KA ? 0.17677669529663687f * LOG2E_W : ((n >= Z_QC && n < Z_KC) ? 0.125f * LOG2E_W : 1.f);
    }
    __device__ __forceinline__ void get4(int n0, int f, const float*& src, long& pitch, float& sc, int& nl0, int& nls) const { get(n0 + 4 * f, src, pitch, sc); nl0 = 4 * f; nls = 1; }
};
struct MapPlain {
    const float* w; int N, nvalid; float scale;
    __device__ __forceinline__ void get(int n, const float*& src, long& pitch, float& sc) const { src = n < nvalid ? w + n : nullptr; pitch = N; sc = scale; }
    __device__ __forceinline__ void get4(int n0, int f, const float*& src, long& pitch, float& sc, int& nl0, int& nls) const { get(n0 + 4 * f, src, pitch, sc); nl0 = 4 * f; nls = 1; }
};

struct MapGU {
    const float* wg; const float* wu;
    __device__ __forceinline__ void get(int n, const float*& src, long& pitch, float& sc) const {
        const int e = n >> 9, r = n & 511, f = r >> 1;
        const long dlt = (r & 1) ? (long)(wu - wg) : 0l;
        src = wg + dlt + (size_t)e * 1024 * 256 + f; pitch = 256; sc = 1.f;
    }
    __device__ __forceinline__ void get4(int n0, int f, const float*& src, long& pitch, float& sc, int& nl0, int& nls) const {
        const int e = n0 >> 9, f0 = (n0 & 511) >> 1;
        const long dlt = (f >> 2) ? (long)(wu - wg) : 0l;
        src = wg + dlt + (size_t)e * 1024 * 256 + f0 + 4 * (f & 3); pitch = 256; sc = 1.f; nl0 = 8 * (f & 3) + (f >> 2); nls = 2;
    }
};
struct MapD {
    const float* wd;
    __device__ __forceinline__ void get(int n, const float*& src, long& pitch, float& sc) const {
        const int e = n >> 10, c = n & 1023;
        src = wd + (size_t)e * 256 * 1024 + c; pitch = 1024; sc = 1.f;
    }
    __device__ __forceinline__ void get4(int n0, int f, const float*& src, long& pitch, float& sc, int& nl0, int& nls) const { get(n0 + 4 * f, src, pitch, sc); nl0 = 4 * f; nls = 1; }
};

constexpr int ATT_GD_OFF = 100352;
struct AttnP {
    const bf16* z16; const bf16* qb16; const bf16* kvb16; const bf16* krr16; const float* cum; const float* cosT; const float* sinT;
    const int* pos; bf16* mixed16; const float* lq1; const float* lk1; const float* lq2; const float* lk2; const float* gdiff; int layer; unsigned* prof; const int* tpmax; float lam, lam_init;
};
typedef short bf16x8_t __attribute__((ext_vector_type(8)));
typedef float f32x16_t __attribute__((ext_vector_type(16)));
typedef short s16x4_t __attribute__((ext_vector_type(4)));
typedef float f32x2_t __attribute__((ext_vector_type(2)));
typedef __bf16 bf16x2_t __attribute__((ext_vector_type(2)));
__device__ __forceinline__ unsigned cvtpk(float lo, float hi) { f32x2_t v = {lo, hi}; bf16x2_t b = __builtin_convertvector(v, bf16x2_t); return __builtin_bit_cast(unsigned, b); }
__device__ __forceinline__ int crow(int r, int hi) { return (r & 3) + 8 * (r >> 2) + 4 * hi; }
__device__ __forceinline__ s16x4_t vtr(const LAS unsigned char* p) { typedef short v4i16_t __attribute__((ext_vector_type(4))); return __builtin_bit_cast(s16x4_t, __builtin_amdgcn_ds_read_tr16_b64_v4i16((LAS v4i16_t*)p)); }
constexpr float LOG2E = 1.4426950408889634f;

__device__ __forceinline__ float xhalf_max(float m) { auto rr = __builtin_amdgcn_permlane32_swap(__float_as_uint(m), __float_as_uint(m), false, false); return __builtin_fmaxf(__uint_as_float(rr[0]), __uint_as_float(rr[1])); }
__device__ __forceinline__ float xhalf_sum(float m) { auto rr = __builtin_amdgcn_permlane32_swap(__float_as_uint(m), __float_as_uint(m), false, false); return __uint_as_float(rr[0]) + __uint_as_float(rr[1]); }
__device__ __forceinline__ float max3f(float a, float b, float c) { return __builtin_fmaxf(__builtin_fmaxf(a, b), c); }
__device__ __forceinline__ float pair32(float A, float B) { auto rr = __builtin_amdgcn_permlane32_swap(__float_as_uint(A), __float_as_uint(B), false, false); return __uint_as_float(rr[0]) + __uint_as_float(rr[1]); }
__device__ __forceinline__ float pair16(float A, float B) { auto rr = __builtin_amdgcn_permlane16_swap(__float_as_uint(A), __float_as_uint(B), false, false); return __uint_as_float(rr[0]) + __uint_as_float(rr[1]); }
#define DPP_F(v, ctrl) __builtin_bit_cast(float, __builtin_amdgcn_update_dpp(0, __builtin_bit_cast(int, (v)), (ctrl), 0xf, 0xf, true))
__device__ __forceinline__ float sum_low3(float u) {
    u += DPP_F(u, 0xB1); u += DPP_F(u, 0x4E); u += DPP_F(u, 0x141); return u;
}
__device__ __forceinline__ float wave_sum8(const float (&e)[8], int lane) {
    const float s0 = pair32(e[0], e[4]), s1 = pair32(e[1], e[5]), s2 = pair32(e[2], e[6]), s3 = pair32(e[3], e[7]);
    const float t0 = pair16(s0, s2), t1 = pair16(s1, s3);
    const bool b3 = (lane & 8) != 0;
    const float x = b3 ? t1 : t0, y = b3 ? t0 : t1;
    return sum_low3(x + DPP_F(y, 0x128));
}
__device__ __forceinline__ float wave_sum4(const float (&g)[4]) {
    const float s0 = pair32(g[0], g[2]), s1 = pair32(g[1], g[3]);
    const float t = pair16(s0, s1);
    return sum_low3(t + DPP_F(t, 0x128));
}
__device__ __forceinline__ void glds16(const void* gsrc, unsigned lds_dst) { unsigned keep;
    asm volatile("s_mov_b32 %0, m0\n\ts_mov_b32 m0, %2\n\ts_nop 0\n\tglobal_load_lds_dwordx4 %1, off\n\ts_mov_b32 m0, %0" : "=&s"(keep) : "v"(gsrc), "s"(lds_dst) : "memory"); }
__device__ __forceinline__ void glds4(const void* gsrc, unsigned lds_dst) { unsigned keep;
    asm volatile("s_mov_b32 %0, m0\n\ts_mov_b32 m0, %2\n\ts_nop 0\n\tglobal_load_lds_dword %1, off\n\ts_mov_b32 m0, %0" : "=&s"(keep) : "v"(gsrc), "s"(lds_dst) : "memory"); }
template <int MODE> __device__ __forceinline__ void attn_unit(const AttnP& p, int b, int h, int qblk, LAS unsigned char* lds, const int tid_in) {
    int tid = tid_in * 64 + lane_id_now(); asm volatile("" : "+v"(tid));
#ifdef PROF_SEL
    const unsigned long long pu0 = __builtin_amdgcn_s_memrealtime(); unsigned long long pt0 = 0, pl0 = 0, pacc_c = 0, pacc_b = 0;
#define PROF_T(acc) do { const unsigned long long t_ = __builtin_amdgcn_s_memrealtime(); acc += t_ - pt0; pt0 = t_; } while (0)
#else
#define PROF_T(acc) do {} while (0)
#endif
    constexpr int NF = MODE == 0 ? 2 : (MODE == 1 ? 6 : 4);
    constexpr int NC = MODE == 1 ? 12 : 8;
    constexpr int NCX = MODE == 1 ? 0 : 2;
    constexpr int KB = (NC + NCX) * 1024, KBUF = KB + 512;
    constexpr int NSL = 4, AH = 3;
    constexpr int VOFF = NSL * KBUF;
    const int lane = tid & 63, w = __builtin_amdgcn_readfirstlane(tid >> 6), r32 = lane & 31, hi = lane >> 5;
    const int map = MODE == 0 ? (w >> 2) : 0, qg = MODE == 0 ? (w & 3) : w;
    const int c = MODE == 0 ? qblk * 2 + (qg >> 1) : qblk * 4 + (qg >> 1);
    const int ntiles = MODE == 0 ? qblk * 2 + 2 : qblk * 4 + 4;
    const long tok0 = (long)b * SEQ;
    const int q0u = MODE == 0 ? qblk * 128 : qblk * 256;
    const long qrow = tok0 + q0u + qg * 32 + r32;
    float slope2 = 0.f, sq = 0.f, refv = 0.f; int qpmin = 0;
    const bf16* k1src = MODE == 0 ? p.z16 + (tok0 + lane) * ZP + Z_KA + h * 64 + w * 8 : (MODE == 2 ? p.z16 + (tok0 + lane) * ZP + Z_KC + h * 64 + w * 8 : p.kvb16 + (tok0 + lane) * NKVB + h * 128 + w * 8);
    const bf16* k2src = p.krr16 + (tok0 + lane) * 32 + (w & 3) * 8;
    const bf16* vsrc = (MODE == 0 ? p.z16 + Z_VA + h * 64 : (MODE == 1 ? p.kvb16 + h * 128 + 64 : p.z16 + Z_VC + h * 64)) + (tok0 + (w & 3) * 16 + (lane >> 2)) * (MODE == 1 ? NKVB : ZP) + ((w >> 2) * 4 + (lane & 3)) * 8;
    const void* bsrc = MODE == 0 ? (const void*)(p.pos + tok0 + lane) : (const void*)(p.cum + (tok0 + lane) * 4 + h);
    const unsigned lbase = (unsigned)(size_t)lds;
    const int tpv = MODE == 0 ? p.tpmax[b * 32 + (lane & 31)] : 0;
    constexpr int DPT = 3;
    auto issue = [&](int kt_) {
        const int kt = kt_ < ntiles ? kt_ : ntiles - 1; const int slot = kt_ % NSL;
        const unsigned ks = __builtin_amdgcn_readfirstlane(lbase + slot * KBUF), vs = __builtin_amdgcn_readfirstlane(lbase + VOFF + slot * 8192 + w * 1024);
        glds16(k1src + (long)kt * 64 * (MODE == 1 ? NKVB : ZP), ks + w * 1024);
        if (MODE == 1) glds16(k2src + (long)kt * 64 * 32, ks + (8 + (w & 3)) * 1024);
        glds16(vsrc + (long)kt * 64 * (MODE == 1 ? NKVB : ZP), vs);
        if (MODE == 0) glds4((const char*)bsrc + (long)kt * 64 * 4, ks + KB + 256);
        if (MODE == 2) glds4((const char*)bsrc + (long)kt * 64 * 16, ks + KB + 256);
    };
    auto convert_bias = [&](int kt_) {
        {
            LAS unsigned char* sp = lds + (kt_ % NSL) * KBUF;
            const unsigned raw = *(LAS unsigned*)(sp + KB + 256 + lane * 4);
            const float bv = MODE == 0 ? slope2 * ((float)(int)raw - refv) : (refv - __uint_as_float(raw)) * LOG2E;
            *(LAS float*)(sp + KB + lane * 4) = bv;
            const unsigned e0 = f2bf(bv); const float r1 = bv - __uint_as_float(e0 << 16);
            const unsigned e1 = f2bf(r1); const float r2 = r1 - __uint_as_float(e1 << 16);
            const unsigned e2 = f2bf(r2);
            v4u ex; ex.x = e0 | (e1 << 16); ex.y = e2; ex.z = 0u; ex.w = 0u;
            *(LAS v4u*)(sp + NC * 1024 + lane * 16) = ex;
        }
    };
#pragma unroll
    for (int t = 0; t < AH; ++t) issue(t);
    bf16x8_t qf[NF];
    {
        const bf16* qsrc = MODE == 0 ? p.z16 + qrow * ZP + Z_QA + h * 64 + map * 32 : (MODE == 1 ? p.qb16 + qrow * NQBP + h * 96 : p.z16 + qrow * ZP + Z_QC + h * 64);
#pragma unroll
        for (int i = 0; i < NF; ++i) qf[i] = *(const bf16x8_t*)(qsrc + i * 16 + hi * 8);
    }
    if (MODE == 1) {
        const float4 c0 = *(const float4*)(p.cosT + qrow * 16 + hi * 8), c1 = *(const float4*)(p.cosT + qrow * 16 + hi * 8 + 4);
        const float4 s0 = *(const float4*)(p.sinT + qrow * 16 + hi * 8), s1 = *(const float4*)(p.sinT + qrow * 16 + hi * 8 + 4);
        const float cs[8] = {c0.x, c0.y, c0.z, c0.w, c1.x, c1.y, c1.z, c1.w}, sn[8] = {s0.x, s0.y, s0.z, s0.w, s1.x, s1.y, s1.z, s1.w};
        float n1[8], n2[8];
#pragma unroll
        for (int j = 0; j < 8; ++j) {
            const float x1 = __uint_as_float((unsigned)(unsigned short)qf[NF - 2][j] << 16), x2 = __uint_as_float((unsigned)(unsigned short)qf[NF - 1][j] << 16);
            n1[j] = x1 * cs[j] - x2 * sn[j]; n2[j] = x2 * cs[j] + x1 * sn[j];
        }
        v4u a, bb;
        a.x = cvtpk(n1[0], n1[1]); a.y = cvtpk(n1[2], n1[3]); a.z = cvtpk(n1[4], n1[5]); a.w = cvtpk(n1[6], n1[7]);
        bb.x = cvtpk(n2[0], n2[1]); bb.y = cvtpk(n2[2], n2[3]); bb.z = cvtpk(n2[4], n2[5]); bb.w = cvtpk(n2[6], n2[7]);
        qf[NF - 2] = __builtin_bit_cast(bf16x8_t, a); qf[NF - 1] = __builtin_bit_cast(bf16x8_t, bb);
    }
    if (MODE == 0) {
        slope2 = exp2f(-8.0f * (float)(h + 1) / 6.0f) * LOG2E;
        const int pref = p.pos[tok0 + q0u]; refv = (float)pref;
        const int pq = p.pos[qrow]; sq = slope2 * (float)(pq - pref);
        int mn = pq;
#pragma unroll
        for (int o_ = 1; o_ < 64; o_ <<= 1) mn = min(mn, __builtin_amdgcn_ds_bpermute((lane ^ o_) << 2, mn));
        qpmin = __builtin_amdgcn_readfirstlane(mn);
    }
    if (MODE == 2) refv = p.cum[(tok0 + q0u) * 4 + h];
    f32x16_t o[2], negm;
    float mref = 0.f, lsum = 0.f; bool first = true;
#pragma unroll
    for (int r = 0; r < 16; ++r) { o[0][r] = 0.f; o[1][r] = 0.f; negm[r] = 0.f; }
    bf16x8_t qext;
    { v4u q1; q1.x = hi == 0 ? 0x3f803f80u : 0u; q1.y = hi == 0 ? 0x00003f80u : 0u; q1.z = 0u; q1.w = 0u; qext = __builtin_bit_cast(bf16x8_t, q1); }
    LAS unsigned char* const kfp = lds + (map * NF * 2 + hi) * 1024 + r32 * 16;
    LAS unsigned char* const kxp = lds + (NC + hi) * 1024 + r32 * 16;
    LAS unsigned char* const bfp = lds + KB + 16 * hi;
    LAS unsigned char* const vfp = lds + VOFF + (4 * hi + ((lane & 15) >> 2)) * 64 + ((lane >> 4) & 1) * 32 + (lane & 3) * 8;
    auto compute_s = [&](const int kt, const int par, f32x16_t& p0, f32x16_t& p1) {
        constexpr int KG = NF;
        bf16x8_t kf0[KG], kf1[KG], kx0, kx1;
        LAS unsigned char* kfb = kfp + par * KBUF; asm volatile("" : "+v"(kfb));
        LAS unsigned char* kxb = kxp + par * KBUF; if (MODE != 1) asm volatile("" : "+v"(kxb));
#pragma unroll
        for (int d0 = 0; d0 < KG; ++d0) { kf0[d0] = *(const LAS bf16x8_t*)(kfb + d0 * 2048); kf1[d0] = *(const LAS bf16x8_t*)(kfb + d0 * 2048 + 512); }
        if (MODE != 1) { kx0 = *(const LAS bf16x8_t*)(kxb); kx1 = *(const LAS bf16x8_t*)(kxb + 512); }
        __builtin_amdgcn_sched_barrier(0);
        if (MODE != 1) {
            p0 = __builtin_amdgcn_mfma_f32_32x32x16_bf16(kx0, qext, negm, 0, 0, 0);
            p1 = __builtin_amdgcn_mfma_f32_32x32x16_bf16(kx1, qext, negm, 0, 0, 0);
        }
#pragma unroll
        for (int d0 = 0; d0 < KG; ++d0) {
            p0 = __builtin_amdgcn_mfma_f32_32x32x16_bf16(kf0[d0], qf[d0], (MODE == 1 && d0 == 0) ? negm : p0, 0, 0, 0);
            p1 = __builtin_amdgcn_mfma_f32_32x32x16_bf16(kf1[d0], qf[d0], (MODE == 1 && d0 == 0) ? negm : p1, 0, 0, 0);
        }
        if (NF > KG) {
#pragma unroll
            for (int d0 = KG; d0 < NF; ++d0) { kf0[d0 - KG] = *(const LAS bf16x8_t*)(kfb + d0 * 2048); kf1[d0 - KG] = *(const LAS bf16x8_t*)(kfb + d0 * 2048 + 512); }
#pragma unroll
            for (int d0 = KG; d0 < NF; ++d0) {
                p0 = __builtin_amdgcn_mfma_f32_32x32x16_bf16(kf0[d0 - KG], qf[d0], p0, 0, 0, 0);
                p1 = __builtin_amdgcn_mfma_f32_32x32x16_bf16(kf1[d0 - KG], qf[d0], p1, 0, 0, 0);
            }
        }
        if (MODE == 0) {
            if (kt == c || __builtin_amdgcn_readlane(tpv, kt) > qpmin) {
                LAS unsigned char* bfb = bfp + par * KBUF; asm volatile("" : "+v"(bfb));
#pragma unroll
                for (int g = 0; g < 4; ++g) {
                    const f32x4_t b0 = *(const LAS f32x4_t*)(bfb + 32 * g), b1 = *(const LAS f32x4_t*)(bfb + 128 + 32 * g);
                    p0[4 * g] += 2.f * fminf(sq - b0.x, 0.f); p0[4 * g + 1] += 2.f * fminf(sq - b0.y, 0.f); p0[4 * g + 2] += 2.f * fminf(sq - b0.z, 0.f); p0[4 * g + 3] += 2.f * fminf(sq - b0.w, 0.f);
                    p1[4 * g] += 2.f * fminf(sq - b1.x, 0.f); p1[4 * g + 1] += 2.f * fminf(sq - b1.y, 0.f); p1[4 * g + 2] += 2.f * fminf(sq - b1.z, 0.f); p1[4 * g + 3] += 2.f * fminf(sq - b1.w, 0.f);
                }
            }
        }
        if (MODE == 2) {
            if (kt == c) {
                asm volatile("" ::: "memory");
                const int qi = (qg & 1) * 32 + r32;
#pragma unroll
                for (int r = 0; r < 16; ++r) { const int kv = crow(r, hi); if (kv > qi) p0[r] = -INFINITY; if (kv + 32 > qi) p1[r] = -INFINITY; }
            }
        }
    };
    auto softmax_pv = [&](const int par, f32x16_t& p0, f32x16_t& p1) {
        constexpr int VE = MODE == 1 ? 4 : 8;
        s16x4_t vlo[8], vhi[8];
        LAS unsigned char* vfb = vfp + par * 8192; asm volatile("" : "+v"(vfb));
#pragma unroll
        for (int i = 0; i < VE; ++i) { vlo[i] = vtr(vfb + (i & 1) * 4096 + (i >> 1) * 1024); vhi[i] = vtr(vfb + (i & 1) * 4096 + (i >> 1) * 1024 + 512); }
        __builtin_amdgcn_sched_barrier(0);
        float tm0 = max3f(p0[0], p0[1], p0[2]), tm1 = max3f(p1[0], p1[1], p1[2]);
#pragma unroll
        for (int r = 3; r < 15; r += 2) { tm0 = max3f(tm0, p0[r], p0[r + 1]); tm1 = max3f(tm1, p1[r], p1[r + 1]); }
        float tmax = max3f(tm0, tm1, p0[15]); tmax = __builtin_fmaxf(tmax, p1[15]);
        tmax = xhalf_max(tmax);
        if (first || __any(tmax > 8.0f)) {
            const float dl = first ? tmax : __builtin_fmaxf(tmax, 0.f);
            mref += dl;
            const float f = first ? 1.f : __builtin_amdgcn_exp2f(-dl);
            lsum *= f;
#pragma unroll
            for (int r = 0; r < 16; ++r) { o[0][r] *= f; o[1][r] *= f; p0[r] -= dl; p1[r] -= dl; negm[r] = -mref; }
            first = false;
        }
        float ls0 = 0.f, ls1 = 0.f;
#pragma unroll
        for (int r = 0; r < 16; ++r) { p0[r] = __builtin_amdgcn_exp2f(p0[r]); p1[r] = __builtin_amdgcn_exp2f(p1[r]); ls0 += p0[r]; ls1 += p1[r]; }
        lsum += ls0 + ls1;
        bf16x8_t pa[4];
#pragma unroll
        for (int ks = 0; ks < 4; ++ks) {
            v4u wv;
            if (ks < 2) { wv.x = cvtpk(p0[8 * ks + 0], p0[8 * ks + 1]); wv.y = cvtpk(p0[8 * ks + 2], p0[8 * ks + 3]); wv.z = cvtpk(p0[8 * ks + 4], p0[8 * ks + 5]); wv.w = cvtpk(p0[8 * ks + 6], p0[8 * ks + 7]); }
            else { wv.x = cvtpk(p1[8 * (ks - 2) + 0], p1[8 * (ks - 2) + 1]); wv.y = cvtpk(p1[8 * (ks - 2) + 2], p1[8 * (ks - 2) + 3]); wv.z = cvtpk(p1[8 * (ks - 2) + 4], p1[8 * (ks - 2) + 5]); wv.w = cvtpk(p1[8 * (ks - 2) + 6], p1[8 * (ks - 2) + 7]); }
            pa[ks] = __builtin_bit_cast(bf16x8_t, wv);
        }
#pragma unroll
        for (int i = VE; i < 8; ++i) { vlo[i] = vtr(vfb + (i & 1) * 4096 + (i >> 1) * 1024); vhi[i] = vtr(vfb + (i & 1) * 4096 + (i >> 1) * 1024 + 512); }
#pragma unroll
        for (int ks = 0; ks < 4; ++ks)
#pragma unroll
            for (int blk = 0; blk < 2; ++blk) {
                const s16x4_t lo = vlo[ks * 2 + blk], hi4 = vhi[ks * 2 + blk];
                const bf16x8_t vf = {lo[0], lo[1], lo[2], lo[3], hi4[0], hi4[1], hi4[2], hi4[3]};
                o[blk] = __builtin_amdgcn_mfma_f32_32x32x16_bf16(vf, pa[ks], o[blk], 0, 0, 0);
            }
    };
    if (MODE != 1 && tid < NSL * 64) *(LAS v4u*)(lds + (tid >> 6) * KBUF + (NC + 1) * 1024 + (tid & 63) * 16) = (v4u){0u, 0u, 0u, 0u};
    f32x16_t pA0, pA1;
    { int tpu = tpv; asm volatile("" : "+v"(tpu)); }
    asm volatile("s_waitcnt vmcnt(0)" ::: "memory");
    if (MODE != 1 && w < AH) convert_bias(w);
    asm volatile("s_waitcnt lgkmcnt(0)\n\ts_barrier" ::: "memory");
#ifdef PROF_SEL
    pl0 = __builtin_amdgcn_s_memrealtime();
#endif
#pragma unroll 1
    for (int kt = 0; kt < ntiles; ++kt) {
#ifdef PROF_SEL
        pt0 = __builtin_amdgcn_s_memrealtime();
#endif
        if (kt <= c) { const int slot = kt % NSL; compute_s(kt, slot, pA0, pA1); softmax_pv(slot, pA0, pA1); }
        issue(kt + AH);
        asm volatile("s_waitcnt vmcnt(3)" ::: "memory");
        if (MODE != 1 && w == 0) convert_bias(kt + AH - 1);
        PROF_T(pacc_c);
        asm volatile("s_waitcnt lgkmcnt(0)\n\ts_barrier" ::: "memory");
        PROF_T(pacc_b);
    }
    asm volatile("s_waitcnt vmcnt(0)\n\ts_barrier" ::: "memory");
#ifdef PROF_SEL
    const unsigned long long pl1 = __builtin_amdgcn_s_memrealtime();
#endif
    const float inv = 1.f / xhalf_sum(lsum);
    int tid2 = tid_in * 64 + lane_id_now(); asm volatile("" : "+v"(tid2));
    const int lane2 = tid2 & 63, hi2 = lane2 >> 5, qg2 = MODE == 0 ? ((tid2 >> 6) & 3) : (tid2 >> 6);
    const long qrow2 = tok0 + q0u + qg2 * 32 + (lane2 & 31);
    bf16* op = p.mixed16 + qrow2 * D_MODEL + (MODE == 0 ? 0 : (MODE == 1 ? 384 : 768)) + h * 64;
    if (MODE == 0) {
        LAS float* xb = (LAS float*)lds + qg2 * 2048 + lane2;
        if (map == 1) {
#pragma unroll
            for (int blk = 0; blk < 2; ++blk)
#pragma unroll
                for (int r = 0; r < 16; ++r) xb[(blk * 16 + r) * 64] = o[blk][r] * inv;
        }
        asm volatile("s_waitcnt lgkmcnt(0)\n\ts_barrier" ::: "memory");
        if (map == 0) {
            const float lam_init = p.lam_init, lam = p.lam;
            float ss = 0.f;
#pragma unroll
            for (int blk = 0; blk < 2; ++blk)
#pragma unroll
                for (int r = 0; r < 16; ++r) { const float v = o[blk][r] * inv - lam * xb[(blk * 16 + r) * 64]; o[blk][r] = v; ss = fmaf(v, v, ss); }
            ss = xhalf_sum(ss);
            const float rr = rsqrtf(ss * (1.f / 64.f) + RMS_EPS) * (1.f - lam_init);
#pragma unroll
            for (int blk = 0; blk < 2; ++blk)
#pragma unroll
                for (int g = 0; g < 4; ++g) {
                    const int d = 32 * blk + 8 * g + 4 * hi2;
                    const f32x4_t gv = *(const LAS f32x4_t*)(lds + ATT_GD_OFF + d * 4);
                    v2u wv; wv.x = cvtpk(o[blk][4 * g] * rr * gv.x, o[blk][4 * g + 1] * rr * gv.y); wv.y = cvtpk(o[blk][4 * g + 2] * rr * gv.z, o[blk][4 * g + 3] * rr * gv.w);
                    *(v2u*)(op + d) = wv;
                }
        }
        asm volatile("s_waitcnt lgkmcnt(0)\n\ts_barrier" ::: "memory");
    } else {
#pragma unroll
        for (int blk = 0; blk < 2; ++blk)
#pragma unroll
            for (int g = 0; g < 4; ++g) {
                const int d = 32 * blk + 8 * g + 4 * hi2;
                v2u wv; wv.x = cvtpk(o[blk][4 * g] * inv, o[blk][4 * g + 1] * inv); wv.y = cvtpk(o[blk][4 * g + 2] * inv, o[blk][4 * g + 3] * inv);
                *(v2u*)(op + d) = wv;
            }
    }
#ifdef PROF_SEL
    if (p.layer == 0 && blockIdx.x == 7 && w == PROF_WAVE && lane == 0) {
        unsigned* pw = p.prof; const unsigned long long pu1 = __builtin_amdgcn_s_memrealtime();
        atomicAdd(pw + 0, (unsigned)(pu1 - pu0)); atomicAdd(pw + 1, (unsigned)(pl1 - pl0)); atomicAdd(pw + 2, (unsigned)pacc_c); atomicAdd(pw + 3, (unsigned)pacc_b);
        atomicAdd(pw + 4, (unsigned)ntiles * 100u); atomicAdd(pw + 5, 10000u); atomicAdd(pw + 6, (unsigned)(c + 1) * 100u);
    }
#endif
}

typedef const __attribute__((address_space(4))) char* kargp_t;
__device__ __forceinline__ kargp_t karg_base() { kargp_t p = (kargp_t)__builtin_amdgcn_kernarg_segment_ptr(); asm volatile("" : "+s"(p)); return p; }
#define KARG(i) (*(const void* const __attribute__((address_space(4)))*)(kp + 8 * (i)))
#define KOUT (*(float* const __attribute__((address_space(4)))*)(kp + 224))
#define KWS (*(unsigned char* const __attribute__((address_space(4)))*)(kp + 232))
__device__ __forceinline__ void convert_layer_weights(const Args& a, int l, unsigned char* ws, LAS float* scr, int gw, int NGW, int lane) {
    const kargp_t kp = karg_base();
    const float* w_in = (const float*)KARG(3) + (size_t)l * D_MODEL * D_IN;
    const float* w_uq = (const float*)KARG(4) + (size_t)l * 256 * NQB;
    const float* w_ukv = (const float*)KARG(5) + (size_t)l * 128 * NKVB;
    const float* g_cq = (const float*)KARG(6) + l * 256;
    const float* g_ckv = (const float*)KARG(7) + l * 128;
    const float* w_out = (const float*)KARG(14) + (size_t)l * 1024 * 1024;
    transpose_rows(MapIn{w_in}, nullptr, ZP, 1024, (bf16*)(ws + WS_WIN), scr, gw, NGW, lane);
    transpose_rows(MapPlain{w_uq, NQB, NQB, 0.10206207261596575f * LOG2E_W}, g_cq, NQBP, 256, (bf16*)(ws + WS_WUQ), scr, gw, NGW, lane);
    transpose_rows(MapPlain{w_ukv, NKVB, NKVB, 1.f}, g_ckv, NKVB, 128, (bf16*)(ws + WS_WUKV), scr, gw, NGW, lane);
    transpose_rows(MapPlain{w_out, 1024, 1024, 1.f}, nullptr, 1024, 1024, (bf16*)(ws + WS_WOUT), scr, gw, NGW, lane);
    transpose_rows(MapPlain{(const float*)KARG(24) + (size_t)l * 1024 * 1024, 1024, 1024, 1.f}, nullptr, 1024, 1024, (bf16*)(ws + WS_WPG), scr, gw, NGW, lane);
    transpose_rows(MapPlain{(const float*)KARG(25) + (size_t)l * 256 * 1024, 1024, 1024, 1.f}, nullptr, 1024, 256, (bf16*)(ws + WS_WPP), scr, gw, NGW, lane);
    transpose_rows(MapGU{(const float*)KARG(21) + (size_t)l * 32 * 1024 * 256, (const float*)KARG(22) + (size_t)l * 32 * 1024 * 256}, nullptr, 32 * 512, 1024, (bf16*)(ws + WS_WGU), scr, gw, NGW, lane);
    transpose_rows(MapD{(const float*)KARG(23) + (size_t)l * 32 * 256 * 1024}, nullptr, 32 * 1024, 256, (bf16*)(ws + WS_WD), scr, gw, NGW, lane);
}

__device__ __forceinline__ void expert_prefix(const unsigned* cnt, LAS int* xs, int tid) {
    if (tid < 64) {
        const int pc = tid < 32 ? (((int)cnt[tid * 64] + 255) & ~255) : 0;
        int inc = pc;
#pragma unroll
        for (int o = 1; o < 32; o <<= 1) { const int n = __shfl_up(inc, o); if ((tid & 63) >= o) inc += n; }
        if (tid < 32) xs[tid] = inc - pc;
        if (tid == 31) xs[32] = inc;
    }
}
constexpr int LDS_MISC = 147456;
constexpr int PH_PER_LAYER = 9, NPH = 1 + DEPTH * PH_PER_LAYER;
template <int PH, bool DUMMY = false> __device__ __forceinline__ void run_phase(const Args& a, unsigned char* lds_raw, const int wave_s) {
    float* sm = (float*)lds_raw;
    const kargp_t kp = karg_base();
    const int G = gridDim.x, NGW = G * 8, NGT = G * NTHREADS;
    unsigned char* ws = KWS;
    const float* x0 = (const float*)KARG(0);
    const float* pin = (const float*)KARG(1);
    const int* pos = (const int*)KARG(2);
    float* cosT = (float*)(ws + WS_COS); float* sinT = (float*)(ws + WS_SIN);
    bf16* a16 = (bf16*)(ws + WS_A16); bf16* z16 = (bf16*)(ws + WS_Z16); bf16* qb16 = (bf16*)(ws + WS_QB16); bf16* kvb16 = (bf16*)(ws + WS_KVB16);
    bf16* krr16 = (bf16*)(ws + WS_KRR16); float* fcbuf = (float*)(ws + WS_FC); float* cum = (float*)(ws + WS_CUM); float* logf = (float*)(ws + WS_LOGF);
    float* rq = (float*)(ws + WS_RQ); float* rkv = (float*)(ws + WS_RKV);
    bf16* mixed16 = (bf16*)(ws + WS_MIXED16); bf16* mix16 = (bf16*)(ws + WS_MIX16);
    bf16* hs16 = (bf16*)(ws + WS_HS16); bf16* act16 = (bf16*)(ws + WS_ACT16); bf16* outs16 = (bf16*)(ws + WS_OUTS16); bf16* ple16 = (bf16*)(ws + WS_PLE16); bf16* pp16 = (bf16*)(ws + WS_PP16); bf16* p16 = (bf16*)(ws + WS_P16);
    int* ids = (int*)(ws + WS_RT + RT_IDS); float* wts = (float*)(ws + WS_RT + RT_WTS); int* rank = (int*)(ws + WS_RT + RT_RANK);
    int* etok = (int*)(ws + WS_ETOK);
    unsigned* ctl = (unsigned*)(ws + WS_CTL);

        int tid = wave_s * 64 + lane_id_now(); asm volatile("" : "+v"(tid));
        const int lane = tid & 63, wave = __builtin_amdgcn_readfirstlane(tid >> 6);
        const int gw = blockIdx.x * 8 + wave, gtid = blockIdx.x * NTHREADS + tid;
        LAS float* scr = (LAS float*)((LAS unsigned char*)lds_raw + wave * 16384);
        if constexpr (PH == 0) {
            for (int i = gtid; i < NTOK * 16; i += NGT) {
                const int tk = i >> 4, j = i & 15;
                const int j4 = j >> 2, jr = j & 3;
                const double inv = (j4 == 0 ? 1.0 : (j4 == 1 ? 0.1 : (j4 == 2 ? 0.01 : 0.001))) * (jr == 0 ? 1.0 : (jr == 1 ? 0.5623413251903491 : (jr == 2 ? 0.31622776601683794 : 0.1778279410038923)));
                const double ang = (double)pos[tk] * inv;
                const double k = rint(ang * 0.15915494309189535);
                const double r = fma(-k, 6.283185307179586, ang) - k * 2.4492935982947064e-16;
                cosT[i] = cosf((float)r); sinT[i] = sinf((float)r);
            }
            auto cvt_stream = [&](const float* sp, bf16* dp, int n8) {
                for (int i = gtid; i < n8; i += 4 * NGT) {
                    f32x4_t v[8];
#pragma unroll
                    for (int u = 0; u < 4; ++u) { v[2 * u] = *(const f32x4_t*)(sp + (size_t)(i + u * NGT) * 8); v[2 * u + 1] = *(const f32x4_t*)(sp + (size_t)(i + u * NGT) * 8 + 4); }
#pragma unroll
                    for (int u = 0; u < 4; ++u) { v4u o; o.x = cvtpk(v[2 * u].x, v[2 * u].y); o.y = cvtpk(v[2 * u].z, v[2 * u].w); o.z = cvtpk(v[2 * u + 1].x, v[2 * u + 1].y); o.w = cvtpk(v[2 * u + 1].z, v[2 * u + 1].w);
                        *(v4u*)(dp + (size_t)(i + u * NGT) * 8) = o; }
                }
            };
            for (int i = gw; i < BATCH * 32; i += NGW) {
                int v = pos[i * 64 + lane];
#pragma unroll
                for (int o_ = 1; o_ < 64; o_ <<= 1) v = max(v, __shfl_xor(v, o_));
                if (lane == 0) ((int*)(ws + WS_RT + RT_TPMAX))[i] = v;
            }
            cvt_stream(x0, a16, NTOK * D_MODEL / 8);
            cvt_stream(pin, p16, DEPTH * NTOK * PLE_DIM / 8);
            convert_layer_weights(a, 0, ws, scr, gw, NGW, lane);
        } else {
            constexpr int l = (PH - 1) / PH_PER_LAYER, sp = (PH - 1) % PH_PER_LAYER;
            const float* b_forget = (const float*)KARG(13) + l * 4;
            const float* ln1_g = (const float*)KARG(15) + l * 1024; const float* ln1_b = (const float*)KARG(16) + l * 1024;
            const float* w_group = (const float*)KARG(17) + l * 1024 * 4; const float* b_group = (const float*)KARG(18) + l * 4;
            const float* w_er = (const float*)KARG(19) + (size_t)l * 4 * 1024 * 8; const float* b_er = (const float*)KARG(20) + l * 32;
            const float* ln2_g = (const float*)KARG(26) + l * 1024; const float* ln2_b = (const float*)KARG(27) + l * 1024;
            unsigned* cnt = ctl + CW_CNT + l * 2048 + (DUMMY ? 8192 : 0);
            if (DUMMY) rank = (int*)(ws + WS_RT + 512 * 1024);
            if constexpr (sp == 0) {
                pg8::Gemm g{a16, (const bf16*)(ws + WS_WIN), NTOK, ZP, 1024, 1024, 1024};
                pg8::StaticOrder S; S.init(NTOK, ZP, G, (int)blockIdx.x);
                pg8::EpiZ E{z16, ZP, fcbuf};
                pg8::gemm_phase<pg8::EpiZ, pg8::StaticOrder, true, true>((LAS unsigned char*)lds_raw, g, S, E, tid);
                {
                    pg8::Gemm g2{p16 + (size_t)l * NTOK * PLE_DIM, (const bf16*)(ws + WS_WPP), NTOK, 1024, 256, 256, 256};
                    const int bx = (int)blockIdx.x;
                    pg8::StaticOrder S2; S2.init(NTOK, 1024, G / 2, bx >= G / 2 ? bx - G / 2 : 1 << 20);
                    pg8::EpiBf16<0> E2{pp16, 1024, nullptr, 0, 0, 1.f};
                    pg8::gemm_phase<pg8::EpiBf16<0>, pg8::StaticOrder, true, true>((LAS unsigned char*)lds_raw, g2, S2, E2, tid);
                }
            } else if constexpr (sp == 1) {
                const int g16 = lane >> 4, l16 = lane & 15;
                const float bfg = b_forget[l16 & 3];
                struct RowRegs { v4u ca, cb, ka; unsigned short kr1, kr2; float cs, sn, fcv; };
                auto ld_row = [&](int tk, RowRegs& R) {
                    const bf16* zr = z16 + (size_t)tk * ZP;
                    R.ca = *(const v4u*)(zr + Z_CQ + l16 * 16); R.cb = *(const v4u*)(zr + Z_CQ + l16 * 16 + 8);
                    R.ka = *(const v4u*)(zr + Z_CKV + l16 * 8);
                    R.kr1 = zr[Z_KR + l16]; R.kr2 = zr[Z_KR + 16 + l16];
                    R.cs = cosT[tk * 16 + l16]; R.sn = sinT[tk * 16 + l16];
                    R.fcv = fcbuf[tk * 4 + (l16 & 3)];
                };
                auto do_rowp = [&](int tk, const RowRegs& R) {
                    float f[8]; float ss = 0.f;
                    unpack8(R.ca, f);
#pragma unroll
                    for (int i = 0; i < 8; ++i) ss = fmaf(f[i], f[i], ss);
                    unpack8(R.cb, f);
#pragma unroll
                    for (int i = 0; i < 8; ++i) ss = fmaf(f[i], f[i], ss);
                    float s2 = 0.f;
                    unpack8(R.ka, f);
#pragma unroll
                    for (int i = 0; i < 8; ++i) s2 = fmaf(f[i], f[i], s2);
#pragma unroll
                    for (int o = 1; o < 16; o <<= 1) { ss += __shfl_xor(ss, o); s2 += __shfl_xor(s2, o); }
                    if (l16 == 0) { rq[tk] = rsqrtf(ss * (1.f / 256.f) + RMS_EPS); rkv[tk] = rsqrtf(s2 * (1.f / 128.f) + RMS_EPS); }
                    const float x1 = __uint_as_float((unsigned)R.kr1 << 16), x2 = __uint_as_float((unsigned)R.kr2 << 16);
                    krr16[tk * 32 + l16] = (bf16)f2bf(x1 * R.cs - x2 * R.sn); krr16[tk * 32 + 16 + l16] = (bf16)f2bf(x2 * R.cs + x1 * R.sn);
                    if (l16 < 4) {
                        const float xf = R.fcv + bfg;
                        logf[tk * 4 + l16] = fminf(xf, 0.f) - log1pf(expf(-fabsf(xf)));
                    }
                };
                {
                    RowRegs RA, RB; const int st = NGW * 4; int tk = gw * 4 + g16;
                    if (tk < NTOK) ld_row(tk, RA);
                    for (; tk < NTOK; tk += 2 * st) {
                        if (tk + st < NTOK) ld_row(tk + st, RB);
                        do_rowp(tk, RA);
                        if (tk + 2 * st < NTOK) ld_row(tk + 2 * st, RA);
                        if (tk + st < NTOK) do_rowp(tk + st, RB);
                    }
                }
            } else if constexpr (sp == 2) {
                {
                    pg8::Gemm g{z16 + Z_CQ, (const bf16*)(ws + WS_WUQ), NTOK, NQBP, 256, ZP, 256};
                    pg8::StaticOrder S; S.init(NTOK, NQBP, G, (int)blockIdx.x);
                    pg8::EpiRowScale E{qb16, NQBP, rq};
                    pg8::gemm_phase<pg8::EpiRowScale, pg8::StaticOrder, true, true>((LAS unsigned char*)lds_raw, g, S, E, tid);
                }
                {
                    pg8::Gemm g{z16 + Z_CKV, (const bf16*)(ws + WS_WUKV), NTOK, NKVB, 128, ZP, 128};
                    pg8::StaticOrder S; S.init(NTOK, NKVB, G, (int)((blockIdx.x + 128) % G));
                    pg8::EpiRowScale E{kvb16, NKVB, rkv};
                    pg8::gemm_phase<pg8::EpiRowScale, pg8::StaticOrder, true, true>((LAS unsigned char*)lds_raw, g, S, E, tid);
                }
                const int cw = NGW - 1 - gw;
                if (cw < 32) {
                    const int b = cw >> 2, hh = cw & 3;
                    float* cp = cum + ((size_t)b * SEQ) * 4 + hh; const float* lp = logf + ((size_t)b * SEQ) * 4 + hh;
                    float loc[32]; float run = 0.f;
#pragma unroll
                    for (int i = 0; i < 32; ++i) { run += lp[(size_t)(lane * 32 + i) * 4]; loc[i] = run; }
                    float pre = run;
#pragma unroll
                    for (int o = 1; o < 64; o <<= 1) { const float n = __shfl_up(pre, o); if (lane >= o) pre += n; }
                    pre -= run;
#pragma unroll
                    for (int i = 0; i < 32; ++i) cp[(size_t)(lane * 32 + i) * 4] = loc[i] + pre;
                }
            } else if constexpr (sp == 3) {
                float lam_init_, lam_;
                {
                    const float* lq1 = (const float*)KARG(8) + l * 32; const float* lk1 = (const float*)KARG(9) + l * 32; const float* lq2 = (const float*)KARG(10) + l * 32; const float* lk2 = (const float*)KARG(11) + l * 32;
                    lam_init_ = 0.8f - 0.6f * expf(-0.3f * (float)l);
                    float s1 = 0.f, s2 = 0.f;
                    for (int i = 0; i < 32; ++i) { s1 += lq1[i] * lk1[i]; s2 += lq2[i] * lk2[i]; }
                    lam_ = expf(s1) - expf(s2) + lam_init_;
                }
                AttnP p{z16, qb16, kvb16, krr16, cum, cosT, sinT, pos, mixed16,
                        (const float*)KARG(8) + l * 32, (const float*)KARG(9) + l * 32, (const float*)KARG(10) + l * 32, (const float*)KARG(11) + l * 32,
                        (const float*)KARG(12) + l * 64, l, ctl + 14000, (const int*)(ws + WS_RT + RT_TPMAX), lam_, lam_init_};
                volatile LAS int* qslot = (volatile LAS int*)((LAS unsigned char*)lds_raw + LDS_MISC) + 48;
                unsigned* qctr = ctl + 12288 + l * 64 + (DUMMY ? 32 : 0);
                if (tid < 64) *(LAS float*)((LAS unsigned char*)lds_raw + ATT_GD_OFF + tid * 4) = p.gdiff[tid];
                int idx = (int)blockIdx.x;
                for (;;) {
                    if (idx >= 1408) break;
                    int nxt_idx = 0;
                    if (wave_s == 0 && lane_id_now() == 0) nxt_idx = G + (int)atomicAdd(qctr, 1u);
                    const int pi = idx / 176, r = idx % 176, thi = 32 - 4 * pi;
                    if (r < 48) attn_unit<0>(p, r / 6, r % 6, thi / 2 - 1, (LAS unsigned char*)lds_raw, wave_s);
                    else if (r < 96) attn_unit<1>(p, (r - 48) / 6, (r - 48) % 6, thi / 4 - 1, (LAS unsigned char*)lds_raw, wave_s);
                    else if (r < 128) attn_unit<2>(p, (r - 96) / 4, (r - 96) % 4, thi / 4 - 1, (LAS unsigned char*)lds_raw, wave_s);
                    else attn_unit<0>(p, (r - 128) / 6, (r - 128) % 6, (thi - 2) / 2 - 1, (LAS unsigned char*)lds_raw, wave_s);
                    asm volatile("s_waitcnt lgkmcnt(0)\n\ts_barrier" ::: "memory");
                    if (wave_s == 0 && lane_id_now() == 0) *qslot = nxt_idx;
                    asm volatile("s_waitcnt lgkmcnt(0)\n\ts_barrier" ::: "memory");
                    idx = __builtin_amdgcn_readfirstlane(*qslot);
                }
            } else if constexpr (sp == 4) {
                pg8::Gemm g{mixed16, (const bf16*)(ws + WS_WOUT), NTOK, 1024, 1024, 1024, 1024};
                pg8::StaticOrder S; S.init(NTOK, 1024, G, (int)blockIdx.x);
                pg8::EpiBf16<0> E{mix16, 1024, nullptr, 0, 0, 1.f};
                pg8::gemm_phase<pg8::EpiBf16<0>, pg8::StaticOrder, true, true>((LAS unsigned char*)lds_raw, g, S, E, tid);
            } else if constexpr (sp == 5) {
#ifdef PROF_LN1
                if (l == 0 && blockIdx.x == 0 && tid == 0) ctl[14000 + 19] = (unsigned)(__builtin_amdgcn_s_memrealtime() & 0xffffffffu);
#endif
                LAS f32x4_t* Lg = (LAS f32x4_t*)lds_raw; LAS f32x4_t* Le = Lg + 1024;
                LAS unsigned* lcnt = (LAS unsigned*)((LAS unsigned char*)lds_raw + LDS_MISC) + 16;
                __syncthreads();
                if (tid < 32) lcnt[tid] = 0u;
                f32x4_t wgv[2];
#pragma unroll
                for (int u = 0; u < 2; ++u) wgv[u] = *(const f32x4_t*)(w_group + (size_t)(tid + u * NTHREADS) * 4);
                {
                    f32x4_t wv[16];
#pragma unroll
                    for (int u = 0; u < 16; ++u) wv[u] = *(const f32x4_t*)(w_er + (size_t)(tid + u * NTHREADS) * 4);
#pragma unroll
                    for (int u = 0; u < 16; ++u) { const int q = tid + u * NTHREADS; const int g = q >> 11, k = (q >> 1) & 1023, half = q & 1; const int j = k >> 8, ln = (k & 255) >> 2, i = k & 3;
                        Le[((g * 16 + j * 4 + i) * 2 + half) * 64 + ln] = wv[u]; }
#pragma unroll
                    for (int u = 0; u < 2; ++u) { const int k = tid + u * NTHREADS; const int j = k >> 8, ln = (k & 255) >> 2, i = k & 3; Lg[(j * 4 + i) * 64 + ln] = wgv[u]; }
                }
                __syncthreads();
#ifdef PROF_LN1
                if (l == 0 && blockIdx.x == 0 && tid == 0) ctl[14000 + 20] = (unsigned)(__builtin_amdgcn_s_memrealtime() & 0xffffffffu);
#endif
                v2u xvA[4], xvB[4], mwA[4], mwB[4];
                const float bgl = b_group[lane & 3], bel = b_er[lane & 31];
                float4 g1r[4], b1r[4];
#pragma unroll
                for (int j = 0; j < 4; ++j) { g1r[j] = *(const float4*)(ln1_g + j * 256 + lane * 4); b1r[j] = *(const float4*)(ln1_b + j * 256 + lane * 4); }
                auto ld_tok = [&](int tk_, v2u (&xv)[4], v2u (&mw)[4]) {
                    const int tk = tk_ < NTOK ? tk_ : gw;
#pragma unroll
                    for (int j = 0; j < 4; ++j) { xv[j] = *(const v2u*)(a16 + (size_t)tk * D_MODEL + j * 256 + lane * 4); mw[j] = *(const v2u*)(mix16 + (size_t)tk * D_MODEL + j * 256 + lane * 4); }
                };
                int rec_e = 0, rec_r = 0; float rec_w0 = 0.f, rec_w1 = 0.f;
                auto do_tok = [&](int tk, int ti, v2u (&xv)[4], v2u (&mw)[4]) {
                    float4 v[4]; float s = 0.f;
#pragma unroll
                    for (int j = 0; j < 4; ++j) {
                        v[j] = make_float4(ALPHA * bflo(xv[j].x) + bflo(mw[j].x), ALPHA * bfhi(xv[j].x) + bfhi(mw[j].x), ALPHA * bflo(xv[j].y) + bflo(mw[j].y), ALPHA * bfhi(xv[j].y) + bfhi(mw[j].y));
                        s += (v[j].x + v[j].y) + (v[j].z + v[j].w);
                    }
                    ld_tok(tk + 2 * NGW, xv, mw);
                    const float mean = wave_sum(s) * (1.f / 1024.f); float s2 = 0.f;
#pragma unroll
                    for (int j = 0; j < 4; ++j) { v[j].x -= mean; v[j].y -= mean; v[j].z -= mean; v[j].w -= mean; s2 += (v[j].x * v[j].x + v[j].y * v[j].y) + (v[j].z * v[j].z + v[j].w * v[j].w); }
                    const float rstd = rsqrtf(wave_sum(s2) * (1.f / 1024.f) + LN_EPS);
                    float glp[4] = {0.f, 0.f, 0.f, 0.f}, gl[4];
#pragma unroll
                    for (int j = 0; j < 4; ++j) {
                        const int d0 = j * 256 + lane * 4;
                        const float4 gg = g1r[j], bb = b1r[j];
                        v[j] = make_float4(v[j].x * rstd * gg.x + bb.x, v[j].y * rstd * gg.y + bb.y, v[j].z * rstd * gg.z + bb.z, v[j].w * rstd * gg.w + bb.w);
                        { v2u hb; hb.x = cvtpk(v[j].x, v[j].y); hb.y = cvtpk(v[j].z, v[j].w); *(v2u*)(a16 + (size_t)tk * D_MODEL + d0) = hb; }
                        const float hv[4] = {v[j].x, v[j].y, v[j].z, v[j].w};
#pragma unroll
                        for (int i = 0; i < 4; ++i) {
                            const f32x4_t wg = Lg[(j * 4 + i) * 64 + lane];
                            glp[0] = fmaf(hv[i], wg.x, glp[0]); glp[1] = fmaf(hv[i], wg.y, glp[1]); glp[2] = fmaf(hv[i], wg.z, glp[2]); glp[3] = fmaf(hv[i], wg.w, glp[3]);
                        }
                    }
                    { const float gs = wave_sum4(glp);
#pragma unroll
                      for (int i = 0; i < 4; ++i) gl[i] = __builtin_bit_cast(float, __builtin_amdgcn_readlane(__builtin_bit_cast(int, gs), 16 * i)) + __builtin_bit_cast(float, __builtin_amdgcn_readlane(__builtin_bit_cast(int, bgl), i)); }
                    int gi = 0; float gm = gl[0];
#pragma unroll
                    for (int i = 1; i < 4; ++i) if (gl[i] > gm) { gm = gl[i]; gi = i; }
                    gi = __builtin_amdgcn_readfirstlane(gi);
                    float gden = 0.f;
#pragma unroll
                    for (int i = 0; i < 4; ++i) gden += __expf(gl[i] - gm);
                    const float gwt = 1.f / gden;
                    float el[8] = {0.f, 0.f, 0.f, 0.f, 0.f, 0.f, 0.f, 0.f};
                    const LAS f32x4_t* we = Le + gi * 2048;
#pragma unroll
                    for (int j = 0; j < 4; ++j) {
                        const float hv[4] = {v[j].x, v[j].y, v[j].z, v[j].w};
#pragma unroll
                        for (int i = 0; i < 4; ++i) {
                            const f32x4_t w0 = we[((j * 4 + i) * 2) * 64 + lane], w1 = we[((j * 4 + i) * 2 + 1) * 64 + lane];
                            el[0] = fmaf(hv[i], w0.x, el[0]); el[1] = fmaf(hv[i], w0.y, el[1]); el[2] = fmaf(hv[i], w0.z, el[2]); el[3] = fmaf(hv[i], w0.w, el[3]);
                            el[4] = fmaf(hv[i], w1.x, el[4]); el[5] = fmaf(hv[i], w1.y, el[5]); el[6] = fmaf(hv[i], w1.z, el[6]); el[7] = fmaf(hv[i], w1.w, el[7]);
                        }
                    }
                    float els[8];
                    { const float es = wave_sum8(el, lane);
#pragma unroll
                      for (int i = 0; i < 8; ++i) els[i] = __builtin_bit_cast(float, __builtin_amdgcn_readlane(__builtin_bit_cast(int, es), 8 * i)) + __builtin_bit_cast(float, __builtin_amdgcn_readlane(__builtin_bit_cast(int, bel), gi * 8 + i)); }
                    int i0 = 0; float v0 = els[0];
#pragma unroll
                    for (int i = 1; i < 8; ++i) if (els[i] > v0) { v0 = els[i]; i0 = i; }
                    int i1 = -1; float v1 = -INFINITY;
#pragma unroll
                    for (int i = 0; i < 8; ++i) if (i != i0 && els[i] > v1) { v1 = els[i]; i1 = i; }
                    const float e1 = __expf(v1 - v0);
                    const float w0 = gwt / (1.f + e1), w1 = gwt * e1 / (1.f + e1);
                    const int ea = gi * 8 + i0, eb = gi * 8 + i1;
                    int ra = 0, rb = 0;
                    if (lane == 0) {
                        ra = (int)__hip_atomic_fetch_add(lcnt + ea, 1u, __ATOMIC_RELAXED, __HIP_MEMORY_SCOPE_WORKGROUP);
                        rb = (int)__hip_atomic_fetch_add(lcnt + eb, 1u, __ATOMIC_RELAXED, __HIP_MEMORY_SCOPE_WORKGROUP);
                    }
                    ra = __builtin_amdgcn_readfirstlane(ra); rb = __builtin_amdgcn_readfirstlane(rb);
                    if (lane == ti) { rec_e = ea | (eb << 8); rec_r = ra | (rb << 16); rec_w0 = w0; rec_w1 = w1; }
                };
                ld_tok(gw, xvA, mwA); ld_tok(gw + NGW, xvB, mwB);
                {
                    int tk = gw, ti = 0;
                    for (; tk + NGW < NTOK; tk += 2 * NGW, ti += 2) { do_tok(tk, ti, xvA, mwA); do_tok(tk + NGW, ti + 1, xvB, mwB); }
                    if (tk < NTOK) do_tok(tk, ti, xvA, mwA);
                }
#ifdef PROF_LN1
                if (l == 0 && blockIdx.x == 0 && tid == 0) ctl[14000 + 21] = (unsigned)(__builtin_amdgcn_s_memrealtime() & 0xffffffffu);
#endif
                asm volatile("s_waitcnt lgkmcnt(0)\n\ts_barrier" ::: "memory");
                if (tid < 32) { const unsigned n = lcnt[tid]; lcnt[tid] = n ? atomicAdd(cnt + tid * 64, n) : 0u; }
                asm volatile("s_waitcnt lgkmcnt(0)\n\ts_barrier" ::: "memory");
                {
                    const int tkm = gw + lane * NGW;
                    if (tkm < NTOK) {
                        const int ea = rec_e & 255, eb = rec_e >> 8;
                        const int ra = (rec_r & 0xffff) + (int)lcnt[ea], rb = (rec_r >> 16) + (int)lcnt[eb];
                        *(int2*)(ids + tkm * 2) = make_int2(ea, eb); *(float2*)(wts + tkm * 2) = make_float2(rec_w0, rec_w1); *(int2*)(rank + tkm * 2) = make_int2(ra, rb);
                        if (!DUMMY) { etok[ea * 16384 + ra] = tkm; etok[eb * 16384 + rb] = tkm; }
                    }
                }
                __syncthreads();
            } else if constexpr (sp == 6) {
                LAS int* xs = (LAS int*)((LAS unsigned char*)lds_raw + 131072); LAS int* te = xs + 80;
                __syncthreads();
                expert_prefix(cnt, xs, tid);
                if (tid < 32) xs[40 + tid] = (int)cnt[tid * 64];
                __syncthreads();
                if (tid < NSLOT_TILES) { int e = 31; for (int k = 31; k >= 0; --k) if (tid * 256 < xs[k + 1]) e = k; te[tid] = e; }
                __syncthreads();
                const int T = xs[32] >> 8, nU1 = 2 * T;
                const int vc = (int)((blockIdx.x % 8) * (G / 8) + blockIdx.x / 8);
                unsigned go[2][2][2]; int upm[2], upn[2]; int nun = 0;
#pragma unroll
                for (int i = 0; i < 2; ++i) {
                    const int g = vc + i * G;
                    upm[i] = 0; upn[i] = 0;
#pragma unroll
                    for (int h = 0; h < 2; ++h) { go[i][h][0] = 0u; go[i][h][1] = 0u; }
                    if (g < nU1) {
                        const int t = g >> 1, e = __builtin_amdgcn_readfirstlane(te[t]);
                        const int tl = t - (xs[e] >> 8), ce = xs[40 + e];
                        upm[i] = t + pg8::XPM; upn[i] = e * 2 + (g & 1) + pg8::XPN; nun = i + 1;
#pragma unroll
                        for (int pc = 0; pc < 2; ++pc) { int R, C; pg8::stage_rc(tid * 16 + pc * 8192, R, C);
#pragma unroll
                            for (int h = 0; h < 2; ++h) { const int rk = tl * 256 + h * 128 + R; const int tok = rk < ce ? etok[e * 16384 + rk] : 0; go[i][h][pc] = (unsigned)tok * 2048u + (unsigned)C * 2u; } }
                    } else if (g - nU1 < 256) {
                        const int k = g - nU1;
                        upm[i] = k >> 2; upn[i] = k & 3; nun = i + 1;
#pragma unroll
                        for (int pc = 0; pc < 2; ++pc) { int R, C; pg8::stage_rc(tid * 16 + pc * 8192, R, C);
#pragma unroll
                            for (int h = 0; h < 2; ++h) go[i][h][pc] = (unsigned)((k >> 2) * 256 + h * 128 + R) * 2048u + (unsigned)C * 2u; }
                    }
                }
                if (nun == 1) {
#pragma unroll
                    for (int h = 0; h < 2; ++h) { go[1][h][0] = go[0][h][0]; go[1][h][1] = go[0][h][1]; }
                }
                {
                    pg8::Gemm g{a16, (const bf16*)(ws + WS_WPG), NTOK, 1024, 1024, 1024, 1024};
                    pg8::TwoUnits S{upm[0], upn[0], upm[1], upn[1], nun};
                    pg8::EpiX E{pg8::EpiGU{act16}, pg8::EpiPleGate{ple16, pp16}};
                    pg8::gemm_phase_ga<pg8::EpiX, pg8::TwoUnits, true, true>((LAS unsigned char*)lds_raw, g, S, E, tid, go[0], go[1]);
                }
            } else if constexpr (sp == 7) {
                LAS int* xs = (LAS int*)((LAS unsigned char*)lds_raw + 131072); LAS int* te = xs + 80;
                __syncthreads();
                expert_prefix(cnt, xs, tid);
                __syncthreads();
                if (tid < NSLOT_TILES) { int e = 31; for (int k = 31; k >= 0; --k) if (tid * 256 < xs[k + 1]) e = k; te[tid] = e; }
                __syncthreads();
                const int T = xs[32] >> 8;
                const int vc = (int)((blockIdx.x % 8) * (G / 8) + blockIdx.x / 8);
                int nB2 = 2 * T - G; nB2 = nB2 < 0 ? 0 : nB2;
                if (vc >= nB2) {
                    pg8::Gemm g{act16, (const bf16*)(ws + WS_WD), MAX_SLOTS, 32 * 1024, 256, 256, 256};
                    pg8::GroupSched S{(const int*)te, T, 4, G - nB2, vc - nB2};
                    pg8::EpiDown E{outs16};
                    pg8::gemm_phase<pg8::EpiDown, pg8::GroupSched, true, true>((LAS unsigned char*)lds_raw, g, S, E, tid);
                } else {
                    const int k = 256 - nB2 + vc;
                    pg8::Gemm g{a16, (const bf16*)(ws + WS_WPG), NTOK, 1024, 1024, 1024, 1024};
                    pg8::OneUnit S{k >> 2, k & 3};
                    pg8::EpiPleGate E{ple16, pp16};
                    pg8::gemm_phase<pg8::EpiPleGate, pg8::OneUnit, true, true>((LAS unsigned char*)lds_raw, g, S, E, tid);
                }
            } else if constexpr (sp == 8) {
                LAS int* xs = (LAS int*)((LAS unsigned char*)lds_raw + 131072);
                __syncthreads();
                expert_prefix(cnt, xs, tid);
                __syncthreads();
                struct Ln2Regs { v2u hv[4], oa[4], ob[4], pv[4]; float w0, w1; };
                Ln2Regs RA, RB;
                float4 g2r[4], b2r[4];
#pragma unroll
                for (int j = 0; j < 4; ++j) { g2r[j] = *(const float4*)(ln2_g + j * 256 + lane * 4); b2r[j] = *(const float4*)(ln2_b + j * 256 + lane * 4); }
                int ms0 = 0, ms1 = 0; float mw0 = 0.f, mw1 = 0.f;
                { const int tkm = gw + lane * NGW;
                  if (tkm < NTOK) { ms0 = xs[ids[tkm * 2]] + rank[tkm * 2]; ms1 = xs[ids[tkm * 2 + 1]] + rank[tkm * 2 + 1]; mw0 = wts[tkm * 2]; mw1 = wts[tkm * 2 + 1]; } }
                auto ld_rows = [&](int tk, int ti, Ln2Regs& R) {
                    if (tk < NTOK) {
                        const int s0 = __builtin_amdgcn_readlane(ms0, ti), s1 = __builtin_amdgcn_readlane(ms1, ti);
                        R.w0 = __builtin_bit_cast(float, __builtin_amdgcn_readlane(__builtin_bit_cast(int, mw0), ti)); R.w1 = __builtin_bit_cast(float, __builtin_amdgcn_readlane(__builtin_bit_cast(int, mw1), ti));
#pragma unroll
                        for (int j = 0; j < 4; ++j) {
                            const int d0 = j * 256 + lane * 4;
                            R.hv[j] = *(const v2u*)(a16 + (size_t)tk * D_MODEL + d0);
                            R.oa[j] = *(const v2u*)(outs16 + (size_t)s0 * D_MODEL + d0); R.ob[j] = *(const v2u*)(outs16 + (size_t)s1 * D_MODEL + d0);
                            R.pv[j] = *(const v2u*)(ple16 + (size_t)tk * D_MODEL + d0);
                        }
                    }
                };
                auto do_row = [&](int tk, int ti, Ln2Regs& R) {
                    float4 v[4]; float s = 0.f; const float w0 = R.w0, w1 = R.w1;
#pragma unroll
                    for (int j = 0; j < 4; ++j) {
                        v[j] = make_float4(ALPHA * bflo(R.hv[j].x) + w0 * bflo(R.oa[j].x) + w1 * bflo(R.ob[j].x) + bflo(R.pv[j].x), ALPHA * bfhi(R.hv[j].x) + w0 * bfhi(R.oa[j].x) + w1 * bfhi(R.ob[j].x) + bfhi(R.pv[j].x),
                                           ALPHA * bflo(R.hv[j].y) + w0 * bflo(R.oa[j].y) + w1 * bflo(R.ob[j].y) + bflo(R.pv[j].y), ALPHA * bfhi(R.hv[j].y) + w0 * bfhi(R.oa[j].y) + w1 * bfhi(R.ob[j].y) + bfhi(R.pv[j].y));
                        s += (v[j].x + v[j].y) + (v[j].z + v[j].w);
                    }
                    ld_rows(tk + 2 * NGW, ti + 2, R);
                    const float mean = wave_sum(s) * (1.f / 1024.f); float s2 = 0.f;
#pragma unroll
                    for (int j = 0; j < 4; ++j) { v[j].x -= mean; v[j].y -= mean; v[j].z -= mean; v[j].w -= mean; s2 += (v[j].x * v[j].x + v[j].y * v[j].y) + (v[j].z * v[j].z + v[j].w * v[j].w); }
                    const float rstd = rsqrtf(wave_sum(s2) * (1.f / 1024.f) + LN_EPS);
#pragma unroll
                    for (int j = 0; j < 4; ++j) {
                        const int d0 = j * 256 + lane * 4;
                        const float4 gg = g2r[j], bb = b2r[j];
                        const float4 o = make_float4(v[j].x * rstd * gg.x + bb.x, v[j].y * rstd * gg.y + bb.y, v[j].z * rstd * gg.z + bb.z, v[j].w * rstd * gg.w + bb.w);
                        if (!DUMMY || w0 == 12345.678f) {
                        if (l == DEPTH - 1) {
#ifdef PROF_SEL
#ifdef PROF_LN1
                        float4 oo = o; { const float dlt = sqrtf((float)(ctl[14000 + PROF_LN1 + 1] - ctl[14000 + PROF_LN1]) * 1e-8f);
#else
                        float4 oo = o; { const float dlt = sqrtf((float)ctl[14000 + PROF_SEL] * 1e-8f);
#endif
                        oo.x += dlt; oo.y += dlt; oo.z += dlt; oo.w += dlt; }
                        *(float4*)(KOUT + (size_t)tk * D_MODEL + d0) = oo;
#else
                        *(float4*)(KOUT + (size_t)tk * D_MODEL + d0) = o;
#endif
                        } else {
                        v2u ob16; ob16.x = cvtpk(o.x, o.y); ob16.y = cvtpk(o.z, o.w);
                        *(v2u*)(a16 + (size_t)tk * D_MODEL + d0) = ob16;
                        }
                        }
                    }
                };
                ld_rows(gw, 0, RA); ld_rows(gw + NGW, 1, RB);
                for (int tk = gw, ti = 0; tk < NTOK; tk += 2 * NGW, ti += 2) {
                    do_row(tk, ti, RA);
                    if (tk + NGW < NTOK) do_row(tk + NGW, ti + 1, RB);
                }
                if (l + 1 < DEPTH) convert_layer_weights(a, l + 1, ws, scr, gw, NGW, lane);
            }
        }
}

constexpr int CW_BAR = 4096;
constexpr int CW_BAR2 = 15360;
__global__ void __launch_bounds__(NTHREADS, 2) mega(Args a) {
    extern __shared__ __attribute__((aligned(16))) unsigned char lds_raw[];
    cg::grid_group grid = cg::this_grid();
    volatile LAS unsigned* misc = (volatile LAS unsigned*)((LAS unsigned char*)lds_raw + LDS_MISC);
    if (threadIdx.x < 16) misc[threadIdx.x] = 0u;
    __syncthreads();
    XcdBarrier bar = xcd_barrier_post((unsigned*)(a.ws + WS_CTL) + CW_BAR, misc + 8);
    const int wave_s = __builtin_amdgcn_readfirstlane(threadIdx.x >> 6);
#define IS_T0 (wave_s == 0 && lane_id_now() == 0)
#ifndef DUP_SP
#define DUP_SP -1
#endif
#ifndef DUP_X
#define DUP_X 0
#endif
    if (a.ph_hi < 0) grid.sync();
#define SEAM(ph) do { xcd_barrier2(bar, (unsigned*)(a.ws + WS_CTL) + CW_BAR2, wave_s); } while (0)
#ifdef PROF_PH
    unsigned long long ph_t_prev = __builtin_amdgcn_s_memrealtime();
#define PHASE_STAMP(ph) do { const unsigned long long t_ = __builtin_amdgcn_s_memrealtime(); if ((ph) == PROF_PH && blockIdx.x == 0 && IS_T0) ((unsigned*)(a.ws + WS_CTL))[14000 + PROF_SEL] = (unsigned)(t_ - ph_t_prev); ph_t_prev = t_; } while (0)
#else
#define PHASE_STAMP(ph) do {} while (0)
#endif
#define RUN(ph) if (a.ph_lo <= (ph) && (ph) < a.ph_hi) { \
        if (DUP_X == 9 && (ph) > 0 && ((ph) - 1) % PH_PER_LAYER == 9) { run_phase<ph, true>(a, lds_raw, wave_s); xcd_barrier(bar, IS_T0); } \
        run_phase<ph>(a, lds_raw, wave_s); \
        if ((ph) > 0 && ((ph) - 1) % PH_PER_LAYER == DUP_SP) { xcd_barrier(bar, IS_T0); run_phase<ph>(a, lds_raw, wave_s); } \
        if (DUP_X == 100 && (ph) == 0) { xcd_barrier(bar, IS_T0); run_phase<ph>(a, lds_raw, wave_s); } \
        if (DUP_X == 5 && (ph) == 6) { xcd_barrier(bar, IS_T0); run_phase<ph, true>(a, lds_raw, wave_s); } \
        if (DUP_X == 3 && (ph) > 0 && ((ph) - 1) % PH_PER_LAYER == 3) { xcd_barrier(bar, IS_T0); run_phase<ph, true>(a, lds_raw, wave_s); } \
        if ((ph) + 1 < a.ph_hi && (ph) + 1 < NPH) SEAM(ph); PHASE_STAMP(ph); }
    RUN(0) RUN(1) RUN(2) RUN(3) RUN(4) RUN(5) RUN(6) RUN(7) RUN(8) RUN(9)
    RUN(10) RUN(11) RUN(12) RUN(13) RUN(14) RUN(15) RUN(16) RUN(17) RUN(18)
#undef RUN
#undef SEAM
}

extern "C" void kernel_launch(void* const* d_in, const int* in_sizes, int n_in, void* d_out, int out_size, void* d_ws, size_t ws_size, hipStream_t stream) {
    static int grid = 0;
    if (grid == 0) {
        if (n_in != 28 || ws_size < WS_END) { fprintf(stderr, "kernel_launch: unexpected n_in %d or ws_size %zu (< %zu)\n", n_in, ws_size, (size_t)WS_END); grid = -1; return; }
        int dev = 0, cus = 0, per_cu = 0;
        (void)hipGetDevice(&dev);
        (void)hipDeviceGetAttribute(&cus, hipDeviceAttributeMultiprocessorCount, dev);
        (void)hipFuncSetAttribute((const void*)mega, hipFuncAttributeMaxDynamicSharedMemorySize, LDS_BYTES);
        (void)hipOccupancyMaxActiveBlocksPerMultiprocessor(&per_cu, (const void*)mega, NTHREADS, LDS_BYTES);
        if (per_cu < 1) { fprintf(stderr, "kernel_launch: occupancy query says %d blocks/CU\n", per_cu); }
        (void)hipGetLastError();
        grid = cus;
    }
    if (grid < 0) return;
    (void)hipMemsetAsync((char*)d_ws + WS_CTL, 0, 64 * 1024, stream);
    Args a{};
    for (int i = 0; i < 28; ++i) a.in[i] = d_in[i];
    a.out = (float*)d_out; a.ws = (unsigned char*)d_ws; a.ph_lo = 0; a.ph_hi = NPH;
    void* params[] = {&a};
    hipError_t e = hipLaunchCooperativeKernel((const void*)mega, dim3(grid), dim3(NTHREADS), params, LDS_BYTES, stream);
    if (e != hipSuccess) fprintf(stderr, "cooperative launch failed: %s (grid %d)\n", hipGetErrorString(e), grid);
}
```
